# Optimizing an MI355X kernel written in HIP

```python
import jax, jax.numpy as jnp
from jax import lax
import numpy as np

D_MODEL = 1024
BATCH = 4
SEQ = 4096
DEPTH = 2

HEAD_DIM = 64
N_Q_HEADS = 8
N_KV_HEADS = 2
MIX_WIDTH = N_Q_HEADS * HEAD_DIM
KV_WIDTH = N_KV_HEADS * HEAD_DIM
N_MIXERS = 3
D_FF = 4 * D_MODEL
ROPE_THETA = 10000.0
EPS = 1e-6
NEG_INF = -1e30
Q_BLOCK = 128

IDX_HEADS = 4
IDX_DIM = 64
DSA_TOPK_MAX = 256

SWA_WINDOW = 128

CMP_LEN = 32
CMP_STRIDE = 16
CMP_HIDDEN = 256
SLC_LEN = 64
SLC_TOPN = 16
SLC_Q_BLOCK = 64
NSA_WINDOW = 512
FORCE_SCORE = 1e9

IN_SIZES = (
    MIX_WIDTH, KV_WIDTH, KV_WIDTH, IDX_HEADS * IDX_DIM, IDX_DIM, IDX_HEADS,
    MIX_WIDTH, KV_WIDTH, KV_WIDTH,
    MIX_WIDTH, KV_WIDTH, KV_WIDTH, KV_WIDTH, KV_WIDTH, KV_WIDTH, KV_WIDTH, 3 * N_Q_HEADS,
    N_MIXERS * D_MODEL,
)
D_IN = sum(IN_SIZES)
IN_OFFSETS = tuple(int(o) for o in np.cumsum(IN_SIZES)[:-1])

kernel_name = "hybrid_dsa_swa_nsa_block"


def rms_norm(x, g):
    xf = x.astype(jnp.float32)
    y = xf * lax.rsqrt(jnp.mean(xf * xf, axis=-1, keepdims=True) + EPS)
    return (y * g.astype(jnp.float32)).astype(x.dtype)


def rope_tables(seq_len, dim):
    inv_freq = ROPE_THETA ** (-jnp.arange(0, dim, 2, dtype=jnp.float32) / dim)
    ang = jnp.arange(seq_len, dtype=jnp.float32)[:, None] * inv_freq[None, :]
    return jnp.cos(ang), jnp.sin(ang)


def apply_rope(x, cos, sin):
    c = cos[None, :, None, :].astype(x.dtype)
    s = sin[None, :, None, :].astype(x.dtype)
    x1, x2 = jnp.split(x, 2, axis=-1)
    return jnp.concatenate([x1 * c - x2 * s, x2 * c + x1 * s], axis=-1)


def masked_softmax(s, mask):
    p = jax.nn.softmax(jnp.where(mask, s.astype(jnp.float32), NEG_INF), axis=-1)
    return p * mask.astype(jnp.float32)


def to_blocks(t, n_blocks):
    return jnp.swapaxes(t.reshape(t.shape[0], n_blocks, -1, *t.shape[2:]), 0, 1)


def from_blocks(t):
    t = jnp.swapaxes(t, 0, 1)
    return t.reshape(t.shape[0], -1, *t.shape[3:])


def banded_attention(q, k, v, window, sinks):
    B, T, H, D = q.shape
    Hkv = k.shape[2]
    G = H // Hkv
    nb = T // Q_BLOCK
    n_prev = (window + Q_BLOCK - 2) // Q_BLOCK
    pad = n_prev * Q_BLOCK
    width = pad + Q_BLOCK
    kp = jnp.pad(k, ((0, 0), (pad, 0), (0, 0), (0, 0)))
    vp = jnp.pad(v, ((0, 0), (pad, 0), (0, 0), (0, 0)))

    def band(t):
        return jnp.concatenate(
            [t[:, j * Q_BLOCK: j * Q_BLOCK + T].reshape(B, nb, Q_BLOCK, Hkv, D) for j in range(n_prev + 1)], axis=2)

    kb, vb = band(kp), band(vp)
    qb = q.reshape(B, nb, Q_BLOCK, Hkv, G, D)
    r = jnp.arange(Q_BLOCK)[:, None]
    c = jnp.arange(width)[None, :]
    rel = r + pad - c
    kpos = jnp.arange(nb)[:, None, None] * Q_BLOCK - pad + c[None]
    mask = (rel >= 0)[None] & (rel < window)[None] & (kpos >= 0)
    s = jnp.einsum('bnqhgd,bnchd->bnhgqc', qb, kb).astype(jnp.float32) * (D ** -0.5)
    s = jnp.where(mask[None, :, None, None], s, NEG_INF)
    if sinks is not None:
        sink = jnp.broadcast_to(sinks.astype(jnp.float32).reshape(1, 1, Hkv, G, 1, 1), s.shape[:-1] + (1,))
        p = jax.nn.softmax(jnp.concatenate([s, sink], axis=-1), axis=-1)[..., :-1]
    else:
        p = jax.nn.softmax(s, axis=-1)
    o = jnp.einsum('bnhgqc,bnchd->bnqhgd', p.astype(v.dtype), vb)
    return o.reshape(B, T, H, D)


def dsa_attention(q, k, v, iq, ik, iw):
    B, T, H, D = q.shape
    Hkv = k.shape[2]
    G = H // Hkv
    k_top = min(DSA_TOPK_MAX, T // 4)
    nb = T // Q_BLOCK
    kpos = jnp.arange(T)
    gather = jax.vmap(lambda table, idx: table[idx])

    def one_block(inp):
        i, qb, iqb, iwb = inp
        qpos = i * Q_BLOCK + jnp.arange(Q_BLOCK)
        rel = jax.nn.relu(jnp.einsum('bqhd,bsd->bqhs', iqb, ik).astype(jnp.float32) * (IDX_DIM ** -0.5))
        score = jnp.einsum('bqh,bqhs->bqs', iwb.astype(jnp.float32), rel)
        score = jnp.where((kpos[None, :] <= qpos[:, None])[None], score, NEG_INF)
        _, idx = lax.top_k(score, k_top)
        kg, vg = gather(k, idx), gather(v, idx)
        s = jnp.einsum('bqhgd,bqkhd->bqhgk', qb.reshape(B, Q_BLOCK, Hkv, G, D), kg).astype(jnp.float32) * (D ** -0.5)
        p = masked_softmax(s, (idx <= qpos[None, :, None])[:, :, None, None, :])
        o = jnp.einsum('bqhgk,bqkhd->bqhgd', p.astype(v.dtype), vg)
        return o.reshape(B, Q_BLOCK, H, D)

    out = lax.map(one_block, (jnp.arange(nb), to_blocks(q, nb), to_blocks(iq, nb), to_blocks(iw, nb)))
    return from_blocks(out)


def nsa_attention(q, kc, vc, ks, vs, kw, vw, gates, pe_k, pe_v, w_ck1, w_ck2, w_cv1, w_cv2):
    B, T, H, D = q.shape
    Hkv = kc.shape[2]
    G = H // Hkv
    scale = D ** -0.5
    tpos = jnp.arange(T)
    qg = q.reshape(B, T, Hkv, G, D)

    n_cmp = (T - CMP_LEN) // CMP_STRIDE + 1
    cstart = jnp.arange(n_cmp) * CMP_STRIDE
    win = cstart[:, None] + jnp.arange(CMP_LEN)[None, :]

    def compress(t, pe, w1, w2):
        blk = t[:, win] + pe[None, None, :, None, :]
        blk = jnp.swapaxes(blk, 2, 3).reshape(B, n_cmp, Hkv, CMP_LEN * D)
        return jax.nn.relu(blk @ w1) @ w2

    k_cmp = compress(kc, pe_k, w_ck1, w_ck2)
    v_cmp = compress(vc, pe_v, w_cv1, w_cv2)
    cmask = (cstart + CMP_LEN - 1)[None, :] <= tpos[:, None]
    s_cmp = jnp.einsum('bthgd,bchd->bthgc', qg, k_cmp).astype(jnp.float32) * scale
    p_cmp = masked_softmax(s_cmp, cmask[None, :, None, None, :])
    o_cmp = jnp.einsum('bthgc,bchd->bthgd', p_cmp.astype(vc.dtype), v_cmp)

    n_sel = T // SLC_LEN
    n_top = min(SLC_TOPN, n_sel)
    sstart = jnp.arange(n_sel) * SLC_LEN
    overlap = ((cstart[:, None] < sstart[None, :] + SLC_LEN)
               & (cstart[:, None] + CMP_LEN > sstart[None, :])).astype(jnp.float32)
    imp = jnp.einsum('bthgc,cj->bthj', p_cmp, overlap)
    cur = (tpos // SLC_LEN)[:, None]
    jb = jnp.arange(n_sel)[None, :]
    forced = (jb == 0) | (jb == cur) | (jb == cur - 1)
    imp = jnp.where(forced[None, :, None, :], FORCE_SCORE, imp)
    imp = jnp.where((sstart[None, :] <= tpos[:, None])[None, :, None, :], imp, NEG_INF)
    _, sel = lax.top_k(imp, n_top)
    ks_blk = jnp.moveaxis(ks.reshape(B, n_sel, SLC_LEN, Hkv, D), 3, 1)
    vs_blk = jnp.moveaxis(vs.reshape(B, n_sel, SLC_LEN, Hkv, D), 3, 1)
    gather = jax.vmap(jax.vmap(lambda table, idx: table[idx]))
    n_qb = T // SLC_Q_BLOCK
    n_keys = n_top * SLC_LEN

    def one_block(inp):
        i, qb, selb = inp
        qpos = i * SLC_Q_BLOCK + jnp.arange(SLC_Q_BLOCK)
        st = jnp.swapaxes(selb, 1, 2)
        kg = gather(ks_blk, st).reshape(B, Hkv, SLC_Q_BLOCK, n_keys, D)
        vg = gather(vs_blk, st).reshape(B, Hkv, SLC_Q_BLOCK, n_keys, D)
        kpos = (st[..., None] * SLC_LEN + jnp.arange(SLC_LEN)).reshape(B, Hkv, SLC_Q_BLOCK, n_keys)
        valid = jnp.swapaxes(kpos <= qpos[None, None, :, None], 1, 2)
        s = jnp.einsum('bqhgd,bhqkd->bqhgk', qb, kg).astype(jnp.float32) * scale
        p = masked_softmax(s, valid[:, :, :, None, :])
        return jnp.einsum('bqhgk,bhqkd->bqhgd', p.astype(vs.dtype), vg)

    o_slc = from_blocks(lax.map(one_block, (jnp.arange(n_qb), to_blocks(qg, n_qb), to_blocks(sel, n_qb))))

    o_win = banded_attention(q, kw, vw, NSA_WINDOW, None)

    g = jax.nn.sigmoid(gates.reshape(B, T, H, 3))
    return (g[..., 0:1] * o_cmp.reshape(B, T, H, D)
            + g[..., 1:2] * o_slc.reshape(B, T, H, D)
            + g[..., 2:3] * o_win)


def setup_inputs(seed: int = 0) -> dict:
    key = jax.random.key(seed)
    ks = jax.random.split(key, 18)

    def nrm(k, shape, scale):
        return jax.random.normal(k, shape, jnp.float32) * scale

    return {
        "x": nrm(ks[0], (BATCH, SEQ, D_MODEL), 1.0),
        "norm_mix": 1.0 + nrm(ks[1], (DEPTH, D_MODEL), 0.1),
        "w_in": nrm(ks[2], (DEPTH, D_MODEL, D_IN), D_MODEL ** -0.5),
        "q_norm": 1.0 + nrm(ks[3], (DEPTH, N_MIXERS, HEAD_DIM), 0.1),
        "k_norm": 1.0 + nrm(ks[4], (DEPTH, N_MIXERS, HEAD_DIM), 0.1),
        "sinks": nrm(ks[5], (DEPTH, N_Q_HEADS), 1.0),
        "cmp_pe_k": nrm(ks[6], (DEPTH, CMP_LEN, HEAD_DIM), 0.1),
        "cmp_pe_v": nrm(ks[7], (DEPTH, CMP_LEN, HEAD_DIM), 0.1),
        "w_ck1": nrm(ks[8], (DEPTH, CMP_LEN * HEAD_DIM, CMP_HIDDEN), (CMP_LEN * HEAD_DIM) ** -0.5),
        "w_ck2": nrm(ks[9], (DEPTH, CMP_HIDDEN, HEAD_DIM), (CMP_HIDDEN / 2) ** -0.5),
        "w_cv1": nrm(ks[10], (DEPTH, CMP_LEN * HEAD_DIM, CMP_HIDDEN), (CMP_LEN * HEAD_DIM) ** -0.5),
        "w_cv2": nrm(ks[11], (DEPTH, CMP_HIDDEN, HEAD_DIM), (CMP_HIDDEN / 2) ** -0.5),
        "w_branch": nrm(ks[12], (DEPTH, N_MIXERS, MIX_WIDTH, D_MODEL), MIX_WIDTH ** -0.5),
        "w_out": nrm(ks[13], (DEPTH, D_MODEL, D_MODEL), D_MODEL ** -0.5),
        "norm_mlp": 1.0 + nrm(ks[14], (DEPTH, D_MODEL), 0.1),
        "w_up": nrm(ks[15], (DEPTH, D_MODEL, D_FF), D_MODEL ** -0.5),
        "w_down": nrm(ks[16], (DEPTH, D_FF, D_MODEL), D_FF ** -0.5),
    }


def reference(x, norm_mix, w_in, q_norm, k_norm, sinks, cmp_pe_k, cmp_pe_v,
              w_ck1, w_ck2, w_cv1, w_cv2, w_branch, w_out, norm_mlp, w_up, w_down):
    B, T, _ = x.shape
    cos, sin = rope_tables(T, HEAD_DIM)

    def heads(t, n):
        return t.reshape(B, T, n, -1)

    def qk(t, n, gain):
        return apply_rope(rms_norm(heads(t, n), gain), cos, sin)

    for l in range(DEPTH):
        h = rms_norm(x, norm_mix[l])
        z = h @ w_in[l]
        (qa, ka, va, iq, ik, iw, qb, kb, vb,
         qc, kc, vc, ksl, vsl, kwn, vwn, gc, gm) = jnp.split(z, IN_OFFSETS, axis=-1)

        o_a = dsa_attention(qk(qa, N_Q_HEADS, q_norm[l, 0]), qk(ka, N_KV_HEADS, k_norm[l, 0]),
                            heads(va, N_KV_HEADS),
                            apply_rope(heads(iq, IDX_HEADS), cos, sin),
                            apply_rope(heads(ik, 1), cos, sin)[:, :, 0],
                            iw * (IDX_HEADS ** -0.5))
        o_b = banded_attention(qk(qb, N_Q_HEADS, q_norm[l, 1]), qk(kb, N_KV_HEADS, k_norm[l, 1]),
                               heads(vb, N_KV_HEADS), SWA_WINDOW, sinks[l])
        kn = k_norm[l, 2]
        o_c = nsa_attention(qk(qc, N_Q_HEADS, q_norm[l, 2]),
                            qk(kc, N_KV_HEADS, kn), heads(vc, N_KV_HEADS),
                            qk(ksl, N_KV_HEADS, kn), heads(vsl, N_KV_HEADS),
                            qk(kwn, N_KV_HEADS, kn), heads(vwn, N_KV_HEADS),
                            gc, cmp_pe_k[l], cmp_pe_v[l], w_ck1[l], w_ck2[l], w_cv1[l], w_cv2[l])

        o_all = jnp.stack([o_a, o_b, o_c], axis=2).reshape(B, T, N_MIXERS, MIX_WIDTH)
        y = jnp.einsum('btnc,ncd->btnd', o_all, w_branch[l])
        g = jax.nn.sigmoid(gm.reshape(B, T, N_MIXERS, D_MODEL))
        x = x + jnp.sum(g * y, axis=2) @ w_out[l]

        h2 = rms_norm(x, norm_mlp[l])
        x = x + jnp.square(jax.nn.relu(h2 @ w_up[l])) @ w_down[l]
    return x
```

```cpp
#include <hip/hip_runtime.h>
#include <cstdio>
#include <cstdint>

namespace pg8 {
#define PG8_LAS __attribute__((address_space(3)))
typedef unsigned short bf16_t;
typedef short bf16x8 __attribute__((ext_vector_type(8)));
typedef float f32x4 __attribute__((ext_vector_type(4)));
typedef unsigned u32x4 __attribute__((ext_vector_type(4)));
constexpr int BM = 256, BK = 64, HALF = 128, HTB = HALF * BK * 2  , STAGE_BYTES = 8 * HTB, NXCD = 8, WGM = 8;

__host__ __device__ __forceinline__ int lds_byte(int r, int c) { const int st = (r >> 4) * 2 + (c >> 5), rr = r & 15, cc = c & 31, ob = rr * 64 + cc * 2; return st * 1024 + (ob ^ (((ob >> 9) & 1) << 5)); }
__host__ __device__ __forceinline__ void stage_rc(int b, int& R, int& C) { const int st = b / 1024, sb = b % 1024, swz = sb ^ (((sb >> 9) & 1) << 5); R = (st >> 1) * 16 + swz / 64; C = (st & 1) * 32 + (swz % 64) / 2; }
__host__ __device__ __forceinline__ int perm32(int rho) { const int n = rho >> 4, i = rho & 15; return 8 * (i >> 2) + 4 * n + (i & 3); }

struct Unit { int pm, pn; };
struct Gemm { const bf16_t* A; const bf16_t* Bt; int M, N, K; };

struct StaticOrder {
    int nM, nN, nwg, G, c;
    __host__ __device__ void init(int M, int N, int G_, int c_) { nM = M / BM; nN = N / BM; nwg = nM * nN; G = G_; c = c_; }
    __host__ __device__ bool next(int i, Unit& u) const {
        const long L = (long)i * G + c; if (L >= nwg) return false;
        int wgid = (int)L; { const int q = nwg / NXCD, r = nwg % NXCD, xcd = wgid % NXCD, off = wgid / NXCD; wgid = (xcd < r ? xcd * (q + 1) : r * (q + 1) + (xcd - r) * q) + off; }
        const int nig = WGM * nN, gid = wgid / nig, fm = gid * WGM, gsz = (nM - fm) < WGM ? (nM - fm) : WGM;
        u.pm = fm + ((wgid % nig) % gsz); u.pn = (wgid % nig) / gsz; return true;
    }
    __device__ __forceinline__ void a_ready(const Unit&) const {}
    __device__ __forceinline__ void done(const Unit&) const {}
};

__device__ __forceinline__ unsigned cvt_pk_bf16(float lo, float hi) { unsigned r; asm volatile("v_cvt_pk_bf16_f32 %0, %1, %2" : "=v"(r) : "v"(lo), "v"(hi)); return r; }
template <class Epi, class Sched, bool ALIGN_EPI = false, bool SP2 = false>
__device__ __forceinline__ void gemm_phase(PG8_LAS unsigned char* lds, const Gemm g, const Sched& S, const Epi& E) {
    int tid_l = threadIdx.x; asm volatile("" : "+v"(tid_l));
    const int tid = tid_l, wid = __builtin_amdgcn_readfirstlane(tid >> 6), lane = tid & 63, wr = wid >> 2, wc = wid & 3, fr = lane & 15, fq = lane >> 4;
    const int K = g.K, nt = K / BK;
    unsigned voffA[2], voffB[2];
#pragma unroll
    for (int i = 0; i < 2; ++i) { int R, C; stage_rc(tid * 16 + i * 8192, R, C); const int Rb = Epi::PERM ? ((R & ~31) + perm32(R & 31)) : R;
        voffA[i] = (unsigned)(R * K + C) * 2u; voffB[i] = (unsigned)(Rb * K + C) * 2u; }
    const size_t kstep = (size_t)(BK * 2);
    const size_t hstep = (size_t)HALF * K * 2;
    const size_t tstep = 2 * hstep;
    const unsigned ldsw = (unsigned)wid * 1024u;
    const int aoff = lds_byte(wr * 64 + fr, fq * 8), boff = lds_byte(wc * 32 + fr, fq * 8);
#define PG8_SA(b, h) (((b) * 2 + (h)) * HTB)
#define PG8_SB(b, h) ((4 + (b) * 2 + (h)) * HTB)
#define PG8_STAGE(bufoff, gbase, voff) do { _Pragma("unroll") for (int _i = 0; _i < 2; ++_i) \
        __builtin_amdgcn_global_load_lds((const unsigned*)((const char*)(gbase) + (voff)[_i]), (PG8_LAS unsigned*)(lds + (bufoff) + ldsw + _i * 8192), 16, 0, 0); } while (0)
#define PG8_LDA(dst, b, h) do { _Pragma("unroll") for (int m = 0; m < 4; ++m) _Pragma("unroll") for (int k = 0; k < 2; ++k) dst[m][k] = *(const PG8_LAS bf16x8*)(lds + PG8_SA(b, h) + aoff + m * 2048 + k * 1024); } while (0)
#define PG8_LDB(dst, b, h) do { _Pragma("unroll") for (int n = 0; n < 2; ++n) _Pragma("unroll") for (int k = 0; k < 2; ++k) dst[n][k] = *(const PG8_LAS bf16x8*)(lds + PG8_SB(b, h) + boff + n * 2048 + k * 1024); } while (0)
#define PG8_MMA(ai, bj, At, Bt) do { __builtin_amdgcn_s_setprio(1); _Pragma("unroll") for (int m = 0; m < 4; ++m) _Pragma("unroll") for (int n = 0; n < 2; ++n) _Pragma("unroll") for (int k = 0; k < 2; ++k) \
        acc[ai][bj][m][n] = __builtin_amdgcn_mfma_f32_16x16x32_bf16(Bt[n][k], At[m][k], acc[ai][bj][m][n], 0, 0, 0); __builtin_amdgcn_s_setprio(0); } while (0)
#define PG8_WAIT_V(n) asm volatile("s_waitcnt vmcnt(" #n ")" ::: "memory")
#define PG8_WAIT_L(n) asm volatile("s_waitcnt lgkmcnt(" #n ")" ::: "memory")
#define PG8_BAR __builtin_amdgcn_s_barrier()
#define PG8_SCHED __builtin_amdgcn_sched_barrier(0)
    Unit cur, nxt; int ui = 0;
    if (!S.next(0, cur)) return;
    f32x4 acc[2][2][4][2];
#pragma unroll
    for (int a = 0; a < 2; ++a)
#pragma unroll
        for (int b = 0; b < 2; ++b)
#pragma unroll
            for (int m = 0; m < 4; ++m)
#pragma unroll
                for (int n = 0; n < 2; ++n) acc[a][b][m][n] = (f32x4){0.f, 0.f, 0.f, 0.f};
    bf16x8 At[4][2], B0[2][2], B1[2][2];
    const char* cA = (const char*)g.A + (size_t)cur.pm * tstep; const char* cB = (const char*)g.Bt + (size_t)cur.pn * tstep;
    S.a_ready(cur);
    if constexpr (SP2) {
        PG8_STAGE(PG8_SB(0, 0), cB, voffB); PG8_STAGE(PG8_SB(0, 1), cB + hstep, voffB); PG8_STAGE(PG8_SA(0, 0), cA, voffA); PG8_STAGE(PG8_SA(0, 1), cA + hstep, voffA);
        if (wr == 1) PG8_BAR;
        PG8_WAIT_V(2); PG8_BAR;
        PG8_STAGE(PG8_SB(1, 0), cB + kstep, voffB); PG8_STAGE(PG8_SA(1, 0), cA + kstep, voffA); PG8_STAGE(PG8_SB(1, 1), cB + hstep + kstep, voffB);
        PG8_WAIT_V(6); PG8_BAR;
    } else {
        PG8_STAGE(PG8_SB(0, 0), cB, voffB); PG8_STAGE(PG8_SA(0, 0), cA, voffA); PG8_STAGE(PG8_SB(0, 1), cB + hstep, voffB); PG8_STAGE(PG8_SA(0, 1), cA + hstep, voffA);
        if (wr == 1) PG8_BAR;
        PG8_WAIT_V(4); PG8_BAR;
        PG8_STAGE(PG8_SB(1, 0), cB + kstep, voffB); PG8_STAGE(PG8_SA(1, 0), cA + kstep, voffA); PG8_STAGE(PG8_SB(1, 1), cB + hstep + kstep, voffB);
        PG8_WAIT_V(6); PG8_BAR;
    }
    for (;;) {
        const bool has_next = S.next(ui + 1, nxt);
        const char* nA = has_next ? (const char*)g.A + (size_t)nxt.pm * tstep : cA; const char* nB = has_next ? (const char*)g.Bt + (size_t)nxt.pn * tstep : cB;
        for (int t = 0; t < nt; t += 2) {
            const bool last = (t == nt - 2);
            const char* a1 = cA + (size_t)(t + 1) * kstep;
            const char* a2 = last ? nA : cA + (size_t)(t + 2) * kstep; const char* b2 = last ? nB : cB + (size_t)(t + 2) * kstep;
            const char* a3 = a2 + kstep; const char* b3 = b2 + kstep;
            if (last && has_next) S.a_ready(nxt);
            if constexpr (SP2) {
            PG8_LDB(B0, 0, 0); PG8_LDB(B1, 0, 1); PG8_SCHED; PG8_LDA(At, 0, 0); PG8_STAGE(PG8_SA(1, 1), a1 + hstep, voffA);
            PG8_WAIT_V(8); PG8_WAIT_L(0); PG8_BAR; PG8_MMA(0, 0, At, B0); PG8_MMA(0, 1, At, B1); PG8_BAR; PG8_SCHED;
            PG8_LDA(At, 0, 1); PG8_STAGE(PG8_SB(0, 0), b2, voffB); PG8_STAGE(PG8_SB(0, 1), b2 + hstep, voffB); PG8_STAGE(PG8_SA(0, 0), a2, voffA);
            PG8_WAIT_V(8); PG8_WAIT_L(0); PG8_BAR; PG8_MMA(1, 0, At, B0); PG8_MMA(1, 1, At, B1); PG8_BAR; PG8_SCHED;
            PG8_LDB(B0, 1, 0); PG8_LDB(B1, 1, 1); PG8_SCHED; PG8_LDA(At, 1, 0); PG8_STAGE(PG8_SA(0, 1), a2 + hstep, voffA);
            PG8_WAIT_V(8); PG8_WAIT_L(0); PG8_BAR; PG8_MMA(0, 0, At, B0); PG8_MMA(0, 1, At, B1); PG8_BAR; PG8_SCHED;
            PG8_LDA(At, 1, 1); PG8_STAGE(PG8_SB(1, 0), b3, voffB); PG8_STAGE(PG8_SB(1, 1), b3 + hstep, voffB); PG8_STAGE(PG8_SA(1, 0), a3, voffA);
            PG8_WAIT_V(8); PG8_WAIT_L(0); PG8_BAR; PG8_MMA(1, 0, At, B0); PG8_MMA(1, 1, At, B1); PG8_BAR; PG8_SCHED;
            } else {
            PG8_LDB(B0, 0, 0); PG8_SCHED; PG8_LDA(At, 0, 0); PG8_STAGE(PG8_SA(1, 1), a1 + hstep, voffA);
            PG8_WAIT_L(8); PG8_BAR; PG8_WAIT_L(0); PG8_MMA(0, 0, At, B0); PG8_BAR; PG8_SCHED;
            PG8_LDB(B1, 0, 1); PG8_STAGE(PG8_SB(0, 0), b2, voffB);
            PG8_BAR; PG8_WAIT_L(0); PG8_MMA(0, 1, At, B1); PG8_BAR;
            PG8_LDA(At, 0, 1); PG8_STAGE(PG8_SA(0, 0), a2, voffA);
            PG8_BAR; PG8_WAIT_L(0); PG8_MMA(1, 0, At, B0); PG8_BAR; PG8_SCHED;
            PG8_STAGE(PG8_SB(0, 1), b2 + hstep, voffB);
            PG8_WAIT_V(6); PG8_BAR; PG8_MMA(1, 1, At, B1); PG8_BAR;
            PG8_LDB(B0, 1, 0); PG8_SCHED; PG8_LDA(At, 1, 0); PG8_STAGE(PG8_SA(0, 1), a2 + hstep, voffA);
            PG8_WAIT_L(8); PG8_BAR; PG8_WAIT_L(0); PG8_MMA(0, 0, At, B0); PG8_BAR; PG8_SCHED;
            PG8_LDB(B1, 1, 1); PG8_STAGE(PG8_SB(1, 0), b3, voffB);
            PG8_BAR; PG8_WAIT_L(0); PG8_MMA(0, 1, At, B1); PG8_BAR;
            PG8_LDA(At, 1, 1); PG8_STAGE(PG8_SA(1, 0), a3, voffA);
            PG8_BAR; PG8_WAIT_L(0); PG8_MMA(1, 0, At, B0); PG8_BAR; PG8_SCHED;
            PG8_STAGE(PG8_SB(1, 1), b3 + hstep, voffB);
            PG8_WAIT_V(6); PG8_BAR; PG8_MMA(1, 1, At, B1); PG8_BAR;
            }
        }
        if constexpr (ALIGN_EPI) { if (wr == 0) PG8_BAR; }
        if constexpr (!Epi::AFTER_DRAIN) { E(acc, cur, wr, wc, fr, fq); S.done(cur); }
        if (!has_next) break;
#pragma unroll
        for (int a = 0; a < 2; ++a)
#pragma unroll
            for (int b = 0; b < 2; ++b)
#pragma unroll
                for (int m = 0; m < 4; ++m)
#pragma unroll
                    for (int n = 0; n < 2; ++n) acc[a][b][m][n] = (f32x4){0.f, 0.f, 0.f, 0.f};
        cur = nxt; cA = nA; cB = nB; ++ui;
        if constexpr (ALIGN_EPI) { if (wr == 1) PG8_BAR; }
    }
    PG8_WAIT_V(0);
    if constexpr (!ALIGN_EPI) { if (wr == 0) PG8_BAR; }
    PG8_BAR;
    if constexpr (Epi::AFTER_DRAIN) { E.fused(acc, cur, wr, wc, fr, fq, lds, wid, lane); S.done(cur); }
#undef PG8_SA
#undef PG8_SB
#undef PG8_STAGE
#undef PG8_LDA
#undef PG8_LDB
#undef PG8_MMA
#undef PG8_WAIT_V
#undef PG8_WAIT_L
#undef PG8_BAR
#undef PG8_SCHED
}
}

namespace pg8 {
constexpr int MROWS = 16384;
__device__ __forceinline__ unsigned pk_bf16(float lo, float hi) { typedef float f2 __attribute__((ext_vector_type(2))); typedef __bf16 b2 __attribute__((ext_vector_type(2)));
    f2 v = {lo, hi}; b2 b = __builtin_convertvector(v, b2); return __builtin_bit_cast(unsigned, b); }
__device__ __forceinline__ float bf_lo(unsigned w) { return __uint_as_float(w << 16); }
__device__ __forceinline__ float bf_hi(unsigned w) { return __uint_as_float(w & 0xffff0000u); }
__device__ __forceinline__ float row_rstd(const float* ssq, int row) {
    const f32x4* p = (const f32x4*)(ssq + (size_t)row * 16);
    const f32x4 a = p[0], b = p[1], c = p[2], d = p[3];
    const float s = (((a[0] + a[1]) + (a[2] + a[3])) + ((b[0] + b[1]) + (b[2] + b[3]))) + (((c[0] + c[1]) + (c[2] + c[3])) + ((d[0] + d[1]) + (d[2] + d[3])));
    return rsqrtf(s * (1.0f / 1024.0f) + 1e-6f);
}
__device__ __forceinline__ float sigmoidf_(float x) { return __builtin_amdgcn_rcpf(1.0f + __builtin_amdgcn_exp2f(-1.4426950408889634f * x)); }

struct EpiG1 {
    static constexpr bool PERM = true, AFTER_DRAIN = false;
    bf16_t* zq; bf16_t* zkv; const float* ssq;
    __device__ __forceinline__ void operator()(const f32x4 (&acc)[2][2][4][2], const Unit& u, int wr, int wc, int fr, int fq) const {
        const int row0 = u.pm * BM + wr * 64 + fr;
        bf16_t* base; int ldc, colt;
        if (u.pn < 6) { base = zq + (size_t)(u.pn >> 1) * ((size_t)MROWS * 512); ldc = 512; colt = (u.pn & 1) * 256; }
        else { base = zkv + (size_t)(u.pn - 6) * ((size_t)MROWS * 256); ldc = 256; colt = 0; }
        const int col0 = colt + wc * 32 + 8 * fq;
#pragma unroll
        for (int ai = 0; ai < 2; ++ai)
#pragma unroll
            for (int m = 0; m < 4; ++m) { const int row = row0 + ai * HALF + m * 16; const float rs = row_rstd(ssq, row); bf16_t* rowp = base + (size_t)row * ldc + col0;
#pragma unroll
                for (int bj = 0; bj < 2; ++bj) { const f32x4 v0 = acc[ai][bj][m][0] * rs, v1 = acc[ai][bj][m][1] * rs;
                    u32x4 w; w.x = pk_bf16(v0[0], v0[1]); w.y = pk_bf16(v0[2], v0[3]); w.z = pk_bf16(v1[0], v1[1]); w.w = pk_bf16(v1[2], v1[3]);
                    *(u32x4*)(rowp + bj * HALF) = w; } }
    }
};
struct EpiG4 {
    static constexpr bool PERM = true, AFTER_DRAIN = false;
    bf16_t* h; const float* ssq;
    __device__ __forceinline__ void operator()(const f32x4 (&acc)[2][2][4][2], const Unit& u, int wr, int wc, int fr, int fq) const {
        const int row0 = u.pm * BM + wr * 64 + fr; const int col0 = u.pn * BM + wc * 32 + 8 * fq;
#pragma unroll
        for (int ai = 0; ai < 2; ++ai)
#pragma unroll
            for (int m = 0; m < 4; ++m) { const int row = row0 + ai * HALF + m * 16; const float rs = row_rstd(ssq, row); bf16_t* rowp = h + (size_t)row * 4096 + col0;
#pragma unroll
                for (int bj = 0; bj < 2; ++bj) { f32x4 v0 = acc[ai][bj][m][0] * rs, v1 = acc[ai][bj][m][1] * rs;
#pragma unroll
                    for (int e = 0; e < 4; ++e) { v0[e] = fmaxf(v0[e], 0.f); v0[e] *= v0[e]; v1[e] = fmaxf(v1[e], 0.f); v1[e] *= v1[e]; }
                    u32x4 w; w.x = pk_bf16(v0[0], v0[1]); w.y = pk_bf16(v0[2], v0[3]); w.z = pk_bf16(v1[0], v1[1]); w.w = pk_bf16(v1[2], v1[3]);
                    *(u32x4*)(rowp + bj * HALF) = w; } }
    }
};
struct EpiRes {
    static constexpr bool PERM = true, AFTER_DRAIN = false;
    const float* xold; float* xout; bf16_t* xb; float* ssq;
    __device__ __forceinline__ void operator()(const f32x4 (&acc)[2][2][4][2], const Unit& u, int wr, int wc, int fr, int fq) const {
        const int row0 = u.pm * BM + wr * 64 + fr; const int col0 = u.pn * BM + wc * 32 + 8 * fq;
#pragma unroll
        for (int ai = 0; ai < 2; ++ai)
#pragma unroll
            for (int m = 0; m < 4; ++m) { const int row = row0 + ai * HALF + m * 16; float part = 0.f;
#pragma unroll
                for (int bj = 0; bj < 2; ++bj) { const size_t off = (size_t)row * 1024 + col0 + bj * HALF;
                    const f32x4 a0 = *(const f32x4*)(xold + off), a1 = *(const f32x4*)(xold + off + 4);
                    const f32x4 v0 = acc[ai][bj][m][0] + a0, v1 = acc[ai][bj][m][1] + a1;
                    *(f32x4*)(xout + off) = v0; *(f32x4*)(xout + off + 4) = v1;
                    u32x4 w; w.x = pk_bf16(v0[0], v0[1]); w.y = pk_bf16(v0[2], v0[3]); w.z = pk_bf16(v1[0], v1[1]); w.w = pk_bf16(v1[2], v1[3]);
                    *(u32x4*)(xb + off) = w;
                    part += ((v0[0] * v0[0] + v0[1] * v0[1]) + (v0[2] * v0[2] + v0[3] * v0[3])) + ((v1[0] * v1[0] + v1[1] * v1[1]) + (v1[2] * v1[2] + v1[3] * v1[3])); }
                part += __shfl_xor(part, 16); part += __shfl_xor(part, 32);
                if (fq == 0) ssq[(size_t)row * 16 + u.pn * 4 + wc] = part;
                asm volatile("" ::: "memory"); }
    }
};
struct EpiStash {
    static constexpr bool PERM = true, AFTER_DRAIN = true;
    __device__ __forceinline__ void fused(f32x4 (&acc)[2][2][4][2], const Unit& u, int wr, int wc, int fr, int fq, PG8_LAS unsigned char*, int, int) const { (*this)(acc, u, wr, wc, fr, fq); }
    bf16_t* ys;
    __device__ __forceinline__ void operator()(const f32x4 (&acc)[2][2][4][2], const Unit& u, int wr, int wc, int fr, int fq) const {
        bf16_t* base = ys + (size_t)(u.pm * 4 + u.pn) * 65536; const int row0 = wr * 64 + fr, col0 = wc * 32 + 8 * fq;
#pragma unroll
        for (int ai = 0; ai < 2; ++ai)
#pragma unroll
            for (int m = 0; m < 4; ++m) { bf16_t* rowp = base + (row0 + ai * HALF + m * 16) * 256 + col0;
#pragma unroll
                for (int bj = 0; bj < 2; ++bj) { const f32x4 v0 = acc[ai][bj][m][0], v1 = acc[ai][bj][m][1];
                    u32x4 w; w.x = pk_bf16(v0[0], v0[1]); w.y = pk_bf16(v0[2], v0[3]); w.z = pk_bf16(v1[0], v1[1]); w.w = pk_bf16(v1[2], v1[3]);
                    *(u32x4*)(rowp + bj * HALF) = w; } }
    }
};
struct EpiGate {
    static constexpr bool PERM = true, AFTER_DRAIN = true;
    __device__ __forceinline__ void fused(f32x4 (&acc)[2][2][4][2], const Unit& u, int wr, int wc, int fr, int fq, PG8_LAS unsigned char*, int, int) const { (*this)(acc, u, wr, wc, fr, fq); }
    const bf16_t* ys; bf16_t* mb; const float* ssq; int first;
    __device__ __forceinline__ void operator()(const f32x4 (&acc)[2][2][4][2], const Unit& u, int wr, int wc, int fr, int fq) const {
        const bf16_t* sbase = ys + (size_t)(u.pm * 4 + u.pn) * 65536; const int lrow0 = wr * 64 + fr, lcol0 = wc * 32 + 8 * fq;
#pragma unroll
        for (int ai = 0; ai < 2; ++ai)
#pragma unroll
            for (int m = 0; m < 4; ++m) { const int lrow = lrow0 + ai * HALF + m * 16, row = u.pm * BM + lrow; const float rs = row_rstd(ssq, row);
#pragma unroll
                for (int bj = 0; bj < 2; ++bj) { const f32x4 a0 = acc[ai][bj][m][0] * rs, a1 = acc[ai][bj][m][1] * rs;
                    const u32x4 y = *(const u32x4*)(sbase + lrow * 256 + lcol0 + bj * HALF);
                    bf16_t* mp = mb + (size_t)row * 1024 + u.pn * BM + lcol0 + bj * HALF;
                    u32x4 pv = {0u, 0u, 0u, 0u}; if (!first) pv = *(const u32x4*)mp;
                    float r[8];
                    r[0] = bf_lo(pv.x) + sigmoidf_(a0[0]) * bf_lo(y.x); r[1] = bf_hi(pv.x) + sigmoidf_(a0[1]) * bf_hi(y.x);
                    r[2] = bf_lo(pv.y) + sigmoidf_(a0[2]) * bf_lo(y.y); r[3] = bf_hi(pv.y) + sigmoidf_(a0[3]) * bf_hi(y.y);
                    r[4] = bf_lo(pv.z) + sigmoidf_(a1[0]) * bf_lo(y.z); r[5] = bf_hi(pv.z) + sigmoidf_(a1[1]) * bf_hi(y.z);
                    r[6] = bf_lo(pv.w) + sigmoidf_(a1[2]) * bf_lo(y.w); r[7] = bf_hi(pv.w) + sigmoidf_(a1[3]) * bf_hi(y.w);
                    u32x4 w; w.x = pk_bf16(r[0], r[1]); w.y = pk_bf16(r[2], r[3]); w.z = pk_bf16(r[4], r[5]); w.w = pk_bf16(r[6], r[7]);
                    *(u32x4*)mp = w;
                    asm volatile("" ::: "memory"); } }
    }
};
}

#define GAS __attribute__((address_space(1)))
#define LAS __attribute__((address_space(3)))
typedef unsigned short bf16;
typedef unsigned v4u __attribute__((ext_vector_type(4)));
typedef float f32x4 __attribute__((ext_vector_type(4)));
typedef short bf16x8 __attribute__((ext_vector_type(8)));
typedef GAS unsigned gu32;
typedef GAS unsigned long long gu64;
#define RLX_AGENT __ATOMIC_RELAXED, __HIP_MEMORY_SCOPE_AGENT
#define LDS_WAIT() asm volatile("s_waitcnt lgkmcnt(0)" ::: "memory")
#define VM_WAIT() asm volatile("s_waitcnt vmcnt(0)" ::: "memory")
__device__ __forceinline__ unsigned long long rt() { return __builtin_amdgcn_s_memrealtime(); }
__device__ __forceinline__ unsigned f2bf(float f) { unsigned u = __builtin_bit_cast(unsigned, f); return (u + 0x7fffu + ((u >> 16) & 1u)) >> 16; }
__device__ __forceinline__ unsigned pk2(float lo, float hi) { return f2bf(lo) | (f2bf(hi) << 16); }

#define XB_TMO      128
#define XB_XCNT(j)  (256  + 64 * (j))
#define XB_XSUB(j)  (1280 + 64 * (j))
#define XB_XGEN(j)  (2304 + 64 * (j))
#define XB_TOP      3328
#define XB_TOPGEN   3392
#define XCD_BAR_WORDS 3456
#define XB_SPIN_CAP (1u << 18)

__device__ __forceinline__ unsigned xb_ld(unsigned* p)              { return __hip_atomic_load(p, __ATOMIC_RELAXED, __HIP_MEMORY_SCOPE_AGENT); }
__device__ __forceinline__ unsigned xb_add(unsigned* p, unsigned v) { return __hip_atomic_fetch_add(p, v, __ATOMIC_RELAXED, __HIP_MEMORY_SCOPE_AGENT); }
__device__ __forceinline__ unsigned xb_xcc_id() { return (unsigned)__builtin_amdgcn_s_getreg((3 << 11) | 20) & 0xFu; }
#define XB_SPIN(cond, bar) do { unsigned _sp = 0; while (cond) { __builtin_amdgcn_s_sleep(1); \
    if ((++_sp & 255u) == 0u) { if (xb_ld(&(bar)[XB_TMO])) break; if (_sp > XB_SPIN_CAP) { atomicAdd(&(bar)[XB_TMO], 1u); break; } } } } while (0)

struct XcdBarrier {
    unsigned* bar; unsigned x;
    volatile LAS unsigned* st;
};

__device__ __forceinline__ XcdBarrier xcd_barrier_post(unsigned* bar, volatile LAS unsigned* st) {
    XcdBarrier b; b.bar = bar; b.x = xb_xcc_id(); b.st = st;
    if (threadIdx.x == 0) (void)xb_add(&bar[XB_XCNT(b.x)], 1u);
    return b;
}
__device__ __forceinline__ void xcd_barrier_complete(unsigned* bar, unsigned x, unsigned& nloc, unsigned& nx) {
    const unsigned G = gridDim.x * gridDim.y * gridDim.z;
    unsigned sum, cnt, mine, sp = 0u;
    for (;;) {
        sum = 0u; cnt = 0u; mine = 0u;
#pragma unroll
        for (unsigned j = 0; j < 16; ++j) { const unsigned c = xb_ld(&bar[XB_XCNT(j)]); sum += c; cnt += (c > 0u) ? 1u : 0u; mine = (j == x) ? c : mine; }
        if (sum == G) break;
        __builtin_amdgcn_s_sleep(1);
        if ((++sp & 255u) == 0u) { if (xb_ld(&bar[XB_TMO])) break; if (sp > XB_SPIN_CAP) { atomicAdd(&bar[XB_TMO], 1u); break; } }
    }
    nloc = mine > 0u ? mine : 1u; nx = cnt > 0u ? cnt : 1u;
}

__device__ __forceinline__ void xcd_barrier(const XcdBarrier& b) {
    asm volatile("s_waitcnt vmcnt(0)" ::: "memory");
    __syncthreads();
    if (threadIdx.x == 0) {
        unsigned* bar = b.bar;
        __builtin_amdgcn_s_waitcnt(0);
        unsigned nloc = b.st[0], nx = b.st[1];
        if (nloc == 0u) { xcd_barrier_complete(bar, b.x, nloc, nx); b.st[0] = nloc; b.st[1] = nx; }
        const unsigned old = xb_add(&bar[XB_XSUB(b.x)], 1u);
        const unsigned gen = old / nloc;
        if (old + 1u == (gen + 1u) * nloc) {
            __builtin_amdgcn_fence(__ATOMIC_RELEASE, "agent");
            asm volatile("s_waitcnt vmcnt(0)" ::: "memory");
            const unsigned og = xb_add(&bar[XB_TOP], 1u);
            const unsigned tg = og / nx;
            if (og + 1u == (tg + 1u) * nx) xb_add(&bar[XB_TOPGEN], 1u);
            else XB_SPIN(xb_ld(&bar[XB_TOPGEN]) == tg, bar);
            __builtin_amdgcn_fence(__ATOMIC_ACQUIRE, "agent");
            xb_add(&bar[XB_XGEN(b.x)], 1u);
            asm volatile("s_waitcnt vmcnt(0)" ::: "memory");
        } else {
            XB_SPIN(xb_ld(&bar[XB_XGEN(b.x)]) == gen, bar);
            __builtin_amdgcn_fence(__ATOMIC_ACQUIRE, "agent");
            asm volatile("s_waitcnt vmcnt(0)" ::: "memory");
        }
    }
    __syncthreads();
}

namespace att {
typedef short bf16x8 __attribute__((ext_vector_type(8)));
typedef short s16x4 __attribute__((ext_vector_type(4)));
typedef float f32x16 __attribute__((ext_vector_type(16)));
typedef unsigned u32x4 __attribute__((ext_vector_type(4)));
typedef unsigned short bf16_t;
typedef unsigned long long u64;
constexpr int L_K0 = 0, L_K1 = 8320, L_V0 = 16640, L_V1 = 24832, L_WSF = 33024, L_IMP = 35072, L_SEL = 51456, L_OST = 51968  , L_END = 117504;
__device__ __forceinline__ int crow(int r, int hi) { return (r & 3) + 8 * (r >> 2) + 4 * hi; }
__device__ __forceinline__ unsigned pk2(float lo, float hi) { typedef float f2 __attribute__((ext_vector_type(2))); typedef __bf16 b2 __attribute__((ext_vector_type(2)));
    f2 v = {lo, hi}; b2 b = __builtin_convertvector(v, b2); return __builtin_bit_cast(unsigned, b); }
__device__ __forceinline__ s16x4 vtr(LAS const char* p) { typedef short v4i16_t __attribute__((ext_vector_type(4))); return __builtin_bit_cast(s16x4, __builtin_amdgcn_ds_read_tr16_b64_v4i16((LAS v4i16_t*)p)); }

struct KVSrc { const bf16_t* k; const bf16_t* v; int pitch; int nrows; };

struct Lane { int tid, lane, r32, hi, wid; };

__device__ __forceinline__ void tile_gload(const KVSrc& S, int t, int tid, u32x4& kr, u32x4& vr) {
    const int row = 64 * t + (tid >> 3), ch = tid & 7;
    kr = (u32x4){0u, 0u, 0u, 0u}; vr = kr;
    if (row >= 0 && row < S.nrows) { kr = *(const u32x4*)(S.k + (size_t)row * S.pitch + ch * 8); vr = *(const u32x4*)(S.v + (size_t)row * S.pitch + ch * 8); }
}
__device__ __forceinline__ void tile_lstore(LAS char* kb, LAS char* vb, int tid, const u32x4& kr, const u32x4& vr) {
    const int key = tid >> 3, ch = tid & 7;
    *(LAS u32x4*)(kb + ch * 1040 + (key >> 5) * 512 + (key & 31) * 16) = kr;
    *(LAS u32x4*)(vb + (ch >> 2) * 4096 + (key >> 4) * 1024 + ((key >> 3) & 1) * 512 + (key & 7) * 64 + (ch & 3) * 16) = vr;
}
__device__ __forceinline__ void qk_tile(LAS const char* kbuf, const bf16x8 (&qr)[4], f32x16& p0, f32x16& p1, int r32, int hi) {
    LAS const char* kb = kbuf + hi * 1040 + r32 * 16;
#pragma unroll
    for (int d0 = 0; d0 < 4; ++d0) {
        const bf16x8 b0 = *(LAS const bf16x8*)(kb + d0 * 2080);
        const bf16x8 b1 = *(LAS const bf16x8*)(kb + d0 * 2080 + 512);
        p0 = __builtin_amdgcn_mfma_f32_32x32x16_bf16(b0, qr[d0], p0, 0, 0, 0);
        p1 = __builtin_amdgcn_mfma_f32_32x32x16_bf16(b1, qr[d0], p1, 0, 0, 0);
    }
}
__device__ __forceinline__ void pv_tile(LAS const char* vbuf, const u32x4 (&pw)[4], f32x16 (&o)[2], int lane, int hi) {
    LAS const char* vb = vbuf + ((lane >> 4) & 1) * 32 + (lane & 3) * 8 + (4 * hi + ((lane & 15) >> 2)) * 64;
#pragma unroll
    for (int d0 = 0; d0 < 2; ++d0)
#pragma unroll
        for (int ks = 0; ks < 4; ++ks) {
            const s16x4 lo = vtr(vb + d0 * 4096 + ks * 1024), h2 = vtr(vb + d0 * 4096 + ks * 1024 + 512);
            const bf16x8 vf = (bf16x8){lo[0], lo[1], lo[2], lo[3], h2[0], h2[1], h2[2], h2[3]};
            o[d0] = __builtin_amdgcn_mfma_f32_32x32x16_bf16(__builtin_bit_cast(bf16x8, pw[ks]), vf, o[d0], 0, 0, 0);
        }
}
__device__ __forceinline__ void mask_exp_pack(f32x16& p0, f32x16& p1, u64 mask, int hi, float& l, u32x4 (&pw)[4]) {
    const unsigned m0 = (unsigned)(mask >> (4 * hi)), m1 = (unsigned)(mask >> (32 + 4 * hi));
    float s = 0.f;
#pragma unroll
    for (int r = 0; r < 16; ++r) { const int bit = (r & 3) + 8 * (r >> 2);
        const float e0 = __builtin_amdgcn_exp2f(p0[r]), e1 = __builtin_amdgcn_exp2f(p1[r]);
        p0[r] = ((m0 >> bit) & 1u) ? e0 : 0.f; p1[r] = ((m1 >> bit) & 1u) ? e1 : 0.f; s += p0[r] + p1[r]; }
    l += s;
    pw[0] = (u32x4){pk2(p0[0], p0[1]), pk2(p0[2], p0[3]), pk2(p0[4], p0[5]), pk2(p0[6], p0[7])};
    pw[1] = (u32x4){pk2(p0[8], p0[9]), pk2(p0[10], p0[11]), pk2(p0[12], p0[13]), pk2(p0[14], p0[15])};
    pw[2] = (u32x4){pk2(p1[0], p1[1]), pk2(p1[2], p1[3]), pk2(p1[4], p1[5]), pk2(p1[6], p1[7])};
    pw[3] = (u32x4){pk2(p1[8], p1[9]), pk2(p1[10], p1[11]), pk2(p1[12], p1[13]), pk2(p1[14], p1[15])};
}
__device__ __forceinline__ u64 mask_le(int c) { return c >= 63 ? ~0ull : (c < 0 ? 0ull : ((2ull << c) - 1ull)); }
__device__ __forceinline__ u64 mask_ge(int a) { return a <= 0 ? ~0ull : (a > 63 ? 0ull : (~0ull << a)); }

template <class MF>
__device__ __forceinline__ void attend_range(LAS char* lds, const KVSrc& S, int t0, int t1, const MF& mf, const bf16x8 (&qr)[4], float negC, float& l, f32x16 (&o)[2], const Lane& L) {
    if (t0 >= t1) return;
    u32x4 kr, vr;
    tile_gload(S, t0, L.tid, kr, vr);
    tile_lstore(lds + L_K0, lds + L_V0, L.tid, kr, vr);
    __syncthreads();
    for (int t = t0; t < t1; ++t) {
        const int cur = (t - t0) & 1;
        const bool more = (t + 1 < t1);
        if (more) tile_gload(S, t + 1, L.tid, kr, vr);
        f32x16 p0, p1;
#pragma unroll
        for (int r = 0; r < 16; ++r) { p0[r] = negC; p1[r] = negC; }
        qk_tile(lds + (cur ? L_K1 : L_K0), qr, p0, p1, L.r32, L.hi);
        const u64 mk = mf(t);
        u32x4 pw[4];
        mask_exp_pack(p0, p1, mk, L.hi, l, pw);
        pv_tile(lds + (cur ? L_V1 : L_V0), pw, o, L.lane, L.hi);
        if (more) tile_lstore(lds + (cur ? L_K0 : L_K1), lds + (cur ? L_V0 : L_V1), L.tid, kr, vr);
        __syncthreads();
    }
}
__device__ __forceinline__ void rows_to_regs(LAS float* wsf, float v, int r32, int hi, float (&sc)[16]) {
    asm volatile("s_waitcnt lgkmcnt(0)" ::: "memory");
    if (hi == 0) wsf[r32] = v;
    asm volatile("s_waitcnt lgkmcnt(0)" ::: "memory");
#pragma unroll
    for (int r = 0; r < 16; ++r) sc[r] = wsf[crow(r, hi)];
}
__device__ __forceinline__ void load_q(const bf16_t* qrow, int hi, bf16x8 (&qr)[4]) {
#pragma unroll
    for (int d0 = 0; d0 < 4; ++d0) qr[d0] = *(const bf16x8*)(qrow + d0 * 16 + hi * 8);
}
template <class RowPtr>
__device__ __forceinline__ void store_o(LAS char* stage, const f32x16 (&acc)[2], const RowPtr& rowptr, int lane, int r32, int hi) {
    LAS bf16_t* stg = (LAS bf16_t*)stage;
#pragma unroll
    for (int r = 0; r < 16; ++r) { const int orow = crow(r, hi);
#pragma unroll
        for (int d0 = 0; d0 < 2; ++d0) stg[orow * 64 + d0 * 32 + r32] = (bf16_t)(pk2(acc[d0][r], 0.f) & 0xffffu); }
    asm volatile("s_waitcnt lgkmcnt(0)" ::: "memory");
#pragma unroll
    for (int i = 0; i < 4; ++i) { const int row = i * 8 + (lane >> 3), ch = lane & 7; const u32x4 v = *(LAS const u32x4*)(stg + row * 64 + ch * 8); *(u32x4*)(rowptr(row) + ch * 8) = v; }
    asm volatile("s_waitcnt lgkmcnt(0)" ::: "memory");
}
}

constexpr int NWAVES = 8;
constexpr int BATCH = 4, SEQ = 4096, DM = 1024, DFF = 4096, DEPTH = 2, D_IN = 6236;
constexpr int M = BATCH * SEQ;
constexpr size_t MiB = 1u << 20;
constexpr size_t WS_ZQ = 0;
constexpr size_t WS_ZKV = 48 * MiB;
constexpr size_t WS_YS = WS_ZKV;
constexpr size_t WS_MB = 104 * MiB;
constexpr size_t WS_KC2 = WS_MB, WS_VC2 = WS_MB + 4 * MiB;
constexpr size_t WS_XB = 136 * MiB;
constexpr size_t WS_W = 168 * MiB, W_LAYER = 36 * MiB;
constexpr size_t W_IN = 0, W_G = 7 * MiB, W_BR = 13 * MiB, W_OUT = 16 * MiB, W_UP = 18 * MiB, W_DN = 26 * MiB, W_CK1 = 34 * MiB, W_CV1 = 35 * MiB;
constexpr size_t WS_BM = 240 * MiB;
constexpr size_t WS_MISC = 248 * MiB;
constexpr size_t WS_CTL = WS_MISC, CTL_BYTES = 1 * MiB;
constexpr size_t WS_COS = WS_MISC + 1 * MiB, WS_SIN = WS_MISC + 1 * MiB + 512 * 1024;
constexpr size_t WS_KCMP = WS_MISC + 2 * MiB;
constexpr size_t WS_SSQ = WS_MISC + 2 * MiB + 512 * 1024;
constexpr size_t WS_B1P = WS_MISC + 3 * MiB + 512 * 1024;
constexpr size_t WS_W2 = WS_B1P + 64 * 1024;
constexpr size_t WS_HMID = 0;
constexpr size_t WS_END = 256 * MiB;
constexpr int CW_BAR = 4096, CW_Q = 8192, CW_KMAX = 12288;
constexpr int LDS_BYTES = 147456, LDS_UNIT = 147392;
constexpr float C2 = 0.125f * 1.4426950408889634f, LOG2E = 1.4426950408889634f;


struct Args { const float* in[17]; float* out; unsigned char* ws; };
struct Frame {
    LAS unsigned char* lds;
    gu32* ctl;
    int tid, lane, wave, G, gw, NGW;
    unsigned char* ws;
    const struct Args* a;
};
__device__ __forceinline__ float wave_sum(float v) {
#pragma unroll
    for (int o = 1; o < 64; o <<= 1) v += __shfl_xor(v, o);
    return v;
}
__device__ __forceinline__ float wave_max(float v) {
#pragma unroll
    for (int o = 1; o < 64; o <<= 1) v = fmaxf(v, __shfl_xor(v, o));
    return v;
}
__device__ __forceinline__ float bf2f(bf16 h) { return __uint_as_float((unsigned)h << 16); }
__device__ __constant__ float c_inv_freq[32] = {
    1.0f, 0.7498942093324559f, 0.5623413251903491f, 0.4216965034285822f, 0.31622776601683794f, 0.23713737056616552f, 0.1778279410038923f, 0.1333521432163324f,
    0.1f, 0.07498942093324558f, 0.05623413251903491f, 0.042169650342858224f, 0.03162277660168379f, 0.023713737056616554f, 0.01778279410038923f, 0.01333521432163324f,
    0.01f, 0.007498942093324558f, 0.005623413251903491f, 0.004216965034285823f, 0.0031622776601683794f, 0.0023713737056616554f, 0.0017782794100389228f, 0.001333521432163324f,
    0.001f, 0.0007498942093324559f, 0.0005623413251903491f, 0.00042169650342858224f, 0.00031622776601683794f, 0.00023713737056616554f, 0.00017782794100389227f, 0.0001333521432163324f};

__device__ __forceinline__ int mix_src_col(int j) {
    if (j < 512) return j;
    if (j < 1024) return 1092 + (j - 512);
    if (j < 1536) return 1860 + (j - 1024);
    if (j < 1792) return 512 + (j - 1536);
    if (j < 2048) return 1604 + (j - 1792);
    if (j < 2304) return 2372 + (j - 2048);
    if (j < 2560) return 2628 + (j - 2304);
    if (j < 2816) return 2884 + (j - 2560);
    if (j < 3072) return 768 + (j - 2816);
    const int r = j - 3072;
    if (r < 64) return 1024 + r;
    if (r < 68) return 1088 + (r - 64);
    if (r < 92) return 3140 + (r - 68);
    return -1;
}
template <int MODE>
__device__ __forceinline__ void p0_item(const float* W, int ldw, int K, bf16* WT, int nblk, int item, const float* gain, int coff, LAS float* scr, int lane) {
    const int kb = item / nblk, nb = item % nblk, k0 = 64 * kb, n0 = 32 * nb;
    const int sc = MODE == 0 ? (n0 + (lane & 31) + coff) : mix_src_col(n0 + (lane & 31));
#pragma unroll 8
    for (int i = 0; i < 32; ++i) { const int kk = 2 * i + (lane >> 5); float v = 0.f;
        if (sc >= 0) v = W[(size_t)(k0 + kk) * ldw + sc];
        if (gain) v *= gain[k0 + kk];
        scr[kk * 33 + (lane & 31)] = v; }
    LDS_WAIT(); asm volatile("" ::: "memory");
    const int c = lane & 7;
#pragma unroll
    for (int j = 0; j < 4; ++j) { const int n = (lane >> 3) + 8 * j; const LAS float* s = scr + (8 * c) * 33 + n;
        v4u o; o.x = pk2(s[0 * 33], s[1 * 33]); o.y = pk2(s[2 * 33], s[3 * 33]); o.z = pk2(s[4 * 33], s[5 * 33]); o.w = pk2(s[6 * 33], s[7 * 33]);
        *(GAS v4u*)(WT + (size_t)(n0 + n) * K + k0 + 8 * c) = o; }
    LDS_WAIT(); asm volatile("" ::: "memory");
}
__device__ __forceinline__ void p0_prologue(Frame& F) {
    LAS float* scr = (LAS float*)(F.lds + F.wave * 16384);
    constexpr int I_IN = 16 * 104, I_G = 16 * 96, I_BR = 8 * 32, I_OUT = 16 * 32, I_UP = 16 * 128, I_DN = 64 * 32, I_C1 = 32 * 8, I_C2 = 4 * 2;
    constexpr int PER_LAYER = I_IN + I_G + 3 * I_BR + I_OUT + I_UP + I_DN + 2 * I_C1 + 2 * I_C2;
    for (int it = F.gw; it < 2 * PER_LAYER; it += F.NGW) {
        const int l = it / PER_LAYER; int r = it % PER_LAYER;
        unsigned char* wl = F.ws + WS_W + (size_t)l * W_LAYER;
        const float* w_in = F.a->in[2] + (size_t)l * DM * D_IN;
        if (r < I_IN) { p0_item<1>(w_in, D_IN, DM, (bf16*)(wl + W_IN), 104, r, F.a->in[1] + l * DM, 0, scr, F.lane); continue; } r -= I_IN;
        if (r < I_G) { p0_item<0>(w_in, D_IN, DM, (bf16*)(wl + W_G), 96, r, F.a->in[1] + l * DM, 3164, scr, F.lane); continue; } r -= I_G;
        if (r < 3 * I_BR) { const int n = r / I_BR; p0_item<0>(F.a->in[12] + ((size_t)l * 3 + n) * 512 * DM, DM, 512, (bf16*)(wl + W_BR) + (size_t)n * DM * 512, 32, r % I_BR, nullptr, 0, scr, F.lane); continue; } r -= 3 * I_BR;
        if (r < I_OUT) { p0_item<0>(F.a->in[13] + (size_t)l * DM * DM, DM, DM, (bf16*)(wl + W_OUT), 32, r, nullptr, 0, scr, F.lane); continue; } r -= I_OUT;
        if (r < I_UP) { p0_item<0>(F.a->in[15] + (size_t)l * DM * DFF, DFF, DM, (bf16*)(wl + W_UP), 128, r, F.a->in[14] + l * DM, 0, scr, F.lane); continue; } r -= I_UP;
        if (r < I_DN) { p0_item<0>(F.a->in[16] + (size_t)l * DFF * DM, DM, DFF, (bf16*)(wl + W_DN), 32, r, nullptr, 0, scr, F.lane); continue; } r -= I_DN;
        if (r < I_C1) { p0_item<0>(F.a->in[8] + (size_t)l * 2048 * 256, 256, 2048, (bf16*)(wl + W_CK1), 8, r, nullptr, 0, scr, F.lane); continue; } r -= I_C1;
        if (r < I_C1) { p0_item<0>(F.a->in[10] + (size_t)l * 2048 * 256, 256, 2048, (bf16*)(wl + W_CV1), 8, r, nullptr, 0, scr, F.lane); continue; } r -= I_C1;
        if (r < I_C2) { p0_item<0>(F.a->in[9] + (size_t)l * 256 * 64, 64, 256, (bf16*)(F.ws + WS_W2) + (size_t)(l * 2 + 0) * 64 * 256, 2, r, nullptr, 0, scr, F.lane); continue; } r -= I_C2;
        p0_item<0>(F.a->in[11] + (size_t)l * 256 * 64, 64, 256, (bf16*)(F.ws + WS_W2) + (size_t)(l * 2 + 1) * 64 * 256, 2, r, nullptr, 0, scr, F.lane);
    }
    for (int it = F.gw; it < 128; it += F.NGW) {
        const int kp = it & 7, jb = (it >> 3) & 3, which = (it >> 5) & 1, l = it >> 6; const int j = jb * 64 + F.lane;
        const float* pe = (which ? F.a->in[7] : F.a->in[6]) + l * 2048; const float* w1 = (which ? F.a->in[10] : F.a->in[8]) + (size_t)l * 2048 * 256;
        float a = 0.f;
        for (int k = kp * 256; k < kp * 256 + 256; ++k) a = fmaf(pe[k], w1[(size_t)k * 256 + j], a);
        ((float*)(F.ws + WS_B1P))[((l * 2 + which) * 8 + kp) * 256 + j] = a;
    }
    for (int m = F.gw; m < M; m += F.NGW) {
        const GAS f32x4* xr = (const GAS f32x4*)(F.a->in[0] + (size_t)m * DM) + F.lane;
        GAS unsigned long long* o8 = (GAS unsigned long long*)((bf16*)(F.ws + WS_XB) + (size_t)m * DM) + F.lane;
        float s = 0.f;
#pragma unroll
        for (int j = 0; j < 4; ++j) { const f32x4 v = xr[64 * j]; s += (v.x * v.x + v.y * v.y) + (v.z * v.z + v.w * v.w);
            o8[64 * j] = (unsigned long long)pk2(v.x, v.y) | ((unsigned long long)pk2(v.z, v.w) << 32); }
        s = wave_sum(s);
        if (F.lane < 16) ((float*)(F.ws + WS_SSQ))[(size_t)m * 16 + F.lane] = F.lane == 0 ? s : 0.f;
    }
    for (int i = F.gw * 64 + F.lane; i < SEQ * 32; i += F.NGW * 64) {
        const float ang = (float)(i >> 5) * c_inv_freq[i & 31];
        ((float*)(F.ws + WS_COS))[i] = (float)cos((double)ang); ((float*)(F.ws + WS_SIN))[i] = (float)sin((double)ang);
    }
}
__device__ __forceinline__ void post_slot(const bf16* in, bf16* outp, bool norm, float gain, float scale, float c, float s, int lane) {
    float v = bf2f(in[lane]);
    if (norm) { const float ss = wave_sum(v * v) * (1.0f / 64.0f); v = v * rsqrtf(ss + 1e-6f) * gain; }
    const float o = __shfl_xor(v, 32);
    const float r = (lane < 32) ? (v * c - o * s) : (v * c + o * s);
    outp[lane] = (bf16)f2bf(r * scale);
}
__device__ __forceinline__ void post_phase(Frame& F, int l) {
    const float* qn = F.a->in[3] + l * 192; const float* kn = F.a->in[4] + l * 192;
    const float gq0 = qn[F.lane], gq1 = qn[64 + F.lane], gq2 = qn[128 + F.lane], gk0 = kn[F.lane], gk1 = kn[64 + F.lane], gk2 = kn[128 + F.lane];
    bf16* zq = (bf16*)(F.ws + WS_ZQ); bf16* zkv = (bf16*)(F.ws + WS_ZKV);
    const float* cs = (const float*)(F.ws + WS_COS); const float* sn = (const float*)(F.ws + WS_SIN);
    for (int m = F.gw; m < M; m += F.NGW) {
        const int t = m & (SEQ - 1), b = m >> 12;
        const float c = cs[t * 32 + (F.lane & 31)], s = sn[t * 32 + (F.lane & 31)];
        bf16* qa = zq + (size_t)m * 512; bf16* qb = zq + (size_t)M * 512 + (size_t)m * 512; bf16* qc = zq + (size_t)2 * M * 512 + (size_t)m * 512;
#pragma unroll 1
        for (int h = 0; h < 8; ++h) { post_slot(qa + h * 64, qa + h * 64, true, gq0, C2, c, s, F.lane); post_slot(qb + h * 64, qb + h * 64, true, gq1, C2, c, s, F.lane); post_slot(qc + h * 64, qc + h * 64, true, gq2, C2, c, s, F.lane); }
        bf16* kva = zkv + (size_t)m * 256; bf16* kvb = kva + (size_t)M * 256; bf16* kvc = kva + (size_t)2 * M * 256; bf16* kvs = kva + (size_t)3 * M * 256; bf16* kvw = kva + (size_t)4 * M * 256;
        bf16* iq = kva + (size_t)5 * M * 256; bf16* misc = kva + (size_t)6 * M * 256;
#pragma unroll 1
        for (int h = 0; h < 2; ++h) {
            post_slot(kva + h * 64, kva + h * 64, true, gk0, 1.f, c, s, F.lane); post_slot(kvb + h * 64, kvb + h * 64, true, gk1, 1.f, c, s, F.lane);
            post_slot(kvs + h * 64, kvs + h * 64, true, gk2, 1.f, c, s, F.lane); post_slot(kvw + h * 64, kvw + h * 64, true, gk2, 1.f, c, s, F.lane);
            bf16* kc2 = (bf16*)(F.ws + WS_KC2) + ((size_t)(b * 2 + h) * SEQ + t) * 64; bf16* vc2 = (bf16*)(F.ws + WS_VC2) + ((size_t)(b * 2 + h) * SEQ + t) * 64;
            post_slot(kvc + h * 64, kc2, true, gk2, 1.f, c, s, F.lane);
            vc2[F.lane] = kvc[128 + h * 64 + F.lane];
        }
#pragma unroll 1
        for (int h = 0; h < 4; ++h) post_slot(iq + h * 64, iq + h * 64, false, 1.f, 1.f, c, s, F.lane);
        post_slot(misc, misc, false, 1.f, 1.f, c, s, F.lane);
    }
}

#define WAVE_LDS_FENCE() asm volatile("s_waitcnt lgkmcnt(0)" ::: "memory")
__device__ __forceinline__ int next_unit(Frame& F, gu32* counter) {
    LAS int* slot = (LAS int*)(F.lds + LDS_UNIT);
    __syncthreads();
    if (F.tid == 0) *slot = (int)__hip_atomic_fetch_add(counter, 1u, RLX_AGENT);
    __syncthreads();
    return *slot;
}
__device__ __forceinline__ unsigned f2key(float f) { const unsigned u = __float_as_uint(f); return (u & 0x80000000u) ? ~u : (u | 0x80000000u); }
__device__ __forceinline__ float dpp_quad_sum(float v) {
    v += __int_as_float(__builtin_amdgcn_update_dpp(0, __float_as_int(v), 0xB1, 0xF, 0xF, true));
    v += __int_as_float(__builtin_amdgcn_update_dpp(0, __float_as_int(v), 0x4E, 0xF, 0xF, true));
    return v;
}
__device__ __forceinline__ void select_unit(Frame& F, int b, int qblk) {
    using namespace att;
    const int lane = F.lane, r32 = lane & 31, hi = lane >> 5, w = F.wave;
    LAS float* sc = (LAS float*)F.lds;
    LAS unsigned* hist = (LAS unsigned*)(F.lds + 131072) + w * 256;
    const int t0 = qblk * 8; const size_t m0 = (size_t)b * SEQ + t0;
    const bf16* IQ = (const bf16*)(F.ws + WS_ZKV) + (size_t)5 * M * 256; const bf16* MISC = (const bf16*)(F.ws + WS_ZKV) + (size_t)6 * M * 256;
    u64* BM = (u64*)(F.ws + WS_BM);
    const int nkeys = t0 + 8;
    if (nkeys > 256) {
        bf16x8 iqf[4];
        { const bf16* qrow = IQ + (m0 + (r32 >> 2)) * 256 + (r32 & 3) * 64;
#pragma unroll
          for (int d0 = 0; d0 < 4; ++d0) iqf[d0] = *(const bf16x8*)(qrow + d0 * 16 + hi * 8); }
        const float wl = bf2f(MISC[(m0 + (r32 >> 2)) * 256 + 64 + (r32 & 3)]);
        const int ntile = (nkeys + 31) >> 5; const int g = r32 & 3;
        for (int tile = w; tile < ntile; tile += 8) {
            const int s0 = tile * 32;
            const bf16* krow = MISC + ((size_t)b * SEQ + s0 + r32) * 256;
            f32x16 acc;
#pragma unroll
            for (int r = 0; r < 16; ++r) acc[r] = 0.f;
#pragma unroll
            for (int d0 = 0; d0 < 4; ++d0) { const bf16x8 kf = *(const bf16x8*)(krow + d0 * 16 + hi * 8); acc = __builtin_amdgcn_mfma_f32_32x32x16_bf16(kf, iqf[d0], acc, 0, 0, 0); }
            float v[16];
#pragma unroll
            for (int r = 0; r < 16; ++r) v[r] = dpp_quad_sum(fmaxf(acc[r], 0.f) * wl);
            f32x4 o;
#pragma unroll
            for (int j = 0; j < 4; ++j) o[j] = g == 0 ? v[j] : (g == 1 ? v[4 + j] : (g == 2 ? v[8 + j] : v[12 + j]));
            *(LAS f32x4*)(sc + (r32 >> 2) * 4096 + s0 + 8 * g + 4 * hi) = o;
        }
    }
    __syncthreads();
    {
        const int t = t0 + w, n = t + 1; LAS const float* row = sc + w * 4096;
        u64 myword = 0ull;
        if (n <= 256) {
            const int c0 = 64 * lane;
            myword = (c0 + 63 < n) ? ~0ull : (c0 >= n ? 0ull : ((1ull << (n - c0)) - 1ull));
        } else {
            unsigned prefix = 0u; int kk = 256;
#pragma unroll 1
            for (int pass = 0; pass < 4; ++pass) {
                const int shift = 24 - 8 * pass;
#pragma unroll
                for (int i = 0; i < 4; ++i) hist[lane * 4 + i] = 0u;
                WAVE_LDS_FENCE();
#pragma unroll 1
                for (int s = lane; s < n; s += 64) { const unsigned key = f2key(row[s]);
                    if (pass == 0 || (key >> (shift + 8)) == prefix) __hip_atomic_fetch_add(&hist[(key >> shift) & 255u], 1u, __ATOMIC_RELAXED, __HIP_MEMORY_SCOPE_WORKGROUP); }
                WAVE_LDS_FENCE();
                const unsigned h0 = hist[lane * 4], h1 = hist[lane * 4 + 1], h2 = hist[lane * 4 + 2], h3 = hist[lane * 4 + 3];
                int suf = (int)(h0 + h1 + h2 + h3);
#pragma unroll
                for (int o = 1; o < 64; o <<= 1) { const int tt = __shfl_down(suf, o); if (lane + o < 64) suf += tt; }
                const int above = suf - (int)(h0 + h1 + h2 + h3);
                const int a3 = above, a2 = a3 + (int)h3, a1 = a2 + (int)h2, a0 = a1 + (int)h1;
                int dsel = -1, nk = 0;
                if (a3 < kk && kk <= a3 + (int)h3) { dsel = lane * 4 + 3; nk = kk - a3; }
                else if (a2 < kk && kk <= a2 + (int)h2) { dsel = lane * 4 + 2; nk = kk - a2; }
                else if (a1 < kk && kk <= a1 + (int)h1) { dsel = lane * 4 + 1; nk = kk - a1; }
                else if (a0 < kk && kk <= a0 + (int)h0) { dsel = lane * 4 + 0; nk = kk - a0; }
                const u64 bal = __ballot(dsel >= 0);
                const int src = (int)__builtin_ctzll(bal);
                dsel = __shfl(dsel, src); nk = __shfl(nk, src);
                WAVE_LDS_FENCE();
                prefix = (prefix << 8) | (unsigned)dsel; kk = nk;
            }
            const unsigned T = prefix; const int need = kk; int base = 0;
#pragma unroll 1
            for (int c = 0; c < 64; ++c) {
                const int s = 64 * c + lane; const bool valid = s < n; const unsigned key = valid ? f2key(row[s]) : 0u;
                const bool gt = valid && key > T, eq = valid && key == T;
                const u64 beq = __ballot(eq);
                const int rank = base + __builtin_popcountll(beq & ((1ull << lane) - 1ull));
                const u64 word = __ballot(gt || (eq && rank < need));
                if (lane == c) myword = word;
                base += __builtin_popcountll(beq);
            }
        }
        BM[((size_t)b * SEQ + t) * 64 + lane] = myword;
    }
    __syncthreads();
}
__device__ __forceinline__ void compress_unit(Frame& F, int l, int u) {
    using namespace att;
    const int lane = F.lane, r32 = lane & 31, hi = lane >> 5, w = F.wave;
    const int which = u & 1, h = (u >> 1) & 1, b = (u >> 2) & 3, cb = u >> 4;
    const bf16* src = (const bf16*)(F.ws + (which ? WS_VC2 : WS_KC2)) + (size_t)(b * 2 + h) * SEQ * 64;
    const bf16* W1t = (const bf16*)(F.ws + WS_W + (size_t)l * W_LAYER + (which ? W_CV1 : W_CK1));
    const bf16* W2t = (const bf16*)(F.ws + WS_W2) + (size_t)(l * 2 + which) * 64 * 256;
    const float* b1p = (const float*)(F.ws + WS_B1P) + (size_t)(l * 2 + which) * 8 * 256;
    LAS bf16* hid = (LAS bf16*)F.lds;
    int cc = 32 * cb + r32; if (cc > 254) cc = 254;
    const bf16* arow = src + (size_t)(16 * cc) * 64 + hi * 8;
    const bf16* brow = W1t + (size_t)(32 * w + r32) * 2048 + hi * 8;
    f32x16 acc;
#pragma unroll
    for (int r = 0; r < 16; ++r) acc[r] = 0.f;
#pragma unroll 4
    for (int ks = 0; ks < 128; ++ks) { const bf16x8 a = *(const bf16x8*)(arow + ks * 16), bb = *(const bf16x8*)(brow + ks * 16); acc = __builtin_amdgcn_mfma_f32_32x32x16_bf16(a, bb, acc, 0, 0, 0); }
    float b1 = 0.f;
#pragma unroll
    for (int kp = 0; kp < 8; ++kp) b1 += b1p[kp * 256 + 32 * w + r32];
#pragma unroll
    for (int r = 0; r < 16; ++r) hid[crow(r, hi) * 264 + 32 * w + r32] = (bf16)f2bf(fmaxf(acc[r] + b1, 0.f));
    __syncthreads();
    if (w < 2) {
        f32x16 o;
#pragma unroll
        for (int r = 0; r < 16; ++r) o[r] = 0.f;
        const bf16* w2row = W2t + (size_t)(32 * w + r32) * 256 + hi * 8;
#pragma unroll
        for (int ks = 0; ks < 16; ++ks) { const bf16x8 a = *(LAS const bf16x8*)(hid + r32 * 264 + ks * 16 + hi * 8), bb = *(const bf16x8*)(w2row + ks * 16); o = __builtin_amdgcn_mfma_f32_32x32x16_bf16(a, bb, o, 0, 0, 0); }
        bf16* dst = (bf16*)(F.ws + WS_KCMP) + ((size_t)((which * 4 + b) * 2 + h) * 256) * 64;
        float mx = 0.f;
#pragma unroll
        for (int r = 0; r < 16; ++r) { const int c = 32 * cb + crow(r, hi); const float v = c < 255 ? o[r] : 0.f; mx = fmaxf(mx, fabsf(v)); dst[(size_t)c * 64 + 32 * w + r32] = (bf16)f2bf(v); }
        if (which == 0) { mx = wave_max(mx); if (lane == 0) __hip_atomic_fetch_max(F.ctl + CW_KMAX + 64 * (l * 8 + b * 2 + h), __float_as_uint(mx), RLX_AGENT); }
    }
    __syncthreads();
}
struct UnitGeom { int b, kvh, i; att::Lane L; int q; int head; size_t mrow; };
__device__ __forceinline__ UnitGeom unit_geom(Frame& F, int b, int kvh, int i) {
    UnitGeom U; U.b = b; U.kvh = kvh; U.i = i; U.L.tid = F.tid; U.L.lane = F.lane; U.L.r32 = F.lane & 31; U.L.hi = F.lane >> 5; U.L.wid = F.wave;
    U.q = 64 * i + 8 * F.wave + (U.L.r32 >> 2); U.head = 4 * kvh + (U.L.r32 & 3); U.mrow = (size_t)b * SEQ + U.q; return U;
}
__device__ __forceinline__ void branch_finish(LAS float* wsf, float l, float extra, float rowscale, const att::f32x16 (&o)[2], att::f32x16 (&acc)[2], const att::Lane& L, bool first) {
    float lf = l + __shfl_xor(l, 32) + extra;
    const float sc1 = lf > 0.f ? rowscale * __builtin_amdgcn_rcpf(lf) : 0.f;
    float sc[16]; att::rows_to_regs(wsf, sc1, L.r32, L.hi, sc);
#pragma unroll
    for (int d0 = 0; d0 < 2; ++d0)
#pragma unroll
        for (int r = 0; r < 16; ++r) acc[d0][r] = first ? o[d0][r] * sc[r] : acc[d0][r] + o[d0][r] * sc[r];
}
__device__ __forceinline__ void branch_finish_lds(LAS float* wsf, LAS float* accw, float l, float rowscale, const att::f32x16 (&o)[2], const att::Lane& L, bool first) {
    const float lf = l + __shfl_xor(l, 32);
    const float sc1 = lf > 0.f ? rowscale * __builtin_amdgcn_rcpf(lf) : 0.f;
    float sc[16]; att::rows_to_regs(wsf, sc1, L.r32, L.hi, sc);
#pragma unroll
    for (int d0 = 0; d0 < 2; ++d0)
#pragma unroll
        for (int r = 0; r < 16; ++r) { float v = o[d0][r] * sc[r]; if (!first) v += accw[(d0 * 16 + r) * 64 + L.lane]; accw[(d0 * 16 + r) * 64 + L.lane] = v; }
}
__device__ __forceinline__ float gain_bound(const float* g, int lane) { return wave_max(fabsf(g[lane])); }

template <int KIND  >
__device__ __forceinline__ void simple_unit(Frame& F, int l, int b, int kvh, int i) {
    using namespace att;
    const UnitGeom U = unit_geom(F, b, kvh, i); const Lane& L = U.L;
    constexpr int QT = KIND == 0 ? 1 : 0, KT = KIND == 0 ? 1 : 0, NM = KIND == 0 ? 1 : 0;
    bf16* Q = (bf16*)(F.ws + WS_ZQ) + (size_t)QT * M * 512; const bf16* KV = (const bf16*)(F.ws + WS_ZKV) + (size_t)KT * M * 256;
    bf16x8 qr[4]; load_q(Q + U.mrow * 512 + U.head * 64, L.hi, qr);
    const float C = 8.f * gain_bound(F.a->in[3] + l * 192 + NM * 64, L.lane) * gain_bound(F.a->in[4] + l * 192 + NM * 64, L.lane) * LOG2E;
    KVSrc S{KV + (size_t)b * SEQ * 256 + kvh * 64, KV + (size_t)b * SEQ * 256 + 128 + kvh * 64, 256, SEQ};
    float lsum = 0.f; f32x16 o[2];
#pragma unroll
    for (int r = 0; r < 16; ++r) { o[0][r] = 0.f; o[1][r] = 0.f; }
    const int q = U.q;
    float extra = 0.f;
    if (KIND == 0) {
        auto mf = [q](int t) -> u64 { return mask_le(q - 64 * t) & mask_ge(q - 127 - 64 * t); };
        attend_range((LAS char*)F.lds, S, i - 2 < 0 ? 0 : i - 2, i + 1, mf, qr, -C, lsum, o, L);
        extra = __builtin_amdgcn_exp2f(F.a->in[5][l * 8 + U.head] * LOG2E - C);
    } else {
        const u64* bm = (const u64*)(F.ws + WS_BM) + U.mrow * 64;
        auto mf = [bm](int t) -> u64 { return bm[t]; };
        attend_range((LAS char*)F.lds, S, 0, i + 1, mf, qr, -C, lsum, o, L);
    }
    f32x16 acc[2];
    branch_finish((LAS float*)((LAS char*)F.lds + L_WSF) + L.wid * 64, lsum, extra, 1.f, o, acc, L, true);
    const size_t tok0 = (size_t)b * SEQ + 64 * i + 8 * L.wid; const int kvh4 = 4 * kvh;
    auto rowptr = [Q, tok0, kvh4](int row) -> bf16* { return Q + (tok0 + (row >> 2)) * 512 + (kvh4 + (row & 3)) * 64; };
    store_o((LAS char*)F.lds + L_OST + L.wid * 8192, acc, rowptr, L.lane, L.r32, L.hi);
}
__device__ __forceinline__ void nsa_unit(Frame& F, int l, int b, int kvh, int i) {
    using namespace att;
    const UnitGeom U = unit_geom(F, b, kvh, i); const Lane& L = U.L;
    bf16* Q = (bf16*)(F.ws + WS_ZQ) + (size_t)2 * M * 512; const bf16* KVbase = (const bf16*)(F.ws + WS_ZKV);
    const bf16* MISC = KVbase + (size_t)6 * M * 256;
    bf16x8 qr[4]; load_q(Q + U.mrow * 512 + U.head * 64, L.hi, qr);
    const float gqm = gain_bound(F.a->in[3] + l * 192 + 128, L.lane), gkm = gain_bound(F.a->in[4] + l * 192 + 128, L.lane);
    const float Ck = 8.f * gqm * gkm * LOG2E;
    const float kmax = __uint_as_float(__hip_atomic_load(F.ctl + CW_KMAX + 64 * (l * 8 + b * 2 + kvh), RLX_AGENT));
    const float Cc = 8.f * gqm * kmax * LOG2E;
    float gs[3];
#pragma unroll
    for (int br = 0; br < 3; ++br) gs[br] = pg8::sigmoidf_(bf2f(MISC[U.mrow * 256 + 68 + U.head * 3 + br]));
    LAS float* wsf = (LAS float*)((LAS char*)F.lds + L_WSF) + L.wid * 64;
    const int q = U.q;
    f32x16 o[2];
    LAS float* accw = (LAS float*)((LAS char*)F.lds + L_OST + L.wid * 8192);
    const int nval = q >= 31 ? (((q - 31) >> 4) + 1 < 255 ? ((q - 31) >> 4) + 1 : 255) : 0;
    const int qmax = 64 * i + 63; const int nvmax = qmax >= 31 ? (((qmax - 31) >> 4) + 1 < 255 ? ((qmax - 31) >> 4) + 1 : 255) : 0;
    const int tc = (nvmax + 63) >> 6;
    const bf16* kcmp = (const bf16*)(F.ws + WS_KCMP) + (size_t)((0 * 4 + b) * 2 + kvh) * 256 * 64; const bf16* vcmp = (const bf16*)(F.ws + WS_KCMP) + (size_t)((1 * 4 + b) * 2 + kvh) * 256 * 64;
    KVSrc Sc{kcmp, vcmp, 64, 256};
    auto mfc = [nval](int t) -> u64 { return mask_le(nval - 1 - 64 * t); };
    float lsum = 0.f;
#pragma unroll
    for (int r = 0; r < 16; ++r) { o[0][r] = 0.f; o[1][r] = 0.f; }
    attend_range((LAS char*)F.lds, Sc, 0, tc, mfc, qr, -Cc, lsum, o, L);
    const float lc = lsum + __shfl_xor(lsum, 32); const float rlc = lc > 0.f ? __builtin_amdgcn_rcpf(lc) : 0.f;
    branch_finish_lds(wsf, accw, lsum, gs[0], o, L, true);
    LAS float* impw = (LAS float*)((LAS char*)F.lds + L_IMP) + L.wid * 512;
#pragma unroll
    for (int k = 0; k < 8; ++k) impw[L.lane + 64 * k] = 0.f;
    WAVE_LDS_FENCE();
    for (int t = 0; t < tc; ++t) {
        u32x4 kr, vr; tile_gload(Sc, t, L.tid, kr, vr);
        tile_lstore((LAS char*)F.lds + L_K0, (LAS char*)F.lds + L_V0, L.tid, kr, vr);
        __syncthreads();
        f32x16 p0, p1;
#pragma unroll
        for (int r = 0; r < 16; ++r) { p0[r] = -Cc; p1[r] = -Cc; }
        qk_tile((LAS char*)F.lds + L_K0, qr, p0, p1, L.r32, L.hi);
        const u64 mk = mfc(t); const unsigned m0 = (unsigned)(mk >> (4 * L.hi)), m1 = (unsigned)(mk >> (32 + 4 * L.hi));
        const int qloc = L.r32 >> 2; const bool wr = (L.r32 & 3) == 0;
#pragma unroll
        for (int half = 0; half < 2; ++half)
#pragma unroll
            for (int m = 0; m < 4; ++m) {
                float e[4];
#pragma unroll
                for (int k = 0; k < 4; ++k) { const int r = 4 * m + k, bit = k + 8 * m; const float x = half ? p1[r] : p0[r]; const unsigned mm = half ? m1 : m0;
                    e[k] = ((mm >> bit) & 1u) ? __builtin_amdgcn_exp2f(x) * rlc : 0.f; }
                const float core = dpp_quad_sum((e[0] + e[1]) + (e[2] + e[3])), edge = dpp_quad_sum(e[3]);
                const int j = 16 * t + 8 * half + 2 * m + L.hi;
                if (wr) { impw[qloc * 64 + j] += core; }
                WAVE_LDS_FENCE();
                if (wr && j + 1 < 64) { impw[qloc * 64 + j + 1] += edge; }
                WAVE_LDS_FENCE();
            }
        __syncthreads();
    }
    {
        const int qloc = L.lane >> 3, sub = L.lane & 7; const int cur = i;
        u64 keys[8];
#pragma unroll
        for (int k = 0; k < 8; ++k) { const int j = sub + 8 * k; float v = impw[qloc * 64 + j];
            if (j == 0 || j == cur || j == cur - 1) v = 1e9f;
            if (j > cur) v = -1e30f;
            keys[k] = ((u64)f2key(v) << 32) | (u64)(63 - j); }
        u64 selm = 0ull; unsigned used = 0u;
#pragma unroll 1
        for (int it = 0; it < 16; ++it) {
            u64 best = 0ull;
#pragma unroll
            for (int k = 0; k < 8; ++k) { const u64 c = ((used >> k) & 1u) ? 0ull : keys[k]; best = c > best ? c : best; }
#pragma unroll
            for (int o2 = 1; o2 < 8; o2 <<= 1) { const unsigned lo = __shfl_xor((unsigned)best, o2), hi2 = __shfl_xor((unsigned)(best >> 32), o2); const u64 ob = ((u64)hi2 << 32) | lo; best = ob > best ? ob : best; }
            const int jsel = 63 - (int)(best & 63ull);
            if ((jsel & 7) == sub) used |= 1u << (jsel >> 3);
            selm |= 1ull << jsel;
        }
        LAS u64* selw = (LAS u64*)((LAS char*)F.lds + L_SEL) + L.wid * 8;
        if (sub == 0) selw[qloc] = selm;
        WAVE_LDS_FENCE();
    }
    const u64 sel = ((LAS const u64*)((LAS char*)F.lds + L_SEL))[L.wid * 8 + (L.r32 >> 2)];
    {
        const bf16* KV = KVbase + (size_t)3 * M * 256;
        KVSrc S{KV + (size_t)b * SEQ * 256 + kvh * 64, KV + (size_t)b * SEQ * 256 + 128 + kvh * 64, 256, SEQ};
        auto mf = [sel, q](int t) -> u64 { return ((sel >> t) & 1ull) ? mask_le(q - 64 * t) : 0ull; };
        lsum = 0.f;
#pragma unroll
        for (int r = 0; r < 16; ++r) { o[0][r] = 0.f; o[1][r] = 0.f; }
        attend_range((LAS char*)F.lds, S, 0, i + 1, mf, qr, -Ck, lsum, o, L);
        branch_finish_lds(wsf, accw, lsum, gs[1], o, L, false);
    }
    {
        const bf16* KV = KVbase + (size_t)4 * M * 256;
        KVSrc S{KV + (size_t)b * SEQ * 256 + kvh * 64, KV + (size_t)b * SEQ * 256 + 128 + kvh * 64, 256, SEQ};
        auto mf = [q](int t) -> u64 { return mask_le(q - 64 * t) & mask_ge(q - 511 - 64 * t); };
        lsum = 0.f;
#pragma unroll
        for (int r = 0; r < 16; ++r) { o[0][r] = 0.f; o[1][r] = 0.f; }
        attend_range((LAS char*)F.lds, S, i - 8 < 0 ? 0 : i - 8, i + 1, mf, qr, -Ck, lsum, o, L);
        branch_finish_lds(wsf, accw, lsum, gs[2], o, L, false);
    }
    const size_t tok0 = (size_t)b * SEQ + 64 * i + 8 * L.wid; const int kvh4 = 4 * kvh;
    auto rowptr = [Q, tok0, kvh4](int row) -> bf16* { return Q + (tok0 + (row >> 2)) * 512 + (kvh4 + (row & 3)) * 64; };
    f32x16 acc[2];
#pragma unroll
    for (int d0 = 0; d0 < 2; ++d0)
#pragma unroll
        for (int r = 0; r < 16; ++r) acc[d0][r] = accw[(d0 * 16 + r) * 64 + L.lane];
    WAVE_LDS_FENCE();
    store_o((LAS char*)F.lds + L_OST + L.wid * 8192, acc, rowptr, L.lane, L.r32, L.hi);
}

__global__ void __launch_bounds__(NWAVES * 64, 2) mk_fwd(Args args) {
    extern __shared__ __attribute__((aligned(16))) unsigned char lds_raw[];
    LAS unsigned char* lds = (LAS unsigned char*)lds_raw;
    volatile LAS unsigned* MISCW = (volatile LAS unsigned*)(lds + LDS_UNIT + 16);
    if (threadIdx.x < 8) MISCW[threadIdx.x] = 0u;
    __syncthreads();
    XcdBarrier bar = xcd_barrier_post((unsigned*)((gu32*)(args.ws + WS_CTL) + CW_BAR), MISCW);
#define MKFRAME() Frame F; { unsigned char* ws_ = args.ws; asm volatile("" : "+s"(ws_)); int tid_ = threadIdx.x; asm volatile("" : "+v"(tid_)); \
    F.lds = lds; F.tid = tid_; F.lane = tid_ & 63; F.wave = __builtin_amdgcn_readfirstlane(tid_ >> 6); F.G = gridDim.x; F.gw = 0; F.NGW = F.G * NWAVES; \
    F.ws = ws_; F.ctl = (gu32*)(ws_ + WS_CTL); F.a = &args; } int bid = blockIdx.x; asm volatile("" : "+s"(bid)); F.gw = bid * NWAVES + F.wave; \
    unsigned char* ws = F.ws; bf16* XB = (bf16*)(ws + WS_XB); bf16* MB = (bf16*)(ws + WS_MB); bf16* ZQ = (bf16*)(ws + WS_ZQ); bf16* ZKV = (bf16*)(ws + WS_ZKV); bf16* YS = (bf16*)(ws + WS_YS); bf16* HM = (bf16*)(ws + WS_HMID); \
    float* SSQ = (float*)(ws + WS_SSQ); (void)XB; (void)MB; (void)ZQ; (void)ZKV; (void)YS; (void)HM; (void)SSQ;
#define WL(l) (ws + WS_W + (size_t)(l) * W_LAYER)

#ifndef NO_P0
    { MKFRAME(); p0_prologue(F); }
#endif
    xcd_barrier(bar);
#pragma unroll 1
    for (int l = 0; l < DEPTH; ++l) {
#ifndef NO_G1
        {
            MKFRAME(); unsigned char* wl = WL(l);
            pg8::Gemm g{XB, (const bf16*)(wl + W_IN), M, 3328, DM}; pg8::StaticOrder S; S.init(M, 3328, F.G, bid);
            pg8::EpiG1 E{ZQ, ZKV, SSQ};
            pg8::gemm_phase<pg8::EpiG1, pg8::StaticOrder, true, true>(F.lds, g, S, E);
        }
#endif
        xcd_barrier(bar);
#ifndef NO_POST
        { MKFRAME(); post_phase(F, l); }
#endif
        xcd_barrier(bar);
        {
            MKFRAME();
            gu32* ctr = F.ctl + CW_Q + 64 * (2 * l);
            for (;;) { const int u = next_unit(F, ctr); if (u >= 128 + 2048 + 512) break;
#ifndef NO_CMP
                if (u < 128) compress_unit(F, l, u);
#else
                if (u < 128) {}
#endif
#ifndef NO_SEL
                else if (u < 128 + 2048) { const int v = u - 128; select_unit(F, v & 3, 511 - (v >> 2)); }
#endif
#ifndef NO_SWA
                else { const int v = u - 2176; simple_unit<0>(F, l, v & 3, (v >> 2) & 1, v >> 3); }
#endif
            }
        }
        xcd_barrier(bar);
        {
            MKFRAME();
            gu32* ctr = F.ctl + CW_Q + 64 * (2 * l + 1);
            for (;;) { const int u = next_unit(F, ctr); if (u >= 1024) break;
                const int i = 63 - (u >> 4), b = (u >> 1) & 3, kvh = u & 1;
#ifndef NO_DSA
                if ((u >> 3) & 1) simple_unit<1>(F, l, b, kvh, i);
#endif
#ifndef NO_NSA
                if (!((u >> 3) & 1)) nsa_unit(F, l, b, kvh, i);
#endif
            }
        }
        xcd_barrier(bar);
#ifndef NO_G2
#pragma unroll 1
        for (int n = 0; n < 3; ++n) {
            MKFRAME(); unsigned char* wl = WL(l);
#ifndef NO_G2A
            { pg8::Gemm g{ZQ + (size_t)n * M * 512, (const bf16*)(wl + W_BR) + (size_t)n * DM * 512, M, DM, 512}; pg8::StaticOrder S; S.init(M, DM, F.G, bid);
              pg8::EpiStash E{YS}; pg8::gemm_phase<pg8::EpiStash, pg8::StaticOrder, false, true>(F.lds, g, S, E); }
#endif
#ifndef NO_G2B
            { pg8::Gemm g{XB, (const bf16*)(wl + W_G) + (size_t)n * DM * DM, M, DM, DM}; pg8::StaticOrder S; S.init(M, DM, F.G, bid);
              pg8::EpiGate E{YS, MB, SSQ, n == 0 ? 1 : 0}; pg8::gemm_phase<pg8::EpiGate, pg8::StaticOrder, false, true>(F.lds, g, S, E); }
#endif
        }
#endif
        xcd_barrier(bar);
#ifndef NO_G3
        {
            MKFRAME(); unsigned char* wl = WL(l);
            pg8::Gemm g{MB, (const bf16*)(wl + W_OUT), M, DM, DM}; pg8::StaticOrder S; S.init(M, DM, F.G, bid);
            pg8::EpiRes E{l == 0 ? F.a->in[0] : (const float*)F.a->out, F.a->out, XB, SSQ};
            pg8::gemm_phase<pg8::EpiRes, pg8::StaticOrder, false, true>(F.lds, g, S, E);
        }
#endif
        xcd_barrier(bar);
#ifndef NO_G4
        {
            MKFRAME(); unsigned char* wl = WL(l);
            pg8::Gemm g{XB, (const bf16*)(wl + W_UP), M, DFF, DM}; pg8::StaticOrder S; S.init(M, DFF, F.G, bid);
            pg8::EpiG4 E{HM, SSQ};
            pg8::gemm_phase<pg8::EpiG4, pg8::StaticOrder, true, true>(F.lds, g, S, E);
        }
#endif
        xcd_barrier(bar);
#ifndef NO_G5
        {
            MKFRAME(); unsigned char* wl = WL(l);
            pg8::Gemm g{HM, (const bf16*)(wl + W_DN), M, DM, DFF}; pg8::StaticOrder S; S.init(M, DM, F.G, bid);
            pg8::EpiRes E{(const float*)F.a->out, F.a->out, XB, SSQ};
            pg8::gemm_phase<pg8::EpiRes, pg8::StaticOrder, false, true>(F.lds, g, S, E);
        }
#endif
        if (l + 1 < DEPTH) xcd_barrier(bar);
    }
}

extern "C" void kernel_launch(void* const* d_in, const int* in_sizes, int n_in, void* d_out, int out_size, void* d_ws, size_t ws_size, hipStream_t stream) {
    static int grid = 0;
    if (grid == 0) {
        if (n_in != 17 || out_size != M * DM || ws_size < WS_END) { fprintf(stderr, "kernel_launch: unexpected problem shape (n_in %d out %d ws %zu)\n", n_in, out_size, ws_size); grid = -1; return; }
        int dev = 0, cus = 0, per_cu = 0;
        if (hipGetDevice(&dev) != hipSuccess || hipDeviceGetAttribute(&cus, hipDeviceAttributeMultiprocessorCount, dev) != hipSuccess) { grid = -1; return; }
        if (hipFuncSetAttribute((const void*)mk_fwd, hipFuncAttributeMaxDynamicSharedMemorySize, LDS_BYTES) != hipSuccess) { fprintf(stderr, "kernel_launch: hipFuncSetAttribute failed\n"); grid = -1; return; }
        if (hipOccupancyMaxActiveBlocksPerMultiprocessor(&per_cu, (const void*)mk_fwd, NWAVES * 64, LDS_BYTES) != hipSuccess || per_cu < 1) { fprintf(stderr, "kernel_launch: occupancy query says %d blocks/CU\n", per_cu); }
        (void)hipGetLastError();
        if (cus != 256) { fprintf(stderr, "kernel_launch: built for a 256-CU device (one 256x256 GEMM unit per workgroup in the N=1024 phases), found %d CUs\n", cus); grid = -1; return; }
        grid = cus;
    }
    if (grid < 0) return;
    (void)hipMemsetAsync((char*)d_ws + WS_CTL, 0, CTL_BYTES, stream);
    Args a{};
    for (int i = 0; i < 17; ++i) a.in[i] = (const float*)d_in[i];
    a.out = (float*)d_out; a.ws = (unsigned char*)d_ws;
    hipLaunchKernelGGL(mk_fwd, dim3(grid), dim3(NWAVES * 64), LDS_BYTES, stream, a);
}
```

```cpp
#include <hip/hip_runtime.h>
#include <cstdio>
#include <cstdint>

namespace pg8 {
#define PG8_LAS __attribute__((address_space(3)))
typedef unsigned short bf16_t;
typedef short bf16x8 __attribute__((ext_vector_type(8)));
typedef float f32x4 __attribute__((ext_vector_type(4)));
typedef unsigned u32x4 __attribute__((ext_vector_type(4)));
constexpr int BM = 256, BK = 64, HALF = 128, HTB = HALF * BK * 2  , STAGE_BYTES = 8 * HTB, NXCD = 8, WGM = 8;

__host__ __device__ __forceinline__ int lds_byte(int r, int c) { const int st = (r >> 4) * 2 + (c >> 5), rr = r & 15, cc = c & 31, ob = rr * 64 + cc * 2; return st * 1024 + (ob ^ (((ob >> 9) & 1) << 5)); }
__host__ __device__ __forceinline__ void stage_rc(int b, int& R, int& C) { const int st = b / 1024, sb = b % 1024, swz = sb ^ (((sb >> 9) & 1) << 5); R = (st >> 1) * 16 + swz / 64; C = (st & 1) * 32 + (swz % 64) / 2; }
__host__ __device__ __forceinline__ int perm32(int rho) { const int n = rho >> 4, i = rho & 15; return 8 * (i >> 2) + 4 * n + (i & 3); }

struct Unit { int pm, pn; };
struct Gemm { const bf16_t* A; const bf16_t* Bt; int M, N, K; };

struct StaticOrder {
    int nM, nN, nwg, G, c;
    __host__ __device__ void init(int M, int N, int G_, int c_) { nM = M / BM; nN = N / BM; nwg = nM * nN; G = G_; c = c_; }
    __host__ __device__ bool next(int i, Unit& u) const {
        const long L = (long)i * G + c; if (L >= nwg) return false;
        int wgid = (int)L; { const int q = nwg / NXCD, r = nwg % NXCD, xcd = wgid % NXCD, off = wgid / NXCD; wgid = (xcd < r ? xcd * (q + 1) : r * (q + 1) + (xcd - r) * q) + off; }
        const int nig = WGM * nN, gid = wgid / nig, fm = gid * WGM, gsz = (nM - fm) < WGM ? (nM - fm) : WGM;
        u.pm = fm + ((wgid % nig) % gsz); u.pn = (wgid % nig) / gsz; return true;
    }
    __device__ __forceinline__ void a_ready(const Unit&) const {}
    __device__ __forceinline__ void done(const Unit&) const {}
};

__device__ __forceinline__ unsigned cvt_pk_bf16(float lo, float hi) { unsigned r; asm volatile("v_cvt_pk_bf16_f32 %0, %1, %2" : "=v"(r) : "v"(lo), "v"(hi)); return r; }
template <class Epi, class Sched, bool ALIGN_EPI = false, bool SP2 = false>
__device__ __forceinline__ void gemm_phase(PG8_LAS unsigned char* lds, const Gemm g, const Sched& S, const Epi& E) {
    int tid_l = threadIdx.x; asm volatile("" : "+v"(tid_l));
    const int tid = tid_l, wid = __builtin_amdgcn_readfirstlane(tid >> 6), lane = tid & 63, wr = wid >> 2, wc = wid & 3, fr = lane & 15, fq = lane >> 4;
    const int K = g.K, nt = K / BK;
    unsigned voffA[2], voffB[2];
#pragma unroll
    for (int i = 0; i < 2; ++i) { int R, C; stage_rc(tid * 16 + i * 8192, R, C); const int Rb = Epi::PERM ? ((R & ~31) + perm32(R & 31)) : R;
        voffA[i] = (unsigned)(R * K + C) * 2u; voffB[i] = (unsigned)(Rb * K + C) * 2u; }
    const size_t kstep = (size_t)(BK * 2);
    const size_t hstep = (size_t)HALF * K * 2;
    const size_t tstep = 2 * hstep;
    const unsigned ldsw = (unsigned)wid * 1024u;
    const int aoff = lds_byte(wr * 64 + fr, fq * 8), boff = lds_byte(wc * 32 + fr, fq * 8);
#define PG8_SA(b, h) (((b) * 2 + (h)) * HTB)
#define PG8_SB(b, h) ((4 + (b) * 2 + (h)) * HTB)
#define PG8_STAGE(bufoff, gbase, voff) do { _Pragma("unroll") for (int _i = 0; _i < 2; ++_i) \
        __builtin_amdgcn_global_load_lds((const unsigned*)((const char*)(gbase) + (voff)[_i]), (PG8_LAS unsigned*)(lds + (bufoff) + ldsw + _i * 8192), 16, 0, 0); } while (0)
#define PG8_LDA(dst, b, h) do { _Pragma("unroll") for (int m = 0; m < 4; ++m) _Pragma("unroll") for (int k = 0; k < 2; ++k) dst[m][k] = *(const PG8_LAS bf16x8*)(lds + PG8_SA(b, h) + aoff + m * 2048 + k * 1024); } while (0)
#define PG8_LDB(dst, b, h) do { _Pragma("unroll") for (int n = 0; n < 2; ++n) _Pragma("unroll") for (int k = 0; k < 2; ++k) dst[n][k] = *(const PG8_LAS bf16x8*)(lds + PG8_SB(b, h) + boff + n * 2048 + k * 1024); } while (0)
#define PG8_MMA(ai, bj, At, Bt) do { __builtin_amdgcn_s_setprio(1); _Pragma("unroll") for (int m = 0; m < 4; ++m) _Pragma("unroll") for (int n = 0; n < 2; ++n) _Pragma("unroll") for (int k = 0; k < 2; ++k) \
        acc[ai][bj][m][n] = __builtin_amdgcn_mfma_f32_16x16x32_bf16(Bt[n][k], At[m][k], acc[ai][bj][m][n], 0, 0, 0); __builtin_amdgcn_s_setprio(0); } while (0)
#define PG8_WAIT_V(n) asm volatile("s_waitcnt vmcnt(" #n ")" ::: "memory")
#define PG8_WAIT_L(n) asm volatile("s_waitcnt lgkmcnt(" #n ")" ::: "memory")
#define PG8_BAR __builtin_amdgcn_s_barrier()
#define PG8_SCHED __builtin_amdgcn_sched_barrier(0)
    Unit cur, nxt; int ui = 0;
    if (!S.next(0, cur)) return;
    f32x4 acc[2][2][4][2];
#pragma unroll
    for (int a = 0; a < 2; ++a)
#pragma unroll
        for (int b = 0; b < 2; ++b)
#pragma unroll
            for (int m = 0; m < 4; ++m)
#pragma unroll
                for (int n = 0; n < 2; ++n) acc[a][b][m][n] = (f32x4){0.f, 0.f, 0.f, 0.f};
    bf16x8 At[4][2], B0[2][2], B1[2][2];
    const char* cA = (const char*)g.A + (size_t)cur.pm * tstep; const char* cB = (const char*)g.Bt + (size_t)cur.pn * tstep;
    S.a_ready(cur);
    if constexpr (SP2) {
        PG8_STAGE(PG8_SB(0, 0), cB, voffB); PG8_STAGE(PG8_SB(0, 1), cB + hstep, voffB); PG8_STAGE(PG8_SA(0, 0), cA, voffA); PG8_STAGE(PG8_SA(0, 1), cA + hstep, voffA);
        if (wr == 1) PG8_BAR;
        PG8_WAIT_V(2); PG8_BAR;
        PG8_STAGE(PG8_SB(1, 0), cB + kstep, voffB); PG8_STAGE(PG8_SA(1, 0), cA + kstep, voffA); PG8_STAGE(PG8_SB(1, 1), cB + hstep + kstep, voffB);
        PG8_WAIT_V(6); PG8_BAR;
    } else {
        PG8_STAGE(PG8_SB(0, 0), cB, voffB); PG8_STAGE(PG8_SA(0, 0), cA, voffA); PG8_STAGE(PG8_SB(0, 1), cB + hstep, voffB); PG8_STAGE(PG8_SA(0, 1), cA + hstep, voffA);
        if (wr == 1) PG8_BAR;
        PG8_WAIT_V(4); PG8_BAR;
        PG8_STAGE(PG8_SB(1, 0), cB + kstep, voffB); PG8_STAGE(PG8_SA(1, 0), cA + kstep, voffA); PG8_STAGE(PG8_SB(1, 1), cB + hstep + kstep, voffB);
        PG8_WAIT_V(6); PG8_BAR;
    }
    for (;;) {
        const bool has_next = S.next(ui + 1, nxt);
        const char* nA = has_next ? (const char*)g.A + (size_t)nxt.pm * tstep : cA; const char* nB = has_next ? (const char*)g.Bt + (size_t)nxt.pn * tstep : cB;
        for (int t = 0; t < nt; t += 2) {
            const bool last = (t == nt - 2);
            const char* a1 = cA + (size_t)(t + 1) * kstep;
            const char* a2 = last ? nA : cA + (size_t)(t + 2) * kstep; const char* b2 = last ? nB : cB + (size_t)(t + 2) * kstep;
            const char* a3 = a2 + kstep; const char* b3 = b2 + kstep;
            if (last && has_next) S.a_ready(nxt);
            if constexpr (SP2) {
            PG8_LDB(B0, 0, 0); PG8_LDB(B1, 0, 1); PG8_SCHED; PG8_LDA(At, 0, 0); PG8_STAGE(PG8_SA(1, 1), a1 + hstep, voffA);
            PG8_WAIT_V(8); PG8_WAIT_L(0); PG8_BAR; PG8_MMA(0, 0, At, B0); PG8_MMA(0, 1, At, B1); PG8_BAR; PG8_SCHED;
            PG8_LDA(At, 0, 1); PG8_STAGE(PG8_SB(0, 0), b2, voffB); PG8_STAGE(PG8_SB(0, 1), b2 + hstep, voffB); PG8_STAGE(PG8_SA(0, 0), a2, voffA);
            PG8_WAIT_V(8); PG8_WAIT_L(0); PG8_BAR; PG8_MMA(1, 0, At, B0); PG8_MMA(1, 1, At, B1); PG8_BAR; PG8_SCHED;
            PG8_LDB(B0, 1, 0); PG8_LDB(B1, 1, 1); PG8_SCHED; PG8_LDA(At, 1, 0); PG8_STAGE(PG8_SA(0, 1), a2 + hstep, voffA);
            PG8_WAIT_V(8); PG8_WAIT_L(0); PG8_BAR; PG8_MMA(0, 0, At, B0); PG8_MMA(0, 1, At, B1); PG8_BAR; PG8_SCHED;
            PG8_LDA(At, 1, 1); PG8_STAGE(PG8_SB(1, 0), b3, voffB); PG8_STAGE(PG8_SB(1, 1), b3 + hstep, voffB); PG8_STAGE(PG8_SA(1, 0), a3, voffA);
            PG8_WAIT_V(8); PG8_WAIT_L(0); PG8_BAR; PG8_MMA(1, 0, At, B0); PG8_MMA(1, 1, At, B1); PG8_BAR; PG8_SCHED;
            } else {
            PG8_LDB(B0, 0, 0); PG8_SCHED; PG8_LDA(At, 0, 0); PG8_STAGE(PG8_SA(1, 1), a1 + hstep, voffA);
            PG8_WAIT_L(8); PG8_BAR; PG8_WAIT_L(0); PG8_MMA(0, 0, At, B0); PG8_BAR; PG8_SCHED;
            PG8_LDB(B1, 0, 1); PG8_STAGE(PG8_SB(0, 0), b2, voffB);
            PG8_BAR; PG8_WAIT_L(0); PG8_MMA(0, 1, At, B1); PG8_BAR;
            PG8_LDA(At, 0, 1); PG8_STAGE(PG8_SA(0, 0), a2, voffA);
            PG8_BAR; PG8_WAIT_L(0); PG8_MMA(1, 0, At, B0); PG8_BAR; PG8_SCHED;
            PG8_STAGE(PG8_SB(0, 1), b2 + hstep, voffB);
            PG8_WAIT_V(6); PG8_BAR; PG8_MMA(1, 1, At, B1); PG8_BAR;
            PG8_LDB(B0, 1, 0); PG8_SCHED; PG8_LDA(At, 1, 0); PG8_STAGE(PG8_SA(0, 1), a2 + hstep, voffA);
            PG8_WAIT_L(8); PG8_BAR; PG8_WAIT_L(0); PG8_MMA(0, 0, At, B0); PG8_BAR; PG8_SCHED;
            PG8_LDB(B1, 1, 1); PG8_STAGE(PG8_SB(1, 0), b3, voffB);
            PG8_BAR; PG8_WAIT_L(0); PG8_MMA(0, 1, At, B1); PG8_BAR;
            PG8_LDA(At, 1, 1); PG8_STAGE(PG8_SA(1, 0), a3, voffA);
            PG8_BAR; PG8_WAIT_L(0); PG8_MMA(1, 0, At, B0); PG8_BAR; PG8_SCHED;
            PG8_STAGE(PG8_SB(1, 1), b3 + hstep, voffB);
            PG8_WAIT_V(6); PG8_BAR; PG8_MMA(1, 1, At, B1); PG8_BAR;
            }
        }
        if constexpr (ALIGN_EPI) { if (wr == 0) PG8_BAR; }
        if constexpr (!Epi::AFTER_DRAIN) { E(acc, cur, wr, wc, fr, fq); S.done(cur); }
        if (!has_next) break;
#pragma unroll
        for (int a = 0; a < 2; ++a)
#pragma unroll
            for (int b = 0; b < 2; ++b)
#pragma unroll
                for (int m = 0; m < 4; ++m)
#pragma unroll
                    for (int n = 0; n < 2; ++n) acc[a][b][m][n] = (f32x4){0.f, 0.f, 0.f, 0.f};
        cur = nxt; cA = nA; cB = nB; ++ui;
        if constexpr (ALIGN_EPI) { if (wr == 1) PG8_BAR; }
    }
    PG8_WAIT_V(0);
    if constexpr (!ALIGN_EPI) { if (wr == 0) PG8_BAR; }
    PG8_BAR;
    if constexpr (Epi::AFTER_DRAIN) { E.fused(acc, cur, wr, wc, fr, fq, lds, wid, lane); S.done(cur); }
#undef PG8_SA
#undef PG8_SB
#undef PG8_STAGE
#undef PG8_LDA
#undef PG8_LDB
#undef PG8_MMA
#undef PG8_WAIT_V
#undef PG8_WAIT_L
#undef PG8_BAR
#undef PG8_SCHED
}
}

namespace pg8 {
constexpr int MROWS = 16384;
__device__ __forceinline__ unsigned pk_bf16(float lo, float hi) { typedef float f2 __attribute__((ext_vector_type(2))); typedef __bf16 b2 __attribute__((ext_vector_type(2)));
    f2 v = {lo, hi}; b2 b = __builtin_convertvector(v, b2); return __builtin_bit_cast(unsigned, b); }
__device__ __forceinline__ float bf_lo(unsigned w) { return __uint_as_float(w << 16); }
__device__ __forceinline__ float bf_hi(unsigned w) { return __uint_as_float(w & 0xffff0000u); }
__device__ __forceinline__ float row_rstd(const float* ssq, int row) {
    const f32x4* p = (const f32x4*)(ssq + (size_t)row * 16);
    const f32x4 a = p[0], b = p[1], c = p[2], d = p[3];
    const float s = (((a[0] + a[1]) + (a[2] + a[3])) + ((b[0] + b[1]) + (b[2] + b[3]))) + (((c[0] + c[1]) + (c[2] + c[3])) + ((d[0] + d[1]) + (d[2] + d[3])));
    return rsqrtf(s * (1.0f / 1024.0f) + 1e-6f);
}
__device__ __forceinline__ float sigmoidf_(float x) { return __builtin_amdgcn_rcpf(1.0f + __builtin_amdgcn_exp2f(-1.4426950408889634f * x)); }

struct EpiG1 {
    static constexpr bool PERM = true, AFTER_DRAIN = false;
    bf16_t* zq; bf16_t* zkv; const float* ssq;
    __device__ __forceinline__ void operator()(const f32x4 (&acc)[2][2][4][2], const Unit& u, int wr, int wc, int fr, int fq) const {
        const int row0 = u.pm * BM + wr * 64 + fr;
        bf16_t* base; int ldc, colt;
        if (u.pn < 6) { base = zq + (size_t)(u.pn >> 1) * ((size_t)MROWS * 512); ldc = 512; colt = (u.pn & 1) * 256; }
        else { base = zkv + (size_t)(u.pn - 6) * ((size_t)MROWS * 256); ldc = 256; colt = 0; }
        const int col0 = colt + wc * 32 + 8 * fq;
#pragma unroll
        for (int ai = 0; ai < 2; ++ai)
#pragma unroll
            for (int m = 0; m < 4; ++m) { const int row = row0 + ai * HALF + m * 16; const float rs = row_rstd(ssq, row); bf16_t* rowp = base + (size_t)row * ldc + col0;
#pragma unroll
                for (int bj = 0; bj < 2; ++bj) { const f32x4 v0 = acc[ai][bj][m][0] * rs, v1 = acc[ai][bj][m][1] * rs;
                    u32x4 w; w.x = pk_bf16(v0[0], v0[1]); w.y = pk_bf16(v0[2], v0[3]); w.z = pk_bf16(v1[0], v1[1]); w.w = pk_bf16(v1[2], v1[3]);
                    *(u32x4*)(rowp + bj * HALF) = w; } }
    }
};
struct EpiG4 {
    static constexpr bool PERM = true, AFTER_DRAIN = false;
    bf16_t* h; const float* ssq;
    __device__ __forceinline__ void operator()(const f32x4 (&acc)[2][2][4][2], const Unit& u, int wr, int wc, int fr, int fq) const {
        const int row0 = u.pm * BM + wr * 64 + fr; const int col0 = u.pn * BM + wc * 32 + 8 * fq;
#pragma unroll
        for (int ai = 0; ai < 2; ++ai)
#pragma unroll
            for (int m = 0; m < 4; ++m) { const int row = row0 + ai * HALF + m * 16; const float rs = row_rstd(ssq, row); bf16_t* rowp = h + (size_t)row * 4096 + col0;
#pragma unroll
                for (int bj = 0; bj < 2; ++bj) { f32x4 v0 = acc[ai][bj][m][0] * rs, v1 = acc[ai][bj][m][1] * rs;
#pragma unroll
                    for (int e = 0; e < 4; ++e) { v0[e] = fmaxf(v0[e], 0.f); v0[e] *= v0[e]; v1[e] = fmaxf(v1[e], 0.f); v1[e] *= v1[e]; }
                    u32x4 w; w.x = pk_bf16(v0[0], v0[1]); w.y = pk_bf16(v0[2], v0[3]); w.z = pk_bf16(v1[0], v1[1]); w.w = pk_bf16(v1[2], v1[3]);
                    *(u32x4*)(rowp + bj * HALF) = w; } }
    }
};
struct EpiRes {
    static constexpr bool PERM = true, AFTER_DRAIN = false;
    const float* xold; float* xout; bf16_t* xb; float* ssq;
    __device__ __forceinline__ void operator()(const f32x4 (&acc)[2][2][4][2], const Unit& u, int wr, int wc, int fr, int fq) const {
        const int row0 = u.pm * BM + wr * 64 + fr; const int col0 = u.pn * BM + wc * 32 + 8 * fq;
#pragma unroll
        for (int ai = 0; ai < 2; ++ai)
#pragma unroll
            for (int m = 0; m < 4; ++m) { const int row = row0 + ai * HALF + m * 16; float part = 0.f;
#pragma unroll
                for (int bj = 0; bj < 2; ++bj) { const size_t off = (size_t)row * 1024 + col0 + bj * HALF;
                    const f32x4 a0 = *(const f32x4*)(xold + off), a1 = *(const f32x4*)(xold + off + 4);
                    const f32x4 v0 = acc[ai][bj][m][0] + a0, v1 = acc[ai][bj][m][1] + a1;
                    *(f32x4*)(xout + off) = v0; *(f32x4*)(xout + off + 4) = v1;
                    u32x4 w; w.x = pk_bf16(v0[0], v0[1]); w.y = pk_bf16(v0[2], v0[3]); w.z = pk_bf16(v1[0], v1[1]); w.w = pk_bf16(v1[2], v1[3]);
                    *(u32x4*)(xb + off) = w;
                    part += ((v0[0] * v0[0] + v0[1] * v0[1]) + (v0[2] * v0[2] + v0[3] * v0[3])) + ((v1[0] * v1[0] + v1[1] * v1[1]) + (v1[2] * v1[2] + v1[3] * v1[3])); }
                part += __shfl_xor(part, 16); part += __shfl_xor(part, 32);
                if (fq == 0) ssq[(size_t)row * 16 + u.pn * 4 + wc] = part;
                asm volatile("" ::: "memory"); }
    }
};
struct EpiStash {
    static constexpr bool PERM = true, AFTER_DRAIN = true;
    __device__ __forceinline__ void fused(f32x4 (&acc)[2][2][4][2], const Unit& u, int wr, int wc, int fr, int fq, PG8_LAS unsigned char*, int, int) const { (*this)(acc, u, wr, wc, fr, fq); }
    bf16_t* ys;
    __device__ __forceinline__ void operator()(const f32x4 (&acc)[2][2][4][2], const Unit& u, int wr, int wc, int fr, int fq) const {
        bf16_t* base = ys + (size_t)(u.pm * 4 + u.pn) * 65536; const int row0 = wr * 64 + fr, col0 = wc * 32 + 8 * fq;
#pragma unroll
        for (int ai = 0; ai < 2; ++ai)
#pragma unroll
            for (int m = 0; m < 4; ++m) { bf16_t* rowp = base + (row0 + ai * HALF + m * 16) * 256 + col0;
#pragma unroll
                for (int bj = 0; bj < 2; ++bj) { const f32x4 v0 = acc[ai][bj][m][0], v1 = acc[ai][bj][m][1];
                    u32x4 w; w.x = pk_bf16(v0[0], v0[1]); w.y = pk_bf16(v0[2], v0[3]); w.z = pk_bf16(v1[0], v1[1]); w.w = pk_bf16(v1[2], v1[3]);
                    *(u32x4*)(rowp + bj * HALF) = w; } }
    }
};
struct EpiGate {
    static constexpr bool PERM = true, AFTER_DRAIN = true;
    __device__ __forceinline__ void fused(f32x4 (&acc)[2][2][4][2], const Unit& u, int wr, int wc, int fr, int fq, PG8_LAS unsigned char*, int, int) const { (*this)(acc, u, wr, wc, fr, fq); }
    const bf16_t* ys; bf16_t* mb; const float* ssq; int first;
    __device__ __forceinline__ void operator()(const f32x4 (&acc)[2][2][4][2], const Unit& u, int wr, int wc, int fr, int fq) const {
        const bf16_t* sbase = ys + (size_t)(u.pm * 4 + u.pn) * 65536; const int lrow0 = wr * 64 + fr, lcol0 = wc * 32 + 8 * fq;
#pragma unroll
        for (int ai = 0; ai < 2; ++ai)
#pragma unroll
            for (int m = 0; m < 4; ++m) { const int lrow = lrow0 + ai * HALF + m * 16, row = u.pm * BM + lrow; const float rs = row_rstd(ssq, row);
#pragma unroll
                for (int bj = 0; bj < 2; ++bj) { const f32x4 a0 = acc[ai][bj][m][0] * rs, a1 = acc[ai][bj][m][1] * rs;
                    const u32x4 y = *(const u32x4*)(sbase + lrow * 256 + lcol0 + bj * HALF);
                    bf16_t* mp = mb + (size_t)row * 1024 + u.pn * BM + lcol0 + bj * HALF;
                    u32x4 pv = {0u, 0u, 0u, 0u}; if (!first) pv = *(const u32x4*)mp;
                    float r[8];
                    r[0] = bf_lo(pv.x) + sigmoidf_(a0[0]) * bf_lo(y.x); r[1] = bf_hi(pv.x) + sigmoidf_(a0[1]) * bf_hi(y.x);
                    r[2] = bf_lo(pv.y) + sigmoidf_(a0[2]) * bf_lo(y.y); r[3] = bf_hi(pv.y) + sigmoidf_(a0[3]) * bf_hi(y.y);
                    r[4] = bf_lo(pv.z) + sigmoidf_(a1[0]) * bf_lo(y.z); r[5] = bf_hi(pv.z) + sigmoidf_(a1[1]) * bf_hi(y.z);
                    r[6] = bf_lo(pv.w) + sigmoidf_(a1[2]) * bf_lo(y.w); r[7] = bf_hi(pv.w) + sigmoidf_(a1[3]) * bf_hi(y.w);
                    u32x4 w; w.x = pk_bf16(r[0], r[1]); w.y = pk_bf16(r[2], r[3]); w.z = pk_bf16(r[4], r[5]); w.w = pk_bf16(r[6], r[7]);
                    *(u32x4*)mp = w;
                    asm volatile("" ::: "memory"); } }
    }
};
struct EpiNull {
    static constexpr bool PERM = true, AFTER_DRAIN = false;
    __device__ __forceinline__ void operator()(const f32x4 (&acc)[2][2][4][2], const Unit& u, int wr, int wc, int fr, int fq) const {
#pragma unroll
        for (int ai = 0; ai < 2; ++ai)
#pragma unroll
            for (int bj = 0; bj < 2; ++bj)
#pragma unroll
                for (int m = 0; m < 4; ++m) { asm volatile("" :: "v"(acc[ai][bj][m][0]), "v"(acc[ai][bj][m][1])); }
    }
};
}

#define GAS __attribute__((address_space(1)))
#define LAS __attribute__((address_space(3)))
typedef unsigned short bf16;
typedef unsigned v4u __attribute__((ext_vector_type(4)));
typedef float f32x4 __attribute__((ext_vector_type(4)));
typedef short bf16x8 __attribute__((ext_vector_type(8)));
typedef GAS unsigned gu32;
typedef GAS unsigned long long gu64;
#define RLX_AGENT __ATOMIC_RELAXED, __HIP_MEMORY_SCOPE_AGENT
#define LDS_WAIT() asm volatile("s_waitcnt lgkmcnt(0)" ::: "memory")
#define VM_WAIT() asm volatile("s_waitcnt vmcnt(0)" ::: "memory")
__device__ __forceinline__ unsigned long long rt() { return __builtin_amdgcn_s_memrealtime(); }
__device__ __forceinline__ unsigned f2bf(float f) { unsigned u = __builtin_bit_cast(unsigned, f); return (u + 0x7fffu + ((u >> 16) & 1u)) >> 16; }
__device__ __forceinline__ unsigned pk2(float lo, float hi) { return f2bf(lo) | (f2bf(hi) << 16); }

#define XB_TMO      128
#define XB_XCNT(j)  (256  + 64 * (j))
#define XB_XSUB(j)  (1280 + 64 * (j))
#define XB_XGEN(j)  (2304 + 64 * (j))
#define XB_TOP      3328
#define XB_TOPGEN   3392
#define XCD_BAR_WORDS 3456
#define XB_SPIN_CAP (1u << 18)

__device__ __forceinline__ unsigned xb_ld(unsigned* p)              { return __hip_atomic_load(p, __ATOMIC_RELAXED, __HIP_MEMORY_SCOPE_AGENT); }
__device__ __forceinline__ unsigned xb_add(unsigned* p, unsigned v) { return __hip_atomic_fetch_add(p, v, __ATOMIC_RELAXED, __HIP_MEMORY_SCOPE_AGENT); }
__device__ __forceinline__ unsigned xb_xcc_id() { return (unsigned)__builtin_amdgcn_s_getreg((3 << 11) | 20) & 0xFu; }
#define XB_SPIN(cond, bar) do { unsigned _sp = 0; while (cond) { __builtin_amdgcn_s_sleep(1); \
    if ((++_sp & 255u) == 0u) { if (xb_ld(&(bar)[XB_TMO])) break; if (_sp > XB_SPIN_CAP) { atomicAdd(&(bar)[XB_TMO], 1u); break; } } } } while (0)

struct XcdBarrier {
    unsigned* bar; unsigned x;
    volatile LAS unsigned* st;
};

__device__ __forceinline__ XcdBarrier xcd_barrier_post(unsigned* bar, volatile LAS unsigned* st) {
    XcdBarrier b; b.bar = bar; b.x = xb_xcc_id(); b.st = st;
    if (threadIdx.x == 0) (void)xb_add(&bar[XB_XCNT(b.x)], 1u);
    return b;
}
__device__ __forceinline__ void xcd_barrier_complete(unsigned* bar, unsigned x, unsigned& nloc, unsigned& nx) {
    const unsigned G = gridDim.x * gridDim.y * gridDim.z;
    unsigned sum, cnt, mine, sp = 0u;
    for (;;) {
        sum = 0u; cnt = 0u; mine = 0u;
#pragma unroll
        for (unsigned j = 0; j < 16; ++j) { const unsigned c = xb_ld(&bar[XB_XCNT(j)]); sum += c; cnt += (c > 0u) ? 1u : 0u; mine = (j == x) ? c : mine; }
        if (sum == G) break;
        __builtin_amdgcn_s_sleep(1);
        if ((++sp & 255u) == 0u) { if (xb_ld(&bar[XB_TMO])) break; if (sp > XB_SPIN_CAP) { atomicAdd(&bar[XB_TMO], 1u); break; } }
    }
    nloc = mine > 0u ? mine : 1u; nx = cnt > 0u ? cnt : 1u;
}

__device__ __forceinline__ void xcd_barrier(const XcdBarrier& b) {
    asm volatile("s_waitcnt vmcnt(0)" ::: "memory");
    __syncthreads();
    if (threadIdx.x == 0) {
        unsigned* bar = b.bar;
        __builtin_amdgcn_s_waitcnt(0);
        unsigned nloc = b.st[0], nx = b.st[1];
        if (nloc == 0u) { xcd_barrier_complete(bar, b.x, nloc, nx); b.st[0] = nloc; b.st[1] = nx; }
        const unsigned old = xb_add(&bar[XB_XSUB(b.x)], 1u);
        const unsigned gen = old / nloc;
        if (old + 1u == (gen + 1u) * nloc) {
            __builtin_amdgcn_fence(__ATOMIC_RELEASE, "agent");
            asm volatile("s_waitcnt vmcnt(0)" ::: "memory");
            const unsigned og = xb_add(&bar[XB_TOP], 1u);
            const unsigned tg = og / nx;
            if (og + 1u == (tg + 1u) * nx) xb_add(&bar[XB_TOPGEN], 1u);
            else XB_SPIN(xb_ld(&bar[XB_TOPGEN]) == tg, bar);
            __builtin_amdgcn_fence(__ATOMIC_ACQUIRE, "agent");
            xb_add(&bar[XB_XGEN(b.x)], 1u);
            asm volatile("s_waitcnt vmcnt(0)" ::: "memory");
        } else {
            XB_SPIN(xb_ld(&bar[XB_XGEN(b.x)]) == gen, bar);
            __builtin_amdgcn_fence(__ATOMIC_ACQUIRE, "agent");
            asm volatile("s_waitcnt vmcnt(0)" ::: "memory");
        }
    }
    __syncthreads();
}

namespace att {
typedef short bf16x8 __attribute__((ext_vector_type(8)));
typedef short s16x4 __attribute__((ext_vector_type(4)));
typedef float f32x16 __attribute__((ext_vector_type(16)));
typedef unsigned u32x4 __attribute__((ext_vector_type(4)));
typedef unsigned short bf16_t;
typedef unsigned long long u64;
constexpr int L_K0 = 0, L_K1 = 8320, L_V0 = 16640, L_V1 = 24832, L_V2 = 33024, L_WSF = 41216, L_IMP = 43264, L_SEL = 59648, L_OST = 60160  , L_END = 125696;
__device__ __forceinline__ int crow(int r, int hi) { return (r & 3) + 8 * (r >> 2) + 4 * hi; }
__device__ __forceinline__ unsigned pk2(float lo, float hi) { typedef float f2 __attribute__((ext_vector_type(2))); typedef __bf16 b2 __attribute__((ext_vector_type(2)));
    f2 v = {lo, hi}; b2 b = __builtin_convertvector(v, b2); return __builtin_bit_cast(unsigned, b); }
__device__ __forceinline__ s16x4 vtr(LAS const char* p) { typedef short v4i16_t __attribute__((ext_vector_type(4))); return __builtin_bit_cast(s16x4, __builtin_amdgcn_ds_read_tr16_b64_v4i16((LAS v4i16_t*)p)); }

struct KVSrc { const bf16_t* k; const bf16_t* v; int pitch; int nrows; };

struct Lane { int tid, lane, r32, hi, wid; };

__device__ __forceinline__ void tile_gload(const KVSrc& S, int t, int tid, u32x4& kr, u32x4& vr) {
    const int row = 64 * t + (tid >> 3), ch = tid & 7;
    kr = *(const u32x4*)(S.k + (size_t)row * S.pitch + ch * 8); vr = *(const u32x4*)(S.v + (size_t)row * S.pitch + ch * 8);
}
__device__ __forceinline__ void tile_lstore(LAS char* kb, LAS char* vb, int tid, const u32x4& kr, const u32x4& vr) {
    const int key = tid >> 3, ch = tid & 7;
    *(LAS u32x4*)(kb + ch * 1040 + (key >> 5) * 512 + (key & 31) * 16) = kr;
    *(LAS u32x4*)(vb + (ch >> 2) * 4096 + (key >> 4) * 1024 + ((key >> 3) & 1) * 512 + (key & 7) * 64 + (ch & 3) * 16) = vr;
}
__device__ __forceinline__ void qk_tile(LAS const char* kbuf, const bf16x8 (&qr)[4], f32x16& p0, f32x16& p1, int r32, int hi) {
    LAS const char* kb = kbuf + hi * 1040 + r32 * 16;
#pragma unroll
    for (int d0 = 0; d0 < 4; ++d0) {
        const bf16x8 b0 = *(LAS const bf16x8*)(kb + d0 * 2080);
        const bf16x8 b1 = *(LAS const bf16x8*)(kb + d0 * 2080 + 512);
        p0 = __builtin_amdgcn_mfma_f32_32x32x16_bf16(b0, qr[d0], p0, 0, 0, 0);
        p1 = __builtin_amdgcn_mfma_f32_32x32x16_bf16(b1, qr[d0], p1, 0, 0, 0);
    }
}
__device__ __forceinline__ void qk_tile_c(LAS const char* kbuf, const bf16x8 (&qr)[4], const f32x16& negm, f32x16& p0, f32x16& p1, int r32, int hi) {
    LAS const char* kb = kbuf + hi * 1040 + r32 * 16;
#pragma unroll
    for (int d0 = 0; d0 < 4; ++d0) {
        const bf16x8 b0 = *(LAS const bf16x8*)(kb + d0 * 2080);
        const bf16x8 b1 = *(LAS const bf16x8*)(kb + d0 * 2080 + 512);
        if (d0 == 0) { p0 = __builtin_amdgcn_mfma_f32_32x32x16_bf16(b0, qr[0], negm, 0, 0, 0); p1 = __builtin_amdgcn_mfma_f32_32x32x16_bf16(b1, qr[0], negm, 0, 0, 0); }
        else { p0 = __builtin_amdgcn_mfma_f32_32x32x16_bf16(b0, qr[d0], p0, 0, 0, 0); p1 = __builtin_amdgcn_mfma_f32_32x32x16_bf16(b1, qr[d0], p1, 0, 0, 0); }
    }
}
__device__ __forceinline__ void pv_tile(LAS const char* vbuf, const u32x4 (&pw)[4], f32x16 (&o)[2], int lane, int hi) {
    LAS const char* vb = vbuf + ((lane >> 4) & 1) * 32 + (lane & 3) * 8 + (4 * hi + ((lane & 15) >> 2)) * 64;
#pragma unroll
    for (int d0 = 0; d0 < 2; ++d0)
#pragma unroll
        for (int ks = 0; ks < 4; ++ks) {
            const s16x4 lo = vtr(vb + d0 * 4096 + ks * 1024), h2 = vtr(vb + d0 * 4096 + ks * 1024 + 512);
            const bf16x8 vf = (bf16x8){lo[0], lo[1], lo[2], lo[3], h2[0], h2[1], h2[2], h2[3]};
            o[d0] = __builtin_amdgcn_mfma_f32_32x32x16_bf16(__builtin_bit_cast(bf16x8, pw[ks]), vf, o[d0], 0, 0, 0);
        }
}
__device__ __forceinline__ void mask_exp_pack(f32x16& p0, f32x16& p1, u64 mask, int hi, float& l, u32x4 (&pw)[4]) {
    float s = 0.f;
    {
        const int m0 = (int)(unsigned)(mask >> (4 * hi)), m1 = (int)(unsigned)(mask >> (32 + 4 * hi));
#pragma unroll
        for (int r = 0; r < 16; ++r) { const int bit = (r & 3) + 8 * (r >> 2);
            const unsigned e0 = __float_as_uint(__builtin_amdgcn_exp2f(p0[r])), e1 = __float_as_uint(__builtin_amdgcn_exp2f(p1[r]));
            p0[r] = __uint_as_float(e0 & (unsigned)__builtin_amdgcn_sbfe(m0, bit, 1)); p1[r] = __uint_as_float(e1 & (unsigned)__builtin_amdgcn_sbfe(m1, bit, 1)); s += p0[r] + p1[r]; }
    }
    l += s;
    pw[0] = (u32x4){pk2(p0[0], p0[1]), pk2(p0[2], p0[3]), pk2(p0[4], p0[5]), pk2(p0[6], p0[7])};
    pw[1] = (u32x4){pk2(p0[8], p0[9]), pk2(p0[10], p0[11]), pk2(p0[12], p0[13]), pk2(p0[14], p0[15])};
    pw[2] = (u32x4){pk2(p1[0], p1[1]), pk2(p1[2], p1[3]), pk2(p1[4], p1[5]), pk2(p1[6], p1[7])};
    pw[3] = (u32x4){pk2(p1[8], p1[9]), pk2(p1[10], p1[11]), pk2(p1[12], p1[13]), pk2(p1[14], p1[15])};
}
__device__ __forceinline__ u64 mask_le(int c) { return c >= 63 ? ~0ull : (c < 0 ? 0ull : ((2ull << c) - 1ull)); }
__device__ __forceinline__ u64 mask_ge(int a) { return a <= 0 ? ~0ull : (a > 63 ? 0ull : (~0ull << a)); }

__device__ __forceinline__ void k_gload(const KVSrc& S, int t, int tid, u32x4& kr) { const int row = 64 * t + (tid >> 3), ch = tid & 7; kr = (u32x4){0u, 0u, 0u, 0u}; if (row >= 0 && row < S.nrows) kr = *(const u32x4*)(S.k + (size_t)row * S.pitch + ch * 8); }
__device__ __forceinline__ void v_gload(const KVSrc& S, int t, int tid, u32x4& vr) { const int row = 64 * t + (tid >> 3), ch = tid & 7; vr = (u32x4){0u, 0u, 0u, 0u}; if (row >= 0 && row < S.nrows) vr = *(const u32x4*)(S.v + (size_t)row * S.pitch + ch * 8); }
__device__ __forceinline__ void k_lstore(LAS char* kb, int tid, const u32x4& kr) { const int key = tid >> 3, ch = tid & 7; *(LAS u32x4*)(kb + ch * 1040 + (key >> 5) * 512 + (key & 31) * 16) = kr; }
__device__ __forceinline__ void v_lstore(LAS char* vb, int tid, const u32x4& vr) { const int key = tid >> 3, ch = tid & 7; *(LAS u32x4*)(vb + (ch >> 2) * 4096 + (key >> 4) * 1024 + ((key >> 3) & 1) * 512 + (key & 7) * 64 + (ch & 3) * 16) = vr; }

template <class MF>
__device__ __forceinline__ void attend_range(LAS char* lds, const KVSrc& S, int t0, int t1, const MF& mf, const bf16x8 (&qr)[4], float negC, float& l, f32x16 (&o)[2], const Lane& L) {
    if (t0 >= t1) return;
    const bool late = L.wid >= 4;
    f32x16 negm;
#pragma unroll
    for (int r = 0; r < 16; ++r) negm[r] = negC;
    asm volatile("" : "+v"(negm));
    u32x4 kr, vr;
    tile_gload(S, t0, L.tid, kr, vr);
    tile_lstore(lds + L_K0, lds + L_V0, L.tid, kr, vr);
    __syncthreads();
    u32x4 pwp[4];
#pragma unroll
    for (int k = 0; k < 4; ++k) asm volatile("" : "=v"(pwp[k]));
    int vcur = 0, vprev = 0;
#pragma unroll 1
    for (int t = t0; t < t1; ++t) {
        const int kb = (t - t0) & 1; const bool more = t + 1 < t1;
        const int vnext = vcur == 2 ? 0 : vcur + 1;
        if (more) tile_gload(S, t + 1, L.tid, kr, vr);
        if (late && t > t0) pv_tile(lds + L_V0 + vprev * 8192, pwp, o, L.lane, L.hi);
        f32x16 p0, p1;
        qk_tile_c(lds + (kb ? L_K1 : L_K0), qr, negm, p0, p1, L.r32, L.hi);
        const u64 mk = mf(t);
        u32x4 pw[4];
        mask_exp_pack(p0, p1, mk, L.hi, l, pw);
        if (!late) pv_tile(lds + L_V0 + vcur * 8192, pw, o, L.lane, L.hi);
        else {
#pragma unroll
            for (int k = 0; k < 4; ++k) pwp[k] = pw[k]; }
        if (more) tile_lstore(lds + (kb ? L_K0 : L_K1), lds + L_V0 + vnext * 8192, L.tid, kr, vr);
        __syncthreads();
        vprev = vcur; vcur = vnext;
    }
    if (late) pv_tile(lds + L_V0 + vprev * 8192, pwp, o, L.lane, L.hi);
    __syncthreads();
}
__device__ __forceinline__ void rows_to_regs(LAS float* wsf, float v, int r32, int hi, float (&sc)[16]) {
    asm volatile("s_waitcnt lgkmcnt(0)" ::: "memory");
    if (hi == 0) wsf[r32] = v;
    asm volatile("s_waitcnt lgkmcnt(0)" ::: "memory");
#pragma unroll
    for (int r = 0; r < 16; ++r) sc[r] = wsf[crow(r, hi)];
}
__device__ __forceinline__ void load_q(const bf16_t* qrow, int hi, bf16x8 (&qr)[4]) {
#pragma unroll
    for (int d0 = 0; d0 < 4; ++d0) qr[d0] = *(const bf16x8*)(qrow + d0 * 16 + hi * 8);
}
template <class RowPtr>
__device__ __forceinline__ void store_o(LAS char* stage, const f32x16 (&acc)[2], const RowPtr& rowptr, int lane, int r32, int hi) {
    LAS bf16_t* stg = (LAS bf16_t*)stage;
#pragma unroll
    for (int r = 0; r < 16; ++r) { const int orow = crow(r, hi);
#pragma unroll
        for (int d0 = 0; d0 < 2; ++d0) stg[orow * 64 + d0 * 32 + r32] = (bf16_t)(pk2(acc[d0][r], 0.f) & 0xffffu); }
    asm volatile("s_waitcnt lgkmcnt(0)" ::: "memory");
#pragma unroll
    for (int i = 0; i < 4; ++i) { const int row = i * 8 + (lane >> 3), ch = lane & 7; const u32x4 v = *(LAS const u32x4*)(stg + row * 64 + ch * 8); *(u32x4*)(rowptr(row) + ch * 8) = v; }
    asm volatile("s_waitcnt lgkmcnt(0)" ::: "memory");
}
}

constexpr int NWAVES = 8;
constexpr int BATCH = 4, SEQ = 4096, DM = 1024, DFF = 4096, DEPTH = 2, D_IN = 6236;
constexpr int M = BATCH * SEQ;
constexpr size_t MiB = 1u << 20;
constexpr size_t WS_ZQ = 0;
constexpr size_t WS_ZKV = 48 * MiB;
constexpr size_t WS_YS = WS_ZKV;
constexpr size_t WS_MB = 104 * MiB;
constexpr size_t WS_KC2 = WS_MB, WS_VC2 = WS_MB + 4 * MiB;
constexpr size_t WS_XB = 136 * MiB;
constexpr size_t WS_W = 168 * MiB, W_LAYER = 36 * MiB;
constexpr size_t W_IN = 0, W_G = 7 * MiB, W_BR = 13 * MiB, W_OUT = 16 * MiB, W_UP = 18 * MiB, W_DN = 26 * MiB, W_CK1 = 34 * MiB, W_CV1 = 35 * MiB;
constexpr size_t WS_BM = 240 * MiB;
constexpr size_t WS_MISC = 248 * MiB;
constexpr size_t WS_CTL = WS_MISC, CTL_BYTES = 1 * MiB;
constexpr size_t WS_COS = WS_MISC + 1 * MiB, WS_SIN = WS_MISC + 1 * MiB + 512 * 1024;
constexpr size_t WS_KCMP = WS_MISC + 2 * MiB;
constexpr size_t WS_SSQ = WS_MISC + 2 * MiB + 512 * 1024;
constexpr size_t WS_B1P = WS_MISC + 3 * MiB + 512 * 1024;
constexpr size_t WS_W2 = WS_B1P + 64 * 1024;
constexpr size_t WS_HMID = 0;
constexpr size_t WS_END = 256 * MiB;
constexpr int CW_BAR = 4096, CW_Q = 8192, CW_KMAX = 12288;
constexpr int LDS_BYTES = 147456, LDS_UNIT = 147392;
constexpr float C2 = 0.125f * 1.4426950408889634f, LOG2E = 1.4426950408889634f;


struct Args { const float* in[17]; float* out; unsigned char* ws; };
struct Frame {
    LAS unsigned char* lds;
    gu32* ctl;
    int tid, lane, wave, G, gw, NGW;
    unsigned char* ws;
    const struct Args* a;
};
__device__ __forceinline__ float wave_sum(float v) {
#pragma unroll
    for (int o = 1; o < 64; o <<= 1) v += __shfl_xor(v, o);
    return v;
}
__device__ __forceinline__ float wave_max(float v) {
#pragma unroll
    for (int o = 1; o < 64; o <<= 1) v = fmaxf(v, __shfl_xor(v, o));
    return v;
}
__device__ __forceinline__ float bf2f(bf16 h) { return __uint_as_float((unsigned)h << 16); }
__device__ __constant__ float c_inv_freq[32] = {
    1.0f, 0.7498942093324559f, 0.5623413251903491f, 0.4216965034285822f, 0.31622776601683794f, 0.23713737056616552f, 0.1778279410038923f, 0.1333521432163324f,
    0.1f, 0.07498942093324558f, 0.05623413251903491f, 0.042169650342858224f, 0.03162277660168379f, 0.023713737056616554f, 0.01778279410038923f, 0.01333521432163324f,
    0.01f, 0.007498942093324558f, 0.005623413251903491f, 0.004216965034285823f, 0.0031622776601683794f, 0.0023713737056616554f, 0.0017782794100389228f, 0.001333521432163324f,
    0.001f, 0.0007498942093324559f, 0.0005623413251903491f, 0.00042169650342858224f, 0.00031622776601683794f, 0.00023713737056616554f, 0.00017782794100389227f, 0.0001333521432163324f};

__device__ __forceinline__ int mix_src_col(int j) {
    if (j < 512) return j;
    if (j < 1024) return 1092 + (j - 512);
    if (j < 1536) return 1860 + (j - 1024);
    if (j < 1792) return 512 + (j - 1536);
    if (j < 2048) return 1604 + (j - 1792);
    if (j < 2304) return 2372 + (j - 2048);
    if (j < 2560) return 2628 + (j - 2304);
    if (j < 2816) return 2884 + (j - 2560);
    if (j < 3072) return 768 + (j - 2816);
    const int r = j - 3072;
    if (r < 64) return 1024 + r;
    if (r < 68) return 1088 + (r - 64);
    if (r < 92) return 3140 + (r - 68);
    return -1;
}
template <int MODE>
__device__ __forceinline__ void p0_item(const float* W, int ldw, int K, bf16* WT, int nblk, int item, const float* gain, int coff, LAS float* scr, int lane) {
    const int kb = item / nblk, nb = item % nblk, k0 = 64 * kb, n0 = 32 * nb;
    const int sc = MODE == 0 ? (n0 + (lane & 31) + coff) : mix_src_col(n0 + (lane & 31));
#pragma unroll 8
    for (int i = 0; i < 32; ++i) { const int kk = 2 * i + (lane >> 5); float v = 0.f;
        if (sc >= 0) v = W[(size_t)(k0 + kk) * ldw + sc];
        if (gain) v *= gain[k0 + kk];
        scr[kk * 33 + (lane & 31)] = v; }
    LDS_WAIT(); asm volatile("" ::: "memory");
    const int c = lane & 7;
#pragma unroll
    for (int j = 0; j < 4; ++j) { const int n = (lane >> 3) + 8 * j; const LAS float* s = scr + (8 * c) * 33 + n;
        v4u o; o.x = pk2(s[0 * 33], s[1 * 33]); o.y = pk2(s[2 * 33], s[3 * 33]); o.z = pk2(s[4 * 33], s[5 * 33]); o.w = pk2(s[6 * 33], s[7 * 33]);
        *(GAS v4u*)(WT + (size_t)(n0 + n) * K + k0 + 8 * c) = o; }
    LDS_WAIT(); asm volatile("" ::: "memory");
}
__device__ __forceinline__ void p0_prologue(Frame& F) {
    LAS float* scr = (LAS float*)(F.lds + F.wave * 16384);
    constexpr int I_IN = 16 * 104, I_G = 16 * 96, I_BR = 8 * 32, I_OUT = 16 * 32, I_UP = 16 * 128, I_DN = 64 * 32, I_C1 = 32 * 8, I_C2 = 4 * 2;
    constexpr int PER_LAYER = I_IN + I_G + 3 * I_BR + I_OUT + I_UP + I_DN + 2 * I_C1 + 2 * I_C2;
    for (int it = F.gw; it < 2 * PER_LAYER; it += F.NGW) {
        const int l = it / PER_LAYER; int r = it % PER_LAYER;
        unsigned char* wl = F.ws + WS_W + (size_t)l * W_LAYER;
        const float* w_in = F.a->in[2] + (size_t)l * DM * D_IN;
        if (r < I_IN) { p0_item<1>(w_in, D_IN, DM, (bf16*)(wl + W_IN), 104, r, F.a->in[1] + l * DM, 0, scr, F.lane); continue; } r -= I_IN;
        if (r < I_G) { p0_item<0>(w_in, D_IN, DM, (bf16*)(wl + W_G), 96, r, F.a->in[1] + l * DM, 3164, scr, F.lane); continue; } r -= I_G;
        if (r < 3 * I_BR) { const int n = r / I_BR; p0_item<0>(F.a->in[12] + ((size_t)l * 3 + n) * 512 * DM, DM, 512, (bf16*)(wl + W_BR) + (size_t)n * DM * 512, 32, r % I_BR, nullptr, 0, scr, F.lane); continue; } r -= 3 * I_BR;
        if (r < I_OUT) { p0_item<0>(F.a->in[13] + (size_t)l * DM * DM, DM, DM, (bf16*)(wl + W_OUT), 32, r, nullptr, 0, scr, F.lane); continue; } r -= I_OUT;
        if (r < I_UP) { p0_item<0>(F.a->in[15] + (size_t)l * DM * DFF, DFF, DM, (bf16*)(wl + W_UP), 128, r, F.a->in[14] + l * DM, 0, scr, F.lane); continue; } r -= I_UP;
        if (r < I_DN) { p0_item<0>(F.a->in[16] + (size_t)l * DFF * DM, DM, DFF, (bf16*)(wl + W_DN), 32, r, nullptr, 0, scr, F.lane); continue; } r -= I_DN;
        if (r < I_C1) { p0_item<0>(F.a->in[8] + (size_t)l * 2048 * 256, 256, 2048, (bf16*)(wl + W_CK1), 8, r, nullptr, 0, scr, F.lane); continue; } r -= I_C1;
        if (r < I_C1) { p0_item<0>(F.a->in[10] + (size_t)l * 2048 * 256, 256, 2048, (bf16*)(wl + W_CV1), 8, r, nullptr, 0, scr, F.lane); continue; } r -= I_C1;
        if (r < I_C2) { p0_item<0>(F.a->in[9] + (size_t)l * 256 * 64, 64, 256, (bf16*)(F.ws + WS_W2) + (size_t)(l * 2 + 0) * 64 * 256, 2, r, nullptr, 0, scr, F.lane); continue; } r -= I_C2;
        p0_item<0>(F.a->in[11] + (size_t)l * 256 * 64, 64, 256, (bf16*)(F.ws + WS_W2) + (size_t)(l * 2 + 1) * 64 * 256, 2, r, nullptr, 0, scr, F.lane);
    }
    for (int it = F.gw; it < 128; it += F.NGW) {
        const int kp = it & 7, jb = (it >> 3) & 3, which = (it >> 5) & 1, l = it >> 6; const int j = jb * 64 + F.lane;
        const float* pe = (which ? F.a->in[7] : F.a->in[6]) + l * 2048; const float* w1 = (which ? F.a->in[10] : F.a->in[8]) + (size_t)l * 2048 * 256;
        float a = 0.f;
        for (int k = kp * 256; k < kp * 256 + 256; ++k) a = fmaf(pe[k], w1[(size_t)k * 256 + j], a);
        ((float*)(F.ws + WS_B1P))[((l * 2 + which) * 8 + kp) * 256 + j] = a;
    }
    for (int m = F.gw; m < M; m += F.NGW) {
        const GAS f32x4* xr = (const GAS f32x4*)(F.a->in[0] + (size_t)m * DM) + F.lane;
        GAS unsigned long long* o8 = (GAS unsigned long long*)((bf16*)(F.ws + WS_XB) + (size_t)m * DM) + F.lane;
        float s = 0.f;
#pragma unroll
        for (int j = 0; j < 4; ++j) { const f32x4 v = xr[64 * j]; s += (v.x * v.x + v.y * v.y) + (v.z * v.z + v.w * v.w);
            o8[64 * j] = (unsigned long long)pk2(v.x, v.y) | ((unsigned long long)pk2(v.z, v.w) << 32); }
        s = wave_sum(s);
        if (F.lane < 16) ((float*)(F.ws + WS_SSQ))[(size_t)m * 16 + F.lane] = F.lane == 0 ? s : 0.f;
    }
    for (int i = F.gw * 64 + F.lane; i < SEQ * 32; i += F.NGW * 64) {
        const float ang = (float)(i >> 5) * c_inv_freq[i & 31];
        ((float*)(F.ws + WS_COS))[i] = (float)cos((double)ang); ((float*)(F.ws + WS_SIN))[i] = (float)sin((double)ang);
    }
}
typedef unsigned u32x4_t __attribute__((ext_vector_type(4)));
__device__ __forceinline__ void post_group(u32x4_t raw, bool act, bool norm, bool rope, const float (&gain)[8], float scale, const float (&cs)[8], const float (&sn)[8], int lane, bf16* dst) {
    float v[8];
    v[0] = __uint_as_float(raw.x << 16); v[1] = __uint_as_float(raw.x & 0xffff0000u); v[2] = __uint_as_float(raw.y << 16); v[3] = __uint_as_float(raw.y & 0xffff0000u);
    v[4] = __uint_as_float(raw.z << 16); v[5] = __uint_as_float(raw.z & 0xffff0000u); v[6] = __uint_as_float(raw.w << 16); v[7] = __uint_as_float(raw.w & 0xffff0000u);
    float ss = ((v[0] * v[0] + v[1] * v[1]) + (v[2] * v[2] + v[3] * v[3])) + ((v[4] * v[4] + v[5] * v[5]) + (v[6] * v[6] + v[7] * v[7]));
    ss += __shfl_xor(ss, 1); ss += __shfl_xor(ss, 2); ss += __shfl_xor(ss, 4);
    const float rs = norm ? rsqrtf(ss * (1.0f / 64.0f) + 1e-6f) : 1.0f;
    const bool lo = (lane & 4) == 0;
    float r[8];
#pragma unroll
    for (int j = 0; j < 8; ++j) { const float x = norm ? v[j] * rs * gain[j] : v[j]; const float o = __shfl_xor(x, 4);
        r[j] = rope ? (lo ? (x * cs[j] - o * sn[j]) : (x * cs[j] + o * sn[j])) : x; r[j] *= scale; }
    if (act) { u32x4_t w; w.x = pk2(r[0], r[1]); w.y = pk2(r[2], r[3]); w.z = pk2(r[4], r[5]); w.w = pk2(r[6], r[7]); *(u32x4_t*)dst = w; }
}
__device__ __forceinline__ void post_phase(Frame& F, int l, bool dry = false) {
    const float* qn = F.a->in[3] + l * 192; const float* kn = F.a->in[4] + l * 192;
    const int lane = F.lane, g = lane >> 3, c = lane & 7;
    float gq0[8], gq1[8], gq2[8], gk3[8], gk2[8];
#pragma unroll
    for (int j = 0; j < 8; ++j) { gq0[j] = qn[8 * c + j]; gq1[j] = qn[64 + 8 * c + j]; gq2[j] = qn[128 + 8 * c + j]; gk2[j] = kn[128 + 8 * c + j];
        gk3[j] = (g >> 1) == 0 ? kn[8 * c + j] : ((g >> 1) == 1 ? kn[64 + 8 * c + j] : kn[128 + 8 * c + j]); }
    bf16* zq = (bf16*)(F.ws + WS_ZQ); bf16* zkv = (bf16*)(F.ws + WS_ZKV);
    const float* cst = (const float*)(F.ws + WS_COS); const float* snt = (const float*)(F.ws + WS_SIN);
#pragma unroll 1
    for (int m = F.gw; m < M; m += F.NGW) {
        const int t = m & (SEQ - 1), b = m >> 12;
        float cs[8], sn[8];
        { const f32x4* cp = (const f32x4*)(cst + t * 32 + 8 * (c & 3)); const f32x4* sp = (const f32x4*)(snt + t * 32 + 8 * (c & 3));
          const f32x4 c0 = cp[0], c1 = cp[1], s0 = sp[0], s1 = sp[1];
          cs[0] = c0[0]; cs[1] = c0[1]; cs[2] = c0[2]; cs[3] = c0[3]; cs[4] = c1[0]; cs[5] = c1[1]; cs[6] = c1[2]; cs[7] = c1[3];
          sn[0] = s0[0]; sn[1] = s0[1]; sn[2] = s0[2]; sn[3] = s0[3]; sn[4] = s1[0]; sn[5] = s1[1]; sn[6] = s1[2]; sn[7] = s1[3]; }
        bf16* pqa = zq + (size_t)m * 512 + lane * 8; bf16* pqb = pqa + (size_t)M * 512; bf16* pqc = pqa + (size_t)2 * M * 512;
        const int t3 = (g >> 1) < 2 ? (g >> 1) : (g >> 1) + 1;
        bf16* p3 = zkv + (size_t)t3 * M * 256 + (size_t)m * 256 + (g & 1) * 64 + c * 8;
        const bf16* s4 = g < 4 ? zkv + (size_t)2 * M * 256 + (size_t)m * 256 + g * 64 + c * 8 : zkv + (size_t)5 * M * 256 + (size_t)m * 256 + (g - 4) * 64 + c * 8;
        bf16* d4 = g < 2 ? (bf16*)(F.ws + WS_KC2) + ((size_t)(b * 2 + g) * SEQ + t) * 64 + c * 8
                 : (g < 4 ? (bf16*)(F.ws + WS_VC2) + ((size_t)(b * 2 + (g - 2)) * SEQ + t) * 64 + c * 8 : (bf16*)s4);
        bf16* p5 = zkv + (size_t)6 * M * 256 + (size_t)m * 256 + c * 8;
        const u32x4_t r0 = *(const u32x4_t*)pqa, r1 = *(const u32x4_t*)pqb, r2 = *(const u32x4_t*)pqc, r3 = *(const u32x4_t*)p3, r4 = *(const u32x4_t*)s4;
        u32x4_t r5 = {0u, 0u, 0u, 0u}; if (g == 0) r5 = *(const u32x4_t*)p5;
        post_group(r0, !dry, true, true, gq0, C2, cs, sn, lane, pqa);
        post_group(r1, !dry, true, true, gq1, C2, cs, sn, lane, pqb);
        post_group(r2, !dry, true, true, gq2, C2, cs, sn, lane, pqc);
        post_group(r3, !dry, true, true, gk3, 1.f, cs, sn, lane, p3);
        post_group(r4, !dry, g < 2, g < 2 || g >= 4, gk2, 1.f, cs, sn, lane, d4);
        post_group(r5, g == 0 && !dry, false, true, gk2, 1.f, cs, sn, lane, p5);
    }
}

#define WAVE_LDS_FENCE() asm volatile("s_waitcnt lgkmcnt(0)" ::: "memory")
__device__ __forceinline__ int next_unit(Frame& F, gu32* counter) {
    LAS int* slot = (LAS int*)(F.lds + LDS_UNIT);
    __syncthreads();
    if (F.tid == 0) *slot = (int)__hip_atomic_fetch_add(counter, 1u, RLX_AGENT);
    __syncthreads();
    return *slot;
}
__device__ __forceinline__ unsigned f2key(float f) { const unsigned u = __float_as_uint(f); return (u & 0x80000000u) ? ~u : (u | 0x80000000u); }
__device__ __forceinline__ float dpp_quad_sum(float v) {
    v += __int_as_float(__builtin_amdgcn_update_dpp(0, __float_as_int(v), 0xB1, 0xF, 0xF, true));
    v += __int_as_float(__builtin_amdgcn_update_dpp(0, __float_as_int(v), 0x4E, 0xF, 0xF, true));
    return v;
}
__device__ __forceinline__ void select_unit(Frame& F, int b, int qblk) {
    using namespace att;
    const int lane = F.lane, r32 = lane & 31, hi = lane >> 5, w = F.wave;
    LAS unsigned* sc = (LAS unsigned*)F.lds;
    LAS unsigned* hist = (LAS unsigned*)(F.lds + 131072) + w * 256;
    const int t0 = qblk * 8; const size_t m0 = (size_t)b * SEQ + t0;
    const bf16* IQ = (const bf16*)(F.ws + WS_ZKV) + (size_t)5 * M * 256; const bf16* MISC = (const bf16*)(F.ws + WS_ZKV) + (size_t)6 * M * 256;
    u64* BM = (u64*)(F.ws + WS_BM);
    const int nkeys = t0 + 8;
    if (nkeys > 256) {
        bf16x8 iqf[4];
        { const bf16* qrow = IQ + (m0 + (r32 >> 2)) * 256 + (r32 & 3) * 64;
#pragma unroll
          for (int d0 = 0; d0 < 4; ++d0) iqf[d0] = *(const bf16x8*)(qrow + d0 * 16 + hi * 8); }
        const float wl = bf2f(MISC[(m0 + (r32 >> 2)) * 256 + 64 + (r32 & 3)]);
        const int ntile = (nkeys + 31) >> 5; const int g = r32 & 3;
        bf16x8 kf[4], kn[4];
        { const bf16* krow = MISC + ((size_t)b * SEQ + w * 32 + r32) * 256;
#pragma unroll
          for (int d0 = 0; d0 < 4; ++d0) kf[d0] = (w < ntile) ? *(const bf16x8*)(krow + d0 * 16 + hi * 8) : (bf16x8){0, 0, 0, 0, 0, 0, 0, 0}; }
#pragma unroll 1
        for (int tile = w; tile < ntile; tile += 8) {
            const int s0 = tile * 32;
            { const bool more = tile + 8 < ntile; const bf16* krow = MISC + ((size_t)b * SEQ + s0 + 256 + r32) * 256;
#pragma unroll
              for (int d0 = 0; d0 < 4; ++d0) kn[d0] = more ? *(const bf16x8*)(krow + d0 * 16 + hi * 8) : (bf16x8){0, 0, 0, 0, 0, 0, 0, 0}; }
            f32x16 acc;
#pragma unroll
            for (int r = 0; r < 16; ++r) acc[r] = 0.f;
#pragma unroll
            for (int d0 = 0; d0 < 4; ++d0) acc = __builtin_amdgcn_mfma_f32_32x32x16_bf16(kf[d0], iqf[d0], acc, 0, 0, 0);
            float v[16];
#pragma unroll
            for (int r = 0; r < 16; ++r) v[r] = dpp_quad_sum(fmaxf(acc[r], 0.f) * wl);
            u32x4 o;
#pragma unroll
            for (int j = 0; j < 4; ++j) o[j] = f2key(g == 0 ? v[j] : (g == 1 ? v[4 + j] : (g == 2 ? v[8 + j] : v[12 + j])));
            *(LAS u32x4*)(sc + (r32 >> 2) * 4096 + s0 + 8 * g + 4 * hi) = o;
#pragma unroll
            for (int d0 = 0; d0 < 4; ++d0) kf[d0] = kn[d0];
        }
    }
    __syncthreads();
    {
        const int t = t0 + w, n = t + 1; LAS unsigned* row = sc + w * 4096;
        u64 myword = 0ull;
        if (n <= 256) {
            const int c0 = 64 * lane;
            myword = (c0 + 63 < n) ? ~0ull : (c0 >= n ? 0ull : ((1ull << (n - c0)) - 1ull));
        } else {
            const int nblk = (n + 255) >> 8;
            { const int s = (n & ~3) + lane * 4;
              if (s < nblk * 256) { u32x4 v = *(LAS u32x4*)(row + s);
#pragma unroll
                  for (int c = 0; c < 4; ++c) if (s + c >= n) v[c] = 0u;
                  *(LAS u32x4*)(row + s) = v; } }
            WAVE_LDS_FENCE();
            unsigned prefix = 0u; int kk = 256;
#pragma unroll 1
            for (int pass = 0; pass < 4; ++pass) {
                const int shift = 24 - 8 * pass;
#pragma unroll
                for (int i = 0; i < 4; ++i) hist[lane * 4 + i] = 0u;
                WAVE_LDS_FENCE();
#pragma unroll 2
                for (int jb = 0; jb < nblk; ++jb) { const u32x4 v = *(LAS const u32x4*)(row + jb * 256 + lane * 4);
#pragma unroll
                    for (int c = 0; c < 4; ++c) { const unsigned key = v[c];
                        if (pass == 0 || (key >> (shift + 8)) == prefix) __hip_atomic_fetch_add(&hist[(key >> shift) & 255u], 1u, __ATOMIC_RELAXED, __HIP_MEMORY_SCOPE_WORKGROUP); } }
                WAVE_LDS_FENCE();
                const unsigned h0 = hist[lane * 4], h1 = hist[lane * 4 + 1], h2 = hist[lane * 4 + 2], h3 = hist[lane * 4 + 3];
                int suf = (int)(h0 + h1 + h2 + h3);
#pragma unroll
                for (int o = 1; o < 64; o <<= 1) { const int tt = __shfl_down(suf, o); if (lane + o < 64) suf += tt; }
                const int above = suf - (int)(h0 + h1 + h2 + h3);
                const int a3 = above, a2 = a3 + (int)h3, a1 = a2 + (int)h2, a0 = a1 + (int)h1;
                int dsel = -1, nk = 0;
                if (a3 < kk && kk <= a3 + (int)h3) { dsel = lane * 4 + 3; nk = kk - a3; }
                else if (a2 < kk && kk <= a2 + (int)h2) { dsel = lane * 4 + 2; nk = kk - a2; }
                else if (a1 < kk && kk <= a1 + (int)h1) { dsel = lane * 4 + 1; nk = kk - a1; }
                else if (a0 < kk && kk <= a0 + (int)h0) { dsel = lane * 4 + 0; nk = kk - a0; }
                const u64 bal = __ballot(dsel >= 0);
                const int src = (int)__builtin_ctzll(bal);
                dsel = __shfl(dsel, src); nk = __shfl(nk, src);
                WAVE_LDS_FENCE();
                prefix = (prefix << 8) | (unsigned)dsel; kk = nk;
            }
            const unsigned T = prefix; const int need = kk; int base = 0;
            const int nch = (n + 63) >> 6;
#pragma unroll 1
            for (int c = 0; c < nch; c += 4) {
                unsigned vv[4];
#pragma unroll
                for (int u2 = 0; u2 < 4; ++u2) vv[u2] = row[64 * (c + u2) + lane];
#pragma unroll
                for (int u2 = 0; u2 < 4; ++u2) {
                    const int s = 64 * (c + u2) + lane; const bool valid = s < n; const unsigned key = valid ? vv[u2] : 0u;
                    const bool gt = valid && key > T, eq = valid && key == T;
                    const u64 beq = __ballot(eq);
                    const int rank = base + __builtin_popcountll(beq & ((1ull << lane) - 1ull));
                    const u64 word = __ballot(gt || (eq && rank < need));
                    if (lane == c + u2) myword = word;
                    base += __builtin_popcountll(beq);
                }
            }
        }
        BM[((size_t)b * SEQ + t) * 64 + lane] = myword;
    }
    __syncthreads();
}
__device__ __forceinline__ void compress_unit(Frame& F, int l, int u) {
    using namespace att;
    const int lane = F.lane, r32 = lane & 31, hi = lane >> 5, w = F.wave;
    const int which = u & 1, h = (u >> 1) & 1, b = (u >> 2) & 3, cb = u >> 4;
    const bf16* src = (const bf16*)(F.ws + (which ? WS_VC2 : WS_KC2)) + (size_t)(b * 2 + h) * SEQ * 64;
    const bf16* W1t = (const bf16*)(F.ws + WS_W + (size_t)l * W_LAYER + (which ? W_CV1 : W_CK1));
    const bf16* W2t = (const bf16*)(F.ws + WS_W2) + (size_t)(l * 2 + which) * 64 * 256;
    const float* b1p = (const float*)(F.ws + WS_B1P) + (size_t)(l * 2 + which) * 8 * 256;
    LAS bf16* hid = (LAS bf16*)F.lds;
    int cc = 32 * cb + r32; if (cc > 254) cc = 254;
    const bf16* arow = src + (size_t)(16 * cc) * 64 + hi * 8;
    const bf16* brow = W1t + (size_t)(32 * w + r32) * 2048 + hi * 8;
    f32x16 acc;
#pragma unroll
    for (int r = 0; r < 16; ++r) acc[r] = 0.f;
#pragma unroll 4
    for (int ks = 0; ks < 128; ++ks) { const bf16x8 a = *(const bf16x8*)(arow + ks * 16), bb = *(const bf16x8*)(brow + ks * 16); acc = __builtin_amdgcn_mfma_f32_32x32x16_bf16(a, bb, acc, 0, 0, 0); }
    float b1 = 0.f;
#pragma unroll
    for (int kp = 0; kp < 8; ++kp) b1 += b1p[kp * 256 + 32 * w + r32];
#pragma unroll
    for (int r = 0; r < 16; ++r) hid[crow(r, hi) * 264 + 32 * w + r32] = (bf16)f2bf(fmaxf(acc[r] + b1, 0.f));
    __syncthreads();
    if (w < 2) {
        f32x16 o;
#pragma unroll
        for (int r = 0; r < 16; ++r) o[r] = 0.f;
        const bf16* w2row = W2t + (size_t)(32 * w + r32) * 256 + hi * 8;
#pragma unroll
        for (int ks = 0; ks < 16; ++ks) { const bf16x8 a = *(LAS const bf16x8*)(hid + r32 * 264 + ks * 16 + hi * 8), bb = *(const bf16x8*)(w2row + ks * 16); o = __builtin_amdgcn_mfma_f32_32x32x16_bf16(a, bb, o, 0, 0, 0); }
        bf16* dst = (bf16*)(F.ws + WS_KCMP) + ((size_t)((which * 4 + b) * 2 + h) * 256) * 64;
        float mx = 0.f;
#pragma unroll
        for (int r = 0; r < 16; ++r) { const int c = 32 * cb + crow(r, hi); const float v = c < 255 ? o[r] : 0.f; mx = fmaxf(mx, fabsf(v)); dst[(size_t)c * 64 + 32 * w + r32] = (bf16)f2bf(v); }
        if (which == 0) { mx = wave_max(mx); if (lane == 0) __hip_atomic_fetch_max(F.ctl + CW_KMAX + 64 * (l * 8 + b * 2 + h), __float_as_uint(mx), RLX_AGENT); }
    }
    __syncthreads();
}
struct UnitGeom { int b, kvh, i; att::Lane L; int q; int head; size_t mrow; };
__device__ __forceinline__ UnitGeom unit_geom(Frame& F, int b, int kvh, int i) {
    int tid = F.tid; asm volatile("" : "+v"(tid));
    UnitGeom U; U.b = b; U.kvh = kvh; U.i = i; U.L.tid = tid; U.L.lane = tid & 63; U.L.r32 = tid & 31; U.L.hi = (tid >> 5) & 1; U.L.wid = F.wave;
    U.q = 64 * i + 8 * F.wave + (U.L.r32 >> 2); U.head = 4 * kvh + (U.L.r32 & 3); U.mrow = (size_t)b * SEQ + U.q; return U;
}
__device__ __forceinline__ void branch_finish(LAS float* wsf, float l, float extra, float rowscale, const att::f32x16 (&o)[2], att::f32x16 (&acc)[2], const att::Lane& L, bool first) {
    float lf = l + __shfl_xor(l, 32) + extra;
    const float sc1 = lf > 0.f ? rowscale * __builtin_amdgcn_rcpf(lf) : 0.f;
    float sc[16]; att::rows_to_regs(wsf, sc1, L.r32, L.hi, sc);
#pragma unroll
    for (int d0 = 0; d0 < 2; ++d0)
#pragma unroll
        for (int r = 0; r < 16; ++r) acc[d0][r] = first ? o[d0][r] * sc[r] : acc[d0][r] + o[d0][r] * sc[r];
}
__device__ __forceinline__ void branch_finish_lds(LAS float* wsf, LAS float* accw, float l, float rowscale, const att::f32x16 (&o)[2], const att::Lane& L, bool first) {
    const float lf = l + __shfl_xor(l, 32);
    const float sc1 = lf > 0.f ? rowscale * __builtin_amdgcn_rcpf(lf) : 0.f;
    float sc[16]; att::rows_to_regs(wsf, sc1, L.r32, L.hi, sc);
#pragma unroll
    for (int d0 = 0; d0 < 2; ++d0)
#pragma unroll
        for (int r = 0; r < 16; ++r) { float v = o[d0][r] * sc[r]; if (!first) v += accw[(d0 * 16 + r) * 64 + L.lane]; accw[(d0 * 16 + r) * 64 + L.lane] = v; }
}
__device__ __forceinline__ float gain_bound(const float* g, int lane) { return wave_max(fabsf(g[lane])); }

template <int KIND  >
__device__ __forceinline__ void simple_unit(Frame& F, int l, int b, int kvh, int i, bf16* odst = nullptr) {
    using namespace att;
    const UnitGeom U = unit_geom(F, b, kvh, i); const Lane& L = U.L;
    constexpr int QT = KIND == 0 ? 1 : 0, KT = KIND == 0 ? 1 : 0, NM = KIND == 0 ? 1 : 0;
    bf16* Q = (bf16*)(F.ws + WS_ZQ) + (size_t)QT * M * 512; const bf16* KV = (const bf16*)(F.ws + WS_ZKV) + (size_t)KT * M * 256;
    bf16x8 qr[4]; load_q(Q + U.mrow * 512 + U.head * 64, L.hi, qr);
    const float C = 8.f * gain_bound(F.a->in[3] + l * 192 + NM * 64, L.lane) * gain_bound(F.a->in[4] + l * 192 + NM * 64, L.lane) * LOG2E;
    KVSrc S{KV + (size_t)b * SEQ * 256 + kvh * 64, KV + (size_t)b * SEQ * 256 + 128 + kvh * 64, 256, SEQ};
    float lsum = 0.f; f32x16 o[2];
#pragma unroll
    for (int r = 0; r < 16; ++r) { o[0][r] = 0.f; o[1][r] = 0.f; }
    const int q = U.q;
    float extra = 0.f;
    if (KIND == 0) {
        auto mf = [q](int t) -> u64 { return mask_le(q - 64 * t) & mask_ge(q - 127 - 64 * t); };
        attend_range((LAS char*)F.lds, S, i - 2 < 0 ? 0 : i - 2, i + 1, mf, qr, -C, lsum, o, L);
        extra = __builtin_amdgcn_exp2f(F.a->in[5][l * 8 + U.head] * LOG2E - C);
    } else {
        const u64* bm = (const u64*)(F.ws + WS_BM) + U.mrow * 64;
        auto mf = [bm](int t) -> u64 { return bm[t]; };
        attend_range((LAS char*)F.lds, S, 0, i + 1, mf, qr, -C, lsum, o, L);
    }
    f32x16 acc[2];
    branch_finish((LAS float*)((LAS char*)F.lds + L_WSF) + L.wid * 64, lsum, extra, 1.f, o, acc, L, true);
    const size_t tok0 = (size_t)b * SEQ + 64 * i + 8 * L.wid; const int kvh4 = 4 * kvh;
    bf16* Od = odst ? odst : Q;
    auto rowptr = [Od, tok0, kvh4](int row) -> bf16* { return Od + (tok0 + (row >> 2)) * 512 + (kvh4 + (row & 3)) * 64; };
    store_o((LAS char*)F.lds + L_OST + L.wid * 8192, acc, rowptr, L.lane, L.r32, L.hi);
}
__device__ __forceinline__ void nsa_unit(Frame& F, int l, int b, int kvh, int i, bf16* odst = nullptr) {
    using namespace att;
    const UnitGeom U = unit_geom(F, b, kvh, i); const Lane& L = U.L;
    bf16* Q = (bf16*)(F.ws + WS_ZQ) + (size_t)2 * M * 512; const bf16* KVbase = (const bf16*)(F.ws + WS_ZKV);
    const bf16* MISC = KVbase + (size_t)6 * M * 256;
    bf16x8 qr[4]; load_q(Q + U.mrow * 512 + U.head * 64, L.hi, qr);
    const float gqm = gain_bound(F.a->in[3] + l * 192 + 128, L.lane), gkm = gain_bound(F.a->in[4] + l * 192 + 128, L.lane);
    const float Ck = 8.f * gqm * gkm * LOG2E;
    const float kmax = __uint_as_float(__hip_atomic_load(F.ctl + CW_KMAX + 64 * (l * 8 + b * 2 + kvh), RLX_AGENT));
    const float Cc = 8.f * gqm * kmax * LOG2E;
    float gs[3];
#pragma unroll
    for (int br = 0; br < 3; ++br) gs[br] = pg8::sigmoidf_(bf2f(MISC[U.mrow * 256 + 68 + U.head * 3 + br]));
    LAS float* wsf = (LAS float*)((LAS char*)F.lds + L_WSF) + L.wid * 64;
    const int q = U.q;
    f32x16 o[2];
    LAS float* accw = (LAS float*)((LAS char*)F.lds + L_OST + L.wid * 8192);
    const int nval = q >= 31 ? (((q - 31) >> 4) + 1 < 255 ? ((q - 31) >> 4) + 1 : 255) : 0;
    const int qmax = 64 * i + 63; const int nvmax = qmax >= 31 ? (((qmax - 31) >> 4) + 1 < 255 ? ((qmax - 31) >> 4) + 1 : 255) : 0;
    const int tc = (nvmax + 63) >> 6;
    const bf16* kcmp = (const bf16*)(F.ws + WS_KCMP) + (size_t)((0 * 4 + b) * 2 + kvh) * 256 * 64; const bf16* vcmp = (const bf16*)(F.ws + WS_KCMP) + (size_t)((1 * 4 + b) * 2 + kvh) * 256 * 64;
    KVSrc Sc{kcmp, vcmp, 64, 256};
    auto mfc = [nval](int t) -> u64 { return mask_le(nval - 1 - 64 * t); };
    float lsum = 0.f;
#pragma unroll
    for (int r = 0; r < 16; ++r) { o[0][r] = 0.f; o[1][r] = 0.f; }
    attend_range((LAS char*)F.lds, Sc, 0, tc, mfc, qr, -Cc, lsum, o, L);
    const float lc = lsum + __shfl_xor(lsum, 32); const float rlc = lc > 0.f ? __builtin_amdgcn_rcpf(lc) : 0.f;
    branch_finish_lds(wsf, accw, lsum, gs[0], o, L, true);
    LAS float* impw = (LAS float*)((LAS char*)F.lds + L_IMP) + L.wid * 512;
#pragma unroll
    for (int k = 0; k < 8; ++k) impw[L.lane + 64 * k] = 0.f;
    WAVE_LDS_FENCE();
    for (int t = 0; t < tc; ++t) {
        u32x4 kr, vr; tile_gload(Sc, t, L.tid, kr, vr);
        tile_lstore((LAS char*)F.lds + L_K0, (LAS char*)F.lds + L_V0, L.tid, kr, vr);
        __syncthreads();
        f32x16 p0, p1;
#pragma unroll
        for (int r = 0; r < 16; ++r) { p0[r] = -Cc; p1[r] = -Cc; }
        qk_tile((LAS char*)F.lds + L_K0, qr, p0, p1, L.r32, L.hi);
        const u64 mk = mfc(t); const unsigned m0 = (unsigned)(mk >> (4 * L.hi)), m1 = (unsigned)(mk >> (32 + 4 * L.hi));
        const int qloc = L.r32 >> 2; const bool wr = (L.r32 & 3) == 0;
#pragma unroll
        for (int half = 0; half < 2; ++half)
#pragma unroll
            for (int m = 0; m < 4; ++m) {
                float e[4];
#pragma unroll
                for (int k = 0; k < 4; ++k) { const int r = 4 * m + k, bit = k + 8 * m; const float x = half ? p1[r] : p0[r]; const unsigned mm = half ? m1 : m0;
                    e[k] = ((mm >> bit) & 1u) ? __builtin_amdgcn_exp2f(x) * rlc : 0.f; }
                const float core = dpp_quad_sum((e[0] + e[1]) + (e[2] + e[3])), edge = dpp_quad_sum(e[3]);
                const int j = 16 * t + 8 * half + 2 * m + L.hi;
                if (wr) { impw[qloc * 64 + j] += core; }
                WAVE_LDS_FENCE();
                if (wr && j + 1 < 64) { impw[qloc * 64 + j + 1] += edge; }
                WAVE_LDS_FENCE();
            }
        __syncthreads();
    }
    {
        const int qloc = L.lane >> 3, sub = L.lane & 7; const int cur = i;
        u64 keys[8];
#pragma unroll
        for (int k = 0; k < 8; ++k) { const int j = sub + 8 * k; float v = impw[qloc * 64 + j];
            if (j == 0 || j == cur || j == cur - 1) v = 1e9f;
            if (j > cur) v = -1e30f;
            keys[k] = ((u64)f2key(v) << 32) | (u64)(63 - j); }
        u64 selm = 0ull; unsigned used = 0u;
#pragma unroll 1
        for (int it = 0; it < 16; ++it) {
            u64 best = 0ull;
#pragma unroll
            for (int k = 0; k < 8; ++k) { const u64 c = ((used >> k) & 1u) ? 0ull : keys[k]; best = c > best ? c : best; }
#pragma unroll
            for (int o2 = 1; o2 < 8; o2 <<= 1) { const unsigned lo = __shfl_xor((unsigned)best, o2), hi2 = __shfl_xor((unsigned)(best >> 32), o2); const u64 ob = ((u64)hi2 << 32) | lo; best = ob > best ? ob : best; }
            const int jsel = 63 - (int)(best & 63ull);
            if ((jsel & 7) == sub) used |= 1u << (jsel >> 3);
            selm |= 1ull << jsel;
        }
        LAS u64* selw = (LAS u64*)((LAS char*)F.lds + L_SEL) + L.wid * 8;
        if (sub == 0) selw[qloc] = selm;
        WAVE_LDS_FENCE();
    }
    const u64 sel = ((LAS const u64*)((LAS char*)F.lds + L_SEL))[L.wid * 8 + (L.r32 >> 2)];
    {
        const bf16* KV = KVbase + (size_t)3 * M * 256;
        KVSrc S{KV + (size_t)b * SEQ * 256 + kvh * 64, KV + (size_t)b * SEQ * 256 + 128 + kvh * 64, 256, SEQ};
        auto mf = [sel, q](int t) -> u64 { return ((sel >> t) & 1ull) ? mask_le(q - 64 * t) : 0ull; };
        lsum = 0.f;
#pragma unroll
        for (int r = 0; r < 16; ++r) { o[0][r] = 0.f; o[1][r] = 0.f; }
        attend_range((LAS char*)F.lds, S, 0, i + 1, mf, qr, -Ck, lsum, o, L);
        branch_finish_lds(wsf, accw, lsum, gs[1], o, L, false);
    }
    {
        const bf16* KV = KVbase + (size_t)4 * M * 256;
        KVSrc S{KV + (size_t)b * SEQ * 256 + kvh * 64, KV + (size_t)b * SEQ * 256 + 128 + kvh * 64, 256, SEQ};
        auto mf = [q](int t) -> u64 { return mask_le(q - 64 * t) & mask_ge(q - 511 - 64 * t); };
        lsum = 0.f;
#pragma unroll
        for (int r = 0; r < 16; ++r) { o[0][r] = 0.f; o[1][r] = 0.f; }
        attend_range((LAS char*)F.lds, S, i - 8 < 0 ? 0 : i - 8, i + 1, mf, qr, -Ck, lsum, o, L);
        branch_finish_lds(wsf, accw, lsum, gs[2], o, L, false);
    }
    const size_t tok0 = (size_t)b * SEQ + 64 * i + 8 * L.wid; const int kvh4 = 4 * kvh;
    bf16* Od = odst ? odst : Q;
    auto rowptr = [Od, tok0, kvh4](int row) -> bf16* { return Od + (tok0 + (row >> 2)) * 512 + (kvh4 + (row & 3)) * 64; };
    f32x16 acc[2];
#pragma unroll
    for (int d0 = 0; d0 < 2; ++d0)
#pragma unroll
        for (int r = 0; r < 16; ++r) acc[d0][r] = accw[(d0 * 16 + r) * 64 + L.lane];
    WAVE_LDS_FENCE();
    store_o((LAS char*)F.lds + L_OST + L.wid * 8192, acc, rowptr, L.lane, L.r32, L.hi);
}

__global__ void __launch_bounds__(NWAVES * 64, 2) mk_fwd(Args args) {
    extern __shared__ __attribute__((aligned(16))) unsigned char lds_raw[];
    LAS unsigned char* lds = (LAS unsigned char*)lds_raw;
    volatile LAS unsigned* MISCW = (volatile LAS unsigned*)(lds + LDS_UNIT + 16);
    if (threadIdx.x < 8) MISCW[threadIdx.x] = 0u;
    __syncthreads();
    (void)xcd_barrier_post((unsigned*)((gu32*)(args.ws + WS_CTL) + CW_BAR), MISCW);
#define GRID_BARRIER() do { unsigned char* wsb_ = args.ws; asm volatile("" : "+s"(wsb_)); XcdBarrier bar_; bar_.bar = (unsigned*)((gu32*)(wsb_ + WS_CTL) + CW_BAR); bar_.x = xb_xcc_id(); \
    bar_.st = (volatile LAS unsigned*)(lds + LDS_UNIT + 16); xcd_barrier(bar_); } while (0)
#define MKFRAME() Frame F; { unsigned char* ws_ = args.ws; asm volatile("" : "+s"(ws_)); int tid_ = threadIdx.x; asm volatile("" : "+v"(tid_)); \
    F.lds = lds; F.tid = tid_; F.lane = tid_ & 63; F.wave = __builtin_amdgcn_readfirstlane(tid_ >> 6); F.G = gridDim.x; F.gw = 0; F.NGW = F.G * NWAVES; \
    F.ws = ws_; F.ctl = (gu32*)(ws_ + WS_CTL); F.a = &args; } int bid = blockIdx.x; asm volatile("" : "+s"(bid)); F.gw = bid * NWAVES + F.wave; \
    unsigned char* ws = F.ws; bf16* XB = (bf16*)(ws + WS_XB); bf16* MB = (bf16*)(ws + WS_MB); bf16* ZQ = (bf16*)(ws + WS_ZQ); bf16* ZKV = (bf16*)(ws + WS_ZKV); bf16* YS = (bf16*)(ws + WS_YS); bf16* HM = (bf16*)(ws + WS_HMID); \
    float* SSQ = (float*)(ws + WS_SSQ); (void)XB; (void)MB; (void)ZQ; (void)ZKV; (void)YS; (void)HM; (void)SSQ;
#define WL(l) (ws + WS_W + (size_t)(l) * W_LAYER)
#ifdef PROBE_T
#define STAMP(k) do { if (blockIdx.x == 0 && threadIdx.x == 0) ((unsigned long long*)(args.ws + WS_CTL + 512 * 1024))[k] = __builtin_amdgcn_s_memrealtime(); } while (0)
#else
#define STAMP(k) do { } while (0)
#endif

    STAMP(0);
#ifndef NO_P0
    { MKFRAME(); p0_prologue(F); }
#ifdef DBL_P0
    { MKFRAME(); p0_prologue(F); }
#endif
#endif
    GRID_BARRIER();
    STAMP(1);
#pragma unroll 1
    for (int l = 0; l < DEPTH; ++l) {
#ifndef NO_G1
#ifdef DBL_G1
        for (int rep_ = 0; rep_ < 2; ++rep_)
#endif
        {
            MKFRAME(); unsigned char* wl = WL(l);
            pg8::Gemm g{XB, (const bf16*)(wl + W_IN), M, 3328, DM}; pg8::StaticOrder S; S.init(M, 3328, F.G, bid);
            pg8::EpiG1 E{ZQ, ZKV, SSQ};
            pg8::gemm_phase<pg8::EpiG1, pg8::StaticOrder, true, true>(F.lds, g, S, E);
        }
#endif
        GRID_BARRIER();
        STAMP(2 + 8 * l);
#ifndef NO_POST
        { MKFRAME(); post_phase(F, l); }
#ifdef DBL_POST
        { MKFRAME(); post_phase(F, l, true); }
#endif
#endif
        GRID_BARRIER();
        STAMP(3 + 8 * l);
        {
            MKFRAME();
            gu32* ctr = F.ctl + CW_Q + 64 * (2 * l);
            for (;;) { const int u = next_unit(F, ctr); if (u >= 128 + 2048 + 512) break;
#ifndef NO_CMP
                if (u < 128) { compress_unit(F, l, u);
#ifdef DBL_CMP
                    compress_unit(F, l, u);
#endif
                }
#else
                if (u < 128) {}
#endif
#ifndef NO_SEL
                else if (u < 128 + 2048) { const int v = u - 128; select_unit(F, v & 3, 511 - (v >> 2));
#ifdef DBL_SEL
                    select_unit(F, v & 3, 511 - (v >> 2));
#endif
                }
#endif
#ifndef NO_SWA
                else { const int v = u - 2176; simple_unit<0>(F, l, v & 3, (v >> 2) & 1, v >> 3);
#ifdef DBL_SWA
                    simple_unit<0>(F, l, v & 3, (v >> 2) & 1, v >> 3, (bf16*)(ws + WS_MB + 8 * MiB));
#endif
                }
#endif
            }
        }
        GRID_BARRIER();
        STAMP(4 + 8 * l);
#ifdef DBL_ATT2
        for (int rep_ = 0; rep_ < 2; ++rep_)
#else
        const int rep_ = 0;
#endif
        {
            MKFRAME();
            gu32* ctr = F.ctl + CW_Q + 64 * (2 * l + 1 + 4 * rep_);
            bf16* od = rep_ ? (bf16*)(ws + WS_MB) : nullptr;
            for (;;) { const int u = next_unit(F, ctr); if (u >= 1024) break;
                const int i = 63 - (u >> 4), b = (u >> 1) & 3, kvh = u & 1;
#ifdef DBL_ATT2
                if (((u >> 3) & 1) && (rep_ == 0 || DBL_ATT2 != 3)) simple_unit<1>(F, l, b, kvh, i, od);
                if (!((u >> 3) & 1) && (rep_ == 0 || DBL_ATT2 != 2)) nsa_unit(F, l, b, kvh, i, od);
#else
                if ((u >> 3) & 1) simple_unit<1>(F, l, b, kvh, i, od); else nsa_unit(F, l, b, kvh, i, od);
#endif
            }
        }
        GRID_BARRIER();
        STAMP(5 + 8 * l);
#ifndef NO_G2
#ifdef DBL_G2
        for (int rep_ = 0; rep_ < 2; ++rep_)
#endif
#pragma unroll 1
        for (int n = 0; n < 3; ++n) {
            MKFRAME(); unsigned char* wl = WL(l);
#ifndef NO_G2A
            { pg8::Gemm g{ZQ + (size_t)n * M * 512, (const bf16*)(wl + W_BR) + (size_t)n * DM * 512, M, DM, 512}; pg8::StaticOrder S; S.init(M, DM, F.G, bid);
              pg8::EpiStash E{YS}; pg8::gemm_phase<pg8::EpiStash, pg8::StaticOrder, false, true>(F.lds, g, S, E); }
#endif
#ifndef NO_G2B
            { pg8::Gemm g{XB, (const bf16*)(wl + W_G) + (size_t)n * DM * DM, M, DM, DM}; pg8::StaticOrder S; S.init(M, DM, F.G, bid);
              pg8::EpiGate E{YS, MB, SSQ, n == 0 ? 1 : 0}; pg8::gemm_phase<pg8::EpiGate, pg8::StaticOrder, false, true>(F.lds, g, S, E); }
#endif
        }
#endif
        GRID_BARRIER();
        STAMP(6 + 8 * l);
#ifndef NO_G3
        {
            MKFRAME(); unsigned char* wl = WL(l);
            pg8::Gemm g{MB, (const bf16*)(wl + W_OUT), M, DM, DM}; pg8::StaticOrder S; S.init(M, DM, F.G, bid);
            pg8::EpiRes E{l == 0 ? F.a->in[0] : (const float*)F.a->out, F.a->out, XB, SSQ};
            pg8::gemm_phase<pg8::EpiRes, pg8::StaticOrder, false, true>(F.lds, g, S, E);
        }
#ifdef DBL_G3
        {   MKFRAME(); unsigned char* wl = WL(l);
            pg8::Gemm g{MB, (const bf16*)(wl + W_OUT), M, DM, DM}; pg8::StaticOrder S; S.init(M, DM, F.G, bid);
            pg8::EpiRes E{F.a->in[0], (float*)(ws + 0), (bf16*)(ws + 64 * MiB), (float*)(ws + 96 * MiB)};
            pg8::gemm_phase<pg8::EpiRes, pg8::StaticOrder, false, true>(F.lds, g, S, E);
        }
#endif
#endif
        GRID_BARRIER();
        STAMP(7 + 8 * l);
#ifndef NO_G4
#ifdef DBL_G4
        for (int rep_ = 0; rep_ < 2; ++rep_)
#endif
        {
            MKFRAME(); unsigned char* wl = WL(l);
            pg8::Gemm g{XB, (const bf16*)(wl + W_UP), M, DFF, DM}; pg8::StaticOrder S; S.init(M, DFF, F.G, bid);
            pg8::EpiG4 E{HM, SSQ};
            pg8::gemm_phase<pg8::EpiG4, pg8::StaticOrder, true, true>(F.lds, g, S, E);
        }
#endif
        GRID_BARRIER();
        STAMP(8 + 8 * l);
#ifndef NO_G5
        {
            MKFRAME(); unsigned char* wl = WL(l);
            pg8::Gemm g{HM, (const bf16*)(wl + W_DN), M, DM, DFF}; pg8::StaticOrder S; S.init(M, DM, F.G, bid);
            pg8::EpiRes E{(const float*)F.a->out, F.a->out, XB, SSQ};
            pg8::gemm_phase<pg8::EpiRes, pg8::StaticOrder, false, true>(F.lds, g, S, E);
        }
#ifdef DBL_G5
        {   MKFRAME(); unsigned char* wl = WL(l);
            pg8::Gemm g{HM, (const bf16*)(wl + W_DN), M, DM, DFF}; pg8::StaticOrder S; S.init(M, DM, F.G, bid);
            pg8::EpiNull E{};
            pg8::gemm_phase<pg8::EpiNull, pg8::StaticOrder, false, true>(F.lds, g, S, E);
        }
#endif
#endif
#ifdef PROBE_T
        GRID_BARRIER();
        STAMP(9 + 8 * l);
#else
        if (l + 1 < DEPTH) GRID_BARRIER();
#endif
#ifdef DBL_BAR
        for (int rep_ = 0; rep_ < 16; ++rep_) GRID_BARRIER();
#endif
    }
#ifdef PROBE_T
    {
        GRID_BARRIER();
        const unsigned long long* st = (const unsigned long long*)(args.ws + WS_CTL + 512 * 1024);
        float tus;
        if (PROBE_T == 0) tus = (float)(st[1] - st[0]) * 0.01f;
        else tus = 0.5f * ((float)(st[PROBE_T + 1] - st[PROBE_T]) + (float)(st[PROBE_T + 9] - st[PROBE_T + 8])) * 0.01f;
        const float sc = 1.0f + tus * 0.001f;
        float* o = args.out;
        for (size_t i = (size_t)blockIdx.x * 512 + threadIdx.x; i < (size_t)M * DM; i += (size_t)gridDim.x * 512) o[i] *= sc;
    }
#endif
}

extern "C" void kernel_launch(void* const* d_in, const int* in_sizes, int n_in, void* d_out, int out_size, void* d_ws, size_t ws_size, hipStream_t stream) {
    static int grid = 0;
    if (grid == 0) {
        if (n_in != 17 || out_size != M * DM || ws_size < WS_END) { fprintf(stderr, "kernel_launch: unexpected problem shape (n_in %d out %d ws %zu)\n", n_in, out_size, ws_size); grid = -1; return; }
        int dev = 0, cus = 0, per_cu = 0;
        if (hipGetDevice(&dev) != hipSuccess || hipDeviceGetAttribute(&cus, hipDeviceAttributeMultiprocessorCount, dev) != hipSuccess) { grid = -1; return; }
        if (hipFuncSetAttribute((const void*)mk_fwd, hipFuncAttributeMaxDynamicSharedMemorySize, LDS_BYTES) != hipSuccess) { fprintf(stderr, "kernel_launch: hipFuncSetAttribute failed\n"); grid = -1; return; }
        if (hipOccupancyMaxActiveBlocksPerMultiprocessor(&per_cu, (const void*)mk_fwd, NWAVES * 64, LDS_BYTES) != hipSuccess || per_cu < 1) { fprintf(stderr, "kernel_launch: occupancy query says %d blocks/CU\n", per_cu); }
        (void)hipGetLastError();
        if (cus != 256) { fprintf(stderr, "kernel_launch: built for a 256-CU device (one 256x256 GEMM unit per workgroup in the N=1024 phases), found %d CUs\n", cus); grid = -1; return; }
        grid = cus;
    }
    if (grid < 0) return;
    (void)hipMemsetAsync((char*)d_ws + WS_CTL, 0, CTL_BYTES, stream);
    Args a{};
    for (int i = 0; i < 17; ++i) a.in[i] = (const float*)d_in[i];
    a.out = (float*)d_out; a.ws = (unsigned char*)d_ws;
    hipLaunchKernelGGL(mk_fwd, dim3(grid), dim3(NWAVES * 64), LDS_BYTES, stream, a);
}
```

```cpp
#include <hip/hip_runtime.h>
#include <cstdio>
#include <cstdint>

namespace pg8 {
#define PG8_LAS __attribute__((address_space(3)))
typedef unsigned short bf16_t;
typedef short bf16x8 __attribute__((ext_vector_type(8)));
typedef float f32x4 __attribute__((ext_vector_type(4)));
typedef unsigned u32x4 __attribute__((ext_vector_type(4)));
constexpr int BM = 256, BK = 64, HALF = 128, HTB = HALF * BK * 2  , STAGE_BYTES = 8 * HTB, NXCD = 8, WGM = 8;

__host__ __device__ __forceinline__ int lds_byte(int r, int c) { const int st = (r >> 4) * 2 + (c >> 5), rr = r & 15, cc = c & 31, ob = rr * 64 + cc * 2; return st * 1024 + (ob ^ (((ob >> 9) & 1) << 5)); }
__host__ __device__ __forceinline__ void stage_rc(int b, int& R, int& C) { const int st = b / 1024, sb = b % 1024, swz = sb ^ (((sb >> 9) & 1) << 5); R = (st >> 1) * 16 + swz / 64; C = (st & 1) * 32 + (swz % 64) / 2; }
__host__ __device__ __forceinline__ int perm32(int rho) { const int n = rho >> 4, i = rho & 15; return 8 * (i >> 2) + 4 * n + (i & 3); }

struct Unit { int pm, pn; };
struct Gemm { const bf16_t* A; const bf16_t* Bt; int M, N, K; };

struct StaticOrder {
    int nM, nN, nwg, G, c;
    __host__ __device__ void init(int M, int N, int G_, int c_) { nM = M / BM; nN = N / BM; nwg = nM * nN; G = G_; c = c_; }
    __host__ __device__ bool next(int i, Unit& u) const {
        const long L = (long)i * G + c; if (L >= nwg) return false;
        int wgid = (int)L; { const int q = nwg / NXCD, r = nwg % NXCD, xcd = wgid % NXCD, off = wgid / NXCD; wgid = (xcd < r ? xcd * (q + 1) : r * (q + 1) + (xcd - r) * q) + off; }
        const int nig = WGM * nN, gid = wgid / nig, fm = gid * WGM, gsz = (nM - fm) < WGM ? (nM - fm) : WGM;
        u.pm = fm + ((wgid % nig) % gsz); u.pn = (wgid % nig) / gsz; return true;
    }
    __device__ __forceinline__ void a_ready(const Unit&) const {}
    __device__ __forceinline__ void done(const Unit&) const {}
};

__device__ __forceinline__ unsigned cvt_pk_bf16(float lo, float hi) { unsigned r; asm volatile("v_cvt_pk_bf16_f32 %0, %1, %2" : "=v"(r) : "v"(lo), "v"(hi)); return r; }
template <class Epi, class Sched, bool ALIGN_EPI = false, bool SP2 = false>
__device__ __forceinline__ void gemm_phase(PG8_LAS unsigned char* lds, const Gemm g, const Sched& S, const Epi& E) {
    int tid_l = threadIdx.x; asm volatile("" : "+v"(tid_l));
    const int tid = tid_l, wid = __builtin_amdgcn_readfirstlane(tid >> 6), lane = tid & 63, wr = wid >> 2, wc = wid & 3, fr = lane & 15, fq = lane >> 4;
    const int K = g.K, nt = K / BK;
    unsigned voffA[2], voffB[2];
#pragma unroll
    for (int i = 0; i < 2; ++i) { int R, C; stage_rc(tid * 16 + i * 8192, R, C); const int Rb = Epi::PERM ? ((R & ~31) + perm32(R & 31)) : R;
        voffA[i] = (unsigned)(R * K + C) * 2u; voffB[i] = (unsigned)(Rb * K + C) * 2u; }
    const size_t kstep = (size_t)(BK * 2);
    const size_t hstep = (size_t)HALF * K * 2;
    const size_t tstep = 2 * hstep;
    const unsigned ldsw = (unsigned)wid * 1024u;
    const int aoff = lds_byte(wr * 64 + fr, fq * 8), boff = lds_byte(wc * 32 + fr, fq * 8);
#define PG8_SA(b, h) (((b) * 2 + (h)) * HTB)
#define PG8_SB(b, h) ((4 + (b) * 2 + (h)) * HTB)
#define PG8_STAGE(bufoff, gbase, voff) do { _Pragma("unroll") for (int _i = 0; _i < 2; ++_i) \
        __builtin_amdgcn_global_load_lds((const unsigned*)((const char*)(gbase) + (voff)[_i]), (PG8_LAS unsigned*)(lds + (bufoff) + ldsw + _i * 8192), 16, 0, 0); } while (0)
#define PG8_LDA(dst, b, h) do { _Pragma("unroll") for (int m = 0; m < 4; ++m) _Pragma("unroll") for (int k = 0; k < 2; ++k) dst[m][k] = *(const PG8_LAS bf16x8*)(lds + PG8_SA(b, h) + aoff + m * 2048 + k * 1024); } while (0)
#define PG8_LDB(dst, b, h) do { _Pragma("unroll") for (int n = 0; n < 2; ++n) _Pragma("unroll") for (int k = 0; k < 2; ++k) dst[n][k] = *(const PG8_LAS bf16x8*)(lds + PG8_SB(b, h) + boff + n * 2048 + k * 1024); } while (0)
#define PG8_MMA(ai, bj, At, Bt) do { __builtin_amdgcn_s_setprio(1); _Pragma("unroll") for (int m = 0; m < 4; ++m) _Pragma("unroll") for (int n = 0; n < 2; ++n) _Pragma("unroll") for (int k = 0; k < 2; ++k) \
        acc[ai][bj][m][n] = __builtin_amdgcn_mfma_f32_16x16x32_bf16(Bt[n][k], At[m][k], acc[ai][bj][m][n], 0, 0, 0); __builtin_amdgcn_s_setprio(0); } while (0)
#define PG8_WAIT_V(n) asm volatile("s_waitcnt vmcnt(" #n ")" ::: "memory")
#define PG8_WAIT_L(n) asm volatile("s_waitcnt lgkmcnt(" #n ")" ::: "memory")
#define PG8_BAR __builtin_amdgcn_s_barrier()
#define PG8_SCHED __builtin_amdgcn_sched_barrier(0)
    Unit cur, nxt; int ui = 0;
    if (!S.next(0, cur)) return;
    f32x4 acc[2][2][4][2];
#pragma unroll
    for (int a = 0; a < 2; ++a)
#pragma unroll
        for (int b = 0; b < 2; ++b)
#pragma unroll
            for (int m = 0; m < 4; ++m)
#pragma unroll
                for (int n = 0; n < 2; ++n) acc[a][b][m][n] = (f32x4){0.f, 0.f, 0.f, 0.f};
    bf16x8 At[4][2], B0[2][2], B1[2][2];
    const char* cA = (const char*)g.A + (size_t)cur.pm * tstep; const char* cB = (const char*)g.Bt + (size_t)cur.pn * tstep;
    S.a_ready(cur);
    if constexpr (SP2) {
        PG8_STAGE(PG8_SB(0, 0), cB, voffB); PG8_STAGE(PG8_SB(0, 1), cB + hstep, voffB); PG8_STAGE(PG8_SA(0, 0), cA, voffA); PG8_STAGE(PG8_SA(0, 1), cA + hstep, voffA);
        if (wr == 1) PG8_BAR;
        PG8_WAIT_V(2); PG8_BAR;
        PG8_STAGE(PG8_SB(1, 0), cB + kstep, voffB); PG8_STAGE(PG8_SA(1, 0), cA + kstep, voffA); PG8_STAGE(PG8_SB(1, 1), cB + hstep + kstep, voffB);
        PG8_WAIT_V(6); PG8_BAR;
    } else {
        PG8_STAGE(PG8_SB(0, 0), cB, voffB); PG8_STAGE(PG8_SA(0, 0), cA, voffA); PG8_STAGE(PG8_SB(0, 1), cB + hstep, voffB); PG8_STAGE(PG8_SA(0, 1), cA + hstep, voffA);
        if (wr == 1) PG8_BAR;
        PG8_WAIT_V(4); PG8_BAR;
        PG8_STAGE(PG8_SB(1, 0), cB + kstep, voffB); PG8_STAGE(PG8_SA(1, 0), cA + kstep, voffA); PG8_STAGE(PG8_SB(1, 1), cB + hstep + kstep, voffB);
        PG8_WAIT_V(6); PG8_BAR;
    }
    for (;;) {
        const bool has_next = S.next(ui + 1, nxt);
        const char* nA = has_next ? (const char*)g.A + (size_t)nxt.pm * tstep : cA; const char* nB = has_next ? (const char*)g.Bt + (size_t)nxt.pn * tstep : cB;
        for (int t = 0; t < nt; t += 2) {
            const bool last = (t == nt - 2);
            const char* a1 = cA + (size_t)(t + 1) * kstep;
            const char* a2 = last ? nA : cA + (size_t)(t + 2) * kstep; const char* b2 = last ? nB : cB + (size_t)(t + 2) * kstep;
            const char* a3 = a2 + kstep; const char* b3 = b2 + kstep;
            if (last && has_next) S.a_ready(nxt);
            if constexpr (SP2) {
            PG8_LDB(B0, 0, 0); PG8_LDB(B1, 0, 1); PG8_SCHED; PG8_LDA(At, 0, 0); PG8_STAGE(PG8_SA(1, 1), a1 + hstep, voffA);
            PG8_WAIT_V(8); PG8_WAIT_L(0); PG8_BAR; PG8_MMA(0, 0, At, B0); PG8_MMA(0, 1, At, B1); PG8_BAR; PG8_SCHED;
            PG8_LDA(At, 0, 1); PG8_STAGE(PG8_SB(0, 0), b2, voffB); PG8_STAGE(PG8_SB(0, 1), b2 + hstep, voffB); PG8_STAGE(PG8_SA(0, 0), a2, voffA);
            PG8_WAIT_V(8); PG8_WAIT_L(0); PG8_BAR; PG8_MMA(1, 0, At, B0); PG8_MMA(1, 1, At, B1); PG8_BAR; PG8_SCHED;
            PG8_LDB(B0, 1, 0); PG8_LDB(B1, 1, 1); PG8_SCHED; PG8_LDA(At, 1, 0); PG8_STAGE(PG8_SA(0, 1), a2 + hstep, voffA);
            PG8_WAIT_V(8); PG8_WAIT_L(0); PG8_BAR; PG8_MMA(0, 0, At, B0); PG8_MMA(0, 1, At, B1); PG8_BAR; PG8_SCHED;
            PG8_LDA(At, 1, 1); PG8_STAGE(PG8_SB(1, 0), b3, voffB); PG8_STAGE(PG8_SB(1, 1), b3 + hstep, voffB); PG8_STAGE(PG8_SA(1, 0), a3, voffA);
            PG8_WAIT_V(8); PG8_WAIT_L(0); PG8_BAR; PG8_MMA(1, 0, At, B0); PG8_MMA(1, 1, At, B1); PG8_BAR; PG8_SCHED;
            } else {
            PG8_LDB(B0, 0, 0); PG8_SCHED; PG8_LDA(At, 0, 0); PG8_STAGE(PG8_SA(1, 1), a1 + hstep, voffA);
            PG8_WAIT_L(8); PG8_BAR; PG8_WAIT_L(0); PG8_MMA(0, 0, At, B0); PG8_BAR; PG8_SCHED;
            PG8_LDB(B1, 0, 1); PG8_STAGE(PG8_SB(0, 0), b2, voffB);
            PG8_BAR; PG8_WAIT_L(0); PG8_MMA(0, 1, At, B1); PG8_BAR;
            PG8_LDA(At, 0, 1); PG8_STAGE(PG8_SA(0, 0), a2, voffA);
            PG8_BAR; PG8_WAIT_L(0); PG8_MMA(1, 0, At, B0); PG8_BAR; PG8_SCHED;
            PG8_STAGE(PG8_SB(0, 1), b2 + hstep, voffB);
            PG8_WAIT_V(6); PG8_BAR; PG8_MMA(1, 1, At, B1); PG8_BAR;
            PG8_LDB(B0, 1, 0); PG8_SCHED; PG8_LDA(At, 1, 0); PG8_STAGE(PG8_SA(0, 1), a2 + hstep, voffA);
            PG8_WAIT_L(8); PG8_BAR; PG8_WAIT_L(0); PG8_MMA(0, 0, At, B0); PG8_BAR; PG8_SCHED;
            PG8_LDB(B1, 1, 1); PG8_STAGE(PG8_SB(1, 0), b3, voffB);
            PG8_BAR; PG8_WAIT_L(0); PG8_MMA(0, 1, At, B1); PG8_BAR;
            PG8_LDA(At, 1, 1); PG8_STAGE(PG8_SA(1, 0), a3, voffA);
            PG8_BAR; PG8_WAIT_L(0); PG8_MMA(1, 0, At, B0); PG8_BAR; PG8_SCHED;
            PG8_STAGE(PG8_SB(1, 1), b3 + hstep, voffB);
            PG8_WAIT_V(6); PG8_BAR; PG8_MMA(1, 1, At, B1); PG8_BAR;
            }
        }
        if constexpr (ALIGN_EPI) { if (wr == 0) PG8_BAR; }
        if constexpr (!Epi::AFTER_DRAIN) { E(acc, cur, wr, wc, fr, fq); S.done(cur); }
        if (!has_next) break;
#pragma unroll
        for (int a = 0; a < 2; ++a)
#pragma unroll
            for (int b = 0; b < 2; ++b)
#pragma unroll
                for (int m = 0; m < 4; ++m)
#pragma unroll
                    for (int n = 0; n < 2; ++n) acc[a][b][m][n] = (f32x4){0.f, 0.f, 0.f, 0.f};
        cur = nxt; cA = nA; cB = nB; ++ui;
        if constexpr (ALIGN_EPI) { if (wr == 1) PG8_BAR; }
    }
    PG8_WAIT_V(0);
    if constexpr (!ALIGN_EPI) { if (wr == 0) PG8_BAR; }
    PG8_BAR;
    if constexpr (Epi::AFTER_DRAIN) { E.fused(acc, cur, wr, wc, fr, fq, lds, wid, lane); S.done(cur); }
#undef PG8_SA
#undef PG8_SB
#undef PG8_STAGE
#undef PG8_LDA
#undef PG8_LDB
#undef PG8_MMA
#undef PG8_WAIT_V
#undef PG8_WAIT_L
#undef PG8_BAR
#undef PG8_SCHED
}
}

namespace pg8 {
#define PG8_GAS __attribute__((address_space(1)))
constexpr int MROWS = 16384;
__device__ __forceinline__ unsigned pk_bf16(float lo, float hi) { typedef float f2 __attribute__((ext_vector_type(2))); typedef __bf16 b2 __attribute__((ext_vector_type(2)));
    f2 v = {lo, hi}; b2 b = __builtin_convertvector(v, b2); return __builtin_bit_cast(unsigned, b); }
__device__ __forceinline__ float bf_lo(unsigned w) { return __uint_as_float(w << 16); }
__device__ __forceinline__ float bf_hi(unsigned w) { return __uint_as_float(w & 0xffff0000u); }
__device__ __forceinline__ float row_rstd(const float* ssq, int row) {
    const PG8_GAS f32x4* p = (const PG8_GAS f32x4*)(ssq + (size_t)row * 16);
    const f32x4 a = p[0], b = p[1], c = p[2], d = p[3];
    const float s = (((a[0] + a[1]) + (a[2] + a[3])) + ((b[0] + b[1]) + (b[2] + b[3]))) + (((c[0] + c[1]) + (c[2] + c[3])) + ((d[0] + d[1]) + (d[2] + d[3])));
    return rsqrtf(s * (1.0f / 1024.0f) + 1e-6f);
}
__device__ __forceinline__ float sigmoidf_(float x) { return __builtin_amdgcn_rcpf(1.0f + __builtin_amdgcn_exp2f(-1.4426950408889634f * x)); }

struct EpiG1 {
    static constexpr bool PERM = true, AFTER_DRAIN = false;
    bf16_t* zq; bf16_t* zkv; const float* ssq;
    __device__ __forceinline__ void operator()(const f32x4 (&acc)[2][2][4][2], const Unit& u, int wr, int wc, int fr, int fq) const {
        const int row0 = u.pm * BM + wr * 64 + fr;
        bf16_t* base; int ldc, colt;
        if (u.pn < 6) { base = zq + (size_t)(u.pn >> 1) * ((size_t)MROWS * 512); ldc = 512; colt = (u.pn & 1) * 256; }
        else { base = zkv + (size_t)(u.pn - 6) * ((size_t)MROWS * 256); ldc = 256; colt = 0; }
        const int col0 = colt + wc * 32 + 8 * fq;
#pragma unroll
        for (int ai = 0; ai < 2; ++ai)
#pragma unroll
            for (int m = 0; m < 4; ++m) { const int row = row0 + ai * HALF + m * 16; const float rs = row_rstd(ssq, row); bf16_t* rowp = base + (size_t)row * ldc + col0;
#pragma unroll
                for (int bj = 0; bj < 2; ++bj) { const f32x4 v0 = acc[ai][bj][m][0] * rs, v1 = acc[ai][bj][m][1] * rs;
                    u32x4 w; w.x = pk_bf16(v0[0], v0[1]); w.y = pk_bf16(v0[2], v0[3]); w.z = pk_bf16(v1[0], v1[1]); w.w = pk_bf16(v1[2], v1[3]);
                    *(PG8_GAS u32x4*)(rowp + bj * HALF) = w; } }
    }
};
struct EpiG4 {
    static constexpr bool PERM = true, AFTER_DRAIN = false;
    bf16_t* h; const float* ssq;
    __device__ __forceinline__ void operator()(const f32x4 (&acc)[2][2][4][2], const Unit& u, int wr, int wc, int fr, int fq) const {
        const int row0 = u.pm * BM + wr * 64 + fr; const int col0 = u.pn * BM + wc * 32 + 8 * fq;
#pragma unroll
        for (int ai = 0; ai < 2; ++ai)
#pragma unroll
            for (int m = 0; m < 4; ++m) { const int row = row0 + ai * HALF + m * 16; const float rs = row_rstd(ssq, row); bf16_t* rowp = h + (size_t)row * 4096 + col0;
#pragma unroll
                for (int bj = 0; bj < 2; ++bj) { f32x4 v0 = acc[ai][bj][m][0] * rs, v1 = acc[ai][bj][m][1] * rs;
#pragma unroll
                    for (int e = 0; e < 4; ++e) { v0[e] = fmaxf(v0[e], 0.f); v0[e] *= v0[e]; v1[e] = fmaxf(v1[e], 0.f); v1[e] *= v1[e]; }
                    u32x4 w; w.x = pk_bf16(v0[0], v0[1]); w.y = pk_bf16(v0[2], v0[3]); w.z = pk_bf16(v1[0], v1[1]); w.w = pk_bf16(v1[2], v1[3]);
                    *(PG8_GAS u32x4*)(rowp + bj * HALF) = w; } }
    }
};
struct EpiRes {
    static constexpr bool PERM = true, AFTER_DRAIN = false;
    const float* xold; float* xout; bf16_t* xb; float* ssq;
    __device__ __forceinline__ void operator()(const f32x4 (&acc)[2][2][4][2], const Unit& u, int wr, int wc, int fr, int fq) const {
        const int row0 = u.pm * BM + wr * 64 + fr; const int col0 = u.pn * BM + wc * 32 + 8 * fq;
#pragma unroll
        for (int ai = 0; ai < 2; ++ai)
#pragma unroll
            for (int m = 0; m < 4; ++m) { const int row = row0 + ai * HALF + m * 16; float part = 0.f;
#pragma unroll
                for (int bj = 0; bj < 2; ++bj) { const size_t off = (size_t)row * 1024 + col0 + bj * HALF;
                    const f32x4 a0 = *(const PG8_GAS f32x4*)(xold + off), a1 = *(const PG8_GAS f32x4*)(xold + off + 4);
                    const f32x4 v0 = acc[ai][bj][m][0] + a0, v1 = acc[ai][bj][m][1] + a1;
                    *(PG8_GAS f32x4*)(xout + off) = v0; *(PG8_GAS f32x4*)(xout + off + 4) = v1;
                    u32x4 w; w.x = pk_bf16(v0[0], v0[1]); w.y = pk_bf16(v0[2], v0[3]); w.z = pk_bf16(v1[0], v1[1]); w.w = pk_bf16(v1[2], v1[3]);
                    *(PG8_GAS u32x4*)(xb + off) = w;
                    part += ((v0[0] * v0[0] + v0[1] * v0[1]) + (v0[2] * v0[2] + v0[3] * v0[3])) + ((v1[0] * v1[0] + v1[1] * v1[1]) + (v1[2] * v1[2] + v1[3] * v1[3])); }
                part += __shfl_xor(part, 16); part += __shfl_xor(part, 32);
                if (fq == 0) ((PG8_GAS float*)ssq)[(size_t)row * 16 + u.pn * 4 + wc] = part;
                asm volatile("" ::: "memory"); }
    }
};
struct EpiStash {
    static constexpr bool PERM = true, AFTER_DRAIN = true;
    __device__ __forceinline__ void fused(f32x4 (&acc)[2][2][4][2], const Unit& u, int wr, int wc, int fr, int fq, PG8_LAS unsigned char*, int, int) const { (*this)(acc, u, wr, wc, fr, fq); }
    bf16_t* ys;
    __device__ __forceinline__ void operator()(const f32x4 (&acc)[2][2][4][2], const Unit& u, int wr, int wc, int fr, int fq) const {
        bf16_t* base = ys + (size_t)(u.pm * 4 + u.pn) * 65536; const int row0 = wr * 64 + fr, col0 = wc * 32 + 8 * fq;
#pragma unroll
        for (int ai = 0; ai < 2; ++ai)
#pragma unroll
            for (int m = 0; m < 4; ++m) { bf16_t* rowp = base + (row0 + ai * HALF + m * 16) * 256 + col0;
#pragma unroll
                for (int bj = 0; bj < 2; ++bj) { const f32x4 v0 = acc[ai][bj][m][0], v1 = acc[ai][bj][m][1];
                    u32x4 w; w.x = pk_bf16(v0[0], v0[1]); w.y = pk_bf16(v0[2], v0[3]); w.z = pk_bf16(v1[0], v1[1]); w.w = pk_bf16(v1[2], v1[3]);
                    *(PG8_GAS u32x4*)(rowp + bj * HALF) = w; } }
    }
};
struct EpiGate {
    static constexpr bool PERM = true, AFTER_DRAIN = true;
    __device__ __forceinline__ void fused(f32x4 (&acc)[2][2][4][2], const Unit& u, int wr, int wc, int fr, int fq, PG8_LAS unsigned char*, int, int) const { (*this)(acc, u, wr, wc, fr, fq); }
    const bf16_t* ys; bf16_t* mb; const float* ssq; int first;
    __device__ __forceinline__ void operator()(const f32x4 (&acc)[2][2][4][2], const Unit& u, int wr, int wc, int fr, int fq) const {
        const bf16_t* sbase = ys + (size_t)(u.pm * 4 + u.pn) * 65536; const int lrow0 = wr * 64 + fr, lcol0 = wc * 32 + 8 * fq;
#pragma unroll
        for (int ai = 0; ai < 2; ++ai)
#pragma unroll
            for (int m = 0; m < 4; ++m) { const int lrow = lrow0 + ai * HALF + m * 16, row = u.pm * BM + lrow; const float rs = row_rstd(ssq, row);
#pragma unroll
                for (int bj = 0; bj < 2; ++bj) { const f32x4 a0 = acc[ai][bj][m][0] * rs, a1 = acc[ai][bj][m][1] * rs;
                    const u32x4 y = *(const PG8_GAS u32x4*)(sbase + lrow * 256 + lcol0 + bj * HALF);
                    bf16_t* mp = mb + (size_t)row * 1024 + u.pn * BM + lcol0 + bj * HALF;
                    u32x4 pv = {0u, 0u, 0u, 0u}; if (!first) pv = *(const PG8_GAS u32x4*)mp;
                    float r[8];
                    r[0] = bf_lo(pv.x) + sigmoidf_(a0[0]) * bf_lo(y.x); r[1] = bf_hi(pv.x) + sigmoidf_(a0[1]) * bf_hi(y.x);
                    r[2] = bf_lo(pv.y) + sigmoidf_(a0[2]) * bf_lo(y.y); r[3] = bf_hi(pv.y) + sigmoidf_(a0[3]) * bf_hi(y.y);
                    r[4] = bf_lo(pv.z) + sigmoidf_(a1[0]) * bf_lo(y.z); r[5] = bf_hi(pv.z) + sigmoidf_(a1[1]) * bf_hi(y.z);
                    r[6] = bf_lo(pv.w) + sigmoidf_(a1[2]) * bf_lo(y.w); r[7] = bf_hi(pv.w) + sigmoidf_(a1[3]) * bf_hi(y.w);
                    u32x4 w; w.x = pk_bf16(r[0], r[1]); w.y = pk_bf16(r[2], r[3]); w.z = pk_bf16(r[4], r[5]); w.w = pk_bf16(r[6], r[7]);
                    *(PG8_GAS u32x4*)mp = w;
                    asm volatile("" ::: "memory"); } }
    }
};
struct EpiNull {
    static constexpr bool PERM = true, AFTER_DRAIN = false;
    __device__ __forceinline__ void operator()(const f32x4 (&acc)[2][2][4][2], const Unit& u, int wr, int wc, int fr, int fq) const {
#pragma unroll
        for (int ai = 0; ai < 2; ++ai)
#pragma unroll
            for (int bj = 0; bj < 2; ++bj)
#pragma unroll
                for (int m = 0; m < 4; ++m) { asm volatile("" :: "v"(acc[ai][bj][m][0]), "v"(acc[ai][bj][m][1])); }
    }
};
}

#define GAS __attribute__((address_space(1)))
#define LAS __attribute__((address_space(3)))
typedef unsigned short bf16;
typedef unsigned v4u __attribute__((ext_vector_type(4)));
typedef float f32x4 __attribute__((ext_vector_type(4)));
typedef short bf16x8 __attribute__((ext_vector_type(8)));
typedef GAS unsigned gu32;
typedef GAS unsigned long long gu64;
#define RLX_AGENT __ATOMIC_RELAXED, __HIP_MEMORY_SCOPE_AGENT
#define LDS_WAIT() asm volatile("s_waitcnt lgkmcnt(0)" ::: "memory")
#define VM_WAIT() asm volatile("s_waitcnt vmcnt(0)" ::: "memory")
__device__ __forceinline__ unsigned long long rt() { return __builtin_amdgcn_s_memrealtime(); }
__device__ __forceinline__ unsigned f2bf(float f) { unsigned u = __builtin_bit_cast(unsigned, f); return (u + 0x7fffu + ((u >> 16) & 1u)) >> 16; }
__device__ __forceinline__ unsigned pk2(float lo, float hi) { return f2bf(lo) | (f2bf(hi) << 16); }

#define XB_TMO      128
#define XB_XCNT(j)  (256  + 64 * (j))
#define XB_XSUB(j)  (1280 + 64 * (j))
#define XB_XGEN(j)  (2304 + 64 * (j))
#define XB_TOP      3328
#define XB_TOPGEN   3392
#define XCD_BAR_WORDS 3456
#define XB_SPIN_CAP (1u << 18)

__device__ __forceinline__ unsigned xb_ld(unsigned* p)              { return __hip_atomic_load(p, __ATOMIC_RELAXED, __HIP_MEMORY_SCOPE_AGENT); }
__device__ __forceinline__ unsigned xb_add(unsigned* p, unsigned v) { return __hip_atomic_fetch_add(p, v, __ATOMIC_RELAXED, __HIP_MEMORY_SCOPE_AGENT); }
__device__ __forceinline__ unsigned xb_xcc_id() { return (unsigned)__builtin_amdgcn_s_getreg((3 << 11) | 20) & 0xFu; }
#define XB_SPIN(cond, bar) do { unsigned _sp = 0; while (cond) { __builtin_amdgcn_s_sleep(1); \
    if ((++_sp & 255u) == 0u) { if (xb_ld(&(bar)[XB_TMO])) break; if (_sp > XB_SPIN_CAP) { atomicAdd(&(bar)[XB_TMO], 1u); break; } } } } while (0)

struct XcdBarrier {
    unsigned* bar; unsigned x;
    volatile LAS unsigned* st;
};

__device__ __forceinline__ XcdBarrier xcd_barrier_post(unsigned* bar, volatile LAS unsigned* st) {
    XcdBarrier b; b.bar = bar; b.x = xb_xcc_id(); b.st = st;
    if (threadIdx.x == 0) (void)xb_add(&bar[XB_XCNT(b.x)], 1u);
    return b;
}
__device__ __forceinline__ void xcd_barrier_complete(unsigned* bar, unsigned x, unsigned& nloc, unsigned& nx) {
    const unsigned G = gridDim.x * gridDim.y * gridDim.z;
    unsigned sum, cnt, mine, sp = 0u;
    for (;;) {
        sum = 0u; cnt = 0u; mine = 0u;
#pragma unroll
        for (unsigned j = 0; j < 16; ++j) { const unsigned c = xb_ld(&bar[XB_XCNT(j)]); sum += c; cnt += (c > 0u) ? 1u : 0u; mine = (j == x) ? c : mine; }
        if (sum == G) break;
        __builtin_amdgcn_s_sleep(1);
        if ((++sp & 255u) == 0u) { if (xb_ld(&bar[XB_TMO])) break; if (sp > XB_SPIN_CAP) { atomicAdd(&bar[XB_TMO], 1u); break; } }
    }
    nloc = mine > 0u ? mine : 1u; nx = cnt > 0u ? cnt : 1u;
}

__device__ __forceinline__ void xcd_barrier(const XcdBarrier& b) {
    asm volatile("s_waitcnt vmcnt(0)" ::: "memory");
    __syncthreads();
    if (threadIdx.x == 0) {
        unsigned* bar = b.bar;
        __builtin_amdgcn_s_waitcnt(0);
        unsigned nloc = b.st[0], nx = b.st[1];
        if (nloc == 0u) { xcd_barrier_complete(bar, b.x, nloc, nx); b.st[0] = nloc; b.st[1] = nx; }
        const unsigned old = xb_add(&bar[XB_XSUB(b.x)], 1u);
        const unsigned gen = old / nloc;
        if (old + 1u == (gen + 1u) * nloc) {
            __builtin_amdgcn_fence(__ATOMIC_RELEASE, "agent");
            asm volatile("s_waitcnt vmcnt(0)" ::: "memory");
            const unsigned og = xb_add(&bar[XB_TOP], 1u);
            const unsigned tg = og / nx;
            if (og + 1u == (tg + 1u) * nx) xb_add(&bar[XB_TOPGEN], 1u);
            else XB_SPIN(xb_ld(&bar[XB_TOPGEN]) == tg, bar);
            __builtin_amdgcn_fence(__ATOMIC_ACQUIRE, "agent");
            xb_add(&bar[XB_XGEN(b.x)], 1u);
            asm volatile("s_waitcnt vmcnt(0)" ::: "memory");
        } else {
            XB_SPIN(xb_ld(&bar[XB_XGEN(b.x)]) == gen, bar);
            __builtin_amdgcn_fence(__ATOMIC_ACQUIRE, "agent");
            asm volatile("s_waitcnt vmcnt(0)" ::: "memory");
        }
    }
    __syncthreads();
}

namespace att {
typedef short bf16x8 __attribute__((ext_vector_type(8)));
typedef short s16x4 __attribute__((ext_vector_type(4)));
typedef float f32x16 __attribute__((ext_vector_type(16)));
typedef unsigned u32x4 __attribute__((ext_vector_type(4)));
typedef unsigned short bf16_t;
typedef unsigned long long u64;
constexpr int NKB = 4, NVB = 5;
constexpr int L_K0 = 0, L_V0 = NKB * 8320, L_WSF = L_V0 + NVB * 8192, L_IMP = L_WSF + 2048, L_SEL = L_IMP + 16384, L_OST = L_SEL + 512  , L_END = L_OST + 65536;
__device__ __forceinline__ int crow(int r, int hi) { return (r & 3) + 8 * (r >> 2) + 4 * hi; }
__device__ __forceinline__ unsigned pk2(float lo, float hi) { typedef float f2 __attribute__((ext_vector_type(2))); typedef __bf16 b2 __attribute__((ext_vector_type(2)));
    f2 v = {lo, hi}; b2 b = __builtin_convertvector(v, b2); return __builtin_bit_cast(unsigned, b); }
__device__ __forceinline__ s16x4 vtr(LAS const char* p) { typedef short v4i16_t __attribute__((ext_vector_type(4))); return __builtin_bit_cast(s16x4, __builtin_amdgcn_ds_read_tr16_b64_v4i16((LAS v4i16_t*)p)); }

struct KVSrc { const GAS bf16_t* k; const GAS bf16_t* v; int pitch; int nrows; };

struct Lane { int tid, lane, r32, hi, wid; };

__device__ __forceinline__ void tile_gload(const KVSrc& S, int t, int tid, u32x4& kr, u32x4& vr) {
    const int row = 64 * t + (tid >> 3), ch = tid & 7;
    kr = *(const GAS u32x4*)(S.k + (size_t)row * S.pitch + ch * 8); vr = *(const GAS u32x4*)(S.v + (size_t)row * S.pitch + ch * 8);
}
__device__ __forceinline__ void tile_lstore(LAS char* kb, LAS char* vb, int tid, const u32x4& kr, const u32x4& vr) {
    const int key = tid >> 3, ch = tid & 7;
    *(LAS u32x4*)(kb + ch * 1040 + (key >> 5) * 512 + (key & 31) * 16) = kr;
    *(LAS u32x4*)(vb + (ch >> 2) * 4096 + (key >> 4) * 1024 + ((key >> 3) & 1) * 512 + (key & 7) * 64 + (ch & 3) * 16) = vr;
}
__device__ __forceinline__ void qk_tile(LAS const char* kbuf, const bf16x8 (&qr)[4], f32x16& p0, f32x16& p1, int r32, int hi) {
    LAS const char* kb = kbuf + hi * 1040 + r32 * 16;
#pragma unroll
    for (int d0 = 0; d0 < 4; ++d0) {
        const bf16x8 b0 = *(LAS const bf16x8*)(kb + d0 * 2080);
        const bf16x8 b1 = *(LAS const bf16x8*)(kb + d0 * 2080 + 512);
        p0 = __builtin_amdgcn_mfma_f32_32x32x16_bf16(b0, qr[d0], p0, 0, 0, 0);
        p1 = __builtin_amdgcn_mfma_f32_32x32x16_bf16(b1, qr[d0], p1, 0, 0, 0);
    }
}
__device__ __forceinline__ void qk_tile_c(LAS const char* kbuf, const bf16x8 (&qr)[4], const f32x16& negm, f32x16& p0, f32x16& p1, int r32, int hi) {
    const unsigned ka = (unsigned)(size_t)kbuf + hi * 1040 + r32 * 16;
    bf16x8 kf[8];
#pragma unroll
    for (int d0 = 0; d0 < 4; ++d0) {
        asm volatile("ds_read_b128 %0, %1 offset:%c2" : "=&v"(kf[2 * d0]) : "v"(ka), "i"(d0 * 2080) : "memory");
        asm volatile("ds_read_b128 %0, %1 offset:%c2" : "=&v"(kf[2 * d0 + 1]) : "v"(ka), "i"(d0 * 2080 + 512) : "memory");
    }
    asm volatile("s_waitcnt lgkmcnt(0)" : "+v"(kf[0]), "+v"(kf[1]), "+v"(kf[2]), "+v"(kf[3]), "+v"(kf[4]), "+v"(kf[5]), "+v"(kf[6]), "+v"(kf[7]) :: "memory");
    __builtin_amdgcn_sched_barrier(0);
    p0 = __builtin_amdgcn_mfma_f32_32x32x16_bf16(kf[0], qr[0], negm, 0, 0, 0); p1 = __builtin_amdgcn_mfma_f32_32x32x16_bf16(kf[1], qr[0], negm, 0, 0, 0);
#pragma unroll
    for (int d0 = 1; d0 < 4; ++d0) { p0 = __builtin_amdgcn_mfma_f32_32x32x16_bf16(kf[2 * d0], qr[d0], p0, 0, 0, 0); p1 = __builtin_amdgcn_mfma_f32_32x32x16_bf16(kf[2 * d0 + 1], qr[d0], p1, 0, 0, 0); }
}
__device__ __forceinline__ void pv_tile(LAS const char* vbuf, const u32x4 (&pw)[4], f32x16 (&o)[2], f32x16& ol, int lane, int hi) {
    const unsigned va = (unsigned)(size_t)vbuf + ((lane >> 4) & 1) * 32 + (lane & 3) * 8 + (4 * hi + ((lane & 15) >> 2)) * 64;
#pragma unroll
    for (int d0 = 0; d0 < 2; ++d0) {
        s16x4 lo[4], h2[4];
#pragma unroll
        for (int ks = 0; ks < 4; ++ks) {
            asm volatile("ds_read_b64_tr_b16 %0, %1 offset:%c2" : "=&v"(lo[ks]) : "v"(va), "i"(d0 * 4096 + ks * 1024) : "memory");
            asm volatile("ds_read_b64_tr_b16 %0, %1 offset:%c2" : "=&v"(h2[ks]) : "v"(va), "i"(d0 * 4096 + ks * 1024 + 512) : "memory");
        }
        asm volatile("s_waitcnt lgkmcnt(0)" : "+v"(lo[0]), "+v"(lo[1]), "+v"(lo[2]), "+v"(lo[3]), "+v"(h2[0]), "+v"(h2[1]), "+v"(h2[2]), "+v"(h2[3]) :: "memory");
        __builtin_amdgcn_sched_barrier(0);
#pragma unroll
        for (int ks = 0; ks < 4; ++ks) {
            const bf16x8 vf = (bf16x8){lo[ks][0], lo[ks][1], lo[ks][2], lo[ks][3], h2[ks][0], h2[ks][1], h2[ks][2], h2[ks][3]};
            o[d0] = __builtin_amdgcn_mfma_f32_32x32x16_bf16(__builtin_bit_cast(bf16x8, pw[ks]), vf, o[d0], 0, 0, 0);
        }
        if (d0 == 0) {
            const bf16x8 ones = (bf16x8){0x3f80, 0x3f80, 0x3f80, 0x3f80, 0x3f80, 0x3f80, 0x3f80, 0x3f80};
#pragma unroll
            for (int ks = 0; ks < 4; ++ks) ol = __builtin_amdgcn_mfma_f32_32x32x16_bf16(__builtin_bit_cast(bf16x8, pw[ks]), ones, ol, 0, 0, 0);
        }
    }
}
__device__ __forceinline__ void mask_exp_pack(f32x16& p0, f32x16& p1, u64 mask, int hi, u32x4 (&pw)[4]) {
    const bool rowuni = __all(mask == ~0ull || mask == 0ull);
    if (rowuni) {
        const unsigned rm = mask ? ~0u : 0u;
        if (__all(mask == ~0ull)) {
#pragma unroll
            for (int r = 0; r < 16; ++r) { p0[r] = __builtin_amdgcn_exp2f(p0[r]); p1[r] = __builtin_amdgcn_exp2f(p1[r]); }
        } else {
#pragma unroll
            for (int r = 0; r < 16; ++r) { p0[r] = __uint_as_float(__float_as_uint(__builtin_amdgcn_exp2f(p0[r])) & rm); p1[r] = __uint_as_float(__float_as_uint(__builtin_amdgcn_exp2f(p1[r])) & rm); }
        }
    } else {
        const int m0 = (int)(unsigned)(mask >> (4 * hi)), m1 = (int)(unsigned)(mask >> (32 + 4 * hi));
#pragma unroll
        for (int r = 0; r < 16; ++r) { const int bit = (r & 3) + 8 * (r >> 2);
            const unsigned e0 = __float_as_uint(__builtin_amdgcn_exp2f(p0[r])), e1 = __float_as_uint(__builtin_amdgcn_exp2f(p1[r]));
            unsigned k0, k1;
            asm("v_bfe_i32 %0, %1, %2, 1" : "=v"(k0) : "v"(m0), "n"(bit)); asm("v_bfe_i32 %0, %1, %2, 1" : "=v"(k1) : "v"(m1), "n"(bit));
            p0[r] = __uint_as_float(e0 & k0); p1[r] = __uint_as_float(e1 & k1); }
    }
    pw[0] = (u32x4){pk2(p0[0], p0[1]), pk2(p0[2], p0[3]), pk2(p0[4], p0[5]), pk2(p0[6], p0[7])};
    pw[1] = (u32x4){pk2(p0[8], p0[9]), pk2(p0[10], p0[11]), pk2(p0[12], p0[13]), pk2(p0[14], p0[15])};
    pw[2] = (u32x4){pk2(p1[0], p1[1]), pk2(p1[2], p1[3]), pk2(p1[4], p1[5]), pk2(p1[6], p1[7])};
    pw[3] = (u32x4){pk2(p1[8], p1[9]), pk2(p1[10], p1[11]), pk2(p1[12], p1[13]), pk2(p1[14], p1[15])};
}
__device__ __forceinline__ u64 mask_le(int c) { return c >= 63 ? ~0ull : (c < 0 ? 0ull : ((2ull << c) - 1ull)); }
__device__ __forceinline__ u64 mask_ge(int a) { return a <= 0 ? ~0ull : (a > 63 ? 0ull : (~0ull << a)); }

__device__ __forceinline__ void k_gload(const KVSrc& S, int t, int tid, u32x4& kr) { const int row = 64 * t + (tid >> 3), ch = tid & 7; kr = (u32x4){0u, 0u, 0u, 0u}; if (row >= 0 && row < S.nrows) kr = *(const GAS u32x4*)(S.k + (size_t)row * S.pitch + ch * 8); }
__device__ __forceinline__ void v_gload(const KVSrc& S, int t, int tid, u32x4& vr) { const int row = 64 * t + (tid >> 3), ch = tid & 7; vr = (u32x4){0u, 0u, 0u, 0u}; if (row >= 0 && row < S.nrows) vr = *(const GAS u32x4*)(S.v + (size_t)row * S.pitch + ch * 8); }
__device__ __forceinline__ void k_lstore(LAS char* kb, int tid, const u32x4& kr) { const int key = tid >> 3, ch = tid & 7; *(LAS u32x4*)(kb + ch * 1040 + (key >> 5) * 512 + (key & 31) * 16) = kr; }
__device__ __forceinline__ void v_lstore(LAS char* vb, int tid, const u32x4& vr) { const int key = tid >> 3, ch = tid & 7; *(LAS u32x4*)(vb + (ch >> 2) * 4096 + (key >> 4) * 1024 + ((key >> 3) & 1) * 512 + (key & 7) * 64 + (ch & 3) * 16) = vr; }

__device__ __forceinline__ void glds16(const GAS void* gsrc, unsigned lds_dst) { unsigned keep;
    asm volatile("s_mov_b32 %0, m0\n\ts_mov_b32 m0, %2\n\ts_nop 0\n\tglobal_load_lds_dwordx4 %1, off\n\ts_mov_b32 m0, %0" : "=&s"(keep) : "v"(gsrc), "s"(lds_dst) : "memory"); }
__device__ __forceinline__ void tile_dma(const KVSrc& S, int t, unsigned kslot, unsigned vslot, const Lane& L) {
    const GAS bf16_t* ks = S.k + (size_t)(64 * t + L.lane) * S.pitch + L.wid * 8;
    const GAS bf16_t* vs = S.v + (size_t)(64 * t + 16 * (L.wid & 3) + (L.lane >> 2)) * S.pitch + (L.wid >> 2) * 32 + (L.lane & 3) * 8;
    glds16(ks, (unsigned)__builtin_amdgcn_readfirstlane(kslot + L.wid * 1040));
    glds16(vs, (unsigned)__builtin_amdgcn_readfirstlane(vslot + (L.wid >> 2) * 4096 + (L.wid & 3) * 1024));
}
#define ATT_WAIT_BAR(N) asm volatile("s_waitcnt vmcnt(" #N ") lgkmcnt(0)\n\ts_barrier" ::: "memory")
template <class MF>
__device__ __forceinline__ void attend_range(LAS char* lds, const KVSrc& S, int t0, int t1, const MF& mf, const bf16x8 (&qr)[4], float negC, f32x16& ol, f32x16 (&o)[2], const Lane& L, bool abl = false) {
    if (t0 >= t1) return;
    const bool late = L.wid >= 4;
    const unsigned lds0 = (unsigned)(size_t)lds;
    f32x16 negm;
#pragma unroll
    for (int r = 0; r < 16; ++r) negm[r] = negC;
    asm volatile("" : "+v"(negm));
    tile_dma(S, t0, lds0 + L_K0, lds0 + L_V0, L);
    if (t0 + 1 < t1) tile_dma(S, t0 + 1, lds0 + L_K0 + 8320, lds0 + L_V0 + 8192, L);
    if (t0 + 2 < t1) tile_dma(S, t0 + 2, lds0 + L_K0 + 2 * 8320, lds0 + L_V0 + 2 * 8192, L);
    if (t0 + 2 < t1) ATT_WAIT_BAR(4); else if (t0 + 1 < t1) ATT_WAIT_BAR(2); else ATT_WAIT_BAR(0);
    u32x4 pwp[4];
#pragma unroll
    for (int k = 0; k < 4; ++k) asm volatile("" : "=v"(pwp[k]));
    int kcur = 0, vcur = 0, vprev = 0;
    u64 mk_next = mf(t0);
#if defined(PROBE_ABL) && PROBE_ABL == 12
    if (abl) { for (int t = t0; t < t1; ++t) { asm volatile("s_nop 0" ::: "memory"); } return; }
#endif
#if defined(PROBE_ABL) && PROBE_ABL == 13
    if (abl) { for (int t = t0; t < t1; ++t) { ATT_WAIT_BAR(0); } return; }
#endif
#if defined(PROBE_ABL) && PROBE_ABL == 14
    if (abl) { u64 acc_ = 0; for (int t = t0; t < t1; ++t) { acc_ ^= mf(t); asm volatile("s_waitcnt lgkmcnt(0)" : "+v"(acc_) :: "memory"); } asm volatile("" :: "v"(acc_)); return; }
#endif
#if defined(PROBE_ABL) && PROBE_ABL == 15
    if (abl) { for (int t = t0; t < t1; ++t) { f32x16 p0, p1; qk_tile_c(lds + L_K0, qr, negm, p0, p1, L.r32, L.hi); asm volatile("" :: "v"(p0), "v"(p1)); } return; }
#endif
#pragma unroll 1
    for (int t = t0; t < t1; ++t) {
        const u64 mk = mk_next;
        if (t + 1 < t1) mk_next = mf(t + 1);
#if defined(PROBE_ABL) && PROBE_ABL >= 10
        if (t + 3 < t1 && !abl) {
#else
        if (t + 3 < t1) {
#endif
            const int ks = kcur == 0 ? NKB - 1 : kcur - 1; int vs = vcur + 3; vs = vs >= NVB ? vs - NVB : vs;
            tile_dma(S, t + 3, lds0 + L_K0 + ks * 8320, lds0 + L_V0 + vs * 8192, L); }
#if defined(PROBE_ABL) && (PROBE_ABL == 6 || PROBE_ABL >= 10)
        if (late && t > t0 && !abl) pv_tile(lds + L_V0 + vprev * 8192, pwp, o, ol, L.lane, L.hi);
#else
        if (late && t > t0) pv_tile(lds + L_V0 + vprev * 8192, pwp, o, ol, L.lane, L.hi);
#endif
        f32x16 p0, p1;
#if defined(PROBE_ABL) && (PROBE_ABL == 6 || PROBE_ABL >= 10)
        if (abl) { p0 = negm; p1 = negm; asm volatile("" : "+v"(p0), "+v"(p1)); } else
#endif
        qk_tile_c(lds + L_K0 + kcur * 8320, qr, negm, p0, p1, L.r32, L.hi);
        u32x4 pw[4];
#if defined(PROBE_ABL) && (PROBE_ABL == 2 || PROBE_ABL >= 10)
        if (abl) {
#pragma unroll
            for (int k = 0; k < 4; ++k) pw[k] = (u32x4){__float_as_uint(p0[4 * k]) ^ (unsigned)mk, __float_as_uint(p0[4 * k + 1]), __float_as_uint(p1[4 * k + 2]), __float_as_uint(p1[4 * k + 3])}; }
        else
#endif
        mask_exp_pack(p0, p1, mk, L.hi, pw);
#if defined(PROBE_ABL) && (PROBE_ABL == 6 || PROBE_ABL >= 10)
        if (!late && !abl) pv_tile(lds + L_V0 + vcur * 8192, pw, o, ol, L.lane, L.hi);
        else if (!late) { asm volatile("" :: "v"(pw[0]), "v"(pw[1]), "v"(pw[2]), "v"(pw[3])); }
#else
        if (!late) pv_tile(lds + L_V0 + vcur * 8192, pw, o, ol, L.lane, L.hi);
#endif
        else {
#pragma unroll
            for (int k = 0; k < 4; ++k) pwp[k] = pw[k]; }
#if defined(PROBE_ABL) && PROBE_ABL == 11
        if (abl) { asm volatile("s_waitcnt lgkmcnt(0)" ::: "memory"); } else
#endif
        if (t + 3 < t1) ATT_WAIT_BAR(4); else if (t + 2 < t1) ATT_WAIT_BAR(2); else ATT_WAIT_BAR(0);
        vprev = vcur; vcur = vcur == NVB - 1 ? 0 : vcur + 1; kcur = kcur == NKB - 1 ? 0 : kcur + 1;
    }
    if (late) pv_tile(lds + L_V0 + vprev * 8192, pwp, o, ol, L.lane, L.hi);
    ATT_WAIT_BAR(0);
}
__device__ __forceinline__ void rows_to_regs(LAS float* wsf, float v, int r32, int hi, float (&sc)[16]) {
    asm volatile("s_waitcnt lgkmcnt(0)" ::: "memory");
    if (hi == 0) wsf[r32] = v;
    asm volatile("s_waitcnt lgkmcnt(0)" ::: "memory");
#pragma unroll
    for (int r = 0; r < 16; ++r) sc[r] = wsf[crow(r, hi)];
}
__device__ __forceinline__ void load_q(const bf16_t* qrow, int hi, bf16x8 (&qr)[4]) {
#pragma unroll
    for (int d0 = 0; d0 < 4; ++d0) qr[d0] = *(const GAS bf16x8*)(qrow + d0 * 16 + hi * 8);
}
template <class RowPtr>
__device__ __forceinline__ void store_o(LAS char* stage, const f32x16 (&acc)[2], const RowPtr& rowptr, int lane, int r32, int hi) {
    LAS bf16_t* stg = (LAS bf16_t*)stage;
#pragma unroll
    for (int r = 0; r < 16; ++r) { const int orow = crow(r, hi);
#pragma unroll
        for (int d0 = 0; d0 < 2; ++d0) stg[orow * 64 + d0 * 32 + r32] = (bf16_t)(pk2(acc[d0][r], 0.f) & 0xffffu); }
    asm volatile("s_waitcnt lgkmcnt(0)" ::: "memory");
#pragma unroll
    for (int i = 0; i < 4; ++i) { const int row = i * 8 + (lane >> 3), ch = lane & 7; const u32x4 v = *(LAS const u32x4*)(stg + row * 64 + ch * 8); *(GAS u32x4*)(rowptr(row) + ch * 8) = v; }
    asm volatile("s_waitcnt lgkmcnt(0)" ::: "memory");
}
}

constexpr int NWAVES = 8;
constexpr int BATCH = 4, SEQ = 4096, DM = 1024, DFF = 4096, DEPTH = 2, D_IN = 6236;
constexpr int M = BATCH * SEQ;
constexpr size_t MiB = 1u << 20;
constexpr size_t WS_ZQ = 0;
constexpr size_t WS_ZKV = 48 * MiB;
constexpr size_t WS_YS = WS_ZKV;
constexpr size_t WS_MB = 104 * MiB;
constexpr size_t WS_KC2 = WS_MB, WS_VC2 = WS_MB + 4 * MiB;
constexpr size_t WS_XB = 136 * MiB;
constexpr size_t WS_W = 168 * MiB, W_LAYER = 36 * MiB;
constexpr size_t W_IN = 0, W_G = 7 * MiB, W_BR = 13 * MiB, W_OUT = 16 * MiB, W_UP = 18 * MiB, W_DN = 26 * MiB, W_CK1 = 34 * MiB, W_CV1 = 35 * MiB;
constexpr size_t WS_BM = 240 * MiB;
constexpr size_t WS_MISC = 248 * MiB;
constexpr size_t WS_CTL = WS_MISC, CTL_BYTES = 1 * MiB;
constexpr size_t WS_COS = WS_MISC + 1 * MiB, WS_SIN = WS_MISC + 1 * MiB + 512 * 1024;
constexpr size_t WS_KCMP = WS_MISC + 2 * MiB;
constexpr size_t WS_SSQ = WS_MISC + 2 * MiB + 512 * 1024;
constexpr size_t WS_B1P = WS_MISC + 3 * MiB + 512 * 1024;
constexpr size_t WS_W2 = WS_B1P + 64 * 1024;
constexpr size_t WS_HMID = 0;
constexpr size_t WS_END = 256 * MiB;
constexpr int CW_BAR = 4096, CW_Q = 8192, CW_KMAX = 12288;
constexpr int LDS_BYTES = 163840, LDS_UNIT = 163776;
constexpr float C2 = 0.125f * 1.4426950408889634f, LOG2E = 1.4426950408889634f;


struct Args { const float* in[17]; float* out; unsigned char* ws; };
struct Frame {
    LAS unsigned char* lds;
    gu32* ctl;
    int tid, lane, wave, G, gw, NGW;
    unsigned char* ws;
    const struct Args* a;
};
__device__ __forceinline__ float wave_sum(float v) {
#pragma unroll
    for (int o = 1; o < 64; o <<= 1) v += __shfl_xor(v, o);
    return v;
}
__device__ __forceinline__ float wave_max(float v) {
#pragma unroll
    for (int o = 1; o < 64; o <<= 1) v = fmaxf(v, __shfl_xor(v, o));
    return v;
}
__device__ __forceinline__ float bf2f(bf16 h) { return __uint_as_float((unsigned)h << 16); }
__device__ __constant__ float c_inv_freq[32] = {
    1.0f, 0.7498942093324559f, 0.5623413251903491f, 0.4216965034285822f, 0.31622776601683794f, 0.23713737056616552f, 0.1778279410038923f, 0.1333521432163324f,
    0.1f, 0.07498942093324558f, 0.05623413251903491f, 0.042169650342858224f, 0.03162277660168379f, 0.023713737056616554f, 0.01778279410038923f, 0.01333521432163324f,
    0.01f, 0.007498942093324558f, 0.005623413251903491f, 0.004216965034285823f, 0.0031622776601683794f, 0.0023713737056616554f, 0.0017782794100389228f, 0.001333521432163324f,
    0.001f, 0.0007498942093324559f, 0.0005623413251903491f, 0.00042169650342858224f, 0.00031622776601683794f, 0.00023713737056616554f, 0.00017782794100389227f, 0.0001333521432163324f};

__device__ __forceinline__ int mix_src_col(int j) {
    if (j < 512) return j;
    if (j < 1024) return 1092 + (j - 512);
    if (j < 1536) return 1860 + (j - 1024);
    if (j < 1792) return 512 + (j - 1536);
    if (j < 2048) return 1604 + (j - 1792);
    if (j < 2304) return 2372 + (j - 2048);
    if (j < 2560) return 2628 + (j - 2304);
    if (j < 2816) return 2884 + (j - 2560);
    if (j < 3072) return 768 + (j - 2816);
    const int r = j - 3072;
    if (r < 64) return 1024 + r;
    if (r < 68) return 1088 + (r - 64);
    if (r < 92) return 3140 + (r - 68);
    return -1;
}
template <int MODE>
__device__ __forceinline__ void p0_item(const float* W, int ldw, int K, bf16* WT, int nblk, int item, const float* gain, int coff, LAS float* scr, int lane) {
    const int kb = item / nblk, nb = item % nblk, k0 = 64 * kb, n0 = 32 * nb;
    const int nq = 4 * (lane & 7), rr = lane >> 3;
    const int sc = MODE == 0 ? (n0 + nq + coff) : mix_src_col(n0 + nq);
    f32x4 v[8];
#pragma unroll
    for (int i = 0; i < 8; ++i) { v[i] = (f32x4){0.f, 0.f, 0.f, 0.f}; if (sc >= 0) v[i] = *(const GAS f32x4*)(W + (size_t)(k0 + 8 * i + rr) * ldw + sc); }
#pragma unroll
    for (int i = 0; i < 8; ++i) { const int kk = 8 * i + rr; const float g = gain ? gain[k0 + kk] : 1.0f;
        scr[kk * 33 + nq + 0] = v[i][0] * g; scr[kk * 33 + nq + 1] = v[i][1] * g; scr[kk * 33 + nq + 2] = v[i][2] * g; scr[kk * 33 + nq + 3] = v[i][3] * g; }
    LDS_WAIT(); asm volatile("" ::: "memory");
    const int c = lane & 7;
#pragma unroll
    for (int j = 0; j < 4; ++j) { const int n = (lane >> 3) + 8 * j; const LAS float* s = scr + (8 * c) * 33 + n;
        v4u o; o.x = pk2(s[0 * 33], s[1 * 33]); o.y = pk2(s[2 * 33], s[3 * 33]); o.z = pk2(s[4 * 33], s[5 * 33]); o.w = pk2(s[6 * 33], s[7 * 33]);
        *(GAS v4u*)(WT + (size_t)(n0 + n) * K + k0 + 8 * c) = o; }
    LDS_WAIT(); asm volatile("" ::: "memory");
}
__device__ __forceinline__ void p0_prologue(Frame& F) {
    LAS float* scr = (LAS float*)(F.lds + F.wave * 16384);
    constexpr int I_IN = 16 * 104, I_G = 16 * 96, I_BR = 8 * 32, I_OUT = 16 * 32, I_UP = 16 * 128, I_DN = 64 * 32, I_C1 = 32 * 8, I_C2 = 4 * 2;
    constexpr int PER_LAYER = I_IN + I_G + 3 * I_BR + I_OUT + I_UP + I_DN + 2 * I_C1 + 2 * I_C2;
    for (int it = F.gw; it < 2 * PER_LAYER; it += F.NGW) {
        const int l = it / PER_LAYER; int r = it % PER_LAYER;
        unsigned char* wl = F.ws + WS_W + (size_t)l * W_LAYER;
        const float* w_in = F.a->in[2] + (size_t)l * DM * D_IN;
        if (r < I_IN) { p0_item<1>(w_in, D_IN, DM, (bf16*)(wl + W_IN), 104, r, F.a->in[1] + l * DM, 0, scr, F.lane); continue; } r -= I_IN;
        if (r < I_G) { p0_item<0>(w_in, D_IN, DM, (bf16*)(wl + W_G), 96, r, F.a->in[1] + l * DM, 3164, scr, F.lane); continue; } r -= I_G;
        if (r < 3 * I_BR) { const int n = r / I_BR; p0_item<0>(F.a->in[12] + ((size_t)l * 3 + n) * 512 * DM, DM, 512, (bf16*)(wl + W_BR) + (size_t)n * DM * 512, 32, r % I_BR, nullptr, 0, scr, F.lane); continue; } r -= 3 * I_BR;
        if (r < I_OUT) { p0_item<0>(F.a->in[13] + (size_t)l * DM * DM, DM, DM, (bf16*)(wl + W_OUT), 32, r, nullptr, 0, scr, F.lane); continue; } r -= I_OUT;
        if (r < I_UP) { p0_item<0>(F.a->in[15] + (size_t)l * DM * DFF, DFF, DM, (bf16*)(wl + W_UP), 128, r, F.a->in[14] + l * DM, 0, scr, F.lane); continue; } r -= I_UP;
        if (r < I_DN) { p0_item<0>(F.a->in[16] + (size_t)l * DFF * DM, DM, DFF, (bf16*)(wl + W_DN), 32, r, nullptr, 0, scr, F.lane); continue; } r -= I_DN;
        if (r < I_C1) { p0_item<0>(F.a->in[8] + (size_t)l * 2048 * 256, 256, 2048, (bf16*)(wl + W_CK1), 8, r, nullptr, 0, scr, F.lane); continue; } r -= I_C1;
        if (r < I_C1) { p0_item<0>(F.a->in[10] + (size_t)l * 2048 * 256, 256, 2048, (bf16*)(wl + W_CV1), 8, r, nullptr, 0, scr, F.lane); continue; } r -= I_C1;
        if (r < I_C2) { p0_item<0>(F.a->in[9] + (size_t)l * 256 * 64, 64, 256, (bf16*)(F.ws + WS_W2) + (size_t)(l * 2 + 0) * 64 * 256, 2, r, nullptr, 0, scr, F.lane); continue; } r -= I_C2;
        p0_item<0>(F.a->in[11] + (size_t)l * 256 * 64, 64, 256, (bf16*)(F.ws + WS_W2) + (size_t)(l * 2 + 1) * 64 * 256, 2, r, nullptr, 0, scr, F.lane);
    }
    for (int it = F.gw; it < 128; it += F.NGW) {
        const int kp = it & 7, jb = (it >> 3) & 3, which = (it >> 5) & 1, l = it >> 6; const int j = jb * 64 + F.lane;
        const float* pe = (which ? F.a->in[7] : F.a->in[6]) + l * 2048; const float* w1 = (which ? F.a->in[10] : F.a->in[8]) + (size_t)l * 2048 * 256;
        float a = 0.f;
        for (int k = kp * 256; k < kp * 256 + 256; ++k) a = fmaf(pe[k], w1[(size_t)k * 256 + j], a);
        ((float*)(F.ws + WS_B1P))[((l * 2 + which) * 8 + kp) * 256 + j] = a;
    }
    for (int m = F.gw; m < M; m += F.NGW) {
        const GAS f32x4* xr = (const GAS f32x4*)(F.a->in[0] + (size_t)m * DM) + F.lane;
        GAS unsigned long long* o8 = (GAS unsigned long long*)((bf16*)(F.ws + WS_XB) + (size_t)m * DM) + F.lane;
        float s = 0.f;
#pragma unroll
        for (int j = 0; j < 4; ++j) { const f32x4 v = xr[64 * j]; s += (v.x * v.x + v.y * v.y) + (v.z * v.z + v.w * v.w);
            o8[64 * j] = (unsigned long long)pk2(v.x, v.y) | ((unsigned long long)pk2(v.z, v.w) << 32); }
        s = wave_sum(s);
        if (F.lane < 16) ((float*)(F.ws + WS_SSQ))[(size_t)m * 16 + F.lane] = F.lane == 0 ? s : 0.f;
    }
    for (int i = F.gw * 64 + F.lane; i < SEQ * 32; i += F.NGW * 64) {
        const float ang = (float)(i >> 5) * c_inv_freq[i & 31];
        ((float*)(F.ws + WS_COS))[i] = (float)cos((double)ang); ((float*)(F.ws + WS_SIN))[i] = (float)sin((double)ang);
    }
}
typedef unsigned u32x4_t __attribute__((ext_vector_type(4)));
__device__ __forceinline__ void post_group(u32x4_t raw, bool act, bool norm, bool rope, const float (&gain)[8], float scale, const float (&cs)[8], const float (&sn)[8], int lane, bf16* dst) {
    float v[8];
    v[0] = __uint_as_float(raw.x << 16); v[1] = __uint_as_float(raw.x & 0xffff0000u); v[2] = __uint_as_float(raw.y << 16); v[3] = __uint_as_float(raw.y & 0xffff0000u);
    v[4] = __uint_as_float(raw.z << 16); v[5] = __uint_as_float(raw.z & 0xffff0000u); v[6] = __uint_as_float(raw.w << 16); v[7] = __uint_as_float(raw.w & 0xffff0000u);
    float ss = ((v[0] * v[0] + v[1] * v[1]) + (v[2] * v[2] + v[3] * v[3])) + ((v[4] * v[4] + v[5] * v[5]) + (v[6] * v[6] + v[7] * v[7]));
    ss += __shfl_xor(ss, 1); ss += __shfl_xor(ss, 2); ss += __shfl_xor(ss, 4);
    const float rs = norm ? rsqrtf(ss * (1.0f / 64.0f) + 1e-6f) : 1.0f;
    const bool lo = (lane & 4) == 0;
    float r[8];
#pragma unroll
    for (int j = 0; j < 8; ++j) { const float x = norm ? v[j] * rs * gain[j] : v[j]; const float o = __shfl_xor(x, 4);
        r[j] = rope ? (lo ? (x * cs[j] - o * sn[j]) : (x * cs[j] + o * sn[j])) : x; r[j] *= scale; }
    if (act) { u32x4_t w; w.x = pk2(r[0], r[1]); w.y = pk2(r[2], r[3]); w.z = pk2(r[4], r[5]); w.w = pk2(r[6], r[7]); *(GAS u32x4_t*)dst = w; }
}
__device__ __forceinline__ void post_phase(Frame& F, int l, bool dry = false) {
    const float* qn = F.a->in[3] + l * 192; const float* kn = F.a->in[4] + l * 192;
    const int lane = F.lane, g = lane >> 3, c = lane & 7;
    float gq0[8], gq1[8], gq2[8], gk3[8], gk2[8];
#pragma unroll
    for (int j = 0; j < 8; ++j) { gq0[j] = qn[8 * c + j]; gq1[j] = qn[64 + 8 * c + j]; gq2[j] = qn[128 + 8 * c + j]; gk2[j] = kn[128 + 8 * c + j];
        gk3[j] = (g >> 1) == 0 ? kn[8 * c + j] : ((g >> 1) == 1 ? kn[64 + 8 * c + j] : kn[128 + 8 * c + j]); }
    bf16* zq = (bf16*)(F.ws + WS_ZQ); bf16* zkv = (bf16*)(F.ws + WS_ZKV);
    const float* cst = (const float*)(F.ws + WS_COS); const float* snt = (const float*)(F.ws + WS_SIN);
#pragma unroll 1
    for (int m = F.gw; m < M; m += F.NGW) {
        const int t = m & (SEQ - 1), b = m >> 12;
        float cs[8], sn[8];
        { const GAS f32x4* cp = (const GAS f32x4*)(cst + t * 32 + 8 * (c & 3)); const GAS f32x4* sp = (const GAS f32x4*)(snt + t * 32 + 8 * (c & 3));
          const f32x4 c0 = cp[0], c1 = cp[1], s0 = sp[0], s1 = sp[1];
          cs[0] = c0[0]; cs[1] = c0[1]; cs[2] = c0[2]; cs[3] = c0[3]; cs[4] = c1[0]; cs[5] = c1[1]; cs[6] = c1[2]; cs[7] = c1[3];
          sn[0] = s0[0]; sn[1] = s0[1]; sn[2] = s0[2]; sn[3] = s0[3]; sn[4] = s1[0]; sn[5] = s1[1]; sn[6] = s1[2]; sn[7] = s1[3]; }
        bf16* pqa = zq + (size_t)m * 512 + lane * 8; bf16* pqb = pqa + (size_t)M * 512; bf16* pqc = pqa + (size_t)2 * M * 512;
        const int t3 = (g >> 1) < 2 ? (g >> 1) : (g >> 1) + 1;
        bf16* p3 = zkv + (size_t)t3 * M * 256 + (size_t)m * 256 + (g & 1) * 64 + c * 8;
        const bf16* s4 = g < 4 ? zkv + (size_t)2 * M * 256 + (size_t)m * 256 + g * 64 + c * 8 : zkv + (size_t)5 * M * 256 + (size_t)m * 256 + (g - 4) * 64 + c * 8;
        bf16* d4 = g < 2 ? (bf16*)(F.ws + WS_KC2) + ((size_t)(b * 2 + g) * SEQ + t) * 64 + c * 8
                 : (g < 4 ? (bf16*)(F.ws + WS_VC2) + ((size_t)(b * 2 + (g - 2)) * SEQ + t) * 64 + c * 8 : (bf16*)s4);
        bf16* p5 = zkv + (size_t)6 * M * 256 + (size_t)m * 256 + c * 8;
        const u32x4_t r0 = *(const GAS u32x4_t*)pqa, r1 = *(const GAS u32x4_t*)pqb, r2 = *(const GAS u32x4_t*)pqc, r3 = *(const GAS u32x4_t*)p3, r4 = *(const GAS u32x4_t*)s4;
        u32x4_t r5 = {0u, 0u, 0u, 0u}; if (g == 0) r5 = *(const GAS u32x4_t*)p5;
        post_group(r0, !dry, true, true, gq0, C2, cs, sn, lane, pqa);
        post_group(r1, !dry, true, true, gq1, C2, cs, sn, lane, pqb);
        post_group(r2, !dry, true, true, gq2, C2, cs, sn, lane, pqc);
        post_group(r3, !dry, true, true, gk3, 1.f, cs, sn, lane, p3);
        post_group(r4, !dry, g < 2, g < 2 || g >= 4, gk2, 1.f, cs, sn, lane, d4);
        post_group(r5, g == 0 && !dry, false, true, gk2, 1.f, cs, sn, lane, p5);
    }
}

#define WAVE_LDS_FENCE() asm volatile("s_waitcnt lgkmcnt(0)" ::: "memory")
__device__ __forceinline__ int next_unit(Frame& F, gu32* counter) {
    LAS int* slot = (LAS int*)(F.lds + LDS_UNIT);
    __syncthreads();
    if (F.tid == 0) *slot = (int)__hip_atomic_fetch_add(counter, 1u, RLX_AGENT);
    __syncthreads();
    return *slot;
}
__device__ __forceinline__ unsigned f2key(float f) { const unsigned u = __float_as_uint(f); return (u & 0x80000000u) ? ~u : (u | 0x80000000u); }
__device__ __forceinline__ float dpp_quad_sum(float v) {
    v += __int_as_float(__builtin_amdgcn_update_dpp(0, __float_as_int(v), 0xB1, 0xF, 0xF, true));
    v += __int_as_float(__builtin_amdgcn_update_dpp(0, __float_as_int(v), 0x4E, 0xF, 0xF, true));
    return v;
}
__device__ __forceinline__ void select_unit(Frame& F, int b, int qblk) {
    using namespace att;
    const int lane = F.lane, r32 = lane & 31, hi = lane >> 5, w = F.wave;
    LAS unsigned* sc = (LAS unsigned*)F.lds;
    LAS unsigned* hist = (LAS unsigned*)(F.lds + 131072) + w * 256;
    const int t0 = qblk * 8; const size_t m0 = (size_t)b * SEQ + t0;
    const bf16* IQ = (const bf16*)(F.ws + WS_ZKV) + (size_t)5 * M * 256; const bf16* MISC = (const bf16*)(F.ws + WS_ZKV) + (size_t)6 * M * 256;
    u64* BM = (u64*)(F.ws + WS_BM);
    const int nkeys = t0 + 8;
    if (nkeys > 256) {
        bf16x8 iqf[4];
        { const bf16* qrow = IQ + (m0 + (r32 >> 2)) * 256 + (r32 & 3) * 64;
#pragma unroll
          for (int d0 = 0; d0 < 4; ++d0) iqf[d0] = *(const GAS bf16x8*)(qrow + d0 * 16 + hi * 8); }
        const float wl = bf2f(((const GAS bf16*)MISC)[(m0 + (r32 >> 2)) * 256 + 64 + (r32 & 3)]);
        const int ntile = (nkeys + 31) >> 5; const int g = r32 & 3;
        bf16x8 kf[4], kn[4];
        { const bf16* krow = MISC + ((size_t)b * SEQ + w * 32 + r32) * 256;
#pragma unroll
          for (int d0 = 0; d0 < 4; ++d0) kf[d0] = (w < ntile) ? *(const GAS bf16x8*)(krow + d0 * 16 + hi * 8) : (bf16x8){0, 0, 0, 0, 0, 0, 0, 0}; }
#pragma unroll 1
        for (int tile = w; tile < ntile; tile += 8) {
            const int s0 = tile * 32;
            { const bool more = tile + 8 < ntile; const bf16* krow = MISC + ((size_t)b * SEQ + s0 + 256 + r32) * 256;
#pragma unroll
              for (int d0 = 0; d0 < 4; ++d0) kn[d0] = more ? *(const GAS bf16x8*)(krow + d0 * 16 + hi * 8) : (bf16x8){0, 0, 0, 0, 0, 0, 0, 0}; }
            f32x16 acc;
#pragma unroll
            for (int r = 0; r < 16; ++r) acc[r] = 0.f;
#pragma unroll
            for (int d0 = 0; d0 < 4; ++d0) acc = __builtin_amdgcn_mfma_f32_32x32x16_bf16(kf[d0], iqf[d0], acc, 0, 0, 0);
            float v[16];
#pragma unroll
            for (int r = 0; r < 16; ++r) v[r] = dpp_quad_sum(fmaxf(acc[r], 0.f) * wl);
            u32x4 o;
#pragma unroll
            for (int j = 0; j < 4; ++j) o[j] = f2key(g == 0 ? v[j] : (g == 1 ? v[4 + j] : (g == 2 ? v[8 + j] : v[12 + j])));
            *(LAS u32x4*)(sc + (r32 >> 2) * 4096 + s0 + 8 * g + 4 * hi) = o;
#pragma unroll
            for (int d0 = 0; d0 < 4; ++d0) kf[d0] = kn[d0];
        }
    }
    __syncthreads();
    {
        const int t = t0 + w, n = t + 1; LAS unsigned* row = sc + w * 4096;
        u64 myword = 0ull;
        if (n <= 256) {
            const int c0 = 64 * lane;
            myword = (c0 + 63 < n) ? ~0ull : (c0 >= n ? 0ull : ((1ull << (n - c0)) - 1ull));
        } else {
            const int nblk = (n + 255) >> 8;
            { const int s = (n & ~3) + lane * 4;
              if (s < nblk * 256) { u32x4 v = *(LAS u32x4*)(row + s);
#pragma unroll
                  for (int c = 0; c < 4; ++c) if (s + c >= n) v[c] = 0u;
                  *(LAS u32x4*)(row + s) = v; } }
            WAVE_LDS_FENCE();
            unsigned prefix = 0u; int kk = 256;
#pragma unroll 1
            for (int pass = 0; pass < 4; ++pass) {
                const int shift = 24 - 8 * pass;
#pragma unroll
                for (int i = 0; i < 4; ++i) hist[lane * 4 + i] = 0u;
                WAVE_LDS_FENCE();
#pragma unroll 2
                for (int jb = 0; jb < nblk; ++jb) { const u32x4 v = *(LAS const u32x4*)(row + jb * 256 + lane * 4);
#pragma unroll
                    for (int c = 0; c < 4; ++c) { const unsigned key = v[c];
                        if (pass == 0 || (key >> (shift + 8)) == prefix) __hip_atomic_fetch_add(&hist[(key >> shift) & 255u], 1u, __ATOMIC_RELAXED, __HIP_MEMORY_SCOPE_WORKGROUP); } }
                WAVE_LDS_FENCE();
                const unsigned h0 = hist[lane * 4], h1 = hist[lane * 4 + 1], h2 = hist[lane * 4 + 2], h3 = hist[lane * 4 + 3];
                int suf = (int)(h0 + h1 + h2 + h3);
#pragma unroll
                for (int o = 1; o < 64; o <<= 1) { const int tt = __shfl_down(suf, o); if (lane + o < 64) suf += tt; }
                const int above = suf - (int)(h0 + h1 + h2 + h3);
                const int a3 = above, a2 = a3 + (int)h3, a1 = a2 + (int)h2, a0 = a1 + (int)h1;
                int dsel = -1, nk = 0;
                if (a3 < kk && kk <= a3 + (int)h3) { dsel = lane * 4 + 3; nk = kk - a3; }
                else if (a2 < kk && kk <= a2 + (int)h2) { dsel = lane * 4 + 2; nk = kk - a2; }
                else if (a1 < kk && kk <= a1 + (int)h1) { dsel = lane * 4 + 1; nk = kk - a1; }
                else if (a0 < kk && kk <= a0 + (int)h0) { dsel = lane * 4 + 0; nk = kk - a0; }
                const u64 bal = __ballot(dsel >= 0);
                const int src = (int)__builtin_ctzll(bal);
                dsel = __shfl(dsel, src); nk = __shfl(nk, src);
                WAVE_LDS_FENCE();
                prefix = (prefix << 8) | (unsigned)dsel; kk = nk;
            }
            const unsigned T = prefix; const int need = kk; int base = 0;
            const int nch = (n + 63) >> 6;
#pragma unroll 1
            for (int c = 0; c < nch; c += 4) {
                unsigned vv[4];
#pragma unroll
                for (int u2 = 0; u2 < 4; ++u2) vv[u2] = row[64 * (c + u2) + lane];
#pragma unroll
                for (int u2 = 0; u2 < 4; ++u2) {
                    const int s = 64 * (c + u2) + lane; const bool valid = s < n; const unsigned key = valid ? vv[u2] : 0u;
                    const bool gt = valid && key > T, eq = valid && key == T;
                    const u64 beq = __ballot(eq);
                    const int rank = base + __builtin_popcountll(beq & ((1ull << lane) - 1ull));
                    const u64 word = __ballot(gt || (eq && rank < need));
                    if (lane == c + u2) myword = word;
                    base += __builtin_popcountll(beq);
                }
            }
        }
        ((GAS u64*)BM)[((size_t)b * SEQ + t) * 64 + lane] = myword;
    }
    __syncthreads();
}
__device__ __forceinline__ void compress_unit(Frame& F, int l, int u) {
    using namespace att;
    const int lane = F.lane, r32 = lane & 31, hi = lane >> 5, w = F.wave;
    const int which = u & 1, h = (u >> 1) & 1, b = (u >> 2) & 3, cb = u >> 4;
    const bf16* src = (const bf16*)(F.ws + (which ? WS_VC2 : WS_KC2)) + (size_t)(b * 2 + h) * SEQ * 64;
    const bf16* W1t = (const bf16*)(F.ws + WS_W + (size_t)l * W_LAYER + (which ? W_CV1 : W_CK1));
    const bf16* W2t = (const bf16*)(F.ws + WS_W2) + (size_t)(l * 2 + which) * 64 * 256;
    const float* b1p = (const float*)(F.ws + WS_B1P) + (size_t)(l * 2 + which) * 8 * 256;
    LAS bf16* hid = (LAS bf16*)F.lds;
    int cc = 32 * cb + r32; if (cc > 254) cc = 254;
    const bf16* arow = src + (size_t)(16 * cc) * 64 + hi * 8;
    const bf16* brow = W1t + (size_t)(32 * w + r32) * 2048 + hi * 8;
    f32x16 acc;
#pragma unroll
    for (int r = 0; r < 16; ++r) acc[r] = 0.f;
#pragma unroll 4
    for (int ks = 0; ks < 128; ++ks) { const bf16x8 a = *(const GAS bf16x8*)(arow + ks * 16), bb = *(const GAS bf16x8*)(brow + ks * 16); acc = __builtin_amdgcn_mfma_f32_32x32x16_bf16(a, bb, acc, 0, 0, 0); }
    float b1 = 0.f;
#pragma unroll
    for (int kp = 0; kp < 8; ++kp) b1 += ((const GAS float*)b1p)[kp * 256 + 32 * w + r32];
#pragma unroll
    for (int r = 0; r < 16; ++r) hid[crow(r, hi) * 264 + 32 * w + r32] = (bf16)f2bf(fmaxf(acc[r] + b1, 0.f));
    __syncthreads();
    if (w < 2) {
        f32x16 o;
#pragma unroll
        for (int r = 0; r < 16; ++r) o[r] = 0.f;
        const bf16* w2row = W2t + (size_t)(32 * w + r32) * 256 + hi * 8;
#pragma unroll
        for (int ks = 0; ks < 16; ++ks) { const bf16x8 a = *(LAS const bf16x8*)(hid + r32 * 264 + ks * 16 + hi * 8), bb = *(const GAS bf16x8*)(w2row + ks * 16); o = __builtin_amdgcn_mfma_f32_32x32x16_bf16(a, bb, o, 0, 0, 0); }
        bf16* dst = (bf16*)(F.ws + WS_KCMP) + ((size_t)((which * 4 + b) * 2 + h) * 256) * 64;
        float mx = 0.f;
#pragma unroll
        for (int r = 0; r < 16; ++r) { const int c = 32 * cb + crow(r, hi); const float v = c < 255 ? o[r] : 0.f; mx = fmaxf(mx, fabsf(v)); ((GAS bf16*)dst)[(size_t)c * 64 + 32 * w + r32] = (bf16)f2bf(v); }
        if (which == 0) { mx = wave_max(mx); if (lane == 0) __hip_atomic_fetch_max(F.ctl + CW_KMAX + 64 * (l * 8 + b * 2 + h), __float_as_uint(mx), RLX_AGENT); }
    }
    __syncthreads();
}
struct UnitGeom { int b, kvh, i; att::Lane L; int q; int head; size_t mrow; };
__device__ __forceinline__ UnitGeom unit_geom(Frame& F, int b, int kvh, int i) {
    int tid = F.tid; asm volatile("" : "+v"(tid));
    UnitGeom U; U.b = b; U.kvh = kvh; U.i = i; U.L.tid = tid; U.L.lane = tid & 63; U.L.r32 = tid & 31; U.L.hi = (tid >> 5) & 1; U.L.wid = F.wave;
    U.q = 64 * i + 8 * F.wave + (U.L.r32 >> 2); U.head = 4 * kvh + (U.L.r32 & 3); U.mrow = (size_t)b * SEQ + U.q; return U;
}
__device__ __forceinline__ void branch_finish(LAS float* wsf, const att::f32x16& ol, const float (&extra)[4], float rowscale, bool has_scale, const att::f32x16 (&o)[2], att::f32x16 (&acc)[2], const att::Lane& L, bool first) {
    float sc[16];
    if (has_scale) att::rows_to_regs(wsf, rowscale, L.r32, L.hi, sc);
#pragma unroll
    for (int r = 0; r < 16; ++r) { const float lf = ol[r] + extra[r & 3]; const float inv = lf > 0.f ? __builtin_amdgcn_rcpf(lf) : 0.f; sc[r] = has_scale ? sc[r] * inv : inv; }
#pragma unroll
    for (int d0 = 0; d0 < 2; ++d0)
#pragma unroll
        for (int r = 0; r < 16; ++r) acc[d0][r] = first ? o[d0][r] * sc[r] : acc[d0][r] + o[d0][r] * sc[r];
}
__device__ __forceinline__ void branch_finish_lds(LAS float* wsf, LAS float* accw, const att::f32x16& ol, float rowscale, const att::f32x16 (&o)[2], const att::Lane& L, bool first) {
    float sc[16]; att::rows_to_regs(wsf, rowscale, L.r32, L.hi, sc);
#pragma unroll
    for (int r = 0; r < 16; ++r) sc[r] = ol[r] > 0.f ? sc[r] * __builtin_amdgcn_rcpf(ol[r]) : 0.f;
#pragma unroll
    for (int d0 = 0; d0 < 2; ++d0)
#pragma unroll
        for (int r = 0; r < 16; ++r) { float v = o[d0][r] * sc[r]; if (!first) v += accw[(d0 * 16 + r) * 64 + L.lane]; accw[(d0 * 16 + r) * 64 + L.lane] = v; }
}
__device__ __forceinline__ float gain_bound(const float* g, int lane) { return wave_max(fabsf(g[lane])); }

template <int KIND  >
__device__ __forceinline__ void simple_unit(Frame& F, int l, int b, int kvh, int i, bf16* odst = nullptr) {
    using namespace att;
    const UnitGeom U = unit_geom(F, b, kvh, i); const Lane& L = U.L;
    constexpr int QT = KIND == 0 ? 1 : 0, KT = KIND == 0 ? 1 : 0, NM = KIND == 0 ? 1 : 0;
    bf16* Q = (bf16*)(F.ws + WS_ZQ) + (size_t)QT * M * 512; const bf16* KV = (const bf16*)(F.ws + WS_ZKV) + (size_t)KT * M * 256;
    bf16x8 qr[4]; load_q(Q + U.mrow * 512 + U.head * 64, L.hi, qr);
    const float C = 8.f * gain_bound(F.a->in[3] + l * 192 + NM * 64, L.lane) * gain_bound(F.a->in[4] + l * 192 + NM * 64, L.lane) * LOG2E;
    KVSrc S{(const GAS bf16*)(KV + (size_t)b * SEQ * 256 + kvh * 64), (const GAS bf16*)(KV + (size_t)b * SEQ * 256 + 128 + kvh * 64), 256, SEQ};
    f32x16 ol, o[2];
#pragma unroll
    for (int r = 0; r < 16; ++r) { o[0][r] = 0.f; o[1][r] = 0.f; ol[r] = 0.f; }
    const int q = U.q;
    float extra[4] = {0.f, 0.f, 0.f, 0.f};
    if (KIND == 0) {
        auto mf = [q](int t) -> u64 { return mask_le(q - 64 * t) & mask_ge(q - 127 - 64 * t); };
        attend_range((LAS char*)F.lds, S, i - 2 < 0 ? 0 : i - 2, i + 1, mf, qr, -C, ol, o, L);
#pragma unroll
        for (int g = 0; g < 4; ++g) extra[g] = __builtin_amdgcn_exp2f(F.a->in[5][l * 8 + 4 * kvh + g] * LOG2E - C);
    } else {
        LAS char* mrows = (LAS char*)F.lds + L_OST + L.wid * 8192 + 4096;
        { const GAS u32x4* src = (const GAS u32x4*)((const GAS u64*)(F.ws + WS_BM) + ((size_t)b * SEQ + 64 * i + 8 * L.wid) * 64);
#pragma unroll
          for (int k = 0; k < 4; ++k) *(LAS u32x4*)(mrows + (k * 64 + L.lane) * 16) = src[k * 64 + L.lane];
          WAVE_LDS_FENCE(); }
        LAS const char* mrow = mrows + (L.r32 >> 2) * 512;
        auto mf = [mrow](int t) -> u64 { return *(LAS const u64*)(mrow + t * 8); };
#ifdef PROBE_TILES
        attend_range((LAS char*)F.lds, S, 0, odst ? (i + 1 < PROBE_TILES ? i + 1 : PROBE_TILES) : i + 1, mf, qr, -C, ol, o, L, odst != nullptr);
#else
        attend_range((LAS char*)F.lds, S, 0, i + 1, mf, qr, -C, ol, o, L, odst != nullptr);
#endif
    }
    f32x16 acc[2];
    branch_finish((LAS float*)((LAS char*)F.lds + L_WSF) + L.wid * 64, ol, extra, 1.f, false, o, acc, L, true);
    const size_t tok0 = (size_t)b * SEQ + 64 * i + 8 * L.wid; const int kvh4 = 4 * kvh;
    bf16* Od = odst ? odst : Q;
    auto rowptr = [Od, tok0, kvh4](int row) -> bf16* { return Od + (tok0 + (row >> 2)) * 512 + (kvh4 + (row & 3)) * 64; };
    store_o((LAS char*)F.lds + L_OST + L.wid * 8192, acc, rowptr, L.lane, L.r32, L.hi);
}
__device__ __forceinline__ void nsa_unit(Frame& F, int l, int b, int kvh, int i, bf16* odst = nullptr) {
    using namespace att;
    const UnitGeom U = unit_geom(F, b, kvh, i); const Lane& L = U.L;
    bf16* Q = (bf16*)(F.ws + WS_ZQ) + (size_t)2 * M * 512; const bf16* KVbase = (const bf16*)(F.ws + WS_ZKV);
    const bf16* MISC = KVbase + (size_t)6 * M * 256;
    bf16x8 qr[4]; load_q(Q + U.mrow * 512 + U.head * 64, L.hi, qr);
    const float gqm = gain_bound(F.a->in[3] + l * 192 + 128, L.lane), gkm = gain_bound(F.a->in[4] + l * 192 + 128, L.lane);
    const float Ck = 8.f * gqm * gkm * LOG2E;
    const float kmax = __uint_as_float(__hip_atomic_load(F.ctl + CW_KMAX + 64 * (l * 8 + b * 2 + kvh), RLX_AGENT));
    const float Cc = 8.f * gqm * kmax * LOG2E;
    float gs[3];
#pragma unroll
    for (int br = 0; br < 3; ++br) gs[br] = pg8::sigmoidf_(bf2f(((const GAS bf16*)MISC)[U.mrow * 256 + 68 + U.head * 3 + br]));
    LAS float* wsf = (LAS float*)((LAS char*)F.lds + L_WSF) + L.wid * 64;
    const int q = U.q;
    f32x16 o[2];
    LAS float* accw = (LAS float*)((LAS char*)F.lds + L_OST + L.wid * 8192);
    const int nval = q >= 31 ? (((q - 31) >> 4) + 1 < 255 ? ((q - 31) >> 4) + 1 : 255) : 0;
    const int qmax = 64 * i + 63; const int nvmax = qmax >= 31 ? (((qmax - 31) >> 4) + 1 < 255 ? ((qmax - 31) >> 4) + 1 : 255) : 0;
    const int tc = (nvmax + 63) >> 6;
    const bf16* kcmp = (const bf16*)(F.ws + WS_KCMP) + (size_t)((0 * 4 + b) * 2 + kvh) * 256 * 64; const bf16* vcmp = (const bf16*)(F.ws + WS_KCMP) + (size_t)((1 * 4 + b) * 2 + kvh) * 256 * 64;
    KVSrc Sc{(const GAS bf16*)kcmp, (const GAS bf16*)vcmp, 64, 256};
    auto mfc = [nval](int t) -> u64 { return mask_le(nval - 1 - 64 * t); };
    f32x16 ol;
#pragma unroll
    for (int r = 0; r < 16; ++r) { o[0][r] = 0.f; o[1][r] = 0.f; ol[r] = 0.f; }
    attend_range((LAS char*)F.lds, Sc, 0, tc, mfc, qr, -Cc, ol, o, L);
    WAVE_LDS_FENCE();
    if (L.r32 == 0) {
#pragma unroll
        for (int r = 0; r < 16; ++r) wsf[32 + crow(r, L.hi)] = ol[r]; }
    WAVE_LDS_FENCE();
    const float lc = wsf[32 + L.r32]; const float rlc = lc > 0.f ? __builtin_amdgcn_rcpf(lc) : 0.f;
    branch_finish_lds(wsf, accw, ol, gs[0], o, L, true);
    LAS float* impw = (LAS float*)((LAS char*)F.lds + L_IMP) + L.wid * 512;
#pragma unroll
    for (int k = 0; k < 8; ++k) impw[L.lane + 64 * k] = 0.f;
    WAVE_LDS_FENCE();
    for (int t = 0; t < tc; ++t) {
        u32x4 kr, vr; tile_gload(Sc, t, L.tid, kr, vr);
        tile_lstore((LAS char*)F.lds + L_K0, (LAS char*)F.lds + L_V0, L.tid, kr, vr);
        __syncthreads();
        f32x16 p0, p1;
#pragma unroll
        for (int r = 0; r < 16; ++r) { p0[r] = -Cc; p1[r] = -Cc; }
        qk_tile((LAS char*)F.lds + L_K0, qr, p0, p1, L.r32, L.hi);
        const u64 mk = mfc(t); const unsigned m0 = (unsigned)(mk >> (4 * L.hi)), m1 = (unsigned)(mk >> (32 + 4 * L.hi));
        const int qloc = L.r32 >> 2; const bool wr = (L.r32 & 3) == 0;
#pragma unroll
        for (int half = 0; half < 2; ++half)
#pragma unroll
            for (int m = 0; m < 4; ++m) {
                float e[4];
#pragma unroll
                for (int k = 0; k < 4; ++k) { const int r = 4 * m + k, bit = k + 8 * m; const float x = half ? p1[r] : p0[r]; const unsigned mm = half ? m1 : m0;
                    e[k] = ((mm >> bit) & 1u) ? __builtin_amdgcn_exp2f(x) * rlc : 0.f; }
                const float core = dpp_quad_sum((e[0] + e[1]) + (e[2] + e[3])), edge = dpp_quad_sum(e[3]);
                const int j = 16 * t + 8 * half + 2 * m + L.hi;
                if (wr) { impw[qloc * 64 + j] += core; }
                WAVE_LDS_FENCE();
                if (wr && j + 1 < 64) { impw[qloc * 64 + j + 1] += edge; }
                WAVE_LDS_FENCE();
            }
        __syncthreads();
    }
    {
        const int qloc = L.lane >> 3, sub = L.lane & 7; const int cur = i;
        u64 keys[8];
#pragma unroll
        for (int k = 0; k < 8; ++k) { const int j = sub + 8 * k; float v = impw[qloc * 64 + j];
            if (j == 0 || j == cur || j == cur - 1) v = 1e9f;
            if (j > cur) v = -1e30f;
            keys[k] = ((u64)f2key(v) << 32) | (u64)(63 - j); }
        u64 selm = 0ull; unsigned used = 0u;
#pragma unroll 1
        for (int it = 0; it < 16; ++it) {
            u64 best = 0ull;
#pragma unroll
            for (int k = 0; k < 8; ++k) { const u64 c = ((used >> k) & 1u) ? 0ull : keys[k]; best = c > best ? c : best; }
#pragma unroll
            for (int o2 = 1; o2 < 8; o2 <<= 1) { const unsigned lo = __shfl_xor((unsigned)best, o2), hi2 = __shfl_xor((unsigned)(best >> 32), o2); const u64 ob = ((u64)hi2 << 32) | lo; best = ob > best ? ob : best; }
            const int jsel = 63 - (int)(best & 63ull);
            if ((jsel & 7) == sub) used |= 1u << (jsel >> 3);
            selm |= 1ull << jsel;
        }
        LAS u64* selw = (LAS u64*)((LAS char*)F.lds + L_SEL) + L.wid * 8;
        if (sub == 0) selw[qloc] = selm;
        WAVE_LDS_FENCE();
    }
    const u64 sel = ((LAS const u64*)((LAS char*)F.lds + L_SEL))[L.wid * 8 + (L.r32 >> 2)];
    {
        const bf16* KV = KVbase + (size_t)3 * M * 256;
        KVSrc S{(const GAS bf16*)(KV + (size_t)b * SEQ * 256 + kvh * 64), (const GAS bf16*)(KV + (size_t)b * SEQ * 256 + 128 + kvh * 64), 256, SEQ};
        auto mf = [sel, q](int t) -> u64 { return ((sel >> t) & 1ull) ? mask_le(q - 64 * t) : 0ull; };
#pragma unroll
        for (int r = 0; r < 16; ++r) { o[0][r] = 0.f; o[1][r] = 0.f; ol[r] = 0.f; }
        attend_range((LAS char*)F.lds, S, 0, i + 1, mf, qr, -Ck, ol, o, L);
        branch_finish_lds(wsf, accw, ol, gs[1], o, L, false);
    }
    {
        const bf16* KV = KVbase + (size_t)4 * M * 256;
        KVSrc S{(const GAS bf16*)(KV + (size_t)b * SEQ * 256 + kvh * 64), (const GAS bf16*)(KV + (size_t)b * SEQ * 256 + 128 + kvh * 64), 256, SEQ};
        auto mf = [q](int t) -> u64 { return mask_le(q - 64 * t) & mask_ge(q - 511 - 64 * t); };
#pragma unroll
        for (int r = 0; r < 16; ++r) { o[0][r] = 0.f; o[1][r] = 0.f; ol[r] = 0.f; }
        attend_range((LAS char*)F.lds, S, i - 8 < 0 ? 0 : i - 8, i + 1, mf, qr, -Ck, ol, o, L);
        branch_finish_lds(wsf, accw, ol, gs[2], o, L, false);
    }
    const size_t tok0 = (size_t)b * SEQ + 64 * i + 8 * L.wid; const int kvh4 = 4 * kvh;
    bf16* Od = odst ? odst : Q;
    auto rowptr = [Od, tok0, kvh4](int row) -> bf16* { return Od + (tok0 + (row >> 2)) * 512 + (kvh4 + (row & 3)) * 64; };
    f32x16 acc[2];
#pragma unroll
    for (int d0 = 0; d0 < 2; ++d0)
#pragma unroll
        for (int r = 0; r < 16; ++r) acc[d0][r] = accw[(d0 * 16 + r) * 64 + L.lane];
    WAVE_LDS_FENCE();
    store_o((LAS char*)F.lds + L_OST + L.wid * 8192, acc, rowptr, L.lane, L.r32, L.hi);
}

__global__ void __launch_bounds__(NWAVES * 64, 2) mk_fwd(Args args) {
    extern __shared__ __attribute__((aligned(16))) unsigned char lds_raw[];
    LAS unsigned char* lds = (LAS unsigned char*)lds_raw;
    volatile LAS unsigned* MISCW = (volatile LAS unsigned*)(lds + LDS_UNIT + 16);
    if (threadIdx.x < 8) MISCW[threadIdx.x] = 0u;
    __syncthreads();
    (void)xcd_barrier_post((unsigned*)((gu32*)(args.ws + WS_CTL) + CW_BAR), MISCW);
#define GRID_BARRIER() do { unsigned char* wsb_ = args.ws; asm volatile("" : "+s"(wsb_)); XcdBarrier bar_; bar_.bar = (unsigned*)((gu32*)(wsb_ + WS_CTL) + CW_BAR); bar_.x = xb_xcc_id(); \
    bar_.st = (volatile LAS unsigned*)(lds + LDS_UNIT + 16); xcd_barrier(bar_); } while (0)
#define MKFRAME() Frame F; { unsigned char* ws_ = args.ws; asm volatile("" : "+s"(ws_)); int tid_ = threadIdx.x; asm volatile("" : "+v"(tid_)); \
    F.lds = lds; F.tid = tid_; F.lane = tid_ & 63; F.wave = __builtin_amdgcn_readfirstlane(tid_ >> 6); F.G = gridDim.x; F.gw = 0; F.NGW = F.G * NWAVES; \
    F.ws = ws_; F.ctl = (gu32*)(ws_ + WS_CTL); F.a = &args; } int bid = blockIdx.x; asm volatile("" : "+s"(bid)); F.gw = bid * NWAVES + F.wave; \
    unsigned char* ws = F.ws; bf16* XB = (bf16*)(ws + WS_XB); bf16* MB = (bf16*)(ws + WS_MB); bf16* ZQ = (bf16*)(ws + WS_ZQ); bf16* ZKV = (bf16*)(ws + WS_ZKV); bf16* YS = (bf16*)(ws + WS_YS); bf16* HM = (bf16*)(ws + WS_HMID); \
    float* SSQ = (float*)(ws + WS_SSQ); (void)XB; (void)MB; (void)ZQ; (void)ZKV; (void)YS; (void)HM; (void)SSQ;
#define WL(l) (ws + WS_W + (size_t)(l) * W_LAYER)
#ifdef PROBE_T
#define STAMP(k) do { if (blockIdx.x == 0 && threadIdx.x == 0) ((unsigned long long*)(args.ws + WS_CTL + 512 * 1024))[k] = __builtin_amdgcn_s_memrealtime(); } while (0)
#else
#define STAMP(k) do { } while (0)
#endif

    STAMP(0);
#ifndef NO_P0
    { MKFRAME(); p0_prologue(F); }
#ifdef DBL_P0
    { MKFRAME(); p0_prologue(F); }
#endif
#endif
    GRID_BARRIER();
    STAMP(1);
#pragma unroll 1
    for (int l = 0; l < DEPTH; ++l) {
#ifndef NO_G1
#ifdef DBL_G1
        for (int rep_ = 0; rep_ < 2; ++rep_)
#endif
        {
            MKFRAME(); unsigned char* wl = WL(l);
            pg8::Gemm g{XB, (const bf16*)(wl + W_IN), M, 3328, DM}; pg8::StaticOrder S; S.init(M, 3328, F.G, bid);
            pg8::EpiG1 E{ZQ, ZKV, SSQ};
            pg8::gemm_phase<pg8::EpiG1, pg8::StaticOrder, true, true>(F.lds, g, S, E);
        }
#endif
        GRID_BARRIER();
        STAMP(2 + 8 * l);
#ifndef NO_POST
        { MKFRAME(); post_phase(F, l); }
#ifdef DBL_POST
        { MKFRAME(); post_phase(F, l, true); }
#endif
#endif
        GRID_BARRIER();
        STAMP(3 + 8 * l);
        {
            MKFRAME();
            const int xcd = (int)(xb_xcc_id() & 7u);
#pragma unroll 1
            for (int qi = 0; qi < 8; ++qi) {
                const int x = (xcd + qi) & 7, b = x >> 1, sub = x & 1;
                gu32* ctr = F.ctl + CW_Q + 64 * ((2 * l) * 8 + x);
                for (;;) { const int v = next_unit(F, ctr); if (v >= 16 + 256 + 64) break;
                    if (v < 16) { compress_unit(F, l, (v & 1) | (sub << 1) | (b << 2) | ((v >> 1) << 4)); }
                    else if (v < 16 + 256) { select_unit(F, b, 2 * (255 - (v - 16)) + sub); }
                    else { simple_unit<0>(F, l, b, sub, 63 - (v - 272)); }
                }
            }
        }
        GRID_BARRIER();
        STAMP(4 + 8 * l);
#ifdef DBL_ATT2
        for (int rep_ = 0; rep_ < 2; ++rep_)
#else
        const int rep_ = 0;
#endif
        {
            MKFRAME();
            bf16* od = rep_ ? (bf16*)(ws + WS_MB) : nullptr;
            const int xcd = (int)(xb_xcc_id() & 7u);
#pragma unroll 1
            for (int qi = 0; qi < 8; ++qi) {
                const int x = (xcd + qi) & 7, b = x >> 1, kvh = x & 1;
                gu32* ctr = F.ctl + CW_Q + 64 * ((2 * l + 1 + 4 * rep_) * 8 + x);
                for (;;) { const int v = next_unit(F, ctr); if (v >= 128) break;
                    const int i = 63 - (v >> 1);
#ifdef DBL_ATT2
                    if ((v & 1) && (rep_ == 0 || DBL_ATT2 != 3)) simple_unit<1>(F, l, b, kvh, i, od);
                    if (!(v & 1) && (rep_ == 0 || DBL_ATT2 != 2)) nsa_unit(F, l, b, kvh, i, od);
#else
                    if (v & 1) simple_unit<1>(F, l, b, kvh, i, od); else nsa_unit(F, l, b, kvh, i, od);
#endif
                }
            }
        }
        GRID_BARRIER();
        STAMP(5 + 8 * l);
#ifndef NO_G2
#ifdef DBL_G2
        for (int rep_ = 0; rep_ < 2; ++rep_)
#endif
#pragma unroll 1
        for (int n = 0; n < 3; ++n) {
            MKFRAME(); unsigned char* wl = WL(l);
#ifndef NO_G2A
            { pg8::Gemm g{ZQ + (size_t)n * M * 512, (const bf16*)(wl + W_BR) + (size_t)n * DM * 512, M, DM, 512}; pg8::StaticOrder S; S.init(M, DM, F.G, bid);
              pg8::EpiStash E{YS}; pg8::gemm_phase<pg8::EpiStash, pg8::StaticOrder, false, true>(F.lds, g, S, E); }
#endif
#ifndef NO_G2B
            { pg8::Gemm g{XB, (const bf16*)(wl + W_G) + (size_t)n * DM * DM, M, DM, DM}; pg8::StaticOrder S; S.init(M, DM, F.G, bid);
              pg8::EpiGate E{YS, MB, SSQ, n == 0 ? 1 : 0}; pg8::gemm_phase<pg8::EpiGate, pg8::StaticOrder, false, true>(F.lds, g, S, E); }
#endif
        }
#endif
        GRID_BARRIER();
        STAMP(6 + 8 * l);
#ifndef NO_G3
        {
            MKFRAME(); unsigned char* wl = WL(l);
            pg8::Gemm g{MB, (const bf16*)(wl + W_OUT), M, DM, DM}; pg8::StaticOrder S; S.init(M, DM, F.G, bid);
            pg8::EpiRes E{l == 0 ? F.a->in[0] : (const float*)F.a->out, F.a->out, XB, SSQ};
            pg8::gemm_phase<pg8::EpiRes, pg8::StaticOrder, false, true>(F.lds, g, S, E);
        }
#ifdef DBL_G3
        {   MKFRAME(); unsigned char* wl = WL(l);
            pg8::Gemm g{MB, (const bf16*)(wl + W_OUT), M, DM, DM}; pg8::StaticOrder S; S.init(M, DM, F.G, bid);
            pg8::EpiRes E{F.a->in[0], (float*)(ws + 0), (bf16*)(ws + 64 * MiB), (float*)(ws + 96 * MiB)};
            pg8::gemm_phase<pg8::EpiRes, pg8::StaticOrder, false, true>(F.lds, g, S, E);
        }
#endif
#endif
        GRID_BARRIER();
        STAMP(7 + 8 * l);
#ifndef NO_G4
#ifdef DBL_G4
        for (int rep_ = 0; rep_ < 2; ++rep_)
#endif
        {
            MKFRAME(); unsigned char* wl = WL(l);
            pg8::Gemm g{XB, (const bf16*)(wl + W_UP), M, DFF, DM}; pg8::StaticOrder S; S.init(M, DFF, F.G, bid);
            pg8::EpiG4 E{HM, SSQ};
            pg8::gemm_phase<pg8::EpiG4, pg8::StaticOrder, true, true>(F.lds, g, S, E);
        }
#endif
        GRID_BARRIER();
        STAMP(8 + 8 * l);
#ifndef NO_G5
        {
            MKFRAME(); unsigned char* wl = WL(l);
            pg8::Gemm g{HM, (const bf16*)(wl + W_DN), M, DM, DFF}; pg8::StaticOrder S; S.init(M, DM, F.G, bid);
            pg8::EpiRes E{(const float*)F.a->out, F.a->out, XB, SSQ};
            pg8::gemm_phase<pg8::EpiRes, pg8::StaticOrder, false, true>(F.lds, g, S, E);
        }
#ifdef DBL_G5
        {   MKFRAME(); unsigned char* wl = WL(l);
            pg8::Gemm g{HM, (const bf16*)(wl + W_DN), M, DM, DFF}; pg8::StaticOrder S; S.init(M, DM, F.G, bid);
            pg8::EpiNull E{};
            pg8::gemm_phase<pg8::EpiNull, pg8::StaticOrder, false, true>(F.lds, g, S, E);
        }
#endif
#endif
#ifdef PROBE_T
        GRID_BARRIER();
        STAMP(9 + 8 * l);
#else
        if (l + 1 < DEPTH) GRID_BARRIER();
#endif
#ifdef DBL_BAR
        for (int rep_ = 0; rep_ < 16; ++rep_) GRID_BARRIER();
#endif
    }
#ifdef PROBE_T
    {
        GRID_BARRIER();
        const unsigned long long* st = (const unsigned long long*)(args.ws + WS_CTL + 512 * 1024);
        float tus;
        if (PROBE_T == 0) tus = (float)(st[1] - st[0]) * 0.01f;
        else tus = 0.5f * ((float)(st[PROBE_T + 1] - st[PROBE_T]) + (float)(st[PROBE_T + 9] - st[PROBE_T + 8])) * 0.01f;
        const float sc = 1.0f + tus * 0.001f;
        float* o = args.out;
        for (size_t i = (size_t)blockIdx.x * 512 + threadIdx.x; i < (size_t)M * DM; i += (size_t)gridDim.x * 512) o[i] *= sc;
    }
#endif
}

extern "C" void kernel_launch(void* const* d_in, const int* in_sizes, int n_in, void* d_out, int out_size, void* d_ws, size_t ws_size, hipStream_t stream) {
    static int grid = 0;
    if (grid == 0) {
        if (n_in != 17 || out_size != M * DM || ws_size < WS_END) { fprintf(stderr, "kernel_launch: unexpected problem shape (n_in %d out %d ws %zu)\n", n_in, out_size, ws_size); grid = -1; return; }
        int dev = 0, cus = 0, per_cu = 0;
        if (hipGetDevice(&dev) != hipSuccess || hipDeviceGetAttribute(&cus, hipDeviceAttributeMultiprocessorCount, dev) != hipSuccess) { grid = -1; return; }
        if (hipFuncSetAttribute((const void*)mk_fwd, hipFuncAttributeMaxDynamicSharedMemorySize, LDS_BYTES) != hipSuccess) { fprintf(stderr, "kernel_launch: hipFuncSetAttribute failed\n"); grid = -1; return; }
        if (hipOccupancyMaxActiveBlocksPerMultiprocessor(&per_cu, (const void*)mk_fwd, NWAVES * 64, LDS_BYTES) != hipSuccess || per_cu < 1) { fprintf(stderr, "kernel_launch: occupancy query says %d blocks/CU\n", per_cu); }
        (void)hipGetLastError();
        if (cus != 256) { fprintf(stderr, "kernel_launch: built for a 256-CU device (one 256x256 GEMM unit per workgroup in the N=1024 phases), found %d CUs\n", cus); grid = -1; return; }
        grid = cus;
    }
    if (grid < 0) return;
    (void)hipMemsetAsync((char*)d_ws + WS_CTL, 0, CTL_BYTES, stream);
    Args a{};
    for (int i = 0; i < 17; ++i) a.in[i] = (const float*)d_in[i];
    a.out = (float*)d_out; a.ws = (unsigned char*)d_ws;
    hipLaunchKernelGGL(mk_fwd, dim3(grid), dim3(NWAVES * 64), LDS_BYTES, stream, a);
}
```

```cpp
#include <hip/hip_runtime.h>
#include <cstdio>
#include <cstdint>

namespace pg8 {
#define PG8_LAS __attribute__((address_space(3)))
typedef unsigned short bf16_t;
typedef short bf16x8 __attribute__((ext_vector_type(8)));
typedef float f32x4 __attribute__((ext_vector_type(4)));
typedef unsigned u32x4 __attribute__((ext_vector_type(4)));
constexpr int BM = 256, BK = 64, HALF = 128, HTB = HALF * BK * 2  , STAGE_BYTES = 8 * HTB, NXCD = 8, WGM = 8;

__host__ __device__ __forceinline__ int lds_byte(int r, int c) { const int st = (r >> 4) * 2 + (c >> 5), rr = r & 15, cc = c & 31, ob = rr * 64 + cc * 2; return st * 1024 + (ob ^ (((ob >> 9) & 1) << 5)); }
__host__ __device__ __forceinline__ void stage_rc(int b, int& R, int& C) { const int st = b / 1024, sb = b % 1024, swz = sb ^ (((sb >> 9) & 1) << 5); R = (st >> 1) * 16 + swz / 64; C = (st & 1) * 32 + (swz % 64) / 2; }
__host__ __device__ __forceinline__ int perm32(int rho) { const int n = rho >> 4, i = rho & 15; return 8 * (i >> 2) + 4 * n + (i & 3); }

struct Unit { int pm, pn; };
struct Gemm { const bf16_t* A; const bf16_t* Bt; int M, N, K; };

struct StaticOrder {
    int nM, nN, nwg, G, c;
    __host__ __device__ void init(int M, int N, int G_, int c_) { nM = M / BM; nN = N / BM; nwg = nM * nN; G = G_; c = c_; }
    __host__ __device__ bool next(int i, Unit& u) const {
        const long L = (long)i * G + c; if (L >= nwg) return false;
        int wgid = (int)L; { const int q = nwg / NXCD, r = nwg % NXCD, xcd = wgid % NXCD, off = wgid / NXCD; wgid = (xcd < r ? xcd * (q + 1) : r * (q + 1) + (xcd - r) * q) + off; }
        const int nig = WGM * nN, gid = wgid / nig, fm = gid * WGM, gsz = (nM - fm) < WGM ? (nM - fm) : WGM;
        u.pm = fm + ((wgid % nig) % gsz); u.pn = (wgid % nig) / gsz; return true;
    }
    __device__ __forceinline__ void a_ready(const Unit&) const {}
    __device__ __forceinline__ void done(const Unit&) const {}
};

__device__ __forceinline__ unsigned cvt_pk_bf16(float lo, float hi) { unsigned r; asm volatile("v_cvt_pk_bf16_f32 %0, %1, %2" : "=v"(r) : "v"(lo), "v"(hi)); return r; }
template <class Epi, class Sched, bool ALIGN_EPI = false, bool SP2 = false>
__device__ __forceinline__ void gemm_phase(PG8_LAS unsigned char* lds, const Gemm g, const Sched& S, const Epi& E) {
    int tid_l = threadIdx.x; asm volatile("" : "+v"(tid_l));
    const int tid = tid_l, wid = __builtin_amdgcn_readfirstlane(tid >> 6), lane = tid & 63, wr = wid >> 2, wc = wid & 3, fr = lane & 15, fq = lane >> 4;
    const int K = g.K, nt = K / BK;
    unsigned voffA[2], voffB[2];
#pragma unroll
    for (int i = 0; i < 2; ++i) { int R, C; stage_rc(tid * 16 + i * 8192, R, C); const int Rb = Epi::PERM ? ((R & ~31) + perm32(R & 31)) : R;
        voffA[i] = (unsigned)(R * K + C) * 2u; voffB[i] = (unsigned)(Rb * K + C) * 2u; }
    const size_t kstep = (size_t)(BK * 2);
    const size_t hstep = (size_t)HALF * K * 2;
    const size_t tstep = 2 * hstep;
    const unsigned ldsw = (unsigned)wid * 1024u;
    const int aoff = lds_byte(wr * 64 + fr, fq * 8), boff = lds_byte(wc * 32 + fr, fq * 8);
#define PG8_SA(b, h) (((b) * 2 + (h)) * HTB)
#define PG8_SB(b, h) ((4 + (b) * 2 + (h)) * HTB)
#define PG8_STAGE(bufoff, gbase, voff) do { _Pragma("unroll") for (int _i = 0; _i < 2; ++_i) \
        __builtin_amdgcn_global_load_lds((const unsigned*)((const char*)(gbase) + (voff)[_i]), (PG8_LAS unsigned*)(lds + (bufoff) + ldsw + _i * 8192), 16, 0, 0); } while (0)
#define PG8_LDA(dst, b, h) do { _Pragma("unroll") for (int m = 0; m < 4; ++m) _Pragma("unroll") for (int k = 0; k < 2; ++k) dst[m][k] = *(const PG8_LAS bf16x8*)(lds + PG8_SA(b, h) + aoff + m * 2048 + k * 1024); } while (0)
#define PG8_LDB(dst, b, h) do { _Pragma("unroll") for (int n = 0; n < 2; ++n) _Pragma("unroll") for (int k = 0; k < 2; ++k) dst[n][k] = *(const PG8_LAS bf16x8*)(lds + PG8_SB(b, h) + boff + n * 2048 + k * 1024); } while (0)
#define PG8_MMA(ai, bj, At, Bt) do { __builtin_amdgcn_s_setprio(1); _Pragma("unroll") for (int m = 0; m < 4; ++m) _Pragma("unroll") for (int n = 0; n < 2; ++n) _Pragma("unroll") for (int k = 0; k < 2; ++k) \
        acc[ai][bj][m][n] = __builtin_amdgcn_mfma_f32_16x16x32_bf16(Bt[n][k], At[m][k], acc[ai][bj][m][n], 0, 0, 0); __builtin_amdgcn_s_setprio(0); } while (0)
#define PG8_WAIT_V(n) asm volatile("s_waitcnt vmcnt(" #n ")" ::: "memory")
#define PG8_WAIT_L(n) asm volatile("s_waitcnt lgkmcnt(" #n ")" ::: "memory")
#define PG8_BAR __builtin_amdgcn_s_barrier()
#define PG8_SCHED __builtin_amdgcn_sched_barrier(0)
    Unit cur, nxt; int ui = 0;
    if (!S.next(0, cur)) return;
    f32x4 acc[2][2][4][2];
#pragma unroll
    for (int a = 0; a < 2; ++a)
#pragma unroll
        for (int b = 0; b < 2; ++b)
#pragma unroll
            for (int m = 0; m < 4; ++m)
#pragma unroll
                for (int n = 0; n < 2; ++n) acc[a][b][m][n] = (f32x4){0.f, 0.f, 0.f, 0.f};
    bf16x8 At[4][2], B0[2][2], B1[2][2];
    const char* cA = (const char*)g.A + (size_t)cur.pm * tstep; const char* cB = (const char*)g.Bt + (size_t)cur.pn * tstep;
    S.a_ready(cur);
    if constexpr (SP2) {
        PG8_STAGE(PG8_SB(0, 0), cB, voffB); PG8_STAGE(PG8_SB(0, 1), cB + hstep, voffB); PG8_STAGE(PG8_SA(0, 0), cA, voffA); PG8_STAGE(PG8_SA(0, 1), cA + hstep, voffA);
        if (wr == 1) PG8_BAR;
        PG8_WAIT_V(2); PG8_BAR;
        PG8_STAGE(PG8_SB(1, 0), cB + kstep, voffB); PG8_STAGE(PG8_SA(1, 0), cA + kstep, voffA); PG8_STAGE(PG8_SB(1, 1), cB + hstep + kstep, voffB);
        PG8_WAIT_V(6); PG8_BAR;
    } else {
        PG8_STAGE(PG8_SB(0, 0), cB, voffB); PG8_STAGE(PG8_SA(0, 0), cA, voffA); PG8_STAGE(PG8_SB(0, 1), cB + hstep, voffB); PG8_STAGE(PG8_SA(0, 1), cA + hstep, voffA);
        if (wr == 1) PG8_BAR;
        PG8_WAIT_V(4); PG8_BAR;
        PG8_STAGE(PG8_SB(1, 0), cB + kstep, voffB); PG8_STAGE(PG8_SA(1, 0), cA + kstep, voffA); PG8_STAGE(PG8_SB(1, 1), cB + hstep + kstep, voffB);
        PG8_WAIT_V(6); PG8_BAR;
    }
    for (;;) {
        const bool has_next = S.next(ui + 1, nxt);
        const char* nA = has_next ? (const char*)g.A + (size_t)nxt.pm * tstep : cA; const char* nB = has_next ? (const char*)g.Bt + (size_t)nxt.pn * tstep : cB;
        for (int t = 0; t < nt; t += 2) {
            const bool last = (t == nt - 2);
            const char* a1 = cA + (size_t)(t + 1) * kstep;
            const char* a2 = last ? nA : cA + (size_t)(t + 2) * kstep; const char* b2 = last ? nB : cB + (size_t)(t + 2) * kstep;
            const char* a3 = a2 + kstep; const char* b3 = b2 + kstep;
            if (last && has_next) S.a_ready(nxt);
            if constexpr (SP2) {
            PG8_LDB(B0, 0, 0); PG8_LDB(B1, 0, 1); PG8_SCHED; PG8_LDA(At, 0, 0); PG8_STAGE(PG8_SA(1, 1), a1 + hstep, voffA);
            PG8_WAIT_V(8); PG8_WAIT_L(0); PG8_BAR; PG8_MMA(0, 0, At, B0); PG8_MMA(0, 1, At, B1); PG8_BAR; PG8_SCHED;
            PG8_LDA(At, 0, 1); PG8_STAGE(PG8_SB(0, 0), b2, voffB); PG8_STAGE(PG8_SB(0, 1), b2 + hstep, voffB); PG8_STAGE(PG8_SA(0, 0), a2, voffA);
            PG8_WAIT_V(8); PG8_WAIT_L(0); PG8_BAR; PG8_MMA(1, 0, At, B0); PG8_MMA(1, 1, At, B1); PG8_BAR; PG8_SCHED;
            PG8_LDB(B0, 1, 0); PG8_LDB(B1, 1, 1); PG8_SCHED; PG8_LDA(At, 1, 0); PG8_STAGE(PG8_SA(0, 1), a2 + hstep, voffA);
            PG8_WAIT_V(8); PG8_WAIT_L(0); PG8_BAR; PG8_MMA(0, 0, At, B0); PG8_MMA(0, 1, At, B1); PG8_BAR; PG8_SCHED;
            PG8_LDA(At, 1, 1); PG8_STAGE(PG8_SB(1, 0), b3, voffB); PG8_STAGE(PG8_SB(1, 1), b3 + hstep, voffB); PG8_STAGE(PG8_SA(1, 0), a3, voffA);
            PG8_WAIT_V(8); PG8_WAIT_L(0); PG8_BAR; PG8_MMA(1, 0, At, B0); PG8_MMA(1, 1, At, B1); PG8_BAR; PG8_SCHED;
            } else {
            PG8_LDB(B0, 0, 0); PG8_SCHED; PG8_LDA(At, 0, 0); PG8_STAGE(PG8_SA(1, 1), a1 + hstep, voffA);
            PG8_WAIT_L(8); PG8_BAR; PG8_WAIT_L(0); PG8_MMA(0, 0, At, B0); PG8_BAR; PG8_SCHED;
            PG8_LDB(B1, 0, 1); PG8_STAGE(PG8_SB(0, 0), b2, voffB);
            PG8_BAR; PG8_WAIT_L(0); PG8_MMA(0, 1, At, B1); PG8_BAR;
            PG8_LDA(At, 0, 1); PG8_STAGE(PG8_SA(0, 0), a2, voffA);
            PG8_BAR; PG8_WAIT_L(0); PG8_MMA(1, 0, At, B0); PG8_BAR; PG8_SCHED;
            PG8_STAGE(PG8_SB(0, 1), b2 + hstep, voffB);
            PG8_WAIT_V(6); PG8_BAR; PG8_MMA(1, 1, At, B1); PG8_BAR;
            PG8_LDB(B0, 1, 0); PG8_SCHED; PG8_LDA(At, 1, 0); PG8_STAGE(PG8_SA(0, 1), a2 + hstep, voffA);
            PG8_WAIT_L(8); PG8_BAR; PG8_WAIT_L(0); PG8_MMA(0, 0, At, B0); PG8_BAR; PG8_SCHED;
            PG8_LDB(B1, 1, 1); PG8_STAGE(PG8_SB(1, 0), b3, voffB);
            PG8_BAR; PG8_WAIT_L(0); PG8_MMA(0, 1, At, B1); PG8_BAR;
            PG8_LDA(At, 1, 1); PG8_STAGE(PG8_SA(1, 0), a3, voffA);
            PG8_BAR; PG8_WAIT_L(0); PG8_MMA(1, 0, At, B0); PG8_BAR; PG8_SCHED;
            PG8_STAGE(PG8_SB(1, 1), b3 + hstep, voffB);
            PG8_WAIT_V(6); PG8_BAR; PG8_MMA(1, 1, At, B1); PG8_BAR;
            }
        }
        if constexpr (ALIGN_EPI) { if (wr == 0) PG8_BAR; }
        if constexpr (!Epi::AFTER_DRAIN) { E(acc, cur, wr, wc, fr, fq); S.done(cur); }
        if (!has_next) break;
#pragma unroll
        for (int a = 0; a < 2; ++a)
#pragma unroll
            for (int b = 0; b < 2; ++b)
#pragma unroll
                for (int m = 0; m < 4; ++m)
#pragma unroll
                    for (int n = 0; n < 2; ++n) acc[a][b][m][n] = (f32x4){0.f, 0.f, 0.f, 0.f};
        cur = nxt; cA = nA; cB = nB; ++ui;
        if constexpr (ALIGN_EPI) { if (wr == 1) PG8_BAR; }
    }
    PG8_WAIT_V(0);
    if constexpr (!ALIGN_EPI) { if (wr == 0) PG8_BAR; }
    PG8_BAR;
    if constexpr (Epi::AFTER_DRAIN) { E.fused(acc, cur, wr, wc, fr, fq, lds, wid, lane); S.done(cur); }
#undef PG8_SA
#undef PG8_SB
#undef PG8_STAGE
#undef PG8_LDA
#undef PG8_LDB
#undef PG8_MMA
#undef PG8_WAIT_V
#undef PG8_WAIT_L
#undef PG8_BAR
#undef PG8_SCHED
}
}

namespace pg8 {
#define PG8_GAS __attribute__((address_space(1)))
constexpr int MROWS = 16384;
__device__ __forceinline__ unsigned pk_bf16(float lo, float hi) { typedef float f2 __attribute__((ext_vector_type(2))); typedef __bf16 b2 __attribute__((ext_vector_type(2)));
    f2 v = {lo, hi}; b2 b = __builtin_convertvector(v, b2); return __builtin_bit_cast(unsigned, b); }
__device__ __forceinline__ float bf_lo(unsigned w) { return __uint_as_float(w << 16); }
__device__ __forceinline__ float bf_hi(unsigned w) { return __uint_as_float(w & 0xffff0000u); }
__device__ __forceinline__ float row_rstd(const float* ssq, int row) {
    const PG8_GAS f32x4* p = (const PG8_GAS f32x4*)(ssq + (size_t)row * 16);
    const f32x4 a = p[0], b = p[1], c = p[2], d = p[3];
    const float s = (((a[0] + a[1]) + (a[2] + a[3])) + ((b[0] + b[1]) + (b[2] + b[3]))) + (((c[0] + c[1]) + (c[2] + c[3])) + ((d[0] + d[1]) + (d[2] + d[3])));
    return rsqrtf(s * (1.0f / 1024.0f) + 1e-6f);
}
__device__ __forceinline__ float sigmoidf_(float x) { return __builtin_amdgcn_rcpf(1.0f + __builtin_amdgcn_exp2f(-1.4426950408889634f * x)); }

struct EpiG1 {
    static constexpr bool PERM = true, AFTER_DRAIN = false;
    bf16_t* zq; bf16_t* zkv; const float* ssq;
    __device__ __forceinline__ void operator()(const f32x4 (&acc)[2][2][4][2], const Unit& u, int wr, int wc, int fr, int fq) const {
        const int row0 = u.pm * BM + wr * 64 + fr;
        bf16_t* base; int ldc, colt;
        if (u.pn < 6) { base = zq + (size_t)(u.pn >> 1) * ((size_t)MROWS * 512); ldc = 512; colt = (u.pn & 1) * 256; }
        else { base = zkv + (size_t)(u.pn - 6) * ((size_t)MROWS * 256); ldc = 256; colt = 0; }
        const int col0 = colt + wc * 32 + 8 * fq;
#pragma unroll
        for (int ai = 0; ai < 2; ++ai)
#pragma unroll
            for (int m = 0; m < 4; ++m) { const int row = row0 + ai * HALF + m * 16; const float rs = row_rstd(ssq, row); bf16_t* rowp = base + (size_t)row * ldc + col0;
#pragma unroll
                for (int bj = 0; bj < 2; ++bj) { const f32x4 v0 = acc[ai][bj][m][0] * rs, v1 = acc[ai][bj][m][1] * rs;
                    u32x4 w; w.x = pk_bf16(v0[0], v0[1]); w.y = pk_bf16(v0[2], v0[3]); w.z = pk_bf16(v1[0], v1[1]); w.w = pk_bf16(v1[2], v1[3]);
                    *(PG8_GAS u32x4*)(rowp + bj * HALF) = w; } }
    }
};
struct EpiG4 {
    static constexpr bool PERM = true, AFTER_DRAIN = false;
    bf16_t* h; const float* ssq;
    __device__ __forceinline__ void operator()(const f32x4 (&acc)[2][2][4][2], const Unit& u, int wr, int wc, int fr, int fq) const {
        const int row0 = u.pm * BM + wr * 64 + fr; const int col0 = u.pn * BM + wc * 32 + 8 * fq;
#pragma unroll
        for (int ai = 0; ai < 2; ++ai)
#pragma unroll
            for (int m = 0; m < 4; ++m) { const int row = row0 + ai * HALF + m * 16; const float rs = row_rstd(ssq, row); bf16_t* rowp = h + (size_t)row * 4096 + col0;
#pragma unroll
                for (int bj = 0; bj < 2; ++bj) { f32x4 v0 = acc[ai][bj][m][0] * rs, v1 = acc[ai][bj][m][1] * rs;
#pragma unroll
                    for (int e = 0; e < 4; ++e) { v0[e] = fmaxf(v0[e], 0.f); v0[e] *= v0[e]; v1[e] = fmaxf(v1[e], 0.f); v1[e] *= v1[e]; }
                    u32x4 w; w.x = pk_bf16(v0[0], v0[1]); w.y = pk_bf16(v0[2], v0[3]); w.z = pk_bf16(v1[0], v1[1]); w.w = pk_bf16(v1[2], v1[3]);
                    *(PG8_GAS u32x4*)(rowp + bj * HALF) = w; } }
    }
};
struct EpiRes {
    static constexpr bool PERM = true, AFTER_DRAIN = false;
    const float* xold; float* xout; bf16_t* xb; float* ssq;
    __device__ __forceinline__ void operator()(const f32x4 (&acc)[2][2][4][2], const Unit& u, int wr, int wc, int fr, int fq) const {
        const int row0 = u.pm * BM + wr * 64 + fr; const int col0 = u.pn * BM + wc * 32 + 8 * fq;
#pragma unroll
        for (int ai = 0; ai < 2; ++ai)
#pragma unroll
            for (int m = 0; m < 4; ++m) { const int row = row0 + ai * HALF + m * 16; float part = 0.f;
#pragma unroll
                for (int bj = 0; bj < 2; ++bj) { const size_t off = (size_t)row * 1024 + col0 + bj * HALF;
                    const f32x4 a0 = *(const PG8_GAS f32x4*)(xold + off), a1 = *(const PG8_GAS f32x4*)(xold + off + 4);
                    const f32x4 v0 = acc[ai][bj][m][0] + a0, v1 = acc[ai][bj][m][1] + a1;
                    *(PG8_GAS f32x4*)(xout + off) = v0; *(PG8_GAS f32x4*)(xout + off + 4) = v1;
                    u32x4 w; w.x = pk_bf16(v0[0], v0[1]); w.y = pk_bf16(v0[2], v0[3]); w.z = pk_bf16(v1[0], v1[1]); w.w = pk_bf16(v1[2], v1[3]);
                    *(PG8_GAS u32x4*)(xb + off) = w;
                    part += ((v0[0] * v0[0] + v0[1] * v0[1]) + (v0[2] * v0[2] + v0[3] * v0[3])) + ((v1[0] * v1[0] + v1[1] * v1[1]) + (v1[2] * v1[2] + v1[3] * v1[3])); }
                part += __shfl_xor(part, 16); part += __shfl_xor(part, 32);
                if (fq == 0) ((PG8_GAS float*)ssq)[(size_t)row * 16 + u.pn * 4 + wc] = part;
                asm volatile("" ::: "memory"); }
    }
};
struct EpiStash {
    static constexpr bool PERM = true, AFTER_DRAIN = true;
    __device__ __forceinline__ void fused(f32x4 (&acc)[2][2][4][2], const Unit& u, int wr, int wc, int fr, int fq, PG8_LAS unsigned char*, int, int) const { (*this)(acc, u, wr, wc, fr, fq); }
    bf16_t* ys;
    __device__ __forceinline__ void operator()(const f32x4 (&acc)[2][2][4][2], const Unit& u, int wr, int wc, int fr, int fq) const {
        bf16_t* base = ys + (size_t)(u.pm * 4 + u.pn) * 65536; const int row0 = wr * 64 + fr, col0 = wc * 32 + 8 * fq;
#pragma unroll
        for (int ai = 0; ai < 2; ++ai)
#pragma unroll
            for (int m = 0; m < 4; ++m) { bf16_t* rowp = base + (row0 + ai * HALF + m * 16) * 256 + col0;
#pragma unroll
                for (int bj = 0; bj < 2; ++bj) { const f32x4 v0 = acc[ai][bj][m][0], v1 = acc[ai][bj][m][1];
                    u32x4 w; w.x = pk_bf16(v0[0], v0[1]); w.y = pk_bf16(v0[2], v0[3]); w.z = pk_bf16(v1[0], v1[1]); w.w = pk_bf16(v1[2], v1[3]);
                    *(PG8_GAS u32x4*)(rowp + bj * HALF) = w; } }
    }
};
struct EpiGate {
    static constexpr bool PERM = true, AFTER_DRAIN = true;
    __device__ __forceinline__ void fused(f32x4 (&acc)[2][2][4][2], const Unit& u, int wr, int wc, int fr, int fq, PG8_LAS unsigned char*, int, int) const { (*this)(acc, u, wr, wc, fr, fq); }
    const bf16_t* ys; bf16_t* mb; const float* ssq; int first;
    __device__ __forceinline__ void operator()(const f32x4 (&acc)[2][2][4][2], const Unit& u, int wr, int wc, int fr, int fq) const {
        const bf16_t* sbase = ys + (size_t)(u.pm * 4 + u.pn) * 65536; const int lrow0 = wr * 64 + fr, lcol0 = wc * 32 + 8 * fq;
#pragma unroll
        for (int ai = 0; ai < 2; ++ai)
#pragma unroll
            for (int m = 0; m < 4; ++m) { const int lrow = lrow0 + ai * HALF + m * 16, row = u.pm * BM + lrow; const float rs = row_rstd(ssq, row);
#pragma unroll
                for (int bj = 0; bj < 2; ++bj) { const f32x4 a0 = acc[ai][bj][m][0] * rs, a1 = acc[ai][bj][m][1] * rs;
                    const u32x4 y = *(const PG8_GAS u32x4*)(sbase + lrow * 256 + lcol0 + bj * HALF);
                    bf16_t* mp = mb + (size_t)row * 1024 + u.pn * BM + lcol0 + bj * HALF;
                    float r[8];
                    r[0] = sigmoidf_(a0[0]) * bf_lo(y.x); r[1] = sigmoidf_(a0[1]) * bf_hi(y.x); r[2] = sigmoidf_(a0[2]) * bf_lo(y.y); r[3] = sigmoidf_(a0[3]) * bf_hi(y.y);
                    r[4] = sigmoidf_(a1[0]) * bf_lo(y.z); r[5] = sigmoidf_(a1[1]) * bf_hi(y.z); r[6] = sigmoidf_(a1[2]) * bf_lo(y.w); r[7] = sigmoidf_(a1[3]) * bf_hi(y.w);
                    if (!first) { const u32x4 pv = *(const PG8_GAS u32x4*)mp;
                        r[0] += bf_lo(pv.x); r[1] += bf_hi(pv.x); r[2] += bf_lo(pv.y); r[3] += bf_hi(pv.y); r[4] += bf_lo(pv.z); r[5] += bf_hi(pv.z); r[6] += bf_lo(pv.w); r[7] += bf_hi(pv.w); }
                    u32x4 w; w.x = pk_bf16(r[0], r[1]); w.y = pk_bf16(r[2], r[3]); w.z = pk_bf16(r[4], r[5]); w.w = pk_bf16(r[6], r[7]);
                    *(PG8_GAS u32x4*)mp = w;
                    asm volatile("" ::: "memory"); } }
    }
};
struct EpiNull {
    static constexpr bool PERM = true, AFTER_DRAIN = false;
    __device__ __forceinline__ void operator()(const f32x4 (&acc)[2][2][4][2], const Unit& u, int wr, int wc, int fr, int fq) const {
#pragma unroll
        for (int ai = 0; ai < 2; ++ai)
#pragma unroll
            for (int bj = 0; bj < 2; ++bj)
#pragma unroll
                for (int m = 0; m < 4; ++m) { asm volatile("" :: "v"(acc[ai][bj][m][0]), "v"(acc[ai][bj][m][1])); }
    }
};
}

#define GAS __attribute__((address_space(1)))
#define LAS __attribute__((address_space(3)))
typedef unsigned short bf16;
typedef unsigned v4u __attribute__((ext_vector_type(4)));
typedef float f32x4 __attribute__((ext_vector_type(4)));
typedef short bf16x8 __attribute__((ext_vector_type(8)));
typedef GAS unsigned gu32;
typedef GAS unsigned long long gu64;
#define RLX_AGENT __ATOMIC_RELAXED, __HIP_MEMORY_SCOPE_AGENT
#define LDS_WAIT() asm volatile("s_waitcnt lgkmcnt(0)" ::: "memory")
#define VM_WAIT() asm volatile("s_waitcnt vmcnt(0)" ::: "memory")
__device__ __forceinline__ unsigned long long rt() { return __builtin_amdgcn_s_memrealtime(); }
__device__ __forceinline__ unsigned f2bf(float f) { unsigned u = __builtin_bit_cast(unsigned, f); return (u + 0x7fffu + ((u >> 16) & 1u)) >> 16; }
__device__ __forceinline__ unsigned pk2(float lo, float hi) { return f2bf(lo) | (f2bf(hi) << 16); }

#define XB_TMO      128
#define XB_XCNT(j)  (256  + 64 * (j))
#define XB_XSUB(j)  (1280 + 64 * (j))
#define XB_XGEN(j)  (2304 + 64 * (j))
#define XB_TOP      3328
#define XB_TOPGEN   3392
#define XCD_BAR_WORDS 3456
#define XB_SPIN_CAP (1u << 18)

__device__ __forceinline__ unsigned xb_ld(unsigned* p)              { return __hip_atomic_load(p, __ATOMIC_RELAXED, __HIP_MEMORY_SCOPE_AGENT); }
__device__ __forceinline__ unsigned xb_add(unsigned* p, unsigned v) { return __hip_atomic_fetch_add(p, v, __ATOMIC_RELAXED, __HIP_MEMORY_SCOPE_AGENT); }
__device__ __forceinline__ unsigned xb_xcc_id() { return (unsigned)__builtin_amdgcn_s_getreg((3 << 11) | 20) & 0xFu; }
#define XB_SPIN(cond, bar) do { unsigned _sp = 0; while (cond) { __builtin_amdgcn_s_sleep(1); \
    if ((++_sp & 255u) == 0u) { if (xb_ld(&(bar)[XB_TMO])) break; if (_sp > XB_SPIN_CAP) { atomicAdd(&(bar)[XB_TMO], 1u); break; } } } } while (0)

struct XcdBarrier {
    unsigned* bar; unsigned x;
    volatile LAS unsigned* st;
};

__device__ __forceinline__ XcdBarrier xcd_barrier_post(unsigned* bar, volatile LAS unsigned* st) {
    XcdBarrier b; b.bar = bar; b.x = xb_xcc_id(); b.st = st;
    if (threadIdx.x == 0) (void)xb_add(&bar[XB_XCNT(b.x)], 1u);
    return b;
}
__device__ __forceinline__ void xcd_barrier_complete(unsigned* bar, unsigned x, unsigned& nloc, unsigned& nx) {
    const unsigned G = gridDim.x * gridDim.y * gridDim.z;
    unsigned sum, cnt, mine, sp = 0u;
    for (;;) {
        sum = 0u; cnt = 0u; mine = 0u;
#pragma unroll
        for (unsigned j = 0; j < 16; ++j) { const unsigned c = xb_ld(&bar[XB_XCNT(j)]); sum += c; cnt += (c > 0u) ? 1u : 0u; mine = (j == x) ? c : mine; }
        if (sum == G) break;
        __builtin_amdgcn_s_sleep(1);
        if ((++sp & 255u) == 0u) { if (xb_ld(&bar[XB_TMO])) break; if (sp > XB_SPIN_CAP) { atomicAdd(&bar[XB_TMO], 1u); break; } }
    }
    nloc = mine > 0u ? mine : 1u; nx = cnt > 0u ? cnt : 1u;
}

__device__ __forceinline__ void xcd_barrier(const XcdBarrier& b) {
    asm volatile("s_waitcnt vmcnt(0)" ::: "memory");
    __syncthreads();
    if (threadIdx.x == 0) {
        unsigned* bar = b.bar;
        __builtin_amdgcn_s_waitcnt(0);
        unsigned nloc = b.st[0], nx = b.st[1];
        if (nloc == 0u) { xcd_barrier_complete(bar, b.x, nloc, nx); b.st[0] = nloc; b.st[1] = nx; }
        const unsigned old = xb_add(&bar[XB_XSUB(b.x)], 1u);
        const unsigned gen = old / nloc;
        if (old + 1u == (gen + 1u) * nloc) {
            __builtin_amdgcn_fence(__ATOMIC_RELEASE, "agent");
            asm volatile("s_waitcnt vmcnt(0)" ::: "memory");
            const unsigned og = xb_add(&bar[XB_TOP], 1u);
            const unsigned tg = og / nx;
            if (og + 1u == (tg + 1u) * nx) xb_add(&bar[XB_TOPGEN], 1u);
            else XB_SPIN(xb_ld(&bar[XB_TOPGEN]) == tg, bar);
            __builtin_amdgcn_fence(__ATOMIC_ACQUIRE, "agent");
            xb_add(&bar[XB_XGEN(b.x)], 1u);
            asm volatile("s_waitcnt vmcnt(0)" ::: "memory");
        } else {
            XB_SPIN(xb_ld(&bar[XB_XGEN(b.x)]) == gen, bar);
            __builtin_amdgcn_fence(__ATOMIC_ACQUIRE, "agent");
            asm volatile("s_waitcnt vmcnt(0)" ::: "memory");
        }
    }
    __syncthreads();
}

namespace att {
typedef short bf16x8 __attribute__((ext_vector_type(8)));
typedef short s16x4 __attribute__((ext_vector_type(4)));
typedef float f32x16 __attribute__((ext_vector_type(16)));
typedef unsigned u32x4 __attribute__((ext_vector_type(4)));
typedef unsigned short bf16_t;
typedef unsigned long long u64;
constexpr int NKB = 4, NVB = 5;
constexpr int WSF_W = 320;
constexpr int L_K0 = 0, L_V0 = NKB * 8320, L_IMP = L_V0  , L_WSF = L_V0 + NVB * 8192, L_SEL = L_WSF + 8 * WSF_W * 4, L_OST = L_SEL + 512  , L_END = L_OST + 65536;
__device__ __forceinline__ int crow(int r, int hi) { return (r & 3) + 8 * (r >> 2) + 4 * hi; }
__device__ __forceinline__ unsigned pk2(float lo, float hi) { typedef float f2 __attribute__((ext_vector_type(2))); typedef __bf16 b2 __attribute__((ext_vector_type(2)));
    f2 v = {lo, hi}; b2 b = __builtin_convertvector(v, b2); return __builtin_bit_cast(unsigned, b); }
__device__ __forceinline__ s16x4 vtr(LAS const char* p) { typedef short v4i16_t __attribute__((ext_vector_type(4))); return __builtin_bit_cast(s16x4, __builtin_amdgcn_ds_read_tr16_b64_v4i16((LAS v4i16_t*)p)); }

struct KVSrc { const GAS bf16_t* k; const GAS bf16_t* v; int pitch; int nrows; };

struct Lane { int tid, lane, r32, hi, wid; };

__device__ __forceinline__ void tile_gload(const KVSrc& S, int t, int tid, u32x4& kr, u32x4& vr) {
    const int row = 64 * t + (tid >> 3), ch = tid & 7;
    kr = *(const GAS u32x4*)(S.k + (size_t)row * S.pitch + ch * 8); vr = *(const GAS u32x4*)(S.v + (size_t)row * S.pitch + ch * 8);
}
__device__ __forceinline__ void tile_lstore(LAS char* kb, LAS char* vb, int tid, const u32x4& kr, const u32x4& vr) {
    const int key = tid >> 3, ch = tid & 7;
    *(LAS u32x4*)(kb + ch * 1040 + (key >> 5) * 512 + (key & 31) * 16) = kr;
    *(LAS u32x4*)(vb + (ch >> 2) * 4096 + (key >> 4) * 1024 + ((key >> 3) & 1) * 512 + (key & 7) * 64 + (ch & 3) * 16) = vr;
}
__device__ __forceinline__ void qk_tile(LAS const char* kbuf, const bf16x8 (&qr)[4], f32x16& p0, f32x16& p1, int r32, int hi) {
    LAS const char* kb = kbuf + hi * 1040 + r32 * 16;
#pragma unroll
    for (int d0 = 0; d0 < 4; ++d0) {
        const bf16x8 b0 = *(LAS const bf16x8*)(kb + d0 * 2080);
        const bf16x8 b1 = *(LAS const bf16x8*)(kb + d0 * 2080 + 512);
        p0 = __builtin_amdgcn_mfma_f32_32x32x16_bf16(b0, qr[d0], p0, 0, 0, 0);
        p1 = __builtin_amdgcn_mfma_f32_32x32x16_bf16(b1, qr[d0], p1, 0, 0, 0);
    }
}
__device__ __forceinline__ void qk_tile_c(LAS const char* kbuf, const bf16x8 (&qr)[4], const f32x16& negm, f32x16& p0, f32x16& p1, int r32, int hi) {
    const unsigned ka = (unsigned)(size_t)kbuf + hi * 1040 + r32 * 16;
    bf16x8 kf[8];
#pragma unroll
    for (int d0 = 0; d0 < 4; ++d0) {
        asm volatile("ds_read_b128 %0, %1 offset:%c2" : "=&v"(kf[2 * d0]) : "v"(ka), "i"(d0 * 2080) : "memory");
        asm volatile("ds_read_b128 %0, %1 offset:%c2" : "=&v"(kf[2 * d0 + 1]) : "v"(ka), "i"(d0 * 2080 + 512) : "memory");
    }
    asm volatile("s_waitcnt lgkmcnt(0)" : "+v"(kf[0]), "+v"(kf[1]), "+v"(kf[2]), "+v"(kf[3]), "+v"(kf[4]), "+v"(kf[5]), "+v"(kf[6]), "+v"(kf[7]) :: "memory");
    __builtin_amdgcn_sched_barrier(0);
    p0 = __builtin_amdgcn_mfma_f32_32x32x16_bf16(kf[0], qr[0], negm, 0, 0, 0); p1 = __builtin_amdgcn_mfma_f32_32x32x16_bf16(kf[1], qr[0], negm, 0, 0, 0);
#pragma unroll
    for (int d0 = 1; d0 < 4; ++d0) { p0 = __builtin_amdgcn_mfma_f32_32x32x16_bf16(kf[2 * d0], qr[d0], p0, 0, 0, 0); p1 = __builtin_amdgcn_mfma_f32_32x32x16_bf16(kf[2 * d0 + 1], qr[d0], p1, 0, 0, 0); }
}
__device__ __forceinline__ void pv_tile(LAS const char* vbuf, const u32x4 (&pw)[4], f32x16 (&o)[2], f32x16& ol, int lane, int hi) {
    const unsigned va = (unsigned)(size_t)vbuf + ((lane >> 4) & 1) * 32 + (lane & 3) * 8 + (4 * hi + ((lane & 15) >> 2)) * 64;
#pragma unroll
    for (int d0 = 0; d0 < 2; ++d0) {
        s16x4 lo[4], h2[4];
#pragma unroll
        for (int ks = 0; ks < 4; ++ks) {
            asm volatile("ds_read_b64_tr_b16 %0, %1 offset:%c2" : "=&v"(lo[ks]) : "v"(va), "i"(d0 * 4096 + ks * 1024) : "memory");
            asm volatile("ds_read_b64_tr_b16 %0, %1 offset:%c2" : "=&v"(h2[ks]) : "v"(va), "i"(d0 * 4096 + ks * 1024 + 512) : "memory");
        }
        asm volatile("s_waitcnt lgkmcnt(0)" : "+v"(lo[0]), "+v"(lo[1]), "+v"(lo[2]), "+v"(lo[3]), "+v"(h2[0]), "+v"(h2[1]), "+v"(h2[2]), "+v"(h2[3]) :: "memory");
        __builtin_amdgcn_sched_barrier(0);
#pragma unroll
        for (int ks = 0; ks < 4; ++ks) {
            const bf16x8 vf = (bf16x8){lo[ks][0], lo[ks][1], lo[ks][2], lo[ks][3], h2[ks][0], h2[ks][1], h2[ks][2], h2[ks][3]};
            o[d0] = __builtin_amdgcn_mfma_f32_32x32x16_bf16(__builtin_bit_cast(bf16x8, pw[ks]), vf, o[d0], 0, 0, 0);
        }
        if (d0 == 0) {
            const bf16x8 ones = (bf16x8){0x3f80, 0x3f80, 0x3f80, 0x3f80, 0x3f80, 0x3f80, 0x3f80, 0x3f80};
#pragma unroll
            for (int ks = 0; ks < 4; ++ks) ol = __builtin_amdgcn_mfma_f32_32x32x16_bf16(__builtin_bit_cast(bf16x8, pw[ks]), ones, ol, 0, 0, 0);
        }
    }
}
__device__ __forceinline__ void mask_exp_pack(f32x16& p0, f32x16& p1, u64 mask, int hi, u32x4 (&pw)[4]) {
    const bool rowuni = __all(mask == ~0ull || mask == 0ull);
    if (rowuni) {
        const unsigned rm = mask ? ~0u : 0u;
        if (__all(mask == ~0ull)) {
#pragma unroll
            for (int r = 0; r < 16; ++r) { p0[r] = __builtin_amdgcn_exp2f(p0[r]); p1[r] = __builtin_amdgcn_exp2f(p1[r]); }
        } else {
#pragma unroll
            for (int r = 0; r < 16; ++r) { p0[r] = __uint_as_float(__float_as_uint(__builtin_amdgcn_exp2f(p0[r])) & rm); p1[r] = __uint_as_float(__float_as_uint(__builtin_amdgcn_exp2f(p1[r])) & rm); }
        }
    } else {
        const int m0 = (int)(unsigned)(mask >> (4 * hi)), m1 = (int)(unsigned)(mask >> (32 + 4 * hi));
#pragma unroll
        for (int r = 0; r < 16; ++r) { const int bit = (r & 3) + 8 * (r >> 2);
            const unsigned e0 = __float_as_uint(__builtin_amdgcn_exp2f(p0[r])), e1 = __float_as_uint(__builtin_amdgcn_exp2f(p1[r]));
            unsigned k0, k1;
            asm("v_bfe_i32 %0, %1, %2, 1" : "=v"(k0) : "v"(m0), "n"(bit)); asm("v_bfe_i32 %0, %1, %2, 1" : "=v"(k1) : "v"(m1), "n"(bit));
            p0[r] = __uint_as_float(e0 & k0); p1[r] = __uint_as_float(e1 & k1); }
    }
    pw[0] = (u32x4){pk2(p0[0], p0[1]), pk2(p0[2], p0[3]), pk2(p0[4], p0[5]), pk2(p0[6], p0[7])};
    pw[1] = (u32x4){pk2(p0[8], p0[9]), pk2(p0[10], p0[11]), pk2(p0[12], p0[13]), pk2(p0[14], p0[15])};
    pw[2] = (u32x4){pk2(p1[0], p1[1]), pk2(p1[2], p1[3]), pk2(p1[4], p1[5]), pk2(p1[6], p1[7])};
    pw[3] = (u32x4){pk2(p1[8], p1[9]), pk2(p1[10], p1[11]), pk2(p1[12], p1[13]), pk2(p1[14], p1[15])};
}
__device__ __forceinline__ u64 mask_le(int c) { return c >= 63 ? ~0ull : (c < 0 ? 0ull : ((2ull << c) - 1ull)); }
__device__ __forceinline__ u64 mask_ge(int a) { return a <= 0 ? ~0ull : (a > 63 ? 0ull : (~0ull << a)); }


__device__ __forceinline__ void glds16(const GAS void* gsrc, unsigned lds_dst) { unsigned keep;
    asm volatile("s_mov_b32 %0, m0\n\ts_mov_b32 m0, %2\n\ts_nop 0\n\tglobal_load_lds_dwordx4 %1, off\n\ts_mov_b32 m0, %0" : "=&s"(keep) : "v"(gsrc), "s"(lds_dst) : "memory"); }
__device__ __forceinline__ void tile_dma(const KVSrc& S, int t, unsigned kslot, unsigned vslot, const Lane& L) {
    const GAS bf16_t* ks = S.k + (size_t)(64 * t + L.lane) * S.pitch + L.wid * 8;
    const GAS bf16_t* vs = S.v + (size_t)(64 * t + 16 * (L.wid & 3) + (L.lane >> 2)) * S.pitch + (L.wid >> 2) * 32 + (L.lane & 3) * 8;
    glds16(ks, (unsigned)__builtin_amdgcn_readfirstlane(kslot + L.wid * 1040));
    glds16(vs, (unsigned)__builtin_amdgcn_readfirstlane(vslot + (L.wid >> 2) * 4096 + (L.wid & 3) * 1024));
}
#define ATT_WAIT_BAR(N) asm volatile("s_waitcnt vmcnt(" #N ") lgkmcnt(0)\n\ts_barrier" ::: "memory")
template <class MF>
__device__ __forceinline__ void attend_range(LAS char* lds, const KVSrc& S, int t0, int t1, const MF& mf, const bf16x8 (&qr)[4], float negC, f32x16& ol, f32x16 (&o)[2], const Lane& L, bool abl = false) {
    if (t0 >= t1) return;
    const bool late = L.wid >= 4;
    const unsigned lds0 = (unsigned)(size_t)lds;
    const f32x16 negm = {0.f, 0.f, 0.f, 0.f, 0.f, 0.f, 0.f, 0.f, 0.f, 0.f, 0.f, 0.f, 0.f, 0.f, 0.f, 0.f};
    (void)negC;
    tile_dma(S, t0, lds0 + L_K0, lds0 + L_V0, L);
    if (t0 + 1 < t1) tile_dma(S, t0 + 1, lds0 + L_K0 + 8320, lds0 + L_V0 + 8192, L);
    if (t0 + 2 < t1) tile_dma(S, t0 + 2, lds0 + L_K0 + 2 * 8320, lds0 + L_V0 + 2 * 8192, L);
    if (t0 + 2 < t1) ATT_WAIT_BAR(4); else if (t0 + 1 < t1) ATT_WAIT_BAR(2); else ATT_WAIT_BAR(0);
    u32x4 pwp[4];
#pragma unroll
    for (int k = 0; k < 4; ++k) asm volatile("" : "=v"(pwp[k]));
    int kcur = 0, vcur = 0, vprev = 0;
    u64 mk_next = mf(t0);
#if defined(PROBE_ABL) && PROBE_ABL == 12
    if (abl) { for (int t = t0; t < t1; ++t) { asm volatile("s_nop 0" ::: "memory"); } return; }
#endif
#if defined(PROBE_ABL) && PROBE_ABL == 13
    if (abl) { for (int t = t0; t < t1; ++t) { ATT_WAIT_BAR(0); } return; }
#endif
#if defined(PROBE_ABL) && PROBE_ABL == 14
    if (abl) { u64 acc_ = 0; for (int t = t0; t < t1; ++t) { acc_ ^= mf(t); asm volatile("s_waitcnt lgkmcnt(0)" : "+v"(acc_) :: "memory"); } asm volatile("" :: "v"(acc_)); return; }
#endif
#if defined(PROBE_ABL) && PROBE_ABL == 15
    if (abl) { for (int t = t0; t < t1; ++t) { f32x16 p0, p1; qk_tile_c(lds + L_K0, qr, negm, p0, p1, L.r32, L.hi); asm volatile("" :: "v"(p0), "v"(p1)); } return; }
#endif
#pragma unroll 1
    for (int t = t0; t < t1; ++t) {
        const u64 mk = mk_next;
        if (t + 1 < t1) mk_next = mf(t + 1);
#if defined(PROBE_ABL) && PROBE_ABL >= 10
        if (t + 3 < t1 && !abl) {
#else
        if (t + 3 < t1) {
#endif
            const int ks = kcur == 0 ? NKB - 1 : kcur - 1; int vs = vcur + 3; vs = vs >= NVB ? vs - NVB : vs;
            tile_dma(S, t + 3, lds0 + L_K0 + ks * 8320, lds0 + L_V0 + vs * 8192, L); }
#if defined(PROBE_ABL) && (PROBE_ABL == 6 || PROBE_ABL >= 10)
        if (late && t > t0 && !abl) pv_tile(lds + L_V0 + vprev * 8192, pwp, o, ol, L.lane, L.hi);
#else
        if (late && t > t0) pv_tile(lds + L_V0 + vprev * 8192, pwp, o, ol, L.lane, L.hi);
#endif
        f32x16 p0, p1;
#if defined(PROBE_ABL) && (PROBE_ABL == 6 || PROBE_ABL >= 10)
        if (abl) { p0 = negm; p1 = negm; asm volatile("" : "+v"(p0), "+v"(p1)); } else
#endif
        qk_tile_c(lds + L_K0 + kcur * 8320, qr, negm, p0, p1, L.r32, L.hi);
        u32x4 pw[4];
#if defined(PROBE_ABL) && (PROBE_ABL == 2 || PROBE_ABL >= 10)
        if (abl) {
#pragma unroll
            for (int k = 0; k < 4; ++k) pw[k] = (u32x4){__float_as_uint(p0[4 * k]) ^ (unsigned)mk, __float_as_uint(p0[4 * k + 1]), __float_as_uint(p1[4 * k + 2]), __float_as_uint(p1[4 * k + 3])}; }
        else
#endif
        mask_exp_pack(p0, p1, mk, L.hi, pw);
#if defined(PROBE_ABL) && (PROBE_ABL == 6 || PROBE_ABL >= 10)
        if (!late && !abl) pv_tile(lds + L_V0 + vcur * 8192, pw, o, ol, L.lane, L.hi);
        else if (!late) { asm volatile("" :: "v"(pw[0]), "v"(pw[1]), "v"(pw[2]), "v"(pw[3])); }
#else
        if (!late) pv_tile(lds + L_V0 + vcur * 8192, pw, o, ol, L.lane, L.hi);
#endif
        else {
#pragma unroll
            for (int k = 0; k < 4; ++k) pwp[k] = pw[k]; }
#if defined(PROBE_ABL) && PROBE_ABL == 11
        if (abl) { asm volatile("s_waitcnt lgkmcnt(0)" ::: "memory"); } else
#endif
        if (t + 3 < t1) ATT_WAIT_BAR(4); else if (t + 2 < t1) ATT_WAIT_BAR(2); else ATT_WAIT_BAR(0);
        vprev = vcur; vcur = vcur == NVB - 1 ? 0 : vcur + 1; kcur = kcur == NKB - 1 ? 0 : kcur + 1;
    }
    if (late) pv_tile(lds + L_V0 + vprev * 8192, pwp, o, ol, L.lane, L.hi);
    ATT_WAIT_BAR(0);
}
__device__ __forceinline__ void rows_to_regs(LAS float* wsf, float v, int r32, int hi, float (&sc)[16]) {
    asm volatile("s_waitcnt lgkmcnt(0)" ::: "memory");
    if (hi == 0) wsf[r32] = v;
    asm volatile("s_waitcnt lgkmcnt(0)" ::: "memory");
#pragma unroll
    for (int r = 0; r < 16; ++r) sc[r] = wsf[crow(r, hi)];
}
__device__ __forceinline__ void load_q(const bf16_t* qrow, int hi, bf16x8 (&qr)[4]) {
#pragma unroll
    for (int d0 = 0; d0 < 4; ++d0) qr[d0] = *(const GAS bf16x8*)(qrow + d0 * 16 + hi * 8);
}
template <class RowPtr>
__device__ __forceinline__ void store_o(LAS char* stage, const f32x16 (&acc)[2], const RowPtr& rowptr, int lane, int r32, int hi) {
    LAS bf16_t* stg = (LAS bf16_t*)stage;
#pragma unroll
    for (int r = 0; r < 16; ++r) { const int orow = crow(r, hi);
#pragma unroll
        for (int d0 = 0; d0 < 2; ++d0) stg[orow * 64 + d0 * 32 + r32] = (bf16_t)(pk2(acc[d0][r], 0.f) & 0xffffu); }
    asm volatile("s_waitcnt lgkmcnt(0)" ::: "memory");
#pragma unroll
    for (int i = 0; i < 4; ++i) { const int row = i * 8 + (lane >> 3), ch = lane & 7; const u32x4 v = *(LAS const u32x4*)(stg + row * 64 + ch * 8); *(GAS u32x4*)(rowptr(row) + ch * 8) = v; }
    asm volatile("s_waitcnt lgkmcnt(0)" ::: "memory");
}
}

constexpr int NWAVES = 8;
constexpr int BATCH = 4, SEQ = 4096, DM = 1024, DFF = 4096, DEPTH = 2, D_IN = 6236;
constexpr int M = BATCH * SEQ;
constexpr size_t MiB = 1u << 20;
constexpr size_t WS_ZQ = 0;
constexpr size_t WS_ZKV = 48 * MiB;
constexpr size_t WS_YS = WS_ZKV;
constexpr size_t WS_MB = 104 * MiB;
constexpr size_t WS_KC2 = WS_MB, WS_VC2 = WS_MB + 4 * MiB;
constexpr size_t WS_XB = 136 * MiB;
constexpr size_t WS_W = 168 * MiB, W_LAYER = 36 * MiB;
constexpr size_t W_IN = 0, W_G = 7 * MiB, W_BR = 13 * MiB, W_OUT = 16 * MiB, W_UP = 18 * MiB, W_DN = 26 * MiB, W_CK1 = 34 * MiB, W_CV1 = 35 * MiB;
constexpr size_t WS_BM = 240 * MiB;
constexpr size_t WS_MISC = 248 * MiB;
constexpr size_t WS_CTL = WS_MISC, CTL_BYTES = 1 * MiB;
constexpr size_t WS_COS = WS_MISC + 1 * MiB, WS_SIN = WS_MISC + 1 * MiB + 512 * 1024;
constexpr size_t WS_KCMP = WS_MISC + 2 * MiB;
constexpr size_t WS_SSQ = WS_MISC + 2 * MiB + 512 * 1024;
constexpr size_t WS_B1P = WS_MISC + 3 * MiB + 512 * 1024;
constexpr size_t WS_W2 = WS_B1P + 64 * 1024;
constexpr size_t WS_IKF = WS_MISC + 4 * MiB;
constexpr size_t WS_HMID = 0;
constexpr size_t WS_END = 256 * MiB;
constexpr int CW_BAR = 4096, CW_Q = 8192, CW_KMAX = 12288;
constexpr int LDS_BYTES = 163840, LDS_UNIT = 163776;
constexpr float C2 = 0.125f * 1.4426950408889634f, LOG2E = 1.4426950408889634f;


struct Args { const float* in[17]; float* out; unsigned char* ws; };
struct Frame {
    LAS unsigned char* lds;
    gu32* ctl;
    int tid, lane, wave, G, gw, NGW;
    unsigned char* ws;
    const struct Args* a;
};
__device__ __forceinline__ float wave_sum(float v) {
#pragma unroll
    for (int o = 1; o < 64; o <<= 1) v += __shfl_xor(v, o);
    return v;
}
__device__ __forceinline__ float wave_max(float v) {
#pragma unroll
    for (int o = 1; o < 64; o <<= 1) v = fmaxf(v, __shfl_xor(v, o));
    return v;
}
__device__ __forceinline__ float bf2f(bf16 h) { return __uint_as_float((unsigned)h << 16); }
__device__ __constant__ float c_inv_freq[32] = {
    1.0f, 0.7498942093324559f, 0.5623413251903491f, 0.4216965034285822f, 0.31622776601683794f, 0.23713737056616552f, 0.1778279410038923f, 0.1333521432163324f,
    0.1f, 0.07498942093324558f, 0.05623413251903491f, 0.042169650342858224f, 0.03162277660168379f, 0.023713737056616554f, 0.01778279410038923f, 0.01333521432163324f,
    0.01f, 0.007498942093324558f, 0.005623413251903491f, 0.004216965034285823f, 0.0031622776601683794f, 0.0023713737056616554f, 0.0017782794100389228f, 0.001333521432163324f,
    0.001f, 0.0007498942093324559f, 0.0005623413251903491f, 0.00042169650342858224f, 0.00031622776601683794f, 0.00023713737056616554f, 0.00017782794100389227f, 0.0001333521432163324f};

__device__ __forceinline__ int mix_src_col(int j) {
    if (j < 512) return j;
    if (j < 1024) return 1092 + (j - 512);
    if (j < 1536) return 1860 + (j - 1024);
    if (j < 1792) return 512 + (j - 1536);
    if (j < 2048) return 1604 + (j - 1792);
    if (j < 2304) return 2372 + (j - 2048);
    if (j < 2560) return 2628 + (j - 2304);
    if (j < 2816) return 2884 + (j - 2560);
    if (j < 3072) return 768 + (j - 2816);
    const int r = j - 3072;
    if (r < 64) return 1024 + r;
    if (r < 68) return 1088 + (r - 64);
    if (r < 92) return 3140 + (r - 68);
    return -1;
}
template <int MODE>
__device__ __forceinline__ void p0_item(const float* W, int ldw, int K, bf16* WT, int nblk, int item, const float* gain, int coff, LAS float* scr, int lane) {
    const int kb = item / nblk, nb = item % nblk, k0 = 64 * kb, n0 = 32 * nb;
    const int nq = 4 * (lane & 7), rr = lane >> 3;
    const int sc = MODE == 0 ? (n0 + nq + coff) : mix_src_col(n0 + nq);
    f32x4 v[8];
#pragma unroll
    for (int i = 0; i < 8; ++i) { v[i] = (f32x4){0.f, 0.f, 0.f, 0.f}; if (sc >= 0) v[i] = *(const GAS f32x4*)(W + (size_t)(k0 + 8 * i + rr) * ldw + sc); }
#pragma unroll
    for (int i = 0; i < 8; ++i) { const int kk = 8 * i + rr; const float g = gain ? gain[k0 + kk] : 1.0f;
        scr[kk * 33 + nq + 0] = v[i][0] * g; scr[kk * 33 + nq + 1] = v[i][1] * g; scr[kk * 33 + nq + 2] = v[i][2] * g; scr[kk * 33 + nq + 3] = v[i][3] * g; }
    LDS_WAIT(); asm volatile("" ::: "memory");
    const int c = lane & 7;
#pragma unroll
    for (int j = 0; j < 4; ++j) { const int n = (lane >> 3) + 8 * j; const LAS float* s = scr + (8 * c) * 33 + n;
        v4u o; o.x = pk2(s[0 * 33], s[1 * 33]); o.y = pk2(s[2 * 33], s[3 * 33]); o.z = pk2(s[4 * 33], s[5 * 33]); o.w = pk2(s[6 * 33], s[7 * 33]);
        *(GAS v4u*)(WT + (size_t)(n0 + n) * K + k0 + 8 * c) = o; }
    LDS_WAIT(); asm volatile("" ::: "memory");
}
__device__ __forceinline__ void p0_prologue(Frame& F) {
    LAS float* scr = (LAS float*)(F.lds + F.wave * 16384);
    constexpr int I_IN = 16 * 104, I_G = 16 * 96, I_BR = 8 * 32, I_OUT = 16 * 32, I_UP = 16 * 128, I_DN = 64 * 32, I_C1 = 32 * 8, I_C2 = 4 * 2;
    constexpr int PER_LAYER = I_IN + I_G + 3 * I_BR + I_OUT + I_UP + I_DN + 2 * I_C1 + 2 * I_C2;
    for (int it = F.gw; it < 2 * PER_LAYER; it += F.NGW) {
        const int l = it / PER_LAYER; int r = it % PER_LAYER;
        unsigned char* wl = F.ws + WS_W + (size_t)l * W_LAYER;
        const float* w_in = F.a->in[2] + (size_t)l * DM * D_IN;
        if (r < I_IN) { p0_item<1>(w_in, D_IN, DM, (bf16*)(wl + W_IN), 104, r, F.a->in[1] + l * DM, 0, scr, F.lane); continue; } r -= I_IN;
        if (r < I_G) { p0_item<0>(w_in, D_IN, DM, (bf16*)(wl + W_G), 96, r, F.a->in[1] + l * DM, 3164, scr, F.lane); continue; } r -= I_G;
        if (r < 3 * I_BR) { const int n = r / I_BR; p0_item<0>(F.a->in[12] + ((size_t)l * 3 + n) * 512 * DM, DM, 512, (bf16*)(wl + W_BR) + (size_t)n * DM * 512, 32, r % I_BR, nullptr, 0, scr, F.lane); continue; } r -= 3 * I_BR;
        if (r < I_OUT) { p0_item<0>(F.a->in[13] + (size_t)l * DM * DM, DM, DM, (bf16*)(wl + W_OUT), 32, r, nullptr, 0, scr, F.lane); continue; } r -= I_OUT;
        if (r < I_UP) { p0_item<0>(F.a->in[15] + (size_t)l * DM * DFF, DFF, DM, (bf16*)(wl + W_UP), 128, r, F.a->in[14] + l * DM, 0, scr, F.lane); continue; } r -= I_UP;
        if (r < I_DN) { p0_item<0>(F.a->in[16] + (size_t)l * DFF * DM, DM, DFF, (bf16*)(wl + W_DN), 32, r, nullptr, 0, scr, F.lane); continue; } r -= I_DN;
        if (r < I_C1) { p0_item<0>(F.a->in[8] + (size_t)l * 2048 * 256, 256, 2048, (bf16*)(wl + W_CK1), 8, r, nullptr, 0, scr, F.lane); continue; } r -= I_C1;
        if (r < I_C1) { p0_item<0>(F.a->in[10] + (size_t)l * 2048 * 256, 256, 2048, (bf16*)(wl + W_CV1), 8, r, nullptr, 0, scr, F.lane); continue; } r -= I_C1;
        if (r < I_C2) { p0_item<0>(F.a->in[9] + (size_t)l * 256 * 64, 64, 256, (bf16*)(F.ws + WS_W2) + (size_t)(l * 2 + 0) * 64 * 256, 2, r, nullptr, 0, scr, F.lane); continue; } r -= I_C2;
        p0_item<0>(F.a->in[11] + (size_t)l * 256 * 64, 64, 256, (bf16*)(F.ws + WS_W2) + (size_t)(l * 2 + 1) * 64 * 256, 2, r, nullptr, 0, scr, F.lane);
    }
    for (int it = F.gw; it < 128; it += F.NGW) {
        const int kp = it & 7, jb = (it >> 3) & 3, which = (it >> 5) & 1, l = it >> 6; const int j = jb * 64 + F.lane;
        const float* pe = (which ? F.a->in[7] : F.a->in[6]) + l * 2048; const float* w1 = (which ? F.a->in[10] : F.a->in[8]) + (size_t)l * 2048 * 256;
        float a = 0.f;
        for (int k = kp * 256; k < kp * 256 + 256; ++k) a = fmaf(pe[k], w1[(size_t)k * 256 + j], a);
        ((float*)(F.ws + WS_B1P))[((l * 2 + which) * 8 + kp) * 256 + j] = a;
    }
    for (int m = F.gw; m < M; m += F.NGW) {
        const GAS f32x4* xr = (const GAS f32x4*)(F.a->in[0] + (size_t)m * DM) + F.lane;
        GAS unsigned long long* o8 = (GAS unsigned long long*)((bf16*)(F.ws + WS_XB) + (size_t)m * DM) + F.lane;
        float s = 0.f;
#pragma unroll
        for (int j = 0; j < 4; ++j) { const f32x4 v = xr[64 * j]; s += (v.x * v.x + v.y * v.y) + (v.z * v.z + v.w * v.w);
            o8[64 * j] = (unsigned long long)pk2(v.x, v.y) | ((unsigned long long)pk2(v.z, v.w) << 32); }
        s = wave_sum(s);
        if (F.lane < 16) ((float*)(F.ws + WS_SSQ))[(size_t)m * 16 + F.lane] = F.lane == 0 ? s : 0.f;
    }
    for (int i = F.gw * 64 + F.lane; i < SEQ * 32; i += F.NGW * 64) {
        const float ang = (float)(i >> 5) * c_inv_freq[i & 31];
        ((float*)(F.ws + WS_COS))[i] = (float)cos((double)ang); ((float*)(F.ws + WS_SIN))[i] = (float)sin((double)ang);
    }
}
typedef unsigned u32x4_t __attribute__((ext_vector_type(4)));
__device__ __forceinline__ void post_group(u32x4_t raw, bool act, bool norm, bool rope, const float (&gain)[8], float scale, const float (&cs)[8], const float (&sn)[8], int lane, bf16* dst) {
    float v[8];
    v[0] = __uint_as_float(raw.x << 16); v[1] = __uint_as_float(raw.x & 0xffff0000u); v[2] = __uint_as_float(raw.y << 16); v[3] = __uint_as_float(raw.y & 0xffff0000u);
    v[4] = __uint_as_float(raw.z << 16); v[5] = __uint_as_float(raw.z & 0xffff0000u); v[6] = __uint_as_float(raw.w << 16); v[7] = __uint_as_float(raw.w & 0xffff0000u);
    float ss = ((v[0] * v[0] + v[1] * v[1]) + (v[2] * v[2] + v[3] * v[3])) + ((v[4] * v[4] + v[5] * v[5]) + (v[6] * v[6] + v[7] * v[7]));
    ss += __shfl_xor(ss, 1); ss += __shfl_xor(ss, 2); ss += __shfl_xor(ss, 4);
    const float rs = norm ? rsqrtf(ss * (1.0f / 64.0f) + 1e-6f) : 1.0f;
    const bool lo = (lane & 4) == 0;
    float r[8];
#pragma unroll
    for (int j = 0; j < 8; ++j) { const float x = norm ? v[j] * rs * gain[j] : v[j]; const float o = __shfl_xor(x, 4);
        r[j] = rope ? (lo ? (x * cs[j] - o * sn[j]) : (x * cs[j] + o * sn[j])) : x; r[j] *= scale; }
    if (act) { u32x4_t w; w.x = pk2(r[0], r[1]); w.y = pk2(r[2], r[3]); w.z = pk2(r[4], r[5]); w.w = pk2(r[6], r[7]); *(GAS u32x4_t*)dst = w; }
}
__device__ __forceinline__ void post_phase(Frame& F, int l, bool dry = false) {
    const float* qn = F.a->in[3] + l * 192; const float* kn = F.a->in[4] + l * 192;
    const int lane = F.lane, g = lane >> 3, c = lane & 7;
    float gq0[8], gq1[8], gq2[8], gk3[8], gk2[8];
#pragma unroll
    for (int j = 0; j < 8; ++j) { gq0[j] = qn[8 * c + j]; gq1[j] = qn[64 + 8 * c + j]; gq2[j] = qn[128 + 8 * c + j]; gk2[j] = kn[128 + 8 * c + j];
        gk3[j] = (g >> 1) == 0 ? kn[8 * c + j] : ((g >> 1) == 1 ? kn[64 + 8 * c + j] : kn[128 + 8 * c + j]); }
    bf16* zq = (bf16*)(F.ws + WS_ZQ); bf16* zkv = (bf16*)(F.ws + WS_ZKV);
    const float* cst = (const float*)(F.ws + WS_COS); const float* snt = (const float*)(F.ws + WS_SIN);
#pragma unroll 1
    for (int m = F.gw; m < M; m += F.NGW) {
        const int t = m & (SEQ - 1), b = m >> 12;
        float cs[8], sn[8];
        { const GAS f32x4* cp = (const GAS f32x4*)(cst + t * 32 + 8 * (c & 3)); const GAS f32x4* sp = (const GAS f32x4*)(snt + t * 32 + 8 * (c & 3));
          const f32x4 c0 = cp[0], c1 = cp[1], s0 = sp[0], s1 = sp[1];
          cs[0] = c0[0]; cs[1] = c0[1]; cs[2] = c0[2]; cs[3] = c0[3]; cs[4] = c1[0]; cs[5] = c1[1]; cs[6] = c1[2]; cs[7] = c1[3];
          sn[0] = s0[0]; sn[1] = s0[1]; sn[2] = s0[2]; sn[3] = s0[3]; sn[4] = s1[0]; sn[5] = s1[1]; sn[6] = s1[2]; sn[7] = s1[3]; }
        bf16* pqa = zq + (size_t)m * 512 + lane * 8; bf16* pqb = pqa + (size_t)M * 512; bf16* pqc = pqa + (size_t)2 * M * 512;
        const int t3 = (g >> 1) < 2 ? (g >> 1) : (g >> 1) + 1;
        bf16* p3 = zkv + (size_t)t3 * M * 256 + (size_t)m * 256 + (g & 1) * 64 + c * 8;
        const bf16* s4 = g < 4 ? zkv + (size_t)2 * M * 256 + (size_t)m * 256 + g * 64 + c * 8 : zkv + (size_t)5 * M * 256 + (size_t)m * 256 + (g - 4) * 64 + c * 8;
        bf16* d4 = g < 2 ? (bf16*)(F.ws + WS_KC2) + ((size_t)(b * 2 + g) * SEQ + t) * 64 + c * 8
                 : (g < 4 ? (bf16*)(F.ws + WS_VC2) + ((size_t)(b * 2 + (g - 2)) * SEQ + t) * 64 + c * 8 : (bf16*)s4);
        const bf16* p5 = zkv + (size_t)6 * M * 256 + (size_t)m * 256 + c * 8;
        bf16* d5 = (bf16*)(F.ws + WS_IKF) + ((size_t)(b * (SEQ / 32) + (t >> 5)) * 8 + c) * 256 + (t & 31) * 8;
        const u32x4_t r0 = *(const GAS u32x4_t*)pqa, r1 = *(const GAS u32x4_t*)pqb, r2 = *(const GAS u32x4_t*)pqc, r3 = *(const GAS u32x4_t*)p3, r4 = *(const GAS u32x4_t*)s4;
        const u32x4_t r5 = *(const GAS u32x4_t*)p5;
        post_group(r0, !dry, true, true, gq0, C2, cs, sn, lane, pqa);
        post_group(r1, !dry, true, true, gq1, C2, cs, sn, lane, pqb);
        post_group(r2, !dry, true, true, gq2, C2, cs, sn, lane, pqc);
        post_group(r3, !dry, true, true, gk3, 1.f, cs, sn, lane, p3);
        post_group(r4, !dry, g < 2, g < 2 || g >= 4, gk2, 1.f, cs, sn, lane, d4);
        post_group(r5, g == 0 && !dry, false, true, gk2, 1.f, cs, sn, lane, d5);
    }
}

#define WAVE_LDS_FENCE() asm volatile("s_waitcnt lgkmcnt(0)" ::: "memory")
__device__ __forceinline__ int next_unit(Frame& F, gu32* counter) {
    LAS int* slot = (LAS int*)(F.lds + LDS_UNIT);
    __syncthreads();
    if (F.tid == 0) *slot = (int)__hip_atomic_fetch_add(counter, 1u, RLX_AGENT);
    __syncthreads();
    return *slot;
}
__device__ __forceinline__ unsigned f2key(float f) { const unsigned u = __float_as_uint(f); return (u & 0x80000000u) ? ~u : (u | 0x80000000u); }
__device__ __forceinline__ float dpp_quad_sum(float v) {
    v += __int_as_float(__builtin_amdgcn_update_dpp(0, __float_as_int(v), 0xB1, 0xF, 0xF, true));
    v += __int_as_float(__builtin_amdgcn_update_dpp(0, __float_as_int(v), 0x4E, 0xF, 0xF, true));
    return v;
}
__device__ __forceinline__ void radix_select_list(LAS const unsigned* list, int nblk, int k, LAS unsigned* hist, int lane, unsigned& T, int& need) {
    typedef unsigned u32x4_ __attribute__((ext_vector_type(4)));
    unsigned prefix = 0u; int kk = k;
#pragma unroll 1
    for (int pass = 0; pass < 4; ++pass) {
        const int shift = 24 - 8 * pass;
#pragma unroll
        for (int i = 0; i < 4; ++i) hist[lane * 4 + i] = 0u;
        WAVE_LDS_FENCE();
#pragma unroll 2
        for (int jb = 0; jb < nblk; ++jb) { const u32x4_ v = *(LAS const u32x4_*)(list + jb * 256 + lane * 4);
#pragma unroll
            for (int c = 0; c < 4; ++c) { const unsigned key = v[c];
                const unsigned bin = (pass == 0 || (key >> (shift + 8)) == prefix) ? ((key >> shift) & 255u) : 256u + (unsigned)lane;
                __hip_atomic_fetch_add(&hist[bin], 1u, __ATOMIC_RELAXED, __HIP_MEMORY_SCOPE_WORKGROUP); } }
        WAVE_LDS_FENCE();
        const unsigned h0 = hist[lane * 4], h1 = hist[lane * 4 + 1], h2 = hist[lane * 4 + 2], h3 = hist[lane * 4 + 3];
        const int tot4 = (int)(h0 + h1 + h2 + h3);
        int pre = tot4;
        pre += __builtin_amdgcn_update_dpp(0, pre, 0x111, 0xf, 0xf, false);
        pre += __builtin_amdgcn_update_dpp(0, pre, 0x112, 0xf, 0xf, false);
        pre += __builtin_amdgcn_update_dpp(0, pre, 0x114, 0xf, 0xf, false);
        pre += __builtin_amdgcn_update_dpp(0, pre, 0x118, 0xf, 0xf, false);
        pre += __builtin_amdgcn_update_dpp(0, pre, 0x142, 0xa, 0xf, false);
        pre += __builtin_amdgcn_update_dpp(0, pre, 0x143, 0xc, 0xf, false);
        const int total = __builtin_amdgcn_readlane(pre, 63);
        const int above = total - pre;
        const int a3 = above, a2 = a3 + (int)h3, a1 = a2 + (int)h2, a0 = a1 + (int)h1;
        int dsel = -1, nk = 0;
        if (a3 < kk && kk <= a3 + (int)h3) { dsel = lane * 4 + 3; nk = kk - a3; }
        else if (a2 < kk && kk <= a2 + (int)h2) { dsel = lane * 4 + 2; nk = kk - a2; }
        else if (a1 < kk && kk <= a1 + (int)h1) { dsel = lane * 4 + 1; nk = kk - a1; }
        else if (a0 < kk && kk <= a0 + (int)h0) { dsel = lane * 4 + 0; nk = kk - a0; }
        const unsigned long long bal = __ballot(dsel >= 0);
        const int src = (int)__builtin_ctzll(bal);
        dsel = __builtin_amdgcn_readlane(dsel, src); nk = __builtin_amdgcn_readlane(nk, src);
        WAVE_LDS_FENCE();
        prefix = (prefix << 8) | (unsigned)dsel; kk = nk;
    }
    T = prefix; need = kk;
}
__device__ __forceinline__ void select_unit(Frame& F, int b, int qblk, int abl = 0) {
    using namespace att;
    int tid_ = F.tid; asm volatile("" : "+v"(tid_));
    const int lane = tid_ & 63, r32 = lane & 31, hi = lane >> 5, w = F.wave;
    LAS unsigned* sc = (LAS unsigned*)F.lds;
    LAS unsigned* hist = (LAS unsigned*)(F.lds + 131072) + w * 320;
    LAS unsigned* cand = (LAS unsigned*)(F.lds + 131072 + 10240) + w * 512;
    const int t0 = qblk * 8; const size_t m0 = (size_t)b * SEQ + t0;
    const bf16* IQ = (const bf16*)(F.ws + WS_ZKV) + (size_t)5 * M * 256; const bf16* MISC = (const bf16*)(F.ws + WS_ZKV) + (size_t)6 * M * 256;
    const bf16* IKF = (const bf16*)(F.ws + WS_IKF) + (size_t)b * SEQ * 64;
    u64* BM = (u64*)(F.ws + WS_BM);
    const int nkeys = t0 + 8;
    if (nkeys > 256 && abl < 2) {
        bf16x8 iqf[4];
        { const bf16* qrow = IQ + (m0 + (r32 >> 2)) * 256 + (r32 & 3) * 64;
#pragma unroll
          for (int d0 = 0; d0 < 4; ++d0) iqf[d0] = *(const GAS bf16x8*)(qrow + d0 * 16 + hi * 8); }
        const float wl = bf2f(((const GAS bf16*)MISC)[(m0 + (r32 >> 2)) * 256 + 64 + (r32 & 3)]);
        const int ntile = (nkeys + 31) >> 5; const int g = r32 & 3;
#pragma unroll 1
        for (int tile0 = w; tile0 < ntile; tile0 += 16) {
            bf16x8 kf[2][4];
#pragma unroll
            for (int u = 0; u < 2; ++u) { const int tile = tile0 + 8 * u < ntile ? tile0 + 8 * u : tile0;
                const bf16* kt = IKF + (size_t)tile * 2048 + hi * 256 + r32 * 8;
#pragma unroll
                for (int d0 = 0; d0 < 4; ++d0) kf[u][d0] = *(const GAS bf16x8*)(kt + d0 * 512); }
#pragma unroll
            for (int u = 0; u < 2; ++u) { const int tile = tile0 + 8 * u;
                if (tile < ntile) {
                    const int s0 = tile * 32;
                    f32x16 acc;
#pragma unroll
                    for (int r = 0; r < 16; ++r) acc[r] = 0.f;
#pragma unroll
                    for (int d0 = 0; d0 < 4; ++d0) acc = __builtin_amdgcn_mfma_f32_32x32x16_bf16(kf[u][d0], iqf[d0], acc, 0, 0, 0);
                    float v[16];
#pragma unroll
                    for (int r = 0; r < 16; ++r) v[r] = dpp_quad_sum(__builtin_amdgcn_fmed3f(acc[r], 0.f, __builtin_inff()) * wl);
                    u32x4 o;
#pragma unroll
                    for (int j = 0; j < 4; ++j) o[j] = f2key(g == 0 ? v[j] : (g == 1 ? v[4 + j] : (g == 2 ? v[8 + j] : v[12 + j])));
                    *(LAS u32x4*)(sc + (r32 >> 2) * 4096 + s0 + 8 * g + 4 * hi) = o;
                } }
        }
    }
    __syncthreads();
    if (abl != 1) {
        const int t = t0 + w, n = t + 1; LAS unsigned* row = sc + w * 4096;
        u64 myword = 0ull;
        if (n <= 256) {
            const int c0 = 64 * lane;
            myword = (c0 + 63 < n) ? ~0ull : (c0 >= n ? 0ull : ((1ull << (n - c0)) - 1ull));
        } else {
            const int nblk = (n + 255) >> 8;
            { const int s = (n & ~3) + lane * 4;
              if (s < nblk * 256) { u32x4 v = *(LAS u32x4*)(row + s);
#pragma unroll
                  for (int c = 0; c < 4; ++c) if (s + c >= n) v[c] = 0u;
                  *(LAS u32x4*)(row + s) = v; } }
            WAVE_LDS_FENCE();
            unsigned T = 0u; int need = 0; bool done = false;
            if (n > 512 && abl != 5) {
#pragma unroll
                for (int c = 0; c < 8; ++c) { const int i = lane + 64 * c; cand[i] = row[(i * n) >> 9]; }
                WAVE_LDS_FENCE();
                const float er = 131072.0f / (float)n;
                int rr = (int)(er + 2.5f * __builtin_sqrtf(er * (1.0f - 256.0f / (float)n)) + 2.0f); rr = rr > 512 ? 512 : rr;
                unsigned P; int dummy; radix_select_list(cand, 2, rr, hist, lane, P, dummy);
                int C = 0; bool ovf = false;
#pragma unroll 1
                for (int jb = 0; jb < nblk; ++jb) { const u32x4 v = *(LAS const u32x4*)(row + jb * 256 + lane * 4);
#pragma unroll
                    for (int c = 0; c < 4; ++c) { const bool in = v[c] > P; const u64 bal = __ballot(in); const int pos = C + __builtin_popcountll(bal & ((1ull << lane) - 1ull));
                        C += __builtin_popcountll(bal); if (C > 512) ovf = true;
                        if (in && !ovf) cand[pos] = v[c]; } }
                if (!ovf && C >= 256) {
                    WAVE_LDS_FENCE();
                    const int cb = (C + 255) >> 8;
                    { const int s = C + lane; if (s < cb * 256) cand[s] = 0u; const int s2 = s + 64; if (s2 < cb * 256) cand[s2] = 0u; const int s3 = s + 128; if (s3 < cb * 256) cand[s3] = 0u; const int s4 = s + 192; if (s4 < cb * 256) cand[s4] = 0u; }
                    WAVE_LDS_FENCE();
                    radix_select_list(cand, cb, 256, hist, lane, T, need); done = true;
                }
            }
            if (!done && abl < 3) radix_select_list(row, nblk, 256, hist, lane, T, need);
            int base = 0;
            const int nch = abl >= 4 ? 0 : (n + 63) >> 6;
#pragma unroll 1
            for (int c = 0; c < nch; c += 4) {
                unsigned vv[4];
#pragma unroll
                for (int u2 = 0; u2 < 4; ++u2) vv[u2] = row[64 * (c + u2) + lane];
#pragma unroll
                for (int u2 = 0; u2 < 4; ++u2) {
                    const int s = 64 * (c + u2) + lane; const bool valid = s < n; const unsigned key = valid ? vv[u2] : 0u;
                    const bool gt = valid && key > T, eq = valid && key == T;
                    const u64 beq = __ballot(eq);
                    const int rank = base + __builtin_popcountll(beq & ((1ull << lane) - 1ull));
                    const u64 word = __ballot(gt || (eq && rank < need));
                    if (lane == c + u2) myword = word;
                    base += __builtin_popcountll(beq);
                }
            }
        }
        if (abl >= 2) ((GAS u64*)(F.ws + WS_MB + 24 * MiB))[((size_t)b * SEQ + t) * 64 + lane] = myword;
        else ((GAS u64*)BM)[((size_t)b * SEQ + t) * 64 + lane] = myword;
    }
    __syncthreads();
}
__device__ __forceinline__ void compress_unit(Frame& F, int l, int u) {
    using namespace att;
    int tid_ = F.tid; asm volatile("" : "+v"(tid_));
    const int lane = tid_ & 63, r32 = lane & 31, hi = lane >> 5, w = F.wave;
    const int which = u & 1, h = (u >> 1) & 1, b = (u >> 2) & 3, cb = u >> 4;
    const bf16* src = (const bf16*)(F.ws + (which ? WS_VC2 : WS_KC2)) + (size_t)(b * 2 + h) * SEQ * 64;
    const bf16* W1t = (const bf16*)(F.ws + WS_W + (size_t)l * W_LAYER + (which ? W_CV1 : W_CK1));
    const bf16* W2t = (const bf16*)(F.ws + WS_W2) + (size_t)(l * 2 + which) * 64 * 256;
    const float* b1p = (const float*)(F.ws + WS_B1P) + (size_t)(l * 2 + which) * 8 * 256;
    LAS bf16* hid = (LAS bf16*)F.lds;
    int cc = 32 * cb + r32; if (cc > 254) cc = 254;
    const bf16* arow = src + (size_t)(16 * cc) * 64 + hi * 8;
    const bf16* brow = W1t + (size_t)(32 * w + r32) * 2048 + hi * 8;
    f32x16 acc;
#pragma unroll
    for (int r = 0; r < 16; ++r) acc[r] = 0.f;
#pragma unroll 4
    for (int ks = 0; ks < 128; ++ks) { const bf16x8 a = *(const GAS bf16x8*)(arow + ks * 16), bb = *(const GAS bf16x8*)(brow + ks * 16); acc = __builtin_amdgcn_mfma_f32_32x32x16_bf16(a, bb, acc, 0, 0, 0); }
    float b1 = 0.f;
#pragma unroll
    for (int kp = 0; kp < 8; ++kp) b1 += ((const GAS float*)b1p)[kp * 256 + 32 * w + r32];
#pragma unroll
    for (int r = 0; r < 16; ++r) hid[crow(r, hi) * 264 + 32 * w + r32] = (bf16)f2bf(fmaxf(acc[r] + b1, 0.f));
    __syncthreads();
    if (w < 2) {
        f32x16 o;
#pragma unroll
        for (int r = 0; r < 16; ++r) o[r] = 0.f;
        const bf16* w2row = W2t + (size_t)(32 * w + r32) * 256 + hi * 8;
#pragma unroll
        for (int ks = 0; ks < 16; ++ks) { const bf16x8 a = *(LAS const bf16x8*)(hid + r32 * 264 + ks * 16 + hi * 8), bb = *(const GAS bf16x8*)(w2row + ks * 16); o = __builtin_amdgcn_mfma_f32_32x32x16_bf16(a, bb, o, 0, 0, 0); }
        bf16* dst = (bf16*)(F.ws + WS_KCMP) + ((size_t)((which * 4 + b) * 2 + h) * 256) * 64;
        float mx = 0.f;
#pragma unroll
        for (int r = 0; r < 16; ++r) { const int c = 32 * cb + crow(r, hi); const float v = c < 255 ? o[r] : 0.f; mx = fmaxf(mx, fabsf(v)); ((GAS bf16*)dst)[(size_t)c * 64 + 32 * w + r32] = (bf16)f2bf(v); }
        if (which == 0) { mx = wave_max(mx); if (lane == 0) __hip_atomic_fetch_max(F.ctl + CW_KMAX + 64 * (l * 8 + b * 2 + h), __float_as_uint(mx), RLX_AGENT); }
    }
    __syncthreads();
}
struct UnitGeom { int b, kvh, i; att::Lane L; int q; int head; size_t mrow; };
__device__ __forceinline__ UnitGeom unit_geom(Frame& F, int b, int kvh, int i) {
    int tid = F.tid; asm volatile("" : "+v"(tid));
    UnitGeom U; U.b = b; U.kvh = kvh; U.i = i; U.L.tid = tid; U.L.lane = tid & 63; U.L.r32 = tid & 31; U.L.hi = (tid >> 5) & 1; U.L.wid = F.wave;
    U.q = 64 * i + 8 * F.wave + (U.L.r32 >> 2); U.head = 4 * kvh + (U.L.r32 & 3); U.mrow = (size_t)b * SEQ + U.q; return U;
}
__device__ __forceinline__ void branch_finish(LAS float* wsf, const att::f32x16& ol, const float (&extra)[4], float rowscale, bool has_scale, const att::f32x16 (&o)[2], att::f32x16 (&acc)[2], const att::Lane& L, bool first) {
    float sc[16];
    if (has_scale) att::rows_to_regs(wsf, rowscale, L.r32, L.hi, sc);
#pragma unroll
    for (int r = 0; r < 16; ++r) { const float lf = ol[r] + extra[r & 3]; const float inv = lf > 0.f ? __builtin_amdgcn_rcpf(lf) : 0.f; sc[r] = has_scale ? sc[r] * inv : inv; }
#pragma unroll
    for (int d0 = 0; d0 < 2; ++d0)
#pragma unroll
        for (int r = 0; r < 16; ++r) acc[d0][r] = first ? o[d0][r] * sc[r] : acc[d0][r] + o[d0][r] * sc[r];
}
__device__ __forceinline__ void branch_finish_lds(LAS float* wsf, LAS float* accw, const att::f32x16& ol, float rowscale, const att::f32x16 (&o)[2], const att::Lane& L, bool first) {
    float sc[16]; att::rows_to_regs(wsf, rowscale, L.r32, L.hi, sc);
#pragma unroll
    for (int r = 0; r < 16; ++r) sc[r] = ol[r] > 0.f ? sc[r] * __builtin_amdgcn_rcpf(ol[r]) : 0.f;
#pragma unroll
    for (int d0 = 0; d0 < 2; ++d0)
#pragma unroll
        for (int r = 0; r < 16; ++r) { float v = o[d0][r] * sc[r]; if (!first) v += accw[(d0 * 16 + r) * 64 + L.lane]; accw[(d0 * 16 + r) * 64 + L.lane] = v; }
}
__device__ __forceinline__ float gain_bound(const float* g, int lane) { return wave_max(fabsf(g[lane])); }

template <int KIND  >
__device__ __forceinline__ void simple_unit(Frame& F, int l, int b, int kvh, int i, bf16* odst = nullptr) {
    using namespace att;
    const UnitGeom U = unit_geom(F, b, kvh, i); const Lane& L = U.L;
    constexpr int QT = KIND == 0 ? 1 : 0, KT = KIND == 0 ? 1 : 0, NM = KIND == 0 ? 1 : 0;
    bf16* Q = (bf16*)(F.ws + WS_ZQ) + (size_t)QT * M * 512; const bf16* KV = (const bf16*)(F.ws + WS_ZKV) + (size_t)KT * M * 256;
    bf16x8 qr[4]; load_q(Q + U.mrow * 512 + U.head * 64, L.hi, qr);
    const float C = 0.f; (void)NM;
    KVSrc S{(const GAS bf16*)(KV + (size_t)b * SEQ * 256 + kvh * 64), (const GAS bf16*)(KV + (size_t)b * SEQ * 256 + 128 + kvh * 64), 256, SEQ};
    f32x16 ol, o[2];
#pragma unroll
    for (int r = 0; r < 16; ++r) { o[0][r] = 0.f; o[1][r] = 0.f; ol[r] = 0.f; }
    const int q = U.q;
    if (KIND == 0) {
        auto mf = [q](int t) -> u64 { return mask_le(q - 64 * t) & mask_ge(q - 127 - 64 * t); };
        attend_range((LAS char*)F.lds, S, i - 2 < 0 ? 0 : i - 2, i + 1, mf, qr, -C, ol, o, L);
    } else {
        LAS char* mrows = (LAS char*)F.lds + L_OST + L.wid * 8192 + 4096;
        { const GAS u32x4* src = (const GAS u32x4*)((const GAS u64*)(F.ws + WS_BM) + ((size_t)b * SEQ + 64 * i + 8 * L.wid) * 64);
#pragma unroll
          for (int k = 0; k < 4; ++k) *(LAS u32x4*)(mrows + (k * 64 + L.lane) * 16) = src[k * 64 + L.lane];
          WAVE_LDS_FENCE(); }
        LAS const char* mrow = mrows + (L.r32 >> 2) * 512;
        auto mf = [mrow](int t) -> u64 { return *(LAS const u64*)(mrow + t * 8); };
#ifdef PROBE_TILES
        attend_range((LAS char*)F.lds, S, 0, odst ? (i + 1 < PROBE_TILES ? i + 1 : PROBE_TILES) : i + 1, mf, qr, -C, ol, o, L, odst != nullptr);
#else
        attend_range((LAS char*)F.lds, S, 0, i + 1, mf, qr, -C, ol, o, L, odst != nullptr);
#endif
    }
    const UnitGeom V = unit_geom(F, b, kvh, i); const Lane& L2 = V.L;
    float extra[4] = {0.f, 0.f, 0.f, 0.f};
    if (KIND == 0) {
#pragma unroll
        for (int g = 0; g < 4; ++g) extra[g] = __builtin_amdgcn_exp2f(F.a->in[5][l * 8 + 4 * kvh + g] * LOG2E);
    }
    f32x16 acc[2];
    branch_finish((LAS float*)((LAS char*)F.lds + L_WSF) + L2.wid * WSF_W, ol, extra, 1.f, false, o, acc, L2, true);
    bf16* Q2 = (bf16*)(F.ws + WS_ZQ) + (size_t)QT * M * 512;
    const size_t tok0 = (size_t)b * SEQ + 64 * i + 8 * L2.wid; const int kvh4 = 4 * kvh;
    bf16* Od = odst ? odst : Q2;
    auto rowptr = [Od, tok0, kvh4](int row) -> bf16* { return Od + (tok0 + (row >> 2)) * 512 + (kvh4 + (row & 3)) * 64; };
    store_o((LAS char*)F.lds + L_OST + L2.wid * 8192, acc, rowptr, L2.lane, L2.r32, L2.hi);
}
__device__ __forceinline__ void nsa_unit(Frame& F, int l, int b, int kvh, int i, bf16* odst = nullptr) {
    using namespace att;
    f32x16 o[2], ol;
    bf16x8 qr[4];
    {
        const UnitGeom U = unit_geom(F, b, kvh, i); const Lane& L = U.L;
        const bf16* Q = (const bf16*)(F.ws + WS_ZQ) + (size_t)2 * M * 512; const bf16* MISC = (const bf16*)(F.ws + WS_ZKV) + (size_t)6 * M * 256;
        load_q(Q + U.mrow * 512 + U.head * 64, L.hi, qr);
        LAS float* wsf = (LAS float*)((LAS char*)F.lds + L_WSF) + L.wid * WSF_W;
#pragma unroll
        for (int br = 0; br < 3; ++br) wsf[64 + br * 64 + L.lane] = pg8::sigmoidf_(bf2f(((const GAS bf16*)MISC)[U.mrow * 256 + 68 + U.head * 3 + br]));
        WAVE_LDS_FENCE();
    }
    const float Ck = 0.f, Cc = 0.f;
    const int qmax = 64 * i + 63; const int nvmax = qmax >= 31 ? (((qmax - 31) >> 4) + 1 < 255 ? ((qmax - 31) >> 4) + 1 : 255) : 0;
    const int tc = (nvmax + 63) >> 6;
    const bf16* kcmp = (const bf16*)(F.ws + WS_KCMP) + (size_t)((0 * 4 + b) * 2 + kvh) * 256 * 64; const bf16* vcmp = (const bf16*)(F.ws + WS_KCMP) + (size_t)((1 * 4 + b) * 2 + kvh) * 256 * 64;
    {
        const UnitGeom U = unit_geom(F, b, kvh, i); const Lane& L = U.L; const int q = U.q;
        const int nval = q >= 31 ? (((q - 31) >> 4) + 1 < 255 ? ((q - 31) >> 4) + 1 : 255) : 0;
        KVSrc Sc{(const GAS bf16*)kcmp, (const GAS bf16*)vcmp, 64, 256};
        auto mfc = [nval](int t) -> u64 { return mask_le(nval - 1 - 64 * t); };
#pragma unroll
        for (int r = 0; r < 16; ++r) { o[0][r] = 0.f; o[1][r] = 0.f; ol[r] = 0.f; }
        attend_range((LAS char*)F.lds, Sc, 0, tc, mfc, qr, -Cc, ol, o, L);
    }
    const UnitGeom U = unit_geom(F, b, kvh, i); const Lane& L = U.L; const int q = U.q;
    LAS float* wsf = (LAS float*)((LAS char*)F.lds + L_WSF) + L.wid * WSF_W;
    LAS float* accw = (LAS float*)((LAS char*)F.lds + L_OST + L.wid * 8192);
    const int nval = q >= 31 ? (((q - 31) >> 4) + 1 < 255 ? ((q - 31) >> 4) + 1 : 255) : 0;
    auto mfc = [nval](int t) -> u64 { return mask_le(nval - 1 - 64 * t); };
    WAVE_LDS_FENCE();
    if (L.r32 == 0) {
#pragma unroll
        for (int r = 0; r < 16; ++r) wsf[32 + crow(r, L.hi)] = ol[r]; }
    WAVE_LDS_FENCE();
    const float lc = wsf[32 + L.r32]; const float rlc = lc > 0.f ? __builtin_amdgcn_rcpf(lc) : 0.f;
    branch_finish_lds(wsf, accw, ol, wsf[64 + L.lane], o, L, true);
    LAS float* impw = (LAS float*)((LAS char*)F.lds + L_IMP) + L.wid * 512;
#pragma unroll
    for (int k = 0; k < 8; ++k) impw[L.lane + 64 * k] = 0.f;
    WAVE_LDS_FENCE();
    for (int t = 0; t < tc; ++t) {
        f32x16 p0, p1;
#pragma unroll
        for (int r = 0; r < 16; ++r) { p0[r] = 0.f; p1[r] = 0.f; }
        qk_tile((LAS char*)F.lds + L_K0 + t * 8320, qr, p0, p1, L.r32, L.hi);
        const u64 mk = mfc(t); const unsigned m0 = (unsigned)(mk >> (4 * L.hi)), m1 = (unsigned)(mk >> (32 + 4 * L.hi));
        const int qloc = L.r32 >> 2; const bool wr = (L.r32 & 3) == 0;
#pragma unroll
        for (int half = 0; half < 2; ++half)
#pragma unroll
            for (int m = 0; m < 4; ++m) {
                float e[4];
#pragma unroll
                for (int k = 0; k < 4; ++k) { const int r = 4 * m + k, bit = k + 8 * m; const float x = half ? p1[r] : p0[r]; const unsigned mm = half ? m1 : m0;
                    e[k] = ((mm >> bit) & 1u) ? __builtin_amdgcn_exp2f(x) * rlc : 0.f; }
                const float core = dpp_quad_sum((e[0] + e[1]) + (e[2] + e[3])), edge = dpp_quad_sum(e[3]);
                const int j = 16 * t + 8 * half + 2 * m + L.hi;
                if (wr) { impw[qloc * 64 + j] += core; }
                WAVE_LDS_FENCE();
                if (wr && j + 1 < 64) { impw[qloc * 64 + j + 1] += edge; }
                WAVE_LDS_FENCE();
            }
    }
    __syncthreads();
    {
        const int qloc = L.lane >> 3, sub = L.lane & 7; const int cur = i;
        u64 keys[8];
#pragma unroll
        for (int k = 0; k < 8; ++k) { const int j = sub + 8 * k; float v = impw[qloc * 64 + j];
            if (j == 0 || j == cur || j == cur - 1) v = 1e9f;
            if (j > cur) v = -1e30f;
            keys[k] = ((u64)f2key(v) << 32) | (u64)(63 - j); }
        u64 selm = 0ull; unsigned used = 0u;
#pragma unroll 1
        for (int it = 0; it < 16; ++it) {
            u64 best = 0ull;
#pragma unroll
            for (int k = 0; k < 8; ++k) { const u64 c = ((used >> k) & 1u) ? 0ull : keys[k]; best = c > best ? c : best; }
#pragma unroll
            for (int o2 = 1; o2 < 8; o2 <<= 1) { const unsigned lo = __shfl_xor((unsigned)best, o2), hi2 = __shfl_xor((unsigned)(best >> 32), o2); const u64 ob = ((u64)hi2 << 32) | lo; best = ob > best ? ob : best; }
            const int jsel = 63 - (int)(best & 63ull);
            if ((jsel & 7) == sub) used |= 1u << (jsel >> 3);
            selm |= 1ull << jsel;
        }
        LAS u64* selw = (LAS u64*)((LAS char*)F.lds + L_SEL) + L.wid * 8;
        if (sub == 0) selw[qloc] = selm;
        WAVE_LDS_FENCE();
    }
    {
        const UnitGeom X = unit_geom(F, b, kvh, i); const Lane& L = X.L; const int q = X.q;
        const u64 sel = ((LAS const u64*)((LAS char*)F.lds + L_SEL))[L.wid * 8 + (L.r32 >> 2)];
        const bf16* KV = (const bf16*)(F.ws + WS_ZKV) + (size_t)3 * M * 256;
        KVSrc S{(const GAS bf16*)(KV + (size_t)b * SEQ * 256 + kvh * 64), (const GAS bf16*)(KV + (size_t)b * SEQ * 256 + 128 + kvh * 64), 256, SEQ};
        auto mf = [sel, q](int t) -> u64 { return ((sel >> t) & 1ull) ? mask_le(q - 64 * t) : 0ull; };
#pragma unroll
        for (int r = 0; r < 16; ++r) { o[0][r] = 0.f; o[1][r] = 0.f; ol[r] = 0.f; }
        attend_range((LAS char*)F.lds, S, 0, i + 1, mf, qr, -Ck, ol, o, L);
        const UnitGeom W = unit_geom(F, b, kvh, i); LAS float* wsf2 = (LAS float*)((LAS char*)F.lds + L_WSF) + W.L.wid * WSF_W;
        branch_finish_lds(wsf2, (LAS float*)((LAS char*)F.lds + L_OST + W.L.wid * 8192), ol, wsf2[128 + W.L.lane], o, W.L, false);
    }
    {
        const UnitGeom X = unit_geom(F, b, kvh, i); const Lane& L = X.L; const int q = X.q;
        const bf16* KV = (const bf16*)(F.ws + WS_ZKV) + (size_t)4 * M * 256;
        KVSrc S{(const GAS bf16*)(KV + (size_t)b * SEQ * 256 + kvh * 64), (const GAS bf16*)(KV + (size_t)b * SEQ * 256 + 128 + kvh * 64), 256, SEQ};
        auto mf = [q](int t) -> u64 { return mask_le(q - 64 * t) & mask_ge(q - 511 - 64 * t); };
#pragma unroll
        for (int r = 0; r < 16; ++r) { o[0][r] = 0.f; o[1][r] = 0.f; ol[r] = 0.f; }
        attend_range((LAS char*)F.lds, S, i - 8 < 0 ? 0 : i - 8, i + 1, mf, qr, -Ck, ol, o, L);
        const UnitGeom W = unit_geom(F, b, kvh, i); LAS float* wsf2 = (LAS float*)((LAS char*)F.lds + L_WSF) + W.L.wid * WSF_W;
        branch_finish_lds(wsf2, (LAS float*)((LAS char*)F.lds + L_OST + W.L.wid * 8192), ol, wsf2[192 + W.L.lane], o, W.L, false);
    }
    {
        const UnitGeom X = unit_geom(F, b, kvh, i); const Lane& L = X.L;
        LAS float* accw2 = (LAS float*)((LAS char*)F.lds + L_OST + L.wid * 8192);
        const size_t tok0 = (size_t)b * SEQ + 64 * i + 8 * L.wid; const int kvh4 = 4 * kvh;
        bf16* Od = odst ? odst : (bf16*)(F.ws + WS_ZQ) + (size_t)2 * M * 512;
        auto rowptr = [Od, tok0, kvh4](int row) -> bf16* { return Od + (tok0 + (row >> 2)) * 512 + (kvh4 + (row & 3)) * 64; };
        f32x16 acc[2];
#pragma unroll
        for (int d0 = 0; d0 < 2; ++d0)
#pragma unroll
            for (int r = 0; r < 16; ++r) acc[d0][r] = accw2[(d0 * 16 + r) * 64 + L.lane];
        WAVE_LDS_FENCE();
        store_o((LAS char*)F.lds + L_OST + L.wid * 8192, acc, rowptr, L.lane, L.r32, L.hi);
    }
}

__global__ void __launch_bounds__(NWAVES * 64, 2) mk_fwd(Args args) {
    extern __shared__ __attribute__((aligned(16))) unsigned char lds_raw[];
    LAS unsigned char* lds = (LAS unsigned char*)lds_raw;
    volatile LAS unsigned* MISCW = (volatile LAS unsigned*)(lds + LDS_UNIT + 16);
    if (threadIdx.x < 8) MISCW[threadIdx.x] = 0u;
    __syncthreads();
    (void)xcd_barrier_post((unsigned*)((gu32*)(args.ws + WS_CTL) + CW_BAR), MISCW);
#define GRID_BARRIER() do { unsigned char* wsb_ = args.ws; asm volatile("" : "+s"(wsb_)); XcdBarrier bar_; bar_.bar = (unsigned*)((gu32*)(wsb_ + WS_CTL) + CW_BAR); bar_.x = xb_xcc_id(); \
    bar_.st = (volatile LAS unsigned*)(lds + LDS_UNIT + 16); xcd_barrier(bar_); } while (0)
#define MKFRAME() Frame F; { unsigned char* ws_ = args.ws; asm volatile("" : "+s"(ws_)); int tid_ = threadIdx.x; asm volatile("" : "+v"(tid_)); \
    F.lds = lds; F.tid = tid_; F.lane = tid_ & 63; F.wave = __builtin_amdgcn_readfirstlane(tid_ >> 6); F.G = gridDim.x; F.gw = 0; F.NGW = F.G * NWAVES; \
    F.ws = ws_; F.ctl = (gu32*)(ws_ + WS_CTL); F.a = &args; } int bid = blockIdx.x; asm volatile("" : "+s"(bid)); F.gw = bid * NWAVES + F.wave; \
    unsigned char* ws = F.ws; bf16* XB = (bf16*)(ws + WS_XB); bf16* MB = (bf16*)(ws + WS_MB); bf16* ZQ = (bf16*)(ws + WS_ZQ); bf16* ZKV = (bf16*)(ws + WS_ZKV); bf16* YS = (bf16*)(ws + WS_YS); bf16* HM = (bf16*)(ws + WS_HMID); \
    float* SSQ = (float*)(ws + WS_SSQ); (void)XB; (void)MB; (void)ZQ; (void)ZKV; (void)YS; (void)HM; (void)SSQ;
#define WL(l) (ws + WS_W + (size_t)(l) * W_LAYER)
#ifdef PROBE_T
#define STAMP(k) do { if (blockIdx.x == 0 && threadIdx.x == 0) ((unsigned long long*)(args.ws + WS_CTL + 512 * 1024))[k] = __builtin_amdgcn_s_memrealtime(); } while (0)
#else
#define STAMP(k) do { } while (0)
#endif

    STAMP(0);
#ifndef NO_P0
    { MKFRAME(); p0_prologue(F); }
#ifdef DBL_P0
    { MKFRAME(); p0_prologue(F); }
#endif
#endif
    GRID_BARRIER();
    STAMP(1);
#pragma unroll 1
    for (int l = 0; l < DEPTH; ++l) {
#ifndef NO_G1
#ifdef DBL_G1
        for (int rep_ = 0; rep_ < 2; ++rep_)
#endif
        {
            MKFRAME(); unsigned char* wl = WL(l);
            pg8::Gemm g{XB, (const bf16*)(wl + W_IN), M, 3328, DM}; pg8::StaticOrder S; S.init(M, 3328, F.G, bid);
            pg8::EpiG1 E{ZQ, ZKV, SSQ};
            pg8::gemm_phase<pg8::EpiG1, pg8::StaticOrder, true, true>(F.lds, g, S, E);
        }
#endif
        GRID_BARRIER();
        STAMP(2 + 8 * l);
#ifndef NO_POST
        { MKFRAME(); post_phase(F, l); }
#ifdef DBL_POST
        { MKFRAME(); post_phase(F, l, true); }
#endif
#endif
        GRID_BARRIER();
        STAMP(3 + 8 * l);
#ifdef DBL_ATT1
        for (int rep1_ = 0; rep1_ < 2; ++rep1_)
#else
        const int rep1_ = 0;
#endif
        {
            MKFRAME();
            const int xcd = (int)(xb_xcc_id() & 7u);
#pragma unroll 1
            for (int qi = 0; qi < 8; ++qi) {
                const int x = (xcd + qi) & 7, b = x >> 1, sub = x & 1;
                gu32* ctr = F.ctl + CW_Q + 64 * ((2 * l + 4 * rep1_) * 8 + x);
                for (;;) { const int v = next_unit(F, ctr); if (v >= 16 + 256 + 64) break;
#ifdef DBL_ATT1
                    if (v < 16) { if (rep1_ == 0 || DBL_ATT1 == 1 || DBL_ATT1 == 2) compress_unit(F, l, (v & 1) | (sub << 1) | (b << 2) | ((v >> 1) << 4)); }
                    else if (v < 16 + 256) { if (rep1_ == 0 || DBL_ATT1 == 1 || DBL_ATT1 == 3 || DBL_ATT1 >= 5) select_unit(F, b, 2 * (255 - (v - 16)) + sub, rep1_ ? (DBL_ATT1 >= 5 ? DBL_ATT1 - 4 : 0) : 0  ); }
                    else if (rep1_ && DBL_ATT1 != 1 && DBL_ATT1 != 4) { }
#else
                    if (v < 16) { compress_unit(F, l, (v & 1) | (sub << 1) | (b << 2) | ((v >> 1) << 4)); }
                    else if (v < 16 + 256) { select_unit(F, b, 2 * (255 - (v - 16)) + sub); }
#endif
                    else { simple_unit<0>(F, l, b, sub, 63 - (v - 272), rep1_ ? (bf16*)(ws + WS_MB + 8 * MiB) : nullptr); }
                }
            }
        }
        GRID_BARRIER();
        STAMP(4 + 8 * l);
#ifdef DBL_ATT2
        for (int rep_ = 0; rep_ < 2; ++rep_)
#else
        const int rep_ = 0;
#endif
        {
            MKFRAME();
            bf16* od = rep_ ? (bf16*)(ws + WS_MB) : nullptr;
            const int xcd = (int)(xb_xcc_id() & 7u);
#pragma unroll 1
            for (int qi = 0; qi < 8; ++qi) {
                const int x = (xcd + qi) & 7, b = x >> 1, kvh = x & 1;
                gu32* ctr = F.ctl + CW_Q + 64 * ((2 * l + 1 + 4 * rep_) * 8 + x);
                for (;;) { const int v = next_unit(F, ctr); if (v >= 128) break;
                    const int i = 63 - (v >> 1);
#ifdef DBL_ATT2
                    if ((v & 1) && (rep_ == 0 || DBL_ATT2 != 3)) simple_unit<1>(F, l, b, kvh, i, od);
                    if (!(v & 1) && (rep_ == 0 || DBL_ATT2 != 2)) nsa_unit(F, l, b, kvh, i, od);
#else
                    if (v & 1) simple_unit<1>(F, l, b, kvh, i, od); else nsa_unit(F, l, b, kvh, i, od);
#endif
                }
            }
        }
        GRID_BARRIER();
        STAMP(5 + 8 * l);
#ifndef NO_G2
#ifdef DBL_G2
        for (int rep_ = 0; rep_ < 2; ++rep_)
#endif
#pragma unroll 1
        for (int n = 0; n < 3; ++n) {
            MKFRAME(); unsigned char* wl = WL(l);
#ifndef NO_G2A
            { pg8::Gemm g{ZQ + (size_t)n * M * 512, (const bf16*)(wl + W_BR) + (size_t)n * DM * 512, M, DM, 512}; pg8::StaticOrder S; S.init(M, DM, F.G, bid);
              pg8::EpiStash E{YS}; pg8::gemm_phase<pg8::EpiStash, pg8::StaticOrder, false, true>(F.lds, g, S, E); }
#endif
#ifndef NO_G2B
            { pg8::Gemm g{XB, (const bf16*)(wl + W_G) + (size_t)n * DM * DM, M, DM, DM}; pg8::StaticOrder S; S.init(M, DM, F.G, bid);
              pg8::EpiGate E{YS, MB, SSQ, n == 0 ? 1 : 0}; pg8::gemm_phase<pg8::EpiGate, pg8::StaticOrder, false, true>(F.lds, g, S, E); }
#endif
        }
#endif
        GRID_BARRIER();
        STAMP(6 + 8 * l);
#ifndef NO_G3
        {
            MKFRAME(); unsigned char* wl = WL(l);
            pg8::Gemm g{MB, (const bf16*)(wl + W_OUT), M, DM, DM}; pg8::StaticOrder S; S.init(M, DM, F.G, bid);
            pg8::EpiRes E{l == 0 ? F.a->in[0] : (const float*)F.a->out, F.a->out, XB, SSQ};
            pg8::gemm_phase<pg8::EpiRes, pg8::StaticOrder, false, true>(F.lds, g, S, E);
        }
#ifdef DBL_G3
        {   MKFRAME(); unsigned char* wl = WL(l);
            pg8::Gemm g{MB, (const bf16*)(wl + W_OUT), M, DM, DM}; pg8::StaticOrder S; S.init(M, DM, F.G, bid);
            pg8::EpiRes E{F.a->in[0], (float*)(ws + 0), (bf16*)(ws + 64 * MiB), (float*)(ws + 96 * MiB)};
            pg8::gemm_phase<pg8::EpiRes, pg8::StaticOrder, false, true>(F.lds, g, S, E);
        }
#endif
#endif
        GRID_BARRIER();
        STAMP(7 + 8 * l);
#ifndef NO_G4
#ifdef DBL_G4
        for (int rep_ = 0; rep_ < 2; ++rep_)
#endif
        {
            MKFRAME(); unsigned char* wl = WL(l);
            pg8::Gemm g{XB, (const bf16*)(wl + W_UP), M, DFF, DM}; pg8::StaticOrder S; S.init(M, DFF, F.G, bid);
            pg8::EpiG4 E{HM, SSQ};
            pg8::gemm_phase<pg8::EpiG4, pg8::StaticOrder, true, true>(F.lds, g, S, E);
        }
#endif
        GRID_BARRIER();
        STAMP(8 + 8 * l);
#ifndef NO_G5
        {
            MKFRAME(); unsigned char* wl = WL(l);
            pg8::Gemm g{HM, (const bf16*)(wl + W_DN), M, DM, DFF}; pg8::StaticOrder S; S.init(M, DM, F.G, bid);
            pg8::EpiRes E{(const float*)F.a->out, F.a->out, XB, SSQ};
            pg8::gemm_phase<pg8::EpiRes, pg8::StaticOrder, false, true>(F.lds, g, S, E);
        }
#ifdef DBL_G5
        {   MKFRAME(); unsigned char* wl = WL(l);
            pg8::Gemm g{HM, (const bf16*)(wl + W_DN), M, DM, DFF}; pg8::StaticOrder S; S.init(M, DM, F.G, bid);
            pg8::EpiNull E{};
            pg8::gemm_phase<pg8::EpiNull, pg8::StaticOrder, false, true>(F.lds, g, S, E);
        }
#endif
#endif
#ifdef PROBE_T
        GRID_BARRIER();
        STAMP(9 + 8 * l);
#else
        if (l + 1 < DEPTH) GRID_BARRIER();
#endif
#ifdef DBL_BAR
        for (int rep_ = 0; rep_ < 16; ++rep_) GRID_BARRIER();
#endif
    }
#ifdef PROBE_T
    {
        GRID_BARRIER();
        const unsigned long long* st = (const unsigned long long*)(args.ws + WS_CTL + 512 * 1024);
        float tus;
        if (PROBE_T == 0) tus = (float)(st[1] - st[0]) * 0.01f;
        else tus = 0.5f * ((float)(st[PROBE_T + 1] - st[PROBE_T]) + (float)(st[PROBE_T + 9] - st[PROBE_T + 8])) * 0.01f;
        const float sc = 1.0f + tus * 0.001f;
        float* o = args.out;
        for (size_t i = (size_t)blockIdx.x * 512 + threadIdx.x; i < (size_t)M * DM; i += (size_t)gridDim.x * 512) o[i] *= sc;
    }
#endif
}

extern "C" void kernel_launch(void* const* d_in, const int* in_sizes, int n_in, void* d_out, int out_size, void* d_ws, size_t ws_size, hipStream_t stream) {
    static int grid = 0;
    if (grid == 0) {
        if (n_in != 17 || out_size != M * DM || ws_size < WS_END) { fprintf(stderr, "kernel_launch: unexpected problem shape (n_in %d out %d ws %zu)\n", n_in, out_size, ws_size); grid = -1; return; }
        int dev = 0, cus = 0, per_cu = 0;
        if (hipGetDevice(&dev) != hipSuccess || hipDeviceGetAttribute(&cus, hipDeviceAttributeMultiprocessorCount, dev) != hipSuccess) { grid = -1; return; }
        if (hipFuncSetAttribute((const void*)mk_fwd, hipFuncAttributeMaxDynamicSharedMemorySize, LDS_BYTES) != hipSuccess) { fprintf(stderr, "kernel_launch: hipFuncSetAttribute failed\n"); grid = -1; return; }
        if (hipOccupancyMaxActiveBlocksPerMultiprocessor(&per_cu, (const void*)mk_fwd, NWAVES * 64, LDS_BYTES) != hipSuccess || per_cu < 1) { fprintf(stderr, "kernel_launch: occupancy query says %d blocks/CU\n", per_cu); }
        (void)hipGetLastError();
        if (cus != 256) { fprintf(stderr, "kernel_launch: built for a 256-CU device (one 256x256 GEMM unit per workgroup in the N=1024 phases), found %d CUs\n", cus); grid = -1; return; }
        grid = cus;
    }
    if (grid < 0) return;
    (void)hipMemsetAsync((char*)d_ws + WS_CTL, 0, CTL_BYTES, stream);
    Args a{};
    for (int i = 0; i < 17; ++i) a.in[i] = (const float*)d_in[i];
    a.out = (float*)d_out; a.ws = (unsigned char*)d_ws;
    hipLaunchKernelGGL(mk_fwd, dim3(grid), dim3(NWAVES * 64), LDS_BYTES, stream, a);
}
```

```cpp
#include <hip/hip_runtime.h>
#include <cstdio>
#include <cstdint>

namespace pg8 {
#define PG8_LAS __attribute__((address_space(3)))
typedef unsigned short bf16_t;
typedef short bf16x8 __attribute__((ext_vector_type(8)));
typedef float f32x4 __attribute__((ext_vector_type(4)));
typedef unsigned u32x4 __attribute__((ext_vector_type(4)));
constexpr int BM = 256, BK = 64, HALF = 128, HTB = HALF * BK * 2  , STAGE_BYTES = 8 * HTB, NXCD = 8, WGM = 8;

__host__ __device__ __forceinline__ int lds_byte(int r, int c) { const int st = (r >> 4) * 2 + (c >> 5), rr = r & 15, cc = c & 31, ob = rr * 64 + cc * 2; return st * 1024 + (ob ^ (((ob >> 9) & 1) << 5)); }
__host__ __device__ __forceinline__ void stage_rc(int b, int& R, int& C) { const int st = b / 1024, sb = b % 1024, swz = sb ^ (((sb >> 9) & 1) << 5); R = (st >> 1) * 16 + swz / 64; C = (st & 1) * 32 + (swz % 64) / 2; }
__host__ __device__ __forceinline__ int perm32(int rho) { const int n = rho >> 4, i = rho & 15; return 8 * (i >> 2) + 4 * n + (i & 3); }

struct Unit { int pm, pn; };
struct Gemm { const bf16_t* A; const bf16_t* Bt; int M, N, K; };

struct StaticOrder {
    int nM, nN, nwg, G, c;
    __host__ __device__ void init(int M, int N, int G_, int c_) { nM = M / BM; nN = N / BM; nwg = nM * nN; G = G_; c = c_; }
    __host__ __device__ bool next(int i, Unit& u) const {
        const long L = (long)i * G + c; if (L >= nwg) return false;
        int wgid = (int)L; { const int q = nwg / NXCD, r = nwg % NXCD, xcd = wgid % NXCD, off = wgid / NXCD; wgid = (xcd < r ? xcd * (q + 1) : r * (q + 1) + (xcd - r) * q) + off; }
        const int nig = WGM * nN, gid = wgid / nig, fm = gid * WGM, gsz = (nM - fm) < WGM ? (nM - fm) : WGM;
        u.pm = fm + ((wgid % nig) % gsz); u.pn = (wgid % nig) / gsz; return true;
    }
    __device__ __forceinline__ void a_ready(const Unit&) const {}
    __device__ __forceinline__ void done(const Unit&) const {}
};

__device__ __forceinline__ unsigned cvt_pk_bf16(float lo, float hi) { unsigned r; asm volatile("v_cvt_pk_bf16_f32 %0, %1, %2" : "=v"(r) : "v"(lo), "v"(hi)); return r; }
template <class Epi, class Sched, bool ALIGN_EPI = false, bool SP2 = false>
__device__ __forceinline__ void gemm_phase(PG8_LAS unsigned char* lds, const Gemm g, const Sched& S, const Epi& E) {
    int tid_l = threadIdx.x; asm volatile("" : "+v"(tid_l));
    const int tid = tid_l, wid = __builtin_amdgcn_readfirstlane(tid >> 6), lane = tid & 63, wr = wid >> 2, wc = wid & 3, fr = lane & 15, fq = lane >> 4;
    const int K = g.K, nt = K / BK;
    unsigned voffA[2], voffB[2];
#pragma unroll
    for (int i = 0; i < 2; ++i) { int R, C; stage_rc(tid * 16 + i * 8192, R, C); const int Rb = Epi::PERM ? ((R & ~31) + perm32(R & 31)) : R;
        voffA[i] = (unsigned)(R * K + C) * 2u; voffB[i] = (unsigned)(Rb * K + C) * 2u; }
    const size_t kstep = (size_t)(BK * 2);
    const size_t hstep = (size_t)HALF * K * 2;
    const size_t tstep = 2 * hstep;
    const unsigned ldsw = (unsigned)wid * 1024u;
    const int aoff = lds_byte(wr * 64 + fr, fq * 8), boff = lds_byte(wc * 32 + fr, fq * 8);
#define PG8_SA(b, h) (((b) * 2 + (h)) * HTB)
#define PG8_SB(b, h) ((4 + (b) * 2 + (h)) * HTB)
#define PG8_STAGE(bufoff, gbase, voff) do { _Pragma("unroll") for (int _i = 0; _i < 2; ++_i) \
        __builtin_amdgcn_global_load_lds((const unsigned*)((const char*)(gbase) + (voff)[_i]), (PG8_LAS unsigned*)(lds + (bufoff) + ldsw + _i * 8192), 16, 0, 0); } while (0)
#define PG8_LDA(dst, b, h) do { _Pragma("unroll") for (int m = 0; m < 4; ++m) _Pragma("unroll") for (int k = 0; k < 2; ++k) dst[m][k] = *(const PG8_LAS bf16x8*)(lds + PG8_SA(b, h) + aoff + m * 2048 + k * 1024); } while (0)
#define PG8_LDB(dst, b, h) do { _Pragma("unroll") for (int n = 0; n < 2; ++n) _Pragma("unroll") for (int k = 0; k < 2; ++k) dst[n][k] = *(const PG8_LAS bf16x8*)(lds + PG8_SB(b, h) + boff + n * 2048 + k * 1024); } while (0)
#define PG8_MMA(ai, bj, At, Bt) do { __builtin_amdgcn_s_setprio(1); _Pragma("unroll") for (int m = 0; m < 4; ++m) _Pragma("unroll") for (int n = 0; n < 2; ++n) _Pragma("unroll") for (int k = 0; k < 2; ++k) \
        acc[ai][bj][m][n] = __builtin_amdgcn_mfma_f32_16x16x32_bf16(Bt[n][k], At[m][k], acc[ai][bj][m][n], 0, 0, 0); __builtin_amdgcn_s_setprio(0); } while (0)
#define PG8_WAIT_V(n) asm volatile("s_waitcnt vmcnt(" #n ")" ::: "memory")
#define PG8_WAIT_L(n) asm volatile("s_waitcnt lgkmcnt(" #n ")" ::: "memory")
#define PG8_BAR __builtin_amdgcn_s_barrier()
#define PG8_SCHED __builtin_amdgcn_sched_barrier(0)
    Unit cur, nxt; int ui = 0;
    if (!S.next(0, cur)) return;
    f32x4 acc[2][2][4][2];
#pragma unroll
    for (int a = 0; a < 2; ++a)
#pragma unroll
        for (int b = 0; b < 2; ++b)
#pragma unroll
            for (int m = 0; m < 4; ++m)
#pragma unroll
                for (int n = 0; n < 2; ++n) acc[a][b][m][n] = (f32x4){0.f, 0.f, 0.f, 0.f};
    bf16x8 At[4][2], B0[2][2], B1[2][2];
    const char* cA = (const char*)g.A + (size_t)cur.pm * tstep; const char* cB = (const char*)g.Bt + (size_t)cur.pn * tstep;
    S.a_ready(cur);
    if constexpr (SP2) {
        PG8_STAGE(PG8_SB(0, 0), cB, voffB); PG8_STAGE(PG8_SB(0, 1), cB + hstep, voffB); PG8_STAGE(PG8_SA(0, 0), cA, voffA); PG8_STAGE(PG8_SA(0, 1), cA + hstep, voffA);
        if (wr == 1) PG8_BAR;
        PG8_WAIT_V(2); PG8_BAR;
        PG8_STAGE(PG8_SB(1, 0), cB + kstep, voffB); PG8_STAGE(PG8_SA(1, 0), cA + kstep, voffA); PG8_STAGE(PG8_SB(1, 1), cB + hstep + kstep, voffB);
        PG8_WAIT_V(6); PG8_BAR;
    } else {
        PG8_STAGE(PG8_SB(0, 0), cB, voffB); PG8_STAGE(PG8_SA(0, 0), cA, voffA); PG8_STAGE(PG8_SB(0, 1), cB + hstep, voffB); PG8_STAGE(PG8_SA(0, 1), cA + hstep, voffA);
        if (wr == 1) PG8_BAR;
        PG8_WAIT_V(4); PG8_BAR;
        PG8_STAGE(PG8_SB(1, 0), cB + kstep, voffB); PG8_STAGE(PG8_SA(1, 0), cA + kstep, voffA); PG8_STAGE(PG8_SB(1, 1), cB + hstep + kstep, voffB);
        PG8_WAIT_V(6); PG8_BAR;
    }
    for (;;) {
        const bool has_next = S.next(ui + 1, nxt);
        const char* nA = has_next ? (const char*)g.A + (size_t)nxt.pm * tstep : cA; const char* nB = has_next ? (const char*)g.Bt + (size_t)nxt.pn * tstep : cB;
        for (int t = 0; t < nt; t += 2) {
            const bool last = (t == nt - 2);
            const char* a1 = cA + (size_t)(t + 1) * kstep;
            const char* a2 = last ? nA : cA + (size_t)(t + 2) * kstep; const char* b2 = last ? nB : cB + (size_t)(t + 2) * kstep;
            const char* a3 = a2 + kstep; const char* b3 = b2 + kstep;
            if (last && has_next) S.a_ready(nxt);
            if constexpr (SP2) {
            PG8_LDB(B0, 0, 0); PG8_LDB(B1, 0, 1); PG8_SCHED; PG8_LDA(At, 0, 0); PG8_STAGE(PG8_SA(1, 1), a1 + hstep, voffA);
            PG8_WAIT_V(8); PG8_WAIT_L(0); PG8_BAR; PG8_MMA(0, 0, At, B0); PG8_MMA(0, 1, At, B1); PG8_BAR; PG8_SCHED;
            PG8_LDA(At, 0, 1); PG8_STAGE(PG8_SB(0, 0), b2, voffB); PG8_STAGE(PG8_SB(0, 1), b2 + hstep, voffB); PG8_STAGE(PG8_SA(0, 0), a2, voffA);
            PG8_WAIT_V(8); PG8_WAIT_L(0); PG8_BAR; PG8_MMA(1, 0, At, B0); PG8_MMA(1, 1, At, B1); PG8_BAR; PG8_SCHED;
            PG8_LDB(B0, 1, 0); PG8_LDB(B1, 1, 1); PG8_SCHED; PG8_LDA(At, 1, 0); PG8_STAGE(PG8_SA(0, 1), a2 + hstep, voffA);
            PG8_WAIT_V(8); PG8_WAIT_L(0); PG8_BAR; PG8_MMA(0, 0, At, B0); PG8_MMA(0, 1, At, B1); PG8_BAR; PG8_SCHED;
            PG8_LDA(At, 1, 1); PG8_STAGE(PG8_SB(1, 0), b3, voffB); PG8_STAGE(PG8_SB(1, 1), b3 + hstep, voffB); PG8_STAGE(PG8_SA(1, 0), a3, voffA);
            PG8_WAIT_V(8); PG8_WAIT_L(0); PG8_BAR; PG8_MMA(1, 0, At, B0); PG8_MMA(1, 1, At, B1); PG8_BAR; PG8_SCHED;
            } else {
            PG8_LDB(B0, 0, 0); PG8_SCHED; PG8_LDA(At, 0, 0); PG8_STAGE(PG8_SA(1, 1), a1 + hstep, voffA);
            PG8_WAIT_L(8); PG8_BAR; PG8_WAIT_L(0); PG8_MMA(0, 0, At, B0); PG8_BAR; PG8_SCHED;
            PG8_LDB(B1, 0, 1); PG8_STAGE(PG8_SB(0, 0), b2, voffB);
            PG8_BAR; PG8_WAIT_L(0); PG8_MMA(0, 1, At, B1); PG8_BAR;
            PG8_LDA(At, 0, 1); PG8_STAGE(PG8_SA(0, 0), a2, voffA);
            PG8_BAR; PG8_WAIT_L(0); PG8_MMA(1, 0, At, B0); PG8_BAR; PG8_SCHED;
            PG8_STAGE(PG8_SB(0, 1), b2 + hstep, voffB);
            PG8_WAIT_V(6); PG8_BAR; PG8_MMA(1, 1, At, B1); PG8_BAR;
            PG8_LDB(B0, 1, 0); PG8_SCHED; PG8_LDA(At, 1, 0); PG8_STAGE(PG8_SA(0, 1), a2 + hstep, voffA);
            PG8_WAIT_L(8); PG8_BAR; PG8_WAIT_L(0); PG8_MMA(0, 0, At, B0); PG8_BAR; PG8_SCHED;
            PG8_LDB(B1, 1, 1); PG8_STAGE(PG8_SB(1, 0), b3, voffB);
            PG8_BAR; PG8_WAIT_L(0); PG8_MMA(0, 1, At, B1); PG8_BAR;
            PG8_LDA(At, 1, 1); PG8_STAGE(PG8_SA(1, 0), a3, voffA);
            PG8_BAR; PG8_WAIT_L(0); PG8_MMA(1, 0, At, B0); PG8_BAR; PG8_SCHED;
            PG8_STAGE(PG8_SB(1, 1), b3 + hstep, voffB);
            PG8_WAIT_V(6); PG8_BAR; PG8_MMA(1, 1, At, B1); PG8_BAR;
            }
        }
        if constexpr (ALIGN_EPI) { if (wr == 0) PG8_BAR; }
        if constexpr (!Epi::AFTER_DRAIN) { E(acc, cur, wr, wc, fr, fq); S.done(cur); }
        if (!has_next) break;
#pragma unroll
        for (int a = 0; a < 2; ++a)
#pragma unroll
            for (int b = 0; b < 2; ++b)
#pragma unroll
                for (int m = 0; m < 4; ++m)
#pragma unroll
                    for (int n = 0; n < 2; ++n) acc[a][b][m][n] = (f32x4){0.f, 0.f, 0.f, 0.f};
        cur = nxt; cA = nA; cB = nB; ++ui;
        if constexpr (ALIGN_EPI) { if (wr == 1) PG8_BAR; }
    }
    PG8_WAIT_V(0);
    if constexpr (!ALIGN_EPI) { if (wr == 0) PG8_BAR; }
    PG8_BAR;
    if constexpr (Epi::AFTER_DRAIN) { E.fused(acc, cur, wr, wc, fr, fq, lds, wid, lane); S.done(cur); }
#undef PG8_SA
#undef PG8_SB
#undef PG8_STAGE
#undef PG8_LDA
#undef PG8_LDB
#undef PG8_MMA
#undef PG8_WAIT_V
#undef PG8_WAIT_L
#undef PG8_BAR
#undef PG8_SCHED
}
}

namespace pg8 {
#define PG8_GAS __attribute__((address_space(1)))
constexpr int MROWS = 16384;
__device__ __forceinline__ unsigned pk_bf16(float lo, float hi) { typedef float f2 __attribute__((ext_vector_type(2))); typedef __bf16 b2 __attribute__((ext_vector_type(2)));
    f2 v = {lo, hi}; b2 b = __builtin_convertvector(v, b2); return __builtin_bit_cast(unsigned, b); }
__device__ __forceinline__ float bf_lo(unsigned w) { return __uint_as_float(w << 16); }
__device__ __forceinline__ float bf_hi(unsigned w) { return __uint_as_float(w & 0xffff0000u); }
__device__ __forceinline__ float row_rstd(const float* ssq, int row) {
    const PG8_GAS f32x4* p = (const PG8_GAS f32x4*)(ssq + (size_t)row * 16);
    const f32x4 a = p[0], b = p[1], c = p[2], d = p[3];
    const float s = (((a[0] + a[1]) + (a[2] + a[3])) + ((b[0] + b[1]) + (b[2] + b[3]))) + (((c[0] + c[1]) + (c[2] + c[3])) + ((d[0] + d[1]) + (d[2] + d[3])));
    return rsqrtf(s * (1.0f / 1024.0f) + 1e-6f);
}
__device__ __forceinline__ float sigmoidf_(float x) { return __builtin_amdgcn_rcpf(1.0f + __builtin_amdgcn_exp2f(-1.4426950408889634f * x)); }

struct EpiG1 {
    static constexpr bool PERM = true, AFTER_DRAIN = false;
    bf16_t* zq; bf16_t* zkv; const float* ssq;
    __device__ __forceinline__ void operator()(const f32x4 (&acc)[2][2][4][2], const Unit& u, int wr, int wc, int fr, int fq) const {
        const int row0 = u.pm * BM + wr * 64 + fr;
        bf16_t* base; int ldc, colt;
        if (u.pn < 6) { base = zq + (size_t)(u.pn >> 1) * ((size_t)MROWS * 512); ldc = 512; colt = (u.pn & 1) * 256; }
        else { base = zkv + (size_t)(u.pn - 6) * ((size_t)MROWS * 256); ldc = 256; colt = 0; }
        const int col0 = colt + wc * 32 + 8 * fq;
#pragma unroll
        for (int ai = 0; ai < 2; ++ai)
#pragma unroll
            for (int m = 0; m < 4; ++m) { const int row = row0 + ai * HALF + m * 16; const float rs = row_rstd(ssq, row); bf16_t* rowp = base + (size_t)row * ldc + col0;
#pragma unroll
                for (int bj = 0; bj < 2; ++bj) { const f32x4 v0 = acc[ai][bj][m][0] * rs, v1 = acc[ai][bj][m][1] * rs;
                    u32x4 w; w.x = pk_bf16(v0[0], v0[1]); w.y = pk_bf16(v0[2], v0[3]); w.z = pk_bf16(v1[0], v1[1]); w.w = pk_bf16(v1[2], v1[3]);
                    *(PG8_GAS u32x4*)(rowp + bj * HALF) = w; } }
    }
};
struct EpiG4 {
    static constexpr bool PERM = true, AFTER_DRAIN = false;
    bf16_t* h; const float* ssq;
    __device__ __forceinline__ void operator()(const f32x4 (&acc)[2][2][4][2], const Unit& u, int wr, int wc, int fr, int fq) const {
        const int row0 = u.pm * BM + wr * 64 + fr; const int col0 = u.pn * BM + wc * 32 + 8 * fq;
#pragma unroll
        for (int ai = 0; ai < 2; ++ai)
#pragma unroll
            for (int m = 0; m < 4; ++m) { const int row = row0 + ai * HALF + m * 16; const float rs = row_rstd(ssq, row); bf16_t* rowp = h + (size_t)row * 4096 + col0;
#pragma unroll
                for (int bj = 0; bj < 2; ++bj) { f32x4 v0 = acc[ai][bj][m][0] * rs, v1 = acc[ai][bj][m][1] * rs;
#pragma unroll
                    for (int e = 0; e < 4; ++e) { v0[e] = fmaxf(v0[e], 0.f); v0[e] *= v0[e]; v1[e] = fmaxf(v1[e], 0.f); v1[e] *= v1[e]; }
                    u32x4 w; w.x = pk_bf16(v0[0], v0[1]); w.y = pk_bf16(v0[2], v0[3]); w.z = pk_bf16(v1[0], v1[1]); w.w = pk_bf16(v1[2], v1[3]);
                    *(PG8_GAS u32x4*)(rowp + bj * HALF) = w; } }
    }
};
struct EpiRes {
    static constexpr bool PERM = true, AFTER_DRAIN = false;
    const float* xold; float* xout; bf16_t* xb; float* ssq;
    __device__ __forceinline__ void operator()(const f32x4 (&acc)[2][2][4][2], const Unit& u, int wr, int wc, int fr, int fq) const {
        const int row0 = u.pm * BM + wr * 64 + fr; const int col0 = u.pn * BM + wc * 32 + 8 * fq;
#pragma unroll
        for (int ai = 0; ai < 2; ++ai)
#pragma unroll
            for (int m = 0; m < 4; ++m) { const int row = row0 + ai * HALF + m * 16; float part = 0.f;
#pragma unroll
                for (int bj = 0; bj < 2; ++bj) { const size_t off = (size_t)row * 1024 + col0 + bj * HALF;
                    const f32x4 a0 = *(const PG8_GAS f32x4*)(xold + off), a1 = *(const PG8_GAS f32x4*)(xold + off + 4);
                    const f32x4 v0 = acc[ai][bj][m][0] + a0, v1 = acc[ai][bj][m][1] + a1;
                    *(PG8_GAS f32x4*)(xout + off) = v0; *(PG8_GAS f32x4*)(xout + off + 4) = v1;
                    u32x4 w; w.x = pk_bf16(v0[0], v0[1]); w.y = pk_bf16(v0[2], v0[3]); w.z = pk_bf16(v1[0], v1[1]); w.w = pk_bf16(v1[2], v1[3]);
                    *(PG8_GAS u32x4*)(xb + off) = w;
                    part += ((v0[0] * v0[0] + v0[1] * v0[1]) + (v0[2] * v0[2] + v0[3] * v0[3])) + ((v1[0] * v1[0] + v1[1] * v1[1]) + (v1[2] * v1[2] + v1[3] * v1[3])); }
                part += __shfl_xor(part, 16); part += __shfl_xor(part, 32);
                if (fq == 0) ((PG8_GAS float*)ssq)[(size_t)row * 16 + u.pn * 4 + wc] = part;
                asm volatile("" ::: "memory"); }
    }
};
struct EpiStash {
    static constexpr bool PERM = true, AFTER_DRAIN = true;
    __device__ __forceinline__ void fused(f32x4 (&acc)[2][2][4][2], const Unit& u, int wr, int wc, int fr, int fq, PG8_LAS unsigned char*, int, int) const { (*this)(acc, u, wr, wc, fr, fq); }
    bf16_t* ys;
    __device__ __forceinline__ void operator()(const f32x4 (&acc)[2][2][4][2], const Unit& u, int wr, int wc, int fr, int fq) const {
        bf16_t* base = ys + (size_t)(u.pm * 4 + u.pn) * 65536; const int row0 = wr * 64 + fr, col0 = wc * 32 + 8 * fq;
#pragma unroll
        for (int ai = 0; ai < 2; ++ai)
#pragma unroll
            for (int m = 0; m < 4; ++m) { bf16_t* rowp = base + (row0 + ai * HALF + m * 16) * 256 + col0;
#pragma unroll
                for (int bj = 0; bj < 2; ++bj) { const f32x4 v0 = acc[ai][bj][m][0], v1 = acc[ai][bj][m][1];
                    u32x4 w; w.x = pk_bf16(v0[0], v0[1]); w.y = pk_bf16(v0[2], v0[3]); w.z = pk_bf16(v1[0], v1[1]); w.w = pk_bf16(v1[2], v1[3]);
                    *(PG8_GAS u32x4*)(rowp + bj * HALF) = w; } }
    }
};
struct EpiGate {
    static constexpr bool PERM = true, AFTER_DRAIN = true;
    __device__ __forceinline__ void fused(f32x4 (&acc)[2][2][4][2], const Unit& u, int wr, int wc, int fr, int fq, PG8_LAS unsigned char*, int, int) const { (*this)(acc, u, wr, wc, fr, fq); }
    const bf16_t* ys; bf16_t* mb; const float* ssq; int first;
    __device__ __forceinline__ void operator()(const f32x4 (&acc)[2][2][4][2], const Unit& u, int wr, int wc, int fr, int fq) const {
        const bf16_t* sbase = ys + (size_t)(u.pm * 4 + u.pn) * 65536; const int lrow0 = wr * 64 + fr, lcol0 = wc * 32 + 8 * fq;
#pragma unroll
        for (int ai = 0; ai < 2; ++ai)
#pragma unroll
            for (int m = 0; m < 4; ++m) { const int lrow = lrow0 + ai * HALF + m * 16, row = u.pm * BM + lrow; const float rs = row_rstd(ssq, row);
#pragma unroll
                for (int bj = 0; bj < 2; ++bj) { const f32x4 a0 = acc[ai][bj][m][0] * rs, a1 = acc[ai][bj][m][1] * rs;
                    const u32x4 y = *(const PG8_GAS u32x4*)(sbase + lrow * 256 + lcol0 + bj * HALF);
                    bf16_t* mp = mb + (size_t)row * 1024 + u.pn * BM + lcol0 + bj * HALF;
                    float r[8];
                    r[0] = sigmoidf_(a0[0]) * bf_lo(y.x); r[1] = sigmoidf_(a0[1]) * bf_hi(y.x); r[2] = sigmoidf_(a0[2]) * bf_lo(y.y); r[3] = sigmoidf_(a0[3]) * bf_hi(y.y);
                    r[4] = sigmoidf_(a1[0]) * bf_lo(y.z); r[5] = sigmoidf_(a1[1]) * bf_hi(y.z); r[6] = sigmoidf_(a1[2]) * bf_lo(y.w); r[7] = sigmoidf_(a1[3]) * bf_hi(y.w);
                    if (!first) { const u32x4 pv = *(const PG8_GAS u32x4*)mp;
                        r[0] += bf_lo(pv.x); r[1] += bf_hi(pv.x); r[2] += bf_lo(pv.y); r[3] += bf_hi(pv.y); r[4] += bf_lo(pv.z); r[5] += bf_hi(pv.z); r[6] += bf_lo(pv.w); r[7] += bf_hi(pv.w); }
                    u32x4 w; w.x = pk_bf16(r[0], r[1]); w.y = pk_bf16(r[2], r[3]); w.z = pk_bf16(r[4], r[5]); w.w = pk_bf16(r[6], r[7]);
                    *(PG8_GAS u32x4*)mp = w;
                    asm volatile("" ::: "memory"); } }
    }
};
struct EpiNull {
    static constexpr bool PERM = true, AFTER_DRAIN = false;
    __device__ __forceinline__ void operator()(const f32x4 (&acc)[2][2][4][2], const Unit& u, int wr, int wc, int fr, int fq) const {
#pragma unroll
        for (int ai = 0; ai < 2; ++ai)
#pragma unroll
            for (int bj = 0; bj < 2; ++bj)
#pragma unroll
                for (int m = 0; m < 4; ++m) { asm volatile("" :: "v"(acc[ai][bj][m][0]), "v"(acc[ai][bj][m][1])); }
    }
};
}

#define GAS __attribute__((address_space(1)))
#define LAS __attribute__((address_space(3)))
typedef unsigned short bf16;
typedef unsigned v4u __attribute__((ext_vector_type(4)));
typedef float f32x4 __attribute__((ext_vector_type(4)));
typedef short bf16x8 __attribute__((ext_vector_type(8)));
typedef GAS unsigned gu32;
typedef GAS unsigned long long gu64;
#define RLX_AGENT __ATOMIC_RELAXED, __HIP_MEMORY_SCOPE_AGENT
#define LDS_WAIT() asm volatile("s_waitcnt lgkmcnt(0)" ::: "memory")
#define VM_WAIT() asm volatile("s_waitcnt vmcnt(0)" ::: "memory")
__device__ __forceinline__ unsigned long long rt() { return __builtin_amdgcn_s_memrealtime(); }
__device__ __forceinline__ unsigned f2bf(float f) { unsigned u = __builtin_bit_cast(unsigned, f); return (u + 0x7fffu + ((u >> 16) & 1u)) >> 16; }
__device__ __forceinline__ unsigned pk2(float lo, float hi) { return f2bf(lo) | (f2bf(hi) << 16); }

#define XB_TMO      128
#define XB_XCNT(j)  (256  + 64 * (j))
#define XB_XSUB(j)  (1280 + 64 * (j))
#define XB_XGEN(j)  (2304 + 64 * (j))
#define XB_TOP      3328
#define XB_TOPGEN   3392
#define XCD_BAR_WORDS 3456
#define XB_SPIN_CAP (1u << 18)

__device__ __forceinline__ unsigned xb_ld(unsigned* p)              { return __hip_atomic_load(p, __ATOMIC_RELAXED, __HIP_MEMORY_SCOPE_AGENT); }
__device__ __forceinline__ unsigned xb_add(unsigned* p, unsigned v) { return __hip_atomic_fetch_add(p, v, __ATOMIC_RELAXED, __HIP_MEMORY_SCOPE_AGENT); }
__device__ __forceinline__ unsigned xb_xcc_id() { return (unsigned)__builtin_amdgcn_s_getreg((3 << 11) | 20) & 0xFu; }
#define XB_SPIN(cond, bar) do { unsigned _sp = 0; while (cond) { __builtin_amdgcn_s_sleep(1); \
    if ((++_sp & 255u) == 0u) { if (xb_ld(&(bar)[XB_TMO])) break; if (_sp > XB_SPIN_CAP) { atomicAdd(&(bar)[XB_TMO], 1u); break; } } } } while (0)

struct XcdBarrier {
    unsigned* bar; unsigned x;
    volatile LAS unsigned* st;
};

__device__ __forceinline__ XcdBarrier xcd_barrier_post(unsigned* bar, volatile LAS unsigned* st) {
    XcdBarrier b; b.bar = bar; b.x = xb_xcc_id(); b.st = st;
    if (threadIdx.x == 0) (void)xb_add(&bar[XB_XCNT(b.x)], 1u);
    return b;
}
__device__ __forceinline__ void xcd_barrier_complete(unsigned* bar, unsigned x, unsigned& nloc, unsigned& nx) {
    const unsigned G = gridDim.x * gridDim.y * gridDim.z;
    unsigned sum, cnt, mine, sp = 0u;
    for (;;) {
        sum = 0u; cnt = 0u; mine = 0u;
#pragma unroll
        for (unsigned j = 0; j < 16; ++j) { const unsigned c = xb_ld(&bar[XB_XCNT(j)]); sum += c; cnt += (c > 0u) ? 1u : 0u; mine = (j == x) ? c : mine; }
        if (sum == G) break;
        __builtin_amdgcn_s_sleep(1);
        if ((++sp & 255u) == 0u) { if (xb_ld(&bar[XB_TMO])) break; if (sp > XB_SPIN_CAP) { atomicAdd(&bar[XB_TMO], 1u); break; } }
    }
    nloc = mine > 0u ? mine : 1u; nx = cnt > 0u ? cnt : 1u;
}

__device__ __forceinline__ void xcd_barrier(const XcdBarrier& b) {
    asm volatile("s_waitcnt vmcnt(0)" ::: "memory");
    __syncthreads();
    if (threadIdx.x == 0) {
        unsigned* bar = b.bar;
        __builtin_amdgcn_s_waitcnt(0);
        unsigned nloc = b.st[0], nx = b.st[1];
        if (nloc == 0u) { xcd_barrier_complete(bar, b.x, nloc, nx); b.st[0] = nloc; b.st[1] = nx; }
        const unsigned old = xb_add(&bar[XB_XSUB(b.x)], 1u);
        const unsigned gen = old / nloc;
        if (old + 1u == (gen + 1u) * nloc) {
            __builtin_amdgcn_fence(__ATOMIC_RELEASE, "agent");
            asm volatile("s_waitcnt vmcnt(0)" ::: "memory");
            const unsigned og = xb_add(&bar[XB_TOP], 1u);
            const unsigned tg = og / nx;
            if (og + 1u == (tg + 1u) * nx) xb_add(&bar[XB_TOPGEN], 1u);
            else XB_SPIN(xb_ld(&bar[XB_TOPGEN]) == tg, bar);
            __builtin_amdgcn_fence(__ATOMIC_ACQUIRE, "agent");
            xb_add(&bar[XB_XGEN(b.x)], 1u);
            asm volatile("s_waitcnt vmcnt(0)" ::: "memory");
        } else {
            XB_SPIN(xb_ld(&bar[XB_XGEN(b.x)]) == gen, bar);
            __builtin_amdgcn_fence(__ATOMIC_ACQUIRE, "agent");
            asm volatile("s_waitcnt vmcnt(0)" ::: "memory");
        }
    }
    __syncthreads();
}

namespace att {
typedef short bf16x8 __attribute__((ext_vector_type(8)));
typedef short s16x4 __attribute__((ext_vector_type(4)));
typedef float f32x16 __attribute__((ext_vector_type(16)));
typedef unsigned u32x4 __attribute__((ext_vector_type(4)));
typedef unsigned short bf16_t;
typedef unsigned long long u64;
constexpr int NKB = 4, NVB = 5;
constexpr int WSF_W = 320;
constexpr int L_K0 = 0, L_V0 = NKB * 8320, L_IMP = L_V0  , L_WSF = L_V0 + NVB * 8192, L_SEL = L_WSF + 8 * WSF_W * 4, L_OST = L_SEL + 512  , L_END = L_OST + 65536;
__device__ __forceinline__ int crow(int r, int hi) { return (r & 3) + 8 * (r >> 2) + 4 * hi; }
__device__ __forceinline__ unsigned pk2(float lo, float hi) { typedef float f2 __attribute__((ext_vector_type(2))); typedef __bf16 b2 __attribute__((ext_vector_type(2)));
    f2 v = {lo, hi}; b2 b = __builtin_convertvector(v, b2); return __builtin_bit_cast(unsigned, b); }
__device__ __forceinline__ s16x4 vtr(LAS const char* p) { typedef short v4i16_t __attribute__((ext_vector_type(4))); return __builtin_bit_cast(s16x4, __builtin_amdgcn_ds_read_tr16_b64_v4i16((LAS v4i16_t*)p)); }

struct KVSrc { const GAS bf16_t* k; const GAS bf16_t* v; int pitch; int nrows; };

struct Lane { int tid, lane, r32, hi, wid; };

__device__ __forceinline__ void tile_gload(const KVSrc& S, int t, int tid, u32x4& kr, u32x4& vr) {
    const int row = 64 * t + (tid >> 3), ch = tid & 7;
    kr = *(const GAS u32x4*)(S.k + (size_t)row * S.pitch + ch * 8); vr = *(const GAS u32x4*)(S.v + (size_t)row * S.pitch + ch * 8);
}
__device__ __forceinline__ void tile_lstore(LAS char* kb, LAS char* vb, int tid, const u32x4& kr, const u32x4& vr) {
    const int key = tid >> 3, ch = tid & 7;
    *(LAS u32x4*)(kb + ch * 1040 + (key >> 5) * 512 + (key & 31) * 16) = kr;
    *(LAS u32x4*)(vb + (ch >> 2) * 4096 + (key >> 4) * 1024 + ((key >> 3) & 1) * 512 + (key & 7) * 64 + (ch & 3) * 16) = vr;
}
__device__ __forceinline__ void qk_tile(LAS const char* kbuf, const bf16x8 (&qr)[4], f32x16& p0, f32x16& p1, int r32, int hi) {
    LAS const char* kb = kbuf + hi * 1040 + r32 * 16;
#pragma unroll
    for (int d0 = 0; d0 < 4; ++d0) {
        const bf16x8 b0 = *(LAS const bf16x8*)(kb + d0 * 2080);
        const bf16x8 b1 = *(LAS const bf16x8*)(kb + d0 * 2080 + 512);
        p0 = __builtin_amdgcn_mfma_f32_32x32x16_bf16(b0, qr[d0], p0, 0, 0, 0);
        p1 = __builtin_amdgcn_mfma_f32_32x32x16_bf16(b1, qr[d0], p1, 0, 0, 0);
    }
}
__device__ __forceinline__ void qk_tile_c(LAS const char* kbuf, const bf16x8 (&qr)[4], const f32x16& negm, f32x16& p0, f32x16& p1, int r32, int hi) {
    const unsigned ka = (unsigned)(size_t)kbuf + hi * 1040 + r32 * 16;
    bf16x8 kf[8];
#pragma unroll
    for (int d0 = 0; d0 < 4; ++d0) {
        asm volatile("ds_read_b128 %0, %1 offset:%c2" : "=&v"(kf[2 * d0]) : "v"(ka), "i"(d0 * 2080) : "memory");
        asm volatile("ds_read_b128 %0, %1 offset:%c2" : "=&v"(kf[2 * d0 + 1]) : "v"(ka), "i"(d0 * 2080 + 512) : "memory");
    }
    asm volatile("s_waitcnt lgkmcnt(0)" : "+v"(kf[0]), "+v"(kf[1]), "+v"(kf[2]), "+v"(kf[3]), "+v"(kf[4]), "+v"(kf[5]), "+v"(kf[6]), "+v"(kf[7]) :: "memory");
    __builtin_amdgcn_sched_barrier(0);
    p0 = __builtin_amdgcn_mfma_f32_32x32x16_bf16(kf[0], qr[0], negm, 0, 0, 0); p1 = __builtin_amdgcn_mfma_f32_32x32x16_bf16(kf[1], qr[0], negm, 0, 0, 0);
#pragma unroll
    for (int d0 = 1; d0 < 4; ++d0) { p0 = __builtin_amdgcn_mfma_f32_32x32x16_bf16(kf[2 * d0], qr[d0], p0, 0, 0, 0); p1 = __builtin_amdgcn_mfma_f32_32x32x16_bf16(kf[2 * d0 + 1], qr[d0], p1, 0, 0, 0); }
}
__device__ __forceinline__ void pv_tile(LAS const char* vbuf, const u32x4 (&pw)[4], f32x16 (&o)[2], f32x16& ol, int lane, int hi) {
    const unsigned va = (unsigned)(size_t)vbuf + ((lane >> 4) & 1) * 32 + (lane & 3) * 8 + (4 * hi + ((lane & 15) >> 2)) * 64;
#pragma unroll
    for (int d0 = 0; d0 < 2; ++d0) {
        s16x4 lo[4], h2[4];
#pragma unroll
        for (int ks = 0; ks < 4; ++ks) {
            asm volatile("ds_read_b64_tr_b16 %0, %1 offset:%c2" : "=&v"(lo[ks]) : "v"(va), "i"(d0 * 4096 + ks * 1024) : "memory");
            asm volatile("ds_read_b64_tr_b16 %0, %1 offset:%c2" : "=&v"(h2[ks]) : "v"(va), "i"(d0 * 4096 + ks * 1024 + 512) : "memory");
        }
        asm volatile("s_waitcnt lgkmcnt(0)" : "+v"(lo[0]), "+v"(lo[1]), "+v"(lo[2]), "+v"(lo[3]), "+v"(h2[0]), "+v"(h2[1]), "+v"(h2[2]), "+v"(h2[3]) :: "memory");
        __builtin_amdgcn_sched_barrier(0);
#pragma unroll
        for (int ks = 0; ks < 4; ++ks) {
            const bf16x8 vf = (bf16x8){lo[ks][0], lo[ks][1], lo[ks][2], lo[ks][3], h2[ks][0], h2[ks][1], h2[ks][2], h2[ks][3]};
            o[d0] = __builtin_amdgcn_mfma_f32_32x32x16_bf16(__builtin_bit_cast(bf16x8, pw[ks]), vf, o[d0], 0, 0, 0);
        }
        if (d0 == 0) {
            const bf16x8 ones = (bf16x8){0x3f80, 0x3f80, 0x3f80, 0x3f80, 0x3f80, 0x3f80, 0x3f80, 0x3f80};
#pragma unroll
            for (int ks = 0; ks < 4; ++ks) ol = __builtin_amdgcn_mfma_f32_32x32x16_bf16(__builtin_bit_cast(bf16x8, pw[ks]), ones, ol, 0, 0, 0);
        }
    }
}
__device__ __forceinline__ void mask_exp_pack(f32x16& p0, f32x16& p1, u64 mask, int hi, u32x4 (&pw)[4]) {
    const bool rowuni = __all(mask == ~0ull || mask == 0ull);
    if (rowuni) {
        const unsigned rm = mask ? ~0u : 0u;
        if (__all(mask == ~0ull)) {
#pragma unroll
            for (int r = 0; r < 16; ++r) { p0[r] = __builtin_amdgcn_exp2f(p0[r]); p1[r] = __builtin_amdgcn_exp2f(p1[r]); }
        } else {
#pragma unroll
            for (int r = 0; r < 16; ++r) { p0[r] = __uint_as_float(__float_as_uint(__builtin_amdgcn_exp2f(p0[r])) & rm); p1[r] = __uint_as_float(__float_as_uint(__builtin_amdgcn_exp2f(p1[r])) & rm); }
        }
    } else {
        const int m0 = (int)(unsigned)(mask >> (4 * hi)), m1 = (int)(unsigned)(mask >> (32 + 4 * hi));
#pragma unroll
        for (int r = 0; r < 16; ++r) { const int bit = (r & 3) + 8 * (r >> 2);
            const unsigned e0 = __float_as_uint(__builtin_amdgcn_exp2f(p0[r])), e1 = __float_as_uint(__builtin_amdgcn_exp2f(p1[r]));
            unsigned k0, k1;
            asm("v_bfe_i32 %0, %1, %2, 1" : "=v"(k0) : "v"(m0), "n"(bit)); asm("v_bfe_i32 %0, %1, %2, 1" : "=v"(k1) : "v"(m1), "n"(bit));
            p0[r] = __uint_as_float(e0 & k0); p1[r] = __uint_as_float(e1 & k1); }
    }
    pw[0] = (u32x4){pk2(p0[0], p0[1]), pk2(p0[2], p0[3]), pk2(p0[4], p0[5]), pk2(p0[6], p0[7])};
    pw[1] = (u32x4){pk2(p0[8], p0[9]), pk2(p0[10], p0[11]), pk2(p0[12], p0[13]), pk2(p0[14], p0[15])};
    pw[2] = (u32x4){pk2(p1[0], p1[1]), pk2(p1[2], p1[3]), pk2(p1[4], p1[5]), pk2(p1[6], p1[7])};
    pw[3] = (u32x4){pk2(p1[8], p1[9]), pk2(p1[10], p1[11]), pk2(p1[12], p1[13]), pk2(p1[14], p1[15])};
}
__device__ __forceinline__ u64 mask_le(int c) { return c >= 63 ? ~0ull : (c < 0 ? 0ull : ((2ull << c) - 1ull)); }
__device__ __forceinline__ u64 mask_ge(int a) { return a <= 0 ? ~0ull : (a > 63 ? 0ull : (~0ull << a)); }


__device__ __forceinline__ void glds16(const GAS void* gsrc, unsigned lds_dst) { unsigned keep;
    asm volatile("s_mov_b32 %0, m0\n\ts_mov_b32 m0, %2\n\ts_nop 0\n\tglobal_load_lds_dwordx4 %1, off\n\ts_mov_b32 m0, %0" : "=&s"(keep) : "v"(gsrc), "s"(lds_dst) : "memory"); }
__device__ __forceinline__ void tile_dma(const KVSrc& S, int t, unsigned kslot, unsigned vslot, const Lane& L) {
    const GAS bf16_t* ks = S.k + (size_t)(64 * t + L.lane) * S.pitch + L.wid * 8;
    const GAS bf16_t* vs = S.v + (size_t)(64 * t + 16 * (L.wid & 3) + (L.lane >> 2)) * S.pitch + (L.wid >> 2) * 32 + (L.lane & 3) * 8;
    glds16(ks, (unsigned)__builtin_amdgcn_readfirstlane(kslot + L.wid * 1040));
    glds16(vs, (unsigned)__builtin_amdgcn_readfirstlane(vslot + (L.wid >> 2) * 4096 + (L.wid & 3) * 1024));
}
#define ATT_WAIT_BAR(N) asm volatile("s_waitcnt vmcnt(" #N ") lgkmcnt(0)\n\ts_barrier" ::: "memory")
template <class MF>
__device__ __forceinline__ void attend_range(LAS char* lds, const KVSrc& S, int t0, int t1, const MF& mf, const bf16x8 (&qr)[4], float negC, f32x16& ol, f32x16 (&o)[2], const Lane& L, bool abl = false) {
    if (t0 >= t1) return;
    const bool late = L.wid >= 4;
    const unsigned lds0 = (unsigned)(size_t)lds;
    const f32x16 negm = {0.f, 0.f, 0.f, 0.f, 0.f, 0.f, 0.f, 0.f, 0.f, 0.f, 0.f, 0.f, 0.f, 0.f, 0.f, 0.f};
    (void)negC;
    tile_dma(S, t0, lds0 + L_K0, lds0 + L_V0, L);
    if (t0 + 1 < t1) tile_dma(S, t0 + 1, lds0 + L_K0 + 8320, lds0 + L_V0 + 8192, L);
    if (t0 + 2 < t1) tile_dma(S, t0 + 2, lds0 + L_K0 + 2 * 8320, lds0 + L_V0 + 2 * 8192, L);
    if (t0 + 2 < t1) ATT_WAIT_BAR(4); else if (t0 + 1 < t1) ATT_WAIT_BAR(2); else ATT_WAIT_BAR(0);
    u32x4 pwp[4];
#pragma unroll
    for (int k = 0; k < 4; ++k) asm volatile("" : "=v"(pwp[k]));
    int kcur = 0, vcur = 0, vprev = 0;
    u64 mk_next = mf(t0);
#if defined(PROBE_ABL) && PROBE_ABL == 12
    if (abl) { for (int t = t0; t < t1; ++t) { asm volatile("s_nop 0" ::: "memory"); } return; }
#endif
#if defined(PROBE_ABL) && PROBE_ABL == 13
    if (abl) { for (int t = t0; t < t1; ++t) { ATT_WAIT_BAR(0); } return; }
#endif
#if defined(PROBE_ABL) && PROBE_ABL == 14
    if (abl) { u64 acc_ = 0; for (int t = t0; t < t1; ++t) { acc_ ^= mf(t); asm volatile("s_waitcnt lgkmcnt(0)" : "+v"(acc_) :: "memory"); } asm volatile("" :: "v"(acc_)); return; }
#endif
#if defined(PROBE_ABL) && PROBE_ABL == 15
    if (abl) { for (int t = t0; t < t1; ++t) { f32x16 p0, p1; qk_tile_c(lds + L_K0, qr, negm, p0, p1, L.r32, L.hi); asm volatile("" :: "v"(p0), "v"(p1)); } return; }
#endif
#pragma unroll 1
    for (int t = t0; t < t1; ++t) {
        const u64 mk = mk_next;
        if (t + 1 < t1) mk_next = mf(t + 1);
#if defined(PROBE_ABL) && PROBE_ABL >= 10
        if (t + 3 < t1 && !abl) {
#else
        if (t + 3 < t1) {
#endif
            const int ks = kcur == 0 ? NKB - 1 : kcur - 1; int vs = vcur + 3; vs = vs >= NVB ? vs - NVB : vs;
            tile_dma(S, t + 3, lds0 + L_K0 + ks * 8320, lds0 + L_V0 + vs * 8192, L); }
#if defined(PROBE_ABL) && (PROBE_ABL == 6 || PROBE_ABL >= 10)
        if (late && t > t0 && !abl) pv_tile(lds + L_V0 + vprev * 8192, pwp, o, ol, L.lane, L.hi);
#else
        if (late && t > t0) pv_tile(lds + L_V0 + vprev * 8192, pwp, o, ol, L.lane, L.hi);
#endif
        f32x16 p0, p1;
#if defined(PROBE_ABL) && (PROBE_ABL == 6 || PROBE_ABL >= 10)
        if (abl) { p0 = negm; p1 = negm; asm volatile("" : "+v"(p0), "+v"(p1)); } else
#endif
        qk_tile_c(lds + L_K0 + kcur * 8320, qr, negm, p0, p1, L.r32, L.hi);
        u32x4 pw[4];
#if defined(PROBE_ABL) && (PROBE_ABL == 2 || PROBE_ABL >= 10)
        if (abl) {
#pragma unroll
            for (int k = 0; k < 4; ++k) pw[k] = (u32x4){__float_as_uint(p0[4 * k]) ^ (unsigned)mk, __float_as_uint(p0[4 * k + 1]), __float_as_uint(p1[4 * k + 2]), __float_as_uint(p1[4 * k + 3])}; }
        else
#endif
        mask_exp_pack(p0, p1, mk, L.hi, pw);
#if defined(PROBE_ABL) && (PROBE_ABL == 6 || PROBE_ABL >= 10)
        if (!late && !abl) pv_tile(lds + L_V0 + vcur * 8192, pw, o, ol, L.lane, L.hi);
        else if (!late) { asm volatile("" :: "v"(pw[0]), "v"(pw[1]), "v"(pw[2]), "v"(pw[3])); }
#else
        if (!late) pv_tile(lds + L_V0 + vcur * 8192, pw, o, ol, L.lane, L.hi);
#endif
        else {
#pragma unroll
            for (int k = 0; k < 4; ++k) pwp[k] = pw[k]; }
#if defined(PROBE_ABL) && PROBE_ABL == 11
        if (abl) { asm volatile("s_waitcnt lgkmcnt(0)" ::: "memory"); } else
#endif
        if (t + 3 < t1) ATT_WAIT_BAR(4); else if (t + 2 < t1) ATT_WAIT_BAR(2); else ATT_WAIT_BAR(0);
        vprev = vcur; vcur = vcur == NVB - 1 ? 0 : vcur + 1; kcur = kcur == NKB - 1 ? 0 : kcur + 1;
    }
    if (late) pv_tile(lds + L_V0 + vprev * 8192, pwp, o, ol, L.lane, L.hi);
    ATT_WAIT_BAR(0);
}
__device__ __forceinline__ void rows_to_regs(LAS float* wsf, float v, int r32, int hi, float (&sc)[16]) {
    asm volatile("s_waitcnt lgkmcnt(0)" ::: "memory");
    if (hi == 0) wsf[r32] = v;
    asm volatile("s_waitcnt lgkmcnt(0)" ::: "memory");
#pragma unroll
    for (int r = 0; r < 16; ++r) sc[r] = wsf[crow(r, hi)];
}
__device__ __forceinline__ void load_q(const bf16_t* qrow, int hi, bf16x8 (&qr)[4]) {
#pragma unroll
    for (int d0 = 0; d0 < 4; ++d0) qr[d0] = *(const GAS bf16x8*)(qrow + d0 * 16 + hi * 8);
}
template <class RowPtr>
__device__ __forceinline__ void store_o(LAS char* stage, const f32x16 (&acc)[2], const RowPtr& rowptr, int lane, int r32, int hi) {
    LAS bf16_t* stg = (LAS bf16_t*)stage;
#pragma unroll
    for (int r = 0; r < 16; ++r) { const int orow = crow(r, hi);
#pragma unroll
        for (int d0 = 0; d0 < 2; ++d0) stg[orow * 64 + d0 * 32 + r32] = (bf16_t)(pk2(acc[d0][r], 0.f) & 0xffffu); }
    asm volatile("s_waitcnt lgkmcnt(0)" ::: "memory");
#pragma unroll
    for (int i = 0; i < 4; ++i) { const int row = i * 8 + (lane >> 3), ch = lane & 7; const u32x4 v = *(LAS const u32x4*)(stg + row * 64 + ch * 8); *(GAS u32x4*)(rowptr(row) + ch * 8) = v; }
    asm volatile("s_waitcnt lgkmcnt(0)" ::: "memory");
}
}

constexpr int NWAVES = 8;
constexpr int BATCH = 4, SEQ = 4096, DM = 1024, DFF = 4096, DEPTH = 2, D_IN = 6236;
constexpr int M = BATCH * SEQ;
constexpr size_t MiB = 1u << 20;
constexpr size_t WS_ZQ = 0;
constexpr size_t WS_ZKV = 48 * MiB;
constexpr size_t WS_YS = WS_ZKV;
constexpr size_t WS_MB = 104 * MiB;
constexpr size_t WS_KC2 = WS_MB, WS_VC2 = WS_MB + 4 * MiB;
constexpr size_t WS_XB = 136 * MiB;
constexpr size_t WS_W = 168 * MiB, W_LAYER = 36 * MiB;
constexpr size_t W_IN = 0, W_G = 7 * MiB, W_BR = 13 * MiB, W_OUT = 16 * MiB, W_UP = 18 * MiB, W_DN = 26 * MiB, W_CK1 = 34 * MiB, W_CV1 = 35 * MiB;
constexpr size_t WS_BM = 240 * MiB;
constexpr size_t WS_MISC = 248 * MiB;
constexpr size_t WS_CTL = WS_MISC, CTL_BYTES = 128 * 1024;
constexpr size_t WS_COS = WS_MISC + 1 * MiB, WS_SIN = WS_MISC + 1 * MiB + 512 * 1024;
constexpr size_t WS_KCMP = WS_MISC + 2 * MiB;
constexpr size_t WS_SSQ = WS_MISC + 2 * MiB + 512 * 1024;
constexpr size_t WS_B1P = WS_MISC + 3 * MiB + 512 * 1024;
constexpr size_t WS_W2 = WS_B1P + 64 * 1024;
constexpr size_t WS_IKF = WS_MISC + 4 * MiB;
constexpr size_t WS_HMID = 0;
constexpr size_t WS_END = 256 * MiB;
constexpr int CW_BAR = 4096, CW_Q = 8192, CW_KMAX = 12288;
constexpr int LDS_BYTES = 163840, LDS_UNIT = 163776;
constexpr float C2 = 0.125f * 1.4426950408889634f, LOG2E = 1.4426950408889634f;


struct Args { const float* in[17]; float* out; unsigned char* ws; };
struct Frame {
    LAS unsigned char* lds;
    gu32* ctl;
    int tid, lane, wave, G, gw, NGW;
    unsigned char* ws;
    const struct Args* a;
};
__device__ __forceinline__ float wave_sum(float v) {
#pragma unroll
    for (int o = 1; o < 64; o <<= 1) v += __shfl_xor(v, o);
    return v;
}
__device__ __forceinline__ float wave_max(float v) {
#pragma unroll
    for (int o = 1; o < 64; o <<= 1) v = fmaxf(v, __shfl_xor(v, o));
    return v;
}
__device__ __forceinline__ float bf2f(bf16 h) { return __uint_as_float((unsigned)h << 16); }
__device__ __constant__ float c_inv_freq[32] = {
    1.0f, 0.7498942093324559f, 0.5623413251903491f, 0.4216965034285822f, 0.31622776601683794f, 0.23713737056616552f, 0.1778279410038923f, 0.1333521432163324f,
    0.1f, 0.07498942093324558f, 0.05623413251903491f, 0.042169650342858224f, 0.03162277660168379f, 0.023713737056616554f, 0.01778279410038923f, 0.01333521432163324f,
    0.01f, 0.007498942093324558f, 0.005623413251903491f, 0.004216965034285823f, 0.0031622776601683794f, 0.0023713737056616554f, 0.0017782794100389228f, 0.001333521432163324f,
    0.001f, 0.0007498942093324559f, 0.0005623413251903491f, 0.00042169650342858224f, 0.00031622776601683794f, 0.00023713737056616554f, 0.00017782794100389227f, 0.0001333521432163324f};

__device__ __forceinline__ int mix_src_col(int j) {
    if (j < 512) return j;
    if (j < 1024) return 1092 + (j - 512);
    if (j < 1536) return 1860 + (j - 1024);
    if (j < 1792) return 512 + (j - 1536);
    if (j < 2048) return 1604 + (j - 1792);
    if (j < 2304) return 2372 + (j - 2048);
    if (j < 2560) return 2628 + (j - 2304);
    if (j < 2816) return 2884 + (j - 2560);
    if (j < 3072) return 768 + (j - 2816);
    const int r = j - 3072;
    if (r < 64) return 1024 + r;
    if (r < 68) return 1088 + (r - 64);
    if (r < 92) return 3140 + (r - 68);
    return -1;
}
template <int MODE>
__device__ __forceinline__ void p0_item(const float* W, int ldw, int K, bf16* WT, int nblk, int item, const float* gain, int coff, LAS float* scr, int lane) {
    const int kb = item / nblk, nb = item % nblk, k0 = 64 * kb, n0 = 32 * nb;
    const int nq = 4 * (lane & 7), rr = lane >> 3;
    const int sc = MODE == 0 ? (n0 + nq + coff) : mix_src_col(n0 + nq);
    f32x4 v[8];
#pragma unroll
    for (int i = 0; i < 8; ++i) { v[i] = (f32x4){0.f, 0.f, 0.f, 0.f}; if (sc >= 0) v[i] = *(const GAS f32x4*)(W + (size_t)(k0 + 8 * i + rr) * ldw + sc); }
#pragma unroll
    for (int i = 0; i < 8; ++i) { const int kk = 8 * i + rr; const float g = gain ? gain[k0 + kk] : 1.0f;
        scr[kk * 33 + nq + 0] = v[i][0] * g; scr[kk * 33 + nq + 1] = v[i][1] * g; scr[kk * 33 + nq + 2] = v[i][2] * g; scr[kk * 33 + nq + 3] = v[i][3] * g; }
    LDS_WAIT(); asm volatile("" ::: "memory");
    const int c = lane & 7;
#pragma unroll
    for (int j = 0; j < 4; ++j) { const int n = (lane >> 3) + 8 * j; const LAS float* s = scr + (8 * c) * 33 + n;
        v4u o; o.x = pk2(s[0 * 33], s[1 * 33]); o.y = pk2(s[2 * 33], s[3 * 33]); o.z = pk2(s[4 * 33], s[5 * 33]); o.w = pk2(s[6 * 33], s[7 * 33]);
        *(GAS v4u*)(WT + (size_t)(n0 + n) * K + k0 + 8 * c) = o; }
    LDS_WAIT(); asm volatile("" ::: "memory");
}
__device__ __forceinline__ void p0_prologue(Frame& F) {
    LAS float* scr = (LAS float*)(F.lds + F.wave * 16384);
    constexpr int I_IN = 16 * 104, I_G = 16 * 96, I_BR = 8 * 32, I_OUT = 16 * 32, I_UP = 16 * 128, I_DN = 64 * 32, I_C1 = 32 * 8, I_C2 = 4 * 2;
    constexpr int PER_LAYER = I_IN + I_G + 3 * I_BR + I_OUT + I_UP + I_DN + 2 * I_C1 + 2 * I_C2;
    for (int it = F.gw; it < 2 * PER_LAYER; it += F.NGW) {
        const int l = it / PER_LAYER; int r = it % PER_LAYER;
        unsigned char* wl = F.ws + WS_W + (size_t)l * W_LAYER;
        const float* w_in = F.a->in[2] + (size_t)l * DM * D_IN;
        if (r < I_IN) { p0_item<1>(w_in, D_IN, DM, (bf16*)(wl + W_IN), 104, r, F.a->in[1] + l * DM, 0, scr, F.lane); continue; } r -= I_IN;
        if (r < I_G) { p0_item<0>(w_in, D_IN, DM, (bf16*)(wl + W_G), 96, r, F.a->in[1] + l * DM, 3164, scr, F.lane); continue; } r -= I_G;
        if (r < 3 * I_BR) { const int n = r / I_BR; p0_item<0>(F.a->in[12] + ((size_t)l * 3 + n) * 512 * DM, DM, 512, (bf16*)(wl + W_BR) + (size_t)n * DM * 512, 32, r % I_BR, nullptr, 0, scr, F.lane); continue; } r -= 3 * I_BR;
        if (r < I_OUT) { p0_item<0>(F.a->in[13] + (size_t)l * DM * DM, DM, DM, (bf16*)(wl + W_OUT), 32, r, nullptr, 0, scr, F.lane); continue; } r -= I_OUT;
        if (r < I_UP) { p0_item<0>(F.a->in[15] + (size_t)l * DM * DFF, DFF, DM, (bf16*)(wl + W_UP), 128, r, F.a->in[14] + l * DM, 0, scr, F.lane); continue; } r -= I_UP;
        if (r < I_DN) { p0_item<0>(F.a->in[16] + (size_t)l * DFF * DM, DM, DFF, (bf16*)(wl + W_DN), 32, r, nullptr, 0, scr, F.lane); continue; } r -= I_DN;
        if (r < I_C1) { p0_item<0>(F.a->in[8] + (size_t)l * 2048 * 256, 256, 2048, (bf16*)(wl + W_CK1), 8, r, nullptr, 0, scr, F.lane); continue; } r -= I_C1;
        if (r < I_C1) { p0_item<0>(F.a->in[10] + (size_t)l * 2048 * 256, 256, 2048, (bf16*)(wl + W_CV1), 8, r, nullptr, 0, scr, F.lane); continue; } r -= I_C1;
        if (r < I_C2) { p0_item<0>(F.a->in[9] + (size_t)l * 256 * 64, 64, 256, (bf16*)(F.ws + WS_W2) + (size_t)(l * 2 + 0) * 64 * 256, 2, r, nullptr, 0, scr, F.lane); continue; } r -= I_C2;
        p0_item<0>(F.a->in[11] + (size_t)l * 256 * 64, 64, 256, (bf16*)(F.ws + WS_W2) + (size_t)(l * 2 + 1) * 64 * 256, 2, r, nullptr, 0, scr, F.lane);
    }
    for (int it = F.gw; it < 128; it += F.NGW) {
        const int kp = it & 7, jb = (it >> 3) & 3, which = (it >> 5) & 1, l = it >> 6; const int j = jb * 64 + F.lane;
        const float* pe = (which ? F.a->in[7] : F.a->in[6]) + l * 2048; const float* w1 = (which ? F.a->in[10] : F.a->in[8]) + (size_t)l * 2048 * 256;
        float a = 0.f;
        for (int k = kp * 256; k < kp * 256 + 256; ++k) a = fmaf(pe[k], w1[(size_t)k * 256 + j], a);
        ((float*)(F.ws + WS_B1P))[((l * 2 + which) * 8 + kp) * 256 + j] = a;
    }
    for (int m = F.gw; m < M; m += F.NGW) {
        const GAS f32x4* xr = (const GAS f32x4*)(F.a->in[0] + (size_t)m * DM) + F.lane;
        GAS unsigned long long* o8 = (GAS unsigned long long*)((bf16*)(F.ws + WS_XB) + (size_t)m * DM) + F.lane;
        float s = 0.f;
#pragma unroll
        for (int j = 0; j < 4; ++j) { const f32x4 v = xr[64 * j]; s += (v.x * v.x + v.y * v.y) + (v.z * v.z + v.w * v.w);
            o8[64 * j] = (unsigned long long)pk2(v.x, v.y) | ((unsigned long long)pk2(v.z, v.w) << 32); }
        s = wave_sum(s);
        if (F.lane < 16) ((float*)(F.ws + WS_SSQ))[(size_t)m * 16 + F.lane] = F.lane == 0 ? s : 0.f;
    }
    for (int i = F.gw * 64 + F.lane; i < SEQ * 32; i += F.NGW * 64) {
        const float ang = (float)(i >> 5) * c_inv_freq[i & 31];
        ((float*)(F.ws + WS_COS))[i] = (float)cos((double)ang); ((float*)(F.ws + WS_SIN))[i] = (float)sin((double)ang);
    }
}
typedef unsigned u32x4_t __attribute__((ext_vector_type(4)));
__device__ __forceinline__ void post_group(u32x4_t raw, bool act, bool norm, bool rope, const float (&gain)[8], float scale, const float (&cs)[8], const float (&sn)[8], int lane, bf16* dst) {
    float v[8];
    v[0] = __uint_as_float(raw.x << 16); v[1] = __uint_as_float(raw.x & 0xffff0000u); v[2] = __uint_as_float(raw.y << 16); v[3] = __uint_as_float(raw.y & 0xffff0000u);
    v[4] = __uint_as_float(raw.z << 16); v[5] = __uint_as_float(raw.z & 0xffff0000u); v[6] = __uint_as_float(raw.w << 16); v[7] = __uint_as_float(raw.w & 0xffff0000u);
    float ss = ((v[0] * v[0] + v[1] * v[1]) + (v[2] * v[2] + v[3] * v[3])) + ((v[4] * v[4] + v[5] * v[5]) + (v[6] * v[6] + v[7] * v[7]));
    ss += __shfl_xor(ss, 1); ss += __shfl_xor(ss, 2); ss += __shfl_xor(ss, 4);
    const float rs = norm ? rsqrtf(ss * (1.0f / 64.0f) + 1e-6f) : 1.0f;
    const bool lo = (lane & 4) == 0;
    float r[8];
#pragma unroll
    for (int j = 0; j < 8; ++j) { const float x = norm ? v[j] * rs * gain[j] : v[j]; const float o = __shfl_xor(x, 4);
        r[j] = rope ? (lo ? (x * cs[j] - o * sn[j]) : (x * cs[j] + o * sn[j])) : x; r[j] *= scale; }
    if (act) { u32x4_t w; w.x = pk2(r[0], r[1]); w.y = pk2(r[2], r[3]); w.z = pk2(r[4], r[5]); w.w = pk2(r[6], r[7]); *(GAS u32x4_t*)dst = w; }
}
__device__ __forceinline__ void post_phase(Frame& F, int l, bool dry = false) {
    const float* qn = F.a->in[3] + l * 192; const float* kn = F.a->in[4] + l * 192;
    const int lane = F.lane, g = lane >> 3, c = lane & 7;
    float gq0[8], gq1[8], gq2[8], gk3[8], gk2[8];
#pragma unroll
    for (int j = 0; j < 8; ++j) { gq0[j] = qn[8 * c + j]; gq1[j] = qn[64 + 8 * c + j]; gq2[j] = qn[128 + 8 * c + j]; gk2[j] = kn[128 + 8 * c + j];
        gk3[j] = (g >> 1) == 0 ? kn[8 * c + j] : ((g >> 1) == 1 ? kn[64 + 8 * c + j] : kn[128 + 8 * c + j]); }
    bf16* zq = (bf16*)(F.ws + WS_ZQ); bf16* zkv = (bf16*)(F.ws + WS_ZKV);
    const float* cst = (const float*)(F.ws + WS_COS); const float* snt = (const float*)(F.ws + WS_SIN);
#pragma unroll 1
    for (int m = F.gw; m < M; m += F.NGW) {
        const int t = m & (SEQ - 1), b = m >> 12;
        float cs[8], sn[8];
        { const GAS f32x4* cp = (const GAS f32x4*)(cst + t * 32 + 8 * (c & 3)); const GAS f32x4* sp = (const GAS f32x4*)(snt + t * 32 + 8 * (c & 3));
          const f32x4 c0 = cp[0], c1 = cp[1], s0 = sp[0], s1 = sp[1];
          cs[0] = c0[0]; cs[1] = c0[1]; cs[2] = c0[2]; cs[3] = c0[3]; cs[4] = c1[0]; cs[5] = c1[1]; cs[6] = c1[2]; cs[7] = c1[3];
          sn[0] = s0[0]; sn[1] = s0[1]; sn[2] = s0[2]; sn[3] = s0[3]; sn[4] = s1[0]; sn[5] = s1[1]; sn[6] = s1[2]; sn[7] = s1[3]; }
        bf16* pqa = zq + (size_t)m * 512 + lane * 8; bf16* pqb = pqa + (size_t)M * 512; bf16* pqc = pqa + (size_t)2 * M * 512;
        const int t3 = (g >> 1) < 2 ? (g >> 1) : (g >> 1) + 1;
        bf16* p3 = zkv + (size_t)t3 * M * 256 + (size_t)m * 256 + (g & 1) * 64 + c * 8;
        const bf16* s4 = g < 4 ? zkv + (size_t)2 * M * 256 + (size_t)m * 256 + g * 64 + c * 8 : zkv + (size_t)5 * M * 256 + (size_t)m * 256 + (g - 4) * 64 + c * 8;
        bf16* d4 = g < 2 ? (bf16*)(F.ws + WS_KC2) + ((size_t)(b * 2 + g) * SEQ + t) * 64 + c * 8
                 : (g < 4 ? (bf16*)(F.ws + WS_VC2) + ((size_t)(b * 2 + (g - 2)) * SEQ + t) * 64 + c * 8 : (bf16*)s4);
        const bf16* p5 = zkv + (size_t)6 * M * 256 + (size_t)m * 256 + c * 8;
        bf16* d5 = (bf16*)(F.ws + WS_IKF) + ((size_t)(b * (SEQ / 32) + (t >> 5)) * 8 + c) * 256 + (t & 31) * 8;
        const u32x4_t r0 = *(const GAS u32x4_t*)pqa, r1 = *(const GAS u32x4_t*)pqb, r2 = *(const GAS u32x4_t*)pqc, r3 = *(const GAS u32x4_t*)p3, r4 = *(const GAS u32x4_t*)s4;
        const u32x4_t r5 = *(const GAS u32x4_t*)p5;
        post_group(r0, !dry, true, true, gq0, C2, cs, sn, lane, pqa);
        post_group(r1, !dry, true, true, gq1, C2, cs, sn, lane, pqb);
        post_group(r2, !dry, true, true, gq2, C2, cs, sn, lane, pqc);
        post_group(r3, !dry, true, true, gk3, 1.f, cs, sn, lane, p3);
        post_group(r4, !dry, g < 2, g < 2 || g >= 4, gk2, 1.f, cs, sn, lane, d4);
        post_group(r5, g == 0 && !dry, false, true, gk2, 1.f, cs, sn, lane, d5);
    }
}

#define WAVE_LDS_FENCE() asm volatile("s_waitcnt lgkmcnt(0)" ::: "memory")
__device__ __forceinline__ int next_unit(Frame& F, gu32* counter) {
    LAS int* slot = (LAS int*)(F.lds + LDS_UNIT);
    __syncthreads();
    if (F.tid == 0) *slot = (int)__hip_atomic_fetch_add(counter, 1u, RLX_AGENT);
    __syncthreads();
    return *slot;
}
__device__ __forceinline__ unsigned f2key(float f) { const unsigned u = __float_as_uint(f); return (u & 0x80000000u) ? ~u : (u | 0x80000000u); }
__device__ __forceinline__ float dpp_quad_sum(float v) {
    v += __int_as_float(__builtin_amdgcn_update_dpp(0, __float_as_int(v), 0xB1, 0xF, 0xF, true));
    v += __int_as_float(__builtin_amdgcn_update_dpp(0, __float_as_int(v), 0x4E, 0xF, 0xF, true));
    return v;
}
__device__ __forceinline__ void radix_select_list(LAS const unsigned* list, int nblk, int k, LAS unsigned* hist, int lane, unsigned& T, int& need) {
    typedef unsigned u32x4_ __attribute__((ext_vector_type(4)));
    unsigned prefix = 0u; int kk = k;
#pragma unroll 1
    for (int pass = 0; pass < 4; ++pass) {
        const int shift = 24 - 8 * pass;
#pragma unroll
        for (int i = 0; i < 4; ++i) hist[lane * 4 + i] = 0u;
        WAVE_LDS_FENCE();
#pragma unroll 2
        for (int jb = 0; jb < nblk; ++jb) { const u32x4_ v = *(LAS const u32x4_*)(list + jb * 256 + lane * 4);
#pragma unroll
            for (int c = 0; c < 4; ++c) { const unsigned key = v[c];
                const unsigned bin = (pass == 0 || (key >> (shift + 8)) == prefix) ? ((key >> shift) & 255u) : 256u + (unsigned)lane;
                __hip_atomic_fetch_add(&hist[bin], 1u, __ATOMIC_RELAXED, __HIP_MEMORY_SCOPE_WORKGROUP); } }
        WAVE_LDS_FENCE();
        const unsigned h0 = hist[lane * 4], h1 = hist[lane * 4 + 1], h2 = hist[lane * 4 + 2], h3 = hist[lane * 4 + 3];
        const int tot4 = (int)(h0 + h1 + h2 + h3);
        int pre = tot4;
        pre += __builtin_amdgcn_update_dpp(0, pre, 0x111, 0xf, 0xf, false);
        pre += __builtin_amdgcn_update_dpp(0, pre, 0x112, 0xf, 0xf, false);
        pre += __builtin_amdgcn_update_dpp(0, pre, 0x114, 0xf, 0xf, false);
        pre += __builtin_amdgcn_update_dpp(0, pre, 0x118, 0xf, 0xf, false);
        pre += __builtin_amdgcn_update_dpp(0, pre, 0x142, 0xa, 0xf, false);
        pre += __builtin_amdgcn_update_dpp(0, pre, 0x143, 0xc, 0xf, false);
        const int total = __builtin_amdgcn_readlane(pre, 63);
        const int above = total - pre;
        const int a3 = above, a2 = a3 + (int)h3, a1 = a2 + (int)h2, a0 = a1 + (int)h1;
        int dsel = -1, nk = 0;
        if (a3 < kk && kk <= a3 + (int)h3) { dsel = lane * 4 + 3; nk = kk - a3; }
        else if (a2 < kk && kk <= a2 + (int)h2) { dsel = lane * 4 + 2; nk = kk - a2; }
        else if (a1 < kk && kk <= a1 + (int)h1) { dsel = lane * 4 + 1; nk = kk - a1; }
        else if (a0 < kk && kk <= a0 + (int)h0) { dsel = lane * 4 + 0; nk = kk - a0; }
        const unsigned long long bal = __ballot(dsel >= 0);
        const int src = (int)__builtin_ctzll(bal);
        dsel = __builtin_amdgcn_readlane(dsel, src); nk = __builtin_amdgcn_readlane(nk, src);
        WAVE_LDS_FENCE();
        prefix = (prefix << 8) | (unsigned)dsel; kk = nk;
    }
    T = prefix; need = kk;
}
__device__ __forceinline__ void select_unit(Frame& F, int b, int qblk, int abl = 0) {
    using namespace att;
    int tid_ = F.tid; asm volatile("" : "+v"(tid_));
    const int lane = tid_ & 63, r32 = lane & 31, hi = lane >> 5, w = F.wave;
    LAS unsigned* sc = (LAS unsigned*)F.lds;
    LAS unsigned* hist = (LAS unsigned*)(F.lds + 131072) + w * 320;
    LAS unsigned* cand = (LAS unsigned*)(F.lds + 131072 + 10240) + w * 512;
    const int t0 = qblk * 8; const size_t m0 = (size_t)b * SEQ + t0;
    const bf16* IQ = (const bf16*)(F.ws + WS_ZKV) + (size_t)5 * M * 256; const bf16* MISC = (const bf16*)(F.ws + WS_ZKV) + (size_t)6 * M * 256;
    const bf16* IKF = (const bf16*)(F.ws + WS_IKF) + (size_t)b * SEQ * 64;
    u64* BM = (u64*)(F.ws + WS_BM);
    const int nkeys = t0 + 8;
    if (nkeys > 256 && abl < 2) {
        bf16x8 iqf[4];
        { const bf16* qrow = IQ + (m0 + (r32 >> 2)) * 256 + (r32 & 3) * 64;
#pragma unroll
          for (int d0 = 0; d0 < 4; ++d0) iqf[d0] = *(const GAS bf16x8*)(qrow + d0 * 16 + hi * 8); }
        const float wl = bf2f(((const GAS bf16*)MISC)[(m0 + (r32 >> 2)) * 256 + 64 + (r32 & 3)]);
        const int ntile = (nkeys + 31) >> 5; const int g = r32 & 3;
#pragma unroll 1
        for (int tile0 = w; tile0 < ntile; tile0 += 16) {
            bf16x8 kf[2][4];
#pragma unroll
            for (int u = 0; u < 2; ++u) { const int tile = tile0 + 8 * u < ntile ? tile0 + 8 * u : tile0;
                const bf16* kt = IKF + (size_t)tile * 2048 + hi * 256 + r32 * 8;
#pragma unroll
                for (int d0 = 0; d0 < 4; ++d0) kf[u][d0] = *(const GAS bf16x8*)(kt + d0 * 512); }
#pragma unroll
            for (int u = 0; u < 2; ++u) { const int tile = tile0 + 8 * u;
                if (tile < ntile) {
                    const int s0 = tile * 32;
                    f32x16 acc;
#pragma unroll
                    for (int r = 0; r < 16; ++r) acc[r] = 0.f;
#pragma unroll
                    for (int d0 = 0; d0 < 4; ++d0) acc = __builtin_amdgcn_mfma_f32_32x32x16_bf16(kf[u][d0], iqf[d0], acc, 0, 0, 0);
                    float v[16];
#pragma unroll
                    for (int r = 0; r < 16; ++r) v[r] = dpp_quad_sum(__builtin_amdgcn_fmed3f(acc[r], 0.f, __builtin_inff()) * wl);
                    u32x4 o;
#pragma unroll
                    for (int j = 0; j < 4; ++j) o[j] = f2key(g == 0 ? v[j] : (g == 1 ? v[4 + j] : (g == 2 ? v[8 + j] : v[12 + j])));
                    *(LAS u32x4*)(sc + (r32 >> 2) * 4096 + s0 + 8 * g + 4 * hi) = o;
                } }
        }
    }
    __syncthreads();
    if (abl != 1) {
        const int t = t0 + w, n = t + 1; LAS unsigned* row = sc + w * 4096;
        u64 myword = 0ull;
        if (n <= 256) {
            const int c0 = 64 * lane;
            myword = (c0 + 63 < n) ? ~0ull : (c0 >= n ? 0ull : ((1ull << (n - c0)) - 1ull));
        } else {
            const int nblk = (n + 255) >> 8;
            { const int s = (n & ~3) + lane * 4;
              if (s < nblk * 256) { u32x4 v = *(LAS u32x4*)(row + s);
#pragma unroll
                  for (int c = 0; c < 4; ++c) if (s + c >= n) v[c] = 0u;
                  *(LAS u32x4*)(row + s) = v; } }
            WAVE_LDS_FENCE();
            unsigned T = 0u; int need = 0; bool done = false;
            if (n > 512 && abl != 5) {
#pragma unroll
                for (int c = 0; c < 8; ++c) { const int i = lane + 64 * c; cand[i] = row[(i * n) >> 9]; }
                WAVE_LDS_FENCE();
                const float er = 131072.0f / (float)n;
                int rr = (int)(er + 2.5f * __builtin_sqrtf(er * (1.0f - 256.0f / (float)n)) + 2.0f); rr = rr > 512 ? 512 : rr;
                unsigned P; int dummy; radix_select_list(cand, 2, rr, hist, lane, P, dummy);
                int C = 0; bool ovf = false;
#pragma unroll 1
                for (int jb = 0; jb < nblk; ++jb) { const u32x4 v = *(LAS const u32x4*)(row + jb * 256 + lane * 4);
#pragma unroll
                    for (int c = 0; c < 4; ++c) { const bool in = v[c] > P; const u64 bal = __ballot(in); const int pos = C + __builtin_popcountll(bal & ((1ull << lane) - 1ull));
                        C += __builtin_popcountll(bal); if (C > 512) ovf = true;
                        if (in && !ovf) cand[pos] = v[c]; } }
                if (!ovf && C >= 256) {
                    WAVE_LDS_FENCE();
                    const int cb = (C + 255) >> 8;
                    { const int s = C + lane; if (s < cb * 256) cand[s] = 0u; const int s2 = s + 64; if (s2 < cb * 256) cand[s2] = 0u; const int s3 = s + 128; if (s3 < cb * 256) cand[s3] = 0u; const int s4 = s + 192; if (s4 < cb * 256) cand[s4] = 0u; }
                    WAVE_LDS_FENCE();
                    radix_select_list(cand, cb, 256, hist, lane, T, need); done = true;
                }
            }
            if (!done && abl < 3) radix_select_list(row, nblk, 256, hist, lane, T, need);
            int base = 0;
            const int nch = abl >= 4 ? 0 : (n + 63) >> 6;
#pragma unroll 1
            for (int c = 0; c < nch; c += 4) {
                unsigned vv[4];
#pragma unroll
                for (int u2 = 0; u2 < 4; ++u2) vv[u2] = row[64 * (c + u2) + lane];
#pragma unroll
                for (int u2 = 0; u2 < 4; ++u2) {
                    const int s = 64 * (c + u2) + lane; const bool valid = s < n; const unsigned key = valid ? vv[u2] : 0u;
                    const bool gt = valid && key > T, eq = valid && key == T;
                    const u64 beq = __ballot(eq);
                    const int rank = base + __builtin_popcountll(beq & ((1ull << lane) - 1ull));
                    const u64 word = __ballot(gt || (eq && rank < need));
                    if (lane == c + u2) myword = word;
                    base += __builtin_popcountll(beq);
                }
            }
        }
        if (abl >= 2) ((GAS u64*)(F.ws + WS_MB + 24 * MiB))[((size_t)b * SEQ + t) * 64 + lane] = myword;
        else ((GAS u64*)BM)[((size_t)b * SEQ + t) * 64 + lane] = myword;
    }
    __syncthreads();
}
__device__ __forceinline__ void compress_unit(Frame& F, int l, int u) {
    using namespace att;
    int tid_ = F.tid; asm volatile("" : "+v"(tid_));
    const int lane = tid_ & 63, r32 = lane & 31, hi = lane >> 5, w = F.wave;
    const int which = u & 1, h = (u >> 1) & 1, b = (u >> 2) & 3, cb = u >> 4;
    const bf16* src = (const bf16*)(F.ws + (which ? WS_VC2 : WS_KC2)) + (size_t)(b * 2 + h) * SEQ * 64;
    const bf16* W1t = (const bf16*)(F.ws + WS_W + (size_t)l * W_LAYER + (which ? W_CV1 : W_CK1));
    const bf16* W2t = (const bf16*)(F.ws + WS_W2) + (size_t)(l * 2 + which) * 64 * 256;
    const float* b1p = (const float*)(F.ws + WS_B1P) + (size_t)(l * 2 + which) * 8 * 256;
    LAS bf16* hid = (LAS bf16*)F.lds;
    int cc = 32 * cb + r32; if (cc > 254) cc = 254;
    const bf16* arow = src + (size_t)(16 * cc) * 64 + hi * 8;
    const bf16* brow = W1t + (size_t)(32 * w + r32) * 2048 + hi * 8;
    f32x16 acc;
#pragma unroll
    for (int r = 0; r < 16; ++r) acc[r] = 0.f;
#pragma unroll 4
    for (int ks = 0; ks < 128; ++ks) { const bf16x8 a = *(const GAS bf16x8*)(arow + ks * 16), bb = *(const GAS bf16x8*)(brow + ks * 16); acc = __builtin_amdgcn_mfma_f32_32x32x16_bf16(a, bb, acc, 0, 0, 0); }
    float b1 = 0.f;
#pragma unroll
    for (int kp = 0; kp < 8; ++kp) b1 += ((const GAS float*)b1p)[kp * 256 + 32 * w + r32];
#pragma unroll
    for (int r = 0; r < 16; ++r) hid[crow(r, hi) * 264 + 32 * w + r32] = (bf16)f2bf(fmaxf(acc[r] + b1, 0.f));
    __syncthreads();
    if (w < 2) {
        f32x16 o;
#pragma unroll
        for (int r = 0; r < 16; ++r) o[r] = 0.f;
        const bf16* w2row = W2t + (size_t)(32 * w + r32) * 256 + hi * 8;
#pragma unroll
        for (int ks = 0; ks < 16; ++ks) { const bf16x8 a = *(LAS const bf16x8*)(hid + r32 * 264 + ks * 16 + hi * 8), bb = *(const GAS bf16x8*)(w2row + ks * 16); o = __builtin_amdgcn_mfma_f32_32x32x16_bf16(a, bb, o, 0, 0, 0); }
        bf16* dst = (bf16*)(F.ws + WS_KCMP) + ((size_t)((which * 4 + b) * 2 + h) * 256) * 64;
        float mx = 0.f;
#pragma unroll
        for (int r = 0; r < 16; ++r) { const int c = 32 * cb + crow(r, hi); const float v = c < 255 ? o[r] : 0.f; mx = fmaxf(mx, fabsf(v)); ((GAS bf16*)dst)[(size_t)c * 64 + 32 * w + r32] = (bf16)f2bf(v); }
        if (which == 0) { mx = wave_max(mx); if (lane == 0) __hip_atomic_fetch_max(F.ctl + CW_KMAX + 64 * (l * 8 + b * 2 + h), __float_as_uint(mx), RLX_AGENT); }
    }
    __syncthreads();
}
struct UnitGeom { int b, kvh, i; att::Lane L; int q; int head; size_t mrow; };
__device__ __forceinline__ UnitGeom unit_geom(Frame& F, int b, int kvh, int i) {
    int tid = F.tid; asm volatile("" : "+v"(tid));
    UnitGeom U; U.b = b; U.kvh = kvh; U.i = i; U.L.tid = tid; U.L.lane = tid & 63; U.L.r32 = tid & 31; U.L.hi = (tid >> 5) & 1; U.L.wid = F.wave;
    U.q = 64 * i + 8 * F.wave + (U.L.r32 >> 2); U.head = 4 * kvh + (U.L.r32 & 3); U.mrow = (size_t)b * SEQ + U.q; return U;
}
__device__ __forceinline__ void branch_finish(LAS float* wsf, const att::f32x16& ol, const float (&extra)[4], float rowscale, bool has_scale, const att::f32x16 (&o)[2], att::f32x16 (&acc)[2], const att::Lane& L, bool first) {
    float sc[16];
    if (has_scale) att::rows_to_regs(wsf, rowscale, L.r32, L.hi, sc);
#pragma unroll
    for (int r = 0; r < 16; ++r) { const float lf = ol[r] + extra[r & 3]; const float inv = lf > 0.f ? __builtin_amdgcn_rcpf(lf) : 0.f; sc[r] = has_scale ? sc[r] * inv : inv; }
#pragma unroll
    for (int d0 = 0; d0 < 2; ++d0)
#pragma unroll
        for (int r = 0; r < 16; ++r) acc[d0][r] = first ? o[d0][r] * sc[r] : acc[d0][r] + o[d0][r] * sc[r];
}
__device__ __forceinline__ void branch_finish_lds(LAS float* wsf, LAS float* accw, const att::f32x16& ol, float rowscale, const att::f32x16 (&o)[2], const att::Lane& L, bool first) {
    float sc[16]; att::rows_to_regs(wsf, rowscale, L.r32, L.hi, sc);
#pragma unroll
    for (int r = 0; r < 16; ++r) sc[r] = ol[r] > 0.f ? sc[r] * __builtin_amdgcn_rcpf(ol[r]) : 0.f;
#pragma unroll
    for (int d0 = 0; d0 < 2; ++d0)
#pragma unroll
        for (int r = 0; r < 16; ++r) { float v = o[d0][r] * sc[r]; if (!first) v += accw[(d0 * 16 + r) * 64 + L.lane]; accw[(d0 * 16 + r) * 64 + L.lane] = v; }
}
__device__ __forceinline__ float gain_bound(const float* g, int lane) { return wave_max(fabsf(g[lane])); }

template <int KIND  >
__device__ __forceinline__ void simple_unit(Frame& F, int l, int b, int kvh, int i, bf16* odst = nullptr) {
    using namespace att;
    const UnitGeom U = unit_geom(F, b, kvh, i); const Lane& L = U.L;
    constexpr int QT = KIND == 0 ? 1 : 0, KT = KIND == 0 ? 1 : 0, NM = KIND == 0 ? 1 : 0;
    bf16* Q = (bf16*)(F.ws + WS_ZQ) + (size_t)QT * M * 512; const bf16* KV = (const bf16*)(F.ws + WS_ZKV) + (size_t)KT * M * 256;
    bf16x8 qr[4]; load_q(Q + U.mrow * 512 + U.head * 64, L.hi, qr);
    const float C = 0.f; (void)NM;
    KVSrc S{(const GAS bf16*)(KV + (size_t)b * SEQ * 256 + kvh * 64), (const GAS bf16*)(KV + (size_t)b * SEQ * 256 + 128 + kvh * 64), 256, SEQ};
    f32x16 ol, o[2];
#pragma unroll
    for (int r = 0; r < 16; ++r) { o[0][r] = 0.f; o[1][r] = 0.f; ol[r] = 0.f; }
    const int q = U.q;
    if (KIND == 0) {
        auto mf = [q](int t) -> u64 { return mask_le(q - 64 * t) & mask_ge(q - 127 - 64 * t); };
        attend_range((LAS char*)F.lds, S, i - 2 < 0 ? 0 : i - 2, i + 1, mf, qr, -C, ol, o, L);
    } else {
        LAS char* mrows = (LAS char*)F.lds + L_OST + L.wid * 8192 + 4096;
        { const GAS u32x4* src = (const GAS u32x4*)((const GAS u64*)(F.ws + WS_BM) + ((size_t)b * SEQ + 64 * i + 8 * L.wid) * 64);
#pragma unroll
          for (int k = 0; k < 4; ++k) *(LAS u32x4*)(mrows + (k * 64 + L.lane) * 16) = src[k * 64 + L.lane];
          WAVE_LDS_FENCE(); }
        LAS const char* mrow = mrows + (L.r32 >> 2) * 512;
        auto mf = [mrow](int t) -> u64 { return *(LAS const u64*)(mrow + t * 8); };
#ifdef PROBE_TILES
        attend_range((LAS char*)F.lds, S, 0, odst ? (i + 1 < PROBE_TILES ? i + 1 : PROBE_TILES) : i + 1, mf, qr, -C, ol, o, L, odst != nullptr);
#else
        attend_range((LAS char*)F.lds, S, 0, i + 1, mf, qr, -C, ol, o, L, odst != nullptr);
#endif
    }
    const UnitGeom V = unit_geom(F, b, kvh, i); const Lane& L2 = V.L;
    float extra[4] = {0.f, 0.f, 0.f, 0.f};
    if (KIND == 0) {
#pragma unroll
        for (int g = 0; g < 4; ++g) extra[g] = __builtin_amdgcn_exp2f(F.a->in[5][l * 8 + 4 * kvh + g] * LOG2E);
    }
    f32x16 acc[2];
    branch_finish((LAS float*)((LAS char*)F.lds + L_WSF) + L2.wid * WSF_W, ol, extra, 1.f, false, o, acc, L2, true);
    bf16* Q2 = (bf16*)(F.ws + WS_ZQ) + (size_t)QT * M * 512;
    const size_t tok0 = (size_t)b * SEQ + 64 * i + 8 * L2.wid; const int kvh4 = 4 * kvh;
    bf16* Od = odst ? odst : Q2;
    auto rowptr = [Od, tok0, kvh4](int row) -> bf16* { return Od + (tok0 + (row >> 2)) * 512 + (kvh4 + (row & 3)) * 64; };
    store_o((LAS char*)F.lds + L_OST + L2.wid * 8192, acc, rowptr, L2.lane, L2.r32, L2.hi);
}
__device__ __forceinline__ void nsa_unit(Frame& F, int l, int b, int kvh, int i, bf16* odst = nullptr) {
    using namespace att;
    f32x16 o[2], ol;
    bf16x8 qr[4];
    {
        const UnitGeom U = unit_geom(F, b, kvh, i); const Lane& L = U.L;
        const bf16* Q = (const bf16*)(F.ws + WS_ZQ) + (size_t)2 * M * 512; const bf16* MISC = (const bf16*)(F.ws + WS_ZKV) + (size_t)6 * M * 256;
        load_q(Q + U.mrow * 512 + U.head * 64, L.hi, qr);
        LAS float* wsf = (LAS float*)((LAS char*)F.lds + L_WSF) + L.wid * WSF_W;
#pragma unroll
        for (int br = 0; br < 3; ++br) wsf[64 + br * 64 + L.lane] = pg8::sigmoidf_(bf2f(((const GAS bf16*)MISC)[U.mrow * 256 + 68 + U.head * 3 + br]));
        WAVE_LDS_FENCE();
    }
    const float Ck = 0.f, Cc = 0.f;
    const int qmax = 64 * i + 63; const int nvmax = qmax >= 31 ? (((qmax - 31) >> 4) + 1 < 255 ? ((qmax - 31) >> 4) + 1 : 255) : 0;
    const int tc = (nvmax + 63) >> 6;
    const bf16* kcmp = (const bf16*)(F.ws + WS_KCMP) + (size_t)((0 * 4 + b) * 2 + kvh) * 256 * 64; const bf16* vcmp = (const bf16*)(F.ws + WS_KCMP) + (size_t)((1 * 4 + b) * 2 + kvh) * 256 * 64;
    {
        const UnitGeom U = unit_geom(F, b, kvh, i); const Lane& L = U.L; const int q = U.q;
        const int nval = q >= 31 ? (((q - 31) >> 4) + 1 < 255 ? ((q - 31) >> 4) + 1 : 255) : 0;
        KVSrc Sc{(const GAS bf16*)kcmp, (const GAS bf16*)vcmp, 64, 256};
        auto mfc = [nval](int t) -> u64 { return mask_le(nval - 1 - 64 * t); };
#pragma unroll
        for (int r = 0; r < 16; ++r) { o[0][r] = 0.f; o[1][r] = 0.f; ol[r] = 0.f; }
        attend_range((LAS char*)F.lds, Sc, 0, tc, mfc, qr, -Cc, ol, o, L);
    }
    const UnitGeom U = unit_geom(F, b, kvh, i); const Lane& L = U.L; const int q = U.q;
    LAS float* wsf = (LAS float*)((LAS char*)F.lds + L_WSF) + L.wid * WSF_W;
    LAS float* accw = (LAS float*)((LAS char*)F.lds + L_OST + L.wid * 8192);
    const int nval = q >= 31 ? (((q - 31) >> 4) + 1 < 255 ? ((q - 31) >> 4) + 1 : 255) : 0;
    auto mfc = [nval](int t) -> u64 { return mask_le(nval - 1 - 64 * t); };
    WAVE_LDS_FENCE();
    if (L.r32 == 0) {
#pragma unroll
        for (int r = 0; r < 16; ++r) wsf[32 + crow(r, L.hi)] = ol[r]; }
    WAVE_LDS_FENCE();
    const float lc = wsf[32 + L.r32]; const float rlc = lc > 0.f ? __builtin_amdgcn_rcpf(lc) : 0.f;
    branch_finish_lds(wsf, accw, ol, wsf[64 + L.lane], o, L, true);
    LAS float* impw = (LAS float*)((LAS char*)F.lds + L_IMP) + L.wid * 512;
#pragma unroll
    for (int k = 0; k < 8; ++k) impw[L.lane + 64 * k] = 0.f;
    WAVE_LDS_FENCE();
    for (int t = 0; t < tc; ++t) {
        f32x16 p0, p1;
#pragma unroll
        for (int r = 0; r < 16; ++r) { p0[r] = 0.f; p1[r] = 0.f; }
        qk_tile((LAS char*)F.lds + L_K0 + t * 8320, qr, p0, p1, L.r32, L.hi);
        const u64 mk = mfc(t); const unsigned m0 = (unsigned)(mk >> (4 * L.hi)), m1 = (unsigned)(mk >> (32 + 4 * L.hi));
        const int qloc = L.r32 >> 2; const bool wr = (L.r32 & 3) == 0;
#pragma unroll
        for (int half = 0; half < 2; ++half)
#pragma unroll
            for (int m = 0; m < 4; ++m) {
                float e[4];
#pragma unroll
                for (int k = 0; k < 4; ++k) { const int r = 4 * m + k, bit = k + 8 * m; const float x = half ? p1[r] : p0[r]; const unsigned mm = half ? m1 : m0;
                    e[k] = ((mm >> bit) & 1u) ? __builtin_amdgcn_exp2f(x) * rlc : 0.f; }
                const float core = dpp_quad_sum((e[0] + e[1]) + (e[2] + e[3])), edge = dpp_quad_sum(e[3]);
                const int j = 16 * t + 8 * half + 2 * m + L.hi;
                if (wr) { impw[qloc * 64 + j] += core; }
                WAVE_LDS_FENCE();
                if (wr && j + 1 < 64) { impw[qloc * 64 + j + 1] += edge; }
                WAVE_LDS_FENCE();
            }
    }
    __syncthreads();
    {
        const int qloc = L.lane >> 3, sub = L.lane & 7; const int cur = i;
        u64 keys[8];
#pragma unroll
        for (int k = 0; k < 8; ++k) { const int j = sub + 8 * k; float v = impw[qloc * 64 + j];
            if (j == 0 || j == cur || j == cur - 1) v = 1e9f;
            if (j > cur) v = -1e30f;
            keys[k] = ((u64)f2key(v) << 32) | (u64)(63 - j); }
        u64 selm = 0ull; unsigned used = 0u;
#pragma unroll 1
        for (int it = 0; it < 16; ++it) {
            u64 best = 0ull;
#pragma unroll
            for (int k = 0; k < 8; ++k) { const u64 c = ((used >> k) & 1u) ? 0ull : keys[k]; best = c > best ? c : best; }
#pragma unroll
            for (int o2 = 1; o2 < 8; o2 <<= 1) { const unsigned lo = __shfl_xor((unsigned)best, o2), hi2 = __shfl_xor((unsigned)(best >> 32), o2); const u64 ob = ((u64)hi2 << 32) | lo; best = ob > best ? ob : best; }
            const int jsel = 63 - (int)(best & 63ull);
            if ((jsel & 7) == sub) used |= 1u << (jsel >> 3);
            selm |= 1ull << jsel;
        }
        LAS u64* selw = (LAS u64*)((LAS char*)F.lds + L_SEL) + L.wid * 8;
        if (sub == 0) selw[qloc] = selm;
        WAVE_LDS_FENCE();
    }
    {
        const UnitGeom X = unit_geom(F, b, kvh, i); const Lane& L = X.L; const int q = X.q;
        const u64 sel = ((LAS const u64*)((LAS char*)F.lds + L_SEL))[L.wid * 8 + (L.r32 >> 2)];
        const bf16* KV = (const bf16*)(F.ws + WS_ZKV) + (size_t)3 * M * 256;
        KVSrc S{(const GAS bf16*)(KV + (size_t)b * SEQ * 256 + kvh * 64), (const GAS bf16*)(KV + (size_t)b * SEQ * 256 + 128 + kvh * 64), 256, SEQ};
        auto mf = [sel, q](int t) -> u64 { return ((sel >> t) & 1ull) ? mask_le(q - 64 * t) : 0ull; };
#pragma unroll
        for (int r = 0; r < 16; ++r) { o[0][r] = 0.f; o[1][r] = 0.f; ol[r] = 0.f; }
        attend_range((LAS char*)F.lds, S, 0, i + 1, mf, qr, -Ck, ol, o, L);
        const UnitGeom W = unit_geom(F, b, kvh, i); LAS float* wsf2 = (LAS float*)((LAS char*)F.lds + L_WSF) + W.L.wid * WSF_W;
        branch_finish_lds(wsf2, (LAS float*)((LAS char*)F.lds + L_OST + W.L.wid * 8192), ol, wsf2[128 + W.L.lane], o, W.L, false);
    }
    {
        const UnitGeom X = unit_geom(F, b, kvh, i); const Lane& L = X.L; const int q = X.q;
        const bf16* KV = (const bf16*)(F.ws + WS_ZKV) + (size_t)4 * M * 256;
        KVSrc S{(const GAS bf16*)(KV + (size_t)b * SEQ * 256 + kvh * 64), (const GAS bf16*)(KV + (size_t)b * SEQ * 256 + 128 + kvh * 64), 256, SEQ};
        auto mf = [q](int t) -> u64 { return mask_le(q - 64 * t) & mask_ge(q - 511 - 64 * t); };
#pragma unroll
        for (int r = 0; r < 16; ++r) { o[0][r] = 0.f; o[1][r] = 0.f; ol[r] = 0.f; }
        attend_range((LAS char*)F.lds, S, i - 8 < 0 ? 0 : i - 8, i + 1, mf, qr, -Ck, ol, o, L);
        const UnitGeom W = unit_geom(F, b, kvh, i); LAS float* wsf2 = (LAS float*)((LAS char*)F.lds + L_WSF) + W.L.wid * WSF_W;
        branch_finish_lds(wsf2, (LAS float*)((LAS char*)F.lds + L_OST + W.L.wid * 8192), ol, wsf2[192 + W.L.lane], o, W.L, false);
    }
    {
        const UnitGeom X = unit_geom(F, b, kvh, i); const Lane& L = X.L;
        LAS float* accw2 = (LAS float*)((LAS char*)F.lds + L_OST + L.wid * 8192);
        const size_t tok0 = (size_t)b * SEQ + 64 * i + 8 * L.wid; const int kvh4 = 4 * kvh;
        bf16* Od = odst ? odst : (bf16*)(F.ws + WS_ZQ) + (size_t)2 * M * 512;
        auto rowptr = [Od, tok0, kvh4](int row) -> bf16* { return Od + (tok0 + (row >> 2)) * 512 + (kvh4 + (row & 3)) * 64; };
        f32x16 acc[2];
#pragma unroll
        for (int d0 = 0; d0 < 2; ++d0)
#pragma unroll
            for (int r = 0; r < 16; ++r) acc[d0][r] = accw2[(d0 * 16 + r) * 64 + L.lane];
        WAVE_LDS_FENCE();
        store_o((LAS char*)F.lds + L_OST + L.wid * 8192, acc, rowptr, L.lane, L.r32, L.hi);
    }
}

__global__ void __launch_bounds__(NWAVES * 64, 2) mk_fwd(Args args) {
    extern __shared__ __attribute__((aligned(16))) unsigned char lds_raw[];
    LAS unsigned char* lds = (LAS unsigned char*)lds_raw;
    volatile LAS unsigned* MISCW = (volatile LAS unsigned*)(lds + LDS_UNIT + 16);
    if (threadIdx.x < 8) MISCW[threadIdx.x] = 0u;
    __syncthreads();
    (void)xcd_barrier_post((unsigned*)((gu32*)(args.ws + WS_CTL) + CW_BAR), MISCW);
#define GRID_BARRIER() do { unsigned char* wsb_ = args.ws; asm volatile("" : "+s"(wsb_)); XcdBarrier bar_; bar_.bar = (unsigned*)((gu32*)(wsb_ + WS_CTL) + CW_BAR); bar_.x = xb_xcc_id(); \
    bar_.st = (volatile LAS unsigned*)(lds + LDS_UNIT + 16); xcd_barrier(bar_); } while (0)
#define MKFRAME() Frame F; { unsigned char* ws_ = args.ws; asm volatile("" : "+s"(ws_)); int tid_ = threadIdx.x; asm volatile("" : "+v"(tid_)); \
    F.lds = lds; F.tid = tid_; F.lane = tid_ & 63; F.wave = __builtin_amdgcn_readfirstlane(tid_ >> 6); F.G = gridDim.x; F.gw = 0; F.NGW = F.G * NWAVES; \
    F.ws = ws_; F.ctl = (gu32*)(ws_ + WS_CTL); F.a = &args; } int bid = blockIdx.x; asm volatile("" : "+s"(bid)); F.gw = bid * NWAVES + F.wave; \
    unsigned char* ws = F.ws; bf16* XB = (bf16*)(ws + WS_XB); bf16* MB = (bf16*)(ws + WS_MB); bf16* ZQ = (bf16*)(ws + WS_ZQ); bf16* ZKV = (bf16*)(ws + WS_ZKV); bf16* YS = (bf16*)(ws + WS_YS); bf16* HM = (bf16*)(ws + WS_HMID); \
    float* SSQ = (float*)(ws + WS_SSQ); (void)XB; (void)MB; (void)ZQ; (void)ZKV; (void)YS; (void)HM; (void)SSQ;
#define WL(l) (ws + WS_W + (size_t)(l) * W_LAYER)
#ifdef PROBE_T
#define STAMP(k) do { if (blockIdx.x == 0 && threadIdx.x == 0) ((unsigned long long*)(args.ws + WS_CTL + 96 * 1024))[k] = __builtin_amdgcn_s_memrealtime(); } while (0)
#else
#define STAMP(k) do { } while (0)
#endif

    STAMP(0);
#ifndef NO_P0
    { MKFRAME(); p0_prologue(F); }
#ifdef DBL_P0
    { MKFRAME(); p0_prologue(F); }
#endif
#endif
    GRID_BARRIER();
    STAMP(1);
#pragma unroll 1
    for (int l = 0; l < DEPTH; ++l) {
#ifndef NO_G1
#ifdef DBL_G1
        for (int rep_ = 0; rep_ < 2; ++rep_)
#endif
        {
            MKFRAME(); unsigned char* wl = WL(l);
            pg8::Gemm g{XB, (const bf16*)(wl + W_IN), M, 3328, DM}; pg8::StaticOrder S; S.init(M, 3328, F.G, bid);
            pg8::EpiG1 E{ZQ, ZKV, SSQ};
            pg8::gemm_phase<pg8::EpiG1, pg8::StaticOrder, true, true>(F.lds, g, S, E);
        }
#endif
        GRID_BARRIER();
        STAMP(2 + 8 * l);
#ifndef NO_POST
        { MKFRAME(); post_phase(F, l); }
#ifdef DBL_POST
        { MKFRAME(); post_phase(F, l, true); }
#endif
#endif
        GRID_BARRIER();
        STAMP(3 + 8 * l);
#ifdef DBL_ATT1
        for (int rep1_ = 0; rep1_ < 2; ++rep1_)
#else
        const int rep1_ = 0;
#endif
        {
            MKFRAME();
            const int xcd = (int)(xb_xcc_id() & 7u);
#pragma unroll 1
            for (int qi = 0; qi < 8; ++qi) {
                const int x = (xcd + qi) & 7, b = x >> 1, sub = x & 1;
                gu32* ctr = F.ctl + CW_Q + 64 * ((2 * l + 4 * rep1_) * 8 + x);
                for (;;) { const int v = next_unit(F, ctr); if (v >= 16 + 256 + 64) break;
#ifdef DBL_ATT1
                    if (v < 16) { if (rep1_ == 0 || DBL_ATT1 == 1 || DBL_ATT1 == 2) compress_unit(F, l, (v & 1) | (sub << 1) | (b << 2) | ((v >> 1) << 4)); }
                    else if (v < 16 + 256) { if (rep1_ == 0 || DBL_ATT1 == 1 || DBL_ATT1 == 3 || DBL_ATT1 >= 5) select_unit(F, b, 2 * (255 - (v - 16)) + sub, rep1_ ? (DBL_ATT1 >= 5 ? DBL_ATT1 - 4 : 0) : 0  ); }
                    else if (rep1_ && DBL_ATT1 != 1 && DBL_ATT1 != 4) { }
#else
                    if (v < 16) { compress_unit(F, l, (v & 1) | (sub << 1) | (b << 2) | ((v >> 1) << 4)); }
                    else if (v < 16 + 256) { select_unit(F, b, 2 * (255 - (v - 16)) + sub); }
#endif
                    else { simple_unit<0>(F, l, b, sub, 63 - (v - 272), rep1_ ? (bf16*)(ws + WS_MB + 8 * MiB) : nullptr); }
                }
            }
        }
        GRID_BARRIER();
        STAMP(4 + 8 * l);
#ifdef DBL_ATT2
        for (int rep_ = 0; rep_ < 2; ++rep_)
#else
        const int rep_ = 0;
#endif
        {
            MKFRAME();
            bf16* od = rep_ ? (bf16*)(ws + WS_MB) : nullptr;
            const int xcd = (int)(xb_xcc_id() & 7u);
#pragma unroll 1
            for (int qi = 0; qi < 8; ++qi) {
                const int x = (xcd + qi) & 7, b = x >> 1, kvh = x & 1;
                gu32* ctr = F.ctl + CW_Q + 64 * ((2 * l + 1 + 4 * rep_) * 8 + x);
                for (;;) { const int v = next_unit(F, ctr); if (v >= 128) break;
                    const int i = 63 - (v >> 1);
#ifdef DBL_ATT2
                    if ((v & 1) && (rep_ == 0 || DBL_ATT2 != 3)) simple_unit<1>(F, l, b, kvh, i, od);
                    if (!(v & 1) && (rep_ == 0 || DBL_ATT2 != 2)) nsa_unit(F, l, b, kvh, i, od);
#else
                    if (v & 1) simple_unit<1>(F, l, b, kvh, i, od); else nsa_unit(F, l, b, kvh, i, od);
#endif
                }
            }
        }
        GRID_BARRIER();
        STAMP(5 + 8 * l);
#ifndef NO_G2
#ifdef DBL_G2
        for (int rep_ = 0; rep_ < 2; ++rep_)
#endif
#pragma unroll 1
        for (int n = 0; n < 3; ++n) {
            MKFRAME(); unsigned char* wl = WL(l);
#ifndef NO_G2A
            { pg8::Gemm g{ZQ + (size_t)n * M * 512, (const bf16*)(wl + W_BR) + (size_t)n * DM * 512, M, DM, 512}; pg8::StaticOrder S; S.init(M, DM, F.G, bid);
              pg8::EpiStash E{YS}; pg8::gemm_phase<pg8::EpiStash, pg8::StaticOrder, false, true>(F.lds, g, S, E); }
#endif
#ifndef NO_G2B
            { pg8::Gemm g{XB, (const bf16*)(wl + W_G) + (size_t)n * DM * DM, M, DM, DM}; pg8::StaticOrder S; S.init(M, DM, F.G, bid);
              pg8::EpiGate E{YS, MB, SSQ, n == 0 ? 1 : 0}; pg8::gemm_phase<pg8::EpiGate, pg8::StaticOrder, false, true>(F.lds, g, S, E); }
#endif
        }
#endif
        GRID_BARRIER();
        STAMP(6 + 8 * l);
#ifndef NO_G3
        {
            MKFRAME(); unsigned char* wl = WL(l);
            pg8::Gemm g{MB, (const bf16*)(wl + W_OUT), M, DM, DM}; pg8::StaticOrder S; S.init(M, DM, F.G, bid);
            pg8::EpiRes E{l == 0 ? F.a->in[0] : (const float*)F.a->out, F.a->out, XB, SSQ};
            pg8::gemm_phase<pg8::EpiRes, pg8::StaticOrder, false, true>(F.lds, g, S, E);
        }
#ifdef DBL_G3
        {   MKFRAME(); unsigned char* wl = WL(l);
            pg8::Gemm g{MB, (const bf16*)(wl + W_OUT), M, DM, DM}; pg8::StaticOrder S; S.init(M, DM, F.G, bid);
            pg8::EpiRes E{F.a->in[0], (float*)(ws + 0), (bf16*)(ws + 64 * MiB), (float*)(ws + 96 * MiB)};
            pg8::gemm_phase<pg8::EpiRes, pg8::StaticOrder, false, true>(F.lds, g, S, E);
        }
#endif
#endif
        GRID_BARRIER();
        STAMP(7 + 8 * l);
#ifndef NO_G4
#ifdef DBL_G4
        for (int rep_ = 0; rep_ < 2; ++rep_)
#endif
        {
            MKFRAME(); unsigned char* wl = WL(l);
            pg8::Gemm g{XB, (const bf16*)(wl + W_UP), M, DFF, DM}; pg8::StaticOrder S; S.init(M, DFF, F.G, bid);
            pg8::EpiG4 E{HM, SSQ};
            pg8::gemm_phase<pg8::EpiG4, pg8::StaticOrder, true, true>(F.lds, g, S, E);
        }
#endif
        GRID_BARRIER();
        STAMP(8 + 8 * l);
#ifndef NO_G5
        {
            MKFRAME(); unsigned char* wl = WL(l);
            pg8::Gemm g{HM, (const bf16*)(wl + W_DN), M, DM, DFF}; pg8::StaticOrder S; S.init(M, DM, F.G, bid);
            pg8::EpiRes E{(const float*)F.a->out, F.a->out, XB, SSQ};
            pg8::gemm_phase<pg8::EpiRes, pg8::StaticOrder, false, true>(F.lds, g, S, E);
        }
#ifdef DBL_G5
        {   MKFRAME(); unsigned char* wl = WL(l);
            pg8::Gemm g{HM, (const bf16*)(wl + W_DN), M, DM, DFF}; pg8::StaticOrder S; S.init(M, DM, F.G, bid);
            pg8::EpiNull E{};
            pg8::gemm_phase<pg8::EpiNull, pg8::StaticOrder, false, true>(F.lds, g, S, E);
        }
#endif
#endif
#ifdef PROBE_T
        GRID_BARRIER();
        STAMP(9 + 8 * l);
#else
        if (l + 1 < DEPTH) GRID_BARRIER();
#endif
#ifdef DBL_BAR
        for (int rep_ = 0; rep_ < 16; ++rep_) GRID_BARRIER();
#endif
    }
#ifdef PROBE_T
    {
        GRID_BARRIER();
        const unsigned long long* st = (const unsigned long long*)(args.ws + WS_CTL + 96 * 1024);
        float tus;
        if (PROBE_T == 0) tus = (float)(st[1] - st[0]) * 0.01f;
        else tus = 0.5f * ((float)(st[PROBE_T + 1] - st[PROBE_T]) + (float)(st[PROBE_T + 9] - st[PROBE_T + 8])) * 0.01f;
        const float sc = 1.0f + tus * 0.001f;
        float* o = args.out;
        for (size_t i = (size_t)blockIdx.x * 512 + threadIdx.x; i < (size_t)M * DM; i += (size_t)gridDim.x * 512) o[i] *= sc;
    }
#endif
}

extern "C" void kernel_launch(void* const* d_in, const int* in_sizes, int n_in, void* d_out, int out_size, void* d_ws, size_t ws_size, hipStream_t stream) {
    static int grid = 0;
    if (grid == 0) {
        if (n_in != 17 || out_size != M * DM || ws_size < WS_END) { fprintf(stderr, "kernel_launch: unexpected problem shape (n_in %d out %d ws %zu)\n", n_in, out_size, ws_size); grid = -1; return; }
        int dev = 0, cus = 0, per_cu = 0;
        if (hipGetDevice(&dev) != hipSuccess || hipDeviceGetAttribute(&cus, hipDeviceAttributeMultiprocessorCount, dev) != hipSuccess) { grid = -1; return; }
        if (hipFuncSetAttribute((const void*)mk_fwd, hipFuncAttributeMaxDynamicSharedMemorySize, LDS_BYTES) != hipSuccess) { fprintf(stderr, "kernel_launch: hipFuncSetAttribute failed\n"); grid = -1; return; }
        if (hipOccupancyMaxActiveBlocksPerMultiprocessor(&per_cu, (const void*)mk_fwd, NWAVES * 64, LDS_BYTES) != hipSuccess || per_cu < 1) { fprintf(stderr, "kernel_launch: occupancy query says %d blocks/CU\n", per_cu); }
        (void)hipGetLastError();
        if (cus != 256) { fprintf(stderr, "kernel_launch: built for a 256-CU device (one 256x256 GEMM unit per workgroup in the N=1024 phases), found %d CUs\n", cus); grid = -1; return; }
        grid = cus;
    }
    if (grid < 0) return;
    (void)hipMemsetAsync((char*)d_ws + WS_CTL, 0, CTL_BYTES, stream);
    Args a{};
    for (int i = 0; i < 17; ++i) a.in[i] = (const float*)d_in[i];
    a.out = (float*)d_out; a.ws = (unsigned char*)d_ws;
    hipLaunchKernelGGL(mk_fwd, dim3(grid), dim3(NWAVES * 64), LDS_BYTES, stream, a);
}
```

```cpp
#include <hip/hip_runtime.h>
#include <cstdio>
#include <cstdint>

namespace pg8 {
#define PG8_LAS __attribute__((address_space(3)))
typedef unsigned short bf16_t;
typedef short bf16x8 __attribute__((ext_vector_type(8)));
typedef float f32x4 __attribute__((ext_vector_type(4)));
typedef unsigned u32x4 __attribute__((ext_vector_type(4)));
constexpr int BM = 256, BK = 64, HALF = 128, HTB = HALF * BK * 2  , STAGE_BYTES = 8 * HTB, NXCD = 8, WGM = 8;

__host__ __device__ __forceinline__ int lds_byte(int r, int c) { const int st = (r >> 4) * 2 + (c >> 5), rr = r & 15, cc = c & 31, ob = rr * 64 + cc * 2; return st * 1024 + (ob ^ (((ob >> 9) & 1) << 5)); }
__host__ __device__ __forceinline__ void stage_rc(int b, int& R, int& C) { const int st = b / 1024, sb = b % 1024, swz = sb ^ (((sb >> 9) & 1) << 5); R = (st >> 1) * 16 + swz / 64; C = (st & 1) * 32 + (swz % 64) / 2; }
__host__ __device__ __forceinline__ int perm32(int rho) { const int n = rho >> 4, i = rho & 15; return 8 * (i >> 2) + 4 * n + (i & 3); }

struct Unit { int pm, pn; };
struct Gemm { const bf16_t* A; const bf16_t* Bt; int M, N, K; };

struct StaticOrder {
    int nM, nN, nwg, G, c;
    __host__ __device__ void init(int M, int N, int G_, int c_) { nM = M / BM; nN = N / BM; nwg = nM * nN; G = G_; c = c_; }
    __host__ __device__ bool next(int i, Unit& u) const {
        const long L = (long)i * G + c; if (L >= nwg) return false;
        int wgid = (int)L; { const int q = nwg / NXCD, r = nwg % NXCD, xcd = wgid % NXCD, off = wgid / NXCD; wgid = (xcd < r ? xcd * (q + 1) : r * (q + 1) + (xcd - r) * q) + off; }
        const int nig = WGM * nN, gid = wgid / nig, fm = gid * WGM, gsz = (nM - fm) < WGM ? (nM - fm) : WGM;
        u.pm = fm + ((wgid % nig) % gsz); u.pn = (wgid % nig) / gsz; return true;
    }
    __device__ __forceinline__ void a_ready(const Unit&) const {}
    __device__ __forceinline__ void done(const Unit&) const {}
};

__device__ __forceinline__ unsigned cvt_pk_bf16(float lo, float hi) { unsigned r; asm volatile("v_cvt_pk_bf16_f32 %0, %1, %2" : "=v"(r) : "v"(lo), "v"(hi)); return r; }
template <class Epi, class Sched, bool ALIGN_EPI = false, bool SP2 = false>
__device__ __forceinline__ void gemm_phase(PG8_LAS unsigned char* lds, const Gemm g, const Sched& S, const Epi& E) {
    int tid_l = threadIdx.x; asm volatile("" : "+v"(tid_l));
    const int tid = tid_l, wid = __builtin_amdgcn_readfirstlane(tid >> 6), lane = tid & 63, wr = wid >> 2, wc = wid & 3, fr = lane & 15, fq = lane >> 4;
    const int K = g.K, nt = K / BK;
    unsigned voffA[2], voffB[2];
#pragma unroll
    for (int i = 0; i < 2; ++i) { int R, C; stage_rc(tid * 16 + i * 8192, R, C); const int Rb = Epi::PERM ? ((R & ~31) + perm32(R & 31)) : R;
        voffA[i] = (unsigned)(R * K + C) * 2u; voffB[i] = (unsigned)(Rb * K + C) * 2u; }
    const size_t kstep = (size_t)(BK * 2);
    const size_t hstep = (size_t)HALF * K * 2;
    const size_t tstep = 2 * hstep;
    const unsigned ldsw = (unsigned)wid * 1024u;
    const int aoff = lds_byte(wr * 64 + fr, fq * 8), boff = lds_byte(wc * 32 + fr, fq * 8);
#define PG8_SA(b, h) (((b) * 2 + (h)) * HTB)
#define PG8_SB(b, h) ((4 + (b) * 2 + (h)) * HTB)
#define PG8_STAGE(bufoff, gbase, voff) do { _Pragma("unroll") for (int _i = 0; _i < 2; ++_i) \
        __builtin_amdgcn_global_load_lds((const unsigned*)((const char*)(gbase) + (voff)[_i]), (PG8_LAS unsigned*)(lds + (bufoff) + ldsw + _i * 8192), 16, 0, 0); } while (0)
#define PG8_LDA(dst, b, h) do { _Pragma("unroll") for (int m = 0; m < 4; ++m) _Pragma("unroll") for (int k = 0; k < 2; ++k) dst[m][k] = *(const PG8_LAS bf16x8*)(lds + PG8_SA(b, h) + aoff + m * 2048 + k * 1024); } while (0)
#define PG8_LDB(dst, b, h) do { _Pragma("unroll") for (int n = 0; n < 2; ++n) _Pragma("unroll") for (int k = 0; k < 2; ++k) dst[n][k] = *(const PG8_LAS bf16x8*)(lds + PG8_SB(b, h) + boff + n * 2048 + k * 1024); } while (0)
#define PG8_MMA(ai, bj, At, Bt) do { __builtin_amdgcn_s_setprio(1); _Pragma("unroll") for (int m = 0; m < 4; ++m) _Pragma("unroll") for (int n = 0; n < 2; ++n) _Pragma("unroll") for (int k = 0; k < 2; ++k) \
        acc[ai][bj][m][n] = __builtin_amdgcn_mfma_f32_16x16x32_bf16(Bt[n][k], At[m][k], acc[ai][bj][m][n], 0, 0, 0); __builtin_amdgcn_s_setprio(0); } while (0)
#define PG8_WAIT_V(n) asm volatile("s_waitcnt vmcnt(" #n ")" ::: "memory")
#define PG8_WAIT_L(n) asm volatile("s_waitcnt lgkmcnt(" #n ")" ::: "memory")
#define PG8_BAR __builtin_amdgcn_s_barrier()
#define PG8_SCHED __builtin_amdgcn_sched_barrier(0)
    Unit cur, nxt; int ui = 0;
    if (!S.next(0, cur)) return;
    f32x4 acc[2][2][4][2];
#pragma unroll
    for (int a = 0; a < 2; ++a)
#pragma unroll
        for (int b = 0; b < 2; ++b)
#pragma unroll
            for (int m = 0; m < 4; ++m)
#pragma unroll
                for (int n = 0; n < 2; ++n) acc[a][b][m][n] = (f32x4){0.f, 0.f, 0.f, 0.f};
    bf16x8 At[4][2], B0[2][2], B1[2][2];
    const char* cA = (const char*)g.A + (size_t)cur.pm * tstep; const char* cB = (const char*)g.Bt + (size_t)cur.pn * tstep;
    S.a_ready(cur);
    if constexpr (SP2) {
        PG8_STAGE(PG8_SB(0, 0), cB, voffB); PG8_STAGE(PG8_SB(0, 1), cB + hstep, voffB); PG8_STAGE(PG8_SA(0, 0), cA, voffA); PG8_STAGE(PG8_SA(0, 1), cA + hstep, voffA);
        if (wr == 1) PG8_BAR;
        PG8_WAIT_V(2); PG8_BAR;
        PG8_STAGE(PG8_SB(1, 0), cB + kstep, voffB); PG8_STAGE(PG8_SA(1, 0), cA + kstep, voffA); PG8_STAGE(PG8_SB(1, 1), cB + hstep + kstep, voffB);
        PG8_WAIT_V(6); PG8_BAR;
    } else {
        PG8_STAGE(PG8_SB(0, 0), cB, voffB); PG8_STAGE(PG8_SA(0, 0), cA, voffA); PG8_STAGE(PG8_SB(0, 1), cB + hstep, voffB); PG8_STAGE(PG8_SA(0, 1), cA + hstep, voffA);
        if (wr == 1) PG8_BAR;
        PG8_WAIT_V(4); PG8_BAR;
        PG8_STAGE(PG8_SB(1, 0), cB + kstep, voffB); PG8_STAGE(PG8_SA(1, 0), cA + kstep, voffA); PG8_STAGE(PG8_SB(1, 1), cB + hstep + kstep, voffB);
        PG8_WAIT_V(6); PG8_BAR;
    }
    for (;;) {
        const bool has_next = S.next(ui + 1, nxt);
        const char* nA = has_next ? (const char*)g.A + (size_t)nxt.pm * tstep : cA; const char* nB = has_next ? (const char*)g.Bt + (size_t)nxt.pn * tstep : cB;
        for (int t = 0; t < nt; t += 2) {
            const bool last = (t == nt - 2);
            const char* a1 = cA + (size_t)(t + 1) * kstep;
            const char* a2 = last ? nA : cA + (size_t)(t + 2) * kstep; const char* b2 = last ? nB : cB + (size_t)(t + 2) * kstep;
            const char* a3 = a2 + kstep; const char* b3 = b2 + kstep;
            if (last && has_next) S.a_ready(nxt);
            if constexpr (SP2) {
            PG8_LDB(B0, 0, 0); PG8_LDB(B1, 0, 1); PG8_SCHED; PG8_LDA(At, 0, 0); PG8_STAGE(PG8_SA(1, 1), a1 + hstep, voffA);
            PG8_WAIT_V(8); PG8_WAIT_L(0); PG8_BAR; PG8_MMA(0, 0, At, B0); PG8_MMA(0, 1, At, B1); PG8_BAR; PG8_SCHED;
            PG8_LDA(At, 0, 1); PG8_STAGE(PG8_SB(0, 0), b2, voffB); PG8_STAGE(PG8_SB(0, 1), b2 + hstep, voffB); PG8_STAGE(PG8_SA(0, 0), a2, voffA);
            PG8_WAIT_V(8); PG8_WAIT_L(0); PG8_BAR; PG8_MMA(1, 0, At, B0); PG8_MMA(1, 1, At, B1); PG8_BAR; PG8_SCHED;
            PG8_LDB(B0, 1, 0); PG8_LDB(B1, 1, 1); PG8_SCHED; PG8_LDA(At, 1, 0); PG8_STAGE(PG8_SA(0, 1), a2 + hstep, voffA);
            PG8_WAIT_V(8); PG8_WAIT_L(0); PG8_BAR; PG8_MMA(0, 0, At, B0); PG8_MMA(0, 1, At, B1); PG8_BAR; PG8_SCHED;
            PG8_LDA(At, 1, 1); PG8_STAGE(PG8_SB(1, 0), b3, voffB); PG8_STAGE(PG8_SB(1, 1), b3 + hstep, voffB); PG8_STAGE(PG8_SA(1, 0), a3, voffA);
            PG8_WAIT_V(8); PG8_WAIT_L(0); PG8_BAR; PG8_MMA(1, 0, At, B0); PG8_MMA(1, 1, At, B1); PG8_BAR; PG8_SCHED;
            } else {
            PG8_LDB(B0, 0, 0); PG8_SCHED; PG8_LDA(At, 0, 0); PG8_STAGE(PG8_SA(1, 1), a1 + hstep, voffA);
            PG8_WAIT_L(8); PG8_BAR; PG8_WAIT_L(0); PG8_MMA(0, 0, At, B0); PG8_BAR; PG8_SCHED;
            PG8_LDB(B1, 0, 1); PG8_STAGE(PG8_SB(0, 0), b2, voffB);
            PG8_BAR; PG8_WAIT_L(0); PG8_MMA(0, 1, At, B1); PG8_BAR;
            PG8_LDA(At, 0, 1); PG8_STAGE(PG8_SA(0, 0), a2, voffA);
            PG8_BAR; PG8_WAIT_L(0); PG8_MMA(1, 0, At, B0); PG8_BAR; PG8_SCHED;
            PG8_STAGE(PG8_SB(0, 1), b2 + hstep, voffB);
            PG8_WAIT_V(6); PG8_BAR; PG8_MMA(1, 1, At, B1); PG8_BAR;
            PG8_LDB(B0, 1, 0); PG8_SCHED; PG8_LDA(At, 1, 0); PG8_STAGE(PG8_SA(0, 1), a2 + hstep, voffA);
            PG8_WAIT_L(8); PG8_BAR; PG8_WAIT_L(0); PG8_MMA(0, 0, At, B0); PG8_BAR; PG8_SCHED;
            PG8_LDB(B1, 1, 1); PG8_STAGE(PG8_SB(1, 0), b3, voffB);
            PG8_BAR; PG8_WAIT_L(0); PG8_MMA(0, 1, At, B1); PG8_BAR;
            PG8_LDA(At, 1, 1); PG8_STAGE(PG8_SA(1, 0), a3, voffA);
            PG8_BAR; PG8_WAIT_L(0); PG8_MMA(1, 0, At, B0); PG8_BAR; PG8_SCHED;
            PG8_STAGE(PG8_SB(1, 1), b3 + hstep, voffB);
            PG8_WAIT_V(6); PG8_BAR; PG8_MMA(1, 1, At, B1); PG8_BAR;
            }
        }
        if constexpr (ALIGN_EPI) { if (wr == 0) PG8_BAR; }
        if constexpr (!Epi::AFTER_DRAIN) { E(acc, cur, wr, wc, fr, fq); S.done(cur); }
        if (!has_next) break;
#pragma unroll
        for (int a = 0; a < 2; ++a)
#pragma unroll
            for (int b = 0; b < 2; ++b)
#pragma unroll
                for (int m = 0; m < 4; ++m)
#pragma unroll
                    for (int n = 0; n < 2; ++n) acc[a][b][m][n] = (f32x4){0.f, 0.f, 0.f, 0.f};
        cur = nxt; cA = nA; cB = nB; ++ui;
        if constexpr (ALIGN_EPI) { if (wr == 1) PG8_BAR; }
    }
    PG8_WAIT_V(0);
    if constexpr (!ALIGN_EPI) { if (wr == 0) PG8_BAR; }
    PG8_BAR;
    if constexpr (Epi::AFTER_DRAIN) { E.fused(acc, cur, wr, wc, fr, fq, lds, wid, lane); S.done(cur); }
#undef PG8_SA
#undef PG8_SB
#undef PG8_STAGE
#undef PG8_LDA
#undef PG8_LDB
#undef PG8_MMA
#undef PG8_WAIT_V
#undef PG8_WAIT_L
#undef PG8_BAR
#undef PG8_SCHED
}
}

namespace pg8 {
#define PG8_GAS __attribute__((address_space(1)))
constexpr int MROWS = 16384;
__device__ __forceinline__ unsigned pk_bf16(float lo, float hi) { typedef float f2 __attribute__((ext_vector_type(2))); typedef __bf16 b2 __attribute__((ext_vector_type(2)));
    f2 v = {lo, hi}; b2 b = __builtin_convertvector(v, b2); return __builtin_bit_cast(unsigned, b); }
__device__ __forceinline__ float bf_lo(unsigned w) { return __uint_as_float(w << 16); }
__device__ __forceinline__ float bf_hi(unsigned w) { return __uint_as_float(w & 0xffff0000u); }
__device__ __forceinline__ float row_rstd(const float* ssq, int row) {
    const PG8_GAS f32x4* p = (const PG8_GAS f32x4*)(ssq + (size_t)row * 16);
    const f32x4 a = p[0], b = p[1], c = p[2], d = p[3];
    const float s = (((a[0] + a[1]) + (a[2] + a[3])) + ((b[0] + b[1]) + (b[2] + b[3]))) + (((c[0] + c[1]) + (c[2] + c[3])) + ((d[0] + d[1]) + (d[2] + d[3])));
    return rsqrtf(s * (1.0f / 1024.0f) + 1e-6f);
}
__device__ __forceinline__ float sigmoidf_(float x) { return __builtin_amdgcn_rcpf(1.0f + __builtin_amdgcn_exp2f(-1.4426950408889634f * x)); }

__device__ __forceinline__ void wave_rstd(const float* ssq, int rowbase, int lane, float (&v)[2]) {
    const PG8_GAS f32x4* p0 = (const PG8_GAS f32x4*)(ssq + (size_t)(rowbase + lane) * 16);
    const PG8_GAS f32x4* p1 = p0 + HALF * 4;
    const f32x4 a = p0[0], b = p0[1], c = p0[2], d = p0[3], e = p1[0], f = p1[1], g = p1[2], h = p1[3];
    const float s0 = (((a[0] + a[1]) + (a[2] + a[3])) + ((b[0] + b[1]) + (b[2] + b[3]))) + (((c[0] + c[1]) + (c[2] + c[3])) + ((d[0] + d[1]) + (d[2] + d[3])));
    const float s1 = (((e[0] + e[1]) + (e[2] + e[3])) + ((f[0] + f[1]) + (f[2] + f[3]))) + (((g[0] + g[1]) + (g[2] + g[3])) + ((h[0] + h[1]) + (h[2] + h[3])));
    v[0] = rsqrtf(s0 * (1.0f / 1024.0f) + 1e-6f); v[1] = rsqrtf(s1 * (1.0f / 1024.0f) + 1e-6f);
}

struct EpiG1 {
    static constexpr bool PERM = true, AFTER_DRAIN = false;
    bf16_t* zq; bf16_t* zkv; const float* ssq;
    __device__ __forceinline__ void operator()(const f32x4 (&acc)[2][2][4][2], const Unit& u, int wr, int wc, int fr, int fq) const {
        const int row0 = u.pm * BM + wr * 64 + fr;
        bf16_t* base; int ldc, colt;
        if (u.pn < 6) { base = zq + (size_t)(u.pn >> 1) * ((size_t)MROWS * 512); ldc = 512; colt = (u.pn & 1) * 256; }
        else { base = zkv + (size_t)(u.pn - 6) * ((size_t)MROWS * 256); ldc = 256; colt = 0; }
        const int col0 = colt + wc * 32 + 8 * fq;
        float rv[2]; wave_rstd(ssq, u.pm * BM + wr * 64, fq * 16 + fr, rv);
#pragma unroll
        for (int ai = 0; ai < 2; ++ai)
#pragma unroll
            for (int m = 0; m < 4; ++m) { const int row = row0 + ai * HALF + m * 16; const float rs = __shfl(rv[ai], m * 16 + fr); bf16_t* rowp = base + (size_t)row * ldc + col0;
#pragma unroll
                for (int bj = 0; bj < 2; ++bj) { const f32x4 v0 = acc[ai][bj][m][0] * rs, v1 = acc[ai][bj][m][1] * rs;
                    u32x4 w; w.x = pk_bf16(v0[0], v0[1]); w.y = pk_bf16(v0[2], v0[3]); w.z = pk_bf16(v1[0], v1[1]); w.w = pk_bf16(v1[2], v1[3]);
                    *(PG8_GAS u32x4*)(rowp + bj * HALF) = w; } }
    }
};
struct EpiG4 {
    static constexpr bool PERM = true, AFTER_DRAIN = false;
    bf16_t* h; const float* ssq;
    __device__ __forceinline__ void operator()(const f32x4 (&acc)[2][2][4][2], const Unit& u, int wr, int wc, int fr, int fq) const {
        const int row0 = u.pm * BM + wr * 64 + fr; const int col0 = u.pn * BM + wc * 32 + 8 * fq;
        float rv[2]; wave_rstd(ssq, u.pm * BM + wr * 64, fq * 16 + fr, rv);
#pragma unroll
        for (int ai = 0; ai < 2; ++ai)
#pragma unroll
            for (int m = 0; m < 4; ++m) { const int row = row0 + ai * HALF + m * 16; const float rs = __shfl(rv[ai], m * 16 + fr); bf16_t* rowp = h + (size_t)row * 4096 + col0;
#pragma unroll
                for (int bj = 0; bj < 2; ++bj) { f32x4 v0 = acc[ai][bj][m][0] * rs, v1 = acc[ai][bj][m][1] * rs;
#pragma unroll
                    for (int e = 0; e < 4; ++e) { v0[e] = fmaxf(v0[e], 0.f); v0[e] *= v0[e]; v1[e] = fmaxf(v1[e], 0.f); v1[e] *= v1[e]; }
                    u32x4 w; w.x = pk_bf16(v0[0], v0[1]); w.y = pk_bf16(v0[2], v0[3]); w.z = pk_bf16(v1[0], v1[1]); w.w = pk_bf16(v1[2], v1[3]);
                    *(PG8_GAS u32x4*)(rowp + bj * HALF) = w; } }
    }
};
struct EpiRes {
    static constexpr bool PERM = true, AFTER_DRAIN = false;
    const float* xold; float* xout; bf16_t* xb; float* ssq;
    __device__ __forceinline__ void operator()(const f32x4 (&acc)[2][2][4][2], const Unit& u, int wr, int wc, int fr, int fq) const {
        const int row0 = u.pm * BM + wr * 64 + fr; const int col0 = u.pn * BM + wc * 32 + 8 * fq;
#pragma unroll
        for (int ai = 0; ai < 2; ++ai) {
            f32x4 xo[4][2][2];
#pragma unroll
            for (int m = 0; m < 4; ++m)
#pragma unroll
                for (int bj = 0; bj < 2; ++bj) { const size_t off = (size_t)(row0 + ai * HALF + m * 16) * 1024 + col0 + bj * HALF;
                    xo[m][bj][0] = *(const PG8_GAS f32x4*)(xold + off); xo[m][bj][1] = *(const PG8_GAS f32x4*)(xold + off + 4); }
#pragma unroll
            for (int m = 0; m < 4; ++m) { const int row = row0 + ai * HALF + m * 16; float part = 0.f;
#pragma unroll
                for (int bj = 0; bj < 2; ++bj) { const size_t off = (size_t)row * 1024 + col0 + bj * HALF;
                    const f32x4 v0 = acc[ai][bj][m][0] + xo[m][bj][0], v1 = acc[ai][bj][m][1] + xo[m][bj][1];
                    *(PG8_GAS f32x4*)(xout + off) = v0; *(PG8_GAS f32x4*)(xout + off + 4) = v1;
                    u32x4 w; w.x = pk_bf16(v0[0], v0[1]); w.y = pk_bf16(v0[2], v0[3]); w.z = pk_bf16(v1[0], v1[1]); w.w = pk_bf16(v1[2], v1[3]);
                    *(PG8_GAS u32x4*)(xb + off) = w;
                    part += ((v0[0] * v0[0] + v0[1] * v0[1]) + (v0[2] * v0[2] + v0[3] * v0[3])) + ((v1[0] * v1[0] + v1[1] * v1[1]) + (v1[2] * v1[2] + v1[3] * v1[3])); }
                part += __shfl_xor(part, 16); part += __shfl_xor(part, 32);
                if (fq == 0) ((PG8_GAS float*)ssq)[(size_t)row * 16 + u.pn * 4 + wc] = part; }
            asm volatile("" ::: "memory"); }
    }
};
struct EpiStash {
    static constexpr bool PERM = true, AFTER_DRAIN = true;
    __device__ __forceinline__ void fused(f32x4 (&acc)[2][2][4][2], const Unit& u, int wr, int wc, int fr, int fq, PG8_LAS unsigned char*, int, int) const { (*this)(acc, u, wr, wc, fr, fq); }
    bf16_t* ys;
    __device__ __forceinline__ void operator()(const f32x4 (&acc)[2][2][4][2], const Unit& u, int wr, int wc, int fr, int fq) const {
        bf16_t* base = ys + (size_t)(u.pm * 4 + u.pn) * 65536; const int row0 = wr * 64 + fr, col0 = wc * 32 + 8 * fq;
#pragma unroll
        for (int ai = 0; ai < 2; ++ai)
#pragma unroll
            for (int m = 0; m < 4; ++m) { bf16_t* rowp = base + (row0 + ai * HALF + m * 16) * 256 + col0;
#pragma unroll
                for (int bj = 0; bj < 2; ++bj) { const f32x4 v0 = acc[ai][bj][m][0], v1 = acc[ai][bj][m][1];
                    u32x4 w; w.x = pk_bf16(v0[0], v0[1]); w.y = pk_bf16(v0[2], v0[3]); w.z = pk_bf16(v1[0], v1[1]); w.w = pk_bf16(v1[2], v1[3]);
                    *(PG8_GAS u32x4*)(rowp + bj * HALF) = w; } }
    }
};
struct EpiGate {
    static constexpr bool PERM = true, AFTER_DRAIN = true;
    __device__ __forceinline__ void fused(f32x4 (&acc)[2][2][4][2], const Unit& u, int wr, int wc, int fr, int fq, PG8_LAS unsigned char*, int, int) const { (*this)(acc, u, wr, wc, fr, fq); }
    const bf16_t* ys; bf16_t* mb; const float* ssq; int first;
    __device__ __forceinline__ void operator()(const f32x4 (&acc)[2][2][4][2], const Unit& u, int wr, int wc, int fr, int fq) const {
        const bf16_t* sbase = ys + (size_t)(u.pm * 4 + u.pn) * 65536; const int lrow0 = wr * 64 + fr, lcol0 = wc * 32 + 8 * fq;
        float rv[2]; wave_rstd(ssq, u.pm * BM + wr * 64, fq * 16 + fr, rv);
        const bool fst = first != 0;
#pragma unroll
        for (int ai = 0; ai < 2; ++ai) {
            u32x4 yv[4][2], pv[4][2];
#pragma unroll
            for (int m = 0; m < 4; ++m)
#pragma unroll
                for (int bj = 0; bj < 2; ++bj) { const int lrow = lrow0 + ai * HALF + m * 16;
                    yv[m][bj] = *(const PG8_GAS u32x4*)(sbase + lrow * 256 + lcol0 + bj * HALF);
                    pv[m][bj] = *(const PG8_GAS u32x4*)(mb + (size_t)(u.pm * BM + lrow) * 1024 + u.pn * BM + lcol0 + bj * HALF); }
#pragma unroll
            for (int m = 0; m < 4; ++m) { const int lrow = lrow0 + ai * HALF + m * 16, row = u.pm * BM + lrow; const float rs = __shfl(rv[ai], m * 16 + fr);
#pragma unroll
                for (int bj = 0; bj < 2; ++bj) { const f32x4 a0 = acc[ai][bj][m][0] * rs, a1 = acc[ai][bj][m][1] * rs;
                    const u32x4 y = yv[m][bj], p = pv[m][bj];
                    bf16_t* mp = mb + (size_t)row * 1024 + u.pn * BM + lcol0 + bj * HALF;
                    float r[8], q[8];
                    r[0] = sigmoidf_(a0[0]) * bf_lo(y.x); r[1] = sigmoidf_(a0[1]) * bf_hi(y.x); r[2] = sigmoidf_(a0[2]) * bf_lo(y.y); r[3] = sigmoidf_(a0[3]) * bf_hi(y.y);
                    r[4] = sigmoidf_(a1[0]) * bf_lo(y.z); r[5] = sigmoidf_(a1[1]) * bf_hi(y.z); r[6] = sigmoidf_(a1[2]) * bf_lo(y.w); r[7] = sigmoidf_(a1[3]) * bf_hi(y.w);
                    q[0] = bf_lo(p.x); q[1] = bf_hi(p.x); q[2] = bf_lo(p.y); q[3] = bf_hi(p.y); q[4] = bf_lo(p.z); q[5] = bf_hi(p.z); q[6] = bf_lo(p.w); q[7] = bf_hi(p.w);
#pragma unroll
                    for (int e = 0; e < 8; ++e) r[e] = fst ? r[e] : r[e] + q[e];
                    u32x4 w; w.x = pk_bf16(r[0], r[1]); w.y = pk_bf16(r[2], r[3]); w.z = pk_bf16(r[4], r[5]); w.w = pk_bf16(r[6], r[7]);
                    *(PG8_GAS u32x4*)mp = w; } }
            asm volatile("" ::: "memory"); }
    }
};
struct EpiNull {
    static constexpr bool PERM = true, AFTER_DRAIN = false;
    __device__ __forceinline__ void operator()(const f32x4 (&acc)[2][2][4][2], const Unit& u, int wr, int wc, int fr, int fq) const {
#pragma unroll
        for (int ai = 0; ai < 2; ++ai)
#pragma unroll
            for (int bj = 0; bj < 2; ++bj)
#pragma unroll
                for (int m = 0; m < 4; ++m) { asm volatile("" :: "v"(acc[ai][bj][m][0]), "v"(acc[ai][bj][m][1])); }
    }
};
}

#define GAS __attribute__((address_space(1)))
#define LAS __attribute__((address_space(3)))
typedef unsigned short bf16;
typedef unsigned v4u __attribute__((ext_vector_type(4)));
typedef float f32x4 __attribute__((ext_vector_type(4)));
typedef short bf16x8 __attribute__((ext_vector_type(8)));
typedef GAS unsigned gu32;
typedef GAS unsigned long long gu64;
#define RLX_AGENT __ATOMIC_RELAXED, __HIP_MEMORY_SCOPE_AGENT
#define LDS_WAIT() asm volatile("s_waitcnt lgkmcnt(0)" ::: "memory")
#define VM_WAIT() asm volatile("s_waitcnt vmcnt(0)" ::: "memory")
__device__ __forceinline__ unsigned long long rt() { return __builtin_amdgcn_s_memrealtime(); }
__device__ __forceinline__ unsigned f2bf(float f) { unsigned u = __builtin_bit_cast(unsigned, f); return (u + 0x7fffu + ((u >> 16) & 1u)) >> 16; }
__device__ __forceinline__ unsigned pk2(float lo, float hi) { return f2bf(lo) | (f2bf(hi) << 16); }

#define XB_TMO      128
#define XB_XCNT(j)  (256  + 64 * (j))
#define XB_XSUB(j)  (1280 + 64 * (j))
#define XB_XGEN(j)  (2304 + 64 * (j))
#define XB_TOP      3328
#define XB_TOPGEN   3392
#define XCD_BAR_WORDS 3456
#define XB_SPIN_CAP (1u << 18)

__device__ __forceinline__ unsigned xb_ld(unsigned* p)              { return __hip_atomic_load(p, __ATOMIC_RELAXED, __HIP_MEMORY_SCOPE_AGENT); }
__device__ __forceinline__ unsigned xb_add(unsigned* p, unsigned v) { return __hip_atomic_fetch_add(p, v, __ATOMIC_RELAXED, __HIP_MEMORY_SCOPE_AGENT); }
__device__ __forceinline__ unsigned xb_xcc_id() { return (unsigned)__builtin_amdgcn_s_getreg((3 << 11) | 20) & 0xFu; }
#define XB_SPIN(cond, bar) do { unsigned _sp = 0; while (cond) { __builtin_amdgcn_s_sleep(1); \
    if ((++_sp & 255u) == 0u) { if (xb_ld(&(bar)[XB_TMO])) break; if (_sp > XB_SPIN_CAP) { atomicAdd(&(bar)[XB_TMO], 1u); break; } } } } while (0)

struct XcdBarrier {
    unsigned* bar; unsigned x;
    volatile LAS unsigned* st;
};

__device__ __forceinline__ XcdBarrier xcd_barrier_post(unsigned* bar, volatile LAS unsigned* st) {
    XcdBarrier b; b.bar = bar; b.x = xb_xcc_id(); b.st = st;
    if (threadIdx.x == 0) (void)xb_add(&bar[XB_XCNT(b.x)], 1u);
    return b;
}
__device__ __forceinline__ void xcd_barrier_complete(unsigned* bar, unsigned x, unsigned& nloc, unsigned& nx) {
    const unsigned G = gridDim.x * gridDim.y * gridDim.z;
    unsigned sum, cnt, mine, sp = 0u;
    for (;;) {
        sum = 0u; cnt = 0u; mine = 0u;
#pragma unroll
        for (unsigned j = 0; j < 16; ++j) { const unsigned c = xb_ld(&bar[XB_XCNT(j)]); sum += c; cnt += (c > 0u) ? 1u : 0u; mine = (j == x) ? c : mine; }
        if (sum == G) break;
        __builtin_amdgcn_s_sleep(1);
        if ((++sp & 255u) == 0u) { if (xb_ld(&bar[XB_TMO])) break; if (sp > XB_SPIN_CAP) { atomicAdd(&bar[XB_TMO], 1u); break; } }
    }
    nloc = mine > 0u ? mine : 1u; nx = cnt > 0u ? cnt : 1u;
}

__device__ __forceinline__ void xcd_barrier(const XcdBarrier& b) {
    asm volatile("s_waitcnt vmcnt(0)" ::: "memory");
    __syncthreads();
    if (threadIdx.x == 0) {
        unsigned* bar = b.bar;
        __builtin_amdgcn_s_waitcnt(0);
        unsigned nloc = b.st[0], nx = b.st[1];
        if (nloc == 0u) { xcd_barrier_complete(bar, b.x, nloc, nx); b.st[0] = nloc; b.st[1] = nx; }
        const unsigned old = xb_add(&bar[XB_XSUB(b.x)], 1u);
        const unsigned gen = old / nloc;
        if (old + 1u == (gen + 1u) * nloc) {
            __builtin_amdgcn_fence(__ATOMIC_RELEASE, "agent");
            asm volatile("s_waitcnt vmcnt(0)" ::: "memory");
            const unsigned og = xb_add(&bar[XB_TOP], 1u);
            const unsigned tg = og / nx;
            if (og + 1u == (tg + 1u) * nx) xb_add(&bar[XB_TOPGEN], 1u);
            else XB_SPIN(xb_ld(&bar[XB_TOPGEN]) == tg, bar);
            __builtin_amdgcn_fence(__ATOMIC_ACQUIRE, "agent");
            xb_add(&bar[XB_XGEN(b.x)], 1u);
            asm volatile("s_waitcnt vmcnt(0)" ::: "memory");
        } else {
            XB_SPIN(xb_ld(&bar[XB_XGEN(b.x)]) == gen, bar);
            __builtin_amdgcn_fence(__ATOMIC_ACQUIRE, "agent");
            asm volatile("s_waitcnt vmcnt(0)" ::: "memory");
        }
    }
    __syncthreads();
}

namespace att {
typedef short bf16x8 __attribute__((ext_vector_type(8)));
typedef short s16x4 __attribute__((ext_vector_type(4)));
typedef float f32x16 __attribute__((ext_vector_type(16)));
typedef unsigned u32x4 __attribute__((ext_vector_type(4)));
typedef unsigned short bf16_t;
typedef unsigned long long u64;
constexpr int NKB = 4, NVB = 5;
constexpr int WSF_W = 320;
constexpr int L_K0 = 0, L_V0 = NKB * 8320, L_IMP = L_V0  , L_WSF = L_V0 + NVB * 8192, L_SEL = L_WSF + 8 * WSF_W * 4, L_OST = L_SEL + 512  , L_END = L_OST + 65536;
__device__ __forceinline__ int crow(int r, int hi) { return (r & 3) + 8 * (r >> 2) + 4 * hi; }
__device__ __forceinline__ unsigned pk2(float lo, float hi) { typedef float f2 __attribute__((ext_vector_type(2))); typedef __bf16 b2 __attribute__((ext_vector_type(2)));
    f2 v = {lo, hi}; b2 b = __builtin_convertvector(v, b2); return __builtin_bit_cast(unsigned, b); }
__device__ __forceinline__ s16x4 vtr(LAS const char* p) { typedef short v4i16_t __attribute__((ext_vector_type(4))); return __builtin_bit_cast(s16x4, __builtin_amdgcn_ds_read_tr16_b64_v4i16((LAS v4i16_t*)p)); }

struct KVSrc { const GAS bf16_t* k; const GAS bf16_t* v; int pitch; int nrows; };

struct Lane { int tid, lane, r32, hi, wid; };

__device__ __forceinline__ void tile_gload(const KVSrc& S, int t, int tid, u32x4& kr, u32x4& vr) {
    const int row = 64 * t + (tid >> 3), ch = tid & 7;
    kr = *(const GAS u32x4*)(S.k + (size_t)row * S.pitch + ch * 8); vr = *(const GAS u32x4*)(S.v + (size_t)row * S.pitch + ch * 8);
}
__device__ __forceinline__ void tile_lstore(LAS char* kb, LAS char* vb, int tid, const u32x4& kr, const u32x4& vr) {
    const int key = tid >> 3, ch = tid & 7;
    *(LAS u32x4*)(kb + ch * 1040 + (key >> 5) * 512 + (key & 31) * 16) = kr;
    *(LAS u32x4*)(vb + (ch >> 2) * 4096 + (key >> 4) * 1024 + ((key >> 3) & 1) * 512 + (key & 7) * 64 + (ch & 3) * 16) = vr;
}
__device__ __forceinline__ void qk_tile(LAS const char* kbuf, const bf16x8 (&qr)[4], f32x16& p0, f32x16& p1, int r32, int hi) {
    LAS const char* kb = kbuf + hi * 1040 + r32 * 16;
#pragma unroll
    for (int d0 = 0; d0 < 4; ++d0) {
        const bf16x8 b0 = *(LAS const bf16x8*)(kb + d0 * 2080);
        const bf16x8 b1 = *(LAS const bf16x8*)(kb + d0 * 2080 + 512);
        p0 = __builtin_amdgcn_mfma_f32_32x32x16_bf16(b0, qr[d0], p0, 0, 0, 0);
        p1 = __builtin_amdgcn_mfma_f32_32x32x16_bf16(b1, qr[d0], p1, 0, 0, 0);
    }
}
__device__ __forceinline__ void qk_tile_c(LAS const char* kbuf, const bf16x8 (&qr)[4], const f32x16& negm, f32x16& p0, f32x16& p1, int r32, int hi) {
    const unsigned ka = (unsigned)(size_t)kbuf + hi * 1040 + r32 * 16;
    bf16x8 kf[8];
#pragma unroll
    for (int d0 = 0; d0 < 4; ++d0) {
        asm volatile("ds_read_b128 %0, %1 offset:%c2" : "=&v"(kf[2 * d0]) : "v"(ka), "i"(d0 * 2080) : "memory");
        asm volatile("ds_read_b128 %0, %1 offset:%c2" : "=&v"(kf[2 * d0 + 1]) : "v"(ka), "i"(d0 * 2080 + 512) : "memory");
    }
    asm volatile("s_waitcnt lgkmcnt(0)" : "+v"(kf[0]), "+v"(kf[1]), "+v"(kf[2]), "+v"(kf[3]), "+v"(kf[4]), "+v"(kf[5]), "+v"(kf[6]), "+v"(kf[7]) :: "memory");
    __builtin_amdgcn_sched_barrier(0);
    p0 = __builtin_amdgcn_mfma_f32_32x32x16_bf16(kf[0], qr[0], negm, 0, 0, 0); p1 = __builtin_amdgcn_mfma_f32_32x32x16_bf16(kf[1], qr[0], negm, 0, 0, 0);
#pragma unroll
    for (int d0 = 1; d0 < 4; ++d0) { p0 = __builtin_amdgcn_mfma_f32_32x32x16_bf16(kf[2 * d0], qr[d0], p0, 0, 0, 0); p1 = __builtin_amdgcn_mfma_f32_32x32x16_bf16(kf[2 * d0 + 1], qr[d0], p1, 0, 0, 0); }
}
__device__ __forceinline__ void pv_tile(LAS const char* vbuf, const u32x4 (&pw)[4], f32x16 (&o)[2], f32x16& ol, int lane, int hi) {
    const unsigned va = (unsigned)(size_t)vbuf + ((lane >> 4) & 1) * 32 + (lane & 3) * 8 + (4 * hi + ((lane & 15) >> 2)) * 64;
#pragma unroll
    for (int d0 = 0; d0 < 2; ++d0) {
        s16x4 lo[4], h2[4];
#pragma unroll
        for (int ks = 0; ks < 4; ++ks) {
            asm volatile("ds_read_b64_tr_b16 %0, %1 offset:%c2" : "=&v"(lo[ks]) : "v"(va), "i"(d0 * 4096 + ks * 1024) : "memory");
            asm volatile("ds_read_b64_tr_b16 %0, %1 offset:%c2" : "=&v"(h2[ks]) : "v"(va), "i"(d0 * 4096 + ks * 1024 + 512) : "memory");
        }
        asm volatile("s_waitcnt lgkmcnt(0)" : "+v"(lo[0]), "+v"(lo[1]), "+v"(lo[2]), "+v"(lo[3]), "+v"(h2[0]), "+v"(h2[1]), "+v"(h2[2]), "+v"(h2[3]) :: "memory");
        __builtin_amdgcn_sched_barrier(0);
#pragma unroll
        for (int ks = 0; ks < 4; ++ks) {
            const bf16x8 vf = (bf16x8){lo[ks][0], lo[ks][1], lo[ks][2], lo[ks][3], h2[ks][0], h2[ks][1], h2[ks][2], h2[ks][3]};
            o[d0] = __builtin_amdgcn_mfma_f32_32x32x16_bf16(__builtin_bit_cast(bf16x8, pw[ks]), vf, o[d0], 0, 0, 0);
        }
        if (d0 == 0) {
            const bf16x8 ones = (bf16x8){0x3f80, 0x3f80, 0x3f80, 0x3f80, 0x3f80, 0x3f80, 0x3f80, 0x3f80};
#pragma unroll
            for (int ks = 0; ks < 4; ++ks) ol = __builtin_amdgcn_mfma_f32_32x32x16_bf16(__builtin_bit_cast(bf16x8, pw[ks]), ones, ol, 0, 0, 0);
        }
    }
}
__device__ __forceinline__ void mask_exp_pack(f32x16& p0, f32x16& p1, u64 mask, int hi, u32x4 (&pw)[4]) {
    const bool rowuni = __all(mask == ~0ull || mask == 0ull);
    if (rowuni) {
        const unsigned rm = mask ? ~0u : 0u;
        if (__all(mask == ~0ull)) {
#pragma unroll
            for (int r = 0; r < 16; ++r) { p0[r] = __builtin_amdgcn_exp2f(p0[r]); p1[r] = __builtin_amdgcn_exp2f(p1[r]); }
        } else {
#pragma unroll
            for (int r = 0; r < 16; ++r) { p0[r] = __uint_as_float(__float_as_uint(__builtin_amdgcn_exp2f(p0[r])) & rm); p1[r] = __uint_as_float(__float_as_uint(__builtin_amdgcn_exp2f(p1[r])) & rm); }
        }
    } else {
        const int m0 = (int)(unsigned)(mask >> (4 * hi)), m1 = (int)(unsigned)(mask >> (32 + 4 * hi));
#pragma unroll
        for (int r = 0; r < 16; ++r) { const int bit = (r & 3) + 8 * (r >> 2);
            const unsigned e0 = __float_as_uint(__builtin_amdgcn_exp2f(p0[r])), e1 = __float_as_uint(__builtin_amdgcn_exp2f(p1[r]));
            unsigned k0, k1;
            asm("v_bfe_i32 %0, %1, %2, 1" : "=v"(k0) : "v"(m0), "n"(bit)); asm("v_bfe_i32 %0, %1, %2, 1" : "=v"(k1) : "v"(m1), "n"(bit));
            p0[r] = __uint_as_float(e0 & k0); p1[r] = __uint_as_float(e1 & k1); }
    }
    pw[0] = (u32x4){pk2(p0[0], p0[1]), pk2(p0[2], p0[3]), pk2(p0[4], p0[5]), pk2(p0[6], p0[7])};
    pw[1] = (u32x4){pk2(p0[8], p0[9]), pk2(p0[10], p0[11]), pk2(p0[12], p0[13]), pk2(p0[14], p0[15])};
    pw[2] = (u32x4){pk2(p1[0], p1[1]), pk2(p1[2], p1[3]), pk2(p1[4], p1[5]), pk2(p1[6], p1[7])};
    pw[3] = (u32x4){pk2(p1[8], p1[9]), pk2(p1[10], p1[11]), pk2(p1[12], p1[13]), pk2(p1[14], p1[15])};
}
__device__ __forceinline__ u64 mask_le(int c) { return c >= 63 ? ~0ull : (c < 0 ? 0ull : ((2ull << c) - 1ull)); }
__device__ __forceinline__ u64 mask_ge(int a) { return a <= 0 ? ~0ull : (a > 63 ? 0ull : (~0ull << a)); }


__device__ __forceinline__ void glds16(const GAS void* gsrc, unsigned lds_dst) { unsigned keep;
    asm volatile("s_mov_b32 %0, m0\n\ts_mov_b32 m0, %2\n\ts_nop 0\n\tglobal_load_lds_dwordx4 %1, off\n\ts_mov_b32 m0, %0" : "=&s"(keep) : "v"(gsrc), "s"(lds_dst) : "memory"); }
__device__ __forceinline__ void tile_dma(const KVSrc& S, int t, unsigned kslot, unsigned vslot, const Lane& L) {
    const GAS bf16_t* ks = S.k + (size_t)(64 * t + L.lane) * S.pitch + L.wid * 8;
    const GAS bf16_t* vs = S.v + (size_t)(64 * t + 16 * (L.wid & 3) + (L.lane >> 2)) * S.pitch + (L.wid >> 2) * 32 + (L.lane & 3) * 8;
    glds16(ks, (unsigned)__builtin_amdgcn_readfirstlane(kslot + L.wid * 1040));
    glds16(vs, (unsigned)__builtin_amdgcn_readfirstlane(vslot + (L.wid >> 2) * 4096 + (L.wid & 3) * 1024));
}
#define ATT_WAIT_BAR(N) asm volatile("s_waitcnt vmcnt(" #N ") lgkmcnt(0)\n\ts_barrier" ::: "memory")
template <class MF>
__device__ __forceinline__ void attend_range(LAS char* lds, const KVSrc& S, int t0, int t1, const MF& mf, const bf16x8 (&qr)[4], float negC, f32x16& ol, f32x16 (&o)[2], const Lane& L, bool abl = false) {
    if (t0 >= t1) return;
    const bool late = L.wid >= 4;
    const unsigned lds0 = (unsigned)(size_t)lds;
    const f32x16 negm = {0.f, 0.f, 0.f, 0.f, 0.f, 0.f, 0.f, 0.f, 0.f, 0.f, 0.f, 0.f, 0.f, 0.f, 0.f, 0.f};
    (void)negC;
    tile_dma(S, t0, lds0 + L_K0, lds0 + L_V0, L);
    if (t0 + 1 < t1) tile_dma(S, t0 + 1, lds0 + L_K0 + 8320, lds0 + L_V0 + 8192, L);
    if (t0 + 2 < t1) tile_dma(S, t0 + 2, lds0 + L_K0 + 2 * 8320, lds0 + L_V0 + 2 * 8192, L);
    if (t0 + 2 < t1) ATT_WAIT_BAR(4); else if (t0 + 1 < t1) ATT_WAIT_BAR(2); else ATT_WAIT_BAR(0);
    u32x4 pwp[4];
#pragma unroll
    for (int k = 0; k < 4; ++k) asm volatile("" : "=v"(pwp[k]));
    int kcur = 0, vcur = 0, vprev = 0;
    u64 mk_next = mf(t0);
#if defined(PROBE_ABL) && PROBE_ABL == 12
    if (abl) { for (int t = t0; t < t1; ++t) { asm volatile("s_nop 0" ::: "memory"); } return; }
#endif
#if defined(PROBE_ABL) && PROBE_ABL == 13
    if (abl) { for (int t = t0; t < t1; ++t) { ATT_WAIT_BAR(0); } return; }
#endif
#if defined(PROBE_ABL) && PROBE_ABL == 14
    if (abl) { u64 acc_ = 0; for (int t = t0; t < t1; ++t) { acc_ ^= mf(t); asm volatile("s_waitcnt lgkmcnt(0)" : "+v"(acc_) :: "memory"); } asm volatile("" :: "v"(acc_)); return; }
#endif
#if defined(PROBE_ABL) && PROBE_ABL == 15
    if (abl) { for (int t = t0; t < t1; ++t) { f32x16 p0, p1; qk_tile_c(lds + L_K0, qr, negm, p0, p1, L.r32, L.hi); asm volatile("" :: "v"(p0), "v"(p1)); } return; }
#endif
#pragma unroll 1
    for (int t = t0; t < t1; ++t) {
        const u64 mk = mk_next;
        if (t + 1 < t1) mk_next = mf(t + 1);
#if defined(PROBE_ABL) && PROBE_ABL >= 10
        if (t + 3 < t1 && !abl) {
#else
        if (t + 3 < t1) {
#endif
            const int ks = kcur == 0 ? NKB - 1 : kcur - 1; int vs = vcur + 3; vs = vs >= NVB ? vs - NVB : vs;
            tile_dma(S, t + 3, lds0 + L_K0 + ks * 8320, lds0 + L_V0 + vs * 8192, L); }
#if defined(PROBE_ABL) && (PROBE_ABL == 6 || PROBE_ABL >= 10)
        if (late && t > t0 && !abl) pv_tile(lds + L_V0 + vprev * 8192, pwp, o, ol, L.lane, L.hi);
#else
        if (late && t > t0) pv_tile(lds + L_V0 + vprev * 8192, pwp, o, ol, L.lane, L.hi);
#endif
        f32x16 p0, p1;
#if defined(PROBE_ABL) && (PROBE_ABL == 6 || PROBE_ABL >= 10)
        if (abl) { p0 = negm; p1 = negm; asm volatile("" : "+v"(p0), "+v"(p1)); } else
#endif
        qk_tile_c(lds + L_K0 + kcur * 8320, qr, negm, p0, p1, L.r32, L.hi);
        u32x4 pw[4];
#if defined(PROBE_ABL) && (PROBE_ABL == 2 || PROBE_ABL >= 10)
        if (abl) {
#pragma unroll
            for (int k = 0; k < 4; ++k) pw[k] = (u32x4){__float_as_uint(p0[4 * k]) ^ (unsigned)mk, __float_as_uint(p0[4 * k + 1]), __float_as_uint(p1[4 * k + 2]), __float_as_uint(p1[4 * k + 3])}; }
        else
#endif
        mask_exp_pack(p0, p1, mk, L.hi, pw);
#if defined(PROBE_ABL) && (PROBE_ABL == 6 || PROBE_ABL >= 10)
        if (!late && !abl) pv_tile(lds + L_V0 + vcur * 8192, pw, o, ol, L.lane, L.hi);
        else if (!late) { asm volatile("" :: "v"(pw[0]), "v"(pw[1]), "v"(pw[2]), "v"(pw[3])); }
#else
        if (!late) pv_tile(lds + L_V0 + vcur * 8192, pw, o, ol, L.lane, L.hi);
#endif
        else {
#pragma unroll
            for (int k = 0; k < 4; ++k) pwp[k] = pw[k]; }
#if defined(PROBE_ABL) && PROBE_ABL == 11
        if (abl) { asm volatile("s_waitcnt lgkmcnt(0)" ::: "memory"); } else
#endif
        if (t + 3 < t1) ATT_WAIT_BAR(4); else if (t + 2 < t1) ATT_WAIT_BAR(2); else ATT_WAIT_BAR(0);
        vprev = vcur; vcur = vcur == NVB - 1 ? 0 : vcur + 1; kcur = kcur == NKB - 1 ? 0 : kcur + 1;
    }
    if (late) pv_tile(lds + L_V0 + vprev * 8192, pwp, o, ol, L.lane, L.hi);
    ATT_WAIT_BAR(0);
}
__device__ __forceinline__ void rows_to_regs(LAS float* wsf, float v, int r32, int hi, float (&sc)[16]) {
    asm volatile("s_waitcnt lgkmcnt(0)" ::: "memory");
    if (hi == 0) wsf[r32] = v;
    asm volatile("s_waitcnt lgkmcnt(0)" ::: "memory");
#pragma unroll
    for (int r = 0; r < 16; ++r) sc[r] = wsf[crow(r, hi)];
}
__device__ __forceinline__ void load_q(const bf16_t* qrow, int hi, bf16x8 (&qr)[4]) {
#pragma unroll
    for (int d0 = 0; d0 < 4; ++d0) qr[d0] = *(const GAS bf16x8*)(qrow + d0 * 16 + hi * 8);
}
template <class RowPtr>
__device__ __forceinline__ void store_o(LAS char* stage, const f32x16 (&acc)[2], const RowPtr& rowptr, int lane, int r32, int hi) {
    LAS bf16_t* stg = (LAS bf16_t*)stage;
#pragma unroll
    for (int r = 0; r < 16; ++r) { const int orow = crow(r, hi);
#pragma unroll
        for (int d0 = 0; d0 < 2; ++d0) stg[orow * 64 + d0 * 32 + r32] = (bf16_t)(pk2(acc[d0][r], 0.f) & 0xffffu); }
    asm volatile("s_waitcnt lgkmcnt(0)" ::: "memory");
#pragma unroll
    for (int i = 0; i < 4; ++i) { const int row = i * 8 + (lane >> 3), ch = lane & 7; const u32x4 v = *(LAS const u32x4*)(stg + row * 64 + ch * 8); *(GAS u32x4*)(rowptr(row) + ch * 8) = v; }
    asm volatile("s_waitcnt lgkmcnt(0)" ::: "memory");
}
}

constexpr int NWAVES = 8;
constexpr int BATCH = 4, SEQ = 4096, DM = 1024, DFF = 4096, DEPTH = 2, D_IN = 6236;
constexpr int M = BATCH * SEQ;
constexpr size_t MiB = 1u << 20;
constexpr size_t WS_ZQ = 0;
constexpr size_t WS_ZKV = 48 * MiB;
constexpr size_t WS_YS = WS_ZKV;
constexpr size_t WS_MB = 104 * MiB;
constexpr size_t WS_KC2 = WS_MB, WS_VC2 = WS_MB + 4 * MiB;
constexpr size_t WS_XB = 136 * MiB;
constexpr size_t WS_W = 168 * MiB, W_LAYER = 36 * MiB;
constexpr size_t W_IN = 0, W_G = 7 * MiB, W_BR = 13 * MiB, W_OUT = 16 * MiB, W_UP = 18 * MiB, W_DN = 26 * MiB, W_CK1 = 34 * MiB, W_CV1 = 35 * MiB;
constexpr size_t WS_BM = 240 * MiB;
constexpr size_t WS_MISC = 248 * MiB;
constexpr size_t WS_CTL = WS_MISC, CTL_BYTES = 128 * 1024;
constexpr size_t WS_COS = WS_MISC + 1 * MiB, WS_SIN = WS_MISC + 1 * MiB + 512 * 1024;
constexpr size_t WS_KCMP = WS_MISC + 2 * MiB;
constexpr size_t WS_SSQ = WS_MISC + 2 * MiB + 512 * 1024;
constexpr size_t WS_B1P = WS_MISC + 3 * MiB + 512 * 1024;
constexpr size_t WS_W2 = WS_B1P + 64 * 1024;
constexpr size_t WS_IKF = WS_MISC + 4 * MiB;
constexpr size_t WS_HMID = 0;
constexpr size_t WS_END = 256 * MiB;
constexpr int CW_BAR = 4096, CW_Q = 8192, CW_KMAX = 12288;
constexpr int LDS_BYTES = 163840, LDS_UNIT = 163776;
constexpr float C2 = 0.125f * 1.4426950408889634f, LOG2E = 1.4426950408889634f;


struct Args { const float* in[17]; float* out; unsigned char* ws; };
struct Frame {
    LAS unsigned char* lds;
    gu32* ctl;
    int tid, lane, wave, G, gw, NGW;
    unsigned char* ws;
    const struct Args* a;
};
__device__ __forceinline__ float wave_sum(float v) {
#pragma unroll
    for (int o = 1; o < 64; o <<= 1) v += __shfl_xor(v, o);
    return v;
}
__device__ __forceinline__ float wave_max(float v) {
#pragma unroll
    for (int o = 1; o < 64; o <<= 1) v = fmaxf(v, __shfl_xor(v, o));
    return v;
}
__device__ __forceinline__ float bf2f(bf16 h) { return __uint_as_float((unsigned)h << 16); }
__device__ __constant__ float c_inv_freq[32] = {
    1.0f, 0.7498942093324559f, 0.5623413251903491f, 0.4216965034285822f, 0.31622776601683794f, 0.23713737056616552f, 0.1778279410038923f, 0.1333521432163324f,
    0.1f, 0.07498942093324558f, 0.05623413251903491f, 0.042169650342858224f, 0.03162277660168379f, 0.023713737056616554f, 0.01778279410038923f, 0.01333521432163324f,
    0.01f, 0.007498942093324558f, 0.005623413251903491f, 0.004216965034285823f, 0.0031622776601683794f, 0.0023713737056616554f, 0.0017782794100389228f, 0.001333521432163324f,
    0.001f, 0.0007498942093324559f, 0.0005623413251903491f, 0.00042169650342858224f, 0.00031622776601683794f, 0.00023713737056616554f, 0.00017782794100389227f, 0.0001333521432163324f};

__device__ __forceinline__ int mix_src_col(int j) {
    if (j < 512) return j;
    if (j < 1024) return 1092 + (j - 512);
    if (j < 1536) return 1860 + (j - 1024);
    if (j < 1792) return 512 + (j - 1536);
    if (j < 2048) return 1604 + (j - 1792);
    if (j < 2304) return 2372 + (j - 2048);
    if (j < 2560) return 2628 + (j - 2304);
    if (j < 2816) return 2884 + (j - 2560);
    if (j < 3072) return 768 + (j - 2816);
    const int r = j - 3072;
    if (r < 64) return 1024 + r;
    if (r < 68) return 1088 + (r - 64);
    if (r < 92) return 3140 + (r - 68);
    return -1;
}
template <int MODE>
__device__ __forceinline__ void p0_item(const float* W, int ldw, int K, bf16* WT, int nblk, int item, const float* gain, int coff, LAS float* scr, int lane) {
    const int kb = item / nblk, nb = item % nblk, k0 = 64 * kb, n0 = 32 * nb;
    const int nq = 4 * (lane & 7), rr = lane >> 3;
    const int sc = MODE == 0 ? (n0 + nq + coff) : mix_src_col(n0 + nq);
    f32x4 v[8];
#pragma unroll
    for (int i = 0; i < 8; ++i) { v[i] = (f32x4){0.f, 0.f, 0.f, 0.f}; if (sc >= 0) v[i] = *(const GAS f32x4*)(W + (size_t)(k0 + 8 * i + rr) * ldw + sc); }
#pragma unroll
    for (int i = 0; i < 8; ++i) { const int kk = 8 * i + rr; const float g = gain ? gain[k0 + kk] : 1.0f;
        scr[kk * 33 + nq + 0] = v[i][0] * g; scr[kk * 33 + nq + 1] = v[i][1] * g; scr[kk * 33 + nq + 2] = v[i][2] * g; scr[kk * 33 + nq + 3] = v[i][3] * g; }
    LDS_WAIT(); asm volatile("" ::: "memory");
    const int c = lane & 7;
#pragma unroll
    for (int j = 0; j < 4; ++j) { const int n = (lane >> 3) + 8 * j; const LAS float* s = scr + (8 * c) * 33 + n;
        v4u o; o.x = pk2(s[0 * 33], s[1 * 33]); o.y = pk2(s[2 * 33], s[3 * 33]); o.z = pk2(s[4 * 33], s[5 * 33]); o.w = pk2(s[6 * 33], s[7 * 33]);
        *(GAS v4u*)(WT + (size_t)(n0 + n) * K + k0 + 8 * c) = o; }
    LDS_WAIT(); asm volatile("" ::: "memory");
}
__device__ __forceinline__ void p0_prologue(Frame& F) {
    LAS float* scr = (LAS float*)(F.lds + F.wave * 16384);
    constexpr int I_IN = 16 * 104, I_G = 16 * 96, I_BR = 8 * 32, I_OUT = 16 * 32, I_UP = 16 * 128, I_DN = 64 * 32, I_C1 = 32 * 8, I_C2 = 4 * 2;
    constexpr int PER_LAYER = I_IN + I_G + 3 * I_BR + I_OUT + I_UP + I_DN + 2 * I_C1 + 2 * I_C2;
    for (int it = F.gw; it < 2 * PER_LAYER; it += F.NGW) {
        const int l = it / PER_LAYER; int r = it % PER_LAYER;
        unsigned char* wl = F.ws + WS_W + (size_t)l * W_LAYER;
        const float* w_in = F.a->in[2] + (size_t)l * DM * D_IN;
        if (r < I_IN) { p0_item<1>(w_in, D_IN, DM, (bf16*)(wl + W_IN), 104, r, F.a->in[1] + l * DM, 0, scr, F.lane); continue; } r -= I_IN;
        if (r < I_G) { p0_item<0>(w_in, D_IN, DM, (bf16*)(wl + W_G), 96, r, F.a->in[1] + l * DM, 3164, scr, F.lane); continue; } r -= I_G;
        if (r < 3 * I_BR) { const int n = r / I_BR; p0_item<0>(F.a->in[12] + ((size_t)l * 3 + n) * 512 * DM, DM, 512, (bf16*)(wl + W_BR) + (size_t)n * DM * 512, 32, r % I_BR, nullptr, 0, scr, F.lane); continue; } r -= 3 * I_BR;
        if (r < I_OUT) { p0_item<0>(F.a->in[13] + (size_t)l * DM * DM, DM, DM, (bf16*)(wl + W_OUT), 32, r, nullptr, 0, scr, F.lane); continue; } r -= I_OUT;
        if (r < I_UP) { p0_item<0>(F.a->in[15] + (size_t)l * DM * DFF, DFF, DM, (bf16*)(wl + W_UP), 128, r, F.a->in[14] + l * DM, 0, scr, F.lane); continue; } r -= I_UP;
        if (r < I_DN) { p0_item<0>(F.a->in[16] + (size_t)l * DFF * DM, DM, DFF, (bf16*)(wl + W_DN), 32, r, nullptr, 0, scr, F.lane); continue; } r -= I_DN;
        if (r < I_C1) { p0_item<0>(F.a->in[8] + (size_t)l * 2048 * 256, 256, 2048, (bf16*)(wl + W_CK1), 8, r, nullptr, 0, scr, F.lane); continue; } r -= I_C1;
        if (r < I_C1) { p0_item<0>(F.a->in[10] + (size_t)l * 2048 * 256, 256, 2048, (bf16*)(wl + W_CV1), 8, r, nullptr, 0, scr, F.lane); continue; } r -= I_C1;
        if (r < I_C2) { p0_item<0>(F.a->in[9] + (size_t)l * 256 * 64, 64, 256, (bf16*)(F.ws + WS_W2) + (size_t)(l * 2 + 0) * 64 * 256, 2, r, nullptr, 0, scr, F.lane); continue; } r -= I_C2;
        p0_item<0>(F.a->in[11] + (size_t)l * 256 * 64, 64, 256, (bf16*)(F.ws + WS_W2) + (size_t)(l * 2 + 1) * 64 * 256, 2, r, nullptr, 0, scr, F.lane);
    }
    for (int it = F.gw; it < 128; it += F.NGW) {
        const int kp = it & 7, jb = (it >> 3) & 3, which = (it >> 5) & 1, l = it >> 6; const int j = jb * 64 + F.lane;
        const float* pe = (which ? F.a->in[7] : F.a->in[6]) + l * 2048; const float* w1 = (which ? F.a->in[10] : F.a->in[8]) + (size_t)l * 2048 * 256;
        float a = 0.f;
        for (int k = kp * 256; k < kp * 256 + 256; ++k) a = fmaf(pe[k], w1[(size_t)k * 256 + j], a);
        ((float*)(F.ws + WS_B1P))[((l * 2 + which) * 8 + kp) * 256 + j] = a;
    }
    for (int m = F.gw; m < M; m += F.NGW) {
        const GAS f32x4* xr = (const GAS f32x4*)(F.a->in[0] + (size_t)m * DM) + F.lane;
        GAS unsigned long long* o8 = (GAS unsigned long long*)((bf16*)(F.ws + WS_XB) + (size_t)m * DM) + F.lane;
        float s = 0.f;
#pragma unroll
        for (int j = 0; j < 4; ++j) { const f32x4 v = xr[64 * j]; s += (v.x * v.x + v.y * v.y) + (v.z * v.z + v.w * v.w);
            o8[64 * j] = (unsigned long long)pk2(v.x, v.y) | ((unsigned long long)pk2(v.z, v.w) << 32); }
        s = wave_sum(s);
        if (F.lane < 16) ((float*)(F.ws + WS_SSQ))[(size_t)m * 16 + F.lane] = F.lane == 0 ? s : 0.f;
    }
    for (int i = F.gw * 64 + F.lane; i < SEQ * 32; i += F.NGW * 64) {
        const float ang = (float)(i >> 5) * c_inv_freq[i & 31];
        ((float*)(F.ws + WS_COS))[i] = (float)cos((double)ang); ((float*)(F.ws + WS_SIN))[i] = (float)sin((double)ang);
    }
}
typedef unsigned u32x4_t __attribute__((ext_vector_type(4)));
__device__ __forceinline__ void post_group(u32x4_t raw, bool act, bool norm, bool rope, const float (&gain)[8], float scale, const float (&cs)[8], const float (&sn)[8], int lane, bf16* dst) {
    float v[8];
    v[0] = __uint_as_float(raw.x << 16); v[1] = __uint_as_float(raw.x & 0xffff0000u); v[2] = __uint_as_float(raw.y << 16); v[3] = __uint_as_float(raw.y & 0xffff0000u);
    v[4] = __uint_as_float(raw.z << 16); v[5] = __uint_as_float(raw.z & 0xffff0000u); v[6] = __uint_as_float(raw.w << 16); v[7] = __uint_as_float(raw.w & 0xffff0000u);
    float ss = ((v[0] * v[0] + v[1] * v[1]) + (v[2] * v[2] + v[3] * v[3])) + ((v[4] * v[4] + v[5] * v[5]) + (v[6] * v[6] + v[7] * v[7]));
    ss += __shfl_xor(ss, 1); ss += __shfl_xor(ss, 2); ss += __shfl_xor(ss, 4);
    const float rs = norm ? rsqrtf(ss * (1.0f / 64.0f) + 1e-6f) : 1.0f;
    const bool lo = (lane & 4) == 0;
    float r[8];
#pragma unroll
    for (int j = 0; j < 8; ++j) { const float x = norm ? v[j] * rs * gain[j] : v[j]; const float o = __shfl_xor(x, 4);
        r[j] = rope ? (lo ? (x * cs[j] - o * sn[j]) : (x * cs[j] + o * sn[j])) : x; r[j] *= scale; }
    if (act) { u32x4_t w; w.x = pk2(r[0], r[1]); w.y = pk2(r[2], r[3]); w.z = pk2(r[4], r[5]); w.w = pk2(r[6], r[7]); *(GAS u32x4_t*)dst = w; }
}
__device__ __forceinline__ void post_phase(Frame& F, int l, bool dry = false) {
    const float* qn = F.a->in[3] + l * 192; const float* kn = F.a->in[4] + l * 192;
    const int lane = F.lane, g = lane >> 3, c = lane & 7;
    float gq0[8], gq1[8], gq2[8], gk3[8], gk2[8];
#pragma unroll
    for (int j = 0; j < 8; ++j) { gq0[j] = qn[8 * c + j]; gq1[j] = qn[64 + 8 * c + j]; gq2[j] = qn[128 + 8 * c + j]; gk2[j] = kn[128 + 8 * c + j];
        gk3[j] = (g >> 1) == 0 ? kn[8 * c + j] : ((g >> 1) == 1 ? kn[64 + 8 * c + j] : kn[128 + 8 * c + j]); }
    bf16* zq = (bf16*)(F.ws + WS_ZQ); bf16* zkv = (bf16*)(F.ws + WS_ZKV);
    const float* cst = (const float*)(F.ws + WS_COS); const float* snt = (const float*)(F.ws + WS_SIN);
#pragma unroll 1
    for (int m = F.gw; m < M; m += F.NGW) {
        const int t = m & (SEQ - 1), b = m >> 12;
        float cs[8], sn[8];
        { const GAS f32x4* cp = (const GAS f32x4*)(cst + t * 32 + 8 * (c & 3)); const GAS f32x4* sp = (const GAS f32x4*)(snt + t * 32 + 8 * (c & 3));
          const f32x4 c0 = cp[0], c1 = cp[1], s0 = sp[0], s1 = sp[1];
          cs[0] = c0[0]; cs[1] = c0[1]; cs[2] = c0[2]; cs[3] = c0[3]; cs[4] = c1[0]; cs[5] = c1[1]; cs[6] = c1[2]; cs[7] = c1[3];
          sn[0] = s0[0]; sn[1] = s0[1]; sn[2] = s0[2]; sn[3] = s0[3]; sn[4] = s1[0]; sn[5] = s1[1]; sn[6] = s1[2]; sn[7] = s1[3]; }
        bf16* pqa = zq + (size_t)m * 512 + lane * 8; bf16* pqb = pqa + (size_t)M * 512; bf16* pqc = pqa + (size_t)2 * M * 512;
        const int t3 = (g >> 1) < 2 ? (g >> 1) : (g >> 1) + 1;
        bf16* p3 = zkv + (size_t)t3 * M * 256 + (size_t)m * 256 + (g & 1) * 64 + c * 8;
        const bf16* s4 = g < 4 ? zkv + (size_t)2 * M * 256 + (size_t)m * 256 + g * 64 + c * 8 : zkv + (size_t)5 * M * 256 + (size_t)m * 256 + (g - 4) * 64 + c * 8;
        bf16* d4 = g < 2 ? (bf16*)(F.ws + WS_KC2) + ((size_t)(b * 2 + g) * SEQ + t) * 64 + c * 8
                 : (g < 4 ? (bf16*)(F.ws + WS_VC2) + ((size_t)(b * 2 + (g - 2)) * SEQ + t) * 64 + c * 8 : (bf16*)s4);
        const bf16* p5 = zkv + (size_t)6 * M * 256 + (size_t)m * 256 + c * 8;
        bf16* d5 = (bf16*)(F.ws + WS_IKF) + ((size_t)(b * (SEQ / 32) + (t >> 5)) * 8 + c) * 256 + (t & 31) * 8;
        const u32x4_t r0 = *(const GAS u32x4_t*)pqa, r1 = *(const GAS u32x4_t*)pqb, r2 = *(const GAS u32x4_t*)pqc, r3 = *(const GAS u32x4_t*)p3, r4 = *(const GAS u32x4_t*)s4;
        const u32x4_t r5 = *(const GAS u32x4_t*)p5;
        post_group(r0, !dry, true, true, gq0, C2, cs, sn, lane, pqa);
        post_group(r1, !dry, true, true, gq1, C2, cs, sn, lane, pqb);
        post_group(r2, !dry, true, true, gq2, C2, cs, sn, lane, pqc);
        post_group(r3, !dry, true, true, gk3, 1.f, cs, sn, lane, p3);
        post_group(r4, !dry, g < 2, g < 2 || g >= 4, gk2, 1.f, cs, sn, lane, d4);
        post_group(r5, g == 0 && !dry, false, true, gk2, 1.f, cs, sn, lane, d5);
    }
}

#define WAVE_LDS_FENCE() asm volatile("s_waitcnt lgkmcnt(0)" ::: "memory")
__device__ __forceinline__ int next_unit(Frame& F, gu32* counter) {
    LAS int* slot = (LAS int*)(F.lds + LDS_UNIT);
    __syncthreads();
    if (F.tid == 0) *slot = (int)__hip_atomic_fetch_add(counter, 1u, RLX_AGENT);
    __syncthreads();
    return *slot;
}
__device__ __forceinline__ unsigned f2key(float f) { const unsigned u = __float_as_uint(f); return (u & 0x80000000u) ? ~u : (u | 0x80000000u); }
__device__ __forceinline__ float dpp_quad_sum(float v) {
    v += __int_as_float(__builtin_amdgcn_update_dpp(0, __float_as_int(v), 0xB1, 0xF, 0xF, true));
    v += __int_as_float(__builtin_amdgcn_update_dpp(0, __float_as_int(v), 0x4E, 0xF, 0xF, true));
    return v;
}
__device__ __forceinline__ void radix_select_list(LAS const unsigned* list, int nblk, int k, LAS unsigned* hist, int lane, unsigned& T, int& need) {
    typedef unsigned u32x4_ __attribute__((ext_vector_type(4)));
    unsigned prefix = 0u; int kk = k;
#pragma unroll 1
    for (int pass = 0; pass < 4; ++pass) {
        const int shift = 24 - 8 * pass;
#pragma unroll
        for (int i = 0; i < 4; ++i) hist[lane * 4 + i] = 0u;
        WAVE_LDS_FENCE();
#pragma unroll 2
        for (int jb = 0; jb < nblk; ++jb) { const u32x4_ v = *(LAS const u32x4_*)(list + jb * 256 + lane * 4);
#pragma unroll
            for (int c = 0; c < 4; ++c) { const unsigned key = v[c];
                const unsigned bin = (pass == 0 || (key >> (shift + 8)) == prefix) ? ((key >> shift) & 255u) : 256u + (unsigned)lane;
                __hip_atomic_fetch_add(&hist[bin], 1u, __ATOMIC_RELAXED, __HIP_MEMORY_SCOPE_WORKGROUP); } }
        WAVE_LDS_FENCE();
        const unsigned h0 = hist[lane * 4], h1 = hist[lane * 4 + 1], h2 = hist[lane * 4 + 2], h3 = hist[lane * 4 + 3];
        const int tot4 = (int)(h0 + h1 + h2 + h3);
        int pre = tot4;
        pre += __builtin_amdgcn_update_dpp(0, pre, 0x111, 0xf, 0xf, false);
        pre += __builtin_amdgcn_update_dpp(0, pre, 0x112, 0xf, 0xf, false);
        pre += __builtin_amdgcn_update_dpp(0, pre, 0x114, 0xf, 0xf, false);
        pre += __builtin_amdgcn_update_dpp(0, pre, 0x118, 0xf, 0xf, false);
        pre += __builtin_amdgcn_update_dpp(0, pre, 0x142, 0xa, 0xf, false);
        pre += __builtin_amdgcn_update_dpp(0, pre, 0x143, 0xc, 0xf, false);
        const int total = __builtin_amdgcn_readlane(pre, 63);
        const int above = total - pre;
        const int a3 = above, a2 = a3 + (int)h3, a1 = a2 + (int)h2, a0 = a1 + (int)h1;
        int dsel = -1, nk = 0;
        if (a3 < kk && kk <= a3 + (int)h3) { dsel = lane * 4 + 3; nk = kk - a3; }
        else if (a2 < kk && kk <= a2 + (int)h2) { dsel = lane * 4 + 2; nk = kk - a2; }
        else if (a1 < kk && kk <= a1 + (int)h1) { dsel = lane * 4 + 1; nk = kk - a1; }
        else if (a0 < kk && kk <= a0 + (int)h0) { dsel = lane * 4 + 0; nk = kk - a0; }
        const unsigned long long bal = __ballot(dsel >= 0);
        const int src = (int)__builtin_ctzll(bal);
        dsel = __builtin_amdgcn_readlane(dsel, src); nk = __builtin_amdgcn_readlane(nk, src);
        WAVE_LDS_FENCE();
        prefix = (prefix << 8) | (unsigned)dsel; kk = nk;
    }
    T = prefix; need = kk;
}
__device__ __forceinline__ void select_unit(Frame& F, int b, int qblk, int abl = 0) {
    using namespace att;
    int tid_ = F.tid; asm volatile("" : "+v"(tid_));
    const int lane = tid_ & 63, r32 = lane & 31, hi = lane >> 5, w = F.wave;
    LAS unsigned* sc = (LAS unsigned*)F.lds;
    LAS unsigned* hist = (LAS unsigned*)(F.lds + 131072) + w * 320;
    LAS unsigned* cand = (LAS unsigned*)(F.lds + 131072 + 10240) + w * 512;
    const int t0 = qblk * 8; const size_t m0 = (size_t)b * SEQ + t0;
    const bf16* IQ = (const bf16*)(F.ws + WS_ZKV) + (size_t)5 * M * 256; const bf16* MISC = (const bf16*)(F.ws + WS_ZKV) + (size_t)6 * M * 256;
    const bf16* IKF = (const bf16*)(F.ws + WS_IKF) + (size_t)b * SEQ * 64;
    u64* BM = (u64*)(F.ws + WS_BM);
    const int nkeys = t0 + 8;
    if (nkeys > 256 && abl < 2) {
        bf16x8 iqf[4];
        { const bf16* qrow = IQ + (m0 + (r32 >> 2)) * 256 + (r32 & 3) * 64;
#pragma unroll
          for (int d0 = 0; d0 < 4; ++d0) iqf[d0] = *(const GAS bf16x8*)(qrow + d0 * 16 + hi * 8); }
        const float wl = bf2f(((const GAS bf16*)MISC)[(m0 + (r32 >> 2)) * 256 + 64 + (r32 & 3)]);
        const int ntile = (nkeys + 31) >> 5; const int g = r32 & 3;
#pragma unroll 1
        for (int tile0 = w; tile0 < ntile; tile0 += 16) {
            bf16x8 kf[2][4];
#pragma unroll
            for (int u = 0; u < 2; ++u) { const int tile = tile0 + 8 * u < ntile ? tile0 + 8 * u : tile0;
                const bf16* kt = IKF + (size_t)tile * 2048 + hi * 256 + r32 * 8;
#pragma unroll
                for (int d0 = 0; d0 < 4; ++d0) kf[u][d0] = *(const GAS bf16x8*)(kt + d0 * 512); }
#pragma unroll
            for (int u = 0; u < 2; ++u) { const int tile = tile0 + 8 * u;
                if (tile < ntile) {
                    const int s0 = tile * 32;
                    f32x16 acc;
#pragma unroll
                    for (int r = 0; r < 16; ++r) acc[r] = 0.f;
#pragma unroll
                    for (int d0 = 0; d0 < 4; ++d0) acc = __builtin_amdgcn_mfma_f32_32x32x16_bf16(kf[u][d0], iqf[d0], acc, 0, 0, 0);
                    float v[16];
#pragma unroll
                    for (int r = 0; r < 16; ++r) v[r] = dpp_quad_sum(__builtin_amdgcn_fmed3f(acc[r], 0.f, __builtin_inff()) * wl);
                    u32x4 o;
#pragma unroll
                    for (int j = 0; j < 4; ++j) o[j] = f2key(g == 0 ? v[j] : (g == 1 ? v[4 + j] : (g == 2 ? v[8 + j] : v[12 + j])));
                    *(LAS u32x4*)(sc + (r32 >> 2) * 4096 + s0 + 8 * g + 4 * hi) = o;
                } }
        }
    }
    __syncthreads();
    if (abl != 1) {
        const int t = t0 + w, n = t + 1; LAS unsigned* row = sc + w * 4096;
        u64 myword = 0ull;
        if (n <= 256) {
            const int c0 = 64 * lane;
            myword = (c0 + 63 < n) ? ~0ull : (c0 >= n ? 0ull : ((1ull << (n - c0)) - 1ull));
        } else {
            const int nblk = (n + 255) >> 8;
            { const int s = (n & ~3) + lane * 4;
              if (s < nblk * 256) { u32x4 v = *(LAS u32x4*)(row + s);
#pragma unroll
                  for (int c = 0; c < 4; ++c) if (s + c >= n) v[c] = 0u;
                  *(LAS u32x4*)(row + s) = v; } }
            WAVE_LDS_FENCE();
            unsigned T = 0u; int need = 0; bool done = false;
            if (n > 512 && abl != 5) {
#pragma unroll
                for (int c = 0; c < 8; ++c) { const int i = lane + 64 * c; cand[i] = row[(i * n) >> 9]; }
                WAVE_LDS_FENCE();
                const float er = 131072.0f / (float)n;
                int rr = (int)(er + 2.5f * __builtin_sqrtf(er * (1.0f - 256.0f / (float)n)) + 2.0f); rr = rr > 512 ? 512 : rr;
                unsigned P; int dummy; radix_select_list(cand, 2, rr, hist, lane, P, dummy);
                int C = 0; bool ovf = false;
#pragma unroll 1
                for (int jb = 0; jb < nblk; ++jb) { const u32x4 v = *(LAS const u32x4*)(row + jb * 256 + lane * 4);
#pragma unroll
                    for (int c = 0; c < 4; ++c) { const bool in = v[c] > P; const u64 bal = __ballot(in); const int pos = C + __builtin_popcountll(bal & ((1ull << lane) - 1ull));
                        C += __builtin_popcountll(bal); if (C > 512) ovf = true;
                        if (in && !ovf) cand[pos] = v[c]; } }
                if (!ovf && C >= 256) {
                    WAVE_LDS_FENCE();
                    const int cb = (C + 255) >> 8;
                    { const int s = C + lane; if (s < cb * 256) cand[s] = 0u; const int s2 = s + 64; if (s2 < cb * 256) cand[s2] = 0u; const int s3 = s + 128; if (s3 < cb * 256) cand[s3] = 0u; const int s4 = s + 192; if (s4 < cb * 256) cand[s4] = 0u; }
                    WAVE_LDS_FENCE();
                    radix_select_list(cand, cb, 256, hist, lane, T, need); done = true;
                }
            }
            if (!done && abl < 3) radix_select_list(row, nblk, 256, hist, lane, T, need);
            int base = 0;
            const int nch = abl >= 4 ? 0 : (n + 63) >> 6;
#pragma unroll 1
            for (int c = 0; c < nch; c += 4) {
                unsigned vv[4];
#pragma unroll
                for (int u2 = 0; u2 < 4; ++u2) vv[u2] = row[64 * (c + u2) + lane];
#pragma unroll
                for (int u2 = 0; u2 < 4; ++u2) {
                    const int s = 64 * (c + u2) + lane; const bool valid = s < n; const unsigned key = valid ? vv[u2] : 0u;
                    const bool gt = valid && key > T, eq = valid && key == T;
                    const u64 beq = __ballot(eq);
                    const int rank = base + __builtin_popcountll(beq & ((1ull << lane) - 1ull));
                    const u64 word = __ballot(gt || (eq && rank < need));
                    if (lane == c + u2) myword = word;
                    base += __builtin_popcountll(beq);
                }
            }
        }
        if (abl >= 2) ((GAS u64*)(F.ws + WS_MB + 24 * MiB))[((size_t)b * SEQ + t) * 64 + lane] = myword;
        else ((GAS u64*)BM)[((size_t)b * SEQ + t) * 64 + lane] = myword;
    }
    __syncthreads();
}
__device__ __forceinline__ void compress_unit(Frame& F, int l, int u) {
    using namespace att;
    int tid_ = F.tid; asm volatile("" : "+v"(tid_));
    const int lane = tid_ & 63, r32 = lane & 31, hi = lane >> 5, w = F.wave;
    const int which = u & 1, h = (u >> 1) & 1, b = (u >> 2) & 3, cb = u >> 4;
    const bf16* src = (const bf16*)(F.ws + (which ? WS_VC2 : WS_KC2)) + (size_t)(b * 2 + h) * SEQ * 64;
    const bf16* W1t = (const bf16*)(F.ws + WS_W + (size_t)l * W_LAYER + (which ? W_CV1 : W_CK1));
    const bf16* W2t = (const bf16*)(F.ws + WS_W2) + (size_t)(l * 2 + which) * 64 * 256;
    const float* b1p = (const float*)(F.ws + WS_B1P) + (size_t)(l * 2 + which) * 8 * 256;
    LAS bf16* hid = (LAS bf16*)F.lds;
    int cc = 32 * cb + r32; if (cc > 254) cc = 254;
    const bf16* arow = src + (size_t)(16 * cc) * 64 + hi * 8;
    const bf16* brow = W1t + (size_t)(32 * w + r32) * 2048 + hi * 8;
    f32x16 acc;
#pragma unroll
    for (int r = 0; r < 16; ++r) acc[r] = 0.f;
#pragma unroll 4
    for (int ks = 0; ks < 128; ++ks) { const bf16x8 a = *(const GAS bf16x8*)(arow + ks * 16), bb = *(const GAS bf16x8*)(brow + ks * 16); acc = __builtin_amdgcn_mfma_f32_32x32x16_bf16(a, bb, acc, 0, 0, 0); }
    float b1 = 0.f;
#pragma unroll
    for (int kp = 0; kp < 8; ++kp) b1 += ((const GAS float*)b1p)[kp * 256 + 32 * w + r32];
#pragma unroll
    for (int r = 0; r < 16; ++r) hid[crow(r, hi) * 264 + 32 * w + r32] = (bf16)f2bf(fmaxf(acc[r] + b1, 0.f));
    __syncthreads();
    if (w < 2) {
        f32x16 o;
#pragma unroll
        for (int r = 0; r < 16; ++r) o[r] = 0.f;
        const bf16* w2row = W2t + (size_t)(32 * w + r32) * 256 + hi * 8;
#pragma unroll
        for (int ks = 0; ks < 16; ++ks) { const bf16x8 a = *(LAS const bf16x8*)(hid + r32 * 264 + ks * 16 + hi * 8), bb = *(const GAS bf16x8*)(w2row + ks * 16); o = __builtin_amdgcn_mfma_f32_32x32x16_bf16(a, bb, o, 0, 0, 0); }
        bf16* dst = (bf16*)(F.ws + WS_KCMP) + ((size_t)((which * 4 + b) * 2 + h) * 256) * 64;
        float mx = 0.f;
#pragma unroll
        for (int r = 0; r < 16; ++r) { const int c = 32 * cb + crow(r, hi); const float v = c < 255 ? o[r] : 0.f; mx = fmaxf(mx, fabsf(v)); ((GAS bf16*)dst)[(size_t)c * 64 + 32 * w + r32] = (bf16)f2bf(v); }
        if (which == 0) { mx = wave_max(mx); if (lane == 0) __hip_atomic_fetch_max(F.ctl + CW_KMAX + 64 * (l * 8 + b * 2 + h), __float_as_uint(mx), RLX_AGENT); }
    }
    __syncthreads();
}
struct UnitGeom { int b, kvh, i; att::Lane L; int q; int head; size_t mrow; };
__device__ __forceinline__ UnitGeom unit_geom(Frame& F, int b, int kvh, int i) {
    int tid = F.tid; asm volatile("" : "+v"(tid));
    UnitGeom U; U.b = b; U.kvh = kvh; U.i = i; U.L.tid = tid; U.L.lane = tid & 63; U.L.r32 = tid & 31; U.L.hi = (tid >> 5) & 1; U.L.wid = F.wave;
    U.q = 64 * i + 8 * F.wave + (U.L.r32 >> 2); U.head = 4 * kvh + (U.L.r32 & 3); U.mrow = (size_t)b * SEQ + U.q; return U;
}
__device__ __forceinline__ void branch_finish(LAS float* wsf, const att::f32x16& ol, const float (&extra)[4], float rowscale, bool has_scale, const att::f32x16 (&o)[2], att::f32x16 (&acc)[2], const att::Lane& L, bool first) {
    float sc[16];
    if (has_scale) att::rows_to_regs(wsf, rowscale, L.r32, L.hi, sc);
#pragma unroll
    for (int r = 0; r < 16; ++r) { const float lf = ol[r] + extra[r & 3]; const float inv = lf > 0.f ? __builtin_amdgcn_rcpf(lf) : 0.f; sc[r] = has_scale ? sc[r] * inv : inv; }
#pragma unroll
    for (int d0 = 0; d0 < 2; ++d0)
#pragma unroll
        for (int r = 0; r < 16; ++r) acc[d0][r] = first ? o[d0][r] * sc[r] : acc[d0][r] + o[d0][r] * sc[r];
}
__device__ __forceinline__ void branch_finish_lds(LAS float* wsf, LAS float* accw, const att::f32x16& ol, float rowscale, const att::f32x16 (&o)[2], const att::Lane& L, bool first) {
    float sc[16]; att::rows_to_regs(wsf, rowscale, L.r32, L.hi, sc);
#pragma unroll
    for (int r = 0; r < 16; ++r) sc[r] = ol[r] > 0.f ? sc[r] * __builtin_amdgcn_rcpf(ol[r]) : 0.f;
#pragma unroll
    for (int d0 = 0; d0 < 2; ++d0)
#pragma unroll
        for (int r = 0; r < 16; ++r) { float v = o[d0][r] * sc[r]; if (!first) v += accw[(d0 * 16 + r) * 64 + L.lane]; accw[(d0 * 16 + r) * 64 + L.lane] = v; }
}
__device__ __forceinline__ float gain_bound(const float* g, int lane) { return wave_max(fabsf(g[lane])); }

template <int KIND  >
__device__ __forceinline__ void simple_unit(Frame& F, int l, int b, int kvh, int i, bf16* odst = nullptr) {
    using namespace att;
    const UnitGeom U = unit_geom(F, b, kvh, i); const Lane& L = U.L;
    constexpr int QT = KIND == 0 ? 1 : 0, KT = KIND == 0 ? 1 : 0, NM = KIND == 0 ? 1 : 0;
    bf16* Q = (bf16*)(F.ws + WS_ZQ) + (size_t)QT * M * 512; const bf16* KV = (const bf16*)(F.ws + WS_ZKV) + (size_t)KT * M * 256;
    bf16x8 qr[4]; load_q(Q + U.mrow * 512 + U.head * 64, L.hi, qr);
    const float C = 0.f; (void)NM;
    KVSrc S{(const GAS bf16*)(KV + (size_t)b * SEQ * 256 + kvh * 64), (const GAS bf16*)(KV + (size_t)b * SEQ * 256 + 128 + kvh * 64), 256, SEQ};
    f32x16 ol, o[2];
#pragma unroll
    for (int r = 0; r < 16; ++r) { o[0][r] = 0.f; o[1][r] = 0.f; ol[r] = 0.f; }
    const int q = U.q;
    if (KIND == 0) {
        auto mf = [q](int t) -> u64 { return mask_le(q - 64 * t) & mask_ge(q - 127 - 64 * t); };
        attend_range((LAS char*)F.lds, S, i - 2 < 0 ? 0 : i - 2, i + 1, mf, qr, -C, ol, o, L);
    } else {
        LAS char* mrows = (LAS char*)F.lds + L_OST + L.wid * 8192 + 4096;
        { const GAS u32x4* src = (const GAS u32x4*)((const GAS u64*)(F.ws + WS_BM) + ((size_t)b * SEQ + 64 * i + 8 * L.wid) * 64);
#pragma unroll
          for (int k = 0; k < 4; ++k) *(LAS u32x4*)(mrows + (k * 64 + L.lane) * 16) = src[k * 64 + L.lane];
          WAVE_LDS_FENCE(); }
        LAS const char* mrow = mrows + (L.r32 >> 2) * 512;
        auto mf = [mrow](int t) -> u64 { return *(LAS const u64*)(mrow + t * 8); };
#ifdef PROBE_TILES
        attend_range((LAS char*)F.lds, S, 0, odst ? (i + 1 < PROBE_TILES ? i + 1 : PROBE_TILES) : i + 1, mf, qr, -C, ol, o, L, odst != nullptr);
#else
        attend_range((LAS char*)F.lds, S, 0, i + 1, mf, qr, -C, ol, o, L, odst != nullptr);
#endif
    }
    const UnitGeom V = unit_geom(F, b, kvh, i); const Lane& L2 = V.L;
    float extra[4] = {0.f, 0.f, 0.f, 0.f};
    if (KIND == 0) {
#pragma unroll
        for (int g = 0; g < 4; ++g) extra[g] = __builtin_amdgcn_exp2f(F.a->in[5][l * 8 + 4 * kvh + g] * LOG2E);
    }
    f32x16 acc[2];
    branch_finish((LAS float*)((LAS char*)F.lds + L_WSF) + L2.wid * WSF_W, ol, extra, 1.f, false, o, acc, L2, true);
    bf16* Q2 = (bf16*)(F.ws + WS_ZQ) + (size_t)QT * M * 512;
    const size_t tok0 = (size_t)b * SEQ + 64 * i + 8 * L2.wid; const int kvh4 = 4 * kvh;
    bf16* Od = odst ? odst : Q2;
    auto rowptr = [Od, tok0, kvh4](int row) -> bf16* { return Od + (tok0 + (row >> 2)) * 512 + (kvh4 + (row & 3)) * 64; };
    store_o((LAS char*)F.lds + L_OST + L2.wid * 8192, acc, rowptr, L2.lane, L2.r32, L2.hi);
}
__device__ __forceinline__ void nsa_unit(Frame& F, int l, int b, int kvh, int i, bf16* odst = nullptr) {
    using namespace att;
    f32x16 o[2], ol;
    bf16x8 qr[4];
    {
        const UnitGeom U = unit_geom(F, b, kvh, i); const Lane& L = U.L;
        const bf16* Q = (const bf16*)(F.ws + WS_ZQ) + (size_t)2 * M * 512; const bf16* MISC = (const bf16*)(F.ws + WS_ZKV) + (size_t)6 * M * 256;
        load_q(Q + U.mrow * 512 + U.head * 64, L.hi, qr);
        LAS float* wsf = (LAS float*)((LAS char*)F.lds + L_WSF) + L.wid * WSF_W;
#pragma unroll
        for (int br = 0; br < 3; ++br) wsf[64 + br * 64 + L.lane] = pg8::sigmoidf_(bf2f(((const GAS bf16*)MISC)[U.mrow * 256 + 68 + U.head * 3 + br]));
        WAVE_LDS_FENCE();
    }
    const float Ck = 0.f, Cc = 0.f;
    const int qmax = 64 * i + 63; const int nvmax = qmax >= 31 ? (((qmax - 31) >> 4) + 1 < 255 ? ((qmax - 31) >> 4) + 1 : 255) : 0;
    const int tc = (nvmax + 63) >> 6;
    const bf16* kcmp = (const bf16*)(F.ws + WS_KCMP) + (size_t)((0 * 4 + b) * 2 + kvh) * 256 * 64; const bf16* vcmp = (const bf16*)(F.ws + WS_KCMP) + (size_t)((1 * 4 + b) * 2 + kvh) * 256 * 64;
    {
        const UnitGeom U = unit_geom(F, b, kvh, i); const Lane& L = U.L; const int q = U.q;
        const int nval = q >= 31 ? (((q - 31) >> 4) + 1 < 255 ? ((q - 31) >> 4) + 1 : 255) : 0;
        KVSrc Sc{(const GAS bf16*)kcmp, (const GAS bf16*)vcmp, 64, 256};
        auto mfc = [nval](int t) -> u64 { return mask_le(nval - 1 - 64 * t); };
#pragma unroll
        for (int r = 0; r < 16; ++r) { o[0][r] = 0.f; o[1][r] = 0.f; ol[r] = 0.f; }
        attend_range((LAS char*)F.lds, Sc, 0, tc, mfc, qr, -Cc, ol, o, L);
    }
    const UnitGeom U = unit_geom(F, b, kvh, i); const Lane& L = U.L; const int q = U.q;
    LAS float* wsf = (LAS float*)((LAS char*)F.lds + L_WSF) + L.wid * WSF_W;
    LAS float* accw = (LAS float*)((LAS char*)F.lds + L_OST + L.wid * 8192);
    const int nval = q >= 31 ? (((q - 31) >> 4) + 1 < 255 ? ((q - 31) >> 4) + 1 : 255) : 0;
    auto mfc = [nval](int t) -> u64 { return mask_le(nval - 1 - 64 * t); };
    WAVE_LDS_FENCE();
    if (L.r32 == 0) {
#pragma unroll
        for (int r = 0; r < 16; ++r) wsf[32 + crow(r, L.hi)] = ol[r]; }
    WAVE_LDS_FENCE();
    const float lc = wsf[32 + L.r32]; const float rlc = lc > 0.f ? __builtin_amdgcn_rcpf(lc) : 0.f;
    branch_finish_lds(wsf, accw, ol, wsf[64 + L.lane], o, L, true);
    LAS float* impw = (LAS float*)((LAS char*)F.lds + L_IMP) + L.wid * 512;
#pragma unroll
    for (int k = 0; k < 8; ++k) impw[L.lane + 64 * k] = 0.f;
    WAVE_LDS_FENCE();
    for (int t = 0; t < tc; ++t) {
        f32x16 p0, p1;
#pragma unroll
        for (int r = 0; r < 16; ++r) { p0[r] = 0.f; p1[r] = 0.f; }
        qk_tile((LAS char*)F.lds + L_K0 + t * 8320, qr, p0, p1, L.r32, L.hi);
        const u64 mk = mfc(t); const unsigned m0 = (unsigned)(mk >> (4 * L.hi)), m1 = (unsigned)(mk >> (32 + 4 * L.hi));
        const int qloc = L.r32 >> 2; const bool wr = (L.r32 & 3) == 0;
#pragma unroll
        for (int half = 0; half < 2; ++half)
#pragma unroll
            for (int m = 0; m < 4; ++m) {
                float e[4];
#pragma unroll
                for (int k = 0; k < 4; ++k) { const int r = 4 * m + k, bit = k + 8 * m; const float x = half ? p1[r] : p0[r]; const unsigned mm = half ? m1 : m0;
                    e[k] = ((mm >> bit) & 1u) ? __builtin_amdgcn_exp2f(x) * rlc : 0.f; }
                const float core = dpp_quad_sum((e[0] + e[1]) + (e[2] + e[3])), edge = dpp_quad_sum(e[3]);
                const int j = 16 * t + 8 * half + 2 * m + L.hi;
                if (wr) { impw[qloc * 64 + j] += core; }
                WAVE_LDS_FENCE();
                if (wr && j + 1 < 64) { impw[qloc * 64 + j + 1] += edge; }
                WAVE_LDS_FENCE();
            }
    }
    __syncthreads();
    {
        const int qloc = L.lane >> 3, sub = L.lane & 7; const int cur = i;
        u64 keys[8];
#pragma unroll
        for (int k = 0; k < 8; ++k) { const int j = sub + 8 * k; float v = impw[qloc * 64 + j];
            if (j == 0 || j == cur || j == cur - 1) v = 1e9f;
            if (j > cur) v = -1e30f;
            keys[k] = ((u64)f2key(v) << 32) | (u64)(63 - j); }
        u64 selm = 0ull; unsigned used = 0u;
#pragma unroll 1
        for (int it = 0; it < 16; ++it) {
            u64 best = 0ull;
#pragma unroll
            for (int k = 0; k < 8; ++k) { const u64 c = ((used >> k) & 1u) ? 0ull : keys[k]; best = c > best ? c : best; }
#pragma unroll
            for (int o2 = 1; o2 < 8; o2 <<= 1) { const unsigned lo = __shfl_xor((unsigned)best, o2), hi2 = __shfl_xor((unsigned)(best >> 32), o2); const u64 ob = ((u64)hi2 << 32) | lo; best = ob > best ? ob : best; }
            const int jsel = 63 - (int)(best & 63ull);
            if ((jsel & 7) == sub) used |= 1u << (jsel >> 3);
            selm |= 1ull << jsel;
        }
        LAS u64* selw = (LAS u64*)((LAS char*)F.lds + L_SEL) + L.wid * 8;
        if (sub == 0) selw[qloc] = selm;
        WAVE_LDS_FENCE();
    }
    {
        const UnitGeom X = unit_geom(F, b, kvh, i); const Lane& L = X.L; const int q = X.q;
        const u64 sel = ((LAS const u64*)((LAS char*)F.lds + L_SEL))[L.wid * 8 + (L.r32 >> 2)];
        const bf16* KV = (const bf16*)(F.ws + WS_ZKV) + (size_t)3 * M * 256;
        KVSrc S{(const GAS bf16*)(KV + (size_t)b * SEQ * 256 + kvh * 64), (const GAS bf16*)(KV + (size_t)b * SEQ * 256 + 128 + kvh * 64), 256, SEQ};
        auto mf = [sel, q](int t) -> u64 { return ((sel >> t) & 1ull) ? mask_le(q - 64 * t) : 0ull; };
#pragma unroll
        for (int r = 0; r < 16; ++r) { o[0][r] = 0.f; o[1][r] = 0.f; ol[r] = 0.f; }
        attend_range((LAS char*)F.lds, S, 0, i + 1, mf, qr, -Ck, ol, o, L);
        const UnitGeom W = unit_geom(F, b, kvh, i); LAS float* wsf2 = (LAS float*)((LAS char*)F.lds + L_WSF) + W.L.wid * WSF_W;
        branch_finish_lds(wsf2, (LAS float*)((LAS char*)F.lds + L_OST + W.L.wid * 8192), ol, wsf2[128 + W.L.lane], o, W.L, false);
    }
    {
        const UnitGeom X = unit_geom(F, b, kvh, i); const Lane& L = X.L; const int q = X.q;
        const bf16* KV = (const bf16*)(F.ws + WS_ZKV) + (size_t)4 * M * 256;
        KVSrc S{(const GAS bf16*)(KV + (size_t)b * SEQ * 256 + kvh * 64), (const GAS bf16*)(KV + (size_t)b * SEQ * 256 + 128 + kvh * 64), 256, SEQ};
        auto mf = [q](int t) -> u64 { return mask_le(q - 64 * t) & mask_ge(q - 511 - 64 * t); };
#pragma unroll
        for (int r = 0; r < 16; ++r) { o[0][r] = 0.f; o[1][r] = 0.f; ol[r] = 0.f; }
        attend_range((LAS char*)F.lds, S, i - 8 < 0 ? 0 : i - 8, i + 1, mf, qr, -Ck, ol, o, L);
        const UnitGeom W = unit_geom(F, b, kvh, i); LAS float* wsf2 = (LAS float*)((LAS char*)F.lds + L_WSF) + W.L.wid * WSF_W;
        branch_finish_lds(wsf2, (LAS float*)((LAS char*)F.lds + L_OST + W.L.wid * 8192), ol, wsf2[192 + W.L.lane], o, W.L, false);
    }
    {
        const UnitGeom X = unit_geom(F, b, kvh, i); const Lane& L = X.L;
        LAS float* accw2 = (LAS float*)((LAS char*)F.lds + L_OST + L.wid * 8192);
        const size_t tok0 = (size_t)b * SEQ + 64 * i + 8 * L.wid; const int kvh4 = 4 * kvh;
        bf16* Od = odst ? odst : (bf16*)(F.ws + WS_ZQ) + (size_t)2 * M * 512;
        auto rowptr = [Od, tok0, kvh4](int row) -> bf16* { return Od + (tok0 + (row >> 2)) * 512 + (kvh4 + (row & 3)) * 64; };
        f32x16 acc[2];
#pragma unroll
        for (int d0 = 0; d0 < 2; ++d0)
#pragma unroll
            for (int r = 0; r < 16; ++r) acc[d0][r] = accw2[(d0 * 16 + r) * 64 + L.lane];
        WAVE_LDS_FENCE();
        store_o((LAS char*)F.lds + L_OST + L.wid * 8192, acc, rowptr, L.lane, L.r32, L.hi);
    }
}

__global__ void __launch_bounds__(NWAVES * 64, 2) mk_fwd(Args args) {
    extern __shared__ __attribute__((aligned(16))) unsigned char lds_raw[];
    LAS unsigned char* lds = (LAS unsigned char*)lds_raw;
    volatile LAS unsigned* MISCW = (volatile LAS unsigned*)(lds + LDS_UNIT + 16);
    if (threadIdx.x < 8) MISCW[threadIdx.x] = 0u;
    __syncthreads();
    (void)xcd_barrier_post((unsigned*)((gu32*)(args.ws + WS_CTL) + CW_BAR), MISCW);
#define GRID_BARRIER() do { unsigned char* wsb_ = args.ws; asm volatile("" : "+s"(wsb_)); XcdBarrier bar_; bar_.bar = (unsigned*)((gu32*)(wsb_ + WS_CTL) + CW_BAR); bar_.x = xb_xcc_id(); \
    bar_.st = (volatile LAS unsigned*)(lds + LDS_UNIT + 16); xcd_barrier(bar_); } while (0)
#define MKFRAME() Frame F; { unsigned char* ws_ = args.ws; asm volatile("" : "+s"(ws_)); int tid_ = threadIdx.x; asm volatile("" : "+v"(tid_)); \
    F.lds = lds; F.tid = tid_; F.lane = tid_ & 63; F.wave = __builtin_amdgcn_readfirstlane(tid_ >> 6); F.G = gridDim.x; F.gw = 0; F.NGW = F.G * NWAVES; \
    F.ws = ws_; F.ctl = (gu32*)(ws_ + WS_CTL); F.a = &args; } int bid = blockIdx.x; asm volatile("" : "+s"(bid)); F.gw = bid * NWAVES + F.wave; \
    unsigned char* ws = F.ws; bf16* XB = (bf16*)(ws + WS_XB); bf16* MB = (bf16*)(ws + WS_MB); bf16* ZQ = (bf16*)(ws + WS_ZQ); bf16* ZKV = (bf16*)(ws + WS_ZKV); bf16* YS = (bf16*)(ws + WS_YS); bf16* HM = (bf16*)(ws + WS_HMID); \
    float* SSQ = (float*)(ws + WS_SSQ); (void)XB; (void)MB; (void)ZQ; (void)ZKV; (void)YS; (void)HM; (void)SSQ;
#define WL(l) (ws + WS_W + (size_t)(l) * W_LAYER)
#ifdef PROBE_T
#define STAMP(k) do { if (blockIdx.x == 0 && threadIdx.x == 0) ((unsigned long long*)(args.ws + WS_CTL + 96 * 1024))[k] = __builtin_amdgcn_s_memrealtime(); } while (0)
#else
#define STAMP(k) do { } while (0)
#endif

    STAMP(0);
#ifndef NO_P0
    { MKFRAME(); p0_prologue(F); }
#ifdef DBL_P0
    { MKFRAME(); p0_prologue(F); }
#endif
#endif
    GRID_BARRIER();
    STAMP(1);
#pragma unroll 1
    for (int l = 0; l < DEPTH; ++l) {
#ifndef NO_G1
#ifdef DBL_G1
        for (int rep_ = 0; rep_ < 2; ++rep_)
#endif
        {
            MKFRAME(); unsigned char* wl = WL(l);
            pg8::Gemm g{XB, (const bf16*)(wl + W_IN), M, 3328, DM}; pg8::StaticOrder S; S.init(M, 3328, F.G, bid);
            pg8::EpiG1 E{ZQ, ZKV, SSQ};
            pg8::gemm_phase<pg8::EpiG1, pg8::StaticOrder, true, true>(F.lds, g, S, E);
        }
#endif
        GRID_BARRIER();
        STAMP(2 + 8 * l);
#ifndef NO_POST
        { MKFRAME(); post_phase(F, l); }
#ifdef DBL_POST
        { MKFRAME(); post_phase(F, l, true); }
#endif
#endif
        GRID_BARRIER();
        STAMP(3 + 8 * l);
#ifdef DBL_ATT1
        for (int rep1_ = 0; rep1_ < 2; ++rep1_)
#else
        const int rep1_ = 0;
#endif
        {
            MKFRAME();
            const int xcd = (int)(xb_xcc_id() & 7u);
#pragma unroll 1
            for (int qi = 0; qi < 8; ++qi) {
                const int x = (xcd + qi) & 7, b = x >> 1, sub = x & 1;
                gu32* ctr = F.ctl + CW_Q + 64 * ((2 * l + 4 * rep1_) * 8 + x);
                for (;;) { const int v = next_unit(F, ctr); if (v >= 16 + 256 + 64) break;
#ifdef DBL_ATT1
                    if (v < 16) { if (rep1_ == 0 || DBL_ATT1 == 1 || DBL_ATT1 == 2) compress_unit(F, l, (v & 1) | (sub << 1) | (b << 2) | ((v >> 1) << 4)); }
                    else if (v < 16 + 256) { if (rep1_ == 0 || DBL_ATT1 == 1 || DBL_ATT1 == 3 || DBL_ATT1 >= 5) select_unit(F, b, 2 * (255 - (v - 16)) + sub, rep1_ ? (DBL_ATT1 >= 5 ? DBL_ATT1 - 4 : 0) : 0  ); }
                    else if (rep1_ && DBL_ATT1 != 1 && DBL_ATT1 != 4) { }
#else
                    if (v < 16) { compress_unit(F, l, (v & 1) | (sub << 1) | (b << 2) | ((v >> 1) << 4)); }
                    else if (v < 16 + 256) { select_unit(F, b, 2 * (255 - (v - 16)) + sub); }
#endif
                    else { simple_unit<0>(F, l, b, sub, 63 - (v - 272), rep1_ ? (bf16*)(ws + WS_MB + 8 * MiB) : nullptr); }
                }
            }
        }
        GRID_BARRIER();
        STAMP(4 + 8 * l);
#ifdef DBL_ATT2
        for (int rep_ = 0; rep_ < 2; ++rep_)
#else
        const int rep_ = 0;
#endif
        {
            MKFRAME();
            bf16* od = rep_ ? (bf16*)(ws + WS_MB) : nullptr;
            const int xcd = (int)(xb_xcc_id() & 7u);
#pragma unroll 1
            for (int qi = 0; qi < 8; ++qi) {
                const int x = (xcd + qi) & 7, b = x >> 1, kvh = x & 1;
                gu32* ctr = F.ctl + CW_Q + 64 * ((2 * l + 1 + 4 * rep_) * 8 + x);
                for (;;) { const int v = next_unit(F, ctr); if (v >= 128) break;
                    const int i = 63 - (v >> 1);
#ifdef DBL_ATT2
                    if ((v & 1) && (rep_ == 0 || DBL_ATT2 != 3)) simple_unit<1>(F, l, b, kvh, i, od);
                    if (!(v & 1) && (rep_ == 0 || DBL_ATT2 != 2)) nsa_unit(F, l, b, kvh, i, od);
#else
                    if (v & 1) simple_unit<1>(F, l, b, kvh, i, od); else nsa_unit(F, l, b, kvh, i, od);
#endif
                }
            }
        }
        GRID_BARRIER();
        STAMP(5 + 8 * l);
#ifndef NO_G2
#ifdef DBL_G2
        for (int rep_ = 0; rep_ < 2; ++rep_)
#endif
#pragma unroll 1
        for (int n = 0; n < 3; ++n) {
            MKFRAME(); unsigned char* wl = WL(l);
#ifndef NO_G2A
            { pg8::Gemm g{ZQ + (size_t)n * M * 512, (const bf16*)(wl + W_BR) + (size_t)n * DM * 512, M, DM, 512}; pg8::StaticOrder S; S.init(M, DM, F.G, bid);
              pg8::EpiStash E{YS}; pg8::gemm_phase<pg8::EpiStash, pg8::StaticOrder, false, true>(F.lds, g, S, E); }
#endif
#ifndef NO_G2B
            { pg8::Gemm g{XB, (const bf16*)(wl + W_G) + (size_t)n * DM * DM, M, DM, DM}; pg8::StaticOrder S; S.init(M, DM, F.G, bid);
              pg8::EpiGate E{YS, MB, SSQ, n == 0 ? 1 : 0}; pg8::gemm_phase<pg8::EpiGate, pg8::StaticOrder, false, true>(F.lds, g, S, E); }
#endif
        }
#endif
        GRID_BARRIER();
        STAMP(6 + 8 * l);
#ifndef NO_G3
        {
            MKFRAME(); unsigned char* wl = WL(l);
            pg8::Gemm g{MB, (const bf16*)(wl + W_OUT), M, DM, DM}; pg8::StaticOrder S; S.init(M, DM, F.G, bid);
            pg8::EpiRes E{l == 0 ? F.a->in[0] : (const float*)F.a->out, F.a->out, XB, SSQ};
            pg8::gemm_phase<pg8::EpiRes, pg8::StaticOrder, false, true>(F.lds, g, S, E);
        }
#ifdef DBL_G3
        {   MKFRAME(); unsigned char* wl = WL(l);
            pg8::Gemm g{MB, (const bf16*)(wl + W_OUT), M, DM, DM}; pg8::StaticOrder S; S.init(M, DM, F.G, bid);
            pg8::EpiRes E{F.a->in[0], (float*)(ws + 0), (bf16*)(ws + 64 * MiB), (float*)(ws + 96 * MiB)};
            pg8::gemm_phase<pg8::EpiRes, pg8::StaticOrder, false, true>(F.lds, g, S, E);
        }
#endif
#endif
        GRID_BARRIER();
        STAMP(7 + 8 * l);
#ifndef NO_G4
#ifdef DBL_G4
        for (int rep_ = 0; rep_ < 2; ++rep_)
#endif
        {
            MKFRAME(); unsigned char* wl = WL(l);
            pg8::Gemm g{XB, (const bf16*)(wl + W_UP), M, DFF, DM}; pg8::StaticOrder S; S.init(M, DFF, F.G, bid);
            pg8::EpiG4 E{HM, SSQ};
            pg8::gemm_phase<pg8::EpiG4, pg8::StaticOrder, true, true>(F.lds, g, S, E);
        }
#endif
        GRID_BARRIER();
        STAMP(8 + 8 * l);
#ifndef NO_G5
        {
            MKFRAME(); unsigned char* wl = WL(l);
            pg8::Gemm g{HM, (const bf16*)(wl + W_DN), M, DM, DFF}; pg8::StaticOrder S; S.init(M, DM, F.G, bid);
            pg8::EpiRes E{(const float*)F.a->out, F.a->out, XB, SSQ};
            pg8::gemm_phase<pg8::EpiRes, pg8::StaticOrder, false, true>(F.lds, g, S, E);
        }
#ifdef DBL_G5
        {   MKFRAME(); unsigned char* wl = WL(l);
            pg8::Gemm g{HM, (const bf16*)(wl + W_DN), M, DM, DFF}; pg8::StaticOrder S; S.init(M, DM, F.G, bid);
            pg8::EpiNull E{};
            pg8::gemm_phase<pg8::EpiNull, pg8::StaticOrder, false, true>(F.lds, g, S, E);
        }
#endif
#endif
#ifdef PROBE_T
        GRID_BARRIER();
        STAMP(9 + 8 * l);
#else
        if (l + 1 < DEPTH) GRID_BARRIER();
#endif
#ifdef DBL_BAR
        for (int rep_ = 0; rep_ < 16; ++rep_) GRID_BARRIER();
#endif
    }
#ifdef PROBE_T
    {
        GRID_BARRIER();
        const unsigned long long* st = (const unsigned long long*)(args.ws + WS_CTL + 96 * 1024);
        float tus;
        if (PROBE_T == 0) tus = (float)(st[1] - st[0]) * 0.01f;
        else tus = 0.5f * ((float)(st[PROBE_T + 1] - st[PROBE_T]) + (float)(st[PROBE_T + 9] - st[PROBE_T + 8])) * 0.01f;
        const float sc = 1.0f + tus * 0.001f;
        float* o = args.out;
        for (size_t i = (size_t)blockIdx.x * 512 + threadIdx.x; i < (size_t)M * DM; i += (size_t)gridDim.x * 512) o[i] *= sc;
    }
#endif
}

extern "C" void kernel_launch(void* const* d_in, const int* in_sizes, int n_in, void* d_out, int out_size, void* d_ws, size_t ws_size, hipStream_t stream) {
    static int grid = 0;
    if (grid == 0) {
        if (n_in != 17 || out_size != M * DM || ws_size < WS_END) { fprintf(stderr, "kernel_launch: unexpected problem shape (n_in %d out %d ws %zu)\n", n_in, out_size, ws_size); grid = -1; return; }
        int dev = 0, cus = 0, per_cu = 0;
        if (hipGetDevice(&dev) != hipSuccess || hipDeviceGetAttribute(&cus, hipDeviceAttributeMultiprocessorCount, dev) != hipSuccess) { grid = -1; return; }
        if (hipFuncSetAttribute((const void*)mk_fwd, hipFuncAttributeMaxDynamicSharedMemorySize, LDS_BYTES) != hipSuccess) { fprintf(stderr, "kernel_launch: hipFuncSetAttribute failed\n"); grid = -1; return; }
        if (hipOccupancyMaxActiveBlocksPerMultiprocessor(&per_cu, (const void*)mk_fwd, NWAVES * 64, LDS_BYTES) != hipSuccess || per_cu < 1) { fprintf(stderr, "kernel_launch: occupancy query says %d blocks/CU\n", per_cu); }
        (void)hipGetLastError();
        if (cus != 256) { fprintf(stderr, "kernel_launch: built for a 256-CU device (one 256x256 GEMM unit per workgroup in the N=1024 phases), found %d CUs\n", cus); grid = -1; return; }
        grid = cus;
    }
    if (grid < 0) return;
    (void)hipMemsetAsync((char*)d_ws + WS_CTL, 0, CTL_BYTES, stream);
    Args a{};
    for (int i = 0; i < 17; ++i) a.in[i] = (const float*)d_in[i];
    a.out = (float*)d_out; a.ws = (unsigned char*)d_ws;
    hipLaunchKernelGGL(mk_fwd, dim3(grid), dim3(NWAVES * 64), LDS_BYTES, stream, a);
}
```

```cpp
#include <hip/hip_runtime.h>
#include <cstdio>
#include <cstdint>

namespace pg8 {
#define PG8_LAS __attribute__((address_space(3)))
typedef unsigned short bf16_t;
typedef short bf16x8 __attribute__((ext_vector_type(8)));
typedef float f32x4 __attribute__((ext_vector_type(4)));
typedef unsigned u32x4 __attribute__((ext_vector_type(4)));
constexpr int BM = 256, BK = 64, HALF = 128, HTB = HALF * BK * 2  , STAGE_BYTES = 8 * HTB, NXCD = 8, WGM = 8;

__host__ __device__ __forceinline__ int lds_byte(int r, int c) { const int st = (r >> 4) * 2 + (c >> 5), rr = r & 15, cc = c & 31, ob = rr * 64 + cc * 2; return st * 1024 + (ob ^ (((ob >> 9) & 1) << 5)); }
__host__ __device__ __forceinline__ void stage_rc(int b, int& R, int& C) { const int st = b / 1024, sb = b % 1024, swz = sb ^ (((sb >> 9) & 1) << 5); R = (st >> 1) * 16 + swz / 64; C = (st & 1) * 32 + (swz % 64) / 2; }
__host__ __device__ __forceinline__ int perm32(int rho) { const int n = rho >> 4, i = rho & 15; return 8 * (i >> 2) + 4 * n + (i & 3); }

struct Unit { int pm, pn; };
struct Gemm { const bf16_t* A; const bf16_t* Bt; int M, N, K; };

struct StaticOrder {
    int nM, nN, nwg, G, c;
    __host__ __device__ void init(int M, int N, int G_, int c_) { nM = M / BM; nN = N / BM; nwg = nM * nN; G = G_; c = c_; }
    __host__ __device__ bool next(int i, Unit& u) const {
        const long L = (long)i * G + c; if (L >= nwg) return false;
        int wgid = (int)L; { const int q = nwg / NXCD, r = nwg % NXCD, xcd = wgid % NXCD, off = wgid / NXCD; wgid = (xcd < r ? xcd * (q + 1) : r * (q + 1) + (xcd - r) * q) + off; }
        const int nig = WGM * nN, gid = wgid / nig, fm = gid * WGM, gsz = (nM - fm) < WGM ? (nM - fm) : WGM;
        u.pm = fm + ((wgid % nig) % gsz); u.pn = (wgid % nig) / gsz; return true;
    }
    __device__ __forceinline__ void a_ready(const Unit&) const {}
    __device__ __forceinline__ void done(const Unit&) const {}
};

__device__ __forceinline__ unsigned cvt_pk_bf16(float lo, float hi) { unsigned r; asm volatile("v_cvt_pk_bf16_f32 %0, %1, %2" : "=v"(r) : "v"(lo), "v"(hi)); return r; }
template <class Epi, class Sched, bool ALIGN_EPI = false, bool SP2 = false>
__device__ __forceinline__ void gemm_phase(PG8_LAS unsigned char* lds, const Gemm g, const Sched& S, const Epi& E) {
    int tid_l = threadIdx.x; asm volatile("" : "+v"(tid_l));
    const int tid = tid_l, wid = __builtin_amdgcn_readfirstlane(tid >> 6), lane = tid & 63, wr = wid >> 2, wc = wid & 3, fr = lane & 15, fq = lane >> 4;
    const int K = g.K, nt = K / BK;
    unsigned voffA[2], voffB[2];
#pragma unroll
    for (int i = 0; i < 2; ++i) { int R, C; stage_rc(tid * 16 + i * 8192, R, C); const int Rb = Epi::PERM ? ((R & ~31) + perm32(R & 31)) : R;
        voffA[i] = (unsigned)(R * K + C) * 2u; voffB[i] = (unsigned)(Rb * K + C) * 2u; }
    const size_t kstep = (size_t)(BK * 2);
    const size_t hstep = (size_t)HALF * K * 2;
    const size_t tstep = 2 * hstep;
    const unsigned ldsw = (unsigned)wid * 1024u;
    const int aoff = lds_byte(wr * 64 + fr, fq * 8), boff = lds_byte(wc * 32 + fr, fq * 8);
#define PG8_SA(b, h) (((b) * 2 + (h)) * HTB)
#define PG8_SB(b, h) ((4 + (b) * 2 + (h)) * HTB)
#define PG8_STAGE(bufoff, gbase, voff) do { _Pragma("unroll") for (int _i = 0; _i < 2; ++_i) \
        __builtin_amdgcn_global_load_lds((const unsigned*)((const char*)(gbase) + (voff)[_i]), (PG8_LAS unsigned*)(lds + (bufoff) + ldsw + _i * 8192), 16, 0, 0); } while (0)
#define PG8_LDA(dst, b, h) do { _Pragma("unroll") for (int m = 0; m < 4; ++m) _Pragma("unroll") for (int k = 0; k < 2; ++k) dst[m][k] = *(const PG8_LAS bf16x8*)(lds + PG8_SA(b, h) + aoff + m * 2048 + k * 1024); } while (0)
#define PG8_LDB(dst, b, h) do { _Pragma("unroll") for (int n = 0; n < 2; ++n) _Pragma("unroll") for (int k = 0; k < 2; ++k) dst[n][k] = *(const PG8_LAS bf16x8*)(lds + PG8_SB(b, h) + boff + n * 2048 + k * 1024); } while (0)
#define PG8_MMA(ai, bj, At, Bt) do { __builtin_amdgcn_s_setprio(1); _Pragma("unroll") for (int m = 0; m < 4; ++m) _Pragma("unroll") for (int n = 0; n < 2; ++n) _Pragma("unroll") for (int k = 0; k < 2; ++k) \
        acc[ai][bj][m][n] = __builtin_amdgcn_mfma_f32_16x16x32_bf16(Bt[n][k], At[m][k], acc[ai][bj][m][n], 0, 0, 0); __builtin_amdgcn_s_setprio(0); } while (0)
#define PG8_WAIT_V(n) asm volatile("s_waitcnt vmcnt(" #n ")" ::: "memory")
#define PG8_WAIT_L(n) asm volatile("s_waitcnt lgkmcnt(" #n ")" ::: "memory")
#define PG8_BAR __builtin_amdgcn_s_barrier()
#define PG8_SCHED __builtin_amdgcn_sched_barrier(0)
    Unit cur, nxt; int ui = 0;
    if (!S.next(0, cur)) return;
    f32x4 acc[2][2][4][2];
#pragma unroll
    for (int a = 0; a < 2; ++a)
#pragma unroll
        for (int b = 0; b < 2; ++b)
#pragma unroll
            for (int m = 0; m < 4; ++m)
#pragma unroll
                for (int n = 0; n < 2; ++n) acc[a][b][m][n] = (f32x4){0.f, 0.f, 0.f, 0.f};
    bf16x8 At[4][2], B0[2][2], B1[2][2];
    const char* cA = (const char*)g.A + (size_t)cur.pm * tstep; const char* cB = (const char*)g.Bt + (size_t)cur.pn * tstep;
    S.a_ready(cur);
    if constexpr (SP2) {
        PG8_STAGE(PG8_SB(0, 0), cB, voffB); PG8_STAGE(PG8_SB(0, 1), cB + hstep, voffB); PG8_STAGE(PG8_SA(0, 0), cA, voffA); PG8_STAGE(PG8_SA(0, 1), cA + hstep, voffA);
        if (wr == 1) PG8_BAR;
        PG8_WAIT_V(2); PG8_BAR;
        PG8_STAGE(PG8_SB(1, 0), cB + kstep, voffB); PG8_STAGE(PG8_SA(1, 0), cA + kstep, voffA); PG8_STAGE(PG8_SB(1, 1), cB + hstep + kstep, voffB);
        PG8_WAIT_V(6); PG8_BAR;
    } else {
        PG8_STAGE(PG8_SB(0, 0), cB, voffB); PG8_STAGE(PG8_SA(0, 0), cA, voffA); PG8_STAGE(PG8_SB(0, 1), cB + hstep, voffB); PG8_STAGE(PG8_SA(0, 1), cA + hstep, voffA);
        if (wr == 1) PG8_BAR;
        PG8_WAIT_V(4); PG8_BAR;
        PG8_STAGE(PG8_SB(1, 0), cB + kstep, voffB); PG8_STAGE(PG8_SA(1, 0), cA + kstep, voffA); PG8_STAGE(PG8_SB(1, 1), cB + hstep + kstep, voffB);
        PG8_WAIT_V(6); PG8_BAR;
    }
    for (;;) {
        const bool has_next = S.next(ui + 1, nxt);
        const char* nA = has_next ? (const char*)g.A + (size_t)nxt.pm * tstep : cA; const char* nB = has_next ? (const char*)g.Bt + (size_t)nxt.pn * tstep : cB;
        for (int t = 0; t < nt; t += 2) {
            const bool last = (t == nt - 2);
            const char* a1 = cA + (size_t)(t + 1) * kstep;
            const char* a2 = last ? nA : cA + (size_t)(t + 2) * kstep; const char* b2 = last ? nB : cB + (size_t)(t + 2) * kstep;
            const char* a3 = a2 + kstep; const char* b3 = b2 + kstep;
            if (last && has_next) S.a_ready(nxt);
            if constexpr (SP2) {
            PG8_LDB(B0, 0, 0); PG8_LDB(B1, 0, 1); PG8_SCHED; PG8_LDA(At, 0, 0); PG8_STAGE(PG8_SA(1, 1), a1 + hstep, voffA);
            PG8_WAIT_V(8); PG8_WAIT_L(0); PG8_BAR; PG8_MMA(0, 0, At, B0); PG8_MMA(0, 1, At, B1); PG8_BAR; PG8_SCHED;
            PG8_LDA(At, 0, 1); PG8_STAGE(PG8_SB(0, 0), b2, voffB); PG8_STAGE(PG8_SB(0, 1), b2 + hstep, voffB); PG8_STAGE(PG8_SA(0, 0), a2, voffA);
            PG8_WAIT_V(8); PG8_WAIT_L(0); PG8_BAR; PG8_MMA(1, 0, At, B0); PG8_MMA(1, 1, At, B1); PG8_BAR; PG8_SCHED;
            PG8_LDB(B0, 1, 0); PG8_LDB(B1, 1, 1); PG8_SCHED; PG8_LDA(At, 1, 0); PG8_STAGE(PG8_SA(0, 1), a2 + hstep, voffA);
            PG8_WAIT_V(8); PG8_WAIT_L(0); PG8_BAR; PG8_MMA(0, 0, At, B0); PG8_MMA(0, 1, At, B1); PG8_BAR; PG8_SCHED;
            PG8_LDA(At, 1, 1); PG8_STAGE(PG8_SB(1, 0), b3, voffB); PG8_STAGE(PG8_SB(1, 1), b3 + hstep, voffB); PG8_STAGE(PG8_SA(1, 0), a3, voffA);
            PG8_WAIT_V(8); PG8_WAIT_L(0); PG8_BAR; PG8_MMA(1, 0, At, B0); PG8_MMA(1, 1, At, B1); PG8_BAR; PG8_SCHED;
            } else {
            PG8_LDB(B0, 0, 0); PG8_SCHED; PG8_LDA(At, 0, 0); PG8_STAGE(PG8_SA(1, 1), a1 + hstep, voffA);
            PG8_WAIT_L(8); PG8_BAR; PG8_WAIT_L(0); PG8_MMA(0, 0, At, B0); PG8_BAR; PG8_SCHED;
            PG8_LDB(B1, 0, 1); PG8_STAGE(PG8_SB(0, 0), b2, voffB);
            PG8_BAR; PG8_WAIT_L(0); PG8_MMA(0, 1, At, B1); PG8_BAR;
            PG8_LDA(At, 0, 1); PG8_STAGE(PG8_SA(0, 0), a2, voffA);
            PG8_BAR; PG8_WAIT_L(0); PG8_MMA(1, 0, At, B0); PG8_BAR; PG8_SCHED;
            PG8_STAGE(PG8_SB(0, 1), b2 + hstep, voffB);
            PG8_WAIT_V(6); PG8_BAR; PG8_MMA(1, 1, At, B1); PG8_BAR;
            PG8_LDB(B0, 1, 0); PG8_SCHED; PG8_LDA(At, 1, 0); PG8_STAGE(PG8_SA(0, 1), a2 + hstep, voffA);
            PG8_WAIT_L(8); PG8_BAR; PG8_WAIT_L(0); PG8_MMA(0, 0, At, B0); PG8_BAR; PG8_SCHED;
            PG8_LDB(B1, 1, 1); PG8_STAGE(PG8_SB(1, 0), b3, voffB);
            PG8_BAR; PG8_WAIT_L(0); PG8_MMA(0, 1, At, B1); PG8_BAR;
            PG8_LDA(At, 1, 1); PG8_STAGE(PG8_SA(1, 0), a3, voffA);
            PG8_BAR; PG8_WAIT_L(0); PG8_MMA(1, 0, At, B0); PG8_BAR; PG8_SCHED;
            PG8_STAGE(PG8_SB(1, 1), b3 + hstep, voffB);
            PG8_WAIT_V(6); PG8_BAR; PG8_MMA(1, 1, At, B1); PG8_BAR;
            }
        }
        if constexpr (ALIGN_EPI) { if (wr == 0) PG8_BAR; }
        if constexpr (!Epi::AFTER_DRAIN) { E(acc, cur, wr, wc, fr, fq); S.done(cur); }
        if (!has_next) break;
#pragma unroll
        for (int a = 0; a < 2; ++a)
#pragma unroll
            for (int b = 0; b < 2; ++b)
#pragma unroll
                for (int m = 0; m < 4; ++m)
#pragma unroll
                    for (int n = 0; n < 2; ++n) acc[a][b][m][n] = (f32x4){0.f, 0.f, 0.f, 0.f};
        cur = nxt; cA = nA; cB = nB; ++ui;
        if constexpr (ALIGN_EPI) { if (wr == 1) PG8_BAR; }
    }
    PG8_WAIT_V(0);
    if constexpr (!ALIGN_EPI) { if (wr == 0) PG8_BAR; }
    PG8_BAR;
    if constexpr (Epi::AFTER_DRAIN) { E.fused(acc, cur, wr, wc, fr, fq, lds, wid, lane); S.done(cur); }
#undef PG8_SA
#undef PG8_SB
#undef PG8_STAGE
#undef PG8_LDA
#undef PG8_LDB
#undef PG8_MMA
#undef PG8_WAIT_V
#undef PG8_WAIT_L
#undef PG8_BAR
#undef PG8_SCHED
}
}

namespace pg8 {
#define PG8_GAS __attribute__((address_space(1)))
constexpr int MROWS = 16384;
__device__ __forceinline__ unsigned pk_bf16(float lo, float hi) { typedef float f2 __attribute__((ext_vector_type(2))); typedef __bf16 b2 __attribute__((ext_vector_type(2)));
    f2 v = {lo, hi}; b2 b = __builtin_convertvector(v, b2); return __builtin_bit_cast(unsigned, b); }
__device__ __forceinline__ float bf_lo(unsigned w) { return __uint_as_float(w << 16); }
__device__ __forceinline__ float bf_hi(unsigned w) { return __uint_as_float(w & 0xffff0000u); }
__device__ __forceinline__ float row_rstd(const float* ssq, int row) {
    const PG8_GAS f32x4* p = (const PG8_GAS f32x4*)(ssq + (size_t)row * 16);
    const f32x4 a = p[0], b = p[1], c = p[2], d = p[3];
    const float s = (((a[0] + a[1]) + (a[2] + a[3])) + ((b[0] + b[1]) + (b[2] + b[3]))) + (((c[0] + c[1]) + (c[2] + c[3])) + ((d[0] + d[1]) + (d[2] + d[3])));
    return rsqrtf(s * (1.0f / 1024.0f) + 1e-6f);
}
__device__ __forceinline__ float sigmoidf_(float x) { return __builtin_amdgcn_rcpf(1.0f + __builtin_amdgcn_exp2f(-1.4426950408889634f * x)); }

__device__ __forceinline__ void wave_rstd(const float* ssq, int rowbase, int lane, float (&v)[2]) {
    const PG8_GAS f32x4* p0 = (const PG8_GAS f32x4*)(ssq + (size_t)(rowbase + lane) * 16);
    const PG8_GAS f32x4* p1 = p0 + HALF * 4;
    const f32x4 a = p0[0], b = p0[1], c = p0[2], d = p0[3], e = p1[0], f = p1[1], g = p1[2], h = p1[3];
    const float s0 = (((a[0] + a[1]) + (a[2] + a[3])) + ((b[0] + b[1]) + (b[2] + b[3]))) + (((c[0] + c[1]) + (c[2] + c[3])) + ((d[0] + d[1]) + (d[2] + d[3])));
    const float s1 = (((e[0] + e[1]) + (e[2] + e[3])) + ((f[0] + f[1]) + (f[2] + f[3]))) + (((g[0] + g[1]) + (g[2] + g[3])) + ((h[0] + h[1]) + (h[2] + h[3])));
    v[0] = rsqrtf(s0 * (1.0f / 1024.0f) + 1e-6f); v[1] = rsqrtf(s1 * (1.0f / 1024.0f) + 1e-6f);
}

struct EpiG1 {
    static constexpr bool PERM = true, AFTER_DRAIN = false;
    bf16_t* zq; bf16_t* zkv; const float* ssq;
    __device__ __forceinline__ void operator()(const f32x4 (&acc)[2][2][4][2], const Unit& u, int wr, int wc, int fr, int fq) const {
        const int row0 = u.pm * BM + wr * 64 + fr;
        bf16_t* base; int ldc, colt;
        if (u.pn < 6) { base = zq + (size_t)(u.pn >> 1) * ((size_t)MROWS * 512); ldc = 512; colt = (u.pn & 1) * 256; }
        else { base = zkv + (size_t)(u.pn - 6) * ((size_t)MROWS * 256); ldc = 256; colt = 0; }
        const int col0 = colt + wc * 32 + 8 * fq;
        float rv[2]; wave_rstd(ssq, u.pm * BM + wr * 64, fq * 16 + fr, rv);
#pragma unroll
        for (int ai = 0; ai < 2; ++ai)
#pragma unroll
            for (int m = 0; m < 4; ++m) { const int row = row0 + ai * HALF + m * 16; const float rs = __shfl(rv[ai], m * 16 + fr); bf16_t* rowp = base + (size_t)row * ldc + col0;
#pragma unroll
                for (int bj = 0; bj < 2; ++bj) { const f32x4 v0 = acc[ai][bj][m][0] * rs, v1 = acc[ai][bj][m][1] * rs;
                    u32x4 w; w.x = pk_bf16(v0[0], v0[1]); w.y = pk_bf16(v0[2], v0[3]); w.z = pk_bf16(v1[0], v1[1]); w.w = pk_bf16(v1[2], v1[3]);
                    *(PG8_GAS u32x4*)(rowp + bj * HALF) = w; } }
    }
};
struct EpiG4 {
    static constexpr bool PERM = true, AFTER_DRAIN = false;
    bf16_t* h; const float* ssq;
    __device__ __forceinline__ void operator()(const f32x4 (&acc)[2][2][4][2], const Unit& u, int wr, int wc, int fr, int fq) const {
        const int row0 = u.pm * BM + wr * 64 + fr; const int col0 = u.pn * BM + wc * 32 + 8 * fq;
        float rv[2]; wave_rstd(ssq, u.pm * BM + wr * 64, fq * 16 + fr, rv);
#pragma unroll
        for (int ai = 0; ai < 2; ++ai)
#pragma unroll
            for (int m = 0; m < 4; ++m) { const int row = row0 + ai * HALF + m * 16; const float rs = __shfl(rv[ai], m * 16 + fr); bf16_t* rowp = h + (size_t)row * 4096 + col0;
#pragma unroll
                for (int bj = 0; bj < 2; ++bj) { f32x4 v0 = acc[ai][bj][m][0] * rs, v1 = acc[ai][bj][m][1] * rs;
#pragma unroll
                    for (int e = 0; e < 4; ++e) { v0[e] = fmaxf(v0[e], 0.f); v0[e] *= v0[e]; v1[e] = fmaxf(v1[e], 0.f); v1[e] *= v1[e]; }
                    u32x4 w; w.x = pk_bf16(v0[0], v0[1]); w.y = pk_bf16(v0[2], v0[3]); w.z = pk_bf16(v1[0], v1[1]); w.w = pk_bf16(v1[2], v1[3]);
                    *(PG8_GAS u32x4*)(rowp + bj * HALF) = w; } }
    }
};
struct EpiRes {
    static constexpr bool PERM = true, AFTER_DRAIN = false;
    const float* xold; float* xout; bf16_t* xb; float* ssq;
    __device__ __forceinline__ void operator()(const f32x4 (&acc)[2][2][4][2], const Unit& u, int wr, int wc, int fr, int fq) const {
        const int row0 = u.pm * BM + wr * 64 + fr; const int col0 = u.pn * BM + wc * 32 + 8 * fq;
#pragma unroll
        for (int ai = 0; ai < 2; ++ai) {
            f32x4 xo[4][2][2];
#pragma unroll
            for (int m = 0; m < 4; ++m)
#pragma unroll
                for (int bj = 0; bj < 2; ++bj) { const size_t off = (size_t)(row0 + ai * HALF + m * 16) * 1024 + col0 + bj * HALF;
                    xo[m][bj][0] = *(const PG8_GAS f32x4*)(xold + off); xo[m][bj][1] = *(const PG8_GAS f32x4*)(xold + off + 4); }
#pragma unroll
            for (int m = 0; m < 4; ++m) { const int row = row0 + ai * HALF + m * 16; float part = 0.f;
#pragma unroll
                for (int bj = 0; bj < 2; ++bj) { const size_t off = (size_t)row * 1024 + col0 + bj * HALF;
                    const f32x4 v0 = acc[ai][bj][m][0] + xo[m][bj][0], v1 = acc[ai][bj][m][1] + xo[m][bj][1];
                    *(PG8_GAS f32x4*)(xout + off) = v0; *(PG8_GAS f32x4*)(xout + off + 4) = v1;
                    u32x4 w; w.x = pk_bf16(v0[0], v0[1]); w.y = pk_bf16(v0[2], v0[3]); w.z = pk_bf16(v1[0], v1[1]); w.w = pk_bf16(v1[2], v1[3]);
                    *(PG8_GAS u32x4*)(xb + off) = w;
                    part += ((v0[0] * v0[0] + v0[1] * v0[1]) + (v0[2] * v0[2] + v0[3] * v0[3])) + ((v1[0] * v1[0] + v1[1] * v1[1]) + (v1[2] * v1[2] + v1[3] * v1[3])); }
                part += __shfl_xor(part, 16); part += __shfl_xor(part, 32);
                if (fq == 0) ((PG8_GAS float*)ssq)[(size_t)row * 16 + u.pn * 4 + wc] = part; }
            asm volatile("" ::: "memory"); }
    }
};
struct EpiStash {
    static constexpr bool PERM = true, AFTER_DRAIN = true;
    __device__ __forceinline__ void fused(f32x4 (&acc)[2][2][4][2], const Unit& u, int wr, int wc, int fr, int fq, PG8_LAS unsigned char*, int, int) const { (*this)(acc, u, wr, wc, fr, fq); }
    bf16_t* ys;
    __device__ __forceinline__ void operator()(const f32x4 (&acc)[2][2][4][2], const Unit& u, int wr, int wc, int fr, int fq) const {
        bf16_t* base = ys + (size_t)(u.pm * 4 + u.pn) * 65536; const int row0 = wr * 64 + fr, col0 = wc * 32 + 8 * fq;
#pragma unroll
        for (int ai = 0; ai < 2; ++ai)
#pragma unroll
            for (int m = 0; m < 4; ++m) { bf16_t* rowp = base + (row0 + ai * HALF + m * 16) * 256 + col0;
#pragma unroll
                for (int bj = 0; bj < 2; ++bj) { const f32x4 v0 = acc[ai][bj][m][0], v1 = acc[ai][bj][m][1];
                    u32x4 w; w.x = pk_bf16(v0[0], v0[1]); w.y = pk_bf16(v0[2], v0[3]); w.z = pk_bf16(v1[0], v1[1]); w.w = pk_bf16(v1[2], v1[3]);
                    *(PG8_GAS u32x4*)(rowp + bj * HALF) = w; } }
    }
};
struct EpiGate {
    static constexpr bool PERM = true, AFTER_DRAIN = true;
    __device__ __forceinline__ void fused(f32x4 (&acc)[2][2][4][2], const Unit& u, int wr, int wc, int fr, int fq, PG8_LAS unsigned char*, int, int) const { (*this)(acc, u, wr, wc, fr, fq); }
    const bf16_t* ys; bf16_t* mb; const float* ssq; int first;
    __device__ __forceinline__ void operator()(const f32x4 (&acc)[2][2][4][2], const Unit& u, int wr, int wc, int fr, int fq) const {
        const bf16_t* sbase = ys + (size_t)(u.pm * 4 + u.pn) * 65536; const int lrow0 = wr * 64 + fr, lcol0 = wc * 32 + 8 * fq;
        float rv[2]; wave_rstd(ssq, u.pm * BM + wr * 64, fq * 16 + fr, rv);
        const bool fst = first != 0;
#pragma unroll
        for (int ai = 0; ai < 2; ++ai)
#pragma unroll
        for (int mh = 0; mh < 2; ++mh) {
            u32x4 yv[2][2], pv[2][2];
#pragma unroll
            for (int m2 = 0; m2 < 2; ++m2)
#pragma unroll
                for (int bj = 0; bj < 2; ++bj) { const int lrow = lrow0 + ai * HALF + (mh * 2 + m2) * 16;
                    yv[m2][bj] = *(const PG8_GAS u32x4*)(sbase + lrow * 256 + lcol0 + bj * HALF);
                    pv[m2][bj] = *(const PG8_GAS u32x4*)(mb + (size_t)(u.pm * BM + lrow) * 1024 + u.pn * BM + lcol0 + bj * HALF); }
#pragma unroll
            for (int m2 = 0; m2 < 2; ++m2) { const int m = mh * 2 + m2; const int lrow = lrow0 + ai * HALF + m * 16, row = u.pm * BM + lrow; const float rs = __shfl(rv[ai], m * 16 + fr);
#pragma unroll
                for (int bj = 0; bj < 2; ++bj) { const f32x4 a0 = acc[ai][bj][m][0] * rs, a1 = acc[ai][bj][m][1] * rs;
                    const u32x4 y = yv[m2][bj], p = pv[m2][bj];
                    bf16_t* mp = mb + (size_t)row * 1024 + u.pn * BM + lcol0 + bj * HALF;
                    float r[8], q[8];
                    r[0] = sigmoidf_(a0[0]) * bf_lo(y.x); r[1] = sigmoidf_(a0[1]) * bf_hi(y.x); r[2] = sigmoidf_(a0[2]) * bf_lo(y.y); r[3] = sigmoidf_(a0[3]) * bf_hi(y.y);
                    r[4] = sigmoidf_(a1[0]) * bf_lo(y.z); r[5] = sigmoidf_(a1[1]) * bf_hi(y.z); r[6] = sigmoidf_(a1[2]) * bf_lo(y.w); r[7] = sigmoidf_(a1[3]) * bf_hi(y.w);
                    q[0] = bf_lo(p.x); q[1] = bf_hi(p.x); q[2] = bf_lo(p.y); q[3] = bf_hi(p.y); q[4] = bf_lo(p.z); q[5] = bf_hi(p.z); q[6] = bf_lo(p.w); q[7] = bf_hi(p.w);
#pragma unroll
                    for (int e = 0; e < 8; ++e) r[e] = fst ? r[e] : r[e] + q[e];
                    u32x4 w; w.x = pk_bf16(r[0], r[1]); w.y = pk_bf16(r[2], r[3]); w.z = pk_bf16(r[4], r[5]); w.w = pk_bf16(r[6], r[7]);
                    *(PG8_GAS u32x4*)mp = w; } }
            asm volatile("" ::: "memory"); }
    }
};
struct EpiNull {
    static constexpr bool PERM = true, AFTER_DRAIN = false;
    __device__ __forceinline__ void operator()(const f32x4 (&acc)[2][2][4][2], const Unit& u, int wr, int wc, int fr, int fq) const {
#pragma unroll
        for (int ai = 0; ai < 2; ++ai)
#pragma unroll
            for (int bj = 0; bj < 2; ++bj)
#pragma unroll
                for (int m = 0; m < 4; ++m) { asm volatile("" :: "v"(acc[ai][bj][m][0]), "v"(acc[ai][bj][m][1])); }
    }
};
}

namespace pg8 {
struct UnitX { int pm, pn; const char* A; const char* Bt; int K; int kind; };
template <class Prog>
__device__ __forceinline__ void gemm_chain(PG8_LAS unsigned char* lds, const Prog& P) {
    int tid_l = threadIdx.x; asm volatile("" : "+v"(tid_l));
    const int tid = tid_l, wid = __builtin_amdgcn_readfirstlane(tid >> 6), lane = tid & 63, wr = wid >> 2, wc = wid & 3, fr = lane & 15, fq = lane >> 4;
    int RA[2], RB[2], C2[2];
#pragma unroll
    for (int i = 0; i < 2; ++i) { int R, C; stage_rc(tid * 16 + i * 8192, R, C); RA[i] = R * 2; RB[i] = ((R & ~31) + perm32(R & 31)) * 2; C2[i] = C * 2; }
    const size_t kstep = (size_t)(BK * 2);
    const unsigned ldsw = (unsigned)wid * 1024u;
    const int aoff = lds_byte(wr * 64 + fr, fq * 8), boff = lds_byte(wc * 32 + fr, fq * 8);
#define PG8_SA(b, h) (((b) * 2 + (h)) * HTB)
#define PG8_SB(b, h) ((4 + (b) * 2 + (h)) * HTB)
#define PG8_STAGE(bufoff, gbase, voff) do { _Pragma("unroll") for (int _i = 0; _i < 2; ++_i) \
        __builtin_amdgcn_global_load_lds((const unsigned*)((const char*)(gbase) + (voff)[_i]), (PG8_LAS unsigned*)(lds + (bufoff) + ldsw + _i * 8192), 16, 0, 0); } while (0)
#define PG8_LDA(dst, b, h) do { _Pragma("unroll") for (int m = 0; m < 4; ++m) _Pragma("unroll") for (int k = 0; k < 2; ++k) dst[m][k] = *(const PG8_LAS bf16x8*)(lds + PG8_SA(b, h) + aoff + m * 2048 + k * 1024); } while (0)
#define PG8_LDB(dst, b, h) do { _Pragma("unroll") for (int n = 0; n < 2; ++n) _Pragma("unroll") for (int k = 0; k < 2; ++k) dst[n][k] = *(const PG8_LAS bf16x8*)(lds + PG8_SB(b, h) + boff + n * 2048 + k * 1024); } while (0)
#define PG8_MMA(ai, bj, At, Bt) do { __builtin_amdgcn_s_setprio(1); _Pragma("unroll") for (int m = 0; m < 4; ++m) _Pragma("unroll") for (int n = 0; n < 2; ++n) _Pragma("unroll") for (int k = 0; k < 2; ++k) \
        acc[ai][bj][m][n] = __builtin_amdgcn_mfma_f32_16x16x32_bf16(Bt[n][k], At[m][k], acc[ai][bj][m][n], 0, 0, 0); __builtin_amdgcn_s_setprio(0); } while (0)
#define PG8_WAIT_V(n) asm volatile("s_waitcnt vmcnt(" #n ")" ::: "memory")
#define PG8_WAIT_L(n) asm volatile("s_waitcnt lgkmcnt(" #n ")" ::: "memory")
#define PG8_BAR __builtin_amdgcn_s_barrier()
#define PG8_SCHED __builtin_amdgcn_sched_barrier(0)
    UnitX cur, nxt; int ui = 0;
    if (!P.get(0, cur)) return;
    f32x4 acc[2][2][4][2];
#pragma unroll
    for (int a = 0; a < 2; ++a)
#pragma unroll
        for (int b = 0; b < 2; ++b)
#pragma unroll
            for (int m = 0; m < 4; ++m)
#pragma unroll
                for (int n = 0; n < 2; ++n) acc[a][b][m][n] = (f32x4){0.f, 0.f, 0.f, 0.f};
    bf16x8 At[4][2], B0[2][2], B1[2][2];
    int Kc = cur.K; size_t hsc = (size_t)HALF * Kc * 2;
    const char* cA = cur.A + (size_t)cur.pm * 2 * hsc; const char* cB = cur.Bt + (size_t)cur.pn * 2 * hsc;
    unsigned vAc[2], vBc[2];
#pragma unroll
    for (int i = 0; i < 2; ++i) { vAc[i] = (unsigned)(RA[i] * Kc + C2[i]); vBc[i] = (unsigned)(RB[i] * Kc + C2[i]); }
    P.a_ready(cur);
    PG8_STAGE(PG8_SB(0, 0), cB, vBc); PG8_STAGE(PG8_SB(0, 1), cB + hsc, vBc); PG8_STAGE(PG8_SA(0, 0), cA, vAc); PG8_STAGE(PG8_SA(0, 1), cA + hsc, vAc);
    if (wr == 1) PG8_BAR;
    PG8_WAIT_V(2); PG8_BAR;
    PG8_STAGE(PG8_SB(1, 0), cB + kstep, vBc); PG8_STAGE(PG8_SA(1, 0), cA + kstep, vAc); PG8_STAGE(PG8_SB(1, 1), cB + hsc + kstep, vBc);
    PG8_WAIT_V(6); PG8_BAR;
    for (;;) {
        const bool has_next = P.get(ui + 1, nxt);
        const int Kn = has_next ? nxt.K : Kc; const size_t hsn = (size_t)HALF * Kn * 2;
        const char* nA = has_next ? nxt.A + (size_t)nxt.pm * 2 * hsn : cA; const char* nB = has_next ? nxt.Bt + (size_t)nxt.pn * 2 * hsn : cB;
        const int nt = Kc / BK;
        for (int t = 0; t < nt; t += 2) {
            const bool last = (t == nt - 2);
            const char* a1 = cA + (size_t)(t + 1) * kstep;
            const char* a2 = last ? nA : cA + (size_t)(t + 2) * kstep; const char* b2 = last ? nB : cB + (size_t)(t + 2) * kstep;
            const char* a3 = a2 + kstep; const char* b3 = b2 + kstep;
            const size_t hs2 = last ? hsn : hsc; const int K2 = last ? Kn : Kc;
            unsigned vA2[2], vB2[2];
#pragma unroll
            for (int i = 0; i < 2; ++i) { vA2[i] = (unsigned)(RA[i] * K2 + C2[i]); vB2[i] = (unsigned)(RB[i] * K2 + C2[i]); }
            if (last && has_next) P.a_ready(nxt);
            PG8_LDB(B0, 0, 0); PG8_LDB(B1, 0, 1); PG8_SCHED; PG8_LDA(At, 0, 0); PG8_STAGE(PG8_SA(1, 1), a1 + hsc, vAc);
            PG8_WAIT_V(8); PG8_WAIT_L(0); PG8_BAR; PG8_MMA(0, 0, At, B0); PG8_MMA(0, 1, At, B1); PG8_BAR; PG8_SCHED;
            PG8_LDA(At, 0, 1); PG8_STAGE(PG8_SB(0, 0), b2, vB2); PG8_STAGE(PG8_SB(0, 1), b2 + hs2, vB2); PG8_STAGE(PG8_SA(0, 0), a2, vA2);
            PG8_WAIT_V(8); PG8_WAIT_L(0); PG8_BAR; PG8_MMA(1, 0, At, B0); PG8_MMA(1, 1, At, B1); PG8_BAR; PG8_SCHED;
            PG8_LDB(B0, 1, 0); PG8_LDB(B1, 1, 1); PG8_SCHED; PG8_LDA(At, 1, 0); PG8_STAGE(PG8_SA(0, 1), a2 + hs2, vA2);
            PG8_WAIT_V(8); PG8_WAIT_L(0); PG8_BAR; PG8_MMA(0, 0, At, B0); PG8_MMA(0, 1, At, B1); PG8_BAR; PG8_SCHED;
            PG8_LDA(At, 1, 1); PG8_STAGE(PG8_SB(1, 0), b3, vB2); PG8_STAGE(PG8_SB(1, 1), b3 + hs2, vB2); PG8_STAGE(PG8_SA(1, 0), a3, vA2);
            PG8_WAIT_V(8); PG8_WAIT_L(0); PG8_BAR; PG8_MMA(1, 0, At, B0); PG8_MMA(1, 1, At, B1); PG8_BAR; PG8_SCHED;
        }
        { int fr_e = fr, fq_e = fq, wr_e = wr, wc_e = wc; asm volatile("" : "+v"(fr_e), "+v"(fq_e), "+s"(wr_e), "+s"(wc_e));
          P.epi(acc, cur, wr_e, wc_e, fr_e, fq_e); }
        if (!has_next) break;
#pragma unroll
        for (int a = 0; a < 2; ++a)
#pragma unroll
            for (int b = 0; b < 2; ++b)
#pragma unroll
                for (int m = 0; m < 4; ++m)
#pragma unroll
                    for (int n = 0; n < 2; ++n) acc[a][b][m][n] = (f32x4){0.f, 0.f, 0.f, 0.f};
        cur = nxt; cA = nA; cB = nB; Kc = Kn; hsc = hsn; ++ui;
#pragma unroll
        for (int i = 0; i < 2; ++i) { vAc[i] = (unsigned)(RA[i] * Kc + C2[i]); vBc[i] = (unsigned)(RB[i] * Kc + C2[i]); }
    }
    PG8_WAIT_V(0);
    if (wr == 0) PG8_BAR;
    PG8_BAR;
#undef PG8_SA
#undef PG8_SB
#undef PG8_STAGE
#undef PG8_LDA
#undef PG8_LDB
#undef PG8_MMA
#undef PG8_WAIT_V
#undef PG8_WAIT_L
#undef PG8_BAR
#undef PG8_SCHED
}
struct ProgG2 {
    int pm, pn; const bf16_t* zq; const bf16_t* wbr; const bf16_t* xb; const bf16_t* wg; bf16_t* ys; bf16_t* mb; const float* ssq;
    __device__ __forceinline__ bool get(int i, UnitX& u) const {
        if (i >= 6) return false;
        const int n = i >> 1; u.pm = pm; u.pn = pn; u.kind = i;
        if (i & 1) { u.A = (const char*)xb; u.Bt = (const char*)(wg + (size_t)n * 1024 * 1024); u.K = 1024; }
        else { u.A = (const char*)(zq + (size_t)n * MROWS * 512); u.Bt = (const char*)(wbr + (size_t)n * 1024 * 512); u.K = 512; }
        return true; }
    __device__ __forceinline__ void a_ready(const UnitX&) const {}
    __device__ __forceinline__ void epi(const f32x4 (&acc)[2][2][4][2], const UnitX& ux, int wr, int wc, int fr, int fq) const {
        Unit u; u.pm = ux.pm; u.pn = ux.pn;
        if (ux.kind & 1) { EpiGate E{ys, mb, ssq, ux.kind == 1 ? 1 : 0}; E(acc, u, wr, wc, fr, fq); }
        else { EpiStash E{ys}; E(acc, u, wr, wc, fr, fq); }
    }
};
}

#define GAS __attribute__((address_space(1)))
#define LAS __attribute__((address_space(3)))
typedef unsigned short bf16;
typedef unsigned v4u __attribute__((ext_vector_type(4)));
typedef float f32x4 __attribute__((ext_vector_type(4)));
typedef short bf16x8 __attribute__((ext_vector_type(8)));
typedef GAS unsigned gu32;
typedef GAS unsigned long long gu64;
#define RLX_AGENT __ATOMIC_RELAXED, __HIP_MEMORY_SCOPE_AGENT
#define LDS_WAIT() asm volatile("s_waitcnt lgkmcnt(0)" ::: "memory")
#define VM_WAIT() asm volatile("s_waitcnt vmcnt(0)" ::: "memory")
__device__ __forceinline__ unsigned long long rt() { return __builtin_amdgcn_s_memrealtime(); }
__device__ __forceinline__ unsigned f2bf(float f) { unsigned u = __builtin_bit_cast(unsigned, f); return (u + 0x7fffu + ((u >> 16) & 1u)) >> 16; }
__device__ __forceinline__ unsigned pk2(float lo, float hi) { return f2bf(lo) | (f2bf(hi) << 16); }

#define XB_TMO      128
#define XB_XCNT(j)  (256  + 64 * (j))
#define XB_XSUB(j)  (1280 + 64 * (j))
#define XB_XGEN(j)  (2304 + 64 * (j))
#define XB_TOP      3328
#define XB_TOPGEN   3392
#define XCD_BAR_WORDS 3456
#define XB_SPIN_CAP (1u << 18)

__device__ __forceinline__ unsigned xb_ld(unsigned* p)              { return __hip_atomic_load(p, __ATOMIC_RELAXED, __HIP_MEMORY_SCOPE_AGENT); }
__device__ __forceinline__ unsigned xb_add(unsigned* p, unsigned v) { return __hip_atomic_fetch_add(p, v, __ATOMIC_RELAXED, __HIP_MEMORY_SCOPE_AGENT); }
__device__ __forceinline__ unsigned xb_xcc_id() { return (unsigned)__builtin_amdgcn_s_getreg((3 << 11) | 20) & 0xFu; }
#define XB_SPIN(cond, bar) do { unsigned _sp = 0; while (cond) { __builtin_amdgcn_s_sleep(1); \
    if ((++_sp & 255u) == 0u) { if (xb_ld(&(bar)[XB_TMO])) break; if (_sp > XB_SPIN_CAP) { atomicAdd(&(bar)[XB_TMO], 1u); break; } } } } while (0)

struct XcdBarrier {
    unsigned* bar; unsigned x;
    volatile LAS unsigned* st;
};

__device__ __forceinline__ XcdBarrier xcd_barrier_post(unsigned* bar, volatile LAS unsigned* st) {
    XcdBarrier b; b.bar = bar; b.x = xb_xcc_id(); b.st = st;
    if (threadIdx.x == 0) (void)xb_add(&bar[XB_XCNT(b.x)], 1u);
    return b;
}
__device__ __forceinline__ void xcd_barrier_complete(unsigned* bar, unsigned x, unsigned& nloc, unsigned& nx) {
    const unsigned G = gridDim.x * gridDim.y * gridDim.z;
    unsigned sum, cnt, mine, sp = 0u;
    for (;;) {
        sum = 0u; cnt = 0u; mine = 0u;
#pragma unroll
        for (unsigned j = 0; j < 16; ++j) { const unsigned c = xb_ld(&bar[XB_XCNT(j)]); sum += c; cnt += (c > 0u) ? 1u : 0u; mine = (j == x) ? c : mine; }
        if (sum == G) break;
        __builtin_amdgcn_s_sleep(1);
        if ((++sp & 255u) == 0u) { if (xb_ld(&bar[XB_TMO])) break; if (sp > XB_SPIN_CAP) { atomicAdd(&bar[XB_TMO], 1u); break; } }
    }
    nloc = mine > 0u ? mine : 1u; nx = cnt > 0u ? cnt : 1u;
}

__device__ __forceinline__ void xcd_barrier(const XcdBarrier& b) {
    asm volatile("s_waitcnt vmcnt(0)" ::: "memory");
    __syncthreads();
    if (threadIdx.x == 0) {
        unsigned* bar = b.bar;
        __builtin_amdgcn_s_waitcnt(0);
        unsigned nloc = b.st[0], nx = b.st[1];
        if (nloc == 0u) { xcd_barrier_complete(bar, b.x, nloc, nx); b.st[0] = nloc; b.st[1] = nx; }
        const unsigned old = xb_add(&bar[XB_XSUB(b.x)], 1u);
        const unsigned gen = old / nloc;
        if (old + 1u == (gen + 1u) * nloc) {
            __builtin_amdgcn_fence(__ATOMIC_RELEASE, "agent");
            asm volatile("s_waitcnt vmcnt(0)" ::: "memory");
            const unsigned og = xb_add(&bar[XB_TOP], 1u);
            const unsigned tg = og / nx;
            if (og + 1u == (tg + 1u) * nx) xb_add(&bar[XB_TOPGEN], 1u);
            else XB_SPIN(xb_ld(&bar[XB_TOPGEN]) == tg, bar);
            __builtin_amdgcn_fence(__ATOMIC_ACQUIRE, "agent");
            xb_add(&bar[XB_XGEN(b.x)], 1u);
            asm volatile("s_waitcnt vmcnt(0)" ::: "memory");
        } else {
            XB_SPIN(xb_ld(&bar[XB_XGEN(b.x)]) == gen, bar);
            __builtin_amdgcn_fence(__ATOMIC_ACQUIRE, "agent");
            asm volatile("s_waitcnt vmcnt(0)" ::: "memory");
        }
    }
    __syncthreads();
}

namespace att {
typedef short bf16x8 __attribute__((ext_vector_type(8)));
typedef short s16x4 __attribute__((ext_vector_type(4)));
typedef float f32x16 __attribute__((ext_vector_type(16)));
typedef unsigned u32x4 __attribute__((ext_vector_type(4)));
typedef unsigned short bf16_t;
typedef unsigned long long u64;
constexpr int NKB = 4, NVB = 5;
constexpr int WSF_W = 320;
constexpr int L_K0 = 0, L_V0 = NKB * 8320, L_IMP = L_V0  , L_WSF = L_V0 + NVB * 8192, L_SEL = L_WSF + 8 * WSF_W * 4, L_OST = L_SEL + 512  , L_END = L_OST + 65536;
__device__ __forceinline__ int crow(int r, int hi) { return (r & 3) + 8 * (r >> 2) + 4 * hi; }
__device__ __forceinline__ unsigned pk2(float lo, float hi) { typedef float f2 __attribute__((ext_vector_type(2))); typedef __bf16 b2 __attribute__((ext_vector_type(2)));
    f2 v = {lo, hi}; b2 b = __builtin_convertvector(v, b2); return __builtin_bit_cast(unsigned, b); }
__device__ __forceinline__ s16x4 vtr(LAS const char* p) { typedef short v4i16_t __attribute__((ext_vector_type(4))); return __builtin_bit_cast(s16x4, __builtin_amdgcn_ds_read_tr16_b64_v4i16((LAS v4i16_t*)p)); }

struct KVSrc { const GAS bf16_t* k; const GAS bf16_t* v; int pitch; int nrows; };

struct Lane { int tid, lane, r32, hi, wid; };

__device__ __forceinline__ void tile_gload(const KVSrc& S, int t, int tid, u32x4& kr, u32x4& vr) {
    const int row = 64 * t + (tid >> 3), ch = tid & 7;
    kr = *(const GAS u32x4*)(S.k + (size_t)row * S.pitch + ch * 8); vr = *(const GAS u32x4*)(S.v + (size_t)row * S.pitch + ch * 8);
}
__device__ __forceinline__ void tile_lstore(LAS char* kb, LAS char* vb, int tid, const u32x4& kr, const u32x4& vr) {
    const int key = tid >> 3, ch = tid & 7;
    *(LAS u32x4*)(kb + ch * 1040 + (key >> 5) * 512 + (key & 31) * 16) = kr;
    *(LAS u32x4*)(vb + (ch >> 2) * 4096 + (key >> 4) * 1024 + ((key >> 3) & 1) * 512 + (key & 7) * 64 + (ch & 3) * 16) = vr;
}
__device__ __forceinline__ void qk_tile(LAS const char* kbuf, const bf16x8 (&qr)[4], f32x16& p0, f32x16& p1, int r32, int hi) {
    LAS const char* kb = kbuf + hi * 1040 + r32 * 16;
#pragma unroll
    for (int d0 = 0; d0 < 4; ++d0) {
        const bf16x8 b0 = *(LAS const bf16x8*)(kb + d0 * 2080);
        const bf16x8 b1 = *(LAS const bf16x8*)(kb + d0 * 2080 + 512);
        p0 = __builtin_amdgcn_mfma_f32_32x32x16_bf16(b0, qr[d0], p0, 0, 0, 0);
        p1 = __builtin_amdgcn_mfma_f32_32x32x16_bf16(b1, qr[d0], p1, 0, 0, 0);
    }
}
__device__ __forceinline__ void qk_tile_c(LAS const char* kbuf, const bf16x8 (&qr)[4], const f32x16& negm, f32x16& p0, f32x16& p1, int r32, int hi) {
    const unsigned ka = (unsigned)(size_t)kbuf + hi * 1040 + r32 * 16;
    bf16x8 kf[8];
#pragma unroll
    for (int d0 = 0; d0 < 4; ++d0) {
        asm volatile("ds_read_b128 %0, %1 offset:%c2" : "=&v"(kf[2 * d0]) : "v"(ka), "i"(d0 * 2080) : "memory");
        asm volatile("ds_read_b128 %0, %1 offset:%c2" : "=&v"(kf[2 * d0 + 1]) : "v"(ka), "i"(d0 * 2080 + 512) : "memory");
    }
    asm volatile("s_waitcnt lgkmcnt(0)" : "+v"(kf[0]), "+v"(kf[1]), "+v"(kf[2]), "+v"(kf[3]), "+v"(kf[4]), "+v"(kf[5]), "+v"(kf[6]), "+v"(kf[7]) :: "memory");
    __builtin_amdgcn_sched_barrier(0);
    p0 = __builtin_amdgcn_mfma_f32_32x32x16_bf16(kf[0], qr[0], negm, 0, 0, 0); p1 = __builtin_amdgcn_mfma_f32_32x32x16_bf16(kf[1], qr[0], negm, 0, 0, 0);
#pragma unroll
    for (int d0 = 1; d0 < 4; ++d0) { p0 = __builtin_amdgcn_mfma_f32_32x32x16_bf16(kf[2 * d0], qr[d0], p0, 0, 0, 0); p1 = __builtin_amdgcn_mfma_f32_32x32x16_bf16(kf[2 * d0 + 1], qr[d0], p1, 0, 0, 0); }
}
__device__ __forceinline__ void pv_tile(LAS const char* vbuf, const u32x4 (&pw)[4], f32x16 (&o)[2], f32x16& ol, int lane, int hi) {
    const unsigned va = (unsigned)(size_t)vbuf + ((lane >> 4) & 1) * 32 + (lane & 3) * 8 + (4 * hi + ((lane & 15) >> 2)) * 64;
#pragma unroll
    for (int d0 = 0; d0 < 2; ++d0) {
        s16x4 lo[4], h2[4];
#pragma unroll
        for (int ks = 0; ks < 4; ++ks) {
            asm volatile("ds_read_b64_tr_b16 %0, %1 offset:%c2" : "=&v"(lo[ks]) : "v"(va), "i"(d0 * 4096 + ks * 1024) : "memory");
            asm volatile("ds_read_b64_tr_b16 %0, %1 offset:%c2" : "=&v"(h2[ks]) : "v"(va), "i"(d0 * 4096 + ks * 1024 + 512) : "memory");
        }
        asm volatile("s_waitcnt lgkmcnt(0)" : "+v"(lo[0]), "+v"(lo[1]), "+v"(lo[2]), "+v"(lo[3]), "+v"(h2[0]), "+v"(h2[1]), "+v"(h2[2]), "+v"(h2[3]) :: "memory");
        __builtin_amdgcn_sched_barrier(0);
#pragma unroll
        for (int ks = 0; ks < 4; ++ks) {
            const bf16x8 vf = (bf16x8){lo[ks][0], lo[ks][1], lo[ks][2], lo[ks][3], h2[ks][0], h2[ks][1], h2[ks][2], h2[ks][3]};
            o[d0] = __builtin_amdgcn_mfma_f32_32x32x16_bf16(__builtin_bit_cast(bf16x8, pw[ks]), vf, o[d0], 0, 0, 0);
        }
        if (d0 == 0) {
            const bf16x8 ones = (bf16x8){0x3f80, 0x3f80, 0x3f80, 0x3f80, 0x3f80, 0x3f80, 0x3f80, 0x3f80};
#pragma unroll
            for (int ks = 0; ks < 4; ++ks) ol = __builtin_amdgcn_mfma_f32_32x32x16_bf16(__builtin_bit_cast(bf16x8, pw[ks]), ones, ol, 0, 0, 0);
        }
    }
}
__device__ __forceinline__ void mask_exp_pack(f32x16& p0, f32x16& p1, u64 mask, int hi, u32x4 (&pw)[4]) {
    const bool rowuni = __all(mask == ~0ull || mask == 0ull);
    if (rowuni) {
        const unsigned rm = mask ? ~0u : 0u;
        if (__all(mask == ~0ull)) {
#pragma unroll
            for (int r = 0; r < 16; ++r) { p0[r] = __builtin_amdgcn_exp2f(p0[r]); p1[r] = __builtin_amdgcn_exp2f(p1[r]); }
        } else {
#pragma unroll
            for (int r = 0; r < 16; ++r) { p0[r] = __uint_as_float(__float_as_uint(__builtin_amdgcn_exp2f(p0[r])) & rm); p1[r] = __uint_as_float(__float_as_uint(__builtin_amdgcn_exp2f(p1[r])) & rm); }
        }
    } else {
        const int m0 = (int)(unsigned)(mask >> (4 * hi)), m1 = (int)(unsigned)(mask >> (32 + 4 * hi));
#pragma unroll
        for (int r = 0; r < 16; ++r) { const int bit = (r & 3) + 8 * (r >> 2);
            const unsigned e0 = __float_as_uint(__builtin_amdgcn_exp2f(p0[r])), e1 = __float_as_uint(__builtin_amdgcn_exp2f(p1[r]));
            unsigned k0, k1;
            asm("v_bfe_i32 %0, %1, %2, 1" : "=v"(k0) : "v"(m0), "n"(bit)); asm("v_bfe_i32 %0, %1, %2, 1" : "=v"(k1) : "v"(m1), "n"(bit));
            p0[r] = __uint_as_float(e0 & k0); p1[r] = __uint_as_float(e1 & k1); }
    }
    pw[0] = (u32x4){pk2(p0[0], p0[1]), pk2(p0[2], p0[3]), pk2(p0[4], p0[5]), pk2(p0[6], p0[7])};
    pw[1] = (u32x4){pk2(p0[8], p0[9]), pk2(p0[10], p0[11]), pk2(p0[12], p0[13]), pk2(p0[14], p0[15])};
    pw[2] = (u32x4){pk2(p1[0], p1[1]), pk2(p1[2], p1[3]), pk2(p1[4], p1[5]), pk2(p1[6], p1[7])};
    pw[3] = (u32x4){pk2(p1[8], p1[9]), pk2(p1[10], p1[11]), pk2(p1[12], p1[13]), pk2(p1[14], p1[15])};
}
__device__ __forceinline__ u64 mask_le(int c) { return c >= 63 ? ~0ull : (c < 0 ? 0ull : ((2ull << c) - 1ull)); }
__device__ __forceinline__ u64 mask_ge(int a) { return a <= 0 ? ~0ull : (a > 63 ? 0ull : (~0ull << a)); }


__device__ __forceinline__ void glds16(const GAS void* gsrc, unsigned lds_dst) { unsigned keep;
    asm volatile("s_mov_b32 %0, m0\n\ts_mov_b32 m0, %2\n\ts_nop 0\n\tglobal_load_lds_dwordx4 %1, off\n\ts_mov_b32 m0, %0" : "=&s"(keep) : "v"(gsrc), "s"(lds_dst) : "memory"); }
__device__ __forceinline__ void tile_dma(const KVSrc& S, int t, unsigned kslot, unsigned vslot, const Lane& L) {
    const GAS bf16_t* ks = S.k + (size_t)(64 * t + L.lane) * S.pitch + L.wid * 8;
    const GAS bf16_t* vs = S.v + (size_t)(64 * t + 16 * (L.wid & 3) + (L.lane >> 2)) * S.pitch + (L.wid >> 2) * 32 + (L.lane & 3) * 8;
    glds16(ks, (unsigned)__builtin_amdgcn_readfirstlane(kslot + L.wid * 1040));
    glds16(vs, (unsigned)__builtin_amdgcn_readfirstlane(vslot + (L.wid >> 2) * 4096 + (L.wid & 3) * 1024));
}
#define ATT_WAIT_BAR(N) asm volatile("s_waitcnt vmcnt(" #N ") lgkmcnt(0)\n\ts_barrier" ::: "memory")
template <class MF>
__device__ __forceinline__ void attend_range(LAS char* lds, const KVSrc& S, int t0, int t1, const MF& mf, const bf16x8 (&qr)[4], float negC, f32x16& ol, f32x16 (&o)[2], const Lane& L, bool abl = false) {
    if (t0 >= t1) return;
    const bool late = L.wid >= 4;
    const unsigned lds0 = (unsigned)(size_t)lds;
    const f32x16 negm = {0.f, 0.f, 0.f, 0.f, 0.f, 0.f, 0.f, 0.f, 0.f, 0.f, 0.f, 0.f, 0.f, 0.f, 0.f, 0.f};
    (void)negC;
    tile_dma(S, t0, lds0 + L_K0, lds0 + L_V0, L);
    if (t0 + 1 < t1) tile_dma(S, t0 + 1, lds0 + L_K0 + 8320, lds0 + L_V0 + 8192, L);
    if (t0 + 2 < t1) tile_dma(S, t0 + 2, lds0 + L_K0 + 2 * 8320, lds0 + L_V0 + 2 * 8192, L);
    if (t0 + 2 < t1) ATT_WAIT_BAR(4); else if (t0 + 1 < t1) ATT_WAIT_BAR(2); else ATT_WAIT_BAR(0);
    u32x4 pwp[4];
#pragma unroll
    for (int k = 0; k < 4; ++k) asm volatile("" : "=v"(pwp[k]));
    int kcur = 0, vcur = 0, vprev = 0;
    u64 mk_next = mf(t0);
#if defined(PROBE_ABL) && PROBE_ABL == 12
    if (abl) { for (int t = t0; t < t1; ++t) { asm volatile("s_nop 0" ::: "memory"); } return; }
#endif
#if defined(PROBE_ABL) && PROBE_ABL == 13
    if (abl) { for (int t = t0; t < t1; ++t) { ATT_WAIT_BAR(0); } return; }
#endif
#if defined(PROBE_ABL) && PROBE_ABL == 14
    if (abl) { u64 acc_ = 0; for (int t = t0; t < t1; ++t) { acc_ ^= mf(t); asm volatile("s_waitcnt lgkmcnt(0)" : "+v"(acc_) :: "memory"); } asm volatile("" :: "v"(acc_)); return; }
#endif
#if defined(PROBE_ABL) && PROBE_ABL == 15
    if (abl) { for (int t = t0; t < t1; ++t) { f32x16 p0, p1; qk_tile_c(lds + L_K0, qr, negm, p0, p1, L.r32, L.hi); asm volatile("" :: "v"(p0), "v"(p1)); } return; }
#endif
#pragma unroll 1
    for (int t = t0; t < t1; ++t) {
        const u64 mk = mk_next;
        if (t + 1 < t1) mk_next = mf(t + 1);
#if defined(PROBE_ABL) && PROBE_ABL >= 10
        if (t + 3 < t1 && !abl) {
#else
        if (t + 3 < t1) {
#endif
            const int ks = kcur == 0 ? NKB - 1 : kcur - 1; int vs = vcur + 3; vs = vs >= NVB ? vs - NVB : vs;
            tile_dma(S, t + 3, lds0 + L_K0 + ks * 8320, lds0 + L_V0 + vs * 8192, L); }
#if defined(PROBE_ABL) && (PROBE_ABL == 6 || PROBE_ABL >= 10)
        if (late && t > t0 && !abl) pv_tile(lds + L_V0 + vprev * 8192, pwp, o, ol, L.lane, L.hi);
#else
        if (late && t > t0) pv_tile(lds + L_V0 + vprev * 8192, pwp, o, ol, L.lane, L.hi);
#endif
        f32x16 p0, p1;
#if defined(PROBE_ABL) && (PROBE_ABL == 6 || PROBE_ABL >= 10)
        if (abl) { p0 = negm; p1 = negm; asm volatile("" : "+v"(p0), "+v"(p1)); } else
#endif
        qk_tile_c(lds + L_K0 + kcur * 8320, qr, negm, p0, p1, L.r32, L.hi);
        u32x4 pw[4];
#if defined(PROBE_ABL) && (PROBE_ABL == 2 || PROBE_ABL >= 10)
        if (abl) {
#pragma unroll
            for (int k = 0; k < 4; ++k) pw[k] = (u32x4){__float_as_uint(p0[4 * k]) ^ (unsigned)mk, __float_as_uint(p0[4 * k + 1]), __float_as_uint(p1[4 * k + 2]), __float_as_uint(p1[4 * k + 3])}; }
        else
#endif
        mask_exp_pack(p0, p1, mk, L.hi, pw);
#if defined(PROBE_ABL) && (PROBE_ABL == 6 || PROBE_ABL >= 10)
        if (!late && !abl) pv_tile(lds + L_V0 + vcur * 8192, pw, o, ol, L.lane, L.hi);
        else if (!late) { asm volatile("" :: "v"(pw[0]), "v"(pw[1]), "v"(pw[2]), "v"(pw[3])); }
#else
        if (!late) pv_tile(lds + L_V0 + vcur * 8192, pw, o, ol, L.lane, L.hi);
#endif
        else {
#pragma unroll
            for (int k = 0; k < 4; ++k) pwp[k] = pw[k]; }
#if defined(PROBE_ABL) && PROBE_ABL == 11
        if (abl) { asm volatile("s_waitcnt lgkmcnt(0)" ::: "memory"); } else
#endif
        if (t + 3 < t1) ATT_WAIT_BAR(4); else if (t + 2 < t1) ATT_WAIT_BAR(2); else ATT_WAIT_BAR(0);
        vprev = vcur; vcur = vcur == NVB - 1 ? 0 : vcur + 1; kcur = kcur == NKB - 1 ? 0 : kcur + 1;
    }
    if (late) pv_tile(lds + L_V0 + vprev * 8192, pwp, o, ol, L.lane, L.hi);
    ATT_WAIT_BAR(0);
}
__device__ __forceinline__ void rows_to_regs(LAS float* wsf, float v, int r32, int hi, float (&sc)[16]) {
    asm volatile("s_waitcnt lgkmcnt(0)" ::: "memory");
    if (hi == 0) wsf[r32] = v;
    asm volatile("s_waitcnt lgkmcnt(0)" ::: "memory");
#pragma unroll
    for (int r = 0; r < 16; ++r) sc[r] = wsf[crow(r, hi)];
}
__device__ __forceinline__ void load_q(const bf16_t* qrow, int hi, bf16x8 (&qr)[4]) {
#pragma unroll
    for (int d0 = 0; d0 < 4; ++d0) qr[d0] = *(const GAS bf16x8*)(qrow + d0 * 16 + hi * 8);
}
template <class RowPtr>
__device__ __forceinline__ void store_o(LAS char* stage, const f32x16 (&acc)[2], const RowPtr& rowptr, int lane, int r32, int hi) {
    LAS bf16_t* stg = (LAS bf16_t*)stage;
#pragma unroll
    for (int r = 0; r < 16; ++r) { const int orow = crow(r, hi);
#pragma unroll
        for (int d0 = 0; d0 < 2; ++d0) stg[orow * 64 + d0 * 32 + r32] = (bf16_t)(pk2(acc[d0][r], 0.f) & 0xffffu); }
    asm volatile("s_waitcnt lgkmcnt(0)" ::: "memory");
#pragma unroll
    for (int i = 0; i < 4; ++i) { const int row = i * 8 + (lane >> 3), ch = lane & 7; const u32x4 v = *(LAS const u32x4*)(stg + row * 64 + ch * 8); *(GAS u32x4*)(rowptr(row) + ch * 8) = v; }
    asm volatile("s_waitcnt lgkmcnt(0)" ::: "memory");
}
}

constexpr int NWAVES = 8;
constexpr int BATCH = 4, SEQ = 4096, DM = 1024, DFF = 4096, DEPTH = 2, D_IN = 6236;
constexpr int M = BATCH * SEQ;
constexpr size_t MiB = 1u << 20;
constexpr size_t WS_ZQ = 0;
constexpr size_t WS_ZKV = 48 * MiB;
constexpr size_t WS_YS = WS_ZKV;
constexpr size_t WS_MB = 104 * MiB;
constexpr size_t WS_KC2 = WS_MB, WS_VC2 = WS_MB + 4 * MiB;
constexpr size_t WS_XB = 136 * MiB;
constexpr size_t WS_W = 168 * MiB, W_LAYER = 36 * MiB;
constexpr size_t W_IN = 0, W_G = 7 * MiB, W_BR = 13 * MiB, W_OUT = 16 * MiB, W_UP = 18 * MiB, W_DN = 26 * MiB, W_CK1 = 34 * MiB, W_CV1 = 35 * MiB;
constexpr size_t WS_BM = 240 * MiB;
constexpr size_t WS_MISC = 248 * MiB;
constexpr size_t WS_CTL = WS_MISC, CTL_BYTES = 128 * 1024;
constexpr size_t WS_COS = WS_MISC + 1 * MiB, WS_SIN = WS_MISC + 1 * MiB + 512 * 1024;
constexpr size_t WS_KCMP = WS_MISC + 2 * MiB;
constexpr size_t WS_SSQ = WS_MISC + 2 * MiB + 512 * 1024;
constexpr size_t WS_B1P = WS_MISC + 3 * MiB + 512 * 1024;
constexpr size_t WS_W2 = WS_B1P + 64 * 1024;
constexpr size_t WS_IKF = WS_MISC + 4 * MiB;
constexpr size_t WS_HMID = 0;
constexpr size_t WS_END = 256 * MiB;
constexpr int CW_BAR = 4096, CW_Q = 8192, CW_KMAX = 12288;
constexpr int LDS_BYTES = 163840, LDS_UNIT = 163776;
constexpr float C2 = 0.125f * 1.4426950408889634f, LOG2E = 1.4426950408889634f;


struct Args { const float* in[17]; float* out; unsigned char* ws; };
struct Frame {
    LAS unsigned char* lds;
    gu32* ctl;
    int tid, lane, wave, G, gw, NGW;
    unsigned char* ws;
    const struct Args* a;
};
__device__ __forceinline__ float wave_sum(float v) {
#pragma unroll
    for (int o = 1; o < 64; o <<= 1) v += __shfl_xor(v, o);
    return v;
}
__device__ __forceinline__ float wave_max(float v) {
#pragma unroll
    for (int o = 1; o < 64; o <<= 1) v = fmaxf(v, __shfl_xor(v, o));
    return v;
}
__device__ __forceinline__ float bf2f(bf16 h) { return __uint_as_float((unsigned)h << 16); }
__device__ __constant__ float c_inv_freq[32] = {
    1.0f, 0.7498942093324559f, 0.5623413251903491f, 0.4216965034285822f, 0.31622776601683794f, 0.23713737056616552f, 0.1778279410038923f, 0.1333521432163324f,
    0.1f, 0.07498942093324558f, 0.05623413251903491f, 0.042169650342858224f, 0.03162277660168379f, 0.023713737056616554f, 0.01778279410038923f, 0.01333521432163324f,
    0.01f, 0.007498942093324558f, 0.005623413251903491f, 0.004216965034285823f, 0.0031622776601683794f, 0.0023713737056616554f, 0.0017782794100389228f, 0.001333521432163324f,
    0.001f, 0.0007498942093324559f, 0.0005623413251903491f, 0.00042169650342858224f, 0.00031622776601683794f, 0.00023713737056616554f, 0.00017782794100389227f, 0.0001333521432163324f};

__device__ __forceinline__ int mix_src_col(int j) {
    if (j < 512) return j;
    if (j < 1024) return 1092 + (j - 512);
    if (j < 1536) return 1860 + (j - 1024);
    if (j < 1792) return 512 + (j - 1536);
    if (j < 2048) return 1604 + (j - 1792);
    if (j < 2304) return 2372 + (j - 2048);
    if (j < 2560) return 2628 + (j - 2304);
    if (j < 2816) return 2884 + (j - 2560);
    if (j < 3072) return 768 + (j - 2816);
    const int r = j - 3072;
    if (r < 64) return 1024 + r;
    if (r < 68) return 1088 + (r - 64);
    if (r < 92) return 3140 + (r - 68);
    return -1;
}
template <int MODE>
__device__ __forceinline__ void p0_item(const float* W, int ldw, int K, bf16* WT, int nblk, int item, const float* gain, int coff, LAS float* scr, int lane) {
    const int kb = item / nblk, nb = item % nblk, k0 = 64 * kb, n0 = 32 * nb;
    const int nq = 4 * (lane & 7), rr = lane >> 3;
    const int sc = MODE == 0 ? (n0 + nq + coff) : mix_src_col(n0 + nq);
    f32x4 v[8];
#pragma unroll
    for (int i = 0; i < 8; ++i) { v[i] = (f32x4){0.f, 0.f, 0.f, 0.f}; if (sc >= 0) v[i] = *(const GAS f32x4*)(W + (size_t)(k0 + 8 * i + rr) * ldw + sc); }
#pragma unroll
    for (int i = 0; i < 8; ++i) { const int kk = 8 * i + rr; const float g = gain ? gain[k0 + kk] : 1.0f;
        scr[kk * 33 + nq + 0] = v[i][0] * g; scr[kk * 33 + nq + 1] = v[i][1] * g; scr[kk * 33 + nq + 2] = v[i][2] * g; scr[kk * 33 + nq + 3] = v[i][3] * g; }
    LDS_WAIT(); asm volatile("" ::: "memory");
    const int c = lane & 7;
#pragma unroll
    for (int j = 0; j < 4; ++j) { const int n = (lane >> 3) + 8 * j; const LAS float* s = scr + (8 * c) * 33 + n;
        v4u o; o.x = pk2(s[0 * 33], s[1 * 33]); o.y = pk2(s[2 * 33], s[3 * 33]); o.z = pk2(s[4 * 33], s[5 * 33]); o.w = pk2(s[6 * 33], s[7 * 33]);
        *(GAS v4u*)(WT + (size_t)(n0 + n) * K + k0 + 8 * c) = o; }
    LDS_WAIT(); asm volatile("" ::: "memory");
}
__device__ __forceinline__ void p0_prologue(Frame& F) {
    LAS float* scr = (LAS float*)(F.lds + F.wave * 16384);
    constexpr int I_IN = 16 * 104, I_G = 16 * 96, I_BR = 8 * 32, I_OUT = 16 * 32, I_UP = 16 * 128, I_DN = 64 * 32, I_C1 = 32 * 8, I_C2 = 4 * 2;
    constexpr int PER_LAYER = I_IN + I_G + 3 * I_BR + I_OUT + I_UP + I_DN + 2 * I_C1 + 2 * I_C2;
    for (int it = F.gw; it < 2 * PER_LAYER; it += F.NGW) {
        const int l = it / PER_LAYER; int r = it % PER_LAYER;
        unsigned char* wl = F.ws + WS_W + (size_t)l * W_LAYER;
        const float* w_in = F.a->in[2] + (size_t)l * DM * D_IN;
        if (r < I_IN) { p0_item<1>(w_in, D_IN, DM, (bf16*)(wl + W_IN), 104, r, F.a->in[1] + l * DM, 0, scr, F.lane); continue; } r -= I_IN;
        if (r < I_G) { p0_item<0>(w_in, D_IN, DM, (bf16*)(wl + W_G), 96, r, F.a->in[1] + l * DM, 3164, scr, F.lane); continue; } r -= I_G;
        if (r < 3 * I_BR) { const int n = r / I_BR; p0_item<0>(F.a->in[12] + ((size_t)l * 3 + n) * 512 * DM, DM, 512, (bf16*)(wl + W_BR) + (size_t)n * DM * 512, 32, r % I_BR, nullptr, 0, scr, F.lane); continue; } r -= 3 * I_BR;
        if (r < I_OUT) { p0_item<0>(F.a->in[13] + (size_t)l * DM * DM, DM, DM, (bf16*)(wl + W_OUT), 32, r, nullptr, 0, scr, F.lane); continue; } r -= I_OUT;
        if (r < I_UP) { p0_item<0>(F.a->in[15] + (size_t)l * DM * DFF, DFF, DM, (bf16*)(wl + W_UP), 128, r, F.a->in[14] + l * DM, 0, scr, F.lane); continue; } r -= I_UP;
        if (r < I_DN) { p0_item<0>(F.a->in[16] + (size_t)l * DFF * DM, DM, DFF, (bf16*)(wl + W_DN), 32, r, nullptr, 0, scr, F.lane); continue; } r -= I_DN;
        if (r < I_C1) { p0_item<0>(F.a->in[8] + (size_t)l * 2048 * 256, 256, 2048, (bf16*)(wl + W_CK1), 8, r, nullptr, 0, scr, F.lane); continue; } r -= I_C1;
        if (r < I_C1) { p0_item<0>(F.a->in[10] + (size_t)l * 2048 * 256, 256, 2048, (bf16*)(wl + W_CV1), 8, r, nullptr, 0, scr, F.lane); continue; } r -= I_C1;
        if (r < I_C2) { p0_item<0>(F.a->in[9] + (size_t)l * 256 * 64, 64, 256, (bf16*)(F.ws + WS_W2) + (size_t)(l * 2 + 0) * 64 * 256, 2, r, nullptr, 0, scr, F.lane); continue; } r -= I_C2;
        p0_item<0>(F.a->in[11] + (size_t)l * 256 * 64, 64, 256, (bf16*)(F.ws + WS_W2) + (size_t)(l * 2 + 1) * 64 * 256, 2, r, nullptr, 0, scr, F.lane);
    }
    for (int it = F.gw; it < 128; it += F.NGW) {
        const int kp = it & 7, jb = (it >> 3) & 3, which = (it >> 5) & 1, l = it >> 6; const int j = jb * 64 + F.lane;
        const float* pe = (which ? F.a->in[7] : F.a->in[6]) + l * 2048; const float* w1 = (which ? F.a->in[10] : F.a->in[8]) + (size_t)l * 2048 * 256;
        float a = 0.f;
        for (int k = kp * 256; k < kp * 256 + 256; ++k) a = fmaf(pe[k], w1[(size_t)k * 256 + j], a);
        ((float*)(F.ws + WS_B1P))[((l * 2 + which) * 8 + kp) * 256 + j] = a;
    }
    for (int m = F.gw; m < M; m += F.NGW) {
        const GAS f32x4* xr = (const GAS f32x4*)(F.a->in[0] + (size_t)m * DM) + F.lane;
        GAS unsigned long long* o8 = (GAS unsigned long long*)((bf16*)(F.ws + WS_XB) + (size_t)m * DM) + F.lane;
        float s = 0.f;
#pragma unroll
        for (int j = 0; j < 4; ++j) { const f32x4 v = xr[64 * j]; s += (v.x * v.x + v.y * v.y) + (v.z * v.z + v.w * v.w);
            o8[64 * j] = (unsigned long long)pk2(v.x, v.y) | ((unsigned long long)pk2(v.z, v.w) << 32); }
        s = wave_sum(s);
        if (F.lane < 16) ((float*)(F.ws + WS_SSQ))[(size_t)m * 16 + F.lane] = F.lane == 0 ? s : 0.f;
    }
    for (int i = F.gw * 64 + F.lane; i < SEQ * 32; i += F.NGW * 64) {
        const float ang = (float)(i >> 5) * c_inv_freq[i & 31];
        ((float*)(F.ws + WS_COS))[i] = (float)cos((double)ang); ((float*)(F.ws + WS_SIN))[i] = (float)sin((double)ang);
    }
}
typedef unsigned u32x4_t __attribute__((ext_vector_type(4)));
__device__ __forceinline__ void post_group(u32x4_t raw, bool act, bool norm, bool rope, const float (&gain)[8], float scale, const float (&cs)[8], const float (&sn)[8], int lane, bf16* dst) {
    float v[8];
    v[0] = __uint_as_float(raw.x << 16); v[1] = __uint_as_float(raw.x & 0xffff0000u); v[2] = __uint_as_float(raw.y << 16); v[3] = __uint_as_float(raw.y & 0xffff0000u);
    v[4] = __uint_as_float(raw.z << 16); v[5] = __uint_as_float(raw.z & 0xffff0000u); v[6] = __uint_as_float(raw.w << 16); v[7] = __uint_as_float(raw.w & 0xffff0000u);
    float ss = ((v[0] * v[0] + v[1] * v[1]) + (v[2] * v[2] + v[3] * v[3])) + ((v[4] * v[4] + v[5] * v[5]) + (v[6] * v[6] + v[7] * v[7]));
    ss += __shfl_xor(ss, 1); ss += __shfl_xor(ss, 2); ss += __shfl_xor(ss, 4);
    const float rs = norm ? rsqrtf(ss * (1.0f / 64.0f) + 1e-6f) : 1.0f;
    const bool lo = (lane & 4) == 0;
    float r[8];
#pragma unroll
    for (int j = 0; j < 8; ++j) { const float x = norm ? v[j] * rs * gain[j] : v[j]; const float o = __shfl_xor(x, 4);
        r[j] = rope ? (lo ? (x * cs[j] - o * sn[j]) : (x * cs[j] + o * sn[j])) : x; r[j] *= scale; }
    if (act) { u32x4_t w; w.x = pk2(r[0], r[1]); w.y = pk2(r[2], r[3]); w.z = pk2(r[4], r[5]); w.w = pk2(r[6], r[7]); *(GAS u32x4_t*)dst = w; }
}
__device__ __forceinline__ void post_phase(Frame& F, int l, bool dry = false) {
    const float* qn = F.a->in[3] + l * 192; const float* kn = F.a->in[4] + l * 192;
    const int lane = F.lane, g = lane >> 3, c = lane & 7;
    float gq0[8], gq1[8], gq2[8], gk3[8], gk2[8];
#pragma unroll
    for (int j = 0; j < 8; ++j) { gq0[j] = qn[8 * c + j]; gq1[j] = qn[64 + 8 * c + j]; gq2[j] = qn[128 + 8 * c + j]; gk2[j] = kn[128 + 8 * c + j];
        gk3[j] = (g >> 1) == 0 ? kn[8 * c + j] : ((g >> 1) == 1 ? kn[64 + 8 * c + j] : kn[128 + 8 * c + j]); }
    bf16* zq = (bf16*)(F.ws + WS_ZQ); bf16* zkv = (bf16*)(F.ws + WS_ZKV);
    const float* cst = (const float*)(F.ws + WS_COS); const float* snt = (const float*)(F.ws + WS_SIN);
#pragma unroll 1
    for (int m = F.gw; m < M; m += F.NGW) {
        const int t = m & (SEQ - 1), b = m >> 12;
        float cs[8], sn[8];
        { const GAS f32x4* cp = (const GAS f32x4*)(cst + t * 32 + 8 * (c & 3)); const GAS f32x4* sp = (const GAS f32x4*)(snt + t * 32 + 8 * (c & 3));
          const f32x4 c0 = cp[0], c1 = cp[1], s0 = sp[0], s1 = sp[1];
          cs[0] = c0[0]; cs[1] = c0[1]; cs[2] = c0[2]; cs[3] = c0[3]; cs[4] = c1[0]; cs[5] = c1[1]; cs[6] = c1[2]; cs[7] = c1[3];
          sn[0] = s0[0]; sn[1] = s0[1]; sn[2] = s0[2]; sn[3] = s0[3]; sn[4] = s1[0]; sn[5] = s1[1]; sn[6] = s1[2]; sn[7] = s1[3]; }
        bf16* pqa = zq + (size_t)m * 512 + lane * 8; bf16* pqb = pqa + (size_t)M * 512; bf16* pqc = pqa + (size_t)2 * M * 512;
        const int t3 = (g >> 1) < 2 ? (g >> 1) : (g >> 1) + 1;
        bf16* p3 = zkv + (size_t)t3 * M * 256 + (size_t)m * 256 + (g & 1) * 64 + c * 8;
        const bf16* s4 = g < 4 ? zkv + (size_t)2 * M * 256 + (size_t)m * 256 + g * 64 + c * 8 : zkv + (size_t)5 * M * 256 + (size_t)m * 256 + (g - 4) * 64 + c * 8;
        bf16* d4 = g < 2 ? (bf16*)(F.ws + WS_KC2) + ((size_t)(b * 2 + g) * SEQ + t) * 64 + c * 8
                 : (g < 4 ? (bf16*)(F.ws + WS_VC2) + ((size_t)(b * 2 + (g - 2)) * SEQ + t) * 64 + c * 8 : (bf16*)s4);
        const bf16* p5 = zkv + (size_t)6 * M * 256 + (size_t)m * 256 + c * 8;
        bf16* d5 = (bf16*)(F.ws + WS_IKF) + ((size_t)(b * (SEQ / 32) + (t >> 5)) * 8 + c) * 256 + (t & 31) * 8;
        const u32x4_t r0 = *(const GAS u32x4_t*)pqa, r1 = *(const GAS u32x4_t*)pqb, r2 = *(const GAS u32x4_t*)pqc, r3 = *(const GAS u32x4_t*)p3, r4 = *(const GAS u32x4_t*)s4;
        const u32x4_t r5 = *(const GAS u32x4_t*)p5;
        post_group(r0, !dry, true, true, gq0, C2, cs, sn, lane, pqa);
        post_group(r1, !dry, true, true, gq1, C2, cs, sn, lane, pqb);
        post_group(r2, !dry, true, true, gq2, C2, cs, sn, lane, pqc);
        post_group(r3, !dry, true, true, gk3, 1.f, cs, sn, lane, p3);
        post_group(r4, !dry, g < 2, g < 2 || g >= 4, gk2, 1.f, cs, sn, lane, d4);
        post_group(r5, g == 0 && !dry, false, true, gk2, 1.f, cs, sn, lane, d5);
    }
}

#define WAVE_LDS_FENCE() asm volatile("s_waitcnt lgkmcnt(0)" ::: "memory")
__device__ __forceinline__ int next_unit(Frame& F, gu32* counter) {
    LAS int* slot = (LAS int*)(F.lds + LDS_UNIT);
    __syncthreads();
    if (F.tid == 0) *slot = (int)__hip_atomic_fetch_add(counter, 1u, RLX_AGENT);
    __syncthreads();
    return *slot;
}
__device__ __forceinline__ unsigned f2key(float f) { const unsigned u = __float_as_uint(f); return (u & 0x80000000u) ? ~u : (u | 0x80000000u); }
__device__ __forceinline__ float dpp_quad_sum(float v) {
    v += __int_as_float(__builtin_amdgcn_update_dpp(0, __float_as_int(v), 0xB1, 0xF, 0xF, true));
    v += __int_as_float(__builtin_amdgcn_update_dpp(0, __float_as_int(v), 0x4E, 0xF, 0xF, true));
    return v;
}
__device__ __forceinline__ void radix_select_list(LAS const unsigned* list, int nblk, int k, LAS unsigned* hist, int lane, unsigned& T, int& need) {
    typedef unsigned u32x4_ __attribute__((ext_vector_type(4)));
    unsigned prefix = 0u; int kk = k;
#pragma unroll 1
    for (int pass = 0; pass < 4; ++pass) {
        const int shift = 24 - 8 * pass;
#pragma unroll
        for (int i = 0; i < 4; ++i) hist[lane * 4 + i] = 0u;
        WAVE_LDS_FENCE();
#pragma unroll 2
        for (int jb = 0; jb < nblk; ++jb) { const u32x4_ v = *(LAS const u32x4_*)(list + jb * 256 + lane * 4);
#pragma unroll
            for (int c = 0; c < 4; ++c) { const unsigned key = v[c];
                const unsigned bin = (pass == 0 || (key >> (shift + 8)) == prefix) ? ((key >> shift) & 255u) : 256u + (unsigned)lane;
                __hip_atomic_fetch_add(&hist[bin], 1u, __ATOMIC_RELAXED, __HIP_MEMORY_SCOPE_WORKGROUP); } }
        WAVE_LDS_FENCE();
        const unsigned h0 = hist[lane * 4], h1 = hist[lane * 4 + 1], h2 = hist[lane * 4 + 2], h3 = hist[lane * 4 + 3];
        const int tot4 = (int)(h0 + h1 + h2 + h3);
        int pre = tot4;
        pre += __builtin_amdgcn_update_dpp(0, pre, 0x111, 0xf, 0xf, false);
        pre += __builtin_amdgcn_update_dpp(0, pre, 0x112, 0xf, 0xf, false);
        pre += __builtin_amdgcn_update_dpp(0, pre, 0x114, 0xf, 0xf, false);
        pre += __builtin_amdgcn_update_dpp(0, pre, 0x118, 0xf, 0xf, false);
        pre += __builtin_amdgcn_update_dpp(0, pre, 0x142, 0xa, 0xf, false);
        pre += __builtin_amdgcn_update_dpp(0, pre, 0x143, 0xc, 0xf, false);
        const int total = __builtin_amdgcn_readlane(pre, 63);
        const int above = total - pre;
        const int a3 = above, a2 = a3 + (int)h3, a1 = a2 + (int)h2, a0 = a1 + (int)h1;
        int dsel = -1, nk = 0;
        if (a3 < kk && kk <= a3 + (int)h3) { dsel = lane * 4 + 3; nk = kk - a3; }
        else if (a2 < kk && kk <= a2 + (int)h2) { dsel = lane * 4 + 2; nk = kk - a2; }
        else if (a1 < kk && kk <= a1 + (int)h1) { dsel = lane * 4 + 1; nk = kk - a1; }
        else if (a0 < kk && kk <= a0 + (int)h0) { dsel = lane * 4 + 0; nk = kk - a0; }
        const unsigned long long bal = __ballot(dsel >= 0);
        const int src = (int)__builtin_ctzll(bal);
        dsel = __builtin_amdgcn_readlane(dsel, src); nk = __builtin_amdgcn_readlane(nk, src);
        WAVE_LDS_FENCE();
        prefix = (prefix << 8) | (unsigned)dsel; kk = nk;
    }
    T = prefix; need = kk;
}
__device__ __forceinline__ void select_unit(Frame& F, int b, int qblk, int abl = 0) {
    using namespace att;
    int tid_ = F.tid; asm volatile("" : "+v"(tid_));
    const int lane = tid_ & 63, r32 = lane & 31, hi = lane >> 5, w = F.wave;
    LAS unsigned* sc = (LAS unsigned*)F.lds;
    LAS unsigned* hist = (LAS unsigned*)(F.lds + 131072) + w * 320;
    LAS unsigned* cand = (LAS unsigned*)(F.lds + 131072 + 10240) + w * 512;
    const int t0 = qblk * 8; const size_t m0 = (size_t)b * SEQ + t0;
    const bf16* IQ = (const bf16*)(F.ws + WS_ZKV) + (size_t)5 * M * 256; const bf16* MISC = (const bf16*)(F.ws + WS_ZKV) + (size_t)6 * M * 256;
    const bf16* IKF = (const bf16*)(F.ws + WS_IKF) + (size_t)b * SEQ * 64;
    u64* BM = (u64*)(F.ws + WS_BM);
    const int nkeys = t0 + 8;
    if (nkeys > 256 && abl < 2) {
        bf16x8 iqf[4];
        { const bf16* qrow = IQ + (m0 + (r32 >> 2)) * 256 + (r32 & 3) * 64;
#pragma unroll
          for (int d0 = 0; d0 < 4; ++d0) iqf[d0] = *(const GAS bf16x8*)(qrow + d0 * 16 + hi * 8); }
        const float wl = bf2f(((const GAS bf16*)MISC)[(m0 + (r32 >> 2)) * 256 + 64 + (r32 & 3)]);
        const int ntile = (nkeys + 31) >> 5; const int g = r32 & 3;
#pragma unroll 1
        for (int tile0 = w; tile0 < ntile; tile0 += 16) {
            bf16x8 kf[2][4];
#pragma unroll
            for (int u = 0; u < 2; ++u) { const int tile = tile0 + 8 * u < ntile ? tile0 + 8 * u : tile0;
                const bf16* kt = IKF + (size_t)tile * 2048 + hi * 256 + r32 * 8;
#pragma unroll
                for (int d0 = 0; d0 < 4; ++d0) kf[u][d0] = *(const GAS bf16x8*)(kt + d0 * 512); }
#pragma unroll
            for (int u = 0; u < 2; ++u) { const int tile = tile0 + 8 * u;
                if (tile < ntile) {
                    const int s0 = tile * 32;
                    f32x16 acc;
#pragma unroll
                    for (int r = 0; r < 16; ++r) acc[r] = 0.f;
#pragma unroll
                    for (int d0 = 0; d0 < 4; ++d0) acc = __builtin_amdgcn_mfma_f32_32x32x16_bf16(kf[u][d0], iqf[d0], acc, 0, 0, 0);
                    float v[16];
#pragma unroll
                    for (int r = 0; r < 16; ++r) v[r] = dpp_quad_sum(__builtin_amdgcn_fmed3f(acc[r], 0.f, __builtin_inff()) * wl);
                    u32x4 o;
#pragma unroll
                    for (int j = 0; j < 4; ++j) o[j] = f2key(g == 0 ? v[j] : (g == 1 ? v[4 + j] : (g == 2 ? v[8 + j] : v[12 + j])));
                    *(LAS u32x4*)(sc + (r32 >> 2) * 4096 + s0 + 8 * g + 4 * hi) = o;
                } }
        }
    }
    __syncthreads();
    if (abl != 1) {
        const int t = t0 + w, n = t + 1; LAS unsigned* row = sc + w * 4096;
        u64 myword = 0ull;
        if (n <= 256) {
            const int c0 = 64 * lane;
            myword = (c0 + 63 < n) ? ~0ull : (c0 >= n ? 0ull : ((1ull << (n - c0)) - 1ull));
        } else {
            const int nblk = (n + 255) >> 8;
            { const int s = (n & ~3) + lane * 4;
              if (s < nblk * 256) { u32x4 v = *(LAS u32x4*)(row + s);
#pragma unroll
                  for (int c = 0; c < 4; ++c) if (s + c >= n) v[c] = 0u;
                  *(LAS u32x4*)(row + s) = v; } }
            WAVE_LDS_FENCE();
            unsigned T = 0u; int need = 0; bool done = false;
            if (n > 512 && abl != 5) {
#pragma unroll
                for (int c = 0; c < 8; ++c) { const int i = lane + 64 * c; cand[i] = row[(i * n) >> 9]; }
                WAVE_LDS_FENCE();
                const float er = 131072.0f / (float)n;
                int rr = (int)(er + 2.5f * __builtin_sqrtf(er * (1.0f - 256.0f / (float)n)) + 2.0f); rr = rr > 512 ? 512 : rr;
                unsigned P; int dummy; radix_select_list(cand, 2, rr, hist, lane, P, dummy);
                int C = 0; bool ovf = false;
#pragma unroll 1
                for (int jb = 0; jb < nblk; ++jb) { const u32x4 v = *(LAS const u32x4*)(row + jb * 256 + lane * 4);
#pragma unroll
                    for (int c = 0; c < 4; ++c) { const bool in = v[c] > P; const u64 bal = __ballot(in); const int pos = C + __builtin_popcountll(bal & ((1ull << lane) - 1ull));
                        C += __builtin_popcountll(bal); if (C > 512) ovf = true;
                        if (in && !ovf) cand[pos] = v[c]; } }
                if (!ovf && C >= 256) {
                    WAVE_LDS_FENCE();
                    const int cb = (C + 255) >> 8;
                    { const int s = C + lane; if (s < cb * 256) cand[s] = 0u; const int s2 = s + 64; if (s2 < cb * 256) cand[s2] = 0u; const int s3 = s + 128; if (s3 < cb * 256) cand[s3] = 0u; const int s4 = s + 192; if (s4 < cb * 256) cand[s4] = 0u; }
                    WAVE_LDS_FENCE();
                    radix_select_list(cand, cb, 256, hist, lane, T, need); done = true;
                }
            }
            if (!done && abl < 3) radix_select_list(row, nblk, 256, hist, lane, T, need);
            int base = 0;
            const int nch = abl >= 4 ? 0 : (n + 63) >> 6;
#pragma unroll 1
            for (int c = 0; c < nch; c += 4) {
                unsigned vv[4];
#pragma unroll
                for (int u2 = 0; u2 < 4; ++u2) vv[u2] = row[64 * (c + u2) + lane];
#pragma unroll
                for (int u2 = 0; u2 < 4; ++u2) {
                    const int s = 64 * (c + u2) + lane; const bool valid = s < n; const unsigned key = valid ? vv[u2] : 0u;
                    const bool gt = valid && key > T, eq = valid && key == T;
                    const u64 beq = __ballot(eq);
                    const int rank = base + __builtin_popcountll(beq & ((1ull << lane) - 1ull));
                    const u64 word = __ballot(gt || (eq && rank < need));
                    if (lane == c + u2) myword = word;
                    base += __builtin_popcountll(beq);
                }
            }
        }
        if (abl >= 2) ((GAS u64*)(F.ws + WS_MB + 24 * MiB))[((size_t)b * SEQ + t) * 64 + lane] = myword;
        else ((GAS u64*)BM)[((size_t)b * SEQ + t) * 64 + lane] = myword;
    }
    __syncthreads();
}
__device__ __forceinline__ void compress_unit(Frame& F, int l, int u) {
    using namespace att;
    int tid_ = F.tid; asm volatile("" : "+v"(tid_));
    const int lane = tid_ & 63, r32 = lane & 31, hi = lane >> 5, w = F.wave;
    const int which = u & 1, h = (u >> 1) & 1, b = (u >> 2) & 3, cb = u >> 4;
    const bf16* src = (const bf16*)(F.ws + (which ? WS_VC2 : WS_KC2)) + (size_t)(b * 2 + h) * SEQ * 64;
    const bf16* W1t = (const bf16*)(F.ws + WS_W + (size_t)l * W_LAYER + (which ? W_CV1 : W_CK1));
    const bf16* W2t = (const bf16*)(F.ws + WS_W2) + (size_t)(l * 2 + which) * 64 * 256;
    const float* b1p = (const float*)(F.ws + WS_B1P) + (size_t)(l * 2 + which) * 8 * 256;
    LAS bf16* hid = (LAS bf16*)F.lds;
    int cc = 32 * cb + r32; if (cc > 254) cc = 254;
    const bf16* arow = src + (size_t)(16 * cc) * 64 + hi * 8;
    const bf16* brow = W1t + (size_t)(32 * w + r32) * 2048 + hi * 8;
    f32x16 acc;
#pragma unroll
    for (int r = 0; r < 16; ++r) acc[r] = 0.f;
#pragma unroll 4
    for (int ks = 0; ks < 128; ++ks) { const bf16x8 a = *(const GAS bf16x8*)(arow + ks * 16), bb = *(const GAS bf16x8*)(brow + ks * 16); acc = __builtin_amdgcn_mfma_f32_32x32x16_bf16(a, bb, acc, 0, 0, 0); }
    float b1 = 0.f;
#pragma unroll
    for (int kp = 0; kp < 8; ++kp) b1 += ((const GAS float*)b1p)[kp * 256 + 32 * w + r32];
#pragma unroll
    for (int r = 0; r < 16; ++r) hid[crow(r, hi) * 264 + 32 * w + r32] = (bf16)f2bf(fmaxf(acc[r] + b1, 0.f));
    __syncthreads();
    if (w < 2) {
        f32x16 o;
#pragma unroll
        for (int r = 0; r < 16; ++r) o[r] = 0.f;
        const bf16* w2row = W2t + (size_t)(32 * w + r32) * 256 + hi * 8;
#pragma unroll
        for (int ks = 0; ks < 16; ++ks) { const bf16x8 a = *(LAS const bf16x8*)(hid + r32 * 264 + ks * 16 + hi * 8), bb = *(const GAS bf16x8*)(w2row + ks * 16); o = __builtin_amdgcn_mfma_f32_32x32x16_bf16(a, bb, o, 0, 0, 0); }
        bf16* dst = (bf16*)(F.ws + WS_KCMP) + ((size_t)((which * 4 + b) * 2 + h) * 256) * 64;
        float mx = 0.f;
#pragma unroll
        for (int r = 0; r < 16; ++r) { const int c = 32 * cb + crow(r, hi); const float v = c < 255 ? o[r] : 0.f; mx = fmaxf(mx, fabsf(v)); ((GAS bf16*)dst)[(size_t)c * 64 + 32 * w + r32] = (bf16)f2bf(v); }
        if (which == 0) { mx = wave_max(mx); if (lane == 0) __hip_atomic_fetch_max(F.ctl + CW_KMAX + 64 * (l * 8 + b * 2 + h), __float_as_uint(mx), RLX_AGENT); }
    }
    __syncthreads();
}
struct UnitGeom { int b, kvh, i; att::Lane L; int q; int head; size_t mrow; };
__device__ __forceinline__ UnitGeom unit_geom(Frame& F, int b, int kvh, int i) {
    int tid = F.tid; asm volatile("" : "+v"(tid));
    UnitGeom U; U.b = b; U.kvh = kvh; U.i = i; U.L.tid = tid; U.L.lane = tid & 63; U.L.r32 = tid & 31; U.L.hi = (tid >> 5) & 1; U.L.wid = F.wave;
    U.q = 64 * i + 8 * F.wave + (U.L.r32 >> 2); U.head = 4 * kvh + (U.L.r32 & 3); U.mrow = (size_t)b * SEQ + U.q; return U;
}
__device__ __forceinline__ void branch_finish(LAS float* wsf, const att::f32x16& ol, const float (&extra)[4], float rowscale, bool has_scale, const att::f32x16 (&o)[2], att::f32x16 (&acc)[2], const att::Lane& L, bool first) {
    float sc[16];
    if (has_scale) att::rows_to_regs(wsf, rowscale, L.r32, L.hi, sc);
#pragma unroll
    for (int r = 0; r < 16; ++r) { const float lf = ol[r] + extra[r & 3]; const float inv = lf > 0.f ? __builtin_amdgcn_rcpf(lf) : 0.f; sc[r] = has_scale ? sc[r] * inv : inv; }
#pragma unroll
    for (int d0 = 0; d0 < 2; ++d0)
#pragma unroll
        for (int r = 0; r < 16; ++r) acc[d0][r] = first ? o[d0][r] * sc[r] : acc[d0][r] + o[d0][r] * sc[r];
}
__device__ __forceinline__ void branch_finish_lds(LAS float* wsf, LAS float* accw, const att::f32x16& ol, float rowscale, const att::f32x16 (&o)[2], const att::Lane& L, bool first) {
    float sc[16]; att::rows_to_regs(wsf, rowscale, L.r32, L.hi, sc);
#pragma unroll
    for (int r = 0; r < 16; ++r) sc[r] = ol[r] > 0.f ? sc[r] * __builtin_amdgcn_rcpf(ol[r]) : 0.f;
#pragma unroll
    for (int d0 = 0; d0 < 2; ++d0)
#pragma unroll
        for (int r = 0; r < 16; ++r) { float v = o[d0][r] * sc[r]; if (!first) v += accw[(d0 * 16 + r) * 64 + L.lane]; accw[(d0 * 16 + r) * 64 + L.lane] = v; }
}
__device__ __forceinline__ float gain_bound(const float* g, int lane) { return wave_max(fabsf(g[lane])); }

template <int KIND  >
__device__ __forceinline__ void simple_unit(Frame& F, int l, int b, int kvh, int i, bf16* odst = nullptr) {
    using namespace att;
    const UnitGeom U = unit_geom(F, b, kvh, i); const Lane& L = U.L;
    constexpr int QT = KIND == 0 ? 1 : 0, KT = KIND == 0 ? 1 : 0, NM = KIND == 0 ? 1 : 0;
    bf16* Q = (bf16*)(F.ws + WS_ZQ) + (size_t)QT * M * 512; const bf16* KV = (const bf16*)(F.ws + WS_ZKV) + (size_t)KT * M * 256;
    bf16x8 qr[4]; load_q(Q + U.mrow * 512 + U.head * 64, L.hi, qr);
    const float C = 0.f; (void)NM;
    KVSrc S{(const GAS bf16*)(KV + (size_t)b * SEQ * 256 + kvh * 64), (const GAS bf16*)(KV + (size_t)b * SEQ * 256 + 128 + kvh * 64), 256, SEQ};
    f32x16 ol, o[2];
#pragma unroll
    for (int r = 0; r < 16; ++r) { o[0][r] = 0.f; o[1][r] = 0.f; ol[r] = 0.f; }
    const int q = U.q;
    if (KIND == 0) {
        auto mf = [q](int t) -> u64 { return mask_le(q - 64 * t) & mask_ge(q - 127 - 64 * t); };
        attend_range((LAS char*)F.lds, S, i - 2 < 0 ? 0 : i - 2, i + 1, mf, qr, -C, ol, o, L);
    } else {
        LAS char* mrows = (LAS char*)F.lds + L_OST + L.wid * 8192 + 4096;
        { const GAS u32x4* src = (const GAS u32x4*)((const GAS u64*)(F.ws + WS_BM) + ((size_t)b * SEQ + 64 * i + 8 * L.wid) * 64);
#pragma unroll
          for (int k = 0; k < 4; ++k) *(LAS u32x4*)(mrows + (k * 64 + L.lane) * 16) = src[k * 64 + L.lane];
          WAVE_LDS_FENCE(); }
        LAS const char* mrow = mrows + (L.r32 >> 2) * 512;
        auto mf = [mrow](int t) -> u64 { return *(LAS const u64*)(mrow + t * 8); };
#ifdef PROBE_TILES
        attend_range((LAS char*)F.lds, S, 0, odst ? (i + 1 < PROBE_TILES ? i + 1 : PROBE_TILES) : i + 1, mf, qr, -C, ol, o, L, odst != nullptr);
#else
        attend_range((LAS char*)F.lds, S, 0, i + 1, mf, qr, -C, ol, o, L, odst != nullptr);
#endif
    }
    const UnitGeom V = unit_geom(F, b, kvh, i); const Lane& L2 = V.L;
    float extra[4] = {0.f, 0.f, 0.f, 0.f};
    if (KIND == 0) {
#pragma unroll
        for (int g = 0; g < 4; ++g) extra[g] = __builtin_amdgcn_exp2f(F.a->in[5][l * 8 + 4 * kvh + g] * LOG2E);
    }
    f32x16 acc[2];
    branch_finish((LAS float*)((LAS char*)F.lds + L_WSF) + L2.wid * WSF_W, ol, extra, 1.f, false, o, acc, L2, true);
    bf16* Q2 = (bf16*)(F.ws + WS_ZQ) + (size_t)QT * M * 512;
    const size_t tok0 = (size_t)b * SEQ + 64 * i + 8 * L2.wid; const int kvh4 = 4 * kvh;
    bf16* Od = odst ? odst : Q2;
    auto rowptr = [Od, tok0, kvh4](int row) -> bf16* { return Od + (tok0 + (row >> 2)) * 512 + (kvh4 + (row & 3)) * 64; };
    store_o((LAS char*)F.lds + L_OST + L2.wid * 8192, acc, rowptr, L2.lane, L2.r32, L2.hi);
}
__device__ __forceinline__ void nsa_unit(Frame& F, int l, int b, int kvh, int i, bf16* odst = nullptr) {
    using namespace att;
    f32x16 o[2], ol;
    bf16x8 qr[4];
    {
        const UnitGeom U = unit_geom(F, b, kvh, i); const Lane& L = U.L;
        const bf16* Q = (const bf16*)(F.ws + WS_ZQ) + (size_t)2 * M * 512; const bf16* MISC = (const bf16*)(F.ws + WS_ZKV) + (size_t)6 * M * 256;
        load_q(Q + U.mrow * 512 + U.head * 64, L.hi, qr);
        LAS float* wsf = (LAS float*)((LAS char*)F.lds + L_WSF) + L.wid * WSF_W;
#pragma unroll
        for (int br = 0; br < 3; ++br) wsf[64 + br * 64 + L.lane] = pg8::sigmoidf_(bf2f(((const GAS bf16*)MISC)[U.mrow * 256 + 68 + U.head * 3 + br]));
        WAVE_LDS_FENCE();
    }
    const float Ck = 0.f, Cc = 0.f;
    const int qmax = 64 * i + 63; const int nvmax = qmax >= 31 ? (((qmax - 31) >> 4) + 1 < 255 ? ((qmax - 31) >> 4) + 1 : 255) : 0;
    const int tc = (nvmax + 63) >> 6;
    const bf16* kcmp = (const bf16*)(F.ws + WS_KCMP) + (size_t)((0 * 4 + b) * 2 + kvh) * 256 * 64; const bf16* vcmp = (const bf16*)(F.ws + WS_KCMP) + (size_t)((1 * 4 + b) * 2 + kvh) * 256 * 64;
    {
        const UnitGeom U = unit_geom(F, b, kvh, i); const Lane& L = U.L; const int q = U.q;
        const int nval = q >= 31 ? (((q - 31) >> 4) + 1 < 255 ? ((q - 31) >> 4) + 1 : 255) : 0;
        KVSrc Sc{(const GAS bf16*)kcmp, (const GAS bf16*)vcmp, 64, 256};
        auto mfc = [nval](int t) -> u64 { return mask_le(nval - 1 - 64 * t); };
#pragma unroll
        for (int r = 0; r < 16; ++r) { o[0][r] = 0.f; o[1][r] = 0.f; ol[r] = 0.f; }
        attend_range((LAS char*)F.lds, Sc, 0, tc, mfc, qr, -Cc, ol, o, L);
    }
    const UnitGeom U = unit_geom(F, b, kvh, i); const Lane& L = U.L; const int q = U.q;
    LAS float* wsf = (LAS float*)((LAS char*)F.lds + L_WSF) + L.wid * WSF_W;
    LAS float* accw = (LAS float*)((LAS char*)F.lds + L_OST + L.wid * 8192);
    const int nval = q >= 31 ? (((q - 31) >> 4) + 1 < 255 ? ((q - 31) >> 4) + 1 : 255) : 0;
    auto mfc = [nval](int t) -> u64 { return mask_le(nval - 1 - 64 * t); };
    WAVE_LDS_FENCE();
    if (L.r32 == 0) {
#pragma unroll
        for (int r = 0; r < 16; ++r) wsf[32 + crow(r, L.hi)] = ol[r]; }
    WAVE_LDS_FENCE();
    const float lc = wsf[32 + L.r32]; const float rlc = lc > 0.f ? __builtin_amdgcn_rcpf(lc) : 0.f;
    branch_finish_lds(wsf, accw, ol, wsf[64 + L.lane], o, L, true);
    LAS float* impw = (LAS float*)((LAS char*)F.lds + L_IMP) + L.wid * 512;
#pragma unroll
    for (int k = 0; k < 8; ++k) impw[L.lane + 64 * k] = 0.f;
    WAVE_LDS_FENCE();
    for (int t = 0; t < tc; ++t) {
        f32x16 p0, p1;
#pragma unroll
        for (int r = 0; r < 16; ++r) { p0[r] = 0.f; p1[r] = 0.f; }
        qk_tile((LAS char*)F.lds + L_K0 + t * 8320, qr, p0, p1, L.r32, L.hi);
        const u64 mk = mfc(t); const unsigned m0 = (unsigned)(mk >> (4 * L.hi)), m1 = (unsigned)(mk >> (32 + 4 * L.hi));
        const int qloc = L.r32 >> 2; const bool wr = (L.r32 & 3) == 0;
#pragma unroll
        for (int half = 0; half < 2; ++half)
#pragma unroll
            for (int m = 0; m < 4; ++m) {
                float e[4];
#pragma unroll
                for (int k = 0; k < 4; ++k) { const int r = 4 * m + k, bit = k + 8 * m; const float x = half ? p1[r] : p0[r]; const unsigned mm = half ? m1 : m0;
                    e[k] = ((mm >> bit) & 1u) ? __builtin_amdgcn_exp2f(x) * rlc : 0.f; }
                const float core = dpp_quad_sum((e[0] + e[1]) + (e[2] + e[3])), edge = dpp_quad_sum(e[3]);
                const int j = 16 * t + 8 * half + 2 * m + L.hi;
                if (wr) { impw[qloc * 64 + j] += core; }
                WAVE_LDS_FENCE();
                if (wr && j + 1 < 64) { impw[qloc * 64 + j + 1] += edge; }
                WAVE_LDS_FENCE();
            }
    }
    __syncthreads();
    {
        const int qloc = L.lane >> 3, sub = L.lane & 7; const int cur = i;
        u64 keys[8];
#pragma unroll
        for (int k = 0; k < 8; ++k) { const int j = sub + 8 * k; float v = impw[qloc * 64 + j];
            if (j == 0 || j == cur || j == cur - 1) v = 1e9f;
            if (j > cur) v = -1e30f;
            keys[k] = ((u64)f2key(v) << 32) | (u64)(63 - j); }
        u64 selm = 0ull; unsigned used = 0u;
#pragma unroll 1
        for (int it = 0; it < 16; ++it) {
            u64 best = 0ull;
#pragma unroll
            for (int k = 0; k < 8; ++k) { const u64 c = ((used >> k) & 1u) ? 0ull : keys[k]; best = c > best ? c : best; }
#pragma unroll
            for (int o2 = 1; o2 < 8; o2 <<= 1) { const unsigned lo = __shfl_xor((unsigned)best, o2), hi2 = __shfl_xor((unsigned)(best >> 32), o2); const u64 ob = ((u64)hi2 << 32) | lo; best = ob > best ? ob : best; }
            const int jsel = 63 - (int)(best & 63ull);
            if ((jsel & 7) == sub) used |= 1u << (jsel >> 3);
            selm |= 1ull << jsel;
        }
        LAS u64* selw = (LAS u64*)((LAS char*)F.lds + L_SEL) + L.wid * 8;
        if (sub == 0) selw[qloc] = selm;
        WAVE_LDS_FENCE();
    }
    {
        const UnitGeom X = unit_geom(F, b, kvh, i); const Lane& L = X.L; const int q = X.q;
        const u64 sel = ((LAS const u64*)((LAS char*)F.lds + L_SEL))[L.wid * 8 + (L.r32 >> 2)];
        const bf16* KV = (const bf16*)(F.ws + WS_ZKV) + (size_t)3 * M * 256;
        KVSrc S{(const GAS bf16*)(KV + (size_t)b * SEQ * 256 + kvh * 64), (const GAS bf16*)(KV + (size_t)b * SEQ * 256 + 128 + kvh * 64), 256, SEQ};
        auto mf = [sel, q](int t) -> u64 { return ((sel >> t) & 1ull) ? mask_le(q - 64 * t) : 0ull; };
#pragma unroll
        for (int r = 0; r < 16; ++r) { o[0][r] = 0.f; o[1][r] = 0.f; ol[r] = 0.f; }
        attend_range((LAS char*)F.lds, S, 0, i + 1, mf, qr, -Ck, ol, o, L);
        const UnitGeom W = unit_geom(F, b, kvh, i); LAS float* wsf2 = (LAS float*)((LAS char*)F.lds + L_WSF) + W.L.wid * WSF_W;
        branch_finish_lds(wsf2, (LAS float*)((LAS char*)F.lds + L_OST + W.L.wid * 8192), ol, wsf2[128 + W.L.lane], o, W.L, false);
    }
    {
        const UnitGeom X = unit_geom(F, b, kvh, i); const Lane& L = X.L; const int q = X.q;
        const bf16* KV = (const bf16*)(F.ws + WS_ZKV) + (size_t)4 * M * 256;
        KVSrc S{(const GAS bf16*)(KV + (size_t)b * SEQ * 256 + kvh * 64), (const GAS bf16*)(KV + (size_t)b * SEQ * 256 + 128 + kvh * 64), 256, SEQ};
        auto mf = [q](int t) -> u64 { return mask_le(q - 64 * t) & mask_ge(q - 511 - 64 * t); };
#pragma unroll
        for (int r = 0; r < 16; ++r) { o[0][r] = 0.f; o[1][r] = 0.f; ol[r] = 0.f; }
        attend_range((LAS char*)F.lds, S, i - 8 < 0 ? 0 : i - 8, i + 1, mf, qr, -Ck, ol, o, L);
        const UnitGeom W = unit_geom(F, b, kvh, i); LAS float* wsf2 = (LAS float*)((LAS char*)F.lds + L_WSF) + W.L.wid * WSF_W;
        branch_finish_lds(wsf2, (LAS float*)((LAS char*)F.lds + L_OST + W.L.wid * 8192), ol, wsf2[192 + W.L.lane], o, W.L, false);
    }
    {
        const UnitGeom X = unit_geom(F, b, kvh, i); const Lane& L = X.L;
        LAS float* accw2 = (LAS float*)((LAS char*)F.lds + L_OST + L.wid * 8192);
        const size_t tok0 = (size_t)b * SEQ + 64 * i + 8 * L.wid; const int kvh4 = 4 * kvh;
        bf16* Od = odst ? odst : (bf16*)(F.ws + WS_ZQ) + (size_t)2 * M * 512;
        auto rowptr = [Od, tok0, kvh4](int row) -> bf16* { return Od + (tok0 + (row >> 2)) * 512 + (kvh4 + (row & 3)) * 64; };
        f32x16 acc[2];
#pragma unroll
        for (int d0 = 0; d0 < 2; ++d0)
#pragma unroll
            for (int r = 0; r < 16; ++r) acc[d0][r] = accw2[(d0 * 16 + r) * 64 + L.lane];
        WAVE_LDS_FENCE();
        store_o((LAS char*)F.lds + L_OST + L.wid * 8192, acc, rowptr, L.lane, L.r32, L.hi);
    }
}

__global__ void __launch_bounds__(NWAVES * 64, 2) mk_fwd(Args args) {
    extern __shared__ __attribute__((aligned(16))) unsigned char lds_raw[];
    LAS unsigned char* lds = (LAS unsigned char*)lds_raw;
    volatile LAS unsigned* MISCW = (volatile LAS unsigned*)(lds + LDS_UNIT + 16);
    if (threadIdx.x < 8) MISCW[threadIdx.x] = 0u;
    __syncthreads();
    (void)xcd_barrier_post((unsigned*)((gu32*)(args.ws + WS_CTL) + CW_BAR), MISCW);
#define GRID_BARRIER() do { unsigned char* wsb_ = args.ws; asm volatile("" : "+s"(wsb_)); XcdBarrier bar_; bar_.bar = (unsigned*)((gu32*)(wsb_ + WS_CTL) + CW_BAR); bar_.x = xb_xcc_id(); \
    bar_.st = (volatile LAS unsigned*)(lds + LDS_UNIT + 16); xcd_barrier(bar_); } while (0)
#define MKFRAME() Frame F; { unsigned char* ws_ = args.ws; asm volatile("" : "+s"(ws_)); int tid_ = threadIdx.x; asm volatile("" : "+v"(tid_)); \
    F.lds = lds; F.tid = tid_; F.lane = tid_ & 63; F.wave = __builtin_amdgcn_readfirstlane(tid_ >> 6); F.G = gridDim.x; F.gw = 0; F.NGW = F.G * NWAVES; \
    F.ws = ws_; F.ctl = (gu32*)(ws_ + WS_CTL); F.a = &args; } int bid = blockIdx.x; asm volatile("" : "+s"(bid)); F.gw = bid * NWAVES + F.wave; \
    unsigned char* ws = F.ws; bf16* XB = (bf16*)(ws + WS_XB); bf16* MB = (bf16*)(ws + WS_MB); bf16* ZQ = (bf16*)(ws + WS_ZQ); bf16* ZKV = (bf16*)(ws + WS_ZKV); bf16* YS = (bf16*)(ws + WS_YS); bf16* HM = (bf16*)(ws + WS_HMID); \
    float* SSQ = (float*)(ws + WS_SSQ); (void)XB; (void)MB; (void)ZQ; (void)ZKV; (void)YS; (void)HM; (void)SSQ;
#define WL(l) (ws + WS_W + (size_t)(l) * W_LAYER)
#ifdef PROBE_T
#define STAMP(k) do { if (blockIdx.x == 0 && threadIdx.x == 0) ((unsigned long long*)(args.ws + WS_CTL + 96 * 1024))[k] = __builtin_amdgcn_s_memrealtime(); } while (0)
#else
#define STAMP(k) do { } while (0)
#endif

    STAMP(0);
#ifndef NO_P0
    { MKFRAME(); p0_prologue(F); }
#ifdef DBL_P0
    { MKFRAME(); p0_prologue(F); }
#endif
#endif
    GRID_BARRIER();
    STAMP(1);
#pragma unroll 1
    for (int l = 0; l < DEPTH; ++l) {
#ifndef NO_G1
#ifdef DBL_G1
        for (int rep_ = 0; rep_ < 2; ++rep_)
#endif
        {
            MKFRAME(); unsigned char* wl = WL(l);
            pg8::Gemm g{XB, (const bf16*)(wl + W_IN), M, 3328, DM}; pg8::StaticOrder S; S.init(M, 3328, F.G, bid);
            pg8::EpiG1 E{ZQ, ZKV, SSQ};
            pg8::gemm_phase<pg8::EpiG1, pg8::StaticOrder, true, true>(F.lds, g, S, E);
        }
#endif
        GRID_BARRIER();
        STAMP(2 + 8 * l);
#ifndef NO_POST
        { MKFRAME(); post_phase(F, l); }
#ifdef DBL_POST
        { MKFRAME(); post_phase(F, l, true); }
#endif
#endif
        GRID_BARRIER();
        STAMP(3 + 8 * l);
#ifdef DBL_ATT1
        for (int rep1_ = 0; rep1_ < 2; ++rep1_)
#else
        const int rep1_ = 0;
#endif
        {
            MKFRAME();
            const int xcd = (int)(xb_xcc_id() & 7u);
#pragma unroll 1
            for (int qi = 0; qi < 8; ++qi) {
                const int x = (xcd + qi) & 7, b = x >> 1, sub = x & 1;
                gu32* ctr = F.ctl + CW_Q + 64 * ((2 * l + 4 * rep1_) * 8 + x);
                for (;;) { const int v = next_unit(F, ctr); if (v >= 16 + 256 + 64) break;
#ifdef DBL_ATT1
                    if (v < 16) { if (rep1_ == 0 || DBL_ATT1 == 1 || DBL_ATT1 == 2) compress_unit(F, l, (v & 1) | (sub << 1) | (b << 2) | ((v >> 1) << 4)); }
                    else if (v < 16 + 256) { if (rep1_ == 0 || DBL_ATT1 == 1 || DBL_ATT1 == 3 || DBL_ATT1 >= 5) select_unit(F, b, 2 * (255 - (v - 16)) + sub, rep1_ ? (DBL_ATT1 >= 5 ? DBL_ATT1 - 4 : 0) : 0  ); }
                    else if (rep1_ && DBL_ATT1 != 1 && DBL_ATT1 != 4) { }
#else
                    if (v < 16) { compress_unit(F, l, (v & 1) | (sub << 1) | (b << 2) | ((v >> 1) << 4)); }
                    else if (v < 16 + 256) { select_unit(F, b, 2 * (255 - (v - 16)) + sub); }
#endif
                    else { simple_unit<0>(F, l, b, sub, 63 - (v - 272), rep1_ ? (bf16*)(ws + WS_MB + 8 * MiB) : nullptr); }
                }
            }
        }
        GRID_BARRIER();
        STAMP(4 + 8 * l);
#ifdef DBL_ATT2
        for (int rep_ = 0; rep_ < 2; ++rep_)
#else
        const int rep_ = 0;
#endif
        {
            MKFRAME();
            bf16* od = rep_ ? (bf16*)(ws + WS_MB) : nullptr;
            const int xcd = (int)(xb_xcc_id() & 7u);
#pragma unroll 1
            for (int qi = 0; qi < 8; ++qi) {
                const int x = (xcd + qi) & 7, b = x >> 1, kvh = x & 1;
                gu32* ctr = F.ctl + CW_Q + 64 * ((2 * l + 1 + 4 * rep_) * 8 + x);
                for (;;) { const int v = next_unit(F, ctr); if (v >= 128) break;
                    const int i = 63 - (v >> 1);
#ifdef DBL_ATT2
                    if ((v & 1) && (rep_ == 0 || DBL_ATT2 != 3)) simple_unit<1>(F, l, b, kvh, i, od);
                    if (!(v & 1) && (rep_ == 0 || DBL_ATT2 != 2)) nsa_unit(F, l, b, kvh, i, od);
#else
                    if (v & 1) simple_unit<1>(F, l, b, kvh, i, od); else nsa_unit(F, l, b, kvh, i, od);
#endif
                }
            }
        }
        GRID_BARRIER();
        STAMP(5 + 8 * l);
#ifndef NO_G2
#ifdef DBL_G2
        for (int rep_ = 0; rep_ < 2; ++rep_)
#endif
        {   MKFRAME(); unsigned char* wl = WL(l);
            pg8::StaticOrder S; S.init(M, DM, F.G, bid); pg8::Unit u0; S.next(0, u0);
            pg8::ProgG2 P{u0.pm, u0.pn, ZQ, (const bf16*)(wl + W_BR), XB, (const bf16*)(wl + W_G), YS, MB, SSQ};
            pg8::gemm_chain<pg8::ProgG2>(F.lds, P); }
#endif
        GRID_BARRIER();
        STAMP(6 + 8 * l);
#ifndef NO_G3
        {
            MKFRAME(); unsigned char* wl = WL(l);
            pg8::Gemm g{MB, (const bf16*)(wl + W_OUT), M, DM, DM}; pg8::StaticOrder S; S.init(M, DM, F.G, bid);
            pg8::EpiRes E{l == 0 ? F.a->in[0] : (const float*)F.a->out, F.a->out, XB, SSQ};
            pg8::gemm_phase<pg8::EpiRes, pg8::StaticOrder, false, true>(F.lds, g, S, E);
        }
#ifdef DBL_G3
        {   MKFRAME(); unsigned char* wl = WL(l);
            pg8::Gemm g{MB, (const bf16*)(wl + W_OUT), M, DM, DM}; pg8::StaticOrder S; S.init(M, DM, F.G, bid);
            pg8::EpiRes E{F.a->in[0], (float*)(ws + 0), (bf16*)(ws + 64 * MiB), (float*)(ws + 96 * MiB)};
            pg8::gemm_phase<pg8::EpiRes, pg8::StaticOrder, false, true>(F.lds, g, S, E);
        }
#endif
#endif
        GRID_BARRIER();
        STAMP(7 + 8 * l);
#ifndef NO_G4
#ifdef DBL_G4
        for (int rep_ = 0; rep_ < 2; ++rep_)
#endif
        {
            MKFRAME(); unsigned char* wl = WL(l);
            pg8::Gemm g{XB, (const bf16*)(wl + W_UP), M, DFF, DM}; pg8::StaticOrder S; S.init(M, DFF, F.G, bid);
            pg8::EpiG4 E{HM, SSQ};
            pg8::gemm_phase<pg8::EpiG4, pg8::StaticOrder, true, true>(F.lds, g, S, E);
        }
#endif
        GRID_BARRIER();
        STAMP(8 + 8 * l);
#ifndef NO_G5
        {
            MKFRAME(); unsigned char* wl = WL(l);
            pg8::Gemm g{HM, (const bf16*)(wl + W_DN), M, DM, DFF}; pg8::StaticOrder S; S.init(M, DM, F.G, bid);
            pg8::EpiRes E{(const float*)F.a->out, F.a->out, XB, SSQ};
            pg8::gemm_phase<pg8::EpiRes, pg8::StaticOrder, false, true>(F.lds, g, S, E);
        }
#ifdef DBL_G5
        {   MKFRAME(); unsigned char* wl = WL(l);
            pg8::Gemm g{HM, (const bf16*)(wl + W_DN), M, DM, DFF}; pg8::StaticOrder S; S.init(M, DM, F.G, bid);
            pg8::EpiNull E{};
            pg8::gemm_phase<pg8::EpiNull, pg8::StaticOrder, false, true>(F.lds, g, S, E);
        }
#endif
#endif
#ifdef PROBE_T
        GRID_BARRIER();
        STAMP(9 + 8 * l);
#else
        if (l + 1 < DEPTH) GRID_BARRIER();
#endif
#ifdef DBL_BAR
        for (int rep_ = 0; rep_ < 16; ++rep_) GRID_BARRIER();
#endif
    }
#ifdef PROBE_T
    {
        GRID_BARRIER();
        const unsigned long long* st = (const unsigned long long*)(args.ws + WS_CTL + 96 * 1024);
        float tus;
        if (PROBE_T == 0) tus = (float)(st[1] - st[0]) * 0.01f;
        else tus = 0.5f * ((float)(st[PROBE_T + 1] - st[PROBE_T]) + (float)(st[PROBE_T + 9] - st[PROBE_T + 8])) * 0.01f;
        const float sc = 1.0f + tus * 0.001f;
        float* o = args.out;
        for (size_t i = (size_t)blockIdx.x * 512 + threadIdx.x; i < (size_t)M * DM; i += (size_t)gridDim.x * 512) o[i] *= sc;
    }
#endif
}

extern "C" void kernel_launch(void* const* d_in, const int* in_sizes, int n_in, void* d_out, int out_size, void* d_ws, size_t ws_size, hipStream_t stream) {
    static int grid = 0;
    if (grid == 0) {
        if (n_in != 17 || out_size != M * DM || ws_size < WS_END) { fprintf(stderr, "kernel_launch: unexpected problem shape (n_in %d out %d ws %zu)\n", n_in, out_size, ws_size); grid = -1; return; }
        int dev = 0, cus = 0, per_cu = 0;
        if (hipGetDevice(&dev) != hipSuccess || hipDeviceGetAttribute(&cus, hipDeviceAttributeMultiprocessorCount, dev) != hipSuccess) { grid = -1; return; }
        if (hipFuncSetAttribute((const void*)mk_fwd, hipFuncAttributeMaxDynamicSharedMemorySize, LDS_BYTES) != hipSuccess) { fprintf(stderr, "kernel_launch: hipFuncSetAttribute failed\n"); grid = -1; return; }
        if (hipOccupancyMaxActiveBlocksPerMultiprocessor(&per_cu, (const void*)mk_fwd, NWAVES * 64, LDS_BYTES) != hipSuccess || per_cu < 1) { fprintf(stderr, "kernel_launch: occupancy query says %d blocks/CU\n", per_cu); }
        (void)hipGetLastError();
        if (cus != 256) { fprintf(stderr, "kernel_launch: built for a 256-CU device (one 256x256 GEMM unit per workgroup in the N=1024 phases), found %d CUs\n", cus); grid = -1; return; }
        grid = cus;
    }
    if (grid < 0) return;
    (void)hipMemsetAsync((char*)d_ws + WS_CTL, 0, CTL_BYTES, stream);
    Args a{};
    for (int i = 0; i < 17; ++i) a.in[i] = (const float*)d_in[i];
    a.out = (float*)d_out; a.ws = (unsigned char*)d_ws;
    hipLaunchKernelGGL(mk_fwd, dim3(grid), dim3(NWAVES * 64), LDS_BYTES, stream, a);
}
```

```cpp
#include <hip/hip_runtime.h>
#include <cstdio>
#include <cstdint>

namespace pg8 {
#define PG8_LAS __attribute__((address_space(3)))
typedef unsigned short bf16_t;
typedef short bf16x8 __attribute__((ext_vector_type(8)));
typedef float f32x4 __attribute__((ext_vector_type(4)));
typedef unsigned u32x4 __attribute__((ext_vector_type(4)));
constexpr int BM = 256, BK = 64, HALF = 128, HTB = HALF * BK * 2  , STAGE_BYTES = 8 * HTB, NXCD = 8, WGM = 8;

__host__ __device__ __forceinline__ int lds_byte(int r, int c) { const int st = (r >> 4) * 2 + (c >> 5), rr = r & 15, cc = c & 31, ob = rr * 64 + cc * 2; return st * 1024 + (ob ^ (((ob >> 9) & 1) << 5)); }
__host__ __device__ __forceinline__ void stage_rc(int b, int& R, int& C) { const int st = b / 1024, sb = b % 1024, swz = sb ^ (((sb >> 9) & 1) << 5); R = (st >> 1) * 16 + swz / 64; C = (st & 1) * 32 + (swz % 64) / 2; }
__host__ __device__ __forceinline__ int perm32(int rho) { const int n = rho >> 4, i = rho & 15; return 8 * (i >> 2) + 4 * n + (i & 3); }

struct Unit { int pm, pn; };
struct Gemm { const bf16_t* A; const bf16_t* Bt; int M, N, K; };

struct StaticOrder {
    int nM, nN, nwg, G, c;
    __host__ __device__ void init(int M, int N, int G_, int c_) { nM = M / BM; nN = N / BM; nwg = nM * nN; G = G_; c = c_; }
    __host__ __device__ bool next(int i, Unit& u) const {
        const long L = (long)i * G + c; if (L >= nwg) return false;
        int wgid = (int)L; { const int q = nwg / NXCD, r = nwg % NXCD, xcd = wgid % NXCD, off = wgid / NXCD; wgid = (xcd < r ? xcd * (q + 1) : r * (q + 1) + (xcd - r) * q) + off; }
        const int nig = WGM * nN, gid = wgid / nig, fm = gid * WGM, gsz = (nM - fm) < WGM ? (nM - fm) : WGM;
        u.pm = fm + ((wgid % nig) % gsz); u.pn = (wgid % nig) / gsz; return true;
    }
    __device__ __forceinline__ void a_ready(const Unit&) const {}
    __device__ __forceinline__ void done(const Unit&) const {}
};

__device__ __forceinline__ unsigned cvt_pk_bf16(float lo, float hi) { unsigned r; asm volatile("v_cvt_pk_bf16_f32 %0, %1, %2" : "=v"(r) : "v"(lo), "v"(hi)); return r; }
template <class Epi, class Sched, bool ALIGN_EPI = false, bool SP2 = false>
__device__ __forceinline__ void gemm_phase(PG8_LAS unsigned char* lds, const Gemm g, const Sched& S, const Epi& E) {
    int tid_l = threadIdx.x; asm volatile("" : "+v"(tid_l));
    const int tid = tid_l, wid = __builtin_amdgcn_readfirstlane(tid >> 6), lane = tid & 63, wr = wid >> 2, wc = wid & 3, fr = lane & 15, fq = lane >> 4;
    const int K = g.K, nt = K / BK;
    unsigned voffA[2], voffB[2];
#pragma unroll
    for (int i = 0; i < 2; ++i) { int R, C; stage_rc(tid * 16 + i * 8192, R, C); const int Rb = Epi::PERM ? ((R & ~31) + perm32(R & 31)) : R;
        voffA[i] = (unsigned)(R * K + C) * 2u; voffB[i] = (unsigned)(Rb * K + C) * 2u; }
    const size_t kstep = (size_t)(BK * 2);
    const size_t hstep = (size_t)HALF * K * 2;
    const size_t tstep = 2 * hstep;
    const unsigned ldsw = (unsigned)wid * 1024u;
    const int aoff = lds_byte(wr * 64 + fr, fq * 8), boff = lds_byte(wc * 32 + fr, fq * 8);
#define PG8_SA(b, h) (((b) * 2 + (h)) * HTB)
#define PG8_SB(b, h) ((4 + (b) * 2 + (h)) * HTB)
#define PG8_STAGE(bufoff, gbase, voff) do { _Pragma("unroll") for (int _i = 0; _i < 2; ++_i) \
        __builtin_amdgcn_global_load_lds((const unsigned*)((const char*)(gbase) + (voff)[_i]), (PG8_LAS unsigned*)(lds + (bufoff) + ldsw + _i * 8192), 16, 0, 0); } while (0)
#define PG8_LDA(dst, b, h) do { _Pragma("unroll") for (int m = 0; m < 4; ++m) _Pragma("unroll") for (int k = 0; k < 2; ++k) dst[m][k] = *(const PG8_LAS bf16x8*)(lds + PG8_SA(b, h) + aoff + m * 2048 + k * 1024); } while (0)
#define PG8_LDB(dst, b, h) do { _Pragma("unroll") for (int n = 0; n < 2; ++n) _Pragma("unroll") for (int k = 0; k < 2; ++k) dst[n][k] = *(const PG8_LAS bf16x8*)(lds + PG8_SB(b, h) + boff + n * 2048 + k * 1024); } while (0)
#define PG8_MMA(ai, bj, At, Bt) do { __builtin_amdgcn_s_setprio(1); _Pragma("unroll") for (int m = 0; m < 4; ++m) _Pragma("unroll") for (int n = 0; n < 2; ++n) _Pragma("unroll") for (int k = 0; k < 2; ++k) \
        acc[ai][bj][m][n] = __builtin_amdgcn_mfma_f32_16x16x32_bf16(Bt[n][k], At[m][k], acc[ai][bj][m][n], 0, 0, 0); __builtin_amdgcn_s_setprio(0); } while (0)
#define PG8_WAIT_V(n) asm volatile("s_waitcnt vmcnt(" #n ")" ::: "memory")
#define PG8_WAIT_L(n) asm volatile("s_waitcnt lgkmcnt(" #n ")" ::: "memory")
#define PG8_BAR __builtin_amdgcn_s_barrier()
#define PG8_SCHED __builtin_amdgcn_sched_barrier(0)
    Unit cur, nxt; int ui = 0;
    if (!S.next(0, cur)) return;
    f32x4 acc[2][2][4][2];
#pragma unroll
    for (int a = 0; a < 2; ++a)
#pragma unroll
        for (int b = 0; b < 2; ++b)
#pragma unroll
            for (int m = 0; m < 4; ++m)
#pragma unroll
                for (int n = 0; n < 2; ++n) acc[a][b][m][n] = (f32x4){0.f, 0.f, 0.f, 0.f};
    bf16x8 At[4][2], B0[2][2], B1[2][2];
    const char* cA = (const char*)g.A + (size_t)cur.pm * tstep; const char* cB = (const char*)g.Bt + (size_t)cur.pn * tstep;
    S.a_ready(cur);
    if constexpr (SP2) {
        PG8_STAGE(PG8_SB(0, 0), cB, voffB); PG8_STAGE(PG8_SB(0, 1), cB + hstep, voffB); PG8_STAGE(PG8_SA(0, 0), cA, voffA); PG8_STAGE(PG8_SA(0, 1), cA + hstep, voffA);
        if (wr == 1) PG8_BAR;
        PG8_WAIT_V(2); PG8_BAR;
        PG8_STAGE(PG8_SB(1, 0), cB + kstep, voffB); PG8_STAGE(PG8_SA(1, 0), cA + kstep, voffA); PG8_STAGE(PG8_SB(1, 1), cB + hstep + kstep, voffB);
        PG8_WAIT_V(6); PG8_BAR;
    } else {
        PG8_STAGE(PG8_SB(0, 0), cB, voffB); PG8_STAGE(PG8_SA(0, 0), cA, voffA); PG8_STAGE(PG8_SB(0, 1), cB + hstep, voffB); PG8_STAGE(PG8_SA(0, 1), cA + hstep, voffA);
        if (wr == 1) PG8_BAR;
        PG8_WAIT_V(4); PG8_BAR;
        PG8_STAGE(PG8_SB(1, 0), cB + kstep, voffB); PG8_STAGE(PG8_SA(1, 0), cA + kstep, voffA); PG8_STAGE(PG8_SB(1, 1), cB + hstep + kstep, voffB);
        PG8_WAIT_V(6); PG8_BAR;
    }
    for (;;) {
        const bool has_next = S.next(ui + 1, nxt);
        const char* nA = has_next ? (const char*)g.A + (size_t)nxt.pm * tstep : cA; const char* nB = has_next ? (const char*)g.Bt + (size_t)nxt.pn * tstep : cB;
        for (int t = 0; t < nt; t += 2) {
            const bool last = (t == nt - 2);
            const char* a1 = cA + (size_t)(t + 1) * kstep;
            const char* a2 = last ? nA : cA + (size_t)(t + 2) * kstep; const char* b2 = last ? nB : cB + (size_t)(t + 2) * kstep;
            const char* a3 = a2 + kstep; const char* b3 = b2 + kstep;
            if (last && has_next) S.a_ready(nxt);
            if constexpr (SP2) {
            PG8_LDB(B0, 0, 0); PG8_LDB(B1, 0, 1); PG8_SCHED; PG8_LDA(At, 0, 0); PG8_STAGE(PG8_SA(1, 1), a1 + hstep, voffA);
            PG8_WAIT_V(8); PG8_WAIT_L(0); PG8_BAR; PG8_MMA(0, 0, At, B0); PG8_MMA(0, 1, At, B1); PG8_BAR; PG8_SCHED;
            PG8_LDA(At, 0, 1); PG8_STAGE(PG8_SB(0, 0), b2, voffB); PG8_STAGE(PG8_SB(0, 1), b2 + hstep, voffB); PG8_STAGE(PG8_SA(0, 0), a2, voffA);
            PG8_WAIT_V(8); PG8_WAIT_L(0); PG8_BAR; PG8_MMA(1, 0, At, B0); PG8_MMA(1, 1, At, B1); PG8_BAR; PG8_SCHED;
            PG8_LDB(B0, 1, 0); PG8_LDB(B1, 1, 1); PG8_SCHED; PG8_LDA(At, 1, 0); PG8_STAGE(PG8_SA(0, 1), a2 + hstep, voffA);
            PG8_WAIT_V(8); PG8_WAIT_L(0); PG8_BAR; PG8_MMA(0, 0, At, B0); PG8_MMA(0, 1, At, B1); PG8_BAR; PG8_SCHED;
            PG8_LDA(At, 1, 1); PG8_STAGE(PG8_SB(1, 0), b3, voffB); PG8_STAGE(PG8_SB(1, 1), b3 + hstep, voffB); PG8_STAGE(PG8_SA(1, 0), a3, voffA);
            PG8_WAIT_V(8); PG8_WAIT_L(0); PG8_BAR; PG8_MMA(1, 0, At, B0); PG8_MMA(1, 1, At, B1); PG8_BAR; PG8_SCHED;
            } else {
            PG8_LDB(B0, 0, 0); PG8_SCHED; PG8_LDA(At, 0, 0); PG8_STAGE(PG8_SA(1, 1), a1 + hstep, voffA);
            PG8_WAIT_L(8); PG8_BAR; PG8_WAIT_L(0); PG8_MMA(0, 0, At, B0); PG8_BAR; PG8_SCHED;
            PG8_LDB(B1, 0, 1); PG8_STAGE(PG8_SB(0, 0), b2, voffB);
            PG8_BAR; PG8_WAIT_L(0); PG8_MMA(0, 1, At, B1); PG8_BAR;
            PG8_LDA(At, 0, 1); PG8_STAGE(PG8_SA(0, 0), a2, voffA);
            PG8_BAR; PG8_WAIT_L(0); PG8_MMA(1, 0, At, B0); PG8_BAR; PG8_SCHED;
            PG8_STAGE(PG8_SB(0, 1), b2 + hstep, voffB);
            PG8_WAIT_V(6); PG8_BAR; PG8_MMA(1, 1, At, B1); PG8_BAR;
            PG8_LDB(B0, 1, 0); PG8_SCHED; PG8_LDA(At, 1, 0); PG8_STAGE(PG8_SA(0, 1), a2 + hstep, voffA);
            PG8_WAIT_L(8); PG8_BAR; PG8_WAIT_L(0); PG8_MMA(0, 0, At, B0); PG8_BAR; PG8_SCHED;
            PG8_LDB(B1, 1, 1); PG8_STAGE(PG8_SB(1, 0), b3, voffB);
            PG8_BAR; PG8_WAIT_L(0); PG8_MMA(0, 1, At, B1); PG8_BAR;
            PG8_LDA(At, 1, 1); PG8_STAGE(PG8_SA(1, 0), a3, voffA);
            PG8_BAR; PG8_WAIT_L(0); PG8_MMA(1, 0, At, B0); PG8_BAR; PG8_SCHED;
            PG8_STAGE(PG8_SB(1, 1), b3 + hstep, voffB);
            PG8_WAIT_V(6); PG8_BAR; PG8_MMA(1, 1, At, B1); PG8_BAR;
            }
        }
        if constexpr (ALIGN_EPI) { if (wr == 0) PG8_BAR; }
        if constexpr (!Epi::AFTER_DRAIN) { E(acc, cur, wr, wc, fr, fq); S.done(cur); }
        if (!has_next) break;
#pragma unroll
        for (int a = 0; a < 2; ++a)
#pragma unroll
            for (int b = 0; b < 2; ++b)
#pragma unroll
                for (int m = 0; m < 4; ++m)
#pragma unroll
                    for (int n = 0; n < 2; ++n) acc[a][b][m][n] = (f32x4){0.f, 0.f, 0.f, 0.f};
        cur = nxt; cA = nA; cB = nB; ++ui;
        if constexpr (ALIGN_EPI) { if (wr == 1) PG8_BAR; }
    }
    PG8_WAIT_V(0);
    if constexpr (!ALIGN_EPI) { if (wr == 0) PG8_BAR; }
    PG8_BAR;
    if constexpr (Epi::AFTER_DRAIN) { E.fused(acc, cur, wr, wc, fr, fq, lds, wid, lane); S.done(cur); }
#undef PG8_SA
#undef PG8_SB
#undef PG8_STAGE
#undef PG8_LDA
#undef PG8_LDB
#undef PG8_MMA
#undef PG8_WAIT_V
#undef PG8_WAIT_L
#undef PG8_BAR
#undef PG8_SCHED
}
}

namespace pg8 {
#define PG8_GAS __attribute__((address_space(1)))
constexpr int MROWS = 16384;
__device__ __forceinline__ unsigned pk_bf16(float lo, float hi) { typedef float f2 __attribute__((ext_vector_type(2))); typedef __bf16 b2 __attribute__((ext_vector_type(2)));
    f2 v = {lo, hi}; b2 b = __builtin_convertvector(v, b2); return __builtin_bit_cast(unsigned, b); }
__device__ __forceinline__ float bf_lo(unsigned w) { return __uint_as_float(w << 16); }
__device__ __forceinline__ float bf_hi(unsigned w) { return __uint_as_float(w & 0xffff0000u); }
__device__ __forceinline__ float row_rstd(const float* ssq, int row) {
    const PG8_GAS f32x4* p = (const PG8_GAS f32x4*)(ssq + (size_t)row * 16);
    const f32x4 a = p[0], b = p[1], c = p[2], d = p[3];
    const float s = (((a[0] + a[1]) + (a[2] + a[3])) + ((b[0] + b[1]) + (b[2] + b[3]))) + (((c[0] + c[1]) + (c[2] + c[3])) + ((d[0] + d[1]) + (d[2] + d[3])));
    return rsqrtf(s * (1.0f / 1024.0f) + 1e-6f);
}
__device__ __forceinline__ float sigmoidf_(float x) { return __builtin_amdgcn_rcpf(1.0f + __builtin_amdgcn_exp2f(-1.4426950408889634f * x)); }

__device__ __forceinline__ void wave_rstd(const float* ssq, int rowbase, int lane, float (&v)[2]) {
    const PG8_GAS f32x4* p0 = (const PG8_GAS f32x4*)(ssq + (size_t)(rowbase + lane) * 16);
    const PG8_GAS f32x4* p1 = p0 + HALF * 4;
    const f32x4 a = p0[0], b = p0[1], c = p0[2], d = p0[3], e = p1[0], f = p1[1], g = p1[2], h = p1[3];
    const float s0 = (((a[0] + a[1]) + (a[2] + a[3])) + ((b[0] + b[1]) + (b[2] + b[3]))) + (((c[0] + c[1]) + (c[2] + c[3])) + ((d[0] + d[1]) + (d[2] + d[3])));
    const float s1 = (((e[0] + e[1]) + (e[2] + e[3])) + ((f[0] + f[1]) + (f[2] + f[3]))) + (((g[0] + g[1]) + (g[2] + g[3])) + ((h[0] + h[1]) + (h[2] + h[3])));
    v[0] = rsqrtf(s0 * (1.0f / 1024.0f) + 1e-6f); v[1] = rsqrtf(s1 * (1.0f / 1024.0f) + 1e-6f);
}

struct EpiG1 {
    static constexpr bool PERM = true, AFTER_DRAIN = false;
    bf16_t* zq; bf16_t* zkv; const float* ssq;
    __device__ __forceinline__ void operator()(const f32x4 (&acc)[2][2][4][2], const Unit& u, int wr, int wc, int fr, int fq) const {
        const int row0 = u.pm * BM + wr * 64 + fr;
        bf16_t* base; int ldc, colt;
        if (u.pn < 6) { base = zq + (size_t)(u.pn >> 1) * ((size_t)MROWS * 512); ldc = 512; colt = (u.pn & 1) * 256; }
        else { base = zkv + (size_t)(u.pn - 6) * ((size_t)MROWS * 256); ldc = 256; colt = 0; }
        const int col0 = colt + wc * 32 + 8 * fq;
        float rv[2]; wave_rstd(ssq, u.pm * BM + wr * 64, fq * 16 + fr, rv);
#pragma unroll
        for (int ai = 0; ai < 2; ++ai)
#pragma unroll
            for (int m = 0; m < 4; ++m) { const int row = row0 + ai * HALF + m * 16; const float rs = __shfl(rv[ai], m * 16 + fr); bf16_t* rowp = base + (size_t)row * ldc + col0;
#pragma unroll
                for (int bj = 0; bj < 2; ++bj) { const f32x4 v0 = acc[ai][bj][m][0] * rs, v1 = acc[ai][bj][m][1] * rs;
                    u32x4 w; w.x = pk_bf16(v0[0], v0[1]); w.y = pk_bf16(v0[2], v0[3]); w.z = pk_bf16(v1[0], v1[1]); w.w = pk_bf16(v1[2], v1[3]);
                    *(PG8_GAS u32x4*)(rowp + bj * HALF) = w; } }
    }
};
struct EpiG4 {
    static constexpr bool PERM = true, AFTER_DRAIN = false;
    bf16_t* h; const float* ssq;
    __device__ __forceinline__ void operator()(const f32x4 (&acc)[2][2][4][2], const Unit& u, int wr, int wc, int fr, int fq) const {
        const int row0 = u.pm * BM + wr * 64 + fr; const int col0 = u.pn * BM + wc * 32 + 8 * fq;
        float rv[2]; wave_rstd(ssq, u.pm * BM + wr * 64, fq * 16 + fr, rv);
#pragma unroll
        for (int ai = 0; ai < 2; ++ai)
#pragma unroll
            for (int m = 0; m < 4; ++m) { const int row = row0 + ai * HALF + m * 16; const float rs = __shfl(rv[ai], m * 16 + fr); bf16_t* rowp = h + (size_t)row * 4096 + col0;
#pragma unroll
                for (int bj = 0; bj < 2; ++bj) { f32x4 v0 = acc[ai][bj][m][0] * rs, v1 = acc[ai][bj][m][1] * rs;
#pragma unroll
                    for (int e = 0; e < 4; ++e) { v0[e] = fmaxf(v0[e], 0.f); v0[e] *= v0[e]; v1[e] = fmaxf(v1[e], 0.f); v1[e] *= v1[e]; }
                    u32x4 w; w.x = pk_bf16(v0[0], v0[1]); w.y = pk_bf16(v0[2], v0[3]); w.z = pk_bf16(v1[0], v1[1]); w.w = pk_bf16(v1[2], v1[3]);
                    *(PG8_GAS u32x4*)(rowp + bj * HALF) = w; } }
    }
};
struct EpiRes {
    static constexpr bool PERM = true, AFTER_DRAIN = false;
    const float* xold; float* xout; bf16_t* xb; float* ssq;
    __device__ __forceinline__ void operator()(const f32x4 (&acc)[2][2][4][2], const Unit& u, int wr, int wc, int fr, int fq) const {
        const int row0 = u.pm * BM + wr * 64 + fr; const int col0 = u.pn * BM + wc * 32 + 8 * fq;
#pragma unroll
        for (int ai = 0; ai < 2; ++ai) {
            f32x4 xo[4][2][2];
#pragma unroll
            for (int m = 0; m < 4; ++m)
#pragma unroll
                for (int bj = 0; bj < 2; ++bj) { const size_t off = (size_t)(row0 + ai * HALF + m * 16) * 1024 + col0 + bj * HALF;
                    xo[m][bj][0] = *(const PG8_GAS f32x4*)(xold + off); xo[m][bj][1] = *(const PG8_GAS f32x4*)(xold + off + 4); }
#pragma unroll
            for (int m = 0; m < 4; ++m) { const int row = row0 + ai * HALF + m * 16; float part = 0.f;
#pragma unroll
                for (int bj = 0; bj < 2; ++bj) { const size_t off = (size_t)row * 1024 + col0 + bj * HALF;
                    const f32x4 v0 = acc[ai][bj][m][0] + xo[m][bj][0], v1 = acc[ai][bj][m][1] + xo[m][bj][1];
                    *(PG8_GAS f32x4*)(xout + off) = v0; *(PG8_GAS f32x4*)(xout + off + 4) = v1;
                    u32x4 w; w.x = pk_bf16(v0[0], v0[1]); w.y = pk_bf16(v0[2], v0[3]); w.z = pk_bf16(v1[0], v1[1]); w.w = pk_bf16(v1[2], v1[3]);
                    *(PG8_GAS u32x4*)(xb + off) = w;
                    part += ((v0[0] * v0[0] + v0[1] * v0[1]) + (v0[2] * v0[2] + v0[3] * v0[3])) + ((v1[0] * v1[0] + v1[1] * v1[1]) + (v1[2] * v1[2] + v1[3] * v1[3])); }
                part += __shfl_xor(part, 16); part += __shfl_xor(part, 32);
                if (fq == 0) ((PG8_GAS float*)ssq)[(size_t)row * 16 + u.pn * 4 + wc] = part; }
            asm volatile("" ::: "memory"); }
    }
};
struct EpiStash {
    static constexpr bool PERM = true, AFTER_DRAIN = true;
    __device__ __forceinline__ void fused(f32x4 (&acc)[2][2][4][2], const Unit& u, int wr, int wc, int fr, int fq, PG8_LAS unsigned char*, int, int) const { (*this)(acc, u, wr, wc, fr, fq); }
    bf16_t* ys;
    __device__ __forceinline__ void operator()(const f32x4 (&acc)[2][2][4][2], const Unit& u, int wr, int wc, int fr, int fq) const {
        bf16_t* base = ys + (size_t)(u.pm * 4 + u.pn) * 65536; const int row0 = wr * 64 + fr, col0 = wc * 32 + 8 * fq;
#pragma unroll
        for (int ai = 0; ai < 2; ++ai)
#pragma unroll
            for (int m = 0; m < 4; ++m) { bf16_t* rowp = base + (row0 + ai * HALF + m * 16) * 256 + col0;
#pragma unroll
                for (int bj = 0; bj < 2; ++bj) { const f32x4 v0 = acc[ai][bj][m][0], v1 = acc[ai][bj][m][1];
                    u32x4 w; w.x = pk_bf16(v0[0], v0[1]); w.y = pk_bf16(v0[2], v0[3]); w.z = pk_bf16(v1[0], v1[1]); w.w = pk_bf16(v1[2], v1[3]);
                    *(PG8_GAS u32x4*)(rowp + bj * HALF) = w; } }
    }
};
struct EpiGate {
    static constexpr bool PERM = true, AFTER_DRAIN = true;
    __device__ __forceinline__ void fused(f32x4 (&acc)[2][2][4][2], const Unit& u, int wr, int wc, int fr, int fq, PG8_LAS unsigned char*, int, int) const { (*this)(acc, u, wr, wc, fr, fq); }
    const bf16_t* ys; bf16_t* mb; const float* ssq; int first;
    __device__ __forceinline__ void operator()(const f32x4 (&acc)[2][2][4][2], const Unit& u, int wr, int wc, int fr, int fq) const {
        const bf16_t* sbase = ys + (size_t)(u.pm * 4 + u.pn) * 65536; const int lrow0 = wr * 64 + fr, lcol0 = wc * 32 + 8 * fq;
        float rv[2]; wave_rstd(ssq, u.pm * BM + wr * 64, fq * 16 + fr, rv);
        const bool fst = first != 0;
#pragma unroll
        for (int ai = 0; ai < 2; ++ai)
#pragma unroll
        for (int mh = 0; mh < 2; ++mh) {
            u32x4 yv[2][2], pv[2][2];
#pragma unroll
            for (int m2 = 0; m2 < 2; ++m2)
#pragma unroll
                for (int bj = 0; bj < 2; ++bj) { const int lrow = lrow0 + ai * HALF + (mh * 2 + m2) * 16;
                    yv[m2][bj] = *(const PG8_GAS u32x4*)(sbase + lrow * 256 + lcol0 + bj * HALF);
                    pv[m2][bj] = *(const PG8_GAS u32x4*)(mb + (size_t)(u.pm * BM + lrow) * 1024 + u.pn * BM + lcol0 + bj * HALF); }
#pragma unroll
            for (int m2 = 0; m2 < 2; ++m2) { const int m = mh * 2 + m2; const int lrow = lrow0 + ai * HALF + m * 16, row = u.pm * BM + lrow; const float rs = __shfl(rv[ai], m * 16 + fr);
#pragma unroll
                for (int bj = 0; bj < 2; ++bj) { const f32x4 a0 = acc[ai][bj][m][0] * rs, a1 = acc[ai][bj][m][1] * rs;
                    const u32x4 y = yv[m2][bj], p = pv[m2][bj];
                    bf16_t* mp = mb + (size_t)row * 1024 + u.pn * BM + lcol0 + bj * HALF;
                    float r[8], q[8];
                    r[0] = sigmoidf_(a0[0]) * bf_lo(y.x); r[1] = sigmoidf_(a0[1]) * bf_hi(y.x); r[2] = sigmoidf_(a0[2]) * bf_lo(y.y); r[3] = sigmoidf_(a0[3]) * bf_hi(y.y);
                    r[4] = sigmoidf_(a1[0]) * bf_lo(y.z); r[5] = sigmoidf_(a1[1]) * bf_hi(y.z); r[6] = sigmoidf_(a1[2]) * bf_lo(y.w); r[7] = sigmoidf_(a1[3]) * bf_hi(y.w);
                    q[0] = bf_lo(p.x); q[1] = bf_hi(p.x); q[2] = bf_lo(p.y); q[3] = bf_hi(p.y); q[4] = bf_lo(p.z); q[5] = bf_hi(p.z); q[6] = bf_lo(p.w); q[7] = bf_hi(p.w);
#pragma unroll
                    for (int e = 0; e < 8; ++e) r[e] = fst ? r[e] : r[e] + q[e];
                    u32x4 w; w.x = pk_bf16(r[0], r[1]); w.y = pk_bf16(r[2], r[3]); w.z = pk_bf16(r[4], r[5]); w.w = pk_bf16(r[6], r[7]);
                    *(PG8_GAS u32x4*)mp = w; } }
            asm volatile("" ::: "memory"); }
    }
};
struct EpiNull {
    static constexpr bool PERM = true, AFTER_DRAIN = false;
    __device__ __forceinline__ void operator()(const f32x4 (&acc)[2][2][4][2], const Unit& u, int wr, int wc, int fr, int fq) const {
#pragma unroll
        for (int ai = 0; ai < 2; ++ai)
#pragma unroll
            for (int bj = 0; bj < 2; ++bj)
#pragma unroll
                for (int m = 0; m < 4; ++m) { asm volatile("" :: "v"(acc[ai][bj][m][0]), "v"(acc[ai][bj][m][1])); }
    }
};
}

namespace pg8 {
struct UnitX { int pm, pn; const char* A; const char* Bt; int K; int kind; };
template <class Prog>
__device__ __forceinline__ void gemm_chain(PG8_LAS unsigned char* lds, const Prog& P) {
    int tid_l = threadIdx.x; asm volatile("" : "+v"(tid_l));
    const int tid = tid_l, wid = __builtin_amdgcn_readfirstlane(tid >> 6), lane = tid & 63, wr = wid >> 2, wc = wid & 3, fr = lane & 15, fq = lane >> 4;
    int RA[2], RB[2], C2[2];
#pragma unroll
    for (int i = 0; i < 2; ++i) { int R, C; stage_rc(tid * 16 + i * 8192, R, C); RA[i] = R * 2; RB[i] = ((R & ~31) + perm32(R & 31)) * 2; C2[i] = C * 2; }
    const size_t kstep = (size_t)(BK * 2);
    const unsigned ldsw = (unsigned)wid * 1024u;
    const int aoff = lds_byte(wr * 64 + fr, fq * 8), boff = lds_byte(wc * 32 + fr, fq * 8);
#define PG8_SA(b, h) (((b) * 2 + (h)) * HTB)
#define PG8_SB(b, h) ((4 + (b) * 2 + (h)) * HTB)
#define PG8_STAGE(bufoff, gbase, voff) do { _Pragma("unroll") for (int _i = 0; _i < 2; ++_i) \
        __builtin_amdgcn_global_load_lds((const unsigned*)((const char*)(gbase) + (voff)[_i]), (PG8_LAS unsigned*)(lds + (bufoff) + ldsw + _i * 8192), 16, 0, 0); } while (0)
#define PG8_LDA(dst, b, h) do { _Pragma("unroll") for (int m = 0; m < 4; ++m) _Pragma("unroll") for (int k = 0; k < 2; ++k) dst[m][k] = *(const PG8_LAS bf16x8*)(lds + PG8_SA(b, h) + aoff + m * 2048 + k * 1024); } while (0)
#define PG8_LDB(dst, b, h) do { _Pragma("unroll") for (int n = 0; n < 2; ++n) _Pragma("unroll") for (int k = 0; k < 2; ++k) dst[n][k] = *(const PG8_LAS bf16x8*)(lds + PG8_SB(b, h) + boff + n * 2048 + k * 1024); } while (0)
#define PG8_MMA(ai, bj, At, Bt) do { __builtin_amdgcn_s_setprio(1); _Pragma("unroll") for (int m = 0; m < 4; ++m) _Pragma("unroll") for (int n = 0; n < 2; ++n) _Pragma("unroll") for (int k = 0; k < 2; ++k) \
        acc[ai][bj][m][n] = __builtin_amdgcn_mfma_f32_16x16x32_bf16(Bt[n][k], At[m][k], acc[ai][bj][m][n], 0, 0, 0); __builtin_amdgcn_s_setprio(0); } while (0)
#define PG8_WAIT_V(n) asm volatile("s_waitcnt vmcnt(" #n ")" ::: "memory")
#define PG8_WAIT_L(n) asm volatile("s_waitcnt lgkmcnt(" #n ")" ::: "memory")
#define PG8_BAR __builtin_amdgcn_s_barrier()
#define PG8_SCHED __builtin_amdgcn_sched_barrier(0)
    UnitX cur, nxt; int ui = 0;
    if (!P.get(0, cur)) return;
    f32x4 acc[2][2][4][2];
#pragma unroll
    for (int a = 0; a < 2; ++a)
#pragma unroll
        for (int b = 0; b < 2; ++b)
#pragma unroll
            for (int m = 0; m < 4; ++m)
#pragma unroll
                for (int n = 0; n < 2; ++n) acc[a][b][m][n] = (f32x4){0.f, 0.f, 0.f, 0.f};
    bf16x8 At[4][2], B0[2][2], B1[2][2];
    int Kc = cur.K; size_t hsc = (size_t)HALF * Kc * 2;
    const char* cA = cur.A + (size_t)cur.pm * 2 * hsc; const char* cB = cur.Bt + (size_t)cur.pn * 2 * hsc;
    unsigned vAc[2], vBc[2];
#pragma unroll
    for (int i = 0; i < 2; ++i) { vAc[i] = (unsigned)(RA[i] * Kc + C2[i]); vBc[i] = (unsigned)(RB[i] * Kc + C2[i]); }
    P.a_ready(cur);
    PG8_STAGE(PG8_SB(0, 0), cB, vBc); PG8_STAGE(PG8_SB(0, 1), cB + hsc, vBc); PG8_STAGE(PG8_SA(0, 0), cA, vAc); PG8_STAGE(PG8_SA(0, 1), cA + hsc, vAc);
    if (wr == 1) PG8_BAR;
    PG8_WAIT_V(2); PG8_BAR;
    PG8_STAGE(PG8_SB(1, 0), cB + kstep, vBc); PG8_STAGE(PG8_SA(1, 0), cA + kstep, vAc); PG8_STAGE(PG8_SB(1, 1), cB + hsc + kstep, vBc);
    PG8_WAIT_V(6); PG8_BAR;
    for (;;) {
        const bool has_next = P.get(ui + 1, nxt);
        const int Kn = has_next ? nxt.K : Kc; const size_t hsn = (size_t)HALF * Kn * 2;
        const char* nA = has_next ? nxt.A + (size_t)nxt.pm * 2 * hsn : cA; const char* nB = has_next ? nxt.Bt + (size_t)nxt.pn * 2 * hsn : cB;
        const int nt = Kc / BK;
        for (int t = 0; t < nt; t += 2) {
            const bool last = (t == nt - 2);
            const char* a1 = cA + (size_t)(t + 1) * kstep;
            const char* a2 = last ? nA : cA + (size_t)(t + 2) * kstep; const char* b2 = last ? nB : cB + (size_t)(t + 2) * kstep;
            const char* a3 = a2 + kstep; const char* b3 = b2 + kstep;
            const size_t hs2 = last ? hsn : hsc; const int K2 = last ? Kn : Kc;
            unsigned vA2[2], vB2[2];
#pragma unroll
            for (int i = 0; i < 2; ++i) { vA2[i] = (unsigned)(RA[i] * K2 + C2[i]); vB2[i] = (unsigned)(RB[i] * K2 + C2[i]); }
            if (last && has_next) P.a_ready(nxt);
            PG8_LDB(B0, 0, 0); PG8_LDB(B1, 0, 1); PG8_SCHED; PG8_LDA(At, 0, 0); PG8_STAGE(PG8_SA(1, 1), a1 + hsc, vAc);
            PG8_WAIT_V(8); PG8_WAIT_L(0); PG8_BAR; PG8_MMA(0, 0, At, B0); PG8_MMA(0, 1, At, B1); PG8_BAR; PG8_SCHED;
            PG8_LDA(At, 0, 1); PG8_STAGE(PG8_SB(0, 0), b2, vB2); PG8_STAGE(PG8_SB(0, 1), b2 + hs2, vB2); PG8_STAGE(PG8_SA(0, 0), a2, vA2);
            PG8_WAIT_V(8); PG8_WAIT_L(0); PG8_BAR; PG8_MMA(1, 0, At, B0); PG8_MMA(1, 1, At, B1); PG8_BAR; PG8_SCHED;
            PG8_LDB(B0, 1, 0); PG8_LDB(B1, 1, 1); PG8_SCHED; PG8_LDA(At, 1, 0); PG8_STAGE(PG8_SA(0, 1), a2 + hs2, vA2);
            PG8_WAIT_V(8); PG8_WAIT_L(0); PG8_BAR; PG8_MMA(0, 0, At, B0); PG8_MMA(0, 1, At, B1); PG8_BAR; PG8_SCHED;
            PG8_LDA(At, 1, 1); PG8_STAGE(PG8_SB(1, 0), b3, vB2); PG8_STAGE(PG8_SB(1, 1), b3 + hs2, vB2); PG8_STAGE(PG8_SA(1, 0), a3, vA2);
            PG8_WAIT_V(8); PG8_WAIT_L(0); PG8_BAR; PG8_MMA(1, 0, At, B0); PG8_MMA(1, 1, At, B1); PG8_BAR; PG8_SCHED;
        }
        { int fr_e = fr, fq_e = fq, wr_e = wr, wc_e = wc; asm volatile("" : "+v"(fr_e), "+v"(fq_e), "+s"(wr_e), "+s"(wc_e));
          P.epi(acc, cur, wr_e, wc_e, fr_e, fq_e); }
        if (!has_next) break;
#pragma unroll
        for (int a = 0; a < 2; ++a)
#pragma unroll
            for (int b = 0; b < 2; ++b)
#pragma unroll
                for (int m = 0; m < 4; ++m)
#pragma unroll
                    for (int n = 0; n < 2; ++n) acc[a][b][m][n] = (f32x4){0.f, 0.f, 0.f, 0.f};
        cur = nxt; cA = nA; cB = nB; Kc = Kn; hsc = hsn; ++ui;
#pragma unroll
        for (int i = 0; i < 2; ++i) { vAc[i] = (unsigned)(RA[i] * Kc + C2[i]); vBc[i] = (unsigned)(RB[i] * Kc + C2[i]); }
    }
    PG8_WAIT_V(0);
    if (wr == 0) PG8_BAR;
    PG8_BAR;
#undef PG8_SA
#undef PG8_SB
#undef PG8_STAGE
#undef PG8_LDA
#undef PG8_LDB
#undef PG8_MMA
#undef PG8_WAIT_V
#undef PG8_WAIT_L
#undef PG8_BAR
#undef PG8_SCHED
}
struct ProgG2 {
    int pm, pn; const bf16_t* zq; const bf16_t* wbr; const bf16_t* xb; const bf16_t* wg; bf16_t* ys; bf16_t* mb; const float* ssq;
    __device__ __forceinline__ bool get(int i, UnitX& u) const {
        if (i >= 6) return false;
        const int n = i >> 1; u.pm = pm; u.pn = pn; u.kind = i;
        if (i & 1) { u.A = (const char*)xb; u.Bt = (const char*)(wg + (size_t)n * 1024 * 1024); u.K = 1024; }
        else { u.A = (const char*)(zq + (size_t)n * MROWS * 512); u.Bt = (const char*)(wbr + (size_t)n * 1024 * 512); u.K = 512; }
        return true; }
    __device__ __forceinline__ void a_ready(const UnitX&) const {}
    __device__ __forceinline__ void epi(const f32x4 (&acc)[2][2][4][2], const UnitX& ux, int wr, int wc, int fr, int fq) const {
        Unit u; u.pm = ux.pm; u.pn = ux.pn;
        if (ux.kind & 1) { EpiGate E{ys, mb, ssq, ux.kind == 1 ? 1 : 0}; E(acc, u, wr, wc, fr, fq); }
        else { EpiStash E{ys}; E(acc, u, wr, wc, fr, fq); }
    }
};
}

#define GAS __attribute__((address_space(1)))
#define LAS __attribute__((address_space(3)))
typedef unsigned short bf16;
typedef unsigned v4u __attribute__((ext_vector_type(4)));
typedef float f32x4 __attribute__((ext_vector_type(4)));
typedef short bf16x8 __attribute__((ext_vector_type(8)));
typedef GAS unsigned gu32;
typedef GAS unsigned long long gu64;
#define RLX_AGENT __ATOMIC_RELAXED, __HIP_MEMORY_SCOPE_AGENT
#define LDS_WAIT() asm volatile("s_waitcnt lgkmcnt(0)" ::: "memory")
#define VM_WAIT() asm volatile("s_waitcnt vmcnt(0)" ::: "memory")
__device__ __forceinline__ unsigned long long rt() { return __builtin_amdgcn_s_memrealtime(); }
__device__ __forceinline__ unsigned f2bf(float f) { unsigned u = __builtin_bit_cast(unsigned, f); return (u + 0x7fffu + ((u >> 16) & 1u)) >> 16; }
__device__ __forceinline__ unsigned pk2(float lo, float hi) { return f2bf(lo) | (f2bf(hi) << 16); }

#define XB_TMO      128
#define XB_XCNT(j)  (256  + 64 * (j))
#define XB_XSUB(j)  (1280 + 64 * (j))
#define XB_XGEN(j)  (2304 + 64 * (j))
#define XB_TOP      3328
#define XB_TOPGEN   3392
#define XCD_BAR_WORDS 3456
#define XB_SPIN_CAP (1u << 18)

__device__ __forceinline__ unsigned xb_ld(unsigned* p)              { return __hip_atomic_load(p, __ATOMIC_RELAXED, __HIP_MEMORY_SCOPE_AGENT); }
__device__ __forceinline__ unsigned xb_add(unsigned* p, unsigned v) { return __hip_atomic_fetch_add(p, v, __ATOMIC_RELAXED, __HIP_MEMORY_SCOPE_AGENT); }
__device__ __forceinline__ unsigned xb_xcc_id() { return (unsigned)__builtin_amdgcn_s_getreg((3 << 11) | 20) & 0xFu; }
#define XB_SPIN(cond, bar) do { unsigned _sp = 0; while (cond) { __builtin_amdgcn_s_sleep(1); \
    if ((++_sp & 255u) == 0u) { if (xb_ld(&(bar)[XB_TMO])) break; if (_sp > XB_SPIN_CAP) { atomicAdd(&(bar)[XB_TMO], 1u); break; } } } } while (0)

struct XcdBarrier {
    unsigned* bar; unsigned x;
    volatile LAS unsigned* st;
};

__device__ __forceinline__ XcdBarrier xcd_barrier_post(unsigned* bar, volatile LAS unsigned* st) {
    XcdBarrier b; b.bar = bar; b.x = xb_xcc_id(); b.st = st;
    if (threadIdx.x == 0) (void)xb_add(&bar[XB_XCNT(b.x)], 1u);
    return b;
}
__device__ __forceinline__ void xcd_barrier_complete(unsigned* bar, unsigned x, unsigned& nloc, unsigned& nx) {
    const unsigned G = gridDim.x * gridDim.y * gridDim.z;
    unsigned sum, cnt, mine, sp = 0u;
    for (;;) {
        sum = 0u; cnt = 0u; mine = 0u;
#pragma unroll
        for (unsigned j = 0; j < 16; ++j) { const unsigned c = xb_ld(&bar[XB_XCNT(j)]); sum += c; cnt += (c > 0u) ? 1u : 0u; mine = (j == x) ? c : mine; }
        if (sum == G) break;
        __builtin_amdgcn_s_sleep(1);
        if ((++sp & 255u) == 0u) { if (xb_ld(&bar[XB_TMO])) break; if (sp > XB_SPIN_CAP) { atomicAdd(&bar[XB_TMO], 1u); break; } }
    }
    nloc = mine > 0u ? mine : 1u; nx = cnt > 0u ? cnt : 1u;
}

__device__ __forceinline__ void xcd_barrier(const XcdBarrier& b) {
    asm volatile("s_waitcnt vmcnt(0)" ::: "memory");
    __syncthreads();
    if (threadIdx.x == 0) {
        unsigned* bar = b.bar;
        __builtin_amdgcn_s_waitcnt(0);
        unsigned nloc = b.st[0], nx = b.st[1];
        if (nloc == 0u) { xcd_barrier_complete(bar, b.x, nloc, nx); b.st[0] = nloc; b.st[1] = nx; }
        const unsigned old = xb_add(&bar[XB_XSUB(b.x)], 1u);
        const unsigned gen = old / nloc;
        if (old + 1u == (gen + 1u) * nloc) {
            __builtin_amdgcn_fence(__ATOMIC_RELEASE, "agent");
            asm volatile("s_waitcnt vmcnt(0)" ::: "memory");
            const unsigned og = xb_add(&bar[XB_TOP], 1u);
            const unsigned tg = og / nx;
            if (og + 1u == (tg + 1u) * nx) xb_add(&bar[XB_TOPGEN], 1u);
            else XB_SPIN(xb_ld(&bar[XB_TOPGEN]) == tg, bar);
            __builtin_amdgcn_fence(__ATOMIC_ACQUIRE, "agent");
            xb_add(&bar[XB_XGEN(b.x)], 1u);
            asm volatile("s_waitcnt vmcnt(0)" ::: "memory");
        } else {
            XB_SPIN(xb_ld(&bar[XB_XGEN(b.x)]) == gen, bar);
            __builtin_amdgcn_fence(__ATOMIC_ACQUIRE, "agent");
            asm volatile("s_waitcnt vmcnt(0)" ::: "memory");
        }
    }
    __syncthreads();
}

namespace att {
typedef short bf16x8 __attribute__((ext_vector_type(8)));
typedef short s16x4 __attribute__((ext_vector_type(4)));
typedef float f32x16 __attribute__((ext_vector_type(16)));
typedef unsigned u32x4 __attribute__((ext_vector_type(4)));
typedef unsigned short bf16_t;
typedef unsigned long long u64;
constexpr int NKB = 4, NVB = 5;
constexpr int WSF_W = 320;
constexpr int L_K0 = 0, L_V0 = NKB * 8320, L_IMP = L_V0  , L_WSF = L_V0 + NVB * 8192, L_SEL = L_WSF + 8 * WSF_W * 4, L_OST = L_SEL + 512  , L_END = L_OST + 65536;
__device__ __forceinline__ int crow(int r, int hi) { return (r & 3) + 8 * (r >> 2) + 4 * hi; }
__device__ __forceinline__ unsigned pk2(float lo, float hi) { typedef float f2 __attribute__((ext_vector_type(2))); typedef __bf16 b2 __attribute__((ext_vector_type(2)));
    f2 v = {lo, hi}; b2 b = __builtin_convertvector(v, b2); return __builtin_bit_cast(unsigned, b); }
__device__ __forceinline__ s16x4 vtr(LAS const char* p) { typedef short v4i16_t __attribute__((ext_vector_type(4))); return __builtin_bit_cast(s16x4, __builtin_amdgcn_ds_read_tr16_b64_v4i16((LAS v4i16_t*)p)); }

struct KVSrc { const GAS bf16_t* k; const GAS bf16_t* v; int pitch; int nrows; };

struct Lane { int tid, lane, r32, hi, wid; };

__device__ __forceinline__ void tile_gload(const KVSrc& S, int t, int tid, u32x4& kr, u32x4& vr) {
    const int row = 64 * t + (tid >> 3), ch = tid & 7;
    kr = *(const GAS u32x4*)(S.k + (size_t)row * S.pitch + ch * 8); vr = *(const GAS u32x4*)(S.v + (size_t)row * S.pitch + ch * 8);
}
__device__ __forceinline__ void tile_lstore(LAS char* kb, LAS char* vb, int tid, const u32x4& kr, const u32x4& vr) {
    const int key = tid >> 3, ch = tid & 7;
    *(LAS u32x4*)(kb + ch * 1040 + (key >> 5) * 512 + (key & 31) * 16) = kr;
    *(LAS u32x4*)(vb + (ch >> 2) * 4096 + (key >> 4) * 1024 + ((key >> 3) & 1) * 512 + (key & 7) * 64 + (ch & 3) * 16) = vr;
}
__device__ __forceinline__ void qk_tile(LAS const char* kbuf, const bf16x8 (&qr)[4], f32x16& p0, f32x16& p1, int r32, int hi) {
    LAS const char* kb = kbuf + hi * 1040 + r32 * 16;
#pragma unroll
    for (int d0 = 0; d0 < 4; ++d0) {
        const bf16x8 b0 = *(LAS const bf16x8*)(kb + d0 * 2080);
        const bf16x8 b1 = *(LAS const bf16x8*)(kb + d0 * 2080 + 512);
        p0 = __builtin_amdgcn_mfma_f32_32x32x16_bf16(b0, qr[d0], p0, 0, 0, 0);
        p1 = __builtin_amdgcn_mfma_f32_32x32x16_bf16(b1, qr[d0], p1, 0, 0, 0);
    }
}
__device__ __forceinline__ void qk_tile_c(LAS const char* kbuf, const bf16x8 (&qr)[4], const f32x16& negm, f32x16& p0, f32x16& p1, int r32, int hi) {
    const unsigned ka = (unsigned)(size_t)kbuf + hi * 1040 + r32 * 16;
    bf16x8 kf[8];
#pragma unroll
    for (int d0 = 0; d0 < 4; ++d0) {
        asm volatile("ds_read_b128 %0, %1 offset:%c2" : "=&v"(kf[2 * d0]) : "v"(ka), "i"(d0 * 2080) : "memory");
        asm volatile("ds_read_b128 %0, %1 offset:%c2" : "=&v"(kf[2 * d0 + 1]) : "v"(ka), "i"(d0 * 2080 + 512) : "memory");
    }
    asm volatile("s_waitcnt lgkmcnt(0)" : "+v"(kf[0]), "+v"(kf[1]), "+v"(kf[2]), "+v"(kf[3]), "+v"(kf[4]), "+v"(kf[5]), "+v"(kf[6]), "+v"(kf[7]) :: "memory");
    __builtin_amdgcn_sched_barrier(0);
    p0 = __builtin_amdgcn_mfma_f32_32x32x16_bf16(kf[0], qr[0], negm, 0, 0, 0); p1 = __builtin_amdgcn_mfma_f32_32x32x16_bf16(kf[1], qr[0], negm, 0, 0, 0);
#pragma unroll
    for (int d0 = 1; d0 < 4; ++d0) { p0 = __builtin_amdgcn_mfma_f32_32x32x16_bf16(kf[2 * d0], qr[d0], p0, 0, 0, 0); p1 = __builtin_amdgcn_mfma_f32_32x32x16_bf16(kf[2 * d0 + 1], qr[d0], p1, 0, 0, 0); }
}
__device__ __forceinline__ void pv_tile(LAS const char* vbuf, const u32x4 (&pw)[4], f32x16 (&o)[2], f32x16& ol, int lane, int hi) {
    const unsigned va = (unsigned)(size_t)vbuf + ((lane >> 4) & 1) * 32 + (lane & 3) * 8 + (4 * hi + ((lane & 15) >> 2)) * 64;
#pragma unroll
    for (int d0 = 0; d0 < 2; ++d0) {
        s16x4 lo[4], h2[4];
#pragma unroll
        for (int ks = 0; ks < 4; ++ks) {
            asm volatile("ds_read_b64_tr_b16 %0, %1 offset:%c2" : "=&v"(lo[ks]) : "v"(va), "i"(d0 * 4096 + ks * 1024) : "memory");
            asm volatile("ds_read_b64_tr_b16 %0, %1 offset:%c2" : "=&v"(h2[ks]) : "v"(va), "i"(d0 * 4096 + ks * 1024 + 512) : "memory");
        }
        asm volatile("s_waitcnt lgkmcnt(0)" : "+v"(lo[0]), "+v"(lo[1]), "+v"(lo[2]), "+v"(lo[3]), "+v"(h2[0]), "+v"(h2[1]), "+v"(h2[2]), "+v"(h2[3]) :: "memory");
        __builtin_amdgcn_sched_barrier(0);
#pragma unroll
        for (int ks = 0; ks < 4; ++ks) {
            const bf16x8 vf = (bf16x8){lo[ks][0], lo[ks][1], lo[ks][2], lo[ks][3], h2[ks][0], h2[ks][1], h2[ks][2], h2[ks][3]};
            o[d0] = __builtin_amdgcn_mfma_f32_32x32x16_bf16(__builtin_bit_cast(bf16x8, pw[ks]), vf, o[d0], 0, 0, 0);
        }
        if (d0 == 0) {
            const bf16x8 ones = (bf16x8){0x3f80, 0x3f80, 0x3f80, 0x3f80, 0x3f80, 0x3f80, 0x3f80, 0x3f80};
#pragma unroll
            for (int ks = 0; ks < 4; ++ks) ol = __builtin_amdgcn_mfma_f32_32x32x16_bf16(__builtin_bit_cast(bf16x8, pw[ks]), ones, ol, 0, 0, 0);
        }
    }
}
__device__ __forceinline__ void mask_exp_pack(f32x16& p0, f32x16& p1, u64 mask, int hi, u32x4 (&pw)[4]) {
    const bool rowuni = __all(mask == ~0ull || mask == 0ull);
    if (rowuni) {
        const unsigned rm = mask ? ~0u : 0u;
        if (__all(mask == ~0ull)) {
#pragma unroll
            for (int r = 0; r < 16; ++r) { p0[r] = __builtin_amdgcn_exp2f(p0[r]); p1[r] = __builtin_amdgcn_exp2f(p1[r]); }
        } else {
#pragma unroll
            for (int r = 0; r < 16; ++r) { p0[r] = __uint_as_float(__float_as_uint(__builtin_amdgcn_exp2f(p0[r])) & rm); p1[r] = __uint_as_float(__float_as_uint(__builtin_amdgcn_exp2f(p1[r])) & rm); }
        }
    } else {
        const int m0 = (int)(unsigned)(mask >> (4 * hi)), m1 = (int)(unsigned)(mask >> (32 + 4 * hi));
#pragma unroll
        for (int r = 0; r < 16; ++r) { const int bit = (r & 3) + 8 * (r >> 2);
            const unsigned e0 = __float_as_uint(__builtin_amdgcn_exp2f(p0[r])), e1 = __float_as_uint(__builtin_amdgcn_exp2f(p1[r]));
            unsigned k0, k1;
            asm("v_bfe_i32 %0, %1, %2, 1" : "=v"(k0) : "v"(m0), "n"(bit)); asm("v_bfe_i32 %0, %1, %2, 1" : "=v"(k1) : "v"(m1), "n"(bit));
            p0[r] = __uint_as_float(e0 & k0); p1[r] = __uint_as_float(e1 & k1); }
    }
    pw[0] = (u32x4){pk2(p0[0], p0[1]), pk2(p0[2], p0[3]), pk2(p0[4], p0[5]), pk2(p0[6], p0[7])};
    pw[1] = (u32x4){pk2(p0[8], p0[9]), pk2(p0[10], p0[11]), pk2(p0[12], p0[13]), pk2(p0[14], p0[15])};
    pw[2] = (u32x4){pk2(p1[0], p1[1]), pk2(p1[2], p1[3]), pk2(p1[4], p1[5]), pk2(p1[6], p1[7])};
    pw[3] = (u32x4){pk2(p1[8], p1[9]), pk2(p1[10], p1[11]), pk2(p1[12], p1[13]), pk2(p1[14], p1[15])};
}
__device__ __forceinline__ u64 mask_le(int c) { return c >= 63 ? ~0ull : (c < 0 ? 0ull : ((2ull << c) - 1ull)); }
__device__ __forceinline__ u64 mask_ge(int a) { return a <= 0 ? ~0ull : (a > 63 ? 0ull : (~0ull << a)); }


__device__ __forceinline__ void glds16(const GAS void* gsrc, unsigned lds_dst) { unsigned keep;
    asm volatile("s_mov_b32 %0, m0\n\ts_mov_b32 m0, %2\n\ts_nop 0\n\tglobal_load_lds_dwordx4 %1, off\n\ts_mov_b32 m0, %0" : "=&s"(keep) : "v"(gsrc), "s"(lds_dst) : "memory"); }
__device__ __forceinline__ void tile_dma(const KVSrc& S, int t, unsigned kslot, unsigned vslot, const Lane& L) {
    const GAS bf16_t* ks = S.k + (size_t)(64 * t + L.lane) * S.pitch + L.wid * 8;
    const GAS bf16_t* vs = S.v + (size_t)(64 * t + 16 * (L.wid & 3) + (L.lane >> 2)) * S.pitch + (L.wid >> 2) * 32 + (L.lane & 3) * 8;
    glds16(ks, (unsigned)__builtin_amdgcn_readfirstlane(kslot + L.wid * 1040));
    glds16(vs, (unsigned)__builtin_amdgcn_readfirstlane(vslot + (L.wid >> 2) * 4096 + (L.wid & 3) * 1024));
}
#define ATT_WAIT_BAR(N) asm volatile("s_waitcnt vmcnt(" #N ") lgkmcnt(0)\n\ts_barrier" ::: "memory")
template <class MF>
__device__ __forceinline__ void attend_range(LAS char* lds, const KVSrc& S, int t0, int t1, const MF& mf, const bf16x8 (&qr)[4], float negC, f32x16& ol, f32x16 (&o)[2], const Lane& L, bool abl = false) {
    if (t0 >= t1) return;
    const bool late = L.wid >= 4;
    const unsigned lds0 = (unsigned)(size_t)lds;
    const f32x16 negm = {0.f, 0.f, 0.f, 0.f, 0.f, 0.f, 0.f, 0.f, 0.f, 0.f, 0.f, 0.f, 0.f, 0.f, 0.f, 0.f};
    (void)negC;
    tile_dma(S, t0, lds0 + L_K0, lds0 + L_V0, L);
    if (t0 + 1 < t1) tile_dma(S, t0 + 1, lds0 + L_K0 + 8320, lds0 + L_V0 + 8192, L);
    if (t0 + 2 < t1) tile_dma(S, t0 + 2, lds0 + L_K0 + 2 * 8320, lds0 + L_V0 + 2 * 8192, L);
    if (t0 + 2 < t1) ATT_WAIT_BAR(4); else if (t0 + 1 < t1) ATT_WAIT_BAR(2); else ATT_WAIT_BAR(0);
    u32x4 pwp[4];
#pragma unroll
    for (int k = 0; k < 4; ++k) asm volatile("" : "=v"(pwp[k]));
    int kcur = 0, vcur = 0, vprev = 0;
    u64 mk_next = mf(t0);
#if defined(PROBE_ABL) && PROBE_ABL == 12
    if (abl) { for (int t = t0; t < t1; ++t) { asm volatile("s_nop 0" ::: "memory"); } return; }
#endif
#if defined(PROBE_ABL) && PROBE_ABL == 13
    if (abl) { for (int t = t0; t < t1; ++t) { ATT_WAIT_BAR(0); } return; }
#endif
#if defined(PROBE_ABL) && PROBE_ABL == 14
    if (abl) { u64 acc_ = 0; for (int t = t0; t < t1; ++t) { acc_ ^= mf(t); asm volatile("s_waitcnt lgkmcnt(0)" : "+v"(acc_) :: "memory"); } asm volatile("" :: "v"(acc_)); return; }
#endif
#if defined(PROBE_ABL) && PROBE_ABL == 15
    if (abl) { for (int t = t0; t < t1; ++t) { f32x16 p0, p1; qk_tile_c(lds + L_K0, qr, negm, p0, p1, L.r32, L.hi); asm volatile("" :: "v"(p0), "v"(p1)); } return; }
#endif
#pragma unroll 1
    for (int t = t0; t < t1; ++t) {
        const u64 mk = mk_next;
        if (t + 1 < t1) mk_next = mf(t + 1);
#if defined(PROBE_ABL) && PROBE_ABL >= 10
        if (t + 3 < t1 && !abl) {
#else
        if (t + 3 < t1) {
#endif
            const int ks = kcur == 0 ? NKB - 1 : kcur - 1; int vs = vcur + 3; vs = vs >= NVB ? vs - NVB : vs;
            tile_dma(S, t + 3, lds0 + L_K0 + ks * 8320, lds0 + L_V0 + vs * 8192, L); }
#if defined(PROBE_ABL) && (PROBE_ABL == 6 || PROBE_ABL >= 10)
        if (late && t > t0 && !abl) pv_tile(lds + L_V0 + vprev * 8192, pwp, o, ol, L.lane, L.hi);
#else
        if (late && t > t0) pv_tile(lds + L_V0 + vprev * 8192, pwp, o, ol, L.lane, L.hi);
#endif
        f32x16 p0, p1;
#if defined(PROBE_ABL) && (PROBE_ABL == 6 || PROBE_ABL >= 10)
        if (abl) { p0 = negm; p1 = negm; asm volatile("" : "+v"(p0), "+v"(p1)); } else
#endif
        qk_tile_c(lds + L_K0 + kcur * 8320, qr, negm, p0, p1, L.r32, L.hi);
        u32x4 pw[4];
#if defined(PROBE_ABL) && (PROBE_ABL == 2 || PROBE_ABL >= 10)
        if (abl) {
#pragma unroll
            for (int k = 0; k < 4; ++k) pw[k] = (u32x4){__float_as_uint(p0[4 * k]) ^ (unsigned)mk, __float_as_uint(p0[4 * k + 1]), __float_as_uint(p1[4 * k + 2]), __float_as_uint(p1[4 * k + 3])}; }
        else
#endif
        mask_exp_pack(p0, p1, mk, L.hi, pw);
#if defined(PROBE_ABL) && (PROBE_ABL == 6 || PROBE_ABL >= 10)
        if (!late && !abl) pv_tile(lds + L_V0 + vcur * 8192, pw, o, ol, L.lane, L.hi);
        else if (!late) { asm volatile("" :: "v"(pw[0]), "v"(pw[1]), "v"(pw[2]), "v"(pw[3])); }
#else
        if (!late) pv_tile(lds + L_V0 + vcur * 8192, pw, o, ol, L.lane, L.hi);
#endif
        else {
#pragma unroll
            for (int k = 0; k < 4; ++k) pwp[k] = pw[k]; }
#if defined(PROBE_ABL) && PROBE_ABL == 11
        if (abl) { asm volatile("s_waitcnt lgkmcnt(0)" ::: "memory"); } else
#endif
        if (t + 3 < t1) ATT_WAIT_BAR(4); else if (t + 2 < t1) ATT_WAIT_BAR(2); else ATT_WAIT_BAR(0);
        vprev = vcur; vcur = vcur == NVB - 1 ? 0 : vcur + 1; kcur = kcur == NKB - 1 ? 0 : kcur + 1;
    }
    if (late) pv_tile(lds + L_V0 + vprev * 8192, pwp, o, ol, L.lane, L.hi);
    ATT_WAIT_BAR(0);
}
__device__ __forceinline__ void rows_to_regs(LAS float* wsf, float v, int r32, int hi, float (&sc)[16]) {
    asm volatile("s_waitcnt lgkmcnt(0)" ::: "memory");
    if (hi == 0) wsf[r32] = v;
    asm volatile("s_waitcnt lgkmcnt(0)" ::: "memory");
#pragma unroll
    for (int r = 0; r < 16; ++r) sc[r] = wsf[crow(r, hi)];
}
__device__ __forceinline__ void load_q(const bf16_t* qrow, int hi, bf16x8 (&qr)[4]) {
#pragma unroll
    for (int d0 = 0; d0 < 4; ++d0) qr[d0] = *(const GAS bf16x8*)(qrow + d0 * 16 + hi * 8);
}
template <class RowPtr>
__device__ __forceinline__ void store_o(LAS char* stage, const f32x16 (&acc)[2], const RowPtr& rowptr, int lane, int r32, int hi) {
    LAS bf16_t* stg = (LAS bf16_t*)stage;
#pragma unroll
    for (int r = 0; r < 16; ++r) { const int orow = crow(r, hi);
#pragma unroll
        for (int d0 = 0; d0 < 2; ++d0) stg[orow * 64 + d0 * 32 + r32] = (bf16_t)(pk2(acc[d0][r], 0.f) & 0xffffu); }
    asm volatile("s_waitcnt lgkmcnt(0)" ::: "memory");
#pragma unroll
    for (int i = 0; i < 4; ++i) { const int row = i * 8 + (lane >> 3), ch = lane & 7; const u32x4 v = *(LAS const u32x4*)(stg + row * 64 + ch * 8); *(GAS u32x4*)(rowptr(row) + ch * 8) = v; }
    asm volatile("s_waitcnt lgkmcnt(0)" ::: "memory");
}
}

constexpr int NWAVES = 8;
constexpr int BATCH = 4, SEQ = 4096, DM = 1024, DFF = 4096, DEPTH = 2, D_IN = 6236;
constexpr int M = BATCH * SEQ;
constexpr size_t MiB = 1u << 20;
constexpr size_t WS_ZQ = 0;
constexpr size_t WS_ZKV = 48 * MiB;
constexpr size_t WS_YS = WS_ZKV;
constexpr size_t WS_MB = 104 * MiB;
constexpr size_t WS_KC2 = WS_MB, WS_VC2 = WS_MB + 4 * MiB;
constexpr size_t WS_XB = 136 * MiB;
constexpr size_t WS_W = 168 * MiB, W_LAYER = 36 * MiB;
constexpr size_t W_IN = 0, W_G = 7 * MiB, W_BR = 13 * MiB, W_OUT = 16 * MiB, W_UP = 18 * MiB, W_DN = 26 * MiB, W_CK1 = 34 * MiB, W_CV1 = 35 * MiB;
constexpr size_t WS_BM = 240 * MiB;
constexpr size_t WS_MISC = 248 * MiB;
constexpr size_t WS_CTL = WS_MISC, CTL_BYTES = 128 * 1024;
constexpr size_t WS_COS = WS_MISC + 1 * MiB, WS_SIN = WS_MISC + 1 * MiB + 512 * 1024;
constexpr size_t WS_KCMP = WS_MISC + 2 * MiB;
constexpr size_t WS_SSQ = WS_MISC + 2 * MiB + 512 * 1024;
constexpr size_t WS_B1P = WS_MISC + 3 * MiB + 512 * 1024;
constexpr size_t WS_W2 = WS_B1P + 64 * 1024;
constexpr size_t WS_IKF = WS_MISC + 4 * MiB;
constexpr size_t WS_HMID = 0;
constexpr size_t WS_END = 256 * MiB;
constexpr int CW_BAR = 4096, CW_Q = 8192, CW_KMAX = 12288;
constexpr int LDS_BYTES = 163840, LDS_UNIT = 163776;
constexpr float C2 = 0.125f * 1.4426950408889634f, LOG2E = 1.4426950408889634f;


struct Args { const float* in[17]; float* out; unsigned char* ws; };
struct Frame {
    LAS unsigned char* lds;
    gu32* ctl;
    int tid, lane, wave, G, gw, NGW;
    unsigned char* ws;
    const struct Args* a;
};
__device__ __forceinline__ float wave_sum(float v) {
#pragma unroll
    for (int o = 1; o < 64; o <<= 1) v += __shfl_xor(v, o);
    return v;
}
__device__ __forceinline__ float wave_max(float v) {
#pragma unroll
    for (int o = 1; o < 64; o <<= 1) v = fmaxf(v, __shfl_xor(v, o));
    return v;
}
__device__ __forceinline__ float bf2f(bf16 h) { return __uint_as_float((unsigned)h << 16); }
__device__ __constant__ float c_inv_freq[32] = {
    1.0f, 0.7498942093324559f, 0.5623413251903491f, 0.4216965034285822f, 0.31622776601683794f, 0.23713737056616552f, 0.1778279410038923f, 0.1333521432163324f,
    0.1f, 0.07498942093324558f, 0.05623413251903491f, 0.042169650342858224f, 0.03162277660168379f, 0.023713737056616554f, 0.01778279410038923f, 0.01333521432163324f,
    0.01f, 0.007498942093324558f, 0.005623413251903491f, 0.004216965034285823f, 0.0031622776601683794f, 0.0023713737056616554f, 0.0017782794100389228f, 0.001333521432163324f,
    0.001f, 0.0007498942093324559f, 0.0005623413251903491f, 0.00042169650342858224f, 0.00031622776601683794f, 0.00023713737056616554f, 0.00017782794100389227f, 0.0001333521432163324f};

__device__ __forceinline__ int mix_src_col(int j) {
    if (j < 512) return j;
    if (j < 1024) return 1092 + (j - 512);
    if (j < 1536) return 1860 + (j - 1024);
    if (j < 1792) return 512 + (j - 1536);
    if (j < 2048) return 1604 + (j - 1792);
    if (j < 2304) return 2372 + (j - 2048);
    if (j < 2560) return 2628 + (j - 2304);
    if (j < 2816) return 2884 + (j - 2560);
    if (j < 3072) return 768 + (j - 2816);
    const int r = j - 3072;
    if (r < 64) return 1024 + r;
    if (r < 68) return 1088 + (r - 64);
    if (r < 92) return 3140 + (r - 68);
    return -1;
}
template <int MODE>
__device__ __forceinline__ void p0_item(const float* W, int ldw, int K, bf16* WT, int nblk, int item, const float* gain, int coff, LAS float* scr, int lane) {
    const int kb = item / nblk, nb = item % nblk, k0 = 64 * kb, n0 = 32 * nb;
    const int nq = 4 * (lane & 7), rr = lane >> 3;
    const int sc = MODE == 0 ? (n0 + nq + coff) : mix_src_col(n0 + nq);
    f32x4 v[8];
#pragma unroll
    for (int i = 0; i < 8; ++i) { v[i] = (f32x4){0.f, 0.f, 0.f, 0.f}; if (sc >= 0) v[i] = *(const GAS f32x4*)(W + (size_t)(k0 + 8 * i + rr) * ldw + sc); }
#pragma unroll
    for (int i = 0; i < 8; ++i) { const int kk = 8 * i + rr; const float g = gain ? gain[k0 + kk] : 1.0f;
        scr[kk * 33 + nq + 0] = v[i][0] * g; scr[kk * 33 + nq + 1] = v[i][1] * g; scr[kk * 33 + nq + 2] = v[i][2] * g; scr[kk * 33 + nq + 3] = v[i][3] * g; }
    LDS_WAIT(); asm volatile("" ::: "memory");
    const int c = lane & 7;
#pragma unroll
    for (int j = 0; j < 4; ++j) { const int n = (lane >> 3) + 8 * j; const LAS float* s = scr + (8 * c) * 33 + n;
        v4u o; o.x = pk2(s[0 * 33], s[1 * 33]); o.y = pk2(s[2 * 33], s[3 * 33]); o.z = pk2(s[4 * 33], s[5 * 33]); o.w = pk2(s[6 * 33], s[7 * 33]);
        *(GAS v4u*)(WT + (size_t)(n0 + n) * K + k0 + 8 * c) = o; }
    LDS_WAIT(); asm volatile("" ::: "memory");
}
__device__ __forceinline__ void p0_prologue(Frame& F) {
    LAS float* scr = (LAS float*)(F.lds + F.wave * 16384);
    constexpr int I_IN = 16 * 104, I_G = 16 * 96, I_BR = 8 * 32, I_OUT = 16 * 32, I_UP = 16 * 128, I_DN = 64 * 32, I_C1 = 32 * 8, I_C2 = 4 * 2;
    constexpr int PER_LAYER = I_IN + I_G + 3 * I_BR + I_OUT + I_UP + I_DN + 2 * I_C1 + 2 * I_C2;
    for (int it = F.gw; it < 2 * PER_LAYER; it += F.NGW) {
        const int l = it / PER_LAYER; int r = it % PER_LAYER;
        unsigned char* wl = F.ws + WS_W + (size_t)l * W_LAYER;
        const float* w_in = F.a->in[2] + (size_t)l * DM * D_IN;
        if (r < I_IN) { p0_item<1>(w_in, D_IN, DM, (bf16*)(wl + W_IN), 104, r, F.a->in[1] + l * DM, 0, scr, F.lane); continue; } r -= I_IN;
        if (r < I_G) { p0_item<0>(w_in, D_IN, DM, (bf16*)(wl + W_G), 96, r, F.a->in[1] + l * DM, 3164, scr, F.lane); continue; } r -= I_G;
        if (r < 3 * I_BR) { const int n = r / I_BR; p0_item<0>(F.a->in[12] + ((size_t)l * 3 + n) * 512 * DM, DM, 512, (bf16*)(wl + W_BR) + (size_t)n * DM * 512, 32, r % I_BR, nullptr, 0, scr, F.lane); continue; } r -= 3 * I_BR;
        if (r < I_OUT) { p0_item<0>(F.a->in[13] + (size_t)l * DM * DM, DM, DM, (bf16*)(wl + W_OUT), 32, r, nullptr, 0, scr, F.lane); continue; } r -= I_OUT;
        if (r < I_UP) { p0_item<0>(F.a->in[15] + (size_t)l * DM * DFF, DFF, DM, (bf16*)(wl + W_UP), 128, r, F.a->in[14] + l * DM, 0, scr, F.lane); continue; } r -= I_UP;
        if (r < I_DN) { p0_item<0>(F.a->in[16] + (size_t)l * DFF * DM, DM, DFF, (bf16*)(wl + W_DN), 32, r, nullptr, 0, scr, F.lane); continue; } r -= I_DN;
        if (r < I_C1) { p0_item<0>(F.a->in[8] + (size_t)l * 2048 * 256, 256, 2048, (bf16*)(wl + W_CK1), 8, r, nullptr, 0, scr, F.lane); continue; } r -= I_C1;
        if (r < I_C1) { p0_item<0>(F.a->in[10] + (size_t)l * 2048 * 256, 256, 2048, (bf16*)(wl + W_CV1), 8, r, nullptr, 0, scr, F.lane); continue; } r -= I_C1;
        if (r < I_C2) { p0_item<0>(F.a->in[9] + (size_t)l * 256 * 64, 64, 256, (bf16*)(F.ws + WS_W2) + (size_t)(l * 2 + 0) * 64 * 256, 2, r, nullptr, 0, scr, F.lane); continue; } r -= I_C2;
        p0_item<0>(F.a->in[11] + (size_t)l * 256 * 64, 64, 256, (bf16*)(F.ws + WS_W2) + (size_t)(l * 2 + 1) * 64 * 256, 2, r, nullptr, 0, scr, F.lane);
    }
    for (int it = F.gw; it < 128; it += F.NGW) {
        const int kp = it & 7, jb = (it >> 3) & 3, which = (it >> 5) & 1, l = it >> 6; const int j = jb * 64 + F.lane;
        const float* pe = (which ? F.a->in[7] : F.a->in[6]) + l * 2048; const float* w1 = (which ? F.a->in[10] : F.a->in[8]) + (size_t)l * 2048 * 256;
        float a = 0.f;
        for (int k = kp * 256; k < kp * 256 + 256; ++k) a = fmaf(pe[k], w1[(size_t)k * 256 + j], a);
        ((float*)(F.ws + WS_B1P))[((l * 2 + which) * 8 + kp) * 256 + j] = a;
    }
    for (int m = F.gw; m < M; m += F.NGW) {
        const GAS f32x4* xr = (const GAS f32x4*)(F.a->in[0] + (size_t)m * DM) + F.lane;
        GAS unsigned long long* o8 = (GAS unsigned long long*)((bf16*)(F.ws + WS_XB) + (size_t)m * DM) + F.lane;
        float s = 0.f;
#pragma unroll
        for (int j = 0; j < 4; ++j) { const f32x4 v = xr[64 * j]; s += (v.x * v.x + v.y * v.y) + (v.z * v.z + v.w * v.w);
            o8[64 * j] = (unsigned long long)pk2(v.x, v.y) | ((unsigned long long)pk2(v.z, v.w) << 32); }
        s = wave_sum(s);
        if (F.lane < 16) ((float*)(F.ws + WS_SSQ))[(size_t)m * 16 + F.lane] = F.lane == 0 ? s : 0.f;
    }
    for (int i = F.gw * 64 + F.lane; i < SEQ * 32; i += F.NGW * 64) {
        const float ang = (float)(i >> 5) * c_inv_freq[i & 31];
        ((float*)(F.ws + WS_COS))[i] = (float)cos((double)ang); ((float*)(F.ws + WS_SIN))[i] = (float)sin((double)ang);
    }
}
typedef unsigned u32x4_t __attribute__((ext_vector_type(4)));
__device__ __forceinline__ void post_group(u32x4_t raw, bool act, bool norm, bool rope, const float (&gain)[8], float scale, const float (&cs)[8], const float (&sn)[8], int lane, bf16* dst) {
    float v[8];
    v[0] = __uint_as_float(raw.x << 16); v[1] = __uint_as_float(raw.x & 0xffff0000u); v[2] = __uint_as_float(raw.y << 16); v[3] = __uint_as_float(raw.y & 0xffff0000u);
    v[4] = __uint_as_float(raw.z << 16); v[5] = __uint_as_float(raw.z & 0xffff0000u); v[6] = __uint_as_float(raw.w << 16); v[7] = __uint_as_float(raw.w & 0xffff0000u);
    float ss = ((v[0] * v[0] + v[1] * v[1]) + (v[2] * v[2] + v[3] * v[3])) + ((v[4] * v[4] + v[5] * v[5]) + (v[6] * v[6] + v[7] * v[7]));
    ss += __shfl_xor(ss, 1); ss += __shfl_xor(ss, 2); ss += __shfl_xor(ss, 4);
    const float rs = norm ? rsqrtf(ss * (1.0f / 64.0f) + 1e-6f) : 1.0f;
    const bool lo = (lane & 4) == 0;
    float r[8];
#pragma unroll
    for (int j = 0; j < 8; ++j) { const float x = norm ? v[j] * rs * gain[j] : v[j]; const float o = __shfl_xor(x, 4);
        r[j] = rope ? (lo ? (x * cs[j] - o * sn[j]) : (x * cs[j] + o * sn[j])) : x; r[j] *= scale; }
    if (act) { u32x4_t w; w.x = pk2(r[0], r[1]); w.y = pk2(r[2], r[3]); w.z = pk2(r[4], r[5]); w.w = pk2(r[6], r[7]); *(GAS u32x4_t*)dst = w; }
}
__device__ __forceinline__ void post_phase(Frame& F, int l, bool dry = false) {
    const float* qn = F.a->in[3] + l * 192; const float* kn = F.a->in[4] + l * 192;
    const int lane = F.lane, g = lane >> 3, c = lane & 7;
    float gq0[8], gq1[8], gq2[8], gk3[8], gk2[8];
#pragma unroll
    for (int j = 0; j < 8; ++j) { gq0[j] = qn[8 * c + j]; gq1[j] = qn[64 + 8 * c + j]; gq2[j] = qn[128 + 8 * c + j]; gk2[j] = kn[128 + 8 * c + j];
        gk3[j] = (g >> 1) == 0 ? kn[8 * c + j] : ((g >> 1) == 1 ? kn[64 + 8 * c + j] : kn[128 + 8 * c + j]); }
    bf16* zq = (bf16*)(F.ws + WS_ZQ); bf16* zkv = (bf16*)(F.ws + WS_ZKV);
    const float* cst = (const float*)(F.ws + WS_COS); const float* snt = (const float*)(F.ws + WS_SIN);
#pragma unroll 1
    for (int m = F.gw; m < M; m += F.NGW) {
        const int t = m & (SEQ - 1), b = m >> 12;
        float cs[8], sn[8];
        { const GAS f32x4* cp = (const GAS f32x4*)(cst + t * 32 + 8 * (c & 3)); const GAS f32x4* sp = (const GAS f32x4*)(snt + t * 32 + 8 * (c & 3));
          const f32x4 c0 = cp[0], c1 = cp[1], s0 = sp[0], s1 = sp[1];
          cs[0] = c0[0]; cs[1] = c0[1]; cs[2] = c0[2]; cs[3] = c0[3]; cs[4] = c1[0]; cs[5] = c1[1]; cs[6] = c1[2]; cs[7] = c1[3];
          sn[0] = s0[0]; sn[1] = s0[1]; sn[2] = s0[2]; sn[3] = s0[3]; sn[4] = s1[0]; sn[5] = s1[1]; sn[6] = s1[2]; sn[7] = s1[3]; }
        bf16* pqa = zq + (size_t)m * 512 + lane * 8; bf16* pqb = pqa + (size_t)M * 512; bf16* pqc = pqa + (size_t)2 * M * 512;
        const int t3 = (g >> 1) < 2 ? (g >> 1) : (g >> 1) + 1;
        bf16* p3 = zkv + (size_t)t3 * M * 256 + (size_t)m * 256 + (g & 1) * 64 + c * 8;
        const bf16* s4 = g < 4 ? zkv + (size_t)2 * M * 256 + (size_t)m * 256 + g * 64 + c * 8 : zkv + (size_t)5 * M * 256 + (size_t)m * 256 + (g - 4) * 64 + c * 8;
        bf16* d4 = g < 2 ? (bf16*)(F.ws + WS_KC2) + ((size_t)(b * 2 + g) * SEQ + t) * 64 + c * 8
                 : (g < 4 ? (bf16*)(F.ws + WS_VC2) + ((size_t)(b * 2 + (g - 2)) * SEQ + t) * 64 + c * 8 : (bf16*)s4);
        const bf16* p5 = zkv + (size_t)6 * M * 256 + (size_t)m * 256 + c * 8;
        bf16* d5 = (bf16*)(F.ws + WS_IKF) + ((size_t)(b * (SEQ / 32) + (t >> 5)) * 8 + c) * 256 + (t & 31) * 8;
        const u32x4_t r0 = *(const GAS u32x4_t*)pqa, r1 = *(const GAS u32x4_t*)pqb, r2 = *(const GAS u32x4_t*)pqc, r3 = *(const GAS u32x4_t*)p3, r4 = *(const GAS u32x4_t*)s4;
        const u32x4_t r5 = *(const GAS u32x4_t*)p5;
        post_group(r0, !dry, true, true, gq0, C2, cs, sn, lane, pqa);
        post_group(r1, !dry, true, true, gq1, C2, cs, sn, lane, pqb);
        post_group(r2, !dry, true, true, gq2, C2, cs, sn, lane, pqc);
        post_group(r3, !dry, true, true, gk3, 1.f, cs, sn, lane, p3);
        post_group(r4, !dry, g < 2, g < 2 || g >= 4, gk2, 1.f, cs, sn, lane, d4);
        post_group(r5, g == 0 && !dry, false, true, gk2, 1.f, cs, sn, lane, d5);
    }
}

#define WAVE_LDS_FENCE() asm volatile("s_waitcnt lgkmcnt(0)" ::: "memory")
__device__ __forceinline__ int next_unit(Frame& F, gu32* counter) {
    LAS int* slot = (LAS int*)(F.lds + LDS_UNIT);
    __syncthreads();
    if (F.tid == 0) *slot = (int)__hip_atomic_fetch_add(counter, 1u, RLX_AGENT);
    __syncthreads();
    return *slot;
}
__device__ __forceinline__ unsigned f2key(float f) { const unsigned u = __float_as_uint(f); return (u & 0x80000000u) ? ~u : (u | 0x80000000u); }
__device__ __forceinline__ float dpp_quad_sum(float v) {
    v += __int_as_float(__builtin_amdgcn_update_dpp(0, __float_as_int(v), 0xB1, 0xF, 0xF, true));
    v += __int_as_float(__builtin_amdgcn_update_dpp(0, __float_as_int(v), 0x4E, 0xF, 0xF, true));
    return v;
}
__device__ __forceinline__ void radix_select_list(LAS const unsigned* list, int nblk, int k, LAS unsigned* hist, int lane, unsigned& T, int& need) {
    typedef unsigned u32x4_ __attribute__((ext_vector_type(4)));
    unsigned prefix = 0u; int kk = k;
#pragma unroll 1
    for (int pass = 0; pass < 4; ++pass) {
        const int shift = 24 - 8 * pass;
#pragma unroll
        for (int i = 0; i < 4; ++i) hist[lane * 4 + i] = 0u;
        WAVE_LDS_FENCE();
#pragma unroll 2
        for (int jb = 0; jb < nblk; ++jb) { const u32x4_ v = *(LAS const u32x4_*)(list + jb * 256 + lane * 4);
#pragma unroll
            for (int c = 0; c < 4; ++c) { const unsigned key = v[c];
                const unsigned bin = (pass == 0 || (key >> (shift + 8)) == prefix) ? ((key >> shift) & 255u) : 256u + (unsigned)lane;
                __hip_atomic_fetch_add(&hist[bin], 1u, __ATOMIC_RELAXED, __HIP_MEMORY_SCOPE_WORKGROUP); } }
        WAVE_LDS_FENCE();
        const unsigned h0 = hist[lane * 4], h1 = hist[lane * 4 + 1], h2 = hist[lane * 4 + 2], h3 = hist[lane * 4 + 3];
        const int tot4 = (int)(h0 + h1 + h2 + h3);
        int pre = tot4;
        pre += __builtin_amdgcn_update_dpp(0, pre, 0x111, 0xf, 0xf, false);
        pre += __builtin_amdgcn_update_dpp(0, pre, 0x112, 0xf, 0xf, false);
        pre += __builtin_amdgcn_update_dpp(0, pre, 0x114, 0xf, 0xf, false);
        pre += __builtin_amdgcn_update_dpp(0, pre, 0x118, 0xf, 0xf, false);
        pre += __builtin_amdgcn_update_dpp(0, pre, 0x142, 0xa, 0xf, false);
        pre += __builtin_amdgcn_update_dpp(0, pre, 0x143, 0xc, 0xf, false);
        const int total = __builtin_amdgcn_readlane(pre, 63);
        const int above = total - pre;
        const int a3 = above, a2 = a3 + (int)h3, a1 = a2 + (int)h2, a0 = a1 + (int)h1;
        int dsel = -1, nk = 0;
        if (a3 < kk && kk <= a3 + (int)h3) { dsel = lane * 4 + 3; nk = kk - a3; }
        else if (a2 < kk && kk <= a2 + (int)h2) { dsel = lane * 4 + 2; nk = kk - a2; }
        else if (a1 < kk && kk <= a1 + (int)h1) { dsel = lane * 4 + 1; nk = kk - a1; }
        else if (a0 < kk && kk <= a0 + (int)h0) { dsel = lane * 4 + 0; nk = kk - a0; }
        const unsigned long long bal = __ballot(dsel >= 0);
        const int src = (int)__builtin_ctzll(bal);
        dsel = __builtin_amdgcn_readlane(dsel, src); nk = __builtin_amdgcn_readlane(nk, src);
        WAVE_LDS_FENCE();
        prefix = (prefix << 8) | (unsigned)dsel; kk = nk;
    }
    T = prefix; need = kk;
}
__device__ __forceinline__ void select_unit(Frame& F, int b, int qblk, int abl = 0) {
    using namespace att;
    int tid_ = F.tid; asm volatile("" : "+v"(tid_));
    const int lane = tid_ & 63, r32 = lane & 31, hi = lane >> 5, w = F.wave;
    LAS unsigned* sc = (LAS unsigned*)F.lds;
    LAS unsigned* hist = (LAS unsigned*)(F.lds + 131072) + w * 320;
    LAS unsigned* cand = (LAS unsigned*)(F.lds + 131072 + 10240) + w * 512;
    const int t0 = qblk * 8; const size_t m0 = (size_t)b * SEQ + t0;
    const bf16* IQ = (const bf16*)(F.ws + WS_ZKV) + (size_t)5 * M * 256; const bf16* MISC = (const bf16*)(F.ws + WS_ZKV) + (size_t)6 * M * 256;
    const bf16* IKF = (const bf16*)(F.ws + WS_IKF) + (size_t)b * SEQ * 64;
    u64* BM = (u64*)(F.ws + WS_BM);
    const int nkeys = t0 + 8;
    if (nkeys > 256 && abl < 2) {
        bf16x8 iqf[4];
        { const bf16* qrow = IQ + (m0 + (r32 >> 2)) * 256 + (r32 & 3) * 64;
#pragma unroll
          for (int d0 = 0; d0 < 4; ++d0) iqf[d0] = *(const GAS bf16x8*)(qrow + d0 * 16 + hi * 8); }
        const float wl = bf2f(((const GAS bf16*)MISC)[(m0 + (r32 >> 2)) * 256 + 64 + (r32 & 3)]);
        const int ntile = (nkeys + 31) >> 5; const int g = r32 & 3;
#pragma unroll 1
        for (int tile0 = w; tile0 < ntile; tile0 += 16) {
            bf16x8 kf[2][4];
#pragma unroll
            for (int u = 0; u < 2; ++u) { const int tile = tile0 + 8 * u < ntile ? tile0 + 8 * u : tile0;
                const bf16* kt = IKF + (size_t)tile * 2048 + hi * 256 + r32 * 8;
#pragma unroll
                for (int d0 = 0; d0 < 4; ++d0) kf[u][d0] = *(const GAS bf16x8*)(kt + d0 * 512); }
#pragma unroll
            for (int u = 0; u < 2; ++u) { const int tile = tile0 + 8 * u;
                if (tile < ntile) {
                    const int s0 = tile * 32;
                    f32x16 acc;
#pragma unroll
                    for (int r = 0; r < 16; ++r) acc[r] = 0.f;
#pragma unroll
                    for (int d0 = 0; d0 < 4; ++d0) acc = __builtin_amdgcn_mfma_f32_32x32x16_bf16(kf[u][d0], iqf[d0], acc, 0, 0, 0);
                    float v[16];
#pragma unroll
                    for (int r = 0; r < 16; ++r) v[r] = dpp_quad_sum(__builtin_amdgcn_fmed3f(acc[r], 0.f, __builtin_inff()) * wl);
                    u32x4 o;
#pragma unroll
                    for (int j = 0; j < 4; ++j) o[j] = f2key(g == 0 ? v[j] : (g == 1 ? v[4 + j] : (g == 2 ? v[8 + j] : v[12 + j])));
                    *(LAS u32x4*)(sc + (r32 >> 2) * 4096 + s0 + 8 * g + 4 * hi) = o;
                } }
        }
    }
    __syncthreads();
    if (abl != 1) {
        const int t = t0 + w, n = t + 1; LAS unsigned* row = sc + w * 4096;
        u64 myword = 0ull;
        if (n <= 256) {
            const int c0 = 64 * lane;
            myword = (c0 + 63 < n) ? ~0ull : (c0 >= n ? 0ull : ((1ull << (n - c0)) - 1ull));
        } else {
            const int nblk = (n + 255) >> 8;
            { const int s = (n & ~3) + lane * 4;
              if (s < nblk * 256) { u32x4 v = *(LAS u32x4*)(row + s);
#pragma unroll
                  for (int c = 0; c < 4; ++c) if (s + c >= n) v[c] = 0u;
                  *(LAS u32x4*)(row + s) = v; } }
            WAVE_LDS_FENCE();
            unsigned T = 0u; int need = 0; bool done = false;
            if (n > 512 && abl != 5) {
#pragma unroll
                for (int c = 0; c < 8; ++c) { const int i = lane + 64 * c; cand[i] = row[(i * n) >> 9]; }
                WAVE_LDS_FENCE();
                const float er = 131072.0f / (float)n;
                int rr = (int)(er + 2.5f * __builtin_sqrtf(er * (1.0f - 256.0f / (float)n)) + 2.0f); rr = rr > 512 ? 512 : rr;
                unsigned P; int dummy; radix_select_list(cand, 2, rr, hist, lane, P, dummy);
                int C = 0; bool ovf = false;
#pragma unroll 1
                for (int jb = 0; jb < nblk; ++jb) { const u32x4 v = *(LAS const u32x4*)(row + jb * 256 + lane * 4);
#pragma unroll
                    for (int c = 0; c < 4; ++c) { const bool in = v[c] > P; const u64 bal = __ballot(in); const int pos = C + __builtin_popcountll(bal & ((1ull << lane) - 1ull));
                        C += __builtin_popcountll(bal); if (C > 512) ovf = true;
                        if (in && !ovf) cand[pos] = v[c]; } }
                if (!ovf && C >= 256) {
                    WAVE_LDS_FENCE();
                    const int cb = (C + 255) >> 8;
                    { const int s = C + lane; if (s < cb * 256) cand[s] = 0u; const int s2 = s + 64; if (s2 < cb * 256) cand[s2] = 0u; const int s3 = s + 128; if (s3 < cb * 256) cand[s3] = 0u; const int s4 = s + 192; if (s4 < cb * 256) cand[s4] = 0u; }
                    WAVE_LDS_FENCE();
                    radix_select_list(cand, cb, 256, hist, lane, T, need); done = true;
                }
            }
            if (!done && abl < 3) radix_select_list(row, nblk, 256, hist, lane, T, need);
            int base = 0;
            const int nch = abl >= 4 ? 0 : (n + 63) >> 6;
#pragma unroll 1
            for (int c = 0; c < nch; c += 4) {
                unsigned vv[4];
#pragma unroll
                for (int u2 = 0; u2 < 4; ++u2) vv[u2] = row[64 * (c + u2) + lane];
#pragma unroll
                for (int u2 = 0; u2 < 4; ++u2) {
                    const int s = 64 * (c + u2) + lane; const bool valid = s < n; const unsigned key = valid ? vv[u2] : 0u;
                    const bool gt = valid && key > T, eq = valid && key == T;
                    const u64 beq = __ballot(eq);
                    const int rank = base + __builtin_popcountll(beq & ((1ull << lane) - 1ull));
                    const u64 word = __ballot(gt || (eq && rank < need));
                    if (lane == c + u2) myword = word;
                    base += __builtin_popcountll(beq);
                }
            }
        }
        if (abl >= 2) ((GAS u64*)(F.ws + WS_MB + 24 * MiB))[((size_t)b * SEQ + t) * 64 + lane] = myword;
        else ((GAS u64*)BM)[((size_t)b * SEQ + t) * 64 + lane] = myword;
    }
    __syncthreads();
}
__device__ __forceinline__ void compress_unit(Frame& F, int l, int u) {
    using namespace att;
    int tid_ = F.tid; asm volatile("" : "+v"(tid_));
    const int lane = tid_ & 63, r32 = lane & 31, hi = lane >> 5, w = F.wave;
    const int which = u & 1, h = (u >> 1) & 1, b = (u >> 2) & 3, cb = u >> 4;
    const bf16* src = (const bf16*)(F.ws + (which ? WS_VC2 : WS_KC2)) + (size_t)(b * 2 + h) * SEQ * 64;
    const bf16* W1t = (const bf16*)(F.ws + WS_W + (size_t)l * W_LAYER + (which ? W_CV1 : W_CK1));
    const bf16* W2t = (const bf16*)(F.ws + WS_W2) + (size_t)(l * 2 + which) * 64 * 256;
    const float* b1p = (const float*)(F.ws + WS_B1P) + (size_t)(l * 2 + which) * 8 * 256;
    LAS bf16* hid = (LAS bf16*)F.lds;
    int cc = 32 * cb + r32; if (cc > 254) cc = 254;
    const bf16* arow = src + (size_t)(16 * cc) * 64 + hi * 8;
    const bf16* brow = W1t + (size_t)(32 * w + r32) * 2048 + hi * 8;
    f32x16 acc;
#pragma unroll
    for (int r = 0; r < 16; ++r) acc[r] = 0.f;
#pragma unroll 4
    for (int ks = 0; ks < 128; ++ks) { const bf16x8 a = *(const GAS bf16x8*)(arow + ks * 16), bb = *(const GAS bf16x8*)(brow + ks * 16); acc = __builtin_amdgcn_mfma_f32_32x32x16_bf16(a, bb, acc, 0, 0, 0); }
    float b1 = 0.f;
#pragma unroll
    for (int kp = 0; kp < 8; ++kp) b1 += ((const GAS float*)b1p)[kp * 256 + 32 * w + r32];
#pragma unroll
    for (int r = 0; r < 16; ++r) hid[crow(r, hi) * 264 + 32 * w + r32] = (bf16)f2bf(fmaxf(acc[r] + b1, 0.f));
    __syncthreads();
    if (w < 2) {
        f32x16 o;
#pragma unroll
        for (int r = 0; r < 16; ++r) o[r] = 0.f;
        const bf16* w2row = W2t + (size_t)(32 * w + r32) * 256 + hi * 8;
#pragma unroll
        for (int ks = 0; ks < 16; ++ks) { const bf16x8 a = *(LAS const bf16x8*)(hid + r32 * 264 + ks * 16 + hi * 8), bb = *(const GAS bf16x8*)(w2row + ks * 16); o = __builtin_amdgcn_mfma_f32_32x32x16_bf16(a, bb, o, 0, 0, 0); }
        bf16* dst = (bf16*)(F.ws + WS_KCMP) + ((size_t)((which * 4 + b) * 2 + h) * 256) * 64;
        float mx = 0.f;
#pragma unroll
        for (int r = 0; r < 16; ++r) { const int c = 32 * cb + crow(r, hi); const float v = c < 255 ? o[r] : 0.f; mx = fmaxf(mx, fabsf(v)); ((GAS bf16*)dst)[(size_t)c * 64 + 32 * w + r32] = (bf16)f2bf(v); }
        if (which == 0) { mx = wave_max(mx); if (lane == 0) __hip_atomic_fetch_max(F.ctl + CW_KMAX + 64 * (l * 8 + b * 2 + h), __float_as_uint(mx), RLX_AGENT); }
    }
    __syncthreads();
}
__device__ __forceinline__ void misc_phase(Frame& F, int l) {
    using namespace att;
    int tid_ = F.tid; asm volatile("" : "+v"(tid_));
    const int lane = tid_ & 63, r32 = lane & 31, hi = lane >> 5, w = F.wave;
    if (w >= 6) return;
    const int task = (int)blockIdx.x * 6 + w, tile = task / 3, cb = task % 3;
    const bf16* arow = (const bf16*)(F.ws + WS_XB) + (size_t)(tile * 32 + r32) * 1024 + hi * 8;
    const bf16* brow = (const bf16*)(F.ws + WS_W + (size_t)l * W_LAYER + W_IN) + (size_t)(3072 + cb * 32 + r32) * 1024 + hi * 8;
    f32x16 acc;
#pragma unroll
    for (int r = 0; r < 16; ++r) acc[r] = 0.f;
#pragma unroll 16
    for (int ks = 0; ks < 64; ++ks) { const bf16x8 a = *(const GAS bf16x8*)(arow + ks * 16), bb = *(const GAS bf16x8*)(brow + ks * 16); acc = __builtin_amdgcn_mfma_f32_32x32x16_bf16(a, bb, acc, 0, 0, 0); }
    const float rv = pg8::row_rstd((const float*)(F.ws + WS_SSQ), tile * 32 + r32);
    bf16* dst = (bf16*)(F.ws + WS_ZKV) + (size_t)6 * M * 256 + (size_t)(tile * 32) * 256 + cb * 32 + r32;
#pragma unroll
    for (int r = 0; r < 16; ++r) { const int row = crow(r, hi); const float rs = __shfl(rv, row); ((GAS bf16*)dst)[(size_t)row * 256] = (bf16)f2bf(acc[r] * rs); }
}
struct UnitGeom { int b, kvh, i; att::Lane L; int q; int head; size_t mrow; };
__device__ __forceinline__ UnitGeom unit_geom(Frame& F, int b, int kvh, int i) {
    int tid = F.tid; asm volatile("" : "+v"(tid));
    UnitGeom U; U.b = b; U.kvh = kvh; U.i = i; U.L.tid = tid; U.L.lane = tid & 63; U.L.r32 = tid & 31; U.L.hi = (tid >> 5) & 1; U.L.wid = F.wave;
    U.q = 64 * i + 8 * F.wave + (U.L.r32 >> 2); U.head = 4 * kvh + (U.L.r32 & 3); U.mrow = (size_t)b * SEQ + U.q; return U;
}
__device__ __forceinline__ void branch_finish(LAS float* wsf, const att::f32x16& ol, const float (&extra)[4], float rowscale, bool has_scale, const att::f32x16 (&o)[2], att::f32x16 (&acc)[2], const att::Lane& L, bool first) {
    float sc[16];
    if (has_scale) att::rows_to_regs(wsf, rowscale, L.r32, L.hi, sc);
#pragma unroll
    for (int r = 0; r < 16; ++r) { const float lf = ol[r] + extra[r & 3]; const float inv = lf > 0.f ? __builtin_amdgcn_rcpf(lf) : 0.f; sc[r] = has_scale ? sc[r] * inv : inv; }
#pragma unroll
    for (int d0 = 0; d0 < 2; ++d0)
#pragma unroll
        for (int r = 0; r < 16; ++r) acc[d0][r] = first ? o[d0][r] * sc[r] : acc[d0][r] + o[d0][r] * sc[r];
}
__device__ __forceinline__ void branch_finish_lds(LAS float* wsf, LAS float* accw, const att::f32x16& ol, float rowscale, const att::f32x16 (&o)[2], const att::Lane& L, bool first) {
    float sc[16]; att::rows_to_regs(wsf, rowscale, L.r32, L.hi, sc);
#pragma unroll
    for (int r = 0; r < 16; ++r) sc[r] = ol[r] > 0.f ? sc[r] * __builtin_amdgcn_rcpf(ol[r]) : 0.f;
#pragma unroll
    for (int d0 = 0; d0 < 2; ++d0)
#pragma unroll
        for (int r = 0; r < 16; ++r) { float v = o[d0][r] * sc[r]; if (!first) v += accw[(d0 * 16 + r) * 64 + L.lane]; accw[(d0 * 16 + r) * 64 + L.lane] = v; }
}
__device__ __forceinline__ float gain_bound(const float* g, int lane) { return wave_max(fabsf(g[lane])); }

template <int KIND  >
__device__ __forceinline__ void simple_unit(Frame& F, int l, int b, int kvh, int i, bf16* odst = nullptr) {
    using namespace att;
    const UnitGeom U = unit_geom(F, b, kvh, i); const Lane& L = U.L;
    constexpr int QT = KIND == 0 ? 1 : 0, KT = KIND == 0 ? 1 : 0, NM = KIND == 0 ? 1 : 0;
    bf16* Q = (bf16*)(F.ws + WS_ZQ) + (size_t)QT * M * 512; const bf16* KV = (const bf16*)(F.ws + WS_ZKV) + (size_t)KT * M * 256;
    bf16x8 qr[4]; load_q(Q + U.mrow * 512 + U.head * 64, L.hi, qr);
    const float C = 0.f; (void)NM;
    KVSrc S{(const GAS bf16*)(KV + (size_t)b * SEQ * 256 + kvh * 64), (const GAS bf16*)(KV + (size_t)b * SEQ * 256 + 128 + kvh * 64), 256, SEQ};
    f32x16 ol, o[2];
#pragma unroll
    for (int r = 0; r < 16; ++r) { o[0][r] = 0.f; o[1][r] = 0.f; ol[r] = 0.f; }
    const int q = U.q;
    if (KIND == 0) {
        auto mf = [q](int t) -> u64 { return mask_le(q - 64 * t) & mask_ge(q - 127 - 64 * t); };
        attend_range((LAS char*)F.lds, S, i - 2 < 0 ? 0 : i - 2, i + 1, mf, qr, -C, ol, o, L);
    } else {
        LAS char* mrows = (LAS char*)F.lds + L_OST + L.wid * 8192 + 4096;
        { const GAS u32x4* src = (const GAS u32x4*)((const GAS u64*)(F.ws + WS_BM) + ((size_t)b * SEQ + 64 * i + 8 * L.wid) * 64);
#pragma unroll
          for (int k = 0; k < 4; ++k) *(LAS u32x4*)(mrows + (k * 64 + L.lane) * 16) = src[k * 64 + L.lane];
          WAVE_LDS_FENCE(); }
        LAS const char* mrow = mrows + (L.r32 >> 2) * 512;
        auto mf = [mrow](int t) -> u64 { return *(LAS const u64*)(mrow + t * 8); };
#ifdef PROBE_TILES
        attend_range((LAS char*)F.lds, S, 0, odst ? (i + 1 < PROBE_TILES ? i + 1 : PROBE_TILES) : i + 1, mf, qr, -C, ol, o, L, odst != nullptr);
#else
        attend_range((LAS char*)F.lds, S, 0, i + 1, mf, qr, -C, ol, o, L, odst != nullptr);
#endif
    }
    const UnitGeom V = unit_geom(F, b, kvh, i); const Lane& L2 = V.L;
    float extra[4] = {0.f, 0.f, 0.f, 0.f};
    if (KIND == 0) {
#pragma unroll
        for (int g = 0; g < 4; ++g) extra[g] = __builtin_amdgcn_exp2f(F.a->in[5][l * 8 + 4 * kvh + g] * LOG2E);
    }
    f32x16 acc[2];
    branch_finish((LAS float*)((LAS char*)F.lds + L_WSF) + L2.wid * WSF_W, ol, extra, 1.f, false, o, acc, L2, true);
    bf16* Q2 = (bf16*)(F.ws + WS_ZQ) + (size_t)QT * M * 512;
    const size_t tok0 = (size_t)b * SEQ + 64 * i + 8 * L2.wid; const int kvh4 = 4 * kvh;
    bf16* Od = odst ? odst : Q2;
    auto rowptr = [Od, tok0, kvh4](int row) -> bf16* { return Od + (tok0 + (row >> 2)) * 512 + (kvh4 + (row & 3)) * 64; };
    store_o((LAS char*)F.lds + L_OST + L2.wid * 8192, acc, rowptr, L2.lane, L2.r32, L2.hi);
}
__device__ __forceinline__ void nsa_unit(Frame& F, int l, int b, int kvh, int i, bf16* odst = nullptr) {
    using namespace att;
    f32x16 o[2], ol;
    bf16x8 qr[4];
    {
        const UnitGeom U = unit_geom(F, b, kvh, i); const Lane& L = U.L;
        const bf16* Q = (const bf16*)(F.ws + WS_ZQ) + (size_t)2 * M * 512; const bf16* MISC = (const bf16*)(F.ws + WS_ZKV) + (size_t)6 * M * 256;
        load_q(Q + U.mrow * 512 + U.head * 64, L.hi, qr);
        LAS float* wsf = (LAS float*)((LAS char*)F.lds + L_WSF) + L.wid * WSF_W;
#pragma unroll
        for (int br = 0; br < 3; ++br) wsf[64 + br * 64 + L.lane] = pg8::sigmoidf_(bf2f(((const GAS bf16*)MISC)[U.mrow * 256 + 68 + U.head * 3 + br]));
        WAVE_LDS_FENCE();
    }
    const float Ck = 0.f, Cc = 0.f;
    const int qmax = 64 * i + 63; const int nvmax = qmax >= 31 ? (((qmax - 31) >> 4) + 1 < 255 ? ((qmax - 31) >> 4) + 1 : 255) : 0;
    const int tc = (nvmax + 63) >> 6;
    const bf16* kcmp = (const bf16*)(F.ws + WS_KCMP) + (size_t)((0 * 4 + b) * 2 + kvh) * 256 * 64; const bf16* vcmp = (const bf16*)(F.ws + WS_KCMP) + (size_t)((1 * 4 + b) * 2 + kvh) * 256 * 64;
    {
        const UnitGeom U = unit_geom(F, b, kvh, i); const Lane& L = U.L; const int q = U.q;
        const int nval = q >= 31 ? (((q - 31) >> 4) + 1 < 255 ? ((q - 31) >> 4) + 1 : 255) : 0;
        KVSrc Sc{(const GAS bf16*)kcmp, (const GAS bf16*)vcmp, 64, 256};
        auto mfc = [nval](int t) -> u64 { return mask_le(nval - 1 - 64 * t); };
#pragma unroll
        for (int r = 0; r < 16; ++r) { o[0][r] = 0.f; o[1][r] = 0.f; ol[r] = 0.f; }
        attend_range((LAS char*)F.lds, Sc, 0, tc, mfc, qr, -Cc, ol, o, L);
    }
    const UnitGeom U = unit_geom(F, b, kvh, i); const Lane& L = U.L; const int q = U.q;
    LAS float* wsf = (LAS float*)((LAS char*)F.lds + L_WSF) + L.wid * WSF_W;
    LAS float* accw = (LAS float*)((LAS char*)F.lds + L_OST + L.wid * 8192);
    const int nval = q >= 31 ? (((q - 31) >> 4) + 1 < 255 ? ((q - 31) >> 4) + 1 : 255) : 0;
    auto mfc = [nval](int t) -> u64 { return mask_le(nval - 1 - 64 * t); };
    WAVE_LDS_FENCE();
    if (L.r32 == 0) {
#pragma unroll
        for (int r = 0; r < 16; ++r) wsf[32 + crow(r, L.hi)] = ol[r]; }
    WAVE_LDS_FENCE();
    const float lc = wsf[32 + L.r32]; const float rlc = lc > 0.f ? __builtin_amdgcn_rcpf(lc) : 0.f;
    branch_finish_lds(wsf, accw, ol, wsf[64 + L.lane], o, L, true);
    LAS float* impw = (LAS float*)((LAS char*)F.lds + L_IMP) + L.wid * 512;
#pragma unroll
    for (int k = 0; k < 8; ++k) impw[L.lane + 64 * k] = 0.f;
    WAVE_LDS_FENCE();
    for (int t = 0; t < tc; ++t) {
        f32x16 p0, p1;
#pragma unroll
        for (int r = 0; r < 16; ++r) { p0[r] = 0.f; p1[r] = 0.f; }
        qk_tile((LAS char*)F.lds + L_K0 + t * 8320, qr, p0, p1, L.r32, L.hi);
        const u64 mk = mfc(t); const unsigned m0 = (unsigned)(mk >> (4 * L.hi)), m1 = (unsigned)(mk >> (32 + 4 * L.hi));
        const int qloc = L.r32 >> 2; const bool wr = (L.r32 & 3) == 0;
#pragma unroll
        for (int half = 0; half < 2; ++half)
#pragma unroll
            for (int m = 0; m < 4; ++m) {
                float e[4];
#pragma unroll
                for (int k = 0; k < 4; ++k) { const int r = 4 * m + k, bit = k + 8 * m; const float x = half ? p1[r] : p0[r]; const unsigned mm = half ? m1 : m0;
                    e[k] = ((mm >> bit) & 1u) ? __builtin_amdgcn_exp2f(x) * rlc : 0.f; }
                const float core = dpp_quad_sum((e[0] + e[1]) + (e[2] + e[3])), edge = dpp_quad_sum(e[3]);
                const int j = 16 * t + 8 * half + 2 * m + L.hi;
                if (wr) { impw[qloc * 64 + j] += core; }
                WAVE_LDS_FENCE();
                if (wr && j + 1 < 64) { impw[qloc * 64 + j + 1] += edge; }
                WAVE_LDS_FENCE();
            }
    }
    __syncthreads();
    {
        const int qloc = L.lane >> 3, sub = L.lane & 7; const int cur = i;
        u64 keys[8];
#pragma unroll
        for (int k = 0; k < 8; ++k) { const int j = sub + 8 * k; float v = impw[qloc * 64 + j];
            if (j == 0 || j == cur || j == cur - 1) v = 1e9f;
            if (j > cur) v = -1e30f;
            keys[k] = ((u64)f2key(v) << 32) | (u64)(63 - j); }
        u64 selm = 0ull; unsigned used = 0u;
#pragma unroll 1
        for (int it = 0; it < 16; ++it) {
            u64 best = 0ull;
#pragma unroll
            for (int k = 0; k < 8; ++k) { const u64 c = ((used >> k) & 1u) ? 0ull : keys[k]; best = c > best ? c : best; }
#pragma unroll
            for (int o2 = 1; o2 < 8; o2 <<= 1) { const unsigned lo = __shfl_xor((unsigned)best, o2), hi2 = __shfl_xor((unsigned)(best >> 32), o2); const u64 ob = ((u64)hi2 << 32) | lo; best = ob > best ? ob : best; }
            const int jsel = 63 - (int)(best & 63ull);
            if ((jsel & 7) == sub) used |= 1u << (jsel >> 3);
            selm |= 1ull << jsel;
        }
        LAS u64* selw = (LAS u64*)((LAS char*)F.lds + L_SEL) + L.wid * 8;
        if (sub == 0) selw[qloc] = selm;
        WAVE_LDS_FENCE();
    }
    {
        const UnitGeom X = unit_geom(F, b, kvh, i); const Lane& L = X.L; const int q = X.q;
        const u64 sel = ((LAS const u64*)((LAS char*)F.lds + L_SEL))[L.wid * 8 + (L.r32 >> 2)];
        const bf16* KV = (const bf16*)(F.ws + WS_ZKV) + (size_t)3 * M * 256;
        KVSrc S{(const GAS bf16*)(KV + (size_t)b * SEQ * 256 + kvh * 64), (const GAS bf16*)(KV + (size_t)b * SEQ * 256 + 128 + kvh * 64), 256, SEQ};
        auto mf = [sel, q](int t) -> u64 { return ((sel >> t) & 1ull) ? mask_le(q - 64 * t) : 0ull; };
#pragma unroll
        for (int r = 0; r < 16; ++r) { o[0][r] = 0.f; o[1][r] = 0.f; ol[r] = 0.f; }
        attend_range((LAS char*)F.lds, S, 0, i + 1, mf, qr, -Ck, ol, o, L);
        const UnitGeom W = unit_geom(F, b, kvh, i); LAS float* wsf2 = (LAS float*)((LAS char*)F.lds + L_WSF) + W.L.wid * WSF_W;
        branch_finish_lds(wsf2, (LAS float*)((LAS char*)F.lds + L_OST + W.L.wid * 8192), ol, wsf2[128 + W.L.lane], o, W.L, false);
    }
    {
        const UnitGeom X = unit_geom(F, b, kvh, i); const Lane& L = X.L; const int q = X.q;
        const bf16* KV = (const bf16*)(F.ws + WS_ZKV) + (size_t)4 * M * 256;
        KVSrc S{(const GAS bf16*)(KV + (size_t)b * SEQ * 256 + kvh * 64), (const GAS bf16*)(KV + (size_t)b * SEQ * 256 + 128 + kvh * 64), 256, SEQ};
        auto mf = [q](int t) -> u64 { return mask_le(q - 64 * t) & mask_ge(q - 511 - 64 * t); };
#pragma unroll
        for (int r = 0; r < 16; ++r) { o[0][r] = 0.f; o[1][r] = 0.f; ol[r] = 0.f; }
        attend_range((LAS char*)F.lds, S, i - 8 < 0 ? 0 : i - 8, i + 1, mf, qr, -Ck, ol, o, L);
        const UnitGeom W = unit_geom(F, b, kvh, i); LAS float* wsf2 = (LAS float*)((LAS char*)F.lds + L_WSF) + W.L.wid * WSF_W;
        branch_finish_lds(wsf2, (LAS float*)((LAS char*)F.lds + L_OST + W.L.wid * 8192), ol, wsf2[192 + W.L.lane], o, W.L, false);
    }
    {
        const UnitGeom X = unit_geom(F, b, kvh, i); const Lane& L = X.L;
        LAS float* accw2 = (LAS float*)((LAS char*)F.lds + L_OST + L.wid * 8192);
        const size_t tok0 = (size_t)b * SEQ + 64 * i + 8 * L.wid; const int kvh4 = 4 * kvh;
        bf16* Od = odst ? odst : (bf16*)(F.ws + WS_ZQ) + (size_t)2 * M * 512;
        auto rowptr = [Od, tok0, kvh4](int row) -> bf16* { return Od + (tok0 + (row >> 2)) * 512 + (kvh4 + (row & 3)) * 64; };
        f32x16 acc[2];
#pragma unroll
        for (int d0 = 0; d0 < 2; ++d0)
#pragma unroll
            for (int r = 0; r < 16; ++r) acc[d0][r] = accw2[(d0 * 16 + r) * 64 + L.lane];
        WAVE_LDS_FENCE();
        store_o((LAS char*)F.lds + L_OST + L.wid * 8192, acc, rowptr, L.lane, L.r32, L.hi);
    }
}

__global__ void __launch_bounds__(NWAVES * 64, 2) mk_fwd(Args args) {
    extern __shared__ __attribute__((aligned(16))) unsigned char lds_raw[];
    LAS unsigned char* lds = (LAS unsigned char*)lds_raw;
    volatile LAS unsigned* MISCW = (volatile LAS unsigned*)(lds + LDS_UNIT + 16);
    if (threadIdx.x < 8) MISCW[threadIdx.x] = 0u;
    __syncthreads();
    (void)xcd_barrier_post((unsigned*)((gu32*)(args.ws + WS_CTL) + CW_BAR), MISCW);
#define GRID_BARRIER() do { unsigned char* wsb_ = args.ws; asm volatile("" : "+s"(wsb_)); XcdBarrier bar_; bar_.bar = (unsigned*)((gu32*)(wsb_ + WS_CTL) + CW_BAR); bar_.x = xb_xcc_id(); \
    bar_.st = (volatile LAS unsigned*)(lds + LDS_UNIT + 16); xcd_barrier(bar_); } while (0)
#define MKFRAME() Frame F; { unsigned char* ws_ = args.ws; asm volatile("" : "+s"(ws_)); int tid_ = threadIdx.x; asm volatile("" : "+v"(tid_)); \
    F.lds = lds; F.tid = tid_; F.lane = tid_ & 63; F.wave = __builtin_amdgcn_readfirstlane(tid_ >> 6); F.G = gridDim.x; F.gw = 0; F.NGW = F.G * NWAVES; \
    F.ws = ws_; F.ctl = (gu32*)(ws_ + WS_CTL); F.a = &args; } int bid = blockIdx.x; asm volatile("" : "+s"(bid)); F.gw = bid * NWAVES + F.wave; \
    unsigned char* ws = F.ws; bf16* XB = (bf16*)(ws + WS_XB); bf16* MB = (bf16*)(ws + WS_MB); bf16* ZQ = (bf16*)(ws + WS_ZQ); bf16* ZKV = (bf16*)(ws + WS_ZKV); bf16* YS = (bf16*)(ws + WS_YS); bf16* HM = (bf16*)(ws + WS_HMID); \
    float* SSQ = (float*)(ws + WS_SSQ); (void)XB; (void)MB; (void)ZQ; (void)ZKV; (void)YS; (void)HM; (void)SSQ;
#define WL(l) (ws + WS_W + (size_t)(l) * W_LAYER)
#ifdef PROBE_T
#define STAMP(k) do { if (blockIdx.x == 0 && threadIdx.x == 0) ((unsigned long long*)(args.ws + WS_CTL + 96 * 1024))[k] = __builtin_amdgcn_s_memrealtime(); } while (0)
#else
#define STAMP(k) do { } while (0)
#endif

    STAMP(0);
#ifndef NO_P0
    { MKFRAME(); p0_prologue(F); }
#ifdef DBL_P0
    { MKFRAME(); p0_prologue(F); }
#endif
#endif
    GRID_BARRIER();
    STAMP(1);
#pragma unroll 1
    for (int l = 0; l < DEPTH; ++l) {
#ifndef NO_G1
#ifdef DBL_G1
        for (int rep_ = 0; rep_ < 2; ++rep_)
#endif
        {
            MKFRAME(); unsigned char* wl = WL(l);
            pg8::Gemm g{XB, (const bf16*)(wl + W_IN), M, 3072, DM}; pg8::StaticOrder S; S.init(M, 3072, F.G, bid);
            pg8::EpiG1 E{ZQ, ZKV, SSQ};
            pg8::gemm_phase<pg8::EpiG1, pg8::StaticOrder, true, true>(F.lds, g, S, E);
        }
        { MKFRAME(); misc_phase(F, l); }
#endif
        GRID_BARRIER();
        STAMP(2 + 8 * l);
#ifndef NO_POST
        { MKFRAME(); post_phase(F, l); }
#ifdef DBL_POST
        { MKFRAME(); post_phase(F, l, true); }
#endif
#endif
        GRID_BARRIER();
        STAMP(3 + 8 * l);
#ifdef DBL_ATT1
        for (int rep1_ = 0; rep1_ < 2; ++rep1_)
#else
        const int rep1_ = 0;
#endif
        {
            MKFRAME();
            const int xcd = (int)(xb_xcc_id() & 7u);
#pragma unroll 1
            for (int qi = 0; qi < 8; ++qi) {
                const int x = (xcd + qi) & 7, b = x >> 1, sub = x & 1;
                gu32* ctr = F.ctl + CW_Q + 64 * ((2 * l + 4 * rep1_) * 8 + x);
                for (;;) { const int v = next_unit(F, ctr); if (v >= 16 + 256 + 64) break;
#ifdef DBL_ATT1
                    if (v < 16) { if (rep1_ == 0 || DBL_ATT1 == 1 || DBL_ATT1 == 2) compress_unit(F, l, (v & 1) | (sub << 1) | (b << 2) | ((v >> 1) << 4)); }
                    else if (v < 16 + 256) { if (rep1_ == 0 || DBL_ATT1 == 1 || DBL_ATT1 == 3 || DBL_ATT1 >= 5) select_unit(F, b, 2 * (255 - (v - 16)) + sub, rep1_ ? (DBL_ATT1 >= 5 ? DBL_ATT1 - 4 : 0) : 0  ); }
                    else if (rep1_ && DBL_ATT1 != 1 && DBL_ATT1 != 4) { }
#else
                    if (v < 16) { compress_unit(F, l, (v & 1) | (sub << 1) | (b << 2) | ((v >> 1) << 4)); }
                    else if (v < 16 + 256) { select_unit(F, b, 2 * (255 - (v - 16)) + sub); }
#endif
                    else { simple_unit<0>(F, l, b, sub, 63 - (v - 272), rep1_ ? (bf16*)(ws + WS_MB + 8 * MiB) : nullptr); }
                }
            }
        }
        GRID_BARRIER();
        STAMP(4 + 8 * l);
#ifdef DBL_ATT2
        for (int rep_ = 0; rep_ < 2; ++rep_)
#else
        const int rep_ = 0;
#endif
        {
            MKFRAME();
            bf16* od = rep_ ? (bf16*)(ws + WS_MB) : nullptr;
            const int xcd = (int)(xb_xcc_id() & 7u);
#pragma unroll 1
            for (int qi = 0; qi < 8; ++qi) {
                const int x = (xcd + qi) & 7, b = x >> 1, kvh = x & 1;
                gu32* ctr = F.ctl + CW_Q + 64 * ((2 * l + 1 + 4 * rep_) * 8 + x);
                for (;;) { const int v = next_unit(F, ctr); if (v >= 128) break;
                    const int i = 63 - (v >> 1);
#ifdef DBL_ATT2
                    if ((v & 1) && (rep_ == 0 || DBL_ATT2 != 3)) simple_unit<1>(F, l, b, kvh, i, od);
                    if (!(v & 1) && (rep_ == 0 || DBL_ATT2 != 2)) nsa_unit(F, l, b, kvh, i, od);
#else
                    if (v & 1) simple_unit<1>(F, l, b, kvh, i, od); else nsa_unit(F, l, b, kvh, i, od);
#endif
                }
            }
        }
        GRID_BARRIER();
        STAMP(5 + 8 * l);
#ifndef NO_G2
#ifdef DBL_G2
        for (int rep_ = 0; rep_ < 2; ++rep_)
#endif
        {   MKFRAME(); unsigned char* wl = WL(l);
            pg8::StaticOrder S; S.init(M, DM, F.G, bid); pg8::Unit u0; S.next(0, u0);
            pg8::ProgG2 P{u0.pm, u0.pn, ZQ, (const bf16*)(wl + W_BR), XB, (const bf16*)(wl + W_G), YS, MB, SSQ};
            pg8::gemm_chain<pg8::ProgG2>(F.lds, P); }
#endif
        GRID_BARRIER();
        STAMP(6 + 8 * l);
#ifndef NO_G3
        {
            MKFRAME(); unsigned char* wl = WL(l);
            pg8::Gemm g{MB, (const bf16*)(wl + W_OUT), M, DM, DM}; pg8::StaticOrder S; S.init(M, DM, F.G, bid);
            pg8::EpiRes E{l == 0 ? F.a->in[0] : (const float*)F.a->out, F.a->out, XB, SSQ};
            pg8::gemm_phase<pg8::EpiRes, pg8::StaticOrder, false, true>(F.lds, g, S, E);
        }
#ifdef DBL_G3
        {   MKFRAME(); unsigned char* wl = WL(l);
            pg8::Gemm g{MB, (const bf16*)(wl + W_OUT), M, DM, DM}; pg8::StaticOrder S; S.init(M, DM, F.G, bid);
            pg8::EpiRes E{F.a->in[0], (float*)(ws + 0), (bf16*)(ws + 64 * MiB), (float*)(ws + 96 * MiB)};
            pg8::gemm_phase<pg8::EpiRes, pg8::StaticOrder, false, true>(F.lds, g, S, E);
        }
#endif
#endif
        GRID_BARRIER();
        STAMP(7 + 8 * l);
#ifndef NO_G4
#ifdef DBL_G4
        for (int rep_ = 0; rep_ < 2; ++rep_)
#endif
        {
            MKFRAME(); unsigned char* wl = WL(l);
            pg8::Gemm g{XB, (const bf16*)(wl + W_UP), M, DFF, DM}; pg8::StaticOrder S; S.init(M, DFF, F.G, bid);
            pg8::EpiG4 E{HM, SSQ};
            pg8::gemm_phase<pg8::EpiG4, pg8::StaticOrder, true, true>(F.lds, g, S, E);
        }
#endif
        GRID_BARRIER();
        STAMP(8 + 8 * l);
#ifndef NO_G5
        {
            MKFRAME(); unsigned char* wl = WL(l);
            pg8::Gemm g{HM, (const bf16*)(wl + W_DN), M, DM, DFF}; pg8::StaticOrder S; S.init(M, DM, F.G, bid);
            pg8::EpiRes E{(const float*)F.a->out, F.a->out, XB, SSQ};
            pg8::gemm_phase<pg8::EpiRes, pg8::StaticOrder, false, true>(F.lds, g, S, E);
        }
#ifdef DBL_G5
        {   MKFRAME(); unsigned char* wl = WL(l);
            pg8::Gemm g{HM, (const bf16*)(wl + W_DN), M, DM, DFF}; pg8::StaticOrder S; S.init(M, DM, F.G, bid);
            pg8::EpiNull E{};
            pg8::gemm_phase<pg8::EpiNull, pg8::StaticOrder, false, true>(F.lds, g, S, E);
        }
#endif
#endif
#ifdef PROBE_T
        GRID_BARRIER();
        STAMP(9 + 8 * l);
#else
        if (l + 1 < DEPTH) GRID_BARRIER();
#endif
#ifdef DBL_BAR
        for (int rep_ = 0; rep_ < 16; ++rep_) GRID_BARRIER();
#endif
    }
#ifdef PROBE_T
    {
        GRID_BARRIER();
        const unsigned long long* st = (const unsigned long long*)(args.ws + WS_CTL + 96 * 1024);
        float tus;
        if (PROBE_T == 0) tus = (float)(st[1] - st[0]) * 0.01f;
        else tus = 0.5f * ((float)(st[PROBE_T + 1] - st[PROBE_T]) + (float)(st[PROBE_T + 9] - st[PROBE_T + 8])) * 0.01f;
        const float sc = 1.0f + tus * 0.001f;
        float* o = args.out;
        for (size_t i = (size_t)blockIdx.x * 512 + threadIdx.x; i < (size_t)M * DM; i += (size_t)gridDim.x * 512) o[i] *= sc;
    }
#endif
}

extern "C" void kernel_launch(void* const* d_in, const int* in_sizes, int n_in, void* d_out, int out_size, void* d_ws, size_t ws_size, hipStream_t stream) {
    static int grid = 0;
    if (grid == 0) {
        if (n_in != 17 || out_size != M * DM || ws_size < WS_END) { fprintf(stderr, "kernel_launch: unexpected problem shape (n_in %d out %d ws %zu)\n", n_in, out_size, ws_size); grid = -1; return; }
        int dev = 0, cus = 0, per_cu = 0;
        if (hipGetDevice(&dev) != hipSuccess || hipDeviceGetAttribute(&cus, hipDeviceAttributeMultiprocessorCount, dev) != hipSuccess) { grid = -1; return; }
        if (hipFuncSetAttribute((const void*)mk_fwd, hipFuncAttributeMaxDynamicSharedMemorySize, LDS_BYTES) != hipSuccess) { fprintf(stderr, "kernel_launch: hipFuncSetAttribute failed\n"); grid = -1; return; }
        if (hipOccupancyMaxActiveBlocksPerMultiprocessor(&per_cu, (const void*)mk_fwd, NWAVES * 64, LDS_BYTES) != hipSuccess || per_cu < 1) { fprintf(stderr, "kernel_launch: occupancy query says %d blocks/CU\n", per_cu); }
        (void)hipGetLastError();
        if (cus != 256) { fprintf(stderr, "kernel_launch: built for a 256-CU device (one 256x256 GEMM unit per workgroup in the N=1024 phases), found %d CUs\n", cus); grid = -1; return; }
        grid = cus;
    }
    if (grid < 0) return;
    (void)hipMemsetAsync((char*)d_ws + WS_CTL, 0, CTL_BYTES, stream);
    Args a{};
    for (int i = 0; i < 17; ++i) a.in[i] = (const float*)d_in[i];
    a.out = (float*)d_out; a.ws = (unsigned char*)d_ws;
    hipLaunchKernelGGL(mk_fwd, dim3(grid), dim3(NWAVES * 64), LDS_BYTES, stream, a);
}
```

```cpp
#include <hip/hip_runtime.h>
#include <cstdio>
#include <cstdint>

namespace pg8 {
#define PG8_LAS __attribute__((address_space(3)))
typedef unsigned short bf16_t;
typedef short bf16x8 __attribute__((ext_vector_type(8)));
typedef float f32x4 __attribute__((ext_vector_type(4)));
typedef unsigned u32x4 __attribute__((ext_vector_type(4)));
constexpr int BM = 256, BK = 64, HALF = 128, HTB = HALF * BK * 2  , STAGE_BYTES = 8 * HTB, NXCD = 8, WGM = 8;

__host__ __device__ __forceinline__ int lds_byte(int r, int c) { const int st = (r >> 4) * 2 + (c >> 5), rr = r & 15, cc = c & 31, ob = rr * 64 + cc * 2; return st * 1024 + (ob ^ (((ob >> 9) & 1) << 5)); }
__host__ __device__ __forceinline__ void stage_rc(int b, int& R, int& C) { const int st = b / 1024, sb = b % 1024, swz = sb ^ (((sb >> 9) & 1) << 5); R = (st >> 1) * 16 + swz / 64; C = (st & 1) * 32 + (swz % 64) / 2; }
__host__ __device__ __forceinline__ int perm32(int rho) { const int n = rho >> 4, i = rho & 15; return 8 * (i >> 2) + 4 * n + (i & 3); }

struct Unit { int pm, pn; };
struct Gemm { const bf16_t* A; const bf16_t* Bt; int M, N, K; };

struct StaticOrder {
    int nM, nN, nwg, G, c;
    __host__ __device__ void init(int M, int N, int G_, int c_) { nM = M / BM; nN = N / BM; nwg = nM * nN; G = G_; c = c_; }
    __host__ __device__ bool next(int i, Unit& u) const {
        const long L = (long)i * G + c; if (L >= nwg) return false;
        int wgid = (int)L; { const int q = nwg / NXCD, r = nwg % NXCD, xcd = wgid % NXCD, off = wgid / NXCD; wgid = (xcd < r ? xcd * (q + 1) : r * (q + 1) + (xcd - r) * q) + off; }
        const int nig = WGM * nN, gid = wgid / nig, fm = gid * WGM, gsz = (nM - fm) < WGM ? (nM - fm) : WGM;
        u.pm = fm + ((wgid % nig) % gsz); u.pn = (wgid % nig) / gsz; return true;
    }
    __device__ __forceinline__ void a_ready(const Unit&) const {}
    __device__ __forceinline__ void done(const Unit&) const {}
};

__device__ __forceinline__ unsigned cvt_pk_bf16(float lo, float hi) { unsigned r; asm volatile("v_cvt_pk_bf16_f32 %0, %1, %2" : "=v"(r) : "v"(lo), "v"(hi)); return r; }
template <class Epi, class Sched, bool ALIGN_EPI = false, bool SP2 = false>
__device__ __forceinline__ void gemm_phase(PG8_LAS unsigned char* lds, const Gemm g, const Sched& S, const Epi& E) {
    int tid_l = threadIdx.x; asm volatile("" : "+v"(tid_l));
    const int tid = tid_l, wid = __builtin_amdgcn_readfirstlane(tid >> 6), lane = tid & 63, wr = wid >> 2, wc = wid & 3, fr = lane & 15, fq = lane >> 4;
    const int K = g.K, nt = K / BK;
    unsigned voffA[2], voffB[2];
#pragma unroll
    for (int i = 0; i < 2; ++i) { int R, C; stage_rc(tid * 16 + i * 8192, R, C); const int Rb = Epi::PERM ? ((R & ~31) + perm32(R & 31)) : R;
        voffA[i] = (unsigned)(R * K + C) * 2u; voffB[i] = (unsigned)(Rb * K + C) * 2u; }
    const size_t kstep = (size_t)(BK * 2);
    const size_t hstep = (size_t)HALF * K * 2;
    const size_t tstep = 2 * hstep;
    const unsigned ldsw = (unsigned)wid * 1024u;
    const int aoff = lds_byte(wr * 64 + fr, fq * 8), boff = lds_byte(wc * 32 + fr, fq * 8);
#define PG8_SA(b, h) (((b) * 2 + (h)) * HTB)
#define PG8_SB(b, h) ((4 + (b) * 2 + (h)) * HTB)
#define PG8_STAGE(bufoff, gbase, voff) do { _Pragma("unroll") for (int _i = 0; _i < 2; ++_i) \
        __builtin_amdgcn_global_load_lds((const unsigned*)((const char*)(gbase) + (voff)[_i]), (PG8_LAS unsigned*)(lds + (bufoff) + ldsw + _i * 8192), 16, 0, 0); } while (0)
#define PG8_LDA(dst, b, h) do { _Pragma("unroll") for (int m = 0; m < 4; ++m) _Pragma("unroll") for (int k = 0; k < 2; ++k) dst[m][k] = *(const PG8_LAS bf16x8*)(lds + PG8_SA(b, h) + aoff + m * 2048 + k * 1024); } while (0)
#define PG8_LDB(dst, b, h) do { _Pragma("unroll") for (int n = 0; n < 2; ++n) _Pragma("unroll") for (int k = 0; k < 2; ++k) dst[n][k] = *(const PG8_LAS bf16x8*)(lds + PG8_SB(b, h) + boff + n * 2048 + k * 1024); } while (0)
#define PG8_MMA(ai, bj, At, Bt) do { __builtin_amdgcn_s_setprio(1); _Pragma("unroll") for (int m = 0; m < 4; ++m) _Pragma("unroll") for (int n = 0; n < 2; ++n) _Pragma("unroll") for (int k = 0; k < 2; ++k) \
        acc[ai][bj][m][n] = __builtin_amdgcn_mfma_f32_16x16x32_bf16(Bt[n][k], At[m][k], acc[ai][bj][m][n], 0, 0, 0); __builtin_amdgcn_s_setprio(0); } while (0)
#define PG8_WAIT_V(n) asm volatile("s_waitcnt vmcnt(" #n ")" ::: "memory")
#define PG8_WAIT_L(n) asm volatile("s_waitcnt lgkmcnt(" #n ")" ::: "memory")
#define PG8_BAR __builtin_amdgcn_s_barrier()
#define PG8_SCHED __builtin_amdgcn_sched_barrier(0)
    Unit cur, nxt; int ui = 0;
    if (!S.next(0, cur)) return;
    f32x4 acc[2][2][4][2];
#pragma unroll
    for (int a = 0; a < 2; ++a)
#pragma unroll
        for (int b = 0; b < 2; ++b)
#pragma unroll
            for (int m = 0; m < 4; ++m)
#pragma unroll
                for (int n = 0; n < 2; ++n) acc[a][b][m][n] = (f32x4){0.f, 0.f, 0.f, 0.f};
    bf16x8 At[4][2], B0[2][2], B1[2][2];
    const char* cA = (const char*)g.A + (size_t)cur.pm * tstep; const char* cB = (const char*)g.Bt + (size_t)cur.pn * tstep;
    S.a_ready(cur);
    if constexpr (SP2) {
        PG8_STAGE(PG8_SB(0, 0), cB, voffB); PG8_STAGE(PG8_SB(0, 1), cB + hstep, voffB); PG8_STAGE(PG8_SA(0, 0), cA, voffA); PG8_STAGE(PG8_SA(0, 1), cA + hstep, voffA);
        if (wr == 1) PG8_BAR;
        PG8_WAIT_V(2); PG8_BAR;
        PG8_STAGE(PG8_SB(1, 0), cB + kstep, voffB); PG8_STAGE(PG8_SA(1, 0), cA + kstep, voffA); PG8_STAGE(PG8_SB(1, 1), cB + hstep + kstep, voffB);
        PG8_WAIT_V(6); PG8_BAR;
    } else {
        PG8_STAGE(PG8_SB(0, 0), cB, voffB); PG8_STAGE(PG8_SA(0, 0), cA, voffA); PG8_STAGE(PG8_SB(0, 1), cB + hstep, voffB); PG8_STAGE(PG8_SA(0, 1), cA + hstep, voffA);
        if (wr == 1) PG8_BAR;
        PG8_WAIT_V(4); PG8_BAR;
        PG8_STAGE(PG8_SB(1, 0), cB + kstep, voffB); PG8_STAGE(PG8_SA(1, 0), cA + kstep, voffA); PG8_STAGE(PG8_SB(1, 1), cB + hstep + kstep, voffB);
        PG8_WAIT_V(6); PG8_BAR;
    }
    for (;;) {
        const bool has_next = S.next(ui + 1, nxt);
        const char* nA = has_next ? (const char*)g.A + (size_t)nxt.pm * tstep : cA; const char* nB = has_next ? (const char*)g.Bt + (size_t)nxt.pn * tstep : cB;
        for (int t = 0; t < nt; t += 2) {
            const bool last = (t == nt - 2);
            const char* a1 = cA + (size_t)(t + 1) * kstep;
            const char* a2 = last ? nA : cA + (size_t)(t + 2) * kstep; const char* b2 = last ? nB : cB + (size_t)(t + 2) * kstep;
            const char* a3 = a2 + kstep; const char* b3 = b2 + kstep;
            if (last && has_next) S.a_ready(nxt);
            if constexpr (SP2) {
            PG8_LDB(B0, 0, 0); PG8_LDB(B1, 0, 1); PG8_SCHED; PG8_LDA(At, 0, 0); PG8_STAGE(PG8_SA(1, 1), a1 + hstep, voffA);
            PG8_WAIT_V(8); PG8_WAIT_L(0); PG8_BAR; PG8_MMA(0, 0, At, B0); PG8_MMA(0, 1, At, B1); PG8_BAR; PG8_SCHED;
            PG8_LDA(At, 0, 1); PG8_STAGE(PG8_SB(0, 0), b2, voffB); PG8_STAGE(PG8_SB(0, 1), b2 + hstep, voffB); PG8_STAGE(PG8_SA(0, 0), a2, voffA);
            PG8_WAIT_V(8); PG8_WAIT_L(0); PG8_BAR; PG8_MMA(1, 0, At, B0); PG8_MMA(1, 1, At, B1); PG8_BAR; PG8_SCHED;
            PG8_LDB(B0, 1, 0); PG8_LDB(B1, 1, 1); PG8_SCHED; PG8_LDA(At, 1, 0); PG8_STAGE(PG8_SA(0, 1), a2 + hstep, voffA);
            PG8_WAIT_V(8); PG8_WAIT_L(0); PG8_BAR; PG8_MMA(0, 0, At, B0); PG8_MMA(0, 1, At, B1); PG8_BAR; PG8_SCHED;
            PG8_LDA(At, 1, 1); PG8_STAGE(PG8_SB(1, 0), b3, voffB); PG8_STAGE(PG8_SB(1, 1), b3 + hstep, voffB); PG8_STAGE(PG8_SA(1, 0), a3, voffA);
            PG8_WAIT_V(8); PG8_WAIT_L(0); PG8_BAR; PG8_MMA(1, 0, At, B0); PG8_MMA(1, 1, At, B1); PG8_BAR; PG8_SCHED;
            } else {
            PG8_LDB(B0, 0, 0); PG8_SCHED; PG8_LDA(At, 0, 0); PG8_STAGE(PG8_SA(1, 1), a1 + hstep, voffA);
            PG8_WAIT_L(8); PG8_BAR; PG8_WAIT_L(0); PG8_MMA(0, 0, At, B0); PG8_BAR; PG8_SCHED;
            PG8_LDB(B1, 0, 1); PG8_STAGE(PG8_SB(0, 0), b2, voffB);
            PG8_BAR; PG8_WAIT_L(0); PG8_MMA(0, 1, At, B1); PG8_BAR;
            PG8_LDA(At, 0, 1); PG8_STAGE(PG8_SA(0, 0), a2, voffA);
            PG8_BAR; PG8_WAIT_L(0); PG8_MMA(1, 0, At, B0); PG8_BAR; PG8_SCHED;
            PG8_STAGE(PG8_SB(0, 1), b2 + hstep, voffB);
            PG8_WAIT_V(6); PG8_BAR; PG8_MMA(1, 1, At, B1); PG8_BAR;
            PG8_LDB(B0, 1, 0); PG8_SCHED; PG8_LDA(At, 1, 0); PG8_STAGE(PG8_SA(0, 1), a2 + hstep, voffA);
            PG8_WAIT_L(8); PG8_BAR; PG8_WAIT_L(0); PG8_MMA(0, 0, At, B0); PG8_BAR; PG8_SCHED;
            PG8_LDB(B1, 1, 1); PG8_STAGE(PG8_SB(1, 0), b3, voffB);
            PG8_BAR; PG8_WAIT_L(0); PG8_MMA(0, 1, At, B1); PG8_BAR;
            PG8_LDA(At, 1, 1); PG8_STAGE(PG8_SA(1, 0), a3, voffA);
            PG8_BAR; PG8_WAIT_L(0); PG8_MMA(1, 0, At, B0); PG8_BAR; PG8_SCHED;
            PG8_STAGE(PG8_SB(1, 1), b3 + hstep, voffB);
            PG8_WAIT_V(6); PG8_BAR; PG8_MMA(1, 1, At, B1); PG8_BAR;
            }
        }
        if constexpr (ALIGN_EPI) { if (wr == 0) PG8_BAR; }
        if constexpr (!Epi::AFTER_DRAIN) { E(acc, cur, wr, wc, fr, fq); S.done(cur); }
        if (!has_next) break;
#pragma unroll
        for (int a = 0; a < 2; ++a)
#pragma unroll
            for (int b = 0; b < 2; ++b)
#pragma unroll
                for (int m = 0; m < 4; ++m)
#pragma unroll
                    for (int n = 0; n < 2; ++n) acc[a][b][m][n] = (f32x4){0.f, 0.f, 0.f, 0.f};
        cur = nxt; cA = nA; cB = nB; ++ui;
        if constexpr (ALIGN_EPI) { if (wr == 1) PG8_BAR; }
    }
    PG8_WAIT_V(0);
    if constexpr (!ALIGN_EPI) { if (wr == 0) PG8_BAR; }
    PG8_BAR;
    if constexpr (Epi::AFTER_DRAIN) { E.fused(acc, cur, wr, wc, fr, fq, lds, wid, lane); S.done(cur); }
#undef PG8_SA
#undef PG8_SB
#undef PG8_STAGE
#undef PG8_LDA
#undef PG8_LDB
#undef PG8_MMA
#undef PG8_WAIT_V
#undef PG8_WAIT_L
#undef PG8_BAR
#undef PG8_SCHED
}
}

namespace pg8 {
#define PG8_GAS __attribute__((address_space(1)))
constexpr int MROWS = 16384;
__device__ __forceinline__ unsigned pk_bf16(float lo, float hi) { typedef float f2 __attribute__((ext_vector_type(2))); typedef __bf16 b2 __attribute__((ext_vector_type(2)));
    f2 v = {lo, hi}; b2 b = __builtin_convertvector(v, b2); return __builtin_bit_cast(unsigned, b); }
__device__ __forceinline__ float bf_lo(unsigned w) { return __uint_as_float(w << 16); }
__device__ __forceinline__ float bf_hi(unsigned w) { return __uint_as_float(w & 0xffff0000u); }
__device__ __forceinline__ float row_rstd(const float* ssq, int row) {
    const PG8_GAS f32x4* p = (const PG8_GAS f32x4*)(ssq + (size_t)row * 16);
    const f32x4 a = p[0], b = p[1], c = p[2], d = p[3];
    const float s = (((a[0] + a[1]) + (a[2] + a[3])) + ((b[0] + b[1]) + (b[2] + b[3]))) + (((c[0] + c[1]) + (c[2] + c[3])) + ((d[0] + d[1]) + (d[2] + d[3])));
    return rsqrtf(s * (1.0f / 1024.0f) + 1e-6f);
}
__device__ __forceinline__ float sigmoidf_(float x) { return __builtin_amdgcn_rcpf(1.0f + __builtin_amdgcn_exp2f(-1.4426950408889634f * x)); }

__device__ __forceinline__ void wave_rstd(const float* ssq, int rowbase, int lane, float (&v)[2]) {
    const PG8_GAS f32x4* p0 = (const PG8_GAS f32x4*)(ssq + (size_t)(rowbase + lane) * 16);
    const PG8_GAS f32x4* p1 = p0 + HALF * 4;
    const f32x4 a = p0[0], b = p0[1], c = p0[2], d = p0[3], e = p1[0], f = p1[1], g = p1[2], h = p1[3];
    const float s0 = (((a[0] + a[1]) + (a[2] + a[3])) + ((b[0] + b[1]) + (b[2] + b[3]))) + (((c[0] + c[1]) + (c[2] + c[3])) + ((d[0] + d[1]) + (d[2] + d[3])));
    const float s1 = (((e[0] + e[1]) + (e[2] + e[3])) + ((f[0] + f[1]) + (f[2] + f[3]))) + (((g[0] + g[1]) + (g[2] + g[3])) + ((h[0] + h[1]) + (h[2] + h[3])));
    v[0] = rsqrtf(s0 * (1.0f / 1024.0f) + 1e-6f); v[1] = rsqrtf(s1 * (1.0f / 1024.0f) + 1e-6f);
}

struct EpiG1 {
    static constexpr bool PERM = true, AFTER_DRAIN = false;
    bf16_t* zq; bf16_t* zkv; const float* ssq;
    __device__ __forceinline__ void operator()(const f32x4 (&acc)[2][2][4][2], const Unit& u, int wr, int wc, int fr, int fq) const {
        const int row0 = u.pm * BM + wr * 64 + fr;
        bf16_t* base; int ldc, colt;
        if (u.pn < 6) { base = zq + (size_t)(u.pn >> 1) * ((size_t)MROWS * 512); ldc = 512; colt = (u.pn & 1) * 256; }
        else { base = zkv + (size_t)(u.pn - 6) * ((size_t)MROWS * 256); ldc = 256; colt = 0; }
        const int col0 = colt + wc * 32 + 8 * fq;
        float rv[2]; wave_rstd(ssq, u.pm * BM + wr * 64, fq * 16 + fr, rv);
#pragma unroll
        for (int ai = 0; ai < 2; ++ai)
#pragma unroll
            for (int m = 0; m < 4; ++m) { const int row = row0 + ai * HALF + m * 16; const float rs = __shfl(rv[ai], m * 16 + fr); bf16_t* rowp = base + (size_t)row * ldc + col0;
#pragma unroll
                for (int bj = 0; bj < 2; ++bj) { const f32x4 v0 = acc[ai][bj][m][0] * rs, v1 = acc[ai][bj][m][1] * rs;
                    u32x4 w; w.x = pk_bf16(v0[0], v0[1]); w.y = pk_bf16(v0[2], v0[3]); w.z = pk_bf16(v1[0], v1[1]); w.w = pk_bf16(v1[2], v1[3]);
                    *(PG8_GAS u32x4*)(rowp + bj * HALF) = w; } }
    }
};
struct EpiG4 {
    static constexpr bool PERM = true, AFTER_DRAIN = false;
    bf16_t* h; const float* ssq;
    __device__ __forceinline__ void operator()(const f32x4 (&acc)[2][2][4][2], const Unit& u, int wr, int wc, int fr, int fq) const {
        const int row0 = u.pm * BM + wr * 64 + fr; const int col0 = u.pn * BM + wc * 32 + 8 * fq;
        float rv[2]; wave_rstd(ssq, u.pm * BM + wr * 64, fq * 16 + fr, rv);
#pragma unroll
        for (int ai = 0; ai < 2; ++ai)
#pragma unroll
            for (int m = 0; m < 4; ++m) { const int row = row0 + ai * HALF + m * 16; const float rs = __shfl(rv[ai], m * 16 + fr); bf16_t* rowp = h + (size_t)row * 4096 + col0;
#pragma unroll
                for (int bj = 0; bj < 2; ++bj) { f32x4 v0 = acc[ai][bj][m][0] * rs, v1 = acc[ai][bj][m][1] * rs;
#pragma unroll
                    for (int e = 0; e < 4; ++e) { v0[e] = fmaxf(v0[e], 0.f); v0[e] *= v0[e]; v1[e] = fmaxf(v1[e], 0.f); v1[e] *= v1[e]; }
                    u32x4 w; w.x = pk_bf16(v0[0], v0[1]); w.y = pk_bf16(v0[2], v0[3]); w.z = pk_bf16(v1[0], v1[1]); w.w = pk_bf16(v1[2], v1[3]);
                    *(PG8_GAS u32x4*)(rowp + bj * HALF) = w; } }
    }
};
struct EpiRes {
    static constexpr bool PERM = true, AFTER_DRAIN = false;
    const float* xold; float* xout; bf16_t* xb; float* ssq;
    __device__ __forceinline__ void operator()(const f32x4 (&acc)[2][2][4][2], const Unit& u, int wr, int wc, int fr, int fq) const {
        const int row0 = u.pm * BM + wr * 64 + fr; const int col0 = u.pn * BM + wc * 32 + 8 * fq;
#pragma unroll
        for (int ai = 0; ai < 2; ++ai) {
            f32x4 xo[4][2][2];
#pragma unroll
            for (int m = 0; m < 4; ++m)
#pragma unroll
                for (int bj = 0; bj < 2; ++bj) { const size_t off = (size_t)(row0 + ai * HALF + m * 16) * 1024 + col0 + bj * HALF;
                    xo[m][bj][0] = *(const PG8_GAS f32x4*)(xold + off); xo[m][bj][1] = *(const PG8_GAS f32x4*)(xold + off + 4); }
#pragma unroll
            for (int m = 0; m < 4; ++m) { const int row = row0 + ai * HALF + m * 16; float part = 0.f;
#pragma unroll
                for (int bj = 0; bj < 2; ++bj) { const size_t off = (size_t)row * 1024 + col0 + bj * HALF;
                    const f32x4 v0 = acc[ai][bj][m][0] + xo[m][bj][0], v1 = acc[ai][bj][m][1] + xo[m][bj][1];
                    *(PG8_GAS f32x4*)(xout + off) = v0; *(PG8_GAS f32x4*)(xout + off + 4) = v1;
                    u32x4 w; w.x = pk_bf16(v0[0], v0[1]); w.y = pk_bf16(v0[2], v0[3]); w.z = pk_bf16(v1[0], v1[1]); w.w = pk_bf16(v1[2], v1[3]);
                    *(PG8_GAS u32x4*)(xb + off) = w;
                    part += ((v0[0] * v0[0] + v0[1] * v0[1]) + (v0[2] * v0[2] + v0[3] * v0[3])) + ((v1[0] * v1[0] + v1[1] * v1[1]) + (v1[2] * v1[2] + v1[3] * v1[3])); }
                part += __shfl_xor(part, 16); part += __shfl_xor(part, 32);
                if (fq == 0) ((PG8_GAS float*)ssq)[(size_t)row * 16 + u.pn * 4 + wc] = part; }
            asm volatile("" ::: "memory"); }
    }
};
struct EpiStash {
    static constexpr bool PERM = true, AFTER_DRAIN = true;
    __device__ __forceinline__ void fused(f32x4 (&acc)[2][2][4][2], const Unit& u, int wr, int wc, int fr, int fq, PG8_LAS unsigned char*, int, int) const { (*this)(acc, u, wr, wc, fr, fq); }
    bf16_t* ys;
    __device__ __forceinline__ void operator()(const f32x4 (&acc)[2][2][4][2], const Unit& u, int wr, int wc, int fr, int fq) const {
        bf16_t* base = ys + (size_t)(u.pm * 4 + u.pn) * 65536; const int row0 = wr * 64 + fr, col0 = wc * 32 + 8 * fq;
#pragma unroll
        for (int ai = 0; ai < 2; ++ai)
#pragma unroll
            for (int m = 0; m < 4; ++m) { bf16_t* rowp = base + (row0 + ai * HALF + m * 16) * 256 + col0;
#pragma unroll
                for (int bj = 0; bj < 2; ++bj) { const f32x4 v0 = acc[ai][bj][m][0], v1 = acc[ai][bj][m][1];
                    u32x4 w; w.x = pk_bf16(v0[0], v0[1]); w.y = pk_bf16(v0[2], v0[3]); w.z = pk_bf16(v1[0], v1[1]); w.w = pk_bf16(v1[2], v1[3]);
                    *(PG8_GAS u32x4*)(rowp + bj * HALF) = w; } }
    }
};
struct EpiGate {
    static constexpr bool PERM = true, AFTER_DRAIN = true;
    __device__ __forceinline__ void fused(f32x4 (&acc)[2][2][4][2], const Unit& u, int wr, int wc, int fr, int fq, PG8_LAS unsigned char*, int, int) const { (*this)(acc, u, wr, wc, fr, fq); }
    const bf16_t* ys; bf16_t* mb; const float* ssq; int first;
    __device__ __forceinline__ void operator()(const f32x4 (&acc)[2][2][4][2], const Unit& u, int wr, int wc, int fr, int fq) const {
        const bf16_t* sbase = ys + (size_t)(u.pm * 4 + u.pn) * 65536; const int lrow0 = wr * 64 + fr, lcol0 = wc * 32 + 8 * fq;
        float rv[2]; wave_rstd(ssq, u.pm * BM + wr * 64, fq * 16 + fr, rv);
        const bool fst = first != 0;
#pragma unroll
        for (int ai = 0; ai < 2; ++ai)
#pragma unroll
        for (int mh = 0; mh < 2; ++mh) {
            u32x4 yv[2][2], pv[2][2];
#pragma unroll
            for (int m2 = 0; m2 < 2; ++m2)
#pragma unroll
                for (int bj = 0; bj < 2; ++bj) { const int lrow = lrow0 + ai * HALF + (mh * 2 + m2) * 16;
                    yv[m2][bj] = *(const PG8_GAS u32x4*)(sbase + lrow * 256 + lcol0 + bj * HALF);
                    pv[m2][bj] = *(const PG8_GAS u32x4*)(mb + (size_t)(u.pm * BM + lrow) * 1024 + u.pn * BM + lcol0 + bj * HALF); }
#pragma unroll
            for (int m2 = 0; m2 < 2; ++m2) { const int m = mh * 2 + m2; const int lrow = lrow0 + ai * HALF + m * 16, row = u.pm * BM + lrow; const float rs = __shfl(rv[ai], m * 16 + fr);
#pragma unroll
                for (int bj = 0; bj < 2; ++bj) { const f32x4 a0 = acc[ai][bj][m][0] * rs, a1 = acc[ai][bj][m][1] * rs;
                    const u32x4 y = yv[m2][bj], p = pv[m2][bj];
                    bf16_t* mp = mb + (size_t)row * 1024 + u.pn * BM + lcol0 + bj * HALF;
                    float r[8], q[8];
                    r[0] = sigmoidf_(a0[0]) * bf_lo(y.x); r[1] = sigmoidf_(a0[1]) * bf_hi(y.x); r[2] = sigmoidf_(a0[2]) * bf_lo(y.y); r[3] = sigmoidf_(a0[3]) * bf_hi(y.y);
                    r[4] = sigmoidf_(a1[0]) * bf_lo(y.z); r[5] = sigmoidf_(a1[1]) * bf_hi(y.z); r[6] = sigmoidf_(a1[2]) * bf_lo(y.w); r[7] = sigmoidf_(a1[3]) * bf_hi(y.w);
                    q[0] = bf_lo(p.x); q[1] = bf_hi(p.x); q[2] = bf_lo(p.y); q[3] = bf_hi(p.y); q[4] = bf_lo(p.z); q[5] = bf_hi(p.z); q[6] = bf_lo(p.w); q[7] = bf_hi(p.w);
#pragma unroll
                    for (int e = 0; e < 8; ++e) r[e] = fst ? r[e] : r[e] + q[e];
                    u32x4 w; w.x = pk_bf16(r[0], r[1]); w.y = pk_bf16(r[2], r[3]); w.z = pk_bf16(r[4], r[5]); w.w = pk_bf16(r[6], r[7]);
                    *(PG8_GAS u32x4*)mp = w; } }
            asm volatile("" ::: "memory"); }
    }
};
struct EpiNull {
    static constexpr bool PERM = true, AFTER_DRAIN = false;
    __device__ __forceinline__ void operator()(const f32x4 (&acc)[2][2][4][2], const Unit& u, int wr, int wc, int fr, int fq) const {
#pragma unroll
        for (int ai = 0; ai < 2; ++ai)
#pragma unroll
            for (int bj = 0; bj < 2; ++bj)
#pragma unroll
                for (int m = 0; m < 4; ++m) { asm volatile("" :: "v"(acc[ai][bj][m][0]), "v"(acc[ai][bj][m][1])); }
    }
};
}

namespace pg8 {
struct UnitX { int pm, pn; const char* A; const char* Bt; int K; int nk; int kind; };
template <class Prog, bool ALIGN_EPI = false>
__device__ __forceinline__ void gemm_chain(PG8_LAS unsigned char* lds, const Prog& P) {
    int tid_l = threadIdx.x; asm volatile("" : "+v"(tid_l));
    const int tid = tid_l, wid = __builtin_amdgcn_readfirstlane(tid >> 6), lane = tid & 63, wr = wid >> 2, wc = wid & 3, fr = lane & 15, fq = lane >> 4;
    int RA[2], RB[2], C2[2];
#pragma unroll
    for (int i = 0; i < 2; ++i) { int R, C; stage_rc(tid * 16 + i * 8192, R, C); RA[i] = R * 2; RB[i] = ((R & ~31) + perm32(R & 31)) * 2; C2[i] = C * 2; }
    const size_t kstep = (size_t)(BK * 2);
    const unsigned ldsw = (unsigned)wid * 1024u;
    const int aoff = lds_byte(wr * 64 + fr, fq * 8), boff = lds_byte(wc * 32 + fr, fq * 8);
#define PG8_SA(b, h) (((b) * 2 + (h)) * HTB)
#define PG8_SB(b, h) ((4 + (b) * 2 + (h)) * HTB)
#define PG8_STAGE(bufoff, gbase, voff) do { _Pragma("unroll") for (int _i = 0; _i < 2; ++_i) \
        __builtin_amdgcn_global_load_lds((const unsigned*)((const char*)(gbase) + (voff)[_i]), (PG8_LAS unsigned*)(lds + (bufoff) + ldsw + _i * 8192), 16, 0, 0); } while (0)
#define PG8_LDA(dst, b, h) do { _Pragma("unroll") for (int m = 0; m < 4; ++m) _Pragma("unroll") for (int k = 0; k < 2; ++k) dst[m][k] = *(const PG8_LAS bf16x8*)(lds + PG8_SA(b, h) + aoff + m * 2048 + k * 1024); } while (0)
#define PG8_LDB(dst, b, h) do { _Pragma("unroll") for (int n = 0; n < 2; ++n) _Pragma("unroll") for (int k = 0; k < 2; ++k) dst[n][k] = *(const PG8_LAS bf16x8*)(lds + PG8_SB(b, h) + boff + n * 2048 + k * 1024); } while (0)
#define PG8_MMA(ai, bj, At, Bt) do { __builtin_amdgcn_s_setprio(1); _Pragma("unroll") for (int m = 0; m < 4; ++m) _Pragma("unroll") for (int n = 0; n < 2; ++n) _Pragma("unroll") for (int k = 0; k < 2; ++k) \
        acc[ai][bj][m][n] = __builtin_amdgcn_mfma_f32_16x16x32_bf16(Bt[n][k], At[m][k], acc[ai][bj][m][n], 0, 0, 0); __builtin_amdgcn_s_setprio(0); } while (0)
#define PG8_WAIT_V(n) asm volatile("s_waitcnt vmcnt(" #n ")" ::: "memory")
#define PG8_WAIT_L(n) asm volatile("s_waitcnt lgkmcnt(" #n ")" ::: "memory")
#define PG8_BAR __builtin_amdgcn_s_barrier()
#define PG8_SCHED __builtin_amdgcn_sched_barrier(0)
    UnitX cur, nxt; int ui = 0;
    if (!P.get(0, cur)) return;
    f32x4 acc[2][2][4][2];
#pragma unroll
    for (int a = 0; a < 2; ++a)
#pragma unroll
        for (int b = 0; b < 2; ++b)
#pragma unroll
            for (int m = 0; m < 4; ++m)
#pragma unroll
                for (int n = 0; n < 2; ++n) acc[a][b][m][n] = (f32x4){0.f, 0.f, 0.f, 0.f};
    bf16x8 At[4][2], B0[2][2], B1[2][2];
    int Kc = cur.K; size_t hsc = (size_t)HALF * Kc * 2;
    const char* cA = cur.A + (size_t)cur.pm * 2 * hsc; const char* cB = cur.Bt + (size_t)cur.pn * 2 * hsc;
    unsigned vAc[2], vBc[2];
#pragma unroll
    for (int i = 0; i < 2; ++i) { vAc[i] = (unsigned)(RA[i] * Kc + C2[i]); vBc[i] = (unsigned)(RB[i] * Kc + C2[i]); }
    P.a_ready(cur);
    PG8_STAGE(PG8_SB(0, 0), cB, vBc); PG8_STAGE(PG8_SB(0, 1), cB + hsc, vBc); PG8_STAGE(PG8_SA(0, 0), cA, vAc); PG8_STAGE(PG8_SA(0, 1), cA + hsc, vAc);
    if (wr == 1) PG8_BAR;
    PG8_WAIT_V(2); PG8_BAR;
    PG8_STAGE(PG8_SB(1, 0), cB + kstep, vBc); PG8_STAGE(PG8_SA(1, 0), cA + kstep, vAc); PG8_STAGE(PG8_SB(1, 1), cB + hsc + kstep, vBc);
    PG8_WAIT_V(6); PG8_BAR;
    for (;;) {
        const bool has_next = P.get(ui + 1, nxt);
        const int Kn = has_next ? nxt.K : Kc; const size_t hsn = (size_t)HALF * Kn * 2;
        const char* nA = has_next ? nxt.A + (size_t)nxt.pm * 2 * hsn : cA; const char* nB = has_next ? nxt.Bt + (size_t)nxt.pn * 2 * hsn : cB;
        const int nt = cur.nk;
        for (int t = 0; t < nt; t += 2) {
            const bool last = (t == nt - 2);
            const char* a1 = cA + (size_t)(t + 1) * kstep;
            const char* a2 = last ? nA : cA + (size_t)(t + 2) * kstep; const char* b2 = last ? nB : cB + (size_t)(t + 2) * kstep;
            const char* a3 = a2 + kstep; const char* b3 = b2 + kstep;
            const size_t hs2 = last ? hsn : hsc; const int K2 = last ? Kn : Kc;
            unsigned vA2[2], vB2[2];
#pragma unroll
            for (int i = 0; i < 2; ++i) { vA2[i] = (unsigned)(RA[i] * K2 + C2[i]); vB2[i] = (unsigned)(RB[i] * K2 + C2[i]); }
            if (last && has_next) P.a_ready(nxt);
            PG8_LDB(B0, 0, 0); PG8_LDB(B1, 0, 1); PG8_SCHED; PG8_LDA(At, 0, 0); PG8_STAGE(PG8_SA(1, 1), a1 + hsc, vAc);
            PG8_WAIT_V(8); PG8_WAIT_L(0); PG8_BAR; PG8_MMA(0, 0, At, B0); PG8_MMA(0, 1, At, B1); PG8_BAR; PG8_SCHED;
            PG8_LDA(At, 0, 1); PG8_STAGE(PG8_SB(0, 0), b2, vB2); PG8_STAGE(PG8_SB(0, 1), b2 + hs2, vB2); PG8_STAGE(PG8_SA(0, 0), a2, vA2);
            PG8_WAIT_V(8); PG8_WAIT_L(0); PG8_BAR; PG8_MMA(1, 0, At, B0); PG8_MMA(1, 1, At, B1); PG8_BAR; PG8_SCHED;
            PG8_LDB(B0, 1, 0); PG8_LDB(B1, 1, 1); PG8_SCHED; PG8_LDA(At, 1, 0); PG8_STAGE(PG8_SA(0, 1), a2 + hs2, vA2);
            PG8_WAIT_V(8); PG8_WAIT_L(0); PG8_BAR; PG8_MMA(0, 0, At, B0); PG8_MMA(0, 1, At, B1); PG8_BAR; PG8_SCHED;
            PG8_LDA(At, 1, 1); PG8_STAGE(PG8_SB(1, 0), b3, vB2); PG8_STAGE(PG8_SB(1, 1), b3 + hs2, vB2); PG8_STAGE(PG8_SA(1, 0), a3, vA2);
            PG8_WAIT_V(8); PG8_WAIT_L(0); PG8_BAR; PG8_MMA(1, 0, At, B0); PG8_MMA(1, 1, At, B1); PG8_BAR; PG8_SCHED;
        }
        if constexpr (ALIGN_EPI) { if (wr == 0) PG8_BAR; }
        { int fr_e = fr, fq_e = fq, wr_e = wr, wc_e = wc; asm volatile("" : "+v"(fr_e), "+v"(fq_e), "+s"(wr_e), "+s"(wc_e));
          P.epi(acc, cur, wr_e, wc_e, fr_e, fq_e); }
        if (!has_next) break;
#pragma unroll
        for (int a = 0; a < 2; ++a)
#pragma unroll
            for (int b = 0; b < 2; ++b)
#pragma unroll
                for (int m = 0; m < 4; ++m)
#pragma unroll
                    for (int n = 0; n < 2; ++n) acc[a][b][m][n] = (f32x4){0.f, 0.f, 0.f, 0.f};
        cur = nxt; cA = nA; cB = nB; Kc = Kn; hsc = hsn; ++ui;
#pragma unroll
        for (int i = 0; i < 2; ++i) { vAc[i] = (unsigned)(RA[i] * Kc + C2[i]); vBc[i] = (unsigned)(RB[i] * Kc + C2[i]); }
        if constexpr (ALIGN_EPI) { if (wr == 1) PG8_BAR; }
    }
    PG8_WAIT_V(0);
    if constexpr (!ALIGN_EPI) { if (wr == 0) PG8_BAR; }
    PG8_BAR;
#undef PG8_SA
#undef PG8_SB
#undef PG8_STAGE
#undef PG8_LDA
#undef PG8_LDB
#undef PG8_MMA
#undef PG8_WAIT_V
#undef PG8_WAIT_L
#undef PG8_BAR
#undef PG8_SCHED
}
struct ProgG2 {
    int pm, pn; const bf16_t* zq; const bf16_t* wbr; const bf16_t* xb; const bf16_t* wg; bf16_t* ys; bf16_t* mb; const float* ssq;
    __device__ __forceinline__ bool get(int i, UnitX& u) const {
        if (i >= 6) return false;
        const int n = i >> 1; u.pm = pm; u.pn = pn; u.kind = i;
        if (i & 1) { u.A = (const char*)xb; u.Bt = (const char*)(wg + (size_t)n * 1024 * 1024); u.K = 1024; u.nk = 16; }
        else { u.A = (const char*)(zq + (size_t)n * MROWS * 512); u.Bt = (const char*)(wbr + (size_t)n * 1024 * 512); u.K = 512; u.nk = 8; }
        return true; }
    __device__ __forceinline__ void a_ready(const UnitX&) const {}
    __device__ __forceinline__ void epi(const f32x4 (&acc)[2][2][4][2], const UnitX& ux, int wr, int wc, int fr, int fq) const {
        Unit u; u.pm = ux.pm; u.pn = ux.pn;
        if (ux.kind & 1) { EpiGate E{ys, mb, ssq, ux.kind == 1 ? 1 : 0}; E(acc, u, wr, wc, fr, fq); }
        else { EpiStash E{ys}; E(acc, u, wr, wc, fr, fq); }
    }
};
struct EpiMiscPart {
    float* part;
    __device__ __forceinline__ void operator()(const f32x4 (&acc)[2][2][4][2], int pm, int kq, int wr, int wc, int fr, int fq) const {
        if (wc >= 3) return;
        float* base = part + ((size_t)kq * MROWS + (size_t)pm * BM + wr * 64 + fr) * 96 + wc * 32 + 8 * fq;
#pragma unroll
        for (int ai = 0; ai < 2; ++ai)
#pragma unroll
            for (int m = 0; m < 4; ++m) { float* rp = base + (size_t)(ai * HALF + m * 16) * 96;
                *(PG8_GAS f32x4*)rp = acc[ai][0][m][0]; *(PG8_GAS f32x4*)(rp + 4) = acc[ai][0][m][1]; }
    }
};
struct ProgG1 {
    StaticOrder S; int spm, skq; const bf16_t* xb; const bf16_t* win; bf16_t* zq; bf16_t* zkv; const float* ssq; float* part;
    __device__ __forceinline__ bool get(int i, UnitX& u) const {
        if (i >= 4) return false;
        u.K = 1024; u.A = (const char*)xb; u.Bt = (const char*)win;
        if (i < 3) { Unit t; S.next(i, t); u.pm = t.pm; u.pn = t.pn; u.nk = 16; u.kind = 0; }
        else { u.pm = spm; u.pn = 12; u.A = (const char*)(xb + skq * 256); u.Bt = (const char*)(win + skq * 256); u.nk = 4; u.kind = 1; }
        return true; }
    __device__ __forceinline__ void a_ready(const UnitX&) const {}
    __device__ __forceinline__ void epi(const f32x4 (&acc)[2][2][4][2], const UnitX& ux, int wr, int wc, int fr, int fq) const {
        if (ux.kind == 0) { Unit u; u.pm = ux.pm; u.pn = ux.pn; EpiG1 E{zq, zkv, ssq}; E(acc, u, wr, wc, fr, fq); }
        else { EpiMiscPart E{part}; E(acc, ux.pm, skq, wr, wc, fr, fq); }
    }
};
}

#define GAS __attribute__((address_space(1)))
#define LAS __attribute__((address_space(3)))
typedef unsigned short bf16;
typedef unsigned v4u __attribute__((ext_vector_type(4)));
typedef float f32x4 __attribute__((ext_vector_type(4)));
typedef short bf16x8 __attribute__((ext_vector_type(8)));
typedef GAS unsigned gu32;
typedef GAS unsigned long long gu64;
#define RLX_AGENT __ATOMIC_RELAXED, __HIP_MEMORY_SCOPE_AGENT
#define LDS_WAIT() asm volatile("s_waitcnt lgkmcnt(0)" ::: "memory")
#define VM_WAIT() asm volatile("s_waitcnt vmcnt(0)" ::: "memory")
__device__ __forceinline__ unsigned long long rt() { return __builtin_amdgcn_s_memrealtime(); }
__device__ __forceinline__ unsigned f2bf(float f) { unsigned u = __builtin_bit_cast(unsigned, f); return (u + 0x7fffu + ((u >> 16) & 1u)) >> 16; }
__device__ __forceinline__ unsigned pk2(float lo, float hi) { return f2bf(lo) | (f2bf(hi) << 16); }

#define XB_TMO      128
#define XB_XCNT(j)  (256  + 64 * (j))
#define XB_XSUB(j)  (1280 + 64 * (j))
#define XB_XGEN(j)  (2304 + 64 * (j))
#define XB_TOP      3328
#define XB_TOPGEN   3392
#define XCD_BAR_WORDS 3456
#define XB_SPIN_CAP (1u << 18)

__device__ __forceinline__ unsigned xb_ld(unsigned* p)              { return __hip_atomic_load(p, __ATOMIC_RELAXED, __HIP_MEMORY_SCOPE_AGENT); }
__device__ __forceinline__ unsigned xb_add(unsigned* p, unsigned v) { return __hip_atomic_fetch_add(p, v, __ATOMIC_RELAXED, __HIP_MEMORY_SCOPE_AGENT); }
__device__ __forceinline__ unsigned xb_xcc_id() { return (unsigned)__builtin_amdgcn_s_getreg((3 << 11) | 20) & 0xFu; }
#define XB_SPIN(cond, bar) do { unsigned _sp = 0; while (cond) { __builtin_amdgcn_s_sleep(1); \
    if ((++_sp & 255u) == 0u) { if (xb_ld(&(bar)[XB_TMO])) break; if (_sp > XB_SPIN_CAP) { atomicAdd(&(bar)[XB_TMO], 1u); break; } } } } while (0)

struct XcdBarrier {
    unsigned* bar; unsigned x;
    volatile LAS unsigned* st;
};

__device__ __forceinline__ XcdBarrier xcd_barrier_post(unsigned* bar, volatile LAS unsigned* st) {
    XcdBarrier b; b.bar = bar; b.x = xb_xcc_id(); b.st = st;
    if (threadIdx.x == 0) (void)xb_add(&bar[XB_XCNT(b.x)], 1u);
    return b;
}
__device__ __forceinline__ void xcd_barrier_complete(unsigned* bar, unsigned x, unsigned& nloc, unsigned& nx) {
    const unsigned G = gridDim.x * gridDim.y * gridDim.z;
    unsigned sum, cnt, mine, sp = 0u;
    for (;;) {
        sum = 0u; cnt = 0u; mine = 0u;
#pragma unroll
        for (unsigned j = 0; j < 16; ++j) { const unsigned c = xb_ld(&bar[XB_XCNT(j)]); sum += c; cnt += (c > 0u) ? 1u : 0u; mine = (j == x) ? c : mine; }
        if (sum == G) break;
        __builtin_amdgcn_s_sleep(1);
        if ((++sp & 255u) == 0u) { if (xb_ld(&bar[XB_TMO])) break; if (sp > XB_SPIN_CAP) { atomicAdd(&bar[XB_TMO], 1u); break; } }
    }
    nloc = mine > 0u ? mine : 1u; nx = cnt > 0u ? cnt : 1u;
}

__device__ __forceinline__ void xcd_barrier(const XcdBarrier& b) {
    asm volatile("s_waitcnt vmcnt(0)" ::: "memory");
    __syncthreads();
    if (threadIdx.x == 0) {
        unsigned* bar = b.bar;
        __builtin_amdgcn_s_waitcnt(0);
        unsigned nloc = b.st[0], nx = b.st[1];
        if (nloc == 0u) { xcd_barrier_complete(bar, b.x, nloc, nx); b.st[0] = nloc; b.st[1] = nx; }
        const unsigned old = xb_add(&bar[XB_XSUB(b.x)], 1u);
        const unsigned gen = old / nloc;
        if (old + 1u == (gen + 1u) * nloc) {
            __builtin_amdgcn_fence(__ATOMIC_RELEASE, "agent");
            asm volatile("s_waitcnt vmcnt(0)" ::: "memory");
            const unsigned og = xb_add(&bar[XB_TOP], 1u);
            const unsigned tg = og / nx;
            if (og + 1u == (tg + 1u) * nx) xb_add(&bar[XB_TOPGEN], 1u);
            else XB_SPIN(xb_ld(&bar[XB_TOPGEN]) == tg, bar);
            __builtin_amdgcn_fence(__ATOMIC_ACQUIRE, "agent");
            xb_add(&bar[XB_XGEN(b.x)], 1u);
            asm volatile("s_waitcnt vmcnt(0)" ::: "memory");
        } else {
            XB_SPIN(xb_ld(&bar[XB_XGEN(b.x)]) == gen, bar);
            __builtin_amdgcn_fence(__ATOMIC_ACQUIRE, "agent");
            asm volatile("s_waitcnt vmcnt(0)" ::: "memory");
        }
    }
    __syncthreads();
}

namespace att {
typedef short bf16x8 __attribute__((ext_vector_type(8)));
typedef short s16x4 __attribute__((ext_vector_type(4)));
typedef float f32x16 __attribute__((ext_vector_type(16)));
typedef unsigned u32x4 __attribute__((ext_vector_type(4)));
typedef unsigned short bf16_t;
typedef unsigned long long u64;
constexpr int NKB = 4, NVB = 5;
constexpr int WSF_W = 320;
constexpr int L_K0 = 0, L_V0 = NKB * 8320, L_IMP = L_V0  , L_WSF = L_V0 + NVB * 8192, L_SEL = L_WSF + 8 * WSF_W * 4, L_OST = L_SEL + 512  , L_END = L_OST + 65536;
__device__ __forceinline__ int crow(int r, int hi) { return (r & 3) + 8 * (r >> 2) + 4 * hi; }
__device__ __forceinline__ unsigned pk2(float lo, float hi) { typedef float f2 __attribute__((ext_vector_type(2))); typedef __bf16 b2 __attribute__((ext_vector_type(2)));
    f2 v = {lo, hi}; b2 b = __builtin_convertvector(v, b2); return __builtin_bit_cast(unsigned, b); }
__device__ __forceinline__ s16x4 vtr(LAS const char* p) { typedef short v4i16_t __attribute__((ext_vector_type(4))); return __builtin_bit_cast(s16x4, __builtin_amdgcn_ds_read_tr16_b64_v4i16((LAS v4i16_t*)p)); }

struct KVSrc { const GAS bf16_t* k; const GAS bf16_t* v; int pitch; int nrows; };

struct Lane { int tid, lane, r32, hi, wid; };

__device__ __forceinline__ void tile_gload(const KVSrc& S, int t, int tid, u32x4& kr, u32x4& vr) {
    const int row = 64 * t + (tid >> 3), ch = tid & 7;
    kr = *(const GAS u32x4*)(S.k + (size_t)row * S.pitch + ch * 8); vr = *(const GAS u32x4*)(S.v + (size_t)row * S.pitch + ch * 8);
}
__device__ __forceinline__ void tile_lstore(LAS char* kb, LAS char* vb, int tid, const u32x4& kr, const u32x4& vr) {
    const int key = tid >> 3, ch = tid & 7;
    *(LAS u32x4*)(kb + ch * 1040 + (key >> 5) * 512 + (key & 31) * 16) = kr;
    *(LAS u32x4*)(vb + (ch >> 2) * 4096 + (key >> 4) * 1024 + ((key >> 3) & 1) * 512 + (key & 7) * 64 + (ch & 3) * 16) = vr;
}
__device__ __forceinline__ void qk_tile(LAS const char* kbuf, const bf16x8 (&qr)[4], f32x16& p0, f32x16& p1, int r32, int hi) {
    LAS const char* kb = kbuf + hi * 1040 + r32 * 16;
#pragma unroll
    for (int d0 = 0; d0 < 4; ++d0) {
        const bf16x8 b0 = *(LAS const bf16x8*)(kb + d0 * 2080);
        const bf16x8 b1 = *(LAS const bf16x8*)(kb + d0 * 2080 + 512);
        p0 = __builtin_amdgcn_mfma_f32_32x32x16_bf16(b0, qr[d0], p0, 0, 0, 0);
        p1 = __builtin_amdgcn_mfma_f32_32x32x16_bf16(b1, qr[d0], p1, 0, 0, 0);
    }
}
__device__ __forceinline__ void qk_tile_c(LAS const char* kbuf, const bf16x8 (&qr)[4], const f32x16& negm, f32x16& p0, f32x16& p1, int r32, int hi) {
    const unsigned ka = (unsigned)(size_t)kbuf + hi * 1040 + r32 * 16;
    bf16x8 kf[8];
#pragma unroll
    for (int d0 = 0; d0 < 4; ++d0) {
        asm volatile("ds_read_b128 %0, %1 offset:%c2" : "=&v"(kf[2 * d0]) : "v"(ka), "i"(d0 * 2080) : "memory");
        asm volatile("ds_read_b128 %0, %1 offset:%c2" : "=&v"(kf[2 * d0 + 1]) : "v"(ka), "i"(d0 * 2080 + 512) : "memory");
    }
    asm volatile("s_waitcnt lgkmcnt(0)" : "+v"(kf[0]), "+v"(kf[1]), "+v"(kf[2]), "+v"(kf[3]), "+v"(kf[4]), "+v"(kf[5]), "+v"(kf[6]), "+v"(kf[7]) :: "memory");
    __builtin_amdgcn_sched_barrier(0);
    p0 = __builtin_amdgcn_mfma_f32_32x32x16_bf16(kf[0], qr[0], negm, 0, 0, 0); p1 = __builtin_amdgcn_mfma_f32_32x32x16_bf16(kf[1], qr[0], negm, 0, 0, 0);
#pragma unroll
    for (int d0 = 1; d0 < 4; ++d0) { p0 = __builtin_amdgcn_mfma_f32_32x32x16_bf16(kf[2 * d0], qr[d0], p0, 0, 0, 0); p1 = __builtin_amdgcn_mfma_f32_32x32x16_bf16(kf[2 * d0 + 1], qr[d0], p1, 0, 0, 0); }
}
__device__ __forceinline__ void pv_tile(LAS const char* vbuf, const u32x4 (&pw)[4], f32x16 (&o)[2], f32x16& ol, int lane, int hi) {
    const unsigned va = (unsigned)(size_t)vbuf + ((lane >> 4) & 1) * 32 + (lane & 3) * 8 + (4 * hi + ((lane & 15) >> 2)) * 64;
#pragma unroll
    for (int d0 = 0; d0 < 2; ++d0) {
        s16x4 lo[4], h2[4];
#pragma unroll
        for (int ks = 0; ks < 4; ++ks) {
            asm volatile("ds_read_b64_tr_b16 %0, %1 offset:%c2" : "=&v"(lo[ks]) : "v"(va), "i"(d0 * 4096 + ks * 1024) : "memory");
            asm volatile("ds_read_b64_tr_b16 %0, %1 offset:%c2" : "=&v"(h2[ks]) : "v"(va), "i"(d0 * 4096 + ks * 1024 + 512) : "memory");
        }
        asm volatile("s_waitcnt lgkmcnt(0)" : "+v"(lo[0]), "+v"(lo[1]), "+v"(lo[2]), "+v"(lo[3]), "+v"(h2[0]), "+v"(h2[1]), "+v"(h2[2]), "+v"(h2[3]) :: "memory");
        __builtin_amdgcn_sched_barrier(0);
#pragma unroll
        for (int ks = 0; ks < 4; ++ks) {
            const bf16x8 vf = (bf16x8){lo[ks][0], lo[ks][1], lo[ks][2], lo[ks][3], h2[ks][0], h2[ks][1], h2[ks][2], h2[ks][3]};
            o[d0] = __builtin_amdgcn_mfma_f32_32x32x16_bf16(__builtin_bit_cast(bf16x8, pw[ks]), vf, o[d0], 0, 0, 0);
        }
        if (d0 == 0) {
            const bf16x8 ones = (bf16x8){0x3f80, 0x3f80, 0x3f80, 0x3f80, 0x3f80, 0x3f80, 0x3f80, 0x3f80};
#pragma unroll
            for (int ks = 0; ks < 4; ++ks) ol = __builtin_amdgcn_mfma_f32_32x32x16_bf16(__builtin_bit_cast(bf16x8, pw[ks]), ones, ol, 0, 0, 0);
        }
    }
}
__device__ __forceinline__ void mask_exp_pack(f32x16& p0, f32x16& p1, u64 mask, int hi, u32x4 (&pw)[4]) {
    const bool rowuni = __all(mask == ~0ull || mask == 0ull);
    if (rowuni) {
        const unsigned rm = mask ? ~0u : 0u;
        if (__all(mask == ~0ull)) {
#pragma unroll
            for (int r = 0; r < 16; ++r) { p0[r] = __builtin_amdgcn_exp2f(p0[r]); p1[r] = __builtin_amdgcn_exp2f(p1[r]); }
        } else {
#pragma unroll
            for (int r = 0; r < 16; ++r) { p0[r] = __uint_as_float(__float_as_uint(__builtin_amdgcn_exp2f(p0[r])) & rm); p1[r] = __uint_as_float(__float_as_uint(__builtin_amdgcn_exp2f(p1[r])) & rm); }
        }
    } else {
        const int m0 = (int)(unsigned)(mask >> (4 * hi)), m1 = (int)(unsigned)(mask >> (32 + 4 * hi));
#pragma unroll
        for (int r = 0; r < 16; ++r) { const int bit = (r & 3) + 8 * (r >> 2);
            const unsigned e0 = __float_as_uint(__builtin_amdgcn_exp2f(p0[r])), e1 = __float_as_uint(__builtin_amdgcn_exp2f(p1[r]));
            unsigned k0, k1;
            asm("v_bfe_i32 %0, %1, %2, 1" : "=v"(k0) : "v"(m0), "n"(bit)); asm("v_bfe_i32 %0, %1, %2, 1" : "=v"(k1) : "v"(m1), "n"(bit));
            p0[r] = __uint_as_float(e0 & k0); p1[r] = __uint_as_float(e1 & k1); }
    }
    pw[0] = (u32x4){pk2(p0[0], p0[1]), pk2(p0[2], p0[3]), pk2(p0[4], p0[5]), pk2(p0[6], p0[7])};
    pw[1] = (u32x4){pk2(p0[8], p0[9]), pk2(p0[10], p0[11]), pk2(p0[12], p0[13]), pk2(p0[14], p0[15])};
    pw[2] = (u32x4){pk2(p1[0], p1[1]), pk2(p1[2], p1[3]), pk2(p1[4], p1[5]), pk2(p1[6], p1[7])};
    pw[3] = (u32x4){pk2(p1[8], p1[9]), pk2(p1[10], p1[11]), pk2(p1[12], p1[13]), pk2(p1[14], p1[15])};
}
__device__ __forceinline__ u64 mask_le(int c) { return c >= 63 ? ~0ull : (c < 0 ? 0ull : ((2ull << c) - 1ull)); }
__device__ __forceinline__ u64 mask_ge(int a) { return a <= 0 ? ~0ull : (a > 63 ? 0ull : (~0ull << a)); }


__device__ __forceinline__ void glds16(const GAS void* gsrc, unsigned lds_dst) { unsigned keep;
    asm volatile("s_mov_b32 %0, m0\n\ts_mov_b32 m0, %2\n\ts_nop 0\n\tglobal_load_lds_dwordx4 %1, off\n\ts_mov_b32 m0, %0" : "=&s"(keep) : "v"(gsrc), "s"(lds_dst) : "memory"); }
__device__ __forceinline__ void tile_dma(const KVSrc& S, int t, unsigned kslot, unsigned vslot, const Lane& L) {
    const GAS bf16_t* ks = S.k + (size_t)(64 * t + L.lane) * S.pitch + L.wid * 8;
    const GAS bf16_t* vs = S.v + (size_t)(64 * t + 16 * (L.wid & 3) + (L.lane >> 2)) * S.pitch + (L.wid >> 2) * 32 + (L.lane & 3) * 8;
    glds16(ks, (unsigned)__builtin_amdgcn_readfirstlane(kslot + L.wid * 1040));
    glds16(vs, (unsigned)__builtin_amdgcn_readfirstlane(vslot + (L.wid >> 2) * 4096 + (L.wid & 3) * 1024));
}
#define ATT_WAIT_BAR(N) asm volatile("s_waitcnt vmcnt(" #N ") lgkmcnt(0)\n\ts_barrier" ::: "memory")
template <class MF>
__device__ __forceinline__ void attend_range(LAS char* lds, const KVSrc& S, int t0, int t1, const MF& mf, const bf16x8 (&qr)[4], float negC, f32x16& ol, f32x16 (&o)[2], const Lane& L, bool abl = false) {
    if (t0 >= t1) return;
    const bool late = L.wid >= 4;
    const unsigned lds0 = (unsigned)(size_t)lds;
    const f32x16 negm = {0.f, 0.f, 0.f, 0.f, 0.f, 0.f, 0.f, 0.f, 0.f, 0.f, 0.f, 0.f, 0.f, 0.f, 0.f, 0.f};
    (void)negC;
    tile_dma(S, t0, lds0 + L_K0, lds0 + L_V0, L);
    if (t0 + 1 < t1) tile_dma(S, t0 + 1, lds0 + L_K0 + 8320, lds0 + L_V0 + 8192, L);
    if (t0 + 2 < t1) tile_dma(S, t0 + 2, lds0 + L_K0 + 2 * 8320, lds0 + L_V0 + 2 * 8192, L);
    if (t0 + 2 < t1) ATT_WAIT_BAR(4); else if (t0 + 1 < t1) ATT_WAIT_BAR(2); else ATT_WAIT_BAR(0);
    u32x4 pwp[4];
#pragma unroll
    for (int k = 0; k < 4; ++k) asm volatile("" : "=v"(pwp[k]));
    int kcur = 0, vcur = 0, vprev = 0;
    u64 mk_next = mf(t0);
#if defined(PROBE_ABL) && PROBE_ABL == 12
    if (abl) { for (int t = t0; t < t1; ++t) { asm volatile("s_nop 0" ::: "memory"); } return; }
#endif
#if defined(PROBE_ABL) && PROBE_ABL == 13
    if (abl) { for (int t = t0; t < t1; ++t) { ATT_WAIT_BAR(0); } return; }
#endif
#if defined(PROBE_ABL) && PROBE_ABL == 14
    if (abl) { u64 acc_ = 0; for (int t = t0; t < t1; ++t) { acc_ ^= mf(t); asm volatile("s_waitcnt lgkmcnt(0)" : "+v"(acc_) :: "memory"); } asm volatile("" :: "v"(acc_)); return; }
#endif
#if defined(PROBE_ABL) && PROBE_ABL == 15
    if (abl) { for (int t = t0; t < t1; ++t) { f32x16 p0, p1; qk_tile_c(lds + L_K0, qr, negm, p0, p1, L.r32, L.hi); asm volatile("" :: "v"(p0), "v"(p1)); } return; }
#endif
#pragma unroll 1
    for (int t = t0; t < t1; ++t) {
        const u64 mk = mk_next;
        if (t + 1 < t1) mk_next = mf(t + 1);
#if defined(PROBE_ABL) && PROBE_ABL >= 10
        if (t + 3 < t1 && !abl) {
#else
        if (t + 3 < t1) {
#endif
            const int ks = kcur == 0 ? NKB - 1 : kcur - 1; int vs = vcur + 3; vs = vs >= NVB ? vs - NVB : vs;
            tile_dma(S, t + 3, lds0 + L_K0 + ks * 8320, lds0 + L_V0 + vs * 8192, L); }
#if defined(PROBE_ABL) && (PROBE_ABL == 6 || PROBE_ABL >= 10)
        if (late && t > t0 && !abl) pv_tile(lds + L_V0 + vprev * 8192, pwp, o, ol, L.lane, L.hi);
#else
        if (late && t > t0) pv_tile(lds + L_V0 + vprev * 8192, pwp, o, ol, L.lane, L.hi);
#endif
        f32x16 p0, p1;
#if defined(PROBE_ABL) && (PROBE_ABL == 6 || PROBE_ABL >= 10)
        if (abl) { p0 = negm; p1 = negm; asm volatile("" : "+v"(p0), "+v"(p1)); } else
#endif
        qk_tile_c(lds + L_K0 + kcur * 8320, qr, negm, p0, p1, L.r32, L.hi);
        u32x4 pw[4];
#if defined(PROBE_ABL) && (PROBE_ABL == 2 || PROBE_ABL >= 10)
        if (abl) {
#pragma unroll
            for (int k = 0; k < 4; ++k) pw[k] = (u32x4){__float_as_uint(p0[4 * k]) ^ (unsigned)mk, __float_as_uint(p0[4 * k + 1]), __float_as_uint(p1[4 * k + 2]), __float_as_uint(p1[4 * k + 3])}; }
        else
#endif
        mask_exp_pack(p0, p1, mk, L.hi, pw);
#if defined(PROBE_ABL) && (PROBE_ABL == 6 || PROBE_ABL >= 10)
        if (!late && !abl) pv_tile(lds + L_V0 + vcur * 8192, pw, o, ol, L.lane, L.hi);
        else if (!late) { asm volatile("" :: "v"(pw[0]), "v"(pw[1]), "v"(pw[2]), "v"(pw[3])); }
#else
        if (!late) pv_tile(lds + L_V0 + vcur * 8192, pw, o, ol, L.lane, L.hi);
#endif
        else {
#pragma unroll
            for (int k = 0; k < 4; ++k) pwp[k] = pw[k]; }
#if defined(PROBE_ABL) && PROBE_ABL == 11
        if (abl) { asm volatile("s_waitcnt lgkmcnt(0)" ::: "memory"); } else
#endif
        if (t + 3 < t1) ATT_WAIT_BAR(4); else if (t + 2 < t1) ATT_WAIT_BAR(2); else ATT_WAIT_BAR(0);
        vprev = vcur; vcur = vcur == NVB - 1 ? 0 : vcur + 1; kcur = kcur == NKB - 1 ? 0 : kcur + 1;
    }
    if (late) pv_tile(lds + L_V0 + vprev * 8192, pwp, o, ol, L.lane, L.hi);
    ATT_WAIT_BAR(0);
}
__device__ __forceinline__ void rows_to_regs(LAS float* wsf, float v, int r32, int hi, float (&sc)[16]) {
    asm volatile("s_waitcnt lgkmcnt(0)" ::: "memory");
    if (hi == 0) wsf[r32] = v;
    asm volatile("s_waitcnt lgkmcnt(0)" ::: "memory");
#pragma unroll
    for (int r = 0; r < 16; ++r) sc[r] = wsf[crow(r, hi)];
}
__device__ __forceinline__ void load_q(const bf16_t* qrow, int hi, bf16x8 (&qr)[4]) {
#pragma unroll
    for (int d0 = 0; d0 < 4; ++d0) qr[d0] = *(const GAS bf16x8*)(qrow + d0 * 16 + hi * 8);
}
template <class RowPtr>
__device__ __forceinline__ void store_o(LAS char* stage, const f32x16 (&acc)[2], const RowPtr& rowptr, int lane, int r32, int hi) {
    LAS bf16_t* stg = (LAS bf16_t*)stage;
#pragma unroll
    for (int r = 0; r < 16; ++r) { const int orow = crow(r, hi);
#pragma unroll
        for (int d0 = 0; d0 < 2; ++d0) stg[orow * 64 + d0 * 32 + r32] = (bf16_t)(pk2(acc[d0][r], 0.f) & 0xffffu); }
    asm volatile("s_waitcnt lgkmcnt(0)" ::: "memory");
#pragma unroll
    for (int i = 0; i < 4; ++i) { const int row = i * 8 + (lane >> 3), ch = lane & 7; const u32x4 v = *(LAS const u32x4*)(stg + row * 64 + ch * 8); *(GAS u32x4*)(rowptr(row) + ch * 8) = v; }
    asm volatile("s_waitcnt lgkmcnt(0)" ::: "memory");
}
}

constexpr int NWAVES = 8;
constexpr int BATCH = 4, SEQ = 4096, DM = 1024, DFF = 4096, DEPTH = 2, D_IN = 6236;
constexpr int M = BATCH * SEQ;
constexpr size_t MiB = 1u << 20;
constexpr size_t WS_ZQ = 0;
constexpr size_t WS_ZKV = 48 * MiB;
constexpr size_t WS_YS = WS_ZKV;
constexpr size_t WS_MB = 104 * MiB;
constexpr size_t WS_KC2 = WS_MB, WS_VC2 = WS_MB + 4 * MiB;
constexpr size_t WS_PART = 112 * MiB;
constexpr size_t WS_XB = 136 * MiB;
constexpr size_t WS_W = 168 * MiB, W_LAYER = 36 * MiB;
constexpr size_t W_IN = 0, W_G = 7 * MiB, W_BR = 13 * MiB, W_OUT = 16 * MiB, W_UP = 18 * MiB, W_DN = 26 * MiB, W_CK1 = 34 * MiB, W_CV1 = 35 * MiB;
constexpr size_t WS_BM = 240 * MiB;
constexpr size_t WS_MISC = 248 * MiB;
constexpr size_t WS_CTL = WS_MISC, CTL_BYTES = 128 * 1024;
constexpr size_t WS_COS = WS_MISC + 1 * MiB, WS_SIN = WS_MISC + 1 * MiB + 512 * 1024;
constexpr size_t WS_KCMP = WS_MISC + 2 * MiB;
constexpr size_t WS_SSQ = WS_MISC + 2 * MiB + 512 * 1024;
constexpr size_t WS_B1P = WS_MISC + 3 * MiB + 512 * 1024;
constexpr size_t WS_W2 = WS_B1P + 64 * 1024;
constexpr size_t WS_IKF = WS_MISC + 4 * MiB;
constexpr size_t WS_HMID = 0;
constexpr size_t WS_END = 256 * MiB;
constexpr int CW_BAR = 4096, CW_Q = 8192, CW_KMAX = 12288;
constexpr int LDS_BYTES = 163840, LDS_UNIT = 163776;
constexpr float C2 = 0.125f * 1.4426950408889634f, LOG2E = 1.4426950408889634f;


struct Args { const float* in[17]; float* out; unsigned char* ws; };
struct Frame {
    LAS unsigned char* lds;
    gu32* ctl;
    int tid, lane, wave, G, gw, NGW;
    unsigned char* ws;
    const struct Args* a;
};
__device__ __forceinline__ float wave_sum(float v) {
#pragma unroll
    for (int o = 1; o < 64; o <<= 1) v += __shfl_xor(v, o);
    return v;
}
__device__ __forceinline__ float wave_max(float v) {
#pragma unroll
    for (int o = 1; o < 64; o <<= 1) v = fmaxf(v, __shfl_xor(v, o));
    return v;
}
__device__ __forceinline__ float bf2f(bf16 h) { return __uint_as_float((unsigned)h << 16); }
__device__ __constant__ float c_inv_freq[32] = {
    1.0f, 0.7498942093324559f, 0.5623413251903491f, 0.4216965034285822f, 0.31622776601683794f, 0.23713737056616552f, 0.1778279410038923f, 0.1333521432163324f,
    0.1f, 0.07498942093324558f, 0.05623413251903491f, 0.042169650342858224f, 0.03162277660168379f, 0.023713737056616554f, 0.01778279410038923f, 0.01333521432163324f,
    0.01f, 0.007498942093324558f, 0.005623413251903491f, 0.004216965034285823f, 0.0031622776601683794f, 0.0023713737056616554f, 0.0017782794100389228f, 0.001333521432163324f,
    0.001f, 0.0007498942093324559f, 0.0005623413251903491f, 0.00042169650342858224f, 0.00031622776601683794f, 0.00023713737056616554f, 0.00017782794100389227f, 0.0001333521432163324f};

__device__ __forceinline__ int mix_src_col(int j) {
    if (j < 512) return j;
    if (j < 1024) return 1092 + (j - 512);
    if (j < 1536) return 1860 + (j - 1024);
    if (j < 1792) return 512 + (j - 1536);
    if (j < 2048) return 1604 + (j - 1792);
    if (j < 2304) return 2372 + (j - 2048);
    if (j < 2560) return 2628 + (j - 2304);
    if (j < 2816) return 2884 + (j - 2560);
    if (j < 3072) return 768 + (j - 2816);
    const int r = j - 3072;
    if (r < 64) return 1024 + r;
    if (r < 68) return 1088 + (r - 64);
    if (r < 92) return 3140 + (r - 68);
    return -1;
}
template <int MODE>
__device__ __forceinline__ void p0_item(const float* W, int ldw, int K, bf16* WT, int nblk, int item, const float* gain, int coff, LAS float* scr, int lane) {
    const int kb = item / nblk, nb = item % nblk, k0 = 64 * kb, n0 = 32 * nb;
    const int nq = 4 * (lane & 7), rr = lane >> 3;
    const int sc = MODE == 0 ? (n0 + nq + coff) : mix_src_col(n0 + nq);
    f32x4 v[8];
#pragma unroll
    for (int i = 0; i < 8; ++i) { v[i] = (f32x4){0.f, 0.f, 0.f, 0.f}; if (sc >= 0) v[i] = *(const GAS f32x4*)(W + (size_t)(k0 + 8 * i + rr) * ldw + sc); }
#pragma unroll
    for (int i = 0; i < 8; ++i) { const int kk = 8 * i + rr; const float g = gain ? gain[k0 + kk] : 1.0f;
        scr[kk * 33 + nq + 0] = v[i][0] * g; scr[kk * 33 + nq + 1] = v[i][1] * g; scr[kk * 33 + nq + 2] = v[i][2] * g; scr[kk * 33 + nq + 3] = v[i][3] * g; }
    LDS_WAIT(); asm volatile("" ::: "memory");
    const int c = lane & 7;
#pragma unroll
    for (int j = 0; j < 4; ++j) { const int n = (lane >> 3) + 8 * j; const LAS float* s = scr + (8 * c) * 33 + n;
        v4u o; o.x = pk2(s[0 * 33], s[1 * 33]); o.y = pk2(s[2 * 33], s[3 * 33]); o.z = pk2(s[4 * 33], s[5 * 33]); o.w = pk2(s[6 * 33], s[7 * 33]);
        *(GAS v4u*)(WT + (size_t)(n0 + n) * K + k0 + 8 * c) = o; }
    LDS_WAIT(); asm volatile("" ::: "memory");
}
__device__ __forceinline__ void p0_prologue(Frame& F) {
    LAS float* scr = (LAS float*)(F.lds + F.wave * 16384);
    constexpr int I_IN = 16 * 104, I_G = 16 * 96, I_BR = 8 * 32, I_OUT = 16 * 32, I_UP = 16 * 128, I_DN = 64 * 32, I_C1 = 32 * 8, I_C2 = 4 * 2;
    constexpr int PER_LAYER = I_IN + I_G + 3 * I_BR + I_OUT + I_UP + I_DN + 2 * I_C1 + 2 * I_C2;
    for (int it = F.gw; it < 2 * PER_LAYER; it += F.NGW) {
        const int l = it / PER_LAYER; int r = it % PER_LAYER;
        unsigned char* wl = F.ws + WS_W + (size_t)l * W_LAYER;
        const float* w_in = F.a->in[2] + (size_t)l * DM * D_IN;
        if (r < I_IN) { p0_item<1>(w_in, D_IN, DM, (bf16*)(wl + W_IN), 104, r, F.a->in[1] + l * DM, 0, scr, F.lane); continue; } r -= I_IN;
        if (r < I_G) { p0_item<0>(w_in, D_IN, DM, (bf16*)(wl + W_G), 96, r, F.a->in[1] + l * DM, 3164, scr, F.lane); continue; } r -= I_G;
        if (r < 3 * I_BR) { const int n = r / I_BR; p0_item<0>(F.a->in[12] + ((size_t)l * 3 + n) * 512 * DM, DM, 512, (bf16*)(wl + W_BR) + (size_t)n * DM * 512, 32, r % I_BR, nullptr, 0, scr, F.lane); continue; } r -= 3 * I_BR;
        if (r < I_OUT) { p0_item<0>(F.a->in[13] + (size_t)l * DM * DM, DM, DM, (bf16*)(wl + W_OUT), 32, r, nullptr, 0, scr, F.lane); continue; } r -= I_OUT;
        if (r < I_UP) { p0_item<0>(F.a->in[15] + (size_t)l * DM * DFF, DFF, DM, (bf16*)(wl + W_UP), 128, r, F.a->in[14] + l * DM, 0, scr, F.lane); continue; } r -= I_UP;
        if (r < I_DN) { p0_item<0>(F.a->in[16] + (size_t)l * DFF * DM, DM, DFF, (bf16*)(wl + W_DN), 32, r, nullptr, 0, scr, F.lane); continue; } r -= I_DN;
        if (r < I_C1) { p0_item<0>(F.a->in[8] + (size_t)l * 2048 * 256, 256, 2048, (bf16*)(wl + W_CK1), 8, r, nullptr, 0, scr, F.lane); continue; } r -= I_C1;
        if (r < I_C1) { p0_item<0>(F.a->in[10] + (size_t)l * 2048 * 256, 256, 2048, (bf16*)(wl + W_CV1), 8, r, nullptr, 0, scr, F.lane); continue; } r -= I_C1;
        if (r < I_C2) { p0_item<0>(F.a->in[9] + (size_t)l * 256 * 64, 64, 256, (bf16*)(F.ws + WS_W2) + (size_t)(l * 2 + 0) * 64 * 256, 2, r, nullptr, 0, scr, F.lane); continue; } r -= I_C2;
        p0_item<0>(F.a->in[11] + (size_t)l * 256 * 64, 64, 256, (bf16*)(F.ws + WS_W2) + (size_t)(l * 2 + 1) * 64 * 256, 2, r, nullptr, 0, scr, F.lane);
    }
    for (int it = F.gw; it < 128; it += F.NGW) {
        const int kp = it & 7, jb = (it >> 3) & 3, which = (it >> 5) & 1, l = it >> 6; const int j = jb * 64 + F.lane;
        const float* pe = (which ? F.a->in[7] : F.a->in[6]) + l * 2048; const float* w1 = (which ? F.a->in[10] : F.a->in[8]) + (size_t)l * 2048 * 256;
        float a = 0.f;
        for (int k = kp * 256; k < kp * 256 + 256; ++k) a = fmaf(pe[k], w1[(size_t)k * 256 + j], a);
        ((float*)(F.ws + WS_B1P))[((l * 2 + which) * 8 + kp) * 256 + j] = a;
    }
    for (int m = F.gw; m < M; m += F.NGW) {
        const GAS f32x4* xr = (const GAS f32x4*)(F.a->in[0] + (size_t)m * DM) + F.lane;
        GAS unsigned long long* o8 = (GAS unsigned long long*)((bf16*)(F.ws + WS_XB) + (size_t)m * DM) + F.lane;
        float s = 0.f;
#pragma unroll
        for (int j = 0; j < 4; ++j) { const f32x4 v = xr[64 * j]; s += (v.x * v.x + v.y * v.y) + (v.z * v.z + v.w * v.w);
            o8[64 * j] = (unsigned long long)pk2(v.x, v.y) | ((unsigned long long)pk2(v.z, v.w) << 32); }
        s = wave_sum(s);
        if (F.lane < 16) ((float*)(F.ws + WS_SSQ))[(size_t)m * 16 + F.lane] = F.lane == 0 ? s : 0.f;
    }
    for (int i = F.gw * 64 + F.lane; i < SEQ * 32; i += F.NGW * 64) {
        const float ang = (float)(i >> 5) * c_inv_freq[i & 31];
        ((float*)(F.ws + WS_COS))[i] = (float)cos((double)ang); ((float*)(F.ws + WS_SIN))[i] = (float)sin((double)ang);
    }
}
typedef unsigned u32x4_t __attribute__((ext_vector_type(4)));
__device__ __forceinline__ void post_group(u32x4_t raw, bool act, bool norm, bool rope, const float (&gain)[8], float scale, const float (&cs)[8], const float (&sn)[8], int lane, bf16* dst) {
    float v[8];
    v[0] = __uint_as_float(raw.x << 16); v[1] = __uint_as_float(raw.x & 0xffff0000u); v[2] = __uint_as_float(raw.y << 16); v[3] = __uint_as_float(raw.y & 0xffff0000u);
    v[4] = __uint_as_float(raw.z << 16); v[5] = __uint_as_float(raw.z & 0xffff0000u); v[6] = __uint_as_float(raw.w << 16); v[7] = __uint_as_float(raw.w & 0xffff0000u);
    float ss = ((v[0] * v[0] + v[1] * v[1]) + (v[2] * v[2] + v[3] * v[3])) + ((v[4] * v[4] + v[5] * v[5]) + (v[6] * v[6] + v[7] * v[7]));
    ss += __shfl_xor(ss, 1); ss += __shfl_xor(ss, 2); ss += __shfl_xor(ss, 4);
    const float rs = norm ? rsqrtf(ss * (1.0f / 64.0f) + 1e-6f) : 1.0f;
    const bool lo = (lane & 4) == 0;
    float r[8];
#pragma unroll
    for (int j = 0; j < 8; ++j) { const float x = norm ? v[j] * rs * gain[j] : v[j]; const float o = __shfl_xor(x, 4);
        r[j] = rope ? (lo ? (x * cs[j] - o * sn[j]) : (x * cs[j] + o * sn[j])) : x; r[j] *= scale; }
    if (act) { u32x4_t w; w.x = pk2(r[0], r[1]); w.y = pk2(r[2], r[3]); w.z = pk2(r[4], r[5]); w.w = pk2(r[6], r[7]); *(GAS u32x4_t*)dst = w; }
}
__device__ __forceinline__ void post_phase(Frame& F, int l, bool dry = false) {
    const float* qn = F.a->in[3] + l * 192; const float* kn = F.a->in[4] + l * 192;
    const int lane = F.lane, g = lane >> 3, c = lane & 7;
    float gq0[8], gq1[8], gq2[8], gk3[8], gk2[8];
#pragma unroll
    for (int j = 0; j < 8; ++j) { gq0[j] = qn[8 * c + j]; gq1[j] = qn[64 + 8 * c + j]; gq2[j] = qn[128 + 8 * c + j]; gk2[j] = kn[128 + 8 * c + j];
        gk3[j] = (g >> 1) == 0 ? kn[8 * c + j] : ((g >> 1) == 1 ? kn[64 + 8 * c + j] : kn[128 + 8 * c + j]); }
    bf16* zq = (bf16*)(F.ws + WS_ZQ); bf16* zkv = (bf16*)(F.ws + WS_ZKV);
    const float* cst = (const float*)(F.ws + WS_COS); const float* snt = (const float*)(F.ws + WS_SIN);
#pragma unroll 1
    for (int m = F.gw; m < M; m += F.NGW) {
        const int t = m & (SEQ - 1), b = m >> 12;
        float cs[8], sn[8];
        { const GAS f32x4* cp = (const GAS f32x4*)(cst + t * 32 + 8 * (c & 3)); const GAS f32x4* sp = (const GAS f32x4*)(snt + t * 32 + 8 * (c & 3));
          const f32x4 c0 = cp[0], c1 = cp[1], s0 = sp[0], s1 = sp[1];
          cs[0] = c0[0]; cs[1] = c0[1]; cs[2] = c0[2]; cs[3] = c0[3]; cs[4] = c1[0]; cs[5] = c1[1]; cs[6] = c1[2]; cs[7] = c1[3];
          sn[0] = s0[0]; sn[1] = s0[1]; sn[2] = s0[2]; sn[3] = s0[3]; sn[4] = s1[0]; sn[5] = s1[1]; sn[6] = s1[2]; sn[7] = s1[3]; }
        bf16* pqa = zq + (size_t)m * 512 + lane * 8; bf16* pqb = pqa + (size_t)M * 512; bf16* pqc = pqa + (size_t)2 * M * 512;
        const int t3 = (g >> 1) < 2 ? (g >> 1) : (g >> 1) + 1;
        bf16* p3 = zkv + (size_t)t3 * M * 256 + (size_t)m * 256 + (g & 1) * 64 + c * 8;
        const bf16* s4 = g < 4 ? zkv + (size_t)2 * M * 256 + (size_t)m * 256 + g * 64 + c * 8 : zkv + (size_t)5 * M * 256 + (size_t)m * 256 + (g - 4) * 64 + c * 8;
        bf16* d4 = g < 2 ? (bf16*)(F.ws + WS_KC2) + ((size_t)(b * 2 + g) * SEQ + t) * 64 + c * 8
                 : (g < 4 ? (bf16*)(F.ws + WS_VC2) + ((size_t)(b * 2 + (g - 2)) * SEQ + t) * 64 + c * 8 : (bf16*)s4);
        const bf16* p5 = zkv + (size_t)6 * M * 256 + (size_t)m * 256 + c * 8;
        bf16* d5 = (bf16*)(F.ws + WS_IKF) + ((size_t)(b * (SEQ / 32) + (t >> 5)) * 8 + c) * 256 + (t & 31) * 8;
        const u32x4_t r0 = *(const GAS u32x4_t*)pqa, r1 = *(const GAS u32x4_t*)pqb, r2 = *(const GAS u32x4_t*)pqc, r3 = *(const GAS u32x4_t*)p3, r4 = *(const GAS u32x4_t*)s4;
        u32x4_t r5;
        { const int cg = (g == 1 && c < 4) ? 8 + c : c;
          const float* pp = (const float*)(F.ws + WS_PART) + (size_t)m * 96 + cg * 8;
          f32x4 s0 = *(const GAS f32x4*)pp, s1 = *(const GAS f32x4*)(pp + 4);
#pragma unroll
          for (int kq = 1; kq < 4; ++kq) { s0 += *(const GAS f32x4*)(pp + (size_t)kq * M * 96); s1 += *(const GAS f32x4*)(pp + (size_t)kq * M * 96 + 4); }
          const float rs = pg8::row_rstd((const float*)(F.ws + WS_SSQ), m);
          r5.x = pk2(s0[0] * rs, s0[1] * rs); r5.y = pk2(s0[2] * rs, s0[3] * rs); r5.z = pk2(s1[0] * rs, s1[1] * rs); r5.w = pk2(s1[2] * rs, s1[3] * rs);
          if (g == 1 && c < 4 && !dry) *(GAS u32x4_t*)(zkv + (size_t)6 * M * 256 + (size_t)m * 256 + 64 + c * 8) = r5; }
        post_group(r0, !dry, true, true, gq0, C2, cs, sn, lane, pqa);
        post_group(r1, !dry, true, true, gq1, C2, cs, sn, lane, pqb);
        post_group(r2, !dry, true, true, gq2, C2, cs, sn, lane, pqc);
        post_group(r3, !dry, true, true, gk3, 1.f, cs, sn, lane, p3);
        post_group(r4, !dry, g < 2, g < 2 || g >= 4, gk2, 1.f, cs, sn, lane, d4);
        post_group(r5, g == 0 && !dry, false, true, gk2, 1.f, cs, sn, lane, d5);
    }
}

#define WAVE_LDS_FENCE() asm volatile("s_waitcnt lgkmcnt(0)" ::: "memory")
__device__ __forceinline__ int next_unit(Frame& F, gu32* counter) {
    LAS int* slot = (LAS int*)(F.lds + LDS_UNIT);
    __syncthreads();
    if (F.tid == 0) *slot = (int)__hip_atomic_fetch_add(counter, 1u, RLX_AGENT);
    __syncthreads();
    return *slot;
}
__device__ __forceinline__ unsigned f2key(float f) { const unsigned u = __float_as_uint(f); return (u & 0x80000000u) ? ~u : (u | 0x80000000u); }
__device__ __forceinline__ float dpp_quad_sum(float v) {
    v += __int_as_float(__builtin_amdgcn_update_dpp(0, __float_as_int(v), 0xB1, 0xF, 0xF, true));
    v += __int_as_float(__builtin_amdgcn_update_dpp(0, __float_as_int(v), 0x4E, 0xF, 0xF, true));
    return v;
}
__device__ __forceinline__ void radix_select_list(LAS const unsigned* list, int nblk, int k, LAS unsigned* hist, int lane, unsigned& T, int& need) {
    typedef unsigned u32x4_ __attribute__((ext_vector_type(4)));
    unsigned prefix = 0u; int kk = k;
#pragma unroll 1
    for (int pass = 0; pass < 4; ++pass) {
        const int shift = 24 - 8 * pass;
#pragma unroll
        for (int i = 0; i < 4; ++i) hist[lane * 4 + i] = 0u;
        WAVE_LDS_FENCE();
#pragma unroll 2
        for (int jb = 0; jb < nblk; ++jb) { const u32x4_ v = *(LAS const u32x4_*)(list + jb * 256 + lane * 4);
#pragma unroll
            for (int c = 0; c < 4; ++c) { const unsigned key = v[c];
                const unsigned bin = (pass == 0 || (key >> (shift + 8)) == prefix) ? ((key >> shift) & 255u) : 256u + (unsigned)lane;
                __hip_atomic_fetch_add(&hist[bin], 1u, __ATOMIC_RELAXED, __HIP_MEMORY_SCOPE_WORKGROUP); } }
        WAVE_LDS_FENCE();
        const unsigned h0 = hist[lane * 4], h1 = hist[lane * 4 + 1], h2 = hist[lane * 4 + 2], h3 = hist[lane * 4 + 3];
        const int tot4 = (int)(h0 + h1 + h2 + h3);
        int pre = tot4;
        pre += __builtin_amdgcn_update_dpp(0, pre, 0x111, 0xf, 0xf, false);
        pre += __builtin_amdgcn_update_dpp(0, pre, 0x112, 0xf, 0xf, false);
        pre += __builtin_amdgcn_update_dpp(0, pre, 0x114, 0xf, 0xf, false);
        pre += __builtin_amdgcn_update_dpp(0, pre, 0x118, 0xf, 0xf, false);
        pre += __builtin_amdgcn_update_dpp(0, pre, 0x142, 0xa, 0xf, false);
        pre += __builtin_amdgcn_update_dpp(0, pre, 0x143, 0xc, 0xf, false);
        const int total = __builtin_amdgcn_readlane(pre, 63);
        const int above = total - pre;
        const int a3 = above, a2 = a3 + (int)h3, a1 = a2 + (int)h2, a0 = a1 + (int)h1;
        int dsel = -1, nk = 0;
        if (a3 < kk && kk <= a3 + (int)h3) { dsel = lane * 4 + 3; nk = kk - a3; }
        else if (a2 < kk && kk <= a2 + (int)h2) { dsel = lane * 4 + 2; nk = kk - a2; }
        else if (a1 < kk && kk <= a1 + (int)h1) { dsel = lane * 4 + 1; nk = kk - a1; }
        else if (a0 < kk && kk <= a0 + (int)h0) { dsel = lane * 4 + 0; nk = kk - a0; }
        const unsigned long long bal = __ballot(dsel >= 0);
        const int src = (int)__builtin_ctzll(bal);
        dsel = __builtin_amdgcn_readlane(dsel, src); nk = __builtin_amdgcn_readlane(nk, src);
        WAVE_LDS_FENCE();
        prefix = (prefix << 8) | (unsigned)dsel; kk = nk;
    }
    T = prefix; need = kk;
}
__device__ __forceinline__ void select_unit(Frame& F, int b, int qblk, int abl = 0) {
    using namespace att;
    int tid_ = F.tid; asm volatile("" : "+v"(tid_));
    const int lane = tid_ & 63, r32 = lane & 31, hi = lane >> 5, w = F.wave;
    LAS unsigned* sc = (LAS unsigned*)F.lds;
    LAS unsigned* hist = (LAS unsigned*)(F.lds + 131072) + w * 320;
    LAS unsigned* cand = (LAS unsigned*)(F.lds + 131072 + 10240) + w * 512;
    const int t0 = qblk * 8; const size_t m0 = (size_t)b * SEQ + t0;
    const bf16* IQ = (const bf16*)(F.ws + WS_ZKV) + (size_t)5 * M * 256; const bf16* MISC = (const bf16*)(F.ws + WS_ZKV) + (size_t)6 * M * 256;
    const bf16* IKF = (const bf16*)(F.ws + WS_IKF) + (size_t)b * SEQ * 64;
    u64* BM = (u64*)(F.ws + WS_BM);
    const int nkeys = t0 + 8;
    if (nkeys > 256 && abl < 2) {
        bf16x8 iqf[4];
        { const bf16* qrow = IQ + (m0 + (r32 >> 2)) * 256 + (r32 & 3) * 64;
#pragma unroll
          for (int d0 = 0; d0 < 4; ++d0) iqf[d0] = *(const GAS bf16x8*)(qrow + d0 * 16 + hi * 8); }
        const float wl = bf2f(((const GAS bf16*)MISC)[(m0 + (r32 >> 2)) * 256 + 64 + (r32 & 3)]);
        const int ntile = (nkeys + 31) >> 5; const int g = r32 & 3;
#pragma unroll 1
        for (int tile0 = w; tile0 < ntile; tile0 += 16) {
            bf16x8 kf[2][4];
#pragma unroll
            for (int u = 0; u < 2; ++u) { const int tile = tile0 + 8 * u < ntile ? tile0 + 8 * u : tile0;
                const bf16* kt = IKF + (size_t)tile * 2048 + hi * 256 + r32 * 8;
#pragma unroll
                for (int d0 = 0; d0 < 4; ++d0) kf[u][d0] = *(const GAS bf16x8*)(kt + d0 * 512); }
#pragma unroll
            for (int u = 0; u < 2; ++u) { const int tile = tile0 + 8 * u;
                if (tile < ntile) {
                    const int s0 = tile * 32;
                    f32x16 acc;
#pragma unroll
                    for (int r = 0; r < 16; ++r) acc[r] = 0.f;
#pragma unroll
                    for (int d0 = 0; d0 < 4; ++d0) acc = __builtin_amdgcn_mfma_f32_32x32x16_bf16(kf[u][d0], iqf[d0], acc, 0, 0, 0);
                    float v[16];
#pragma unroll
                    for (int r = 0; r < 16; ++r) v[r] = dpp_quad_sum(__builtin_amdgcn_fmed3f(acc[r], 0.f, __builtin_inff()) * wl);
                    u32x4 o;
#pragma unroll
                    for (int j = 0; j < 4; ++j) o[j] = f2key(g == 0 ? v[j] : (g == 1 ? v[4 + j] : (g == 2 ? v[8 + j] : v[12 + j])));
                    *(LAS u32x4*)(sc + (r32 >> 2) * 4096 + s0 + 8 * g + 4 * hi) = o;
                } }
        }
    }
    __syncthreads();
    if (abl != 1) {
        const int t = t0 + w, n = t + 1; LAS unsigned* row = sc + w * 4096;
        u64 myword = 0ull;
        if (n <= 256) {
            const int c0 = 64 * lane;
            myword = (c0 + 63 < n) ? ~0ull : (c0 >= n ? 0ull : ((1ull << (n - c0)) - 1ull));
        } else {
            const int nblk = (n + 255) >> 8;
            { const int s = (n & ~3) + lane * 4;
              if (s < nblk * 256) { u32x4 v = *(LAS u32x4*)(row + s);
#pragma unroll
                  for (int c = 0; c < 4; ++c) if (s + c >= n) v[c] = 0u;
                  *(LAS u32x4*)(row + s) = v; } }
            WAVE_LDS_FENCE();
            unsigned T = 0u; int need = 0; bool done = false;
            if (n > 512 && abl != 5) {
#pragma unroll
                for (int c = 0; c < 8; ++c) { const int i = lane + 64 * c; cand[i] = row[(i * n) >> 9]; }
                WAVE_LDS_FENCE();
                const float er = 131072.0f / (float)n;
                int rr = (int)(er + 2.5f * __builtin_sqrtf(er * (1.0f - 256.0f / (float)n)) + 2.0f); rr = rr > 512 ? 512 : rr;
                unsigned P; int dummy; radix_select_list(cand, 2, rr, hist, lane, P, dummy);
                int C = 0; bool ovf = false;
#pragma unroll 1
                for (int jb = 0; jb < nblk; ++jb) { const u32x4 v = *(LAS const u32x4*)(row + jb * 256 + lane * 4);
#pragma unroll
                    for (int c = 0; c < 4; ++c) { const bool in = v[c] > P; const u64 bal = __ballot(in); const int pos = C + __builtin_popcountll(bal & ((1ull << lane) - 1ull));
                        C += __builtin_popcountll(bal); if (C > 512) ovf = true;
                        if (in && !ovf) cand[pos] = v[c]; } }
                if (!ovf && C >= 256) {
                    WAVE_LDS_FENCE();
                    const int cb = (C + 255) >> 8;
                    { const int s = C + lane; if (s < cb * 256) cand[s] = 0u; const int s2 = s + 64; if (s2 < cb * 256) cand[s2] = 0u; const int s3 = s + 128; if (s3 < cb * 256) cand[s3] = 0u; const int s4 = s + 192; if (s4 < cb * 256) cand[s4] = 0u; }
                    WAVE_LDS_FENCE();
                    radix_select_list(cand, cb, 256, hist, lane, T, need); done = true;
                }
            }
            if (!done && abl < 3) radix_select_list(row, nblk, 256, hist, lane, T, need);
            int base = 0;
            const int nch = abl >= 4 ? 0 : (n + 63) >> 6;
#pragma unroll 1
            for (int c = 0; c < nch; c += 4) {
                unsigned vv[4];
#pragma unroll
                for (int u2 = 0; u2 < 4; ++u2) vv[u2] = row[64 * (c + u2) + lane];
#pragma unroll
                for (int u2 = 0; u2 < 4; ++u2) {
                    const int s = 64 * (c + u2) + lane; const bool valid = s < n; const unsigned key = valid ? vv[u2] : 0u;
                    const bool gt = valid && key > T, eq = valid && key == T;
                    const u64 beq = __ballot(eq);
                    const int rank = base + __builtin_popcountll(beq & ((1ull << lane) - 1ull));
                    const u64 word = __ballot(gt || (eq && rank < need));
                    if (lane == c + u2) myword = word;
                    base += __builtin_popcountll(beq);
                }
            }
        }
        if (abl >= 2) ((GAS u64*)(F.ws + WS_MB + 24 * MiB))[((size_t)b * SEQ + t) * 64 + lane] = myword;
        else ((GAS u64*)BM)[((size_t)b * SEQ + t) * 64 + lane] = myword;
    }
    __syncthreads();
}
__device__ __forceinline__ void compress_unit(Frame& F, int l, int u) {
    using namespace att;
    int tid_ = F.tid; asm volatile("" : "+v"(tid_));
    const int lane = tid_ & 63, r32 = lane & 31, hi = lane >> 5, w = F.wave;
    const int which = u & 1, h = (u >> 1) & 1, b = (u >> 2) & 3, cb = u >> 4;
    const bf16* src = (const bf16*)(F.ws + (which ? WS_VC2 : WS_KC2)) + (size_t)(b * 2 + h) * SEQ * 64;
    const bf16* W1t = (const bf16*)(F.ws + WS_W + (size_t)l * W_LAYER + (which ? W_CV1 : W_CK1));
    const bf16* W2t = (const bf16*)(F.ws + WS_W2) + (size_t)(l * 2 + which) * 64 * 256;
    const float* b1p = (const float*)(F.ws + WS_B1P) + (size_t)(l * 2 + which) * 8 * 256;
    LAS bf16* hid = (LAS bf16*)F.lds;
    int cc = 32 * cb + r32; if (cc > 254) cc = 254;
    const bf16* arow = src + (size_t)(16 * cc) * 64 + hi * 8;
    const bf16* brow = W1t + (size_t)(32 * w + r32) * 2048 + hi * 8;
    f32x16 acc;
#pragma unroll
    for (int r = 0; r < 16; ++r) acc[r] = 0.f;
#pragma unroll 4
    for (int ks = 0; ks < 128; ++ks) { const bf16x8 a = *(const GAS bf16x8*)(arow + ks * 16), bb = *(const GAS bf16x8*)(brow + ks * 16); acc = __builtin_amdgcn_mfma_f32_32x32x16_bf16(a, bb, acc, 0, 0, 0); }
    float b1 = 0.f;
#pragma unroll
    for (int kp = 0; kp < 8; ++kp) b1 += ((const GAS float*)b1p)[kp * 256 + 32 * w + r32];
#pragma unroll
    for (int r = 0; r < 16; ++r) hid[crow(r, hi) * 264 + 32 * w + r32] = (bf16)f2bf(fmaxf(acc[r] + b1, 0.f));
    __syncthreads();
    if (w < 2) {
        f32x16 o;
#pragma unroll
        for (int r = 0; r < 16; ++r) o[r] = 0.f;
        const bf16* w2row = W2t + (size_t)(32 * w + r32) * 256 + hi * 8;
#pragma unroll
        for (int ks = 0; ks < 16; ++ks) { const bf16x8 a = *(LAS const bf16x8*)(hid + r32 * 264 + ks * 16 + hi * 8), bb = *(const GAS bf16x8*)(w2row + ks * 16); o = __builtin_amdgcn_mfma_f32_32x32x16_bf16(a, bb, o, 0, 0, 0); }
        bf16* dst = (bf16*)(F.ws + WS_KCMP) + ((size_t)((which * 4 + b) * 2 + h) * 256) * 64;
        float mx = 0.f;
#pragma unroll
        for (int r = 0; r < 16; ++r) { const int c = 32 * cb + crow(r, hi); const float v = c < 255 ? o[r] : 0.f; mx = fmaxf(mx, fabsf(v)); ((GAS bf16*)dst)[(size_t)c * 64 + 32 * w + r32] = (bf16)f2bf(v); }
        if (which == 0) { mx = wave_max(mx); if (lane == 0) __hip_atomic_fetch_max(F.ctl + CW_KMAX + 64 * (l * 8 + b * 2 + h), __float_as_uint(mx), RLX_AGENT); }
    }
    __syncthreads();
}
__device__ __forceinline__ void misc_phase(Frame& F, int l, int mode = 0) {
    using namespace att;
    int tid_ = F.tid; asm volatile("" : "+v"(tid_));
    const int lane = tid_ & 63, r32 = lane & 31, hi = lane >> 5, w = F.wave;
    if (w >= 6) return;
    const int task = (int)blockIdx.x * 6 + w, tile = task / 3, cb = task % 3;
    const bf16* arow = (const bf16*)(F.ws + WS_XB) + (size_t)(tile * 32 + r32) * 1024 + hi * 32;
    const bf16* brow = (const bf16*)(F.ws + WS_W + (size_t)l * W_LAYER + W_IN) + (size_t)(3072 + cb * 32 + r32) * 1024 + hi * 32;
    f32x16 acc;
#pragma unroll
    for (int r = 0; r < 16; ++r) acc[r] = 0.f;
#pragma unroll 1
    for (int it = 0; it < (mode == 1 ? 0 : 4); ++it) { const int lb = (it + w + (int)blockIdx.x) & 3;
        bf16x8 af[16], bfr[16];
#pragma unroll
        for (int i = 0; i < 16; ++i) { af[i] = *(const GAS bf16x8*)(arow + lb * 256 + (i >> 2) * 64 + (i & 3) * 8); bfr[i] = *(const GAS bf16x8*)(brow + lb * 256 + (i >> 2) * 64 + (i & 3) * 8); }
        __builtin_amdgcn_sched_barrier(0);
#pragma unroll
        for (int i = 0; i < 16; ++i) acc = __builtin_amdgcn_mfma_f32_32x32x16_bf16(af[i], bfr[i], acc, 0, 0, 0);
        __builtin_amdgcn_sched_barrier(0);
    }
    const float rv = pg8::row_rstd((const float*)(F.ws + WS_SSQ), tile * 32 + r32);
    bf16* dst = (bf16*)(F.ws + (mode ? WS_MB + 24 * MiB : WS_ZKV + (size_t)6 * M * 256 * 2)) + (size_t)(tile * 32) * 256 + cb * 32;
    LAS unsigned short* tp = (LAS unsigned short*)(F.lds + w * 4096);
#pragma unroll
    for (int r = 0; r < 16; ++r) { const int row = crow(r, hi); const float rs = __shfl(rv, row); tp[row * 40 + r32] = (unsigned short)f2bf(acc[r] * rs); }
    WAVE_LDS_FENCE();
#pragma unroll
    for (int u = 0; u < 2; ++u) { const int pc = lane + 64 * u, row = pc >> 2, q = pc & 3;
        const u32x4 v = *(LAS const u32x4*)(tp + row * 40 + q * 8);
        *(GAS u32x4*)(dst + (size_t)row * 256 + q * 8) = v; }
    WAVE_LDS_FENCE();
}
struct UnitGeom { int b, kvh, i; att::Lane L; int q; int head; size_t mrow; };
__device__ __forceinline__ UnitGeom unit_geom(Frame& F, int b, int kvh, int i) {
    int tid = F.tid; asm volatile("" : "+v"(tid));
    UnitGeom U; U.b = b; U.kvh = kvh; U.i = i; U.L.tid = tid; U.L.lane = tid & 63; U.L.r32 = tid & 31; U.L.hi = (tid >> 5) & 1; U.L.wid = F.wave;
    U.q = 64 * i + 8 * F.wave + (U.L.r32 >> 2); U.head = 4 * kvh + (U.L.r32 & 3); U.mrow = (size_t)b * SEQ + U.q; return U;
}
__device__ __forceinline__ void branch_finish(LAS float* wsf, const att::f32x16& ol, const float (&extra)[4], float rowscale, bool has_scale, const att::f32x16 (&o)[2], att::f32x16 (&acc)[2], const att::Lane& L, bool first) {
    float sc[16];
    if (has_scale) att::rows_to_regs(wsf, rowscale, L.r32, L.hi, sc);
#pragma unroll
    for (int r = 0; r < 16; ++r) { const float lf = ol[r] + extra[r & 3]; const float inv = lf > 0.f ? __builtin_amdgcn_rcpf(lf) : 0.f; sc[r] = has_scale ? sc[r] * inv : inv; }
#pragma unroll
    for (int d0 = 0; d0 < 2; ++d0)
#pragma unroll
        for (int r = 0; r < 16; ++r) acc[d0][r] = first ? o[d0][r] * sc[r] : acc[d0][r] + o[d0][r] * sc[r];
}
__device__ __forceinline__ void branch_finish_lds(LAS float* wsf, LAS float* accw, const att::f32x16& ol, float rowscale, const att::f32x16 (&o)[2], const att::Lane& L, bool first) {
    float sc[16]; att::rows_to_regs(wsf, rowscale, L.r32, L.hi, sc);
#pragma unroll
    for (int r = 0; r < 16; ++r) sc[r] = ol[r] > 0.f ? sc[r] * __builtin_amdgcn_rcpf(ol[r]) : 0.f;
#pragma unroll
    for (int d0 = 0; d0 < 2; ++d0)
#pragma unroll
        for (int r = 0; r < 16; ++r) { float v = o[d0][r] * sc[r]; if (!first) v += accw[(d0 * 16 + r) * 64 + L.lane]; accw[(d0 * 16 + r) * 64 + L.lane] = v; }
}
__device__ __forceinline__ float gain_bound(const float* g, int lane) { return wave_max(fabsf(g[lane])); }

template <int KIND  >
__device__ __forceinline__ void simple_unit(Frame& F, int l, int b, int kvh, int i, bf16* odst = nullptr) {
    using namespace att;
    const UnitGeom U = unit_geom(F, b, kvh, i); const Lane& L = U.L;
    constexpr int QT = KIND == 0 ? 1 : 0, KT = KIND == 0 ? 1 : 0, NM = KIND == 0 ? 1 : 0;
    bf16* Q = (bf16*)(F.ws + WS_ZQ) + (size_t)QT * M * 512; const bf16* KV = (const bf16*)(F.ws + WS_ZKV) + (size_t)KT * M * 256;
    bf16x8 qr[4]; load_q(Q + U.mrow * 512 + U.head * 64, L.hi, qr);
    const float C = 0.f; (void)NM;
    KVSrc S{(const GAS bf16*)(KV + (size_t)b * SEQ * 256 + kvh * 64), (const GAS bf16*)(KV + (size_t)b * SEQ * 256 + 128 + kvh * 64), 256, SEQ};
    f32x16 ol, o[2];
#pragma unroll
    for (int r = 0; r < 16; ++r) { o[0][r] = 0.f; o[1][r] = 0.f; ol[r] = 0.f; }
    const int q = U.q;
    if (KIND == 0) {
        auto mf = [q](int t) -> u64 { return mask_le(q - 64 * t) & mask_ge(q - 127 - 64 * t); };
        attend_range((LAS char*)F.lds, S, i - 2 < 0 ? 0 : i - 2, i + 1, mf, qr, -C, ol, o, L);
    } else {
        LAS char* mrows = (LAS char*)F.lds + L_OST + L.wid * 8192 + 4096;
        { const GAS u32x4* src = (const GAS u32x4*)((const GAS u64*)(F.ws + WS_BM) + ((size_t)b * SEQ + 64 * i + 8 * L.wid) * 64);
#pragma unroll
          for (int k = 0; k < 4; ++k) *(LAS u32x4*)(mrows + (k * 64 + L.lane) * 16) = src[k * 64 + L.lane];
          WAVE_LDS_FENCE(); }
        LAS const char* mrow = mrows + (L.r32 >> 2) * 512;
        auto mf = [mrow](int t) -> u64 { return *(LAS const u64*)(mrow + t * 8); };
#ifdef PROBE_TILES
        attend_range((LAS char*)F.lds, S, 0, odst ? (i + 1 < PROBE_TILES ? i + 1 : PROBE_TILES) : i + 1, mf, qr, -C, ol, o, L, odst != nullptr);
#else
        attend_range((LAS char*)F.lds, S, 0, i + 1, mf, qr, -C, ol, o, L, odst != nullptr);
#endif
    }
    const UnitGeom V = unit_geom(F, b, kvh, i); const Lane& L2 = V.L;
    float extra[4] = {0.f, 0.f, 0.f, 0.f};
    if (KIND == 0) {
#pragma unroll
        for (int g = 0; g < 4; ++g) extra[g] = __builtin_amdgcn_exp2f(F.a->in[5][l * 8 + 4 * kvh + g] * LOG2E);
    }
    f32x16 acc[2];
    branch_finish((LAS float*)((LAS char*)F.lds + L_WSF) + L2.wid * WSF_W, ol, extra, 1.f, false, o, acc, L2, true);
    bf16* Q2 = (bf16*)(F.ws + WS_ZQ) + (size_t)QT * M * 512;
    const size_t tok0 = (size_t)b * SEQ + 64 * i + 8 * L2.wid; const int kvh4 = 4 * kvh;
    bf16* Od = odst ? odst : Q2;
    auto rowptr = [Od, tok0, kvh4](int row) -> bf16* { return Od + (tok0 + (row >> 2)) * 512 + (kvh4 + (row & 3)) * 64; };
    store_o((LAS char*)F.lds + L_OST + L2.wid * 8192, acc, rowptr, L2.lane, L2.r32, L2.hi);
}
__device__ __forceinline__ void nsa_unit(Frame& F, int l, int b, int kvh, int i, bf16* odst = nullptr) {
    using namespace att;
    f32x16 o[2], ol;
    bf16x8 qr[4];
    {
        const UnitGeom U = unit_geom(F, b, kvh, i); const Lane& L = U.L;
        const bf16* Q = (const bf16*)(F.ws + WS_ZQ) + (size_t)2 * M * 512; const bf16* MISC = (const bf16*)(F.ws + WS_ZKV) + (size_t)6 * M * 256;
        load_q(Q + U.mrow * 512 + U.head * 64, L.hi, qr);
        LAS float* wsf = (LAS float*)((LAS char*)F.lds + L_WSF) + L.wid * WSF_W;
#pragma unroll
        for (int br = 0; br < 3; ++br) wsf[64 + br * 64 + L.lane] = pg8::sigmoidf_(bf2f(((const GAS bf16*)MISC)[U.mrow * 256 + 68 + U.head * 3 + br]));
        WAVE_LDS_FENCE();
    }
    const float Ck = 0.f, Cc = 0.f;
    const int qmax = 64 * i + 63; const int nvmax = qmax >= 31 ? (((qmax - 31) >> 4) + 1 < 255 ? ((qmax - 31) >> 4) + 1 : 255) : 0;
    const int tc = (nvmax + 63) >> 6;
    const bf16* kcmp = (const bf16*)(F.ws + WS_KCMP) + (size_t)((0 * 4 + b) * 2 + kvh) * 256 * 64; const bf16* vcmp = (const bf16*)(F.ws + WS_KCMP) + (size_t)((1 * 4 + b) * 2 + kvh) * 256 * 64;
    {
        const UnitGeom U = unit_geom(F, b, kvh, i); const Lane& L = U.L; const int q = U.q;
        const int nval = q >= 31 ? (((q - 31) >> 4) + 1 < 255 ? ((q - 31) >> 4) + 1 : 255) : 0;
        KVSrc Sc{(const GAS bf16*)kcmp, (const GAS bf16*)vcmp, 64, 256};
        auto mfc = [nval](int t) -> u64 { return mask_le(nval - 1 - 64 * t); };
#pragma unroll
        for (int r = 0; r < 16; ++r) { o[0][r] = 0.f; o[1][r] = 0.f; ol[r] = 0.f; }
        attend_range((LAS char*)F.lds, Sc, 0, tc, mfc, qr, -Cc, ol, o, L);
    }
    const UnitGeom U = unit_geom(F, b, kvh, i); const Lane& L = U.L; const int q = U.q;
    LAS float* wsf = (LAS float*)((LAS char*)F.lds + L_WSF) + L.wid * WSF_W;
    LAS float* accw = (LAS float*)((LAS char*)F.lds + L_OST + L.wid * 8192);
    const int nval = q >= 31 ? (((q - 31) >> 4) + 1 < 255 ? ((q - 31) >> 4) + 1 : 255) : 0;
    auto mfc = [nval](int t) -> u64 { return mask_le(nval - 1 - 64 * t); };
    WAVE_LDS_FENCE();
    if (L.r32 == 0) {
#pragma unroll
        for (int r = 0; r < 16; ++r) wsf[32 + crow(r, L.hi)] = ol[r]; }
    WAVE_LDS_FENCE();
    const float lc = wsf[32 + L.r32]; const float rlc = lc > 0.f ? __builtin_amdgcn_rcpf(lc) : 0.f;
    branch_finish_lds(wsf, accw, ol, wsf[64 + L.lane], o, L, true);
    LAS float* impw = (LAS float*)((LAS char*)F.lds + L_IMP) + L.wid * 512;
#pragma unroll
    for (int k = 0; k < 8; ++k) impw[L.lane + 64 * k] = 0.f;
    WAVE_LDS_FENCE();
    for (int t = 0; t < tc; ++t) {
        f32x16 p0, p1;
#pragma unroll
        for (int r = 0; r < 16; ++r) { p0[r] = 0.f; p1[r] = 0.f; }
        qk_tile((LAS char*)F.lds + L_K0 + t * 8320, qr, p0, p1, L.r32, L.hi);
        const u64 mk = mfc(t); const unsigned m0 = (unsigned)(mk >> (4 * L.hi)), m1 = (unsigned)(mk >> (32 + 4 * L.hi));
        const int qloc = L.r32 >> 2; const bool wr = (L.r32 & 3) == 0;
#pragma unroll
        for (int half = 0; half < 2; ++half)
#pragma unroll
            for (int m = 0; m < 4; ++m) {
                float e[4];
#pragma unroll
                for (int k = 0; k < 4; ++k) { const int r = 4 * m + k, bit = k + 8 * m; const float x = half ? p1[r] : p0[r]; const unsigned mm = half ? m1 : m0;
                    e[k] = ((mm >> bit) & 1u) ? __builtin_amdgcn_exp2f(x) * rlc : 0.f; }
                const float core = dpp_quad_sum((e[0] + e[1]) + (e[2] + e[3])), edge = dpp_quad_sum(e[3]);
                const int j = 16 * t + 8 * half + 2 * m + L.hi;
                if (wr) { impw[qloc * 64 + j] += core; }
                WAVE_LDS_FENCE();
                if (wr && j + 1 < 64) { impw[qloc * 64 + j + 1] += edge; }
                WAVE_LDS_FENCE();
            }
    }
    __syncthreads();
    {
        const int qloc = L.lane >> 3, sub = L.lane & 7; const int cur = i;
        u64 keys[8];
#pragma unroll
        for (int k = 0; k < 8; ++k) { const int j = sub + 8 * k; float v = impw[qloc * 64 + j];
            if (j == 0 || j == cur || j == cur - 1) v = 1e9f;
            if (j > cur) v = -1e30f;
            keys[k] = ((u64)f2key(v) << 32) | (u64)(63 - j); }
        u64 selm = 0ull; unsigned used = 0u;
#pragma unroll 1
        for (int it = 0; it < 16; ++it) {
            u64 best = 0ull;
#pragma unroll
            for (int k = 0; k < 8; ++k) { const u64 c = ((used >> k) & 1u) ? 0ull : keys[k]; best = c > best ? c : best; }
#pragma unroll
            for (int o2 = 1; o2 < 8; o2 <<= 1) { const unsigned lo = __shfl_xor((unsigned)best, o2), hi2 = __shfl_xor((unsigned)(best >> 32), o2); const u64 ob = ((u64)hi2 << 32) | lo; best = ob > best ? ob : best; }
            const int jsel = 63 - (int)(best & 63ull);
            if ((jsel & 7) == sub) used |= 1u << (jsel >> 3);
            selm |= 1ull << jsel;
        }
        LAS u64* selw = (LAS u64*)((LAS char*)F.lds + L_SEL) + L.wid * 8;
        if (sub == 0) selw[qloc] = selm;
        WAVE_LDS_FENCE();
    }
    {
        const UnitGeom X = unit_geom(F, b, kvh, i); const Lane& L = X.L; const int q = X.q;
        const u64 sel = ((LAS const u64*)((LAS char*)F.lds + L_SEL))[L.wid * 8 + (L.r32 >> 2)];
        const bf16* KV = (const bf16*)(F.ws + WS_ZKV) + (size_t)3 * M * 256;
        KVSrc S{(const GAS bf16*)(KV + (size_t)b * SEQ * 256 + kvh * 64), (const GAS bf16*)(KV + (size_t)b * SEQ * 256 + 128 + kvh * 64), 256, SEQ};
        auto mf = [sel, q](int t) -> u64 { return ((sel >> t) & 1ull) ? mask_le(q - 64 * t) : 0ull; };
#pragma unroll
        for (int r = 0; r < 16; ++r) { o[0][r] = 0.f; o[1][r] = 0.f; ol[r] = 0.f; }
        attend_range((LAS char*)F.lds, S, 0, i + 1, mf, qr, -Ck, ol, o, L);
        const UnitGeom W = unit_geom(F, b, kvh, i); LAS float* wsf2 = (LAS float*)((LAS char*)F.lds + L_WSF) + W.L.wid * WSF_W;
        branch_finish_lds(wsf2, (LAS float*)((LAS char*)F.lds + L_OST + W.L.wid * 8192), ol, wsf2[128 + W.L.lane], o, W.L, false);
    }
    {
        const UnitGeom X = unit_geom(F, b, kvh, i); const Lane& L = X.L; const int q = X.q;
        const bf16* KV = (const bf16*)(F.ws + WS_ZKV) + (size_t)4 * M * 256;
        KVSrc S{(const GAS bf16*)(KV + (size_t)b * SEQ * 256 + kvh * 64), (const GAS bf16*)(KV + (size_t)b * SEQ * 256 + 128 + kvh * 64), 256, SEQ};
        auto mf = [q](int t) -> u64 { return mask_le(q - 64 * t) & mask_ge(q - 511 - 64 * t); };
#pragma unroll
        for (int r = 0; r < 16; ++r) { o[0][r] = 0.f; o[1][r] = 0.f; ol[r] = 0.f; }
        attend_range((LAS char*)F.lds, S, i - 8 < 0 ? 0 : i - 8, i + 1, mf, qr, -Ck, ol, o, L);
        const UnitGeom W = unit_geom(F, b, kvh, i); LAS float* wsf2 = (LAS float*)((LAS char*)F.lds + L_WSF) + W.L.wid * WSF_W;
        branch_finish_lds(wsf2, (LAS float*)((LAS char*)F.lds + L_OST + W.L.wid * 8192), ol, wsf2[192 + W.L.lane], o, W.L, false);
    }
    {
        const UnitGeom X = unit_geom(F, b, kvh, i); const Lane& L = X.L;
        LAS float* accw2 = (LAS float*)((LAS char*)F.lds + L_OST + L.wid * 8192);
        const size_t tok0 = (size_t)b * SEQ + 64 * i + 8 * L.wid; const int kvh4 = 4 * kvh;
        bf16* Od = odst ? odst : (bf16*)(F.ws + WS_ZQ) + (size_t)2 * M * 512;
        auto rowptr = [Od, tok0, kvh4](int row) -> bf16* { return Od + (tok0 + (row >> 2)) * 512 + (kvh4 + (row & 3)) * 64; };
        f32x16 acc[2];
#pragma unroll
        for (int d0 = 0; d0 < 2; ++d0)
#pragma unroll
            for (int r = 0; r < 16; ++r) acc[d0][r] = accw2[(d0 * 16 + r) * 64 + L.lane];
        WAVE_LDS_FENCE();
        store_o((LAS char*)F.lds + L_OST + L.wid * 8192, acc, rowptr, L.lane, L.r32, L.hi);
    }
}

__global__ void __launch_bounds__(NWAVES * 64, 2) mk_fwd(Args args) {
    extern __shared__ __attribute__((aligned(16))) unsigned char lds_raw[];
    LAS unsigned char* lds = (LAS unsigned char*)lds_raw;
    volatile LAS unsigned* MISCW = (volatile LAS unsigned*)(lds + LDS_UNIT + 16);
    if (threadIdx.x < 8) MISCW[threadIdx.x] = 0u;
    __syncthreads();
    (void)xcd_barrier_post((unsigned*)((gu32*)(args.ws + WS_CTL) + CW_BAR), MISCW);
#define GRID_BARRIER() do { unsigned char* wsb_ = args.ws; asm volatile("" : "+s"(wsb_)); XcdBarrier bar_; bar_.bar = (unsigned*)((gu32*)(wsb_ + WS_CTL) + CW_BAR); bar_.x = xb_xcc_id(); \
    bar_.st = (volatile LAS unsigned*)(lds + LDS_UNIT + 16); xcd_barrier(bar_); } while (0)
#define MKFRAME() Frame F; { unsigned char* ws_ = args.ws; asm volatile("" : "+s"(ws_)); int tid_ = threadIdx.x; asm volatile("" : "+v"(tid_)); \
    F.lds = lds; F.tid = tid_; F.lane = tid_ & 63; F.wave = __builtin_amdgcn_readfirstlane(tid_ >> 6); F.G = gridDim.x; F.gw = 0; F.NGW = F.G * NWAVES; \
    F.ws = ws_; F.ctl = (gu32*)(ws_ + WS_CTL); F.a = &args; } int bid = blockIdx.x; asm volatile("" : "+s"(bid)); F.gw = bid * NWAVES + F.wave; \
    unsigned char* ws = F.ws; bf16* XB = (bf16*)(ws + WS_XB); bf16* MB = (bf16*)(ws + WS_MB); bf16* ZQ = (bf16*)(ws + WS_ZQ); bf16* ZKV = (bf16*)(ws + WS_ZKV); bf16* YS = (bf16*)(ws + WS_YS); bf16* HM = (bf16*)(ws + WS_HMID); \
    float* SSQ = (float*)(ws + WS_SSQ); (void)XB; (void)MB; (void)ZQ; (void)ZKV; (void)YS; (void)HM; (void)SSQ;
#define WL(l) (ws + WS_W + (size_t)(l) * W_LAYER)
#ifdef PROBE_T
#define STAMP(k) do { if (blockIdx.x == 0 && threadIdx.x == 0) ((unsigned long long*)(args.ws + WS_CTL + 96 * 1024))[k] = __builtin_amdgcn_s_memrealtime(); } while (0)
#else
#define STAMP(k) do { } while (0)
#endif

    STAMP(0);
#ifndef NO_P0
    { MKFRAME(); p0_prologue(F); }
#ifdef DBL_P0
    { MKFRAME(); p0_prologue(F); }
#endif
#endif
    GRID_BARRIER();
    STAMP(1);
#pragma unroll 1
    for (int l = 0; l < DEPTH; ++l) {
#ifndef NO_G1
#ifdef DBL_G1
        for (int rep_ = 0; rep_ < 2; ++rep_)
#endif
        {
            MKFRAME(); unsigned char* wl = WL(l);
            pg8::ProgG1 P; P.S.init(M, 3072, F.G, bid); P.spm = (bid & 7) * 8 + (bid >> 5); P.skq = (bid >> 3) & 3;
            P.xb = XB; P.win = (const bf16*)(wl + W_IN); P.zq = ZQ; P.zkv = ZKV; P.ssq = SSQ; P.part = (float*)(ws + WS_PART);
            pg8::gemm_chain<pg8::ProgG1, true>(F.lds, P);
        }
#endif
        GRID_BARRIER();
        STAMP(2 + 8 * l);
#ifndef NO_POST
        { MKFRAME(); post_phase(F, l); }
#ifdef DBL_POST
        { MKFRAME(); post_phase(F, l, true); }
#endif
#endif
        GRID_BARRIER();
        STAMP(3 + 8 * l);
#ifdef DBL_ATT1
        for (int rep1_ = 0; rep1_ < 2; ++rep1_)
#else
        const int rep1_ = 0;
#endif
        {
            MKFRAME();
            const int xcd = (int)(xb_xcc_id() & 7u);
#pragma unroll 1
            for (int qi = 0; qi < 8; ++qi) {
                const int x = (xcd + qi) & 7, b = x >> 1, sub = x & 1;
                gu32* ctr = F.ctl + CW_Q + 64 * ((2 * l + 4 * rep1_) * 8 + x);
                for (;;) { const int v = next_unit(F, ctr); if (v >= 16 + 256 + 64) break;
#ifdef DBL_ATT1
                    if (v < 16) { if (rep1_ == 0 || DBL_ATT1 == 1 || DBL_ATT1 == 2) compress_unit(F, l, (v & 1) | (sub << 1) | (b << 2) | ((v >> 1) << 4)); }
                    else if (v < 16 + 256) { if (rep1_ == 0 || DBL_ATT1 == 1 || DBL_ATT1 == 3 || DBL_ATT1 >= 5) select_unit(F, b, 2 * (255 - (v - 16)) + sub, rep1_ ? (DBL_ATT1 >= 5 ? DBL_ATT1 - 4 : 0) : 0  ); }
                    else if (rep1_ && DBL_ATT1 != 1 && DBL_ATT1 != 4) { }
#else
                    if (v < 16) { compress_unit(F, l, (v & 1) | (sub << 1) | (b << 2) | ((v >> 1) << 4)); }
                    else if (v < 16 + 256) { select_unit(F, b, 2 * (255 - (v - 16)) + sub); }
#endif
                    else { simple_unit<0>(F, l, b, sub, 63 - (v - 272), rep1_ ? (bf16*)(ws + WS_MB + 8 * MiB) : nullptr); }
                }
            }
        }
        GRID_BARRIER();
        STAMP(4 + 8 * l);
#ifdef DBL_ATT2
        for (int rep_ = 0; rep_ < 2; ++rep_)
#else
        const int rep_ = 0;
#endif
        {
            MKFRAME();
            bf16* od = rep_ ? (bf16*)(ws + WS_MB) : nullptr;
            const int xcd = (int)(xb_xcc_id() & 7u);
#pragma unroll 1
            for (int qi = 0; qi < 8; ++qi) {
                const int x = (xcd + qi) & 7, b = x >> 1, kvh = x & 1;
                gu32* ctr = F.ctl + CW_Q + 64 * ((2 * l + 1 + 4 * rep_) * 8 + x);
                for (;;) { const int v = next_unit(F, ctr); if (v >= 128) break;
                    const int i = 63 - (v >> 1);
#ifdef DBL_ATT2
                    if ((v & 1) && (rep_ == 0 || DBL_ATT2 != 3)) simple_unit<1>(F, l, b, kvh, i, od);
                    if (!(v & 1) && (rep_ == 0 || DBL_ATT2 != 2)) nsa_unit(F, l, b, kvh, i, od);
#else
                    if (v & 1) simple_unit<1>(F, l, b, kvh, i, od); else nsa_unit(F, l, b, kvh, i, od);
#endif
                }
            }
        }
        GRID_BARRIER();
        STAMP(5 + 8 * l);
#ifndef NO_G2
#ifdef DBL_G2
        for (int rep_ = 0; rep_ < 2; ++rep_)
#endif
        {   MKFRAME(); unsigned char* wl = WL(l);
            pg8::StaticOrder S; S.init(M, DM, F.G, bid); pg8::Unit u0; S.next(0, u0);
            pg8::ProgG2 P{u0.pm, u0.pn, ZQ, (const bf16*)(wl + W_BR), XB, (const bf16*)(wl + W_G), YS, MB, SSQ};
            pg8::gemm_chain<pg8::ProgG2>(F.lds, P); }
#endif
        GRID_BARRIER();
        STAMP(6 + 8 * l);
#ifndef NO_G3
        {
            MKFRAME(); unsigned char* wl = WL(l);
            pg8::Gemm g{MB, (const bf16*)(wl + W_OUT), M, DM, DM}; pg8::StaticOrder S; S.init(M, DM, F.G, bid);
            pg8::EpiRes E{l == 0 ? F.a->in[0] : (const float*)F.a->out, F.a->out, XB, SSQ};
            pg8::gemm_phase<pg8::EpiRes, pg8::StaticOrder, false, true>(F.lds, g, S, E);
        }
#ifdef DBL_G3
        {   MKFRAME(); unsigned char* wl = WL(l);
            pg8::Gemm g{MB, (const bf16*)(wl + W_OUT), M, DM, DM}; pg8::StaticOrder S; S.init(M, DM, F.G, bid);
            pg8::EpiRes E{F.a->in[0], (float*)(ws + 0), (bf16*)(ws + 64 * MiB), (float*)(ws + 96 * MiB)};
            pg8::gemm_phase<pg8::EpiRes, pg8::StaticOrder, false, true>(F.lds, g, S, E);
        }
#endif
#endif
        GRID_BARRIER();
        STAMP(7 + 8 * l);
#ifndef NO_G4
#ifdef DBL_G4
        for (int rep_ = 0; rep_ < 2; ++rep_)
#endif
        {
            MKFRAME(); unsigned char* wl = WL(l);
            pg8::Gemm g{XB, (const bf16*)(wl + W_UP), M, DFF, DM}; pg8::StaticOrder S; S.init(M, DFF, F.G, bid);
            pg8::EpiG4 E{HM, SSQ};
            pg8::gemm_phase<pg8::EpiG4, pg8::StaticOrder, true, true>(F.lds, g, S, E);
        }
#endif
        GRID_BARRIER();
        STAMP(8 + 8 * l);
#ifndef NO_G5
        {
            MKFRAME(); unsigned char* wl = WL(l);
            pg8::Gemm g{HM, (const bf16*)(wl + W_DN), M, DM, DFF}; pg8::StaticOrder S; S.init(M, DM, F.G, bid);
            pg8::EpiRes E{(const float*)F.a->out, F.a->out, XB, SSQ};
            pg8::gemm_phase<pg8::EpiRes, pg8::StaticOrder, false, true>(F.lds, g, S, E);
        }
#ifdef DBL_G5
        {   MKFRAME(); unsigned char* wl = WL(l);
            pg8::Gemm g{HM, (const bf16*)(wl + W_DN), M, DM, DFF}; pg8::StaticOrder S; S.init(M, DM, F.G, bid);
            pg8::EpiNull E{};
            pg8::gemm_phase<pg8::EpiNull, pg8::StaticOrder, false, true>(F.lds, g, S, E);
        }
#endif
#endif
#ifdef PROBE_T
        GRID_BARRIER();
        STAMP(9 + 8 * l);
#else
        if (l + 1 < DEPTH) GRID_BARRIER();
#endif
#ifdef DBL_BAR
        for (int rep_ = 0; rep_ < 16; ++rep_) GRID_BARRIER();
#endif
    }
#ifdef PROBE_T
    {
        GRID_BARRIER();
        const unsigned long long* st = (const unsigned long long*)(args.ws + WS_CTL + 96 * 1024);
        float tus;
        if (PROBE_T == 0) tus = (float)(st[1] - st[0]) * 0.01f;
        else tus = 0.5f * ((float)(st[PROBE_T + 1] - st[PROBE_T]) + (float)(st[PROBE_T + 9] - st[PROBE_T + 8])) * 0.01f;
        const float sc = 1.0f + tus * 0.001f;
        float* o = args.out;
        for (size_t i = (size_t)blockIdx.x * 512 + threadIdx.x; i < (size_t)M * DM; i += (size_t)gridDim.x * 512) o[i] *= sc;
    }
#endif
}

extern "C" void kernel_launch(void* const* d_in, const int* in_sizes, int n_in, void* d_out, int out_size, void* d_ws, size_t ws_size, hipStream_t stream) {
    static int grid = 0;
    if (grid == 0) {
        if (n_in != 17 || out_size != M * DM || ws_size < WS_END) { fprintf(stderr, "kernel_launch: unexpected problem shape (n_in %d out %d ws %zu)\n", n_in, out_size, ws_size); grid = -1; return; }
        int dev = 0, cus = 0, per_cu = 0;
        if (hipGetDevice(&dev) != hipSuccess || hipDeviceGetAttribute(&cus, hipDeviceAttributeMultiprocessorCount, dev) != hipSuccess) { grid = -1; return; }
        if (hipFuncSetAttribute((const void*)mk_fwd, hipFuncAttributeMaxDynamicSharedMemorySize, LDS_BYTES) != hipSuccess) { fprintf(stderr, "kernel_launch: hipFuncSetAttribute failed\n"); grid = -1; return; }
        if (hipOccupancyMaxActiveBlocksPerMultiprocessor(&per_cu, (const void*)mk_fwd, NWAVES * 64, LDS_BYTES) != hipSuccess || per_cu < 1) { fprintf(stderr, "kernel_launch: occupancy query says %d blocks/CU\n", per_cu); }
        (void)hipGetLastError();
        if (cus != 256) { fprintf(stderr, "kernel_launch: built for a 256-CU device (one 256x256 GEMM unit per workgroup in the N=1024 phases), found %d CUs\n", cus); grid = -1; return; }
        grid = cus;
    }
    if (grid < 0) return;
    (void)hipMemsetAsync((char*)d_ws + WS_CTL, 0, CTL_BYTES, stream);
    Args a{};
    for (int i = 0; i < 17; ++i) a.in[i] = (const float*)d_in[i];
    a.out = (float*)d_out; a.ws = (unsigned char*)d_ws;
    hipLaunchKernelGGL(mk_fwd, dim3(grid), dim3(NWAVES * 64), LDS_BYTES, stream, a);
}
```

```cpp
#include <hip/hip_runtime.h>
#include <cstdio>
#include <cstdint>

namespace pg8 {
#define PG8_LAS __attribute__((address_space(3)))
typedef unsigned short bf16_t;
typedef short bf16x8 __attribute__((ext_vector_type(8)));
typedef float f32x4 __attribute__((ext_vector_type(4)));
typedef unsigned u32x4 __attribute__((ext_vector_type(4)));
constexpr int BM = 256, BK = 64, HALF = 128, HTB = HALF * BK * 2  , STAGE_BYTES = 8 * HTB, NXCD = 8, WGM = 8;

__host__ __device__ __forceinline__ int lds_byte(int r, int c) { const int st = (r >> 4) * 2 + (c >> 5), rr = r & 15, cc = c & 31, ob = rr * 64 + cc * 2; return st * 1024 + (ob ^ (((ob >> 9) & 1) << 5)); }
__host__ __device__ __forceinline__ void stage_rc(int b, int& R, int& C) { const int st = b / 1024, sb = b % 1024, swz = sb ^ (((sb >> 9) & 1) << 5); R = (st >> 1) * 16 + swz / 64; C = (st & 1) * 32 + (swz % 64) / 2; }
__host__ __device__ __forceinline__ int perm32(int rho) { const int n = rho >> 4, i = rho & 15; return 8 * (i >> 2) + 4 * n + (i & 3); }

struct Unit { int pm, pn; };
struct Gemm { const bf16_t* A; const bf16_t* Bt; int M, N, K; };

struct StaticOrder {
    int nM, nN, nwg, G, c;
    __host__ __device__ void init(int M, int N, int G_, int c_) { nM = M / BM; nN = N / BM; nwg = nM * nN; G = G_; c = c_; }
    __host__ __device__ bool next(int i, Unit& u) const {
        const long L = (long)i * G + c; if (L >= nwg) return false;
        int wgid = (int)L; { const int q = nwg / NXCD, r = nwg % NXCD, xcd = wgid % NXCD, off = wgid / NXCD; wgid = (xcd < r ? xcd * (q + 1) : r * (q + 1) + (xcd - r) * q) + off; }
        const int nig = WGM * nN, gid = wgid / nig, fm = gid * WGM, gsz = (nM - fm) < WGM ? (nM - fm) : WGM;
        u.pm = fm + ((wgid % nig) % gsz); u.pn = (wgid % nig) / gsz; return true;
    }
    __device__ __forceinline__ void a_ready(const Unit&) const {}
    __device__ __forceinline__ void done(const Unit&) const {}
};

__device__ __forceinline__ unsigned cvt_pk_bf16(float lo, float hi) { unsigned r; asm volatile("v_cvt_pk_bf16_f32 %0, %1, %2" : "=v"(r) : "v"(lo), "v"(hi)); return r; }
template <class Epi, class Sched, bool ALIGN_EPI = false, bool SP2 = false>
__device__ __forceinline__ void gemm_phase(PG8_LAS unsigned char* lds, const Gemm g, const Sched& S, const Epi& E) {
    int tid_l = threadIdx.x; asm volatile("" : "+v"(tid_l));
    const int tid = tid_l, wid = __builtin_amdgcn_readfirstlane(tid >> 6), lane = tid & 63, wr = wid >> 2, wc = wid & 3, fr = lane & 15, fq = lane >> 4;
    const int K = g.K, nt = K / BK;
    unsigned voffA[2], voffB[2];
#pragma unroll
    for (int i = 0; i < 2; ++i) { int R, C; stage_rc(tid * 16 + i * 8192, R, C); const int Rb = Epi::PERM ? ((R & ~31) + perm32(R & 31)) : R;
        voffA[i] = (unsigned)(R * K + C) * 2u; voffB[i] = (unsigned)(Rb * K + C) * 2u; }
    const size_t kstep = (size_t)(BK * 2);
    const size_t hstep = (size_t)HALF * K * 2;
    const size_t tstep = 2 * hstep;
    const unsigned ldsw = (unsigned)wid * 1024u;
    const int aoff = lds_byte(wr * 64 + fr, fq * 8), boff = lds_byte(wc * 32 + fr, fq * 8);
#define PG8_SA(b, h) (((b) * 2 + (h)) * HTB)
#define PG8_SB(b, h) ((4 + (b) * 2 + (h)) * HTB)
#define PG8_STAGE(bufoff, gbase, voff) do { _Pragma("unroll") for (int _i = 0; _i < 2; ++_i) \
        __builtin_amdgcn_global_load_lds((const unsigned*)((const char*)(gbase) + (voff)[_i]), (PG8_LAS unsigned*)(lds + (bufoff) + ldsw + _i * 8192), 16, 0, 0); } while (0)
#define PG8_LDA(dst, b, h) do { _Pragma("unroll") for (int m = 0; m < 4; ++m) _Pragma("unroll") for (int k = 0; k < 2; ++k) dst[m][k] = *(const PG8_LAS bf16x8*)(lds + PG8_SA(b, h) + aoff + m * 2048 + k * 1024); } while (0)
#define PG8_LDB(dst, b, h) do { _Pragma("unroll") for (int n = 0; n < 2; ++n) _Pragma("unroll") for (int k = 0; k < 2; ++k) dst[n][k] = *(const PG8_LAS bf16x8*)(lds + PG8_SB(b, h) + boff + n * 2048 + k * 1024); } while (0)
#define PG8_MMA(ai, bj, At, Bt) do { __builtin_amdgcn_s_setprio(1); _Pragma("unroll") for (int m = 0; m < 4; ++m) _Pragma("unroll") for (int n = 0; n < 2; ++n) _Pragma("unroll") for (int k = 0; k < 2; ++k) \
        acc[ai][bj][m][n] = __builtin_amdgcn_mfma_f32_16x16x32_bf16(Bt[n][k], At[m][k], acc[ai][bj][m][n], 0, 0, 0); __builtin_amdgcn_s_setprio(0); } while (0)
#define PG8_WAIT_V(n) asm volatile("s_waitcnt vmcnt(" #n ")" ::: "memory")
#define PG8_WAIT_L(n) asm volatile("s_waitcnt lgkmcnt(" #n ")" ::: "memory")
#define PG8_BAR __builtin_amdgcn_s_barrier()
#define PG8_SCHED __builtin_amdgcn_sched_barrier(0)
    Unit cur, nxt; int ui = 0;
    if (!S.next(0, cur)) return;
    f32x4 acc[2][2][4][2];
#pragma unroll
    for (int a = 0; a < 2; ++a)
#pragma unroll
        for (int b = 0; b < 2; ++b)
#pragma unroll
            for (int m = 0; m < 4; ++m)
#pragma unroll
                for (int n = 0; n < 2; ++n) acc[a][b][m][n] = (f32x4){0.f, 0.f, 0.f, 0.f};
    bf16x8 At[4][2], B0[2][2], B1[2][2];
    const char* cA = (const char*)g.A + (size_t)cur.pm * tstep; const char* cB = (const char*)g.Bt + (size_t)cur.pn * tstep;
    S.a_ready(cur);
    if constexpr (SP2) {
        PG8_STAGE(PG8_SB(0, 0), cB, voffB); PG8_STAGE(PG8_SB(0, 1), cB + hstep, voffB); PG8_STAGE(PG8_SA(0, 0), cA, voffA); PG8_STAGE(PG8_SA(0, 1), cA + hstep, voffA);
        if (wr == 1) PG8_BAR;
        PG8_WAIT_V(2); PG8_BAR;
        PG8_STAGE(PG8_SB(1, 0), cB + kstep, voffB); PG8_STAGE(PG8_SA(1, 0), cA + kstep, voffA); PG8_STAGE(PG8_SB(1, 1), cB + hstep + kstep, voffB);
        PG8_WAIT_V(6); PG8_BAR;
    } else {
        PG8_STAGE(PG8_SB(0, 0), cB, voffB); PG8_STAGE(PG8_SA(0, 0), cA, voffA); PG8_STAGE(PG8_SB(0, 1), cB + hstep, voffB); PG8_STAGE(PG8_SA(0, 1), cA + hstep, voffA);
        if (wr == 1) PG8_BAR;
        PG8_WAIT_V(4); PG8_BAR;
        PG8_STAGE(PG8_SB(1, 0), cB + kstep, voffB); PG8_STAGE(PG8_SA(1, 0), cA + kstep, voffA); PG8_STAGE(PG8_SB(1, 1), cB + hstep + kstep, voffB);
        PG8_WAIT_V(6); PG8_BAR;
    }
    for (;;) {
        const bool has_next = S.next(ui + 1, nxt);
        const char* nA = has_next ? (const char*)g.A + (size_t)nxt.pm * tstep : cA; const char* nB = has_next ? (const char*)g.Bt + (size_t)nxt.pn * tstep : cB;
        for (int t = 0; t < nt; t += 2) {
            const bool last = (t == nt - 2);
            const char* a1 = cA + (size_t)(t + 1) * kstep;
            const char* a2 = last ? nA : cA + (size_t)(t + 2) * kstep; const char* b2 = last ? nB : cB + (size_t)(t + 2) * kstep;
            const char* a3 = a2 + kstep; const char* b3 = b2 + kstep;
            if (last && has_next) S.a_ready(nxt);
            if constexpr (SP2) {
            PG8_LDB(B0, 0, 0); PG8_LDB(B1, 0, 1); PG8_SCHED; PG8_LDA(At, 0, 0); PG8_STAGE(PG8_SA(1, 1), a1 + hstep, voffA);
            PG8_WAIT_V(8); PG8_WAIT_L(0); PG8_BAR; PG8_MMA(0, 0, At, B0); PG8_MMA(0, 1, At, B1); PG8_BAR; PG8_SCHED;
            PG8_LDA(At, 0, 1); PG8_STAGE(PG8_SB(0, 0), b2, voffB); PG8_STAGE(PG8_SB(0, 1), b2 + hstep, voffB); PG8_STAGE(PG8_SA(0, 0), a2, voffA);
            PG8_WAIT_V(8); PG8_WAIT_L(0); PG8_BAR; PG8_MMA(1, 0, At, B0); PG8_MMA(1, 1, At, B1); PG8_BAR; PG8_SCHED;
            PG8_LDB(B0, 1, 0); PG8_LDB(B1, 1, 1); PG8_SCHED; PG8_LDA(At, 1, 0); PG8_STAGE(PG8_SA(0, 1), a2 + hstep, voffA);
            PG8_WAIT_V(8); PG8_WAIT_L(0); PG8_BAR; PG8_MMA(0, 0, At, B0); PG8_MMA(0, 1, At, B1); PG8_BAR; PG8_SCHED;
            PG8_LDA(At, 1, 1); PG8_STAGE(PG8_SB(1, 0), b3, voffB); PG8_STAGE(PG8_SB(1, 1), b3 + hstep, voffB); PG8_STAGE(PG8_SA(1, 0), a3, voffA);
            PG8_WAIT_V(8); PG8_WAIT_L(0); PG8_BAR; PG8_MMA(1, 0, At, B0); PG8_MMA(1, 1, At, B1); PG8_BAR; PG8_SCHED;
            } else {
            PG8_LDB(B0, 0, 0); PG8_SCHED; PG8_LDA(At, 0, 0); PG8_STAGE(PG8_SA(1, 1), a1 + hstep, voffA);
            PG8_WAIT_L(8); PG8_BAR; PG8_WAIT_L(0); PG8_MMA(0, 0, At, B0); PG8_BAR; PG8_SCHED;
            PG8_LDB(B1, 0, 1); PG8_STAGE(PG8_SB(0, 0), b2, voffB);
            PG8_BAR; PG8_WAIT_L(0); PG8_MMA(0, 1, At, B1); PG8_BAR;
            PG8_LDA(At, 0, 1); PG8_STAGE(PG8_SA(0, 0), a2, voffA);
            PG8_BAR; PG8_WAIT_L(0); PG8_MMA(1, 0, At, B0); PG8_BAR; PG8_SCHED;
            PG8_STAGE(PG8_SB(0, 1), b2 + hstep, voffB);
            PG8_WAIT_V(6); PG8_BAR; PG8_MMA(1, 1, At, B1); PG8_BAR;
            PG8_LDB(B0, 1, 0); PG8_SCHED; PG8_LDA(At, 1, 0); PG8_STAGE(PG8_SA(0, 1), a2 + hstep, voffA);
            PG8_WAIT_L(8); PG8_BAR; PG8_WAIT_L(0); PG8_MMA(0, 0, At, B0); PG8_BAR; PG8_SCHED;
            PG8_LDB(B1, 1, 1); PG8_STAGE(PG8_SB(1, 0), b3, voffB);
            PG8_BAR; PG8_WAIT_L(0); PG8_MMA(0, 1, At, B1); PG8_BAR;
            PG8_LDA(At, 1, 1); PG8_STAGE(PG8_SA(1, 0), a3, voffA);
            PG8_BAR; PG8_WAIT_L(0); PG8_MMA(1, 0, At, B0); PG8_BAR; PG8_SCHED;
            PG8_STAGE(PG8_SB(1, 1), b3 + hstep, voffB);
            PG8_WAIT_V(6); PG8_BAR; PG8_MMA(1, 1, At, B1); PG8_BAR;
            }
        }
        if constexpr (ALIGN_EPI) { if (wr == 0) PG8_BAR; }
        if constexpr (!Epi::AFTER_DRAIN) { E(acc, cur, wr, wc, fr, fq); S.done(cur); }
        if (!has_next) break;
#pragma unroll
        for (int a = 0; a < 2; ++a)
#pragma unroll
            for (int b = 0; b < 2; ++b)
#pragma unroll
                for (int m = 0; m < 4; ++m)
#pragma unroll
                    for (int n = 0; n < 2; ++n) acc[a][b][m][n] = (f32x4){0.f, 0.f, 0.f, 0.f};
        cur = nxt; cA = nA; cB = nB; ++ui;
        if constexpr (ALIGN_EPI) { if (wr == 1) PG8_BAR; }
    }
    PG8_WAIT_V(0);
    if constexpr (!ALIGN_EPI) { if (wr == 0) PG8_BAR; }
    PG8_BAR;
    if constexpr (Epi::AFTER_DRAIN) { E.fused(acc, cur, wr, wc, fr, fq, lds, wid, lane); S.done(cur); }
#undef PG8_SA
#undef PG8_SB
#undef PG8_STAGE
#undef PG8_LDA
#undef PG8_LDB
#undef PG8_MMA
#undef PG8_WAIT_V
#undef PG8_WAIT_L
#undef PG8_BAR
#undef PG8_SCHED
}
}

namespace pg8 {
#define PG8_GAS __attribute__((address_space(1)))
constexpr int MROWS = 16384;
__device__ __forceinline__ unsigned pk_bf16(float lo, float hi) { typedef float f2 __attribute__((ext_vector_type(2))); typedef __bf16 b2 __attribute__((ext_vector_type(2)));
    f2 v = {lo, hi}; b2 b = __builtin_convertvector(v, b2); return __builtin_bit_cast(unsigned, b); }
__device__ __forceinline__ float bf_lo(unsigned w) { return __uint_as_float(w << 16); }
__device__ __forceinline__ float bf_hi(unsigned w) { return __uint_as_float(w & 0xffff0000u); }
__device__ __forceinline__ float row_rstd(const float* ssq, int row) {
    const PG8_GAS f32x4* p = (const PG8_GAS f32x4*)(ssq + (size_t)row * 16);
    const f32x4 a = p[0], b = p[1], c = p[2], d = p[3];
    const float s = (((a[0] + a[1]) + (a[2] + a[3])) + ((b[0] + b[1]) + (b[2] + b[3]))) + (((c[0] + c[1]) + (c[2] + c[3])) + ((d[0] + d[1]) + (d[2] + d[3])));
    return rsqrtf(s * (1.0f / 1024.0f) + 1e-6f);
}
__device__ __forceinline__ float sigmoidf_(float x) { return __builtin_amdgcn_rcpf(1.0f + __builtin_amdgcn_exp2f(-1.4426950408889634f * x)); }

__device__ __forceinline__ void wave_rstd(const float* ssq, int rowbase, int lane, float (&v)[2]) {
    const PG8_GAS f32x4* p0 = (const PG8_GAS f32x4*)(ssq + (size_t)(rowbase + lane) * 16);
    const PG8_GAS f32x4* p1 = p0 + HALF * 4;
    const f32x4 a = p0[0], b = p0[1], c = p0[2], d = p0[3], e = p1[0], f = p1[1], g = p1[2], h = p1[3];
    const float s0 = (((a[0] + a[1]) + (a[2] + a[3])) + ((b[0] + b[1]) + (b[2] + b[3]))) + (((c[0] + c[1]) + (c[2] + c[3])) + ((d[0] + d[1]) + (d[2] + d[3])));
    const float s1 = (((e[0] + e[1]) + (e[2] + e[3])) + ((f[0] + f[1]) + (f[2] + f[3]))) + (((g[0] + g[1]) + (g[2] + g[3])) + ((h[0] + h[1]) + (h[2] + h[3])));
    v[0] = rsqrtf(s0 * (1.0f / 1024.0f) + 1e-6f); v[1] = rsqrtf(s1 * (1.0f / 1024.0f) + 1e-6f);
}

struct EpiG1 {
    static constexpr bool PERM = true, AFTER_DRAIN = false;
    bf16_t* zq; bf16_t* zkv; const float* ssq;
    __device__ __forceinline__ void operator()(const f32x4 (&acc)[2][2][4][2], const Unit& u, int wr, int wc, int fr, int fq) const {
        const int row0 = u.pm * BM + wr * 64 + fr;
        bf16_t* base; int ldc, colt;
        if (u.pn < 6) { base = zq + (size_t)(u.pn >> 1) * ((size_t)MROWS * 512); ldc = 512; colt = (u.pn & 1) * 256; }
        else { base = zkv + (size_t)(u.pn - 6) * ((size_t)MROWS * 256); ldc = 256; colt = 0; }
        const int col0 = colt + wc * 32 + 8 * fq;
        float rv[2]; wave_rstd(ssq, u.pm * BM + wr * 64, fq * 16 + fr, rv);
#pragma unroll
        for (int ai = 0; ai < 2; ++ai)
#pragma unroll
            for (int m = 0; m < 4; ++m) { const int row = row0 + ai * HALF + m * 16; const float rs = __shfl(rv[ai], m * 16 + fr); bf16_t* rowp = base + (size_t)row * ldc + col0;
#pragma unroll
                for (int bj = 0; bj < 2; ++bj) { const f32x4 v0 = acc[ai][bj][m][0] * rs, v1 = acc[ai][bj][m][1] * rs;
                    u32x4 w; w.x = pk_bf16(v0[0], v0[1]); w.y = pk_bf16(v0[2], v0[3]); w.z = pk_bf16(v1[0], v1[1]); w.w = pk_bf16(v1[2], v1[3]);
                    *(PG8_GAS u32x4*)(rowp + bj * HALF) = w; } }
    }
};
struct EpiG4 {
    static constexpr bool PERM = true, AFTER_DRAIN = false;
    bf16_t* h; const float* ssq;
    __device__ __forceinline__ void operator()(const f32x4 (&acc)[2][2][4][2], const Unit& u, int wr, int wc, int fr, int fq) const {
        const int row0 = u.pm * BM + wr * 64 + fr; const int col0 = u.pn * BM + wc * 32 + 8 * fq;
        float rv[2]; wave_rstd(ssq, u.pm * BM + wr * 64, fq * 16 + fr, rv);
#pragma unroll
        for (int ai = 0; ai < 2; ++ai)
#pragma unroll
            for (int m = 0; m < 4; ++m) { const int row = row0 + ai * HALF + m * 16; const float rs = __shfl(rv[ai], m * 16 + fr); bf16_t* rowp = h + (size_t)row * 4096 + col0;
#pragma unroll
                for (int bj = 0; bj < 2; ++bj) { f32x4 v0 = acc[ai][bj][m][0] * rs, v1 = acc[ai][bj][m][1] * rs;
#pragma unroll
                    for (int e = 0; e < 4; ++e) { v0[e] = fmaxf(v0[e], 0.f); v0[e] *= v0[e]; v1[e] = fmaxf(v1[e], 0.f); v1[e] *= v1[e]; }
                    u32x4 w; w.x = pk_bf16(v0[0], v0[1]); w.y = pk_bf16(v0[2], v0[3]); w.z = pk_bf16(v1[0], v1[1]); w.w = pk_bf16(v1[2], v1[3]);
                    *(PG8_GAS u32x4*)(rowp + bj * HALF) = w; } }
    }
};
struct EpiRes {
    static constexpr bool PERM = true, AFTER_DRAIN = false;
    const float* xold; float* xout; bf16_t* xb; float* ssq;
    __device__ __forceinline__ void operator()(const f32x4 (&acc)[2][2][4][2], const Unit& u, int wr, int wc, int fr, int fq) const {
        const int row0 = u.pm * BM + wr * 64 + fr; const int col0 = u.pn * BM + wc * 32 + 8 * fq;
#pragma unroll
        for (int ai = 0; ai < 2; ++ai) {
            f32x4 xo[4][2][2];
#pragma unroll
            for (int m = 0; m < 4; ++m)
#pragma unroll
                for (int bj = 0; bj < 2; ++bj) { const size_t off = (size_t)(row0 + ai * HALF + m * 16) * 1024 + col0 + bj * HALF;
                    xo[m][bj][0] = *(const PG8_GAS f32x4*)(xold + off); xo[m][bj][1] = *(const PG8_GAS f32x4*)(xold + off + 4); }
#pragma unroll
            for (int m = 0; m < 4; ++m) { const int row = row0 + ai * HALF + m * 16; float part = 0.f;
#pragma unroll
                for (int bj = 0; bj < 2; ++bj) { const size_t off = (size_t)row * 1024 + col0 + bj * HALF;
                    const f32x4 v0 = acc[ai][bj][m][0] + xo[m][bj][0], v1 = acc[ai][bj][m][1] + xo[m][bj][1];
                    *(PG8_GAS f32x4*)(xout + off) = v0; *(PG8_GAS f32x4*)(xout + off + 4) = v1;
                    u32x4 w; w.x = pk_bf16(v0[0], v0[1]); w.y = pk_bf16(v0[2], v0[3]); w.z = pk_bf16(v1[0], v1[1]); w.w = pk_bf16(v1[2], v1[3]);
                    *(PG8_GAS u32x4*)(xb + off) = w;
                    part += ((v0[0] * v0[0] + v0[1] * v0[1]) + (v0[2] * v0[2] + v0[3] * v0[3])) + ((v1[0] * v1[0] + v1[1] * v1[1]) + (v1[2] * v1[2] + v1[3] * v1[3])); }
                part += __shfl_xor(part, 16); part += __shfl_xor(part, 32);
                if (fq == 0) ((PG8_GAS float*)ssq)[(size_t)row * 16 + u.pn * 4 + wc] = part; }
            asm volatile("" ::: "memory"); }
    }
};
struct EpiStash {
    static constexpr bool PERM = true, AFTER_DRAIN = true;
    __device__ __forceinline__ void fused(f32x4 (&acc)[2][2][4][2], const Unit& u, int wr, int wc, int fr, int fq, PG8_LAS unsigned char*, int, int) const { (*this)(acc, u, wr, wc, fr, fq); }
    bf16_t* ys;
    __device__ __forceinline__ void operator()(const f32x4 (&acc)[2][2][4][2], const Unit& u, int wr, int wc, int fr, int fq) const {
        bf16_t* base = ys + (size_t)(u.pm * 4 + u.pn) * 65536; const int row0 = wr * 64 + fr, col0 = wc * 32 + 8 * fq;
#pragma unroll
        for (int ai = 0; ai < 2; ++ai)
#pragma unroll
            for (int m = 0; m < 4; ++m) { bf16_t* rowp = base + (row0 + ai * HALF + m * 16) * 256 + col0;
#pragma unroll
                for (int bj = 0; bj < 2; ++bj) { const f32x4 v0 = acc[ai][bj][m][0], v1 = acc[ai][bj][m][1];
                    u32x4 w; w.x = pk_bf16(v0[0], v0[1]); w.y = pk_bf16(v0[2], v0[3]); w.z = pk_bf16(v1[0], v1[1]); w.w = pk_bf16(v1[2], v1[3]);
                    *(PG8_GAS u32x4*)(rowp + bj * HALF) = w; } }
    }
};
struct EpiGate {
    static constexpr bool PERM = true, AFTER_DRAIN = true;
    __device__ __forceinline__ void fused(f32x4 (&acc)[2][2][4][2], const Unit& u, int wr, int wc, int fr, int fq, PG8_LAS unsigned char*, int, int) const { (*this)(acc, u, wr, wc, fr, fq); }
    const bf16_t* ys; bf16_t* mb; const float* ssq; int first;
    __device__ __forceinline__ void operator()(const f32x4 (&acc)[2][2][4][2], const Unit& u, int wr, int wc, int fr, int fq) const {
        const bf16_t* sbase = ys + (size_t)(u.pm * 4 + u.pn) * 65536; const int lrow0 = wr * 64 + fr, lcol0 = wc * 32 + 8 * fq;
        float rv[2]; wave_rstd(ssq, u.pm * BM + wr * 64, fq * 16 + fr, rv);
        const bool fst = first != 0;
#pragma unroll
        for (int ai = 0; ai < 2; ++ai)
#pragma unroll
        for (int mh = 0; mh < 2; ++mh) {
            u32x4 yv[2][2], pv[2][2];
#pragma unroll
            for (int m2 = 0; m2 < 2; ++m2)
#pragma unroll
                for (int bj = 0; bj < 2; ++bj) { const int lrow = lrow0 + ai * HALF + (mh * 2 + m2) * 16;
                    yv[m2][bj] = *(const PG8_GAS u32x4*)(sbase + lrow * 256 + lcol0 + bj * HALF);
                    pv[m2][bj] = *(const PG8_GAS u32x4*)(mb + (size_t)(u.pm * BM + lrow) * 1024 + u.pn * BM + lcol0 + bj * HALF); }
#pragma unroll
            for (int m2 = 0; m2 < 2; ++m2) { const int m = mh * 2 + m2; const int lrow = lrow0 + ai * HALF + m * 16, row = u.pm * BM + lrow; const float rs = __shfl(rv[ai], m * 16 + fr);
#pragma unroll
                for (int bj = 0; bj < 2; ++bj) { const f32x4 a0 = acc[ai][bj][m][0] * rs, a1 = acc[ai][bj][m][1] * rs;
                    const u32x4 y = yv[m2][bj], p = pv[m2][bj];
                    bf16_t* mp = mb + (size_t)row * 1024 + u.pn * BM + lcol0 + bj * HALF;
                    float r[8], q[8];
                    r[0] = sigmoidf_(a0[0]) * bf_lo(y.x); r[1] = sigmoidf_(a0[1]) * bf_hi(y.x); r[2] = sigmoidf_(a0[2]) * bf_lo(y.y); r[3] = sigmoidf_(a0[3]) * bf_hi(y.y);
                    r[4] = sigmoidf_(a1[0]) * bf_lo(y.z); r[5] = sigmoidf_(a1[1]) * bf_hi(y.z); r[6] = sigmoidf_(a1[2]) * bf_lo(y.w); r[7] = sigmoidf_(a1[3]) * bf_hi(y.w);
                    q[0] = bf_lo(p.x); q[1] = bf_hi(p.x); q[2] = bf_lo(p.y); q[3] = bf_hi(p.y); q[4] = bf_lo(p.z); q[5] = bf_hi(p.z); q[6] = bf_lo(p.w); q[7] = bf_hi(p.w);
#pragma unroll
                    for (int e = 0; e < 8; ++e) r[e] = fst ? r[e] : r[e] + q[e];
                    u32x4 w; w.x = pk_bf16(r[0], r[1]); w.y = pk_bf16(r[2], r[3]); w.z = pk_bf16(r[4], r[5]); w.w = pk_bf16(r[6], r[7]);
                    *(PG8_GAS u32x4*)mp = w; } }
            asm volatile("" ::: "memory"); }
    }
};
struct EpiNull {
    static constexpr bool PERM = true, AFTER_DRAIN = false;
    __device__ __forceinline__ void operator()(const f32x4 (&acc)[2][2][4][2], const Unit& u, int wr, int wc, int fr, int fq) const {
#pragma unroll
        for (int ai = 0; ai < 2; ++ai)
#pragma unroll
            for (int bj = 0; bj < 2; ++bj)
#pragma unroll
                for (int m = 0; m < 4; ++m) { asm volatile("" :: "v"(acc[ai][bj][m][0]), "v"(acc[ai][bj][m][1])); }
    }
};
}

namespace pg8 {
struct UnitX { int pm, pn; const char* A; const char* Bt; int K; int nk; int kind; };
template <class Prog, bool ALIGN_EPI = false>
__device__ __forceinline__ void gemm_chain(PG8_LAS unsigned char* lds, const Prog& P) {
    int tid_l = threadIdx.x; asm volatile("" : "+v"(tid_l));
    const int tid = tid_l, wid = __builtin_amdgcn_readfirstlane(tid >> 6), lane = tid & 63, wr = wid >> 2, wc = wid & 3, fr = lane & 15, fq = lane >> 4;
    int RA[2], RB[2], C2[2];
#pragma unroll
    for (int i = 0; i < 2; ++i) { int R, C; stage_rc(tid * 16 + i * 8192, R, C); RA[i] = R * 2; RB[i] = ((R & ~31) + perm32(R & 31)) * 2; C2[i] = C * 2; }
    const size_t kstep = (size_t)(BK * 2);
    const unsigned ldsw = (unsigned)wid * 1024u;
    const int aoff = lds_byte(wr * 64 + fr, fq * 8), boff = lds_byte(wc * 32 + fr, fq * 8);
#define PG8_SA(b, h) (((b) * 2 + (h)) * HTB)
#define PG8_SB(b, h) ((4 + (b) * 2 + (h)) * HTB)
#define PG8_STAGE(bufoff, gbase, voff) do { _Pragma("unroll") for (int _i = 0; _i < 2; ++_i) \
        __builtin_amdgcn_global_load_lds((const unsigned*)((const char*)(gbase) + (voff)[_i]), (PG8_LAS unsigned*)(lds + (bufoff) + ldsw + _i * 8192), 16, 0, 0); } while (0)
#define PG8_LDA(dst, b, h) do { _Pragma("unroll") for (int m = 0; m < 4; ++m) _Pragma("unroll") for (int k = 0; k < 2; ++k) dst[m][k] = *(const PG8_LAS bf16x8*)(lds + PG8_SA(b, h) + aoff + m * 2048 + k * 1024); } while (0)
#define PG8_LDB(dst, b, h) do { _Pragma("unroll") for (int n = 0; n < 2; ++n) _Pragma("unroll") for (int k = 0; k < 2; ++k) dst[n][k] = *(const PG8_LAS bf16x8*)(lds + PG8_SB(b, h) + boff + n * 2048 + k * 1024); } while (0)
#define PG8_MMA(ai, bj, At, Bt) do { __builtin_amdgcn_s_setprio(1); _Pragma("unroll") for (int m = 0; m < 4; ++m) _Pragma("unroll") for (int n = 0; n < 2; ++n) _Pragma("unroll") for (int k = 0; k < 2; ++k) \
        acc[ai][bj][m][n] = __builtin_amdgcn_mfma_f32_16x16x32_bf16(Bt[n][k], At[m][k], acc[ai][bj][m][n], 0, 0, 0); __builtin_amdgcn_s_setprio(0); } while (0)
#define PG8_WAIT_V(n) asm volatile("s_waitcnt vmcnt(" #n ")" ::: "memory")
#define PG8_WAIT_L(n) asm volatile("s_waitcnt lgkmcnt(" #n ")" ::: "memory")
#define PG8_BAR __builtin_amdgcn_s_barrier()
#define PG8_SCHED __builtin_amdgcn_sched_barrier(0)
    UnitX cur, nxt; int ui = 0;
    if (!P.get(0, cur)) return;
    f32x4 acc[2][2][4][2];
#pragma unroll
    for (int a = 0; a < 2; ++a)
#pragma unroll
        for (int b = 0; b < 2; ++b)
#pragma unroll
            for (int m = 0; m < 4; ++m)
#pragma unroll
                for (int n = 0; n < 2; ++n) acc[a][b][m][n] = (f32x4){0.f, 0.f, 0.f, 0.f};
    bf16x8 At[4][2], B0[2][2], B1[2][2];
    int Kc = cur.K; size_t hsc = (size_t)HALF * Kc * 2;
    const char* cA = cur.A + (size_t)cur.pm * 2 * hsc; const char* cB = cur.Bt + (size_t)cur.pn * 2 * hsc;
    unsigned vAc[2], vBc[2];
#pragma unroll
    for (int i = 0; i < 2; ++i) { vAc[i] = (unsigned)(RA[i] * Kc + C2[i]); vBc[i] = (unsigned)(RB[i] * Kc + C2[i]); }
    P.a_ready(cur);
    PG8_STAGE(PG8_SB(0, 0), cB, vBc); PG8_STAGE(PG8_SB(0, 1), cB + hsc, vBc); PG8_STAGE(PG8_SA(0, 0), cA, vAc); PG8_STAGE(PG8_SA(0, 1), cA + hsc, vAc);
    if (wr == 1) PG8_BAR;
    PG8_WAIT_V(2); PG8_BAR;
    PG8_STAGE(PG8_SB(1, 0), cB + kstep, vBc); PG8_STAGE(PG8_SA(1, 0), cA + kstep, vAc); PG8_STAGE(PG8_SB(1, 1), cB + hsc + kstep, vBc);
    PG8_WAIT_V(6); PG8_BAR;
    for (;;) {
        const bool has_next = P.get(ui + 1, nxt);
        const int Kn = has_next ? nxt.K : Kc; const size_t hsn = (size_t)HALF * Kn * 2;
        const char* nA = has_next ? nxt.A + (size_t)nxt.pm * 2 * hsn : cA; const char* nB = has_next ? nxt.Bt + (size_t)nxt.pn * 2 * hsn : cB;
        const int nt = cur.nk;
        for (int t = 0; t < nt; t += 2) {
            const bool last = (t == nt - 2);
            const char* a1 = cA + (size_t)(t + 1) * kstep;
            const char* a2 = last ? nA : cA + (size_t)(t + 2) * kstep; const char* b2 = last ? nB : cB + (size_t)(t + 2) * kstep;
            const char* a3 = a2 + kstep; const char* b3 = b2 + kstep;
            const size_t hs2 = last ? hsn : hsc; const int K2 = last ? Kn : Kc;
            unsigned vA2[2], vB2[2];
#pragma unroll
            for (int i = 0; i < 2; ++i) { vA2[i] = (unsigned)(RA[i] * K2 + C2[i]); vB2[i] = (unsigned)(RB[i] * K2 + C2[i]); }
            if (last && has_next) P.a_ready(nxt);
            PG8_LDB(B0, 0, 0); PG8_LDB(B1, 0, 1); PG8_SCHED; PG8_LDA(At, 0, 0); PG8_STAGE(PG8_SA(1, 1), a1 + hsc, vAc);
            PG8_WAIT_V(8); PG8_WAIT_L(0); PG8_BAR; PG8_MMA(0, 0, At, B0); PG8_MMA(0, 1, At, B1); PG8_BAR; PG8_SCHED;
            PG8_LDA(At, 0, 1); PG8_STAGE(PG8_SB(0, 0), b2, vB2); PG8_STAGE(PG8_SB(0, 1), b2 + hs2, vB2); PG8_STAGE(PG8_SA(0, 0), a2, vA2);
            PG8_WAIT_V(8); PG8_WAIT_L(0); PG8_BAR; PG8_MMA(1, 0, At, B0); PG8_MMA(1, 1, At, B1); PG8_BAR; PG8_SCHED;
            PG8_LDB(B0, 1, 0); PG8_LDB(B1, 1, 1); PG8_SCHED; PG8_LDA(At, 1, 0); PG8_STAGE(PG8_SA(0, 1), a2 + hs2, vA2);
            PG8_WAIT_V(8); PG8_WAIT_L(0); PG8_BAR; PG8_MMA(0, 0, At, B0); PG8_MMA(0, 1, At, B1); PG8_BAR; PG8_SCHED;
            PG8_LDA(At, 1, 1); PG8_STAGE(PG8_SB(1, 0), b3, vB2); PG8_STAGE(PG8_SB(1, 1), b3 + hs2, vB2); PG8_STAGE(PG8_SA(1, 0), a3, vA2);
            PG8_WAIT_V(8); PG8_WAIT_L(0); PG8_BAR; PG8_MMA(1, 0, At, B0); PG8_MMA(1, 1, At, B1); PG8_BAR; PG8_SCHED;
        }
        if constexpr (ALIGN_EPI) { if (wr == 0) PG8_BAR; }
        { int fr_e = fr, fq_e = fq, wr_e = wr, wc_e = wc; asm volatile("" : "+v"(fr_e), "+v"(fq_e), "+s"(wr_e), "+s"(wc_e));
          P.epi(acc, cur, wr_e, wc_e, fr_e, fq_e); }
        if (!has_next) break;
#pragma unroll
        for (int a = 0; a < 2; ++a)
#pragma unroll
            for (int b = 0; b < 2; ++b)
#pragma unroll
                for (int m = 0; m < 4; ++m)
#pragma unroll
                    for (int n = 0; n < 2; ++n) acc[a][b][m][n] = (f32x4){0.f, 0.f, 0.f, 0.f};
        cur = nxt; cA = nA; cB = nB; Kc = Kn; hsc = hsn; ++ui;
#pragma unroll
        for (int i = 0; i < 2; ++i) { vAc[i] = (unsigned)(RA[i] * Kc + C2[i]); vBc[i] = (unsigned)(RB[i] * Kc + C2[i]); }
        if constexpr (ALIGN_EPI) { if (wr == 1) PG8_BAR; }
    }
    PG8_WAIT_V(0);
    if constexpr (!ALIGN_EPI) { if (wr == 0) PG8_BAR; }
    PG8_BAR;
#undef PG8_SA
#undef PG8_SB
#undef PG8_STAGE
#undef PG8_LDA
#undef PG8_LDB
#undef PG8_MMA
#undef PG8_WAIT_V
#undef PG8_WAIT_L
#undef PG8_BAR
#undef PG8_SCHED
}
struct ProgG2 {
    int pm, pn; const bf16_t* zq; const bf16_t* wbr; const bf16_t* xb; const bf16_t* wg; bf16_t* ys; bf16_t* mb; const float* ssq;
    __device__ __forceinline__ bool get(int i, UnitX& u) const {
        if (i >= 6) return false;
        const int n = i >> 1; u.pm = pm; u.pn = pn; u.kind = i;
        if (i & 1) { u.A = (const char*)xb; u.Bt = (const char*)(wg + (size_t)n * 1024 * 1024); u.K = 1024; u.nk = 16; }
        else { u.A = (const char*)(zq + (size_t)n * MROWS * 512); u.Bt = (const char*)(wbr + (size_t)n * 1024 * 512); u.K = 512; u.nk = 8; }
        return true; }
    __device__ __forceinline__ void a_ready(const UnitX&) const {}
    __device__ __forceinline__ void epi(const f32x4 (&acc)[2][2][4][2], const UnitX& ux, int wr, int wc, int fr, int fq) const {
        Unit u; u.pm = ux.pm; u.pn = ux.pn;
        if (ux.kind & 1) { EpiGate E{ys, mb, ssq, ux.kind == 1 ? 1 : 0}; E(acc, u, wr, wc, fr, fq); }
        else { EpiStash E{ys}; E(acc, u, wr, wc, fr, fq); }
    }
};
struct EpiMiscPart {
    float* part;
    __device__ __forceinline__ void operator()(const f32x4 (&acc)[2][2][4][2], int pm, int kq, int wr, int wc, int fr, int fq) const {
        if (wc >= 3) return;
        float* base = part + ((size_t)kq * MROWS + (size_t)pm * BM + wr * 64 + fr) * 96 + wc * 32 + 8 * fq;
#pragma unroll
        for (int ai = 0; ai < 2; ++ai)
#pragma unroll
            for (int m = 0; m < 4; ++m) { float* rp = base + (size_t)(ai * HALF + m * 16) * 96;
                *(PG8_GAS f32x4*)rp = acc[ai][0][m][0]; *(PG8_GAS f32x4*)(rp + 4) = acc[ai][0][m][1]; }
    }
};
struct ProgG1 {
    StaticOrder S; int spm, skq; const bf16_t* xb; const bf16_t* win; bf16_t* zq; bf16_t* zkv; const float* ssq; float* part;
    __device__ __forceinline__ bool get(int i, UnitX& u) const {
        if (i >= 4) return false;
        u.K = 1024; u.A = (const char*)xb; u.Bt = (const char*)win;
        if (i < 3) { Unit t; S.next(i, t); u.pm = t.pm; u.pn = t.pn; u.nk = 16; u.kind = 0; }
        else { u.pm = spm; u.pn = 12; u.A = (const char*)(xb + skq * 256); u.Bt = (const char*)(win + skq * 256); u.nk = 4; u.kind = 1; }
        return true; }
    __device__ __forceinline__ void a_ready(const UnitX&) const {}
    __device__ __forceinline__ void epi(const f32x4 (&acc)[2][2][4][2], const UnitX& ux, int wr, int wc, int fr, int fq) const {
        if (ux.kind == 0) { Unit u; u.pm = ux.pm; u.pn = ux.pn; EpiG1 E{zq, zkv, ssq}; E(acc, u, wr, wc, fr, fq); }
        else { EpiMiscPart E{part}; E(acc, ux.pm, skq, wr, wc, fr, fq); }
    }
};
}

#define GAS __attribute__((address_space(1)))
#define LAS __attribute__((address_space(3)))
typedef unsigned short bf16;
typedef unsigned v4u __attribute__((ext_vector_type(4)));
typedef float f32x4 __attribute__((ext_vector_type(4)));
typedef short bf16x8 __attribute__((ext_vector_type(8)));
typedef GAS unsigned gu32;
typedef GAS unsigned long long gu64;
#define RLX_AGENT __ATOMIC_RELAXED, __HIP_MEMORY_SCOPE_AGENT
#define LDS_WAIT() asm volatile("s_waitcnt lgkmcnt(0)" ::: "memory")
#define VM_WAIT() asm volatile("s_waitcnt vmcnt(0)" ::: "memory")
__device__ __forceinline__ unsigned long long rt() { return __builtin_amdgcn_s_memrealtime(); }
__device__ __forceinline__ unsigned f2bf(float f) { unsigned u = __builtin_bit_cast(unsigned, f); return (u + 0x7fffu + ((u >> 16) & 1u)) >> 16; }
__device__ __forceinline__ unsigned pk2(float lo, float hi) { return f2bf(lo) | (f2bf(hi) << 16); }

#define XB_TMO      128
#define XB_XCNT(j)  (256  + 64 * (j))
#define XB_XSUB(j)  (1280 + 64 * (j))
#define XB_XGEN(j)  (2304 + 64 * (j))
#define XB_TOP      3328
#define XB_TOPGEN   3392
#define XCD_BAR_WORDS 3456
#define XB_SPIN_CAP (1u << 18)

__device__ __forceinline__ unsigned xb_ld(unsigned* p)              { return __hip_atomic_load(p, __ATOMIC_RELAXED, __HIP_MEMORY_SCOPE_AGENT); }
__device__ __forceinline__ unsigned xb_add(unsigned* p, unsigned v) { return __hip_atomic_fetch_add(p, v, __ATOMIC_RELAXED, __HIP_MEMORY_SCOPE_AGENT); }
__device__ __forceinline__ unsigned xb_xcc_id() { return (unsigned)__builtin_amdgcn_s_getreg((3 << 11) | 20) & 0xFu; }
#define XB_SPIN(cond, bar) do { unsigned _sp = 0; while (cond) { __builtin_amdgcn_s_sleep(1); \
    if ((++_sp & 255u) == 0u) { if (xb_ld(&(bar)[XB_TMO])) break; if (_sp > XB_SPIN_CAP) { atomicAdd(&(bar)[XB_TMO], 1u); break; } } } } while (0)

struct XcdBarrier {
    unsigned* bar; unsigned x;
    volatile LAS unsigned* st;
};

__device__ __forceinline__ XcdBarrier xcd_barrier_post(unsigned* bar, volatile LAS unsigned* st) {
    XcdBarrier b; b.bar = bar; b.x = xb_xcc_id(); b.st = st;
    if (threadIdx.x == 0) (void)xb_add(&bar[XB_XCNT(b.x)], 1u);
    return b;
}
__device__ __forceinline__ void xcd_barrier_complete(unsigned* bar, unsigned x, unsigned& nloc, unsigned& nx) {
    const unsigned G = gridDim.x * gridDim.y * gridDim.z;
    unsigned sum, cnt, mine, sp = 0u;
    for (;;) {
        sum = 0u; cnt = 0u; mine = 0u;
#pragma unroll
        for (unsigned j = 0; j < 16; ++j) { const unsigned c = xb_ld(&bar[XB_XCNT(j)]); sum += c; cnt += (c > 0u) ? 1u : 0u; mine = (j == x) ? c : mine; }
        if (sum == G) break;
        __builtin_amdgcn_s_sleep(1);
        if ((++sp & 255u) == 0u) { if (xb_ld(&bar[XB_TMO])) break; if (sp > XB_SPIN_CAP) { atomicAdd(&bar[XB_TMO], 1u); break; } }
    }
    nloc = mine > 0u ? mine : 1u; nx = cnt > 0u ? cnt : 1u;
}

__device__ __forceinline__ void xcd_barrier(const XcdBarrier& b) {
    asm volatile("s_waitcnt vmcnt(0)" ::: "memory");
    __syncthreads();
    if (threadIdx.x == 0) {
        unsigned* bar = b.bar;
        __builtin_amdgcn_s_waitcnt(0);
        unsigned nloc = b.st[0], nx = b.st[1];
        if (nloc == 0u) { xcd_barrier_complete(bar, b.x, nloc, nx); b.st[0] = nloc; b.st[1] = nx; }
        const unsigned old = xb_add(&bar[XB_XSUB(b.x)], 1u);
        const unsigned gen = old / nloc;
        if (old + 1u == (gen + 1u) * nloc) {
            __builtin_amdgcn_fence(__ATOMIC_RELEASE, "agent");
            asm volatile("s_waitcnt vmcnt(0)" ::: "memory");
            const unsigned og = xb_add(&bar[XB_TOP], 1u);
            const unsigned tg = og / nx;
            if (og + 1u == (tg + 1u) * nx) xb_add(&bar[XB_TOPGEN], 1u);
            else XB_SPIN(xb_ld(&bar[XB_TOPGEN]) == tg, bar);
            __builtin_amdgcn_fence(__ATOMIC_ACQUIRE, "agent");
            xb_add(&bar[XB_XGEN(b.x)], 1u);
            asm volatile("s_waitcnt vmcnt(0)" ::: "memory");
        } else {
            XB_SPIN(xb_ld(&bar[XB_XGEN(b.x)]) == gen, bar);
            __builtin_amdgcn_fence(__ATOMIC_ACQUIRE, "agent");
            asm volatile("s_waitcnt vmcnt(0)" ::: "memory");
        }
    }
    __syncthreads();
}

namespace att {
typedef short bf16x8 __attribute__((ext_vector_type(8)));
typedef short s16x4 __attribute__((ext_vector_type(4)));
typedef float f32x16 __attribute__((ext_vector_type(16)));
typedef unsigned u32x4 __attribute__((ext_vector_type(4)));
typedef unsigned short bf16_t;
typedef unsigned long long u64;
constexpr int NKB = 4, NVB = 5;
constexpr int WSF_W = 320;
constexpr int L_K0 = 0, L_V0 = NKB * 8320, L_IMP = L_V0  , L_WSF = L_V0 + NVB * 8192, L_SEL = L_WSF + 8 * WSF_W * 4, L_OST = L_SEL + 512  , L_END = L_OST + 65536;
__device__ __forceinline__ int crow(int r, int hi) { return (r & 3) + 8 * (r >> 2) + 4 * hi; }
__device__ __forceinline__ unsigned pk2(float lo, float hi) { typedef float f2 __attribute__((ext_vector_type(2))); typedef __bf16 b2 __attribute__((ext_vector_type(2)));
    f2 v = {lo, hi}; b2 b = __builtin_convertvector(v, b2); return __builtin_bit_cast(unsigned, b); }
__device__ __forceinline__ s16x4 vtr(LAS const char* p) { typedef short v4i16_t __attribute__((ext_vector_type(4))); return __builtin_bit_cast(s16x4, __builtin_amdgcn_ds_read_tr16_b64_v4i16((LAS v4i16_t*)p)); }

struct KVSrc { const GAS bf16_t* k; const GAS bf16_t* v; int pitch; int nrows; };

struct Lane { int tid, lane, r32, hi, wid; };

__device__ __forceinline__ void tile_gload(const KVSrc& S, int t, int tid, u32x4& kr, u32x4& vr) {
    const int row = 64 * t + (tid >> 3), ch = tid & 7;
    kr = *(const GAS u32x4*)(S.k + (size_t)row * S.pitch + ch * 8); vr = *(const GAS u32x4*)(S.v + (size_t)row * S.pitch + ch * 8);
}
__device__ __forceinline__ void tile_lstore(LAS char* kb, LAS char* vb, int tid, const u32x4& kr, const u32x4& vr) {
    const int key = tid >> 3, ch = tid & 7;
    *(LAS u32x4*)(kb + ch * 1040 + (key >> 5) * 512 + (key & 31) * 16) = kr;
    *(LAS u32x4*)(vb + (ch >> 2) * 4096 + (key >> 4) * 1024 + ((key >> 3) & 1) * 512 + (key & 7) * 64 + (ch & 3) * 16) = vr;
}
__device__ __forceinline__ void qk_tile(LAS const char* kbuf, const bf16x8 (&qr)[4], f32x16& p0, f32x16& p1, int r32, int hi) {
    LAS const char* kb = kbuf + hi * 1040 + r32 * 16;
#pragma unroll
    for (int d0 = 0; d0 < 4; ++d0) {
        const bf16x8 b0 = *(LAS const bf16x8*)(kb + d0 * 2080);
        const bf16x8 b1 = *(LAS const bf16x8*)(kb + d0 * 2080 + 512);
        p0 = __builtin_amdgcn_mfma_f32_32x32x16_bf16(b0, qr[d0], p0, 0, 0, 0);
        p1 = __builtin_amdgcn_mfma_f32_32x32x16_bf16(b1, qr[d0], p1, 0, 0, 0);
    }
}
__device__ __forceinline__ void qk_tile_c(LAS const char* kbuf, const bf16x8 (&qr)[4], const f32x16& negm, f32x16& p0, f32x16& p1, int r32, int hi) {
    const unsigned ka = (unsigned)(size_t)kbuf + hi * 1040 + r32 * 16;
    bf16x8 kf[8];
#pragma unroll
    for (int d0 = 0; d0 < 4; ++d0) {
        asm volatile("ds_read_b128 %0, %1 offset:%c2" : "=&v"(kf[2 * d0]) : "v"(ka), "i"(d0 * 2080) : "memory");
        asm volatile("ds_read_b128 %0, %1 offset:%c2" : "=&v"(kf[2 * d0 + 1]) : "v"(ka), "i"(d0 * 2080 + 512) : "memory");
    }
    asm volatile("s_waitcnt lgkmcnt(0)" : "+v"(kf[0]), "+v"(kf[1]), "+v"(kf[2]), "+v"(kf[3]), "+v"(kf[4]), "+v"(kf[5]), "+v"(kf[6]), "+v"(kf[7]) :: "memory");
    __builtin_amdgcn_sched_barrier(0);
    p0 = __builtin_amdgcn_mfma_f32_32x32x16_bf16(kf[0], qr[0], negm, 0, 0, 0); p1 = __builtin_amdgcn_mfma_f32_32x32x16_bf16(kf[1], qr[0], negm, 0, 0, 0);
#pragma unroll
    for (int d0 = 1; d0 < 4; ++d0) { p0 = __builtin_amdgcn_mfma_f32_32x32x16_bf16(kf[2 * d0], qr[d0], p0, 0, 0, 0); p1 = __builtin_amdgcn_mfma_f32_32x32x16_bf16(kf[2 * d0 + 1], qr[d0], p1, 0, 0, 0); }
}
__device__ __forceinline__ void pv_tile(LAS const char* vbuf, const u32x4 (&pw)[4], f32x16 (&o)[2], f32x16& ol, int lane, int hi) {
    const unsigned va = (unsigned)(size_t)vbuf + ((lane >> 4) & 1) * 32 + (lane & 3) * 8 + (4 * hi + ((lane & 15) >> 2)) * 64;
#pragma unroll
    for (int d0 = 0; d0 < 2; ++d0) {
        s16x4 lo[4], h2[4];
#pragma unroll
        for (int ks = 0; ks < 4; ++ks) {
            asm volatile("ds_read_b64_tr_b16 %0, %1 offset:%c2" : "=&v"(lo[ks]) : "v"(va), "i"(d0 * 4096 + ks * 1024) : "memory");
            asm volatile("ds_read_b64_tr_b16 %0, %1 offset:%c2" : "=&v"(h2[ks]) : "v"(va), "i"(d0 * 4096 + ks * 1024 + 512) : "memory");
        }
        asm volatile("s_waitcnt lgkmcnt(0)" : "+v"(lo[0]), "+v"(lo[1]), "+v"(lo[2]), "+v"(lo[3]), "+v"(h2[0]), "+v"(h2[1]), "+v"(h2[2]), "+v"(h2[3]) :: "memory");
        __builtin_amdgcn_sched_barrier(0);
#pragma unroll
        for (int ks = 0; ks < 4; ++ks) {
            const bf16x8 vf = (bf16x8){lo[ks][0], lo[ks][1], lo[ks][2], lo[ks][3], h2[ks][0], h2[ks][1], h2[ks][2], h2[ks][3]};
            o[d0] = __builtin_amdgcn_mfma_f32_32x32x16_bf16(__builtin_bit_cast(bf16x8, pw[ks]), vf, o[d0], 0, 0, 0);
        }
        if (d0 == 0) {
            const bf16x8 ones = (bf16x8){0x3f80, 0x3f80, 0x3f80, 0x3f80, 0x3f80, 0x3f80, 0x3f80, 0x3f80};
#pragma unroll
            for (int ks = 0; ks < 4; ++ks) ol = __builtin_amdgcn_mfma_f32_32x32x16_bf16(__builtin_bit_cast(bf16x8, pw[ks]), ones, ol, 0, 0, 0);
        }
    }
}
__device__ __forceinline__ void mask_exp_pack(f32x16& p0, f32x16& p1, u64 mask, int hi, u32x4 (&pw)[4]) {
    const bool rowuni = __all(mask == ~0ull || mask == 0ull);
    if (rowuni) {
        const unsigned rm = mask ? ~0u : 0u;
        if (__all(mask == ~0ull)) {
#pragma unroll
            for (int r = 0; r < 16; ++r) { p0[r] = __builtin_amdgcn_exp2f(p0[r]); p1[r] = __builtin_amdgcn_exp2f(p1[r]); }
        } else {
#pragma unroll
            for (int r = 0; r < 16; ++r) { p0[r] = __uint_as_float(__float_as_uint(__builtin_amdgcn_exp2f(p0[r])) & rm); p1[r] = __uint_as_float(__float_as_uint(__builtin_amdgcn_exp2f(p1[r])) & rm); }
        }
    } else {
        const int m0 = (int)(unsigned)(mask >> (4 * hi)), m1 = (int)(unsigned)(mask >> (32 + 4 * hi));
#pragma unroll
        for (int r = 0; r < 16; ++r) { const int bit = (r & 3) + 8 * (r >> 2);
            const unsigned e0 = __float_as_uint(__builtin_amdgcn_exp2f(p0[r])), e1 = __float_as_uint(__builtin_amdgcn_exp2f(p1[r]));
            unsigned k0, k1;
            asm("v_bfe_i32 %0, %1, %2, 1" : "=v"(k0) : "v"(m0), "n"(bit)); asm("v_bfe_i32 %0, %1, %2, 1" : "=v"(k1) : "v"(m1), "n"(bit));
            p0[r] = __uint_as_float(e0 & k0); p1[r] = __uint_as_float(e1 & k1); }
    }
    pw[0] = (u32x4){pk2(p0[0], p0[1]), pk2(p0[2], p0[3]), pk2(p0[4], p0[5]), pk2(p0[6], p0[7])};
    pw[1] = (u32x4){pk2(p0[8], p0[9]), pk2(p0[10], p0[11]), pk2(p0[12], p0[13]), pk2(p0[14], p0[15])};
    pw[2] = (u32x4){pk2(p1[0], p1[1]), pk2(p1[2], p1[3]), pk2(p1[4], p1[5]), pk2(p1[6], p1[7])};
    pw[3] = (u32x4){pk2(p1[8], p1[9]), pk2(p1[10], p1[11]), pk2(p1[12], p1[13]), pk2(p1[14], p1[15])};
}
__device__ __forceinline__ u64 mask_le(int c) { return c >= 63 ? ~0ull : (c < 0 ? 0ull : ((2ull << c) - 1ull)); }
__device__ __forceinline__ u64 mask_ge(int a) { return a <= 0 ? ~0ull : (a > 63 ? 0ull : (~0ull << a)); }


__device__ __forceinline__ void glds16(const GAS void* gsrc, unsigned lds_dst) { unsigned keep;
    asm volatile("s_mov_b32 %0, m0\n\ts_mov_b32 m0, %2\n\ts_nop 0\n\tglobal_load_lds_dwordx4 %1, off\n\ts_mov_b32 m0, %0" : "=&s"(keep) : "v"(gsrc), "s"(lds_dst) : "memory"); }
__device__ __forceinline__ void tile_dma(const KVSrc& S, int t, unsigned kslot, unsigned vslot, const Lane& L) {
    const GAS bf16_t* ks = S.k + (size_t)(64 * t + L.lane) * S.pitch + L.wid * 8;
    const GAS bf16_t* vs = S.v + (size_t)(64 * t + 16 * (L.wid & 3) + (L.lane >> 2)) * S.pitch + (L.wid >> 2) * 32 + (L.lane & 3) * 8;
    glds16(ks, (unsigned)__builtin_amdgcn_readfirstlane(kslot + L.wid * 1040));
    glds16(vs, (unsigned)__builtin_amdgcn_readfirstlane(vslot + (L.wid >> 2) * 4096 + (L.wid & 3) * 1024));
}
#define ATT_WAIT_BAR(N) asm volatile("s_waitcnt vmcnt(" #N ") lgkmcnt(0)\n\ts_barrier" ::: "memory")
template <class MF>
__device__ __forceinline__ void attend_range(LAS char* lds, const KVSrc& S, int t0, int t1, const MF& mf, const bf16x8 (&qr)[4], float negC, f32x16& ol, f32x16 (&o)[2], const Lane& L, bool abl = false) {
    if (t0 >= t1) return;
    const bool late = L.wid >= 4;
    const unsigned lds0 = (unsigned)(size_t)lds;
    const f32x16 negm = {0.f, 0.f, 0.f, 0.f, 0.f, 0.f, 0.f, 0.f, 0.f, 0.f, 0.f, 0.f, 0.f, 0.f, 0.f, 0.f};
    (void)negC;
    tile_dma(S, t0, lds0 + L_K0, lds0 + L_V0, L);
    if (t0 + 1 < t1) tile_dma(S, t0 + 1, lds0 + L_K0 + 8320, lds0 + L_V0 + 8192, L);
    if (t0 + 2 < t1) tile_dma(S, t0 + 2, lds0 + L_K0 + 2 * 8320, lds0 + L_V0 + 2 * 8192, L);
    if (t0 + 2 < t1) ATT_WAIT_BAR(4); else if (t0 + 1 < t1) ATT_WAIT_BAR(2); else ATT_WAIT_BAR(0);
    u32x4 pwp[4];
#pragma unroll
    for (int k = 0; k < 4; ++k) asm volatile("" : "=v"(pwp[k]));
    int kcur = 0, vcur = 0, vprev = 0;
    u64 mk_next = mf(t0);
#if defined(PROBE_ABL) && PROBE_ABL == 12
    if (abl) { for (int t = t0; t < t1; ++t) { asm volatile("s_nop 0" ::: "memory"); } return; }
#endif
#if defined(PROBE_ABL) && PROBE_ABL == 13
    if (abl) { for (int t = t0; t < t1; ++t) { ATT_WAIT_BAR(0); } return; }
#endif
#if defined(PROBE_ABL) && PROBE_ABL == 14
    if (abl) { u64 acc_ = 0; for (int t = t0; t < t1; ++t) { acc_ ^= mf(t); asm volatile("s_waitcnt lgkmcnt(0)" : "+v"(acc_) :: "memory"); } asm volatile("" :: "v"(acc_)); return; }
#endif
#if defined(PROBE_ABL) && PROBE_ABL == 15
    if (abl) { for (int t = t0; t < t1; ++t) { f32x16 p0, p1; qk_tile_c(lds + L_K0, qr, negm, p0, p1, L.r32, L.hi); asm volatile("" :: "v"(p0), "v"(p1)); } return; }
#endif
#pragma unroll 1
    for (int t = t0; t < t1; ++t) {
        const u64 mk = mk_next;
        if (t + 1 < t1) mk_next = mf(t + 1);
#if defined(PROBE_ABL) && PROBE_ABL >= 10
        if (t + 3 < t1 && !abl) {
#else
        if (t + 3 < t1) {
#endif
            const int ks = kcur == 0 ? NKB - 1 : kcur - 1; int vs = vcur + 3; vs = vs >= NVB ? vs - NVB : vs;
            tile_dma(S, t + 3, lds0 + L_K0 + ks * 8320, lds0 + L_V0 + vs * 8192, L); }
#if defined(PROBE_ABL) && (PROBE_ABL == 6 || PROBE_ABL >= 10)
        if (late && t > t0 && !abl) pv_tile(lds + L_V0 + vprev * 8192, pwp, o, ol, L.lane, L.hi);
#else
        if (late && t > t0) pv_tile(lds + L_V0 + vprev * 8192, pwp, o, ol, L.lane, L.hi);
#endif
        f32x16 p0, p1;
#if defined(PROBE_ABL) && (PROBE_ABL == 6 || PROBE_ABL >= 10)
        if (abl) { p0 = negm; p1 = negm; asm volatile("" : "+v"(p0), "+v"(p1)); } else
#endif
        qk_tile_c(lds + L_K0 + kcur * 8320, qr, negm, p0, p1, L.r32, L.hi);
        u32x4 pw[4];
#if defined(PROBE_ABL) && (PROBE_ABL == 2 || PROBE_ABL >= 10)
        if (abl) {
#pragma unroll
            for (int k = 0; k < 4; ++k) pw[k] = (u32x4){__float_as_uint(p0[4 * k]) ^ (unsigned)mk, __float_as_uint(p0[4 * k + 1]), __float_as_uint(p1[4 * k + 2]), __float_as_uint(p1[4 * k + 3])}; }
        else
#endif
        mask_exp_pack(p0, p1, mk, L.hi, pw);
#if defined(PROBE_ABL) && (PROBE_ABL == 6 || PROBE_ABL >= 10)
        if (!late && !abl) pv_tile(lds + L_V0 + vcur * 8192, pw, o, ol, L.lane, L.hi);
        else if (!late) { asm volatile("" :: "v"(pw[0]), "v"(pw[1]), "v"(pw[2]), "v"(pw[3])); }
#else
        if (!late) pv_tile(lds + L_V0 + vcur * 8192, pw, o, ol, L.lane, L.hi);
#endif
        else {
#pragma unroll
            for (int k = 0; k < 4; ++k) pwp[k] = pw[k]; }
#if defined(PROBE_ABL) && PROBE_ABL == 11
        if (abl) { asm volatile("s_waitcnt lgkmcnt(0)" ::: "memory"); } else
#endif
        if (t + 3 < t1) ATT_WAIT_BAR(4); else if (t + 2 < t1) ATT_WAIT_BAR(2); else ATT_WAIT_BAR(0);
        vprev = vcur; vcur = vcur == NVB - 1 ? 0 : vcur + 1; kcur = kcur == NKB - 1 ? 0 : kcur + 1;
    }
    if (late) pv_tile(lds + L_V0 + vprev * 8192, pwp, o, ol, L.lane, L.hi);
    ATT_WAIT_BAR(0);
}
__device__ __forceinline__ void rows_to_regs(LAS float* wsf, float v, int r32, int hi, float (&sc)[16]) {
    asm volatile("s_waitcnt lgkmcnt(0)" ::: "memory");
    if (hi == 0) wsf[r32] = v;
    asm volatile("s_waitcnt lgkmcnt(0)" ::: "memory");
#pragma unroll
    for (int r = 0; r < 16; ++r) sc[r] = wsf[crow(r, hi)];
}
__device__ __forceinline__ void load_q(const bf16_t* qrow, int hi, bf16x8 (&qr)[4]) {
#pragma unroll
    for (int d0 = 0; d0 < 4; ++d0) qr[d0] = *(const GAS bf16x8*)(qrow + d0 * 16 + hi * 8);
}
template <class RowPtr>
__device__ __forceinline__ void store_o(LAS char* stage, const f32x16 (&acc)[2], const RowPtr& rowptr, int lane, int r32, int hi) {
    LAS bf16_t* stg = (LAS bf16_t*)stage;
#pragma unroll
    for (int r = 0; r < 16; ++r) { const int orow = crow(r, hi);
#pragma unroll
        for (int d0 = 0; d0 < 2; ++d0) stg[orow * 64 + d0 * 32 + r32] = (bf16_t)(pk2(acc[d0][r], 0.f) & 0xffffu); }
    asm volatile("s_waitcnt lgkmcnt(0)" ::: "memory");
#pragma unroll
    for (int i = 0; i < 4; ++i) { const int row = i * 8 + (lane >> 3), ch = lane & 7; const u32x4 v = *(LAS const u32x4*)(stg + row * 64 + ch * 8); *(GAS u32x4*)(rowptr(row) + ch * 8) = v; }
    asm volatile("s_waitcnt lgkmcnt(0)" ::: "memory");
}
}

constexpr int NWAVES = 8;
constexpr int BATCH = 4, SEQ = 4096, DM = 1024, DFF = 4096, DEPTH = 2, D_IN = 6236;
constexpr int M = BATCH * SEQ;
constexpr size_t MiB = 1u << 20;
constexpr size_t WS_ZQ = 0;
constexpr size_t WS_ZKV = 48 * MiB;
constexpr size_t WS_YS = WS_ZKV;
constexpr size_t WS_MB = 104 * MiB;
constexpr size_t WS_KC2 = WS_MB, WS_VC2 = WS_MB + 4 * MiB;
constexpr size_t WS_PART = 112 * MiB;
constexpr size_t WS_XB = 136 * MiB;
constexpr size_t WS_W = 168 * MiB, W_LAYER = 36 * MiB;
constexpr size_t W_IN = 0, W_G = 7 * MiB, W_BR = 13 * MiB, W_OUT = 16 * MiB, W_UP = 18 * MiB, W_DN = 26 * MiB, W_CK1 = 34 * MiB, W_CV1 = 35 * MiB;
constexpr size_t WS_BM = 240 * MiB;
constexpr size_t WS_MISC = 248 * MiB;
constexpr size_t WS_CTL = WS_MISC, CTL_BYTES = 128 * 1024;
constexpr size_t WS_COS = WS_MISC + 1 * MiB, WS_SIN = WS_MISC + 1 * MiB + 512 * 1024;
constexpr size_t WS_KCMP = WS_MISC + 2 * MiB;
constexpr size_t WS_SSQ = WS_MISC + 2 * MiB + 512 * 1024;
constexpr size_t WS_B1P = WS_MISC + 3 * MiB + 512 * 1024;
constexpr size_t WS_W2 = WS_B1P + 64 * 1024;
constexpr size_t WS_IKF = WS_MISC + 4 * MiB;
constexpr size_t WS_HMID = 0;
constexpr size_t WS_END = 256 * MiB;
constexpr int CW_BAR = 4096, CW_Q = 8192, CW_KMAX = 12288;
constexpr int LDS_BYTES = 163840, LDS_UNIT = 163776;
constexpr float C2 = 0.125f * 1.4426950408889634f, LOG2E = 1.4426950408889634f;


struct Args { const float* in[17]; float* out; unsigned char* ws; };
struct Frame {
    LAS unsigned char* lds;
    gu32* ctl;
    int tid, lane, wave, G, gw, NGW;
    unsigned char* ws;
    const struct Args* a;
};
__device__ __forceinline__ float wave_sum(float v) {
#pragma unroll
    for (int o = 1; o < 64; o <<= 1) v += __shfl_xor(v, o);
    return v;
}
__device__ __forceinline__ float wave_max(float v) {
#pragma unroll
    for (int o = 1; o < 64; o <<= 1) v = fmaxf(v, __shfl_xor(v, o));
    return v;
}
__device__ __forceinline__ float bf2f(bf16 h) { return __uint_as_float((unsigned)h << 16); }
__device__ __constant__ float c_inv_freq[32] = {
    1.0f, 0.7498942093324559f, 0.5623413251903491f, 0.4216965034285822f, 0.31622776601683794f, 0.23713737056616552f, 0.1778279410038923f, 0.1333521432163324f,
    0.1f, 0.07498942093324558f, 0.05623413251903491f, 0.042169650342858224f, 0.03162277660168379f, 0.023713737056616554f, 0.01778279410038923f, 0.01333521432163324f,
    0.01f, 0.007498942093324558f, 0.005623413251903491f, 0.004216965034285823f, 0.0031622776601683794f, 0.0023713737056616554f, 0.0017782794100389228f, 0.001333521432163324f,
    0.001f, 0.0007498942093324559f, 0.0005623413251903491f, 0.00042169650342858224f, 0.00031622776601683794f, 0.00023713737056616554f, 0.00017782794100389227f, 0.0001333521432163324f};

__device__ __forceinline__ int mix_src_col(int j) {
    if (j < 512) return j;
    if (j < 1024) return 1092 + (j - 512);
    if (j < 1536) return 1860 + (j - 1024);
    if (j < 1792) return 512 + (j - 1536);
    if (j < 2048) return 1604 + (j - 1792);
    if (j < 2304) return 2372 + (j - 2048);
    if (j < 2560) return 2628 + (j - 2304);
    if (j < 2816) return 2884 + (j - 2560);
    if (j < 3072) return 768 + (j - 2816);
    const int r = j - 3072;
    if (r < 64) return 1024 + r;
    if (r < 68) return 1088 + (r - 64);
    if (r < 92) return 3140 + (r - 68);
    return -1;
}
template <int MODE>
__device__ __forceinline__ void p0_item(const float* W, int ldw, int K, bf16* WT, int nblk, int item, const float* gain, int coff, LAS float* scr, int lane) {
    const int kb = item / nblk, nb = item % nblk, k0 = 64 * kb, n0 = 32 * nb;
    const int nq = 4 * (lane & 7), rr = lane >> 3;
    const int sc = MODE == 0 ? (n0 + nq + coff) : mix_src_col(n0 + nq);
    f32x4 v[8];
#pragma unroll
    for (int i = 0; i < 8; ++i) { v[i] = (f32x4){0.f, 0.f, 0.f, 0.f}; if (sc >= 0) v[i] = *(const GAS f32x4*)(W + (size_t)(k0 + 8 * i + rr) * ldw + sc); }
#pragma unroll
    for (int i = 0; i < 8; ++i) { const int kk = 8 * i + rr; const float g = gain ? gain[k0 + kk] : 1.0f;
        scr[kk * 33 + nq + 0] = v[i][0] * g; scr[kk * 33 + nq + 1] = v[i][1] * g; scr[kk * 33 + nq + 2] = v[i][2] * g; scr[kk * 33 + nq + 3] = v[i][3] * g; }
    LDS_WAIT(); asm volatile("" ::: "memory");
    const int c = lane & 7;
#pragma unroll
    for (int j = 0; j < 4; ++j) { const int n = (lane >> 3) + 8 * j; const LAS float* s = scr + (8 * c) * 33 + n;
        v4u o; o.x = pk2(s[0 * 33], s[1 * 33]); o.y = pk2(s[2 * 33], s[3 * 33]); o.z = pk2(s[4 * 33], s[5 * 33]); o.w = pk2(s[6 * 33], s[7 * 33]);
        *(GAS v4u*)(WT + (size_t)(n0 + n) * K + k0 + 8 * c) = o; }
    LDS_WAIT(); asm volatile("" ::: "memory");
}
__device__ __forceinline__ void p0_prologue(Frame& F) {
    LAS float* scr = (LAS float*)(F.lds + F.wave * 16384);
    constexpr int I_IN = 16 * 104, I_G = 16 * 96, I_BR = 8 * 32, I_OUT = 16 * 32, I_UP = 16 * 128, I_DN = 64 * 32, I_C1 = 32 * 8, I_C2 = 4 * 2;
    constexpr int PER_LAYER = I_IN + I_G + 3 * I_BR + I_OUT + I_UP + I_DN + 2 * I_C1 + 2 * I_C2;
    for (int it = F.gw; it < 2 * PER_LAYER; it += F.NGW) {
        const int l = it / PER_LAYER; int r = it % PER_LAYER;
        unsigned char* wl = F.ws + WS_W + (size_t)l * W_LAYER;
        const float* w_in = F.a->in[2] + (size_t)l * DM * D_IN;
        if (r < I_IN) { p0_item<1>(w_in, D_IN, DM, (bf16*)(wl + W_IN), 104, r, F.a->in[1] + l * DM, 0, scr, F.lane); continue; } r -= I_IN;
        if (r < I_G) { p0_item<0>(w_in, D_IN, DM, (bf16*)(wl + W_G), 96, r, F.a->in[1] + l * DM, 3164, scr, F.lane); continue; } r -= I_G;
        if (r < 3 * I_BR) { const int n = r / I_BR; p0_item<0>(F.a->in[12] + ((size_t)l * 3 + n) * 512 * DM, DM, 512, (bf16*)(wl + W_BR) + (size_t)n * DM * 512, 32, r % I_BR, nullptr, 0, scr, F.lane); continue; } r -= 3 * I_BR;
        if (r < I_OUT) { p0_item<0>(F.a->in[13] + (size_t)l * DM * DM, DM, DM, (bf16*)(wl + W_OUT), 32, r, nullptr, 0, scr, F.lane); continue; } r -= I_OUT;
        if (r < I_UP) { p0_item<0>(F.a->in[15] + (size_t)l * DM * DFF, DFF, DM, (bf16*)(wl + W_UP), 128, r, F.a->in[14] + l * DM, 0, scr, F.lane); continue; } r -= I_UP;
        if (r < I_DN) { p0_item<0>(F.a->in[16] + (size_t)l * DFF * DM, DM, DFF, (bf16*)(wl + W_DN), 32, r, nullptr, 0, scr, F.lane); continue; } r -= I_DN;
        if (r < I_C1) { p0_item<0>(F.a->in[8] + (size_t)l * 2048 * 256, 256, 2048, (bf16*)(wl + W_CK1), 8, r, nullptr, 0, scr, F.lane); continue; } r -= I_C1;
        if (r < I_C1) { p0_item<0>(F.a->in[10] + (size_t)l * 2048 * 256, 256, 2048, (bf16*)(wl + W_CV1), 8, r, nullptr, 0, scr, F.lane); continue; } r -= I_C1;
        if (r < I_C2) { p0_item<0>(F.a->in[9] + (size_t)l * 256 * 64, 64, 256, (bf16*)(F.ws + WS_W2) + (size_t)(l * 2 + 0) * 64 * 256, 2, r, nullptr, 0, scr, F.lane); continue; } r -= I_C2;
        p0_item<0>(F.a->in[11] + (size_t)l * 256 * 64, 64, 256, (bf16*)(F.ws + WS_W2) + (size_t)(l * 2 + 1) * 64 * 256, 2, r, nullptr, 0, scr, F.lane);
    }
    for (int it = F.gw; it < 128; it += F.NGW) {
        const int kp = it & 7, jb = (it >> 3) & 3, which = (it >> 5) & 1, l = it >> 6; const int j = jb * 64 + F.lane;
        const float* pe = (which ? F.a->in[7] : F.a->in[6]) + l * 2048; const float* w1 = (which ? F.a->in[10] : F.a->in[8]) + (size_t)l * 2048 * 256;
        float a = 0.f;
        for (int k = kp * 256; k < kp * 256 + 256; ++k) a = fmaf(pe[k], w1[(size_t)k * 256 + j], a);
        ((float*)(F.ws + WS_B1P))[((l * 2 + which) * 8 + kp) * 256 + j] = a;
    }
    for (int m = F.gw; m < M; m += F.NGW) {
        const GAS f32x4* xr = (const GAS f32x4*)(F.a->in[0] + (size_t)m * DM) + F.lane;
        GAS unsigned long long* o8 = (GAS unsigned long long*)((bf16*)(F.ws + WS_XB) + (size_t)m * DM) + F.lane;
        float s = 0.f;
#pragma unroll
        for (int j = 0; j < 4; ++j) { const f32x4 v = xr[64 * j]; s += (v.x * v.x + v.y * v.y) + (v.z * v.z + v.w * v.w);
            o8[64 * j] = (unsigned long long)pk2(v.x, v.y) | ((unsigned long long)pk2(v.z, v.w) << 32); }
        s = wave_sum(s);
        if (F.lane < 16) ((float*)(F.ws + WS_SSQ))[(size_t)m * 16 + F.lane] = F.lane == 0 ? s : 0.f;
    }
    for (int i = F.gw * 64 + F.lane; i < SEQ * 32; i += F.NGW * 64) {
        const float ang = (float)(i >> 5) * c_inv_freq[i & 31];
        ((float*)(F.ws + WS_COS))[i] = (float)cos((double)ang); ((float*)(F.ws + WS_SIN))[i] = (float)sin((double)ang);
    }
}
typedef unsigned u32x4_t __attribute__((ext_vector_type(4)));
__device__ __forceinline__ void post_group(u32x4_t raw, bool act, bool norm, bool rope, const float (&gain)[8], float scale, const float (&cs)[8], const float (&sn)[8], int lane, bf16* dst) {
    float v[8];
    v[0] = __uint_as_float(raw.x << 16); v[1] = __uint_as_float(raw.x & 0xffff0000u); v[2] = __uint_as_float(raw.y << 16); v[3] = __uint_as_float(raw.y & 0xffff0000u);
    v[4] = __uint_as_float(raw.z << 16); v[5] = __uint_as_float(raw.z & 0xffff0000u); v[6] = __uint_as_float(raw.w << 16); v[7] = __uint_as_float(raw.w & 0xffff0000u);
    float ss = ((v[0] * v[0] + v[1] * v[1]) + (v[2] * v[2] + v[3] * v[3])) + ((v[4] * v[4] + v[5] * v[5]) + (v[6] * v[6] + v[7] * v[7]));
    ss += __shfl_xor(ss, 1); ss += __shfl_xor(ss, 2); ss += __shfl_xor(ss, 4);
    const float rs = norm ? rsqrtf(ss * (1.0f / 64.0f) + 1e-6f) : 1.0f;
    const bool lo = (lane & 4) == 0;
    float r[8];
#pragma unroll
    for (int j = 0; j < 8; ++j) { const float x = norm ? v[j] * rs * gain[j] : v[j]; const float o = __shfl_xor(x, 4);
        r[j] = rope ? (lo ? (x * cs[j] - o * sn[j]) : (x * cs[j] + o * sn[j])) : x; r[j] *= scale; }
    if (act) { u32x4_t w; w.x = pk2(r[0], r[1]); w.y = pk2(r[2], r[3]); w.z = pk2(r[4], r[5]); w.w = pk2(r[6], r[7]); *(GAS u32x4_t*)dst = w; }
}
__device__ __forceinline__ void post_phase(Frame& F, int l, bool dry = false) {
    const float* qn = F.a->in[3] + l * 192; const float* kn = F.a->in[4] + l * 192;
    const int lane = F.lane, g = lane >> 3, c = lane & 7;
    float gq0[8], gq1[8], gq2[8], gk3[8], gk2[8];
#pragma unroll
    for (int j = 0; j < 8; ++j) { gq0[j] = qn[8 * c + j]; gq1[j] = qn[64 + 8 * c + j]; gq2[j] = qn[128 + 8 * c + j]; gk2[j] = kn[128 + 8 * c + j];
        gk3[j] = (g >> 1) == 0 ? kn[8 * c + j] : ((g >> 1) == 1 ? kn[64 + 8 * c + j] : kn[128 + 8 * c + j]); }
    bf16* zq = (bf16*)(F.ws + WS_ZQ); bf16* zkv = (bf16*)(F.ws + WS_ZKV);
    const float* cst = (const float*)(F.ws + WS_COS); const float* snt = (const float*)(F.ws + WS_SIN);
#pragma unroll 1
    for (int m = F.gw; m < M; m += F.NGW) {
        const int t = m & (SEQ - 1), b = m >> 12;
        float cs[8], sn[8];
        { const GAS f32x4* cp = (const GAS f32x4*)(cst + t * 32 + 8 * (c & 3)); const GAS f32x4* sp = (const GAS f32x4*)(snt + t * 32 + 8 * (c & 3));
          const f32x4 c0 = cp[0], c1 = cp[1], s0 = sp[0], s1 = sp[1];
          cs[0] = c0[0]; cs[1] = c0[1]; cs[2] = c0[2]; cs[3] = c0[3]; cs[4] = c1[0]; cs[5] = c1[1]; cs[6] = c1[2]; cs[7] = c1[3];
          sn[0] = s0[0]; sn[1] = s0[1]; sn[2] = s0[2]; sn[3] = s0[3]; sn[4] = s1[0]; sn[5] = s1[1]; sn[6] = s1[2]; sn[7] = s1[3]; }
        bf16* pqa = zq + (size_t)m * 512 + lane * 8; bf16* pqb = pqa + (size_t)M * 512; bf16* pqc = pqa + (size_t)2 * M * 512;
        const int t3 = (g >> 1) < 2 ? (g >> 1) : (g >> 1) + 1;
        bf16* p3 = zkv + (size_t)t3 * M * 256 + (size_t)m * 256 + (g & 1) * 64 + c * 8;
        const bf16* s4 = g < 4 ? zkv + (size_t)2 * M * 256 + (size_t)m * 256 + g * 64 + c * 8 : zkv + (size_t)5 * M * 256 + (size_t)m * 256 + (g - 4) * 64 + c * 8;
        bf16* d4 = g < 2 ? (bf16*)(F.ws + WS_KC2) + ((size_t)(b * 2 + g) * SEQ + t) * 64 + c * 8
                 : (g < 4 ? (bf16*)(F.ws + WS_VC2) + ((size_t)(b * 2 + (g - 2)) * SEQ + t) * 64 + c * 8 : (bf16*)s4);
        const bf16* p5 = zkv + (size_t)6 * M * 256 + (size_t)m * 256 + c * 8;
        bf16* d5 = (bf16*)(F.ws + WS_IKF) + ((size_t)(b * (SEQ / 32) + (t >> 5)) * 8 + c) * 256 + (t & 31) * 8;
        const u32x4_t r0 = *(const GAS u32x4_t*)pqa, r1 = *(const GAS u32x4_t*)pqb, r2 = *(const GAS u32x4_t*)pqc, r3 = *(const GAS u32x4_t*)p3, r4 = *(const GAS u32x4_t*)s4;
        u32x4_t r5;
        { const int cg = (g == 1 && c < 4) ? 8 + c : c;
          const float* pp = (const float*)(F.ws + WS_PART) + (size_t)m * 96 + cg * 8;
          f32x4 s0 = *(const GAS f32x4*)pp, s1 = *(const GAS f32x4*)(pp + 4);
#pragma unroll
          for (int kq = 1; kq < 4; ++kq) { s0 += *(const GAS f32x4*)(pp + (size_t)kq * M * 96); s1 += *(const GAS f32x4*)(pp + (size_t)kq * M * 96 + 4); }
          const float rs = pg8::row_rstd((const float*)(F.ws + WS_SSQ), m);
          r5.x = pk2(s0[0] * rs, s0[1] * rs); r5.y = pk2(s0[2] * rs, s0[3] * rs); r5.z = pk2(s1[0] * rs, s1[1] * rs); r5.w = pk2(s1[2] * rs, s1[3] * rs);
          if (g == 1 && c < 4 && !dry) *(GAS u32x4_t*)(zkv + (size_t)6 * M * 256 + (size_t)m * 256 + 64 + c * 8) = r5; }
        post_group(r0, !dry, true, true, gq0, C2, cs, sn, lane, pqa);
        post_group(r1, !dry, true, true, gq1, C2, cs, sn, lane, pqb);
        post_group(r2, !dry, true, true, gq2, C2, cs, sn, lane, pqc);
        post_group(r3, !dry, true, true, gk3, 1.f, cs, sn, lane, p3);
        post_group(r4, !dry, g < 2, g < 2 || g >= 4, gk2, 1.f, cs, sn, lane, d4);
        post_group(r5, g == 0 && !dry, false, true, gk2, 1.f, cs, sn, lane, d5);
    }
}

#define WAVE_LDS_FENCE() asm volatile("s_waitcnt lgkmcnt(0)" ::: "memory")
__device__ __forceinline__ int next_unit(Frame& F, gu32* counter) {
    LAS int* slot = (LAS int*)(F.lds + LDS_UNIT);
    __syncthreads();
    if (F.tid == 0) *slot = (int)__hip_atomic_fetch_add(counter, 1u, RLX_AGENT);
    __syncthreads();
    return *slot;
}
__device__ __forceinline__ unsigned f2key(float f) { const unsigned u = __float_as_uint(f); return (u & 0x80000000u) ? ~u : (u | 0x80000000u); }
__device__ __forceinline__ float dpp_quad_sum(float v) {
    v += __int_as_float(__builtin_amdgcn_update_dpp(0, __float_as_int(v), 0xB1, 0xF, 0xF, true));
    v += __int_as_float(__builtin_amdgcn_update_dpp(0, __float_as_int(v), 0x4E, 0xF, 0xF, true));
    return v;
}
__device__ __forceinline__ void radix_select_list(LAS const unsigned* list, int nblk, int k, LAS unsigned* hist, int lane, unsigned& T, int& need, int npass = 4) {
    typedef unsigned u32x4_ __attribute__((ext_vector_type(4)));
    unsigned prefix = 0u; int kk = k;
#pragma unroll 1
    for (int pass = 0; pass < npass; ++pass) {
        const int shift = 24 - 8 * pass;
#pragma unroll
        for (int i = 0; i < 4; ++i) hist[lane * 4 + i] = 0u;
        WAVE_LDS_FENCE();
#pragma unroll 2
        for (int jb = 0; jb < nblk; ++jb) { const u32x4_ v = *(LAS const u32x4_*)(list + jb * 256 + lane * 4);
#pragma unroll
            for (int c = 0; c < 4; ++c) { const unsigned key = v[c];
                const unsigned bin = (pass == 0 || (key >> (shift + 8)) == prefix) ? ((key >> shift) & 255u) : 256u + (unsigned)lane;
                __hip_atomic_fetch_add(&hist[bin], 1u, __ATOMIC_RELAXED, __HIP_MEMORY_SCOPE_WORKGROUP); } }
        WAVE_LDS_FENCE();
        const unsigned h0 = hist[lane * 4], h1 = hist[lane * 4 + 1], h2 = hist[lane * 4 + 2], h3 = hist[lane * 4 + 3];
        const int tot4 = (int)(h0 + h1 + h2 + h3);
        int pre = tot4;
        pre += __builtin_amdgcn_update_dpp(0, pre, 0x111, 0xf, 0xf, false);
        pre += __builtin_amdgcn_update_dpp(0, pre, 0x112, 0xf, 0xf, false);
        pre += __builtin_amdgcn_update_dpp(0, pre, 0x114, 0xf, 0xf, false);
        pre += __builtin_amdgcn_update_dpp(0, pre, 0x118, 0xf, 0xf, false);
        pre += __builtin_amdgcn_update_dpp(0, pre, 0x142, 0xa, 0xf, false);
        pre += __builtin_amdgcn_update_dpp(0, pre, 0x143, 0xc, 0xf, false);
        const int total = __builtin_amdgcn_readlane(pre, 63);
        const int above = total - pre;
        const int a3 = above, a2 = a3 + (int)h3, a1 = a2 + (int)h2, a0 = a1 + (int)h1;
        int dsel = -1, nk = 0;
        if (a3 < kk && kk <= a3 + (int)h3) { dsel = lane * 4 + 3; nk = kk - a3; }
        else if (a2 < kk && kk <= a2 + (int)h2) { dsel = lane * 4 + 2; nk = kk - a2; }
        else if (a1 < kk && kk <= a1 + (int)h1) { dsel = lane * 4 + 1; nk = kk - a1; }
        else if (a0 < kk && kk <= a0 + (int)h0) { dsel = lane * 4 + 0; nk = kk - a0; }
        const unsigned long long bal = __ballot(dsel >= 0);
        const int src = (int)__builtin_ctzll(bal);
        dsel = __builtin_amdgcn_readlane(dsel, src); nk = __builtin_amdgcn_readlane(nk, src);
        WAVE_LDS_FENCE();
        prefix = (prefix << 8) | (unsigned)dsel; kk = nk;
    }
    T = prefix << (32 - 8 * npass); need = kk;
}
__device__ __forceinline__ void select_unit(Frame& F, int b, int qblk, int abl = 0) {
    using namespace att;
    int tid_ = F.tid; asm volatile("" : "+v"(tid_));
    const int lane = tid_ & 63, r32 = lane & 31, hi = lane >> 5, w = F.wave;
    LAS unsigned* sc = (LAS unsigned*)F.lds;
    LAS unsigned* hist = (LAS unsigned*)(F.lds + 131072) + w * 320;
    LAS unsigned* cand = (LAS unsigned*)(F.lds + 131072 + 10240) + w * 512;
    const int t0 = qblk * 8; const size_t m0 = (size_t)b * SEQ + t0;
    const bf16* IQ = (const bf16*)(F.ws + WS_ZKV) + (size_t)5 * M * 256; const bf16* MISC = (const bf16*)(F.ws + WS_ZKV) + (size_t)6 * M * 256;
    const bf16* IKF = (const bf16*)(F.ws + WS_IKF) + (size_t)b * SEQ * 64;
    u64* BM = (u64*)(F.ws + WS_BM);
    const int nkeys = t0 + 8;
    if (nkeys > 256 && abl < 2) {
        bf16x8 iqf[4];
        { const bf16* qrow = IQ + (m0 + (r32 >> 2)) * 256 + (r32 & 3) * 64;
#pragma unroll
          for (int d0 = 0; d0 < 4; ++d0) iqf[d0] = *(const GAS bf16x8*)(qrow + d0 * 16 + hi * 8); }
        const float wl = bf2f(((const GAS bf16*)MISC)[(m0 + (r32 >> 2)) * 256 + 64 + (r32 & 3)]);
        const int ntile = (nkeys + 31) >> 5; const int g = r32 & 3;
#pragma unroll 1
        for (int tile0 = w; tile0 < ntile; tile0 += 16) {
            bf16x8 kf[2][4];
#pragma unroll
            for (int u = 0; u < 2; ++u) { const int tile = tile0 + 8 * u < ntile ? tile0 + 8 * u : tile0;
                const bf16* kt = IKF + (size_t)tile * 2048 + hi * 256 + r32 * 8;
#pragma unroll
                for (int d0 = 0; d0 < 4; ++d0) kf[u][d0] = *(const GAS bf16x8*)(kt + d0 * 512); }
#pragma unroll
            for (int u = 0; u < 2; ++u) { const int tile = tile0 + 8 * u;
                if (tile < ntile) {
                    const int s0 = tile * 32;
                    f32x16 acc;
#pragma unroll
                    for (int r = 0; r < 16; ++r) acc[r] = 0.f;
#pragma unroll
                    for (int d0 = 0; d0 < 4; ++d0) acc = __builtin_amdgcn_mfma_f32_32x32x16_bf16(kf[u][d0], iqf[d0], acc, 0, 0, 0);
                    float v[16];
#pragma unroll
                    for (int r = 0; r < 16; ++r) v[r] = dpp_quad_sum(__builtin_amdgcn_fmed3f(acc[r], 0.f, __builtin_inff()) * wl);
                    u32x4 o;
#pragma unroll
                    for (int j = 0; j < 4; ++j) o[j] = f2key(g == 0 ? v[j] : (g == 1 ? v[4 + j] : (g == 2 ? v[8 + j] : v[12 + j])));
                    *(LAS u32x4*)(sc + (r32 >> 2) * 4096 + s0 + 8 * g + 4 * hi) = o;
                } }
        }
    }
    __syncthreads();
    if (abl != 1) {
        const int t = t0 + w, n = t + 1; LAS unsigned* row = sc + w * 4096;
        u64 myword = 0ull;
        if (n <= 256) {
            const int c0 = 64 * lane;
            myword = (c0 + 63 < n) ? ~0ull : (c0 >= n ? 0ull : ((1ull << (n - c0)) - 1ull));
        } else {
            const int nblk = (n + 255) >> 8;
            { const int s = (n & ~3) + lane * 4;
              if (s < nblk * 256) { u32x4 v = *(LAS u32x4*)(row + s);
#pragma unroll
                  for (int c = 0; c < 4; ++c) if (s + c >= n) v[c] = 0u;
                  *(LAS u32x4*)(row + s) = v; } }
            WAVE_LDS_FENCE();
            unsigned T = 0u; int need = 0; bool done = false;
            if (n > 512 && abl != 5) {
#pragma unroll
                for (int c = 0; c < 8; ++c) { const int i = lane + 64 * c; cand[i] = row[(i * n) >> 9]; }
                WAVE_LDS_FENCE();
                const float er = 131072.0f / (float)n;
                int rr = (int)(er + 2.5f * __builtin_sqrtf(er * (1.0f - 256.0f / (float)n)) + 2.0f); rr = rr > 512 ? 512 : rr;
                unsigned P; int dummy; radix_select_list(cand, 2, rr, hist, lane, P, dummy, 2); P -= 1u;
                int C = 0; bool ovf = false;
#pragma unroll 1
                for (int jb = 0; jb < nblk; ++jb) { const u32x4 v = *(LAS const u32x4*)(row + jb * 256 + lane * 4);
#pragma unroll
                    for (int c = 0; c < 4; ++c) { const bool in = v[c] > P; const u64 bal = __ballot(in); const int pos = C + __builtin_popcountll(bal & ((1ull << lane) - 1ull));
                        C += __builtin_popcountll(bal); if (C > 512) ovf = true;
                        if (in && !ovf) cand[pos] = v[c]; } }
                if (!ovf && C >= 256) {
                    WAVE_LDS_FENCE();
                    const int cb = (C + 255) >> 8;
                    { const int s = C + lane; if (s < cb * 256) cand[s] = 0u; const int s2 = s + 64; if (s2 < cb * 256) cand[s2] = 0u; const int s3 = s + 128; if (s3 < cb * 256) cand[s3] = 0u; const int s4 = s + 192; if (s4 < cb * 256) cand[s4] = 0u; }
                    WAVE_LDS_FENCE();
                    radix_select_list(cand, cb, 256, hist, lane, T, need); done = true;
                }
            }
            if (!done && abl < 3) radix_select_list(row, nblk, 256, hist, lane, T, need);
            int base = 0;
            const int nch = abl >= 4 ? 0 : (n + 63) >> 6;
#pragma unroll 1
            for (int c = 0; c < nch; c += 4) {
                unsigned vv[4];
#pragma unroll
                for (int u2 = 0; u2 < 4; ++u2) vv[u2] = row[64 * (c + u2) + lane];
#pragma unroll
                for (int u2 = 0; u2 < 4; ++u2) {
                    const int s = 64 * (c + u2) + lane; const bool valid = s < n; const unsigned key = valid ? vv[u2] : 0u;
                    const bool gt = valid && key > T, eq = valid && key == T;
                    const u64 beq = __ballot(eq);
                    const int rank = base + __builtin_popcountll(beq & ((1ull << lane) - 1ull));
                    const u64 word = __ballot(gt || (eq && rank < need));
                    if (lane == c + u2) myword = word;
                    base += __builtin_popcountll(beq);
                }
            }
        }
        if (abl >= 2) ((GAS u64*)(F.ws + WS_MB + 24 * MiB))[((size_t)b * SEQ + t) * 64 + lane] = myword;
        else ((GAS u64*)BM)[((size_t)b * SEQ + t) * 64 + lane] = myword;
    }
    __syncthreads();
}
__device__ __forceinline__ void compress_unit(Frame& F, int l, int u) {
    using namespace att;
    int tid_ = F.tid; asm volatile("" : "+v"(tid_));
    const int lane = tid_ & 63, r32 = lane & 31, hi = lane >> 5, w = F.wave;
    const int which = u & 1, h = (u >> 1) & 1, b = (u >> 2) & 3, cb = u >> 4;
    const bf16* src = (const bf16*)(F.ws + (which ? WS_VC2 : WS_KC2)) + (size_t)(b * 2 + h) * SEQ * 64;
    const bf16* W1t = (const bf16*)(F.ws + WS_W + (size_t)l * W_LAYER + (which ? W_CV1 : W_CK1));
    const bf16* W2t = (const bf16*)(F.ws + WS_W2) + (size_t)(l * 2 + which) * 64 * 256;
    const float* b1p = (const float*)(F.ws + WS_B1P) + (size_t)(l * 2 + which) * 8 * 256;
    LAS bf16* hid = (LAS bf16*)F.lds;
    int cc = 32 * cb + r32; if (cc > 254) cc = 254;
    const bf16* arow = src + (size_t)(16 * cc) * 64 + hi * 8;
    const bf16* brow = W1t + (size_t)(32 * w + r32) * 2048 + hi * 8;
    f32x16 acc;
#pragma unroll
    for (int r = 0; r < 16; ++r) acc[r] = 0.f;
#pragma unroll 4
    for (int ks = 0; ks < 128; ++ks) { const bf16x8 a = *(const GAS bf16x8*)(arow + ks * 16), bb = *(const GAS bf16x8*)(brow + ks * 16); acc = __builtin_amdgcn_mfma_f32_32x32x16_bf16(a, bb, acc, 0, 0, 0); }
    float b1 = 0.f;
#pragma unroll
    for (int kp = 0; kp < 8; ++kp) b1 += ((const GAS float*)b1p)[kp * 256 + 32 * w + r32];
#pragma unroll
    for (int r = 0; r < 16; ++r) hid[crow(r, hi) * 264 + 32 * w + r32] = (bf16)f2bf(fmaxf(acc[r] + b1, 0.f));
    __syncthreads();
    if (w < 2) {
        f32x16 o;
#pragma unroll
        for (int r = 0; r < 16; ++r) o[r] = 0.f;
        const bf16* w2row = W2t + (size_t)(32 * w + r32) * 256 + hi * 8;
#pragma unroll
        for (int ks = 0; ks < 16; ++ks) { const bf16x8 a = *(LAS const bf16x8*)(hid + r32 * 264 + ks * 16 + hi * 8), bb = *(const GAS bf16x8*)(w2row + ks * 16); o = __builtin_amdgcn_mfma_f32_32x32x16_bf16(a, bb, o, 0, 0, 0); }
        bf16* dst = (bf16*)(F.ws + WS_KCMP) + ((size_t)((which * 4 + b) * 2 + h) * 256) * 64;
        float mx = 0.f;
#pragma unroll
        for (int r = 0; r < 16; ++r) { const int c = 32 * cb + crow(r, hi); const float v = c < 255 ? o[r] : 0.f; mx = fmaxf(mx, fabsf(v)); ((GAS bf16*)dst)[(size_t)c * 64 + 32 * w + r32] = (bf16)f2bf(v); }
        if (which == 0) { mx = wave_max(mx); if (lane == 0) __hip_atomic_fetch_max(F.ctl + CW_KMAX + 64 * (l * 8 + b * 2 + h), __float_as_uint(mx), RLX_AGENT); }
    }
    __syncthreads();
}
__device__ __forceinline__ void misc_phase(Frame& F, int l, int mode = 0) {
    using namespace att;
    int tid_ = F.tid; asm volatile("" : "+v"(tid_));
    const int lane = tid_ & 63, r32 = lane & 31, hi = lane >> 5, w = F.wave;
    if (w >= 6) return;
    const int task = (int)blockIdx.x * 6 + w, tile = task / 3, cb = task % 3;
    const bf16* arow = (const bf16*)(F.ws + WS_XB) + (size_t)(tile * 32 + r32) * 1024 + hi * 32;
    const bf16* brow = (const bf16*)(F.ws + WS_W + (size_t)l * W_LAYER + W_IN) + (size_t)(3072 + cb * 32 + r32) * 1024 + hi * 32;
    f32x16 acc;
#pragma unroll
    for (int r = 0; r < 16; ++r) acc[r] = 0.f;
#pragma unroll 1
    for (int it = 0; it < (mode == 1 ? 0 : 4); ++it) { const int lb = (it + w + (int)blockIdx.x) & 3;
        bf16x8 af[16], bfr[16];
#pragma unroll
        for (int i = 0; i < 16; ++i) { af[i] = *(const GAS bf16x8*)(arow + lb * 256 + (i >> 2) * 64 + (i & 3) * 8); bfr[i] = *(const GAS bf16x8*)(brow + lb * 256 + (i >> 2) * 64 + (i & 3) * 8); }
        __builtin_amdgcn_sched_barrier(0);
#pragma unroll
        for (int i = 0; i < 16; ++i) acc = __builtin_amdgcn_mfma_f32_32x32x16_bf16(af[i], bfr[i], acc, 0, 0, 0);
        __builtin_amdgcn_sched_barrier(0);
    }
    const float rv = pg8::row_rstd((const float*)(F.ws + WS_SSQ), tile * 32 + r32);
    bf16* dst = (bf16*)(F.ws + (mode ? WS_MB + 24 * MiB : WS_ZKV + (size_t)6 * M * 256 * 2)) + (size_t)(tile * 32) * 256 + cb * 32;
    LAS unsigned short* tp = (LAS unsigned short*)(F.lds + w * 4096);
#pragma unroll
    for (int r = 0; r < 16; ++r) { const int row = crow(r, hi); const float rs = __shfl(rv, row); tp[row * 40 + r32] = (unsigned short)f2bf(acc[r] * rs); }
    WAVE_LDS_FENCE();
#pragma unroll
    for (int u = 0; u < 2; ++u) { const int pc = lane + 64 * u, row = pc >> 2, q = pc & 3;
        const u32x4 v = *(LAS const u32x4*)(tp + row * 40 + q * 8);
        *(GAS u32x4*)(dst + (size_t)row * 256 + q * 8) = v; }
    WAVE_LDS_FENCE();
}
struct UnitGeom { int b, kvh, i; att::Lane L; int q; int head; size_t mrow; };
__device__ __forceinline__ UnitGeom unit_geom(Frame& F, int b, int kvh, int i) {
    int tid = F.tid; asm volatile("" : "+v"(tid));
    UnitGeom U; U.b = b; U.kvh = kvh; U.i = i; U.L.tid = tid; U.L.lane = tid & 63; U.L.r32 = tid & 31; U.L.hi = (tid >> 5) & 1; U.L.wid = F.wave;
    U.q = 64 * i + 8 * F.wave + (U.L.r32 >> 2); U.head = 4 * kvh + (U.L.r32 & 3); U.mrow = (size_t)b * SEQ + U.q; return U;
}
__device__ __forceinline__ void branch_finish(LAS float* wsf, const att::f32x16& ol, const float (&extra)[4], float rowscale, bool has_scale, const att::f32x16 (&o)[2], att::f32x16 (&acc)[2], const att::Lane& L, bool first) {
    float sc[16];
    if (has_scale) att::rows_to_regs(wsf, rowscale, L.r32, L.hi, sc);
#pragma unroll
    for (int r = 0; r < 16; ++r) { const float lf = ol[r] + extra[r & 3]; const float inv = lf > 0.f ? __builtin_amdgcn_rcpf(lf) : 0.f; sc[r] = has_scale ? sc[r] * inv : inv; }
#pragma unroll
    for (int d0 = 0; d0 < 2; ++d0)
#pragma unroll
        for (int r = 0; r < 16; ++r) acc[d0][r] = first ? o[d0][r] * sc[r] : acc[d0][r] + o[d0][r] * sc[r];
}
__device__ __forceinline__ void branch_finish_lds(LAS float* wsf, LAS float* accw, const att::f32x16& ol, float rowscale, const att::f32x16 (&o)[2], const att::Lane& L, bool first) {
    float sc[16]; att::rows_to_regs(wsf, rowscale, L.r32, L.hi, sc);
#pragma unroll
    for (int r = 0; r < 16; ++r) sc[r] = ol[r] > 0.f ? sc[r] * __builtin_amdgcn_rcpf(ol[r]) : 0.f;
#pragma unroll
    for (int d0 = 0; d0 < 2; ++d0)
#pragma unroll
        for (int r = 0; r < 16; ++r) { float v = o[d0][r] * sc[r]; if (!first) v += accw[(d0 * 16 + r) * 64 + L.lane]; accw[(d0 * 16 + r) * 64 + L.lane] = v; }
}
__device__ __forceinline__ float gain_bound(const float* g, int lane) { return wave_max(fabsf(g[lane])); }

template <int KIND  >
__device__ __forceinline__ void simple_unit(Frame& F, int l, int b, int kvh, int i, bf16* odst = nullptr) {
    using namespace att;
    const UnitGeom U = unit_geom(F, b, kvh, i); const Lane& L = U.L;
    constexpr int QT = KIND == 0 ? 1 : 0, KT = KIND == 0 ? 1 : 0, NM = KIND == 0 ? 1 : 0;
    bf16* Q = (bf16*)(F.ws + WS_ZQ) + (size_t)QT * M * 512; const bf16* KV = (const bf16*)(F.ws + WS_ZKV) + (size_t)KT * M * 256;
    bf16x8 qr[4]; load_q(Q + U.mrow * 512 + U.head * 64, L.hi, qr);
    const float C = 0.f; (void)NM;
    KVSrc S{(const GAS bf16*)(KV + (size_t)b * SEQ * 256 + kvh * 64), (const GAS bf16*)(KV + (size_t)b * SEQ * 256 + 128 + kvh * 64), 256, SEQ};
    f32x16 ol, o[2];
#pragma unroll
    for (int r = 0; r < 16; ++r) { o[0][r] = 0.f; o[1][r] = 0.f; ol[r] = 0.f; }
    const int q = U.q;
    if (KIND == 0) {
        auto mf = [q](int t) -> u64 { return mask_le(q - 64 * t) & mask_ge(q - 127 - 64 * t); };
        attend_range((LAS char*)F.lds, S, i - 2 < 0 ? 0 : i - 2, i + 1, mf, qr, -C, ol, o, L);
    } else {
        LAS char* mrows = (LAS char*)F.lds + L_OST + L.wid * 8192 + 4096;
        { const GAS u32x4* src = (const GAS u32x4*)((const GAS u64*)(F.ws + WS_BM) + ((size_t)b * SEQ + 64 * i + 8 * L.wid) * 64);
#pragma unroll
          for (int k = 0; k < 4; ++k) *(LAS u32x4*)(mrows + (k * 64 + L.lane) * 16) = src[k * 64 + L.lane];
          WAVE_LDS_FENCE(); }
        LAS const char* mrow = mrows + (L.r32 >> 2) * 512;
        auto mf = [mrow](int t) -> u64 { return *(LAS const u64*)(mrow + t * 8); };
#ifdef PROBE_TILES
        attend_range((LAS char*)F.lds, S, 0, odst ? (i + 1 < PROBE_TILES ? i + 1 : PROBE_TILES) : i + 1, mf, qr, -C, ol, o, L, odst != nullptr);
#else
        attend_range((LAS char*)F.lds, S, 0, i + 1, mf, qr, -C, ol, o, L, odst != nullptr);
#endif
    }
    const UnitGeom V = unit_geom(F, b, kvh, i); const Lane& L2 = V.L;
    float extra[4] = {0.f, 0.f, 0.f, 0.f};
    if (KIND == 0) {
#pragma unroll
        for (int g = 0; g < 4; ++g) extra[g] = __builtin_amdgcn_exp2f(F.a->in[5][l * 8 + 4 * kvh + g] * LOG2E);
    }
    f32x16 acc[2];
    branch_finish((LAS float*)((LAS char*)F.lds + L_WSF) + L2.wid * WSF_W, ol, extra, 1.f, false, o, acc, L2, true);
    bf16* Q2 = (bf16*)(F.ws + WS_ZQ) + (size_t)QT * M * 512;
    const size_t tok0 = (size_t)b * SEQ + 64 * i + 8 * L2.wid; const int kvh4 = 4 * kvh;
    bf16* Od = odst ? odst : Q2;
    auto rowptr = [Od, tok0, kvh4](int row) -> bf16* { return Od + (tok0 + (row >> 2)) * 512 + (kvh4 + (row & 3)) * 64; };
    store_o((LAS char*)F.lds + L_OST + L2.wid * 8192, acc, rowptr, L2.lane, L2.r32, L2.hi);
}
__device__ __forceinline__ void nsa_unit(Frame& F, int l, int b, int kvh, int i, bf16* odst = nullptr) {
    using namespace att;
    f32x16 o[2], ol;
    bf16x8 qr[4];
    {
        const UnitGeom U = unit_geom(F, b, kvh, i); const Lane& L = U.L;
        const bf16* Q = (const bf16*)(F.ws + WS_ZQ) + (size_t)2 * M * 512; const bf16* MISC = (const bf16*)(F.ws + WS_ZKV) + (size_t)6 * M * 256;
        load_q(Q + U.mrow * 512 + U.head * 64, L.hi, qr);
        LAS float* wsf = (LAS float*)((LAS char*)F.lds + L_WSF) + L.wid * WSF_W;
#pragma unroll
        for (int br = 0; br < 3; ++br) wsf[64 + br * 64 + L.lane] = pg8::sigmoidf_(bf2f(((const GAS bf16*)MISC)[U.mrow * 256 + 68 + U.head * 3 + br]));
        WAVE_LDS_FENCE();
    }
    const float Ck = 0.f, Cc = 0.f;
    const int qmax = 64 * i + 63; const int nvmax = qmax >= 31 ? (((qmax - 31) >> 4) + 1 < 255 ? ((qmax - 31) >> 4) + 1 : 255) : 0;
    const int tc = (nvmax + 63) >> 6;
    const bf16* kcmp = (const bf16*)(F.ws + WS_KCMP) + (size_t)((0 * 4 + b) * 2 + kvh) * 256 * 64; const bf16* vcmp = (const bf16*)(F.ws + WS_KCMP) + (size_t)((1 * 4 + b) * 2 + kvh) * 256 * 64;
    {
        const UnitGeom U = unit_geom(F, b, kvh, i); const Lane& L = U.L; const int q = U.q;
        const int nval = q >= 31 ? (((q - 31) >> 4) + 1 < 255 ? ((q - 31) >> 4) + 1 : 255) : 0;
        KVSrc Sc{(const GAS bf16*)kcmp, (const GAS bf16*)vcmp, 64, 256};
        auto mfc = [nval](int t) -> u64 { return mask_le(nval - 1 - 64 * t); };
#pragma unroll
        for (int r = 0; r < 16; ++r) { o[0][r] = 0.f; o[1][r] = 0.f; ol[r] = 0.f; }
        attend_range((LAS char*)F.lds, Sc, 0, tc, mfc, qr, -Cc, ol, o, L);
    }
    const UnitGeom U = unit_geom(F, b, kvh, i); const Lane& L = U.L; const int q = U.q;
    LAS float* wsf = (LAS float*)((LAS char*)F.lds + L_WSF) + L.wid * WSF_W;
    LAS float* accw = (LAS float*)((LAS char*)F.lds + L_OST + L.wid * 8192);
    const int nval = q >= 31 ? (((q - 31) >> 4) + 1 < 255 ? ((q - 31) >> 4) + 1 : 255) : 0;
    auto mfc = [nval](int t) -> u64 { return mask_le(nval - 1 - 64 * t); };
    WAVE_LDS_FENCE();
    if (L.r32 == 0) {
#pragma unroll
        for (int r = 0; r < 16; ++r) wsf[32 + crow(r, L.hi)] = ol[r]; }
    WAVE_LDS_FENCE();
    const float lc = wsf[32 + L.r32]; const float rlc = lc > 0.f ? __builtin_amdgcn_rcpf(lc) : 0.f;
    branch_finish_lds(wsf, accw, ol, wsf[64 + L.lane], o, L, true);
    LAS float* impw = (LAS float*)((LAS char*)F.lds + L_IMP) + L.wid * 512;
#pragma unroll
    for (int k = 0; k < 8; ++k) impw[L.lane + 64 * k] = 0.f;
    WAVE_LDS_FENCE();
    for (int t = 0; t < tc; ++t) {
        f32x16 p0, p1;
#pragma unroll
        for (int r = 0; r < 16; ++r) { p0[r] = 0.f; p1[r] = 0.f; }
        qk_tile((LAS char*)F.lds + L_K0 + t * 8320, qr, p0, p1, L.r32, L.hi);
        const u64 mk = mfc(t); const unsigned m0 = (unsigned)(mk >> (4 * L.hi)), m1 = (unsigned)(mk >> (32 + 4 * L.hi));
        const int qloc = L.r32 >> 2; const bool wr = (L.r32 & 3) == 0;
#pragma unroll
        for (int half = 0; half < 2; ++half)
#pragma unroll
            for (int m = 0; m < 4; ++m) {
                float e[4];
#pragma unroll
                for (int k = 0; k < 4; ++k) { const int r = 4 * m + k, bit = k + 8 * m; const float x = half ? p1[r] : p0[r]; const unsigned mm = half ? m1 : m0;
                    e[k] = ((mm >> bit) & 1u) ? __builtin_amdgcn_exp2f(x) * rlc : 0.f; }
                const float core = dpp_quad_sum((e[0] + e[1]) + (e[2] + e[3])), edge = dpp_quad_sum(e[3]);
                const int j = 16 * t + 8 * half + 2 * m + L.hi;
                if (wr) { impw[qloc * 64 + j] += core; }
                WAVE_LDS_FENCE();
                if (wr && j + 1 < 64) { impw[qloc * 64 + j + 1] += edge; }
                WAVE_LDS_FENCE();
            }
    }
    __syncthreads();
    {
        const int qloc = L.lane >> 3, sub = L.lane & 7; const int cur = i;
        u64 keys[8];
#pragma unroll
        for (int k = 0; k < 8; ++k) { const int j = sub + 8 * k; float v = impw[qloc * 64 + j];
            if (j == 0 || j == cur || j == cur - 1) v = 1e9f;
            if (j > cur) v = -1e30f;
            keys[k] = ((u64)f2key(v) << 32) | (u64)(63 - j); }
        u64 selm = 0ull; unsigned used = 0u;
#pragma unroll 1
        for (int it = 0; it < 16; ++it) {
            u64 best = 0ull;
#pragma unroll
            for (int k = 0; k < 8; ++k) { const u64 c = ((used >> k) & 1u) ? 0ull : keys[k]; best = c > best ? c : best; }
#pragma unroll
            for (int o2 = 1; o2 < 8; o2 <<= 1) { const unsigned lo = __shfl_xor((unsigned)best, o2), hi2 = __shfl_xor((unsigned)(best >> 32), o2); const u64 ob = ((u64)hi2 << 32) | lo; best = ob > best ? ob : best; }
            const int jsel = 63 - (int)(best & 63ull);
            if ((jsel & 7) == sub) used |= 1u << (jsel >> 3);
            selm |= 1ull << jsel;
        }
        LAS u64* selw = (LAS u64*)((LAS char*)F.lds + L_SEL) + L.wid * 8;
        if (sub == 0) selw[qloc] = selm;
        WAVE_LDS_FENCE();
    }
    {
        const UnitGeom X = unit_geom(F, b, kvh, i); const Lane& L = X.L; const int q = X.q;
        const u64 sel = ((LAS const u64*)((LAS char*)F.lds + L_SEL))[L.wid * 8 + (L.r32 >> 2)];
        const bf16* KV = (const bf16*)(F.ws + WS_ZKV) + (size_t)3 * M * 256;
        KVSrc S{(const GAS bf16*)(KV + (size_t)b * SEQ * 256 + kvh * 64), (const GAS bf16*)(KV + (size_t)b * SEQ * 256 + 128 + kvh * 64), 256, SEQ};
        auto mf = [sel, q](int t) -> u64 { return ((sel >> t) & 1ull) ? mask_le(q - 64 * t) : 0ull; };
#pragma unroll
        for (int r = 0; r < 16; ++r) { o[0][r] = 0.f; o[1][r] = 0.f; ol[r] = 0.f; }
        attend_range((LAS char*)F.lds, S, 0, i + 1, mf, qr, -Ck, ol, o, L);
        const UnitGeom W = unit_geom(F, b, kvh, i); LAS float* wsf2 = (LAS float*)((LAS char*)F.lds + L_WSF) + W.L.wid * WSF_W;
        branch_finish_lds(wsf2, (LAS float*)((LAS char*)F.lds + L_OST + W.L.wid * 8192), ol, wsf2[128 + W.L.lane], o, W.L, false);
    }
    {
        const UnitGeom X = unit_geom(F, b, kvh, i); const Lane& L = X.L; const int q = X.q;
        const bf16* KV = (const bf16*)(F.ws + WS_ZKV) + (size_t)4 * M * 256;
        KVSrc S{(const GAS bf16*)(KV + (size_t)b * SEQ * 256 + kvh * 64), (const GAS bf16*)(KV + (size_t)b * SEQ * 256 + 128 + kvh * 64), 256, SEQ};
        auto mf = [q](int t) -> u64 { return mask_le(q - 64 * t) & mask_ge(q - 511 - 64 * t); };
#pragma unroll
        for (int r = 0; r < 16; ++r) { o[0][r] = 0.f; o[1][r] = 0.f; ol[r] = 0.f; }
        attend_range((LAS char*)F.lds, S, i - 8 < 0 ? 0 : i - 8, i + 1, mf, qr, -Ck, ol, o, L);
        const UnitGeom W = unit_geom(F, b, kvh, i); LAS float* wsf2 = (LAS float*)((LAS char*)F.lds + L_WSF) + W.L.wid * WSF_W;
        branch_finish_lds(wsf2, (LAS float*)((LAS char*)F.lds + L_OST + W.L.wid * 8192), ol, wsf2[192 + W.L.lane], o, W.L, false);
    }
    {
        const UnitGeom X = unit_geom(F, b, kvh, i); const Lane& L = X.L;
        LAS float* accw2 = (LAS float*)((LAS char*)F.lds + L_OST + L.wid * 8192);
        const size_t tok0 = (size_t)b * SEQ + 64 * i + 8 * L.wid; const int kvh4 = 4 * kvh;
        bf16* Od = odst ? odst : (bf16*)(F.ws + WS_ZQ) + (size_t)2 * M * 512;
        auto rowptr = [Od, tok0, kvh4](int row) -> bf16* { return Od + (tok0 + (row >> 2)) * 512 + (kvh4 + (row & 3)) * 64; };
        f32x16 acc[2];
#pragma unroll
        for (int d0 = 0; d0 < 2; ++d0)
#pragma unroll
            for (int r = 0; r < 16; ++r) acc[d0][r] = accw2[(d0 * 16 + r) * 64 + L.lane];
        WAVE_LDS_FENCE();
        store_o((LAS char*)F.lds + L_OST + L.wid * 8192, acc, rowptr, L.lane, L.r32, L.hi);
    }
}

__global__ void __launch_bounds__(NWAVES * 64, 2) mk_fwd(Args args) {
    extern __shared__ __attribute__((aligned(16))) unsigned char lds_raw[];
    LAS unsigned char* lds = (LAS unsigned char*)lds_raw;
    volatile LAS unsigned* MISCW = (volatile LAS unsigned*)(lds + LDS_UNIT + 16);
    if (threadIdx.x < 8) MISCW[threadIdx.x] = 0u;
    __syncthreads();
    (void)xcd_barrier_post((unsigned*)((gu32*)(args.ws + WS_CTL) + CW_BAR), MISCW);
#define GRID_BARRIER() do { unsigned char* wsb_ = args.ws; asm volatile("" : "+s"(wsb_)); XcdBarrier bar_; bar_.bar = (unsigned*)((gu32*)(wsb_ + WS_CTL) + CW_BAR); bar_.x = xb_xcc_id(); \
    bar_.st = (volatile LAS unsigned*)(lds + LDS_UNIT + 16); xcd_barrier(bar_); } while (0)
#define MKFRAME() Frame F; { unsigned char* ws_ = args.ws; asm volatile("" : "+s"(ws_)); int tid_ = threadIdx.x; asm volatile("" : "+v"(tid_)); \
    F.lds = lds; F.tid = tid_; F.lane = tid_ & 63; F.wave = __builtin_amdgcn_readfirstlane(tid_ >> 6); F.G = gridDim.x; F.gw = 0; F.NGW = F.G * NWAVES; \
    F.ws = ws_; F.ctl = (gu32*)(ws_ + WS_CTL); F.a = &args; } int bid = blockIdx.x; asm volatile("" : "+s"(bid)); F.gw = bid * NWAVES + F.wave; \
    unsigned char* ws = F.ws; bf16* XB = (bf16*)(ws + WS_XB); bf16* MB = (bf16*)(ws + WS_MB); bf16* ZQ = (bf16*)(ws + WS_ZQ); bf16* ZKV = (bf16*)(ws + WS_ZKV); bf16* YS = (bf16*)(ws + WS_YS); bf16* HM = (bf16*)(ws + WS_HMID); \
    float* SSQ = (float*)(ws + WS_SSQ); (void)XB; (void)MB; (void)ZQ; (void)ZKV; (void)YS; (void)HM; (void)SSQ;
#define WL(l) (ws + WS_W + (size_t)(l) * W_LAYER)
#ifdef PROBE_T
#define STAMP(k) do { if (blockIdx.x == 0 && threadIdx.x == 0) ((unsigned long long*)(args.ws + WS_CTL + 96 * 1024))[k] = __builtin_amdgcn_s_memrealtime(); } while (0)
#else
#define STAMP(k) do { } while (0)
#endif

    STAMP(0);
#ifndef NO_P0
    { MKFRAME(); p0_prologue(F); }
#ifdef DBL_P0
    { MKFRAME(); p0_prologue(F); }
#endif
#endif
    GRID_BARRIER();
    STAMP(1);
#pragma unroll 1
    for (int l = 0; l < DEPTH; ++l) {
#ifndef NO_G1
#ifdef DBL_G1
        for (int rep_ = 0; rep_ < 2; ++rep_)
#endif
        {
            MKFRAME(); unsigned char* wl = WL(l);
            pg8::ProgG1 P; P.S.init(M, 3072, F.G, bid); P.spm = (bid & 7) * 8 + (bid >> 5); P.skq = (bid >> 3) & 3;
            P.xb = XB; P.win = (const bf16*)(wl + W_IN); P.zq = ZQ; P.zkv = ZKV; P.ssq = SSQ; P.part = (float*)(ws + WS_PART);
            pg8::gemm_chain<pg8::ProgG1, true>(F.lds, P);
        }
#endif
        GRID_BARRIER();
        STAMP(2 + 8 * l);
#ifndef NO_POST
        { MKFRAME(); post_phase(F, l); }
#ifdef DBL_POST
        { MKFRAME(); post_phase(F, l, true); }
#endif
#endif
        GRID_BARRIER();
        STAMP(3 + 8 * l);
#ifdef DBL_ATT1
        for (int rep1_ = 0; rep1_ < 2; ++rep1_)
#else
        const int rep1_ = 0;
#endif
        {
            MKFRAME();
            const int xcd = (int)(xb_xcc_id() & 7u);
#pragma unroll 1
            for (int qi = 0; qi < 8; ++qi) {
                const int x = (xcd + qi) & 7, b = x >> 1, sub = x & 1;
                gu32* ctr = F.ctl + CW_Q + 64 * ((2 * l + 4 * rep1_) * 8 + x);
                for (;;) { const int v = next_unit(F, ctr); if (v >= 16 + 256 + 64) break;
#ifdef DBL_ATT1
                    if (v < 16) { if (rep1_ == 0 || DBL_ATT1 == 1 || DBL_ATT1 == 2) compress_unit(F, l, (v & 1) | (sub << 1) | (b << 2) | ((v >> 1) << 4)); }
                    else if (v < 16 + 256) { if (rep1_ == 0 || DBL_ATT1 == 1 || DBL_ATT1 == 3 || DBL_ATT1 >= 5) select_unit(F, b, 2 * (255 - (v - 16)) + sub, rep1_ ? (DBL_ATT1 >= 5 ? DBL_ATT1 - 4 : 0) : 0  ); }
                    else if (rep1_ && DBL_ATT1 != 1 && DBL_ATT1 != 4) { }
#else
                    if (v < 16) { compress_unit(F, l, (v & 1) | (sub << 1) | (b << 2) | ((v >> 1) << 4)); }
                    else if (v < 16 + 256) { select_unit(F, b, 2 * (255 - (v - 16)) + sub); }
#endif
                    else { simple_unit<0>(F, l, b, sub, 63 - (v - 272), rep1_ ? (bf16*)(ws + WS_MB + 8 * MiB) : nullptr); }
                }
            }
        }
        GRID_BARRIER();
        STAMP(4 + 8 * l);
#ifdef DBL_ATT2
        for (int rep_ = 0; rep_ < 2; ++rep_)
#else
        const int rep_ = 0;
#endif
        {
            MKFRAME();
            bf16* od = rep_ ? (bf16*)(ws + WS_MB) : nullptr;
            const int xcd = (int)(xb_xcc_id() & 7u);
#pragma unroll 1
            for (int qi = 0; qi < 8; ++qi) {
                const int x = (xcd + qi) & 7, b = x >> 1, kvh = x & 1;
                gu32* ctr = F.ctl + CW_Q + 64 * ((2 * l + 1 + 4 * rep_) * 8 + x);
                for (;;) { const int v = next_unit(F, ctr); if (v >= 128) break;
                    const int i = 63 - (v >> 1);
#ifdef DBL_ATT2
                    if ((v & 1) && (rep_ == 0 || DBL_ATT2 != 3)) simple_unit<1>(F, l, b, kvh, i, od);
                    if (!(v & 1) && (rep_ == 0 || DBL_ATT2 != 2)) nsa_unit(F, l, b, kvh, i, od);
#else
                    if (v & 1) simple_unit<1>(F, l, b, kvh, i, od); else nsa_unit(F, l, b, kvh, i, od);
#endif
                }
            }
        }
        GRID_BARRIER();
        STAMP(5 + 8 * l);
#ifndef NO_G2
#ifdef DBL_G2
        for (int rep_ = 0; rep_ < 2; ++rep_)
#endif
        {   MKFRAME(); unsigned char* wl = WL(l);
            pg8::StaticOrder S; S.init(M, DM, F.G, bid); pg8::Unit u0; S.next(0, u0);
            pg8::ProgG2 P{u0.pm, u0.pn, ZQ, (const bf16*)(wl + W_BR), XB, (const bf16*)(wl + W_G), YS, MB, SSQ};
            pg8::gemm_chain<pg8::ProgG2>(F.lds, P); }
#endif
        GRID_BARRIER();
        STAMP(6 + 8 * l);
#ifndef NO_G3
        {
            MKFRAME(); unsigned char* wl = WL(l);
            pg8::Gemm g{MB, (const bf16*)(wl + W_OUT), M, DM, DM}; pg8::StaticOrder S; S.init(M, DM, F.G, bid);
            pg8::EpiRes E{l == 0 ? F.a->in[0] : (const float*)F.a->out, F.a->out, XB, SSQ};
            pg8::gemm_phase<pg8::EpiRes, pg8::StaticOrder, false, true>(F.lds, g, S, E);
        }
#ifdef DBL_G3
        {   MKFRAME(); unsigned char* wl = WL(l);
            pg8::Gemm g{MB, (const bf16*)(wl + W_OUT), M, DM, DM}; pg8::StaticOrder S; S.init(M, DM, F.G, bid);
            pg8::EpiRes E{F.a->in[0], (float*)(ws + 0), (bf16*)(ws + 64 * MiB), (float*)(ws + 96 * MiB)};
            pg8::gemm_phase<pg8::EpiRes, pg8::StaticOrder, false, true>(F.lds, g, S, E);
        }
#endif
#endif
        GRID_BARRIER();
        STAMP(7 + 8 * l);
#ifndef NO_G4
#ifdef DBL_G4
        for (int rep_ = 0; rep_ < 2; ++rep_)
#endif
        {
            MKFRAME(); unsigned char* wl = WL(l);
            pg8::Gemm g{XB, (const bf16*)(wl + W_UP), M, DFF, DM}; pg8::StaticOrder S; S.init(M, DFF, F.G, bid);
            pg8::EpiG4 E{HM, SSQ};
            pg8::gemm_phase<pg8::EpiG4, pg8::StaticOrder, true, true>(F.lds, g, S, E);
        }
#endif
        GRID_BARRIER();
        STAMP(8 + 8 * l);
#ifndef NO_G5
        {
            MKFRAME(); unsigned char* wl = WL(l);
            pg8::Gemm g{HM, (const bf16*)(wl + W_DN), M, DM, DFF}; pg8::StaticOrder S; S.init(M, DM, F.G, bid);
            pg8::EpiRes E{(const float*)F.a->out, F.a->out, XB, SSQ};
            pg8::gemm_phase<pg8::EpiRes, pg8::StaticOrder, false, true>(F.lds, g, S, E);
        }
#ifdef DBL_G5
        {   MKFRAME(); unsigned char* wl = WL(l);
            pg8::Gemm g{HM, (const bf16*)(wl + W_DN), M, DM, DFF}; pg8::StaticOrder S; S.init(M, DM, F.G, bid);
            pg8::EpiNull E{};
            pg8::gemm_phase<pg8::EpiNull, pg8::StaticOrder, false, true>(F.lds, g, S, E);
        }
#endif
#endif
#ifdef PROBE_T
        GRID_BARRIER();
        STAMP(9 + 8 * l);
#else
        if (l + 1 < DEPTH) GRID_BARRIER();
#endif
#ifdef DBL_BAR
        for (int rep_ = 0; rep_ < 16; ++rep_) GRID_BARRIER();
#endif
    }
#ifdef PROBE_T
    {
        GRID_BARRIER();
        const unsigned long long* st = (const unsigned long long*)(args.ws + WS_CTL + 96 * 1024);
        float tus;
        if (PROBE_T == 0) tus = (float)(st[1] - st[0]) * 0.01f;
        else tus = 0.5f * ((float)(st[PROBE_T + 1] - st[PROBE_T]) + (float)(st[PROBE_T + 9] - st[PROBE_T + 8])) * 0.01f;
        const float sc = 1.0f + tus * 0.001f;
        float* o = args.out;
        for (size_t i = (size_t)blockIdx.x * 512 + threadIdx.x; i < (size_t)M * DM; i += (size_t)gridDim.x * 512) o[i] *= sc;
    }
#endif
}

extern "C" void kernel_launch(void* const* d_in, const int* in_sizes, int n_in, void* d_out, int out_size, void* d_ws, size_t ws_size, hipStream_t stream) {
    static int grid = 0;
    if (grid == 0) {
        if (n_in != 17 || out_size != M * DM || ws_size < WS_END) { fprintf(stderr, "kernel_launch: unexpected problem shape (n_in %d out %d ws %zu)\n", n_in, out_size, ws_size); grid = -1; return; }
        int dev = 0, cus = 0, per_cu = 0;
        if (hipGetDevice(&dev) != hipSuccess || hipDeviceGetAttribute(&cus, hipDeviceAttributeMultiprocessorCount, dev) != hipSuccess) { grid = -1; return; }
        if (hipFuncSetAttribute((const void*)mk_fwd, hipFuncAttributeMaxDynamicSharedMemorySize, LDS_BYTES) != hipSuccess) { fprintf(stderr, "kernel_launch: hipFuncSetAttribute failed\n"); grid = -1; return; }
        if (hipOccupancyMaxActiveBlocksPerMultiprocessor(&per_cu, (const void*)mk_fwd, NWAVES * 64, LDS_BYTES) != hipSuccess || per_cu < 1) { fprintf(stderr, "kernel_launch: occupancy query says %d blocks/CU\n", per_cu); }
        (void)hipGetLastError();
        if (cus != 256) { fprintf(stderr, "kernel_launch: built for a 256-CU device (one 256x256 GEMM unit per workgroup in the N=1024 phases), found %d CUs\n", cus); grid = -1; return; }
        grid = cus;
    }
    if (grid < 0) return;
    (void)hipMemsetAsync((char*)d_ws + WS_CTL, 0, CTL_BYTES, stream);
    Args a{};
    for (int i = 0; i < 17; ++i) a.in[i] = (const float*)d_in[i];
    a.out = (float*)d_out; a.ws = (unsigned char*)d_ws;
    hipLaunchKernelGGL(mk_fwd, dim3(grid), dim3(NWAVES * 64), LDS_BYTES, stream, a);
}
```

```cpp
#include <hip/hip_runtime.h>
#include <cstdio>
#include <cstdint>

namespace pg8 {
#define PG8_LAS __attribute__((address_space(3)))
typedef unsigned short bf16_t;
typedef short bf16x8 __attribute__((ext_vector_type(8)));
typedef float f32x4 __attribute__((ext_vector_type(4)));
typedef unsigned u32x4 __attribute__((ext_vector_type(4)));
constexpr int BM = 256, BK = 64, HALF = 128, HTB = HALF * BK * 2  , STAGE_BYTES = 8 * HTB, NXCD = 8, WGM = 8;

__host__ __device__ __forceinline__ int lds_byte(int r, int c) { const int st = (r >> 4) * 2 + (c >> 5), rr = r & 15, cc = c & 31, ob = rr * 64 + cc * 2; return st * 1024 + (ob ^ (((ob >> 9) & 1) << 5)); }
__host__ __device__ __forceinline__ void stage_rc(int b, int& R, int& C) { const int st = b / 1024, sb = b % 1024, swz = sb ^ (((sb >> 9) & 1) << 5); R = (st >> 1) * 16 + swz / 64; C = (st & 1) * 32 + (swz % 64) / 2; }
__host__ __device__ __forceinline__ int perm32(int rho) { const int n = rho >> 4, i = rho & 15; return 8 * (i >> 2) + 4 * n + (i & 3); }

struct Unit { int pm, pn; };
struct Gemm { const bf16_t* A; const bf16_t* Bt; int M, N, K; };

struct StaticOrder {
    int nM, nN, nwg, G, c;
    __host__ __device__ __forceinline__ void init(int M, int N, int G_, int c_) { nM = M / BM; nN = N / BM; nwg = nM * nN; G = G_; c = c_; }
    __host__ __device__ __forceinline__ bool next(int i, Unit& u) const {
        const long L = (long)i * G + c; if (L >= nwg) return false;
        int wgid = (int)L; { const int q = nwg / NXCD, r = nwg % NXCD, xcd = wgid % NXCD, off = wgid / NXCD; wgid = (xcd < r ? xcd * (q + 1) : r * (q + 1) + (xcd - r) * q) + off; }
        const int nig = WGM * nN, gid = wgid / nig, fm = gid * WGM, gsz = (nM - fm) < WGM ? (nM - fm) : WGM;
        u.pm = fm + ((wgid % nig) % gsz); u.pn = (wgid % nig) / gsz; return true;
    }
    __device__ __forceinline__ void a_ready(const Unit&) const {}
    __device__ __forceinline__ void done(const Unit&) const {}
};

__device__ __forceinline__ unsigned cvt_pk_bf16(float lo, float hi) { unsigned r; asm volatile("v_cvt_pk_bf16_f32 %0, %1, %2" : "=v"(r) : "v"(lo), "v"(hi)); return r; }
template <class Epi, class Sched, bool ALIGN_EPI = false, bool SP2 = false>
__device__ __forceinline__ void gemm_phase(PG8_LAS unsigned char* lds, const Gemm g, const Sched& S, const Epi& E) {
    int tid_l = threadIdx.x; asm volatile("" : "+v"(tid_l));
    const int tid = tid_l, wid = __builtin_amdgcn_readfirstlane(tid >> 6), lane = tid & 63, wr = wid >> 2, wc = wid & 3, fr = lane & 15, fq = lane >> 4;
    const int K = g.K, nt = K / BK;
    unsigned voffA[2], voffB[2];
#pragma unroll
    for (int i = 0; i < 2; ++i) { int R, C; stage_rc(tid * 16 + i * 8192, R, C); const int Rb = Epi::PERM ? ((R & ~31) + perm32(R & 31)) : R;
        voffA[i] = (unsigned)(R * K + C) * 2u; voffB[i] = (unsigned)(Rb * K + C) * 2u; }
    const size_t kstep = (size_t)(BK * 2);
    const size_t hstep = (size_t)HALF * K * 2;
    const size_t tstep = 2 * hstep;
    const unsigned ldsw = (unsigned)wid * 1024u;
    const int aoff = lds_byte(wr * 64 + fr, fq * 8), boff = lds_byte(wc * 32 + fr, fq * 8);
#define PG8_SA(b, h) (((b) * 2 + (h)) * HTB)
#define PG8_SB(b, h) ((4 + (b) * 2 + (h)) * HTB)
#define PG8_STAGE(bufoff, gbase, voff) do { _Pragma("unroll") for (int _i = 0; _i < 2; ++_i) \
        __builtin_amdgcn_global_load_lds((const unsigned*)((const char*)(gbase) + (voff)[_i]), (PG8_LAS unsigned*)(lds + (bufoff) + ldsw + _i * 8192), 16, 0, 0); } while (0)
#define PG8_LDA(dst, b, h) do { _Pragma("unroll") for (int m = 0; m < 4; ++m) _Pragma("unroll") for (int k = 0; k < 2; ++k) dst[m][k] = *(const PG8_LAS bf16x8*)(lds + PG8_SA(b, h) + aoff + m * 2048 + k * 1024); } while (0)
#define PG8_LDB(dst, b, h) do { _Pragma("unroll") for (int n = 0; n < 2; ++n) _Pragma("unroll") for (int k = 0; k < 2; ++k) dst[n][k] = *(const PG8_LAS bf16x8*)(lds + PG8_SB(b, h) + boff + n * 2048 + k * 1024); } while (0)
#define PG8_MMA(ai, bj, At, Bt) do { __builtin_amdgcn_s_setprio(1); _Pragma("unroll") for (int m = 0; m < 4; ++m) _Pragma("unroll") for (int n = 0; n < 2; ++n) _Pragma("unroll") for (int k = 0; k < 2; ++k) \
        acc[ai][bj][m][n] = __builtin_amdgcn_mfma_f32_16x16x32_bf16(Bt[n][k], At[m][k], acc[ai][bj][m][n], 0, 0, 0); __builtin_amdgcn_s_setprio(0); } while (0)
#define PG8_WAIT_V(n) asm volatile("s_waitcnt vmcnt(" #n ")" ::: "memory")
#define PG8_WAIT_L(n) asm volatile("s_waitcnt lgkmcnt(" #n ")" ::: "memory")
#define PG8_BAR __builtin_amdgcn_s_barrier()
#define PG8_SCHED __builtin_amdgcn_sched_barrier(0)
    Unit cur, nxt; int ui = 0;
    if (!S.next(0, cur)) return;
    f32x4 acc[2][2][4][2];
#pragma unroll
    for (int a = 0; a < 2; ++a)
#pragma unroll
        for (int b = 0; b < 2; ++b)
#pragma unroll
            for (int m = 0; m < 4; ++m)
#pragma unroll
                for (int n = 0; n < 2; ++n) acc[a][b][m][n] = (f32x4){0.f, 0.f, 0.f, 0.f};
    bf16x8 At[4][2], B0[2][2], B1[2][2];
    const char* cA = (const char*)g.A + (size_t)cur.pm * tstep; const char* cB = (const char*)g.Bt + (size_t)cur.pn * tstep;
    S.a_ready(cur);
    if constexpr (SP2) {
        PG8_STAGE(PG8_SB(0, 0), cB, voffB); PG8_STAGE(PG8_SB(0, 1), cB + hstep, voffB); PG8_STAGE(PG8_SA(0, 0), cA, voffA); PG8_STAGE(PG8_SA(0, 1), cA + hstep, voffA);
        if (wr == 1) PG8_BAR;
        PG8_WAIT_V(2); PG8_BAR;
        PG8_STAGE(PG8_SB(1, 0), cB + kstep, voffB); PG8_STAGE(PG8_SA(1, 0), cA + kstep, voffA); PG8_STAGE(PG8_SB(1, 1), cB + hstep + kstep, voffB);
        PG8_WAIT_V(6); PG8_BAR;
    } else {
        PG8_STAGE(PG8_SB(0, 0), cB, voffB); PG8_STAGE(PG8_SA(0, 0), cA, voffA); PG8_STAGE(PG8_SB(0, 1), cB + hstep, voffB); PG8_STAGE(PG8_SA(0, 1), cA + hstep, voffA);
        if (wr == 1) PG8_BAR;
        PG8_WAIT_V(4); PG8_BAR;
        PG8_STAGE(PG8_SB(1, 0), cB + kstep, voffB); PG8_STAGE(PG8_SA(1, 0), cA + kstep, voffA); PG8_STAGE(PG8_SB(1, 1), cB + hstep + kstep, voffB);
        PG8_WAIT_V(6); PG8_BAR;
    }
    for (;;) {
        const bool has_next = S.next(ui + 1, nxt);
        const char* nA = has_next ? (const char*)g.A + (size_t)nxt.pm * tstep : cA; const char* nB = has_next ? (const char*)g.Bt + (size_t)nxt.pn * tstep : cB;
        for (int t = 0; t < nt; t += 2) {
            const bool last = (t == nt - 2);
            const char* a1 = cA + (size_t)(t + 1) * kstep;
            const char* a2 = last ? nA : cA + (size_t)(t + 2) * kstep; const char* b2 = last ? nB : cB + (size_t)(t + 2) * kstep;
            const char* a3 = a2 + kstep; const char* b3 = b2 + kstep;
            if (last && has_next) S.a_ready(nxt);
            if constexpr (SP2) {
            PG8_LDB(B0, 0, 0); PG8_LDB(B1, 0, 1); PG8_SCHED; PG8_LDA(At, 0, 0); PG8_STAGE(PG8_SA(1, 1), a1 + hstep, voffA);
            PG8_WAIT_V(8); PG8_WAIT_L(0); PG8_BAR; PG8_MMA(0, 0, At, B0); PG8_MMA(0, 1, At, B1); PG8_BAR; PG8_SCHED;
            PG8_LDA(At, 0, 1); PG8_STAGE(PG8_SB(0, 0), b2, voffB); PG8_STAGE(PG8_SB(0, 1), b2 + hstep, voffB); PG8_STAGE(PG8_SA(0, 0), a2, voffA);
            PG8_WAIT_V(8); PG8_WAIT_L(0); PG8_BAR; PG8_MMA(1, 0, At, B0); PG8_MMA(1, 1, At, B1); PG8_BAR; PG8_SCHED;
            PG8_LDB(B0, 1, 0); PG8_LDB(B1, 1, 1); PG8_SCHED; PG8_LDA(At, 1, 0); PG8_STAGE(PG8_SA(0, 1), a2 + hstep, voffA);
            PG8_WAIT_V(8); PG8_WAIT_L(0); PG8_BAR; PG8_MMA(0, 0, At, B0); PG8_MMA(0, 1, At, B1); PG8_BAR; PG8_SCHED;
            PG8_LDA(At, 1, 1); PG8_STAGE(PG8_SB(1, 0), b3, voffB); PG8_STAGE(PG8_SB(1, 1), b3 + hstep, voffB); PG8_STAGE(PG8_SA(1, 0), a3, voffA);
            PG8_WAIT_V(8); PG8_WAIT_L(0); PG8_BAR; PG8_MMA(1, 0, At, B0); PG8_MMA(1, 1, At, B1); PG8_BAR; PG8_SCHED;
            } else {
            PG8_LDB(B0, 0, 0); PG8_SCHED; PG8_LDA(At, 0, 0); PG8_STAGE(PG8_SA(1, 1), a1 + hstep, voffA);
            PG8_WAIT_L(8); PG8_BAR; PG8_WAIT_L(0); PG8_MMA(0, 0, At, B0); PG8_BAR; PG8_SCHED;
            PG8_LDB(B1, 0, 1); PG8_STAGE(PG8_SB(0, 0), b2, voffB);
            PG8_BAR; PG8_WAIT_L(0); PG8_MMA(0, 1, At, B1); PG8_BAR;
            PG8_LDA(At, 0, 1); PG8_STAGE(PG8_SA(0, 0), a2, voffA);
            PG8_BAR; PG8_WAIT_L(0); PG8_MMA(1, 0, At, B0); PG8_BAR; PG8_SCHED;
            PG8_STAGE(PG8_SB(0, 1), b2 + hstep, voffB);
            PG8_WAIT_V(6); PG8_BAR; PG8_MMA(1, 1, At, B1); PG8_BAR;
            PG8_LDB(B0, 1, 0); PG8_SCHED; PG8_LDA(At, 1, 0); PG8_STAGE(PG8_SA(0, 1), a2 + hstep, voffA);
            PG8_WAIT_L(8); PG8_BAR; PG8_WAIT_L(0); PG8_MMA(0, 0, At, B0); PG8_BAR; PG8_SCHED;
            PG8_LDB(B1, 1, 1); PG8_STAGE(PG8_SB(1, 0), b3, voffB);
            PG8_BAR; PG8_WAIT_L(0); PG8_MMA(0, 1, At, B1); PG8_BAR;
            PG8_LDA(At, 1, 1); PG8_STAGE(PG8_SA(1, 0), a3, voffA);
            PG8_BAR; PG8_WAIT_L(0); PG8_MMA(1, 0, At, B0); PG8_BAR; PG8_SCHED;
            PG8_STAGE(PG8_SB(1, 1), b3 + hstep, voffB);
            PG8_WAIT_V(6); PG8_BAR; PG8_MMA(1, 1, At, B1); PG8_BAR;
            }
        }
        if constexpr (ALIGN_EPI) { if (wr == 0) PG8_BAR; }
        if constexpr (!Epi::AFTER_DRAIN) { E(acc, cur, wr, wc, fr, fq); S.done(cur); }
        if (!has_next) break;
#pragma unroll
        for (int a = 0; a < 2; ++a)
#pragma unroll
            for (int b = 0; b < 2; ++b)
#pragma unroll
                for (int m = 0; m < 4; ++m)
#pragma unroll
                    for (int n = 0; n < 2; ++n) acc[a][b][m][n] = (f32x4){0.f, 0.f, 0.f, 0.f};
        cur = nxt; cA = nA; cB = nB; ++ui;
        if constexpr (ALIGN_EPI) { if (wr == 1) PG8_BAR; }
    }
    PG8_WAIT_V(0);
    if constexpr (!ALIGN_EPI) { if (wr == 0) PG8_BAR; }
    PG8_BAR;
    if constexpr (Epi::AFTER_DRAIN) { E.fused(acc, cur, wr, wc, fr, fq, lds, wid, lane); S.done(cur); }
#undef PG8_SA
#undef PG8_SB
#undef PG8_STAGE
#undef PG8_LDA
#undef PG8_LDB
#undef PG8_MMA
#undef PG8_WAIT_V
#undef PG8_WAIT_L
#undef PG8_BAR
#undef PG8_SCHED
}
}

namespace pg8 {
#define PG8_GAS __attribute__((address_space(1)))
constexpr int MROWS = 16384;
__device__ __forceinline__ unsigned pk_bf16(float lo, float hi) { typedef float f2 __attribute__((ext_vector_type(2))); typedef __bf16 b2 __attribute__((ext_vector_type(2)));
    f2 v = {lo, hi}; b2 b = __builtin_convertvector(v, b2); return __builtin_bit_cast(unsigned, b); }
__device__ __forceinline__ float bf_lo(unsigned w) { return __uint_as_float(w << 16); }
__device__ __forceinline__ float bf_hi(unsigned w) { return __uint_as_float(w & 0xffff0000u); }
__device__ __forceinline__ float row_rstd(const float* ssq, int row) {
    const PG8_GAS f32x4* p = (const PG8_GAS f32x4*)(ssq + (size_t)row * 16);
    const f32x4 a = p[0], b = p[1], c = p[2], d = p[3];
    const float s = (((a[0] + a[1]) + (a[2] + a[3])) + ((b[0] + b[1]) + (b[2] + b[3]))) + (((c[0] + c[1]) + (c[2] + c[3])) + ((d[0] + d[1]) + (d[2] + d[3])));
    return rsqrtf(s * (1.0f / 1024.0f) + 1e-6f);
}
__device__ __forceinline__ float sigmoidf_(float x) { return __builtin_amdgcn_rcpf(1.0f + __builtin_amdgcn_exp2f(-1.4426950408889634f * x)); }

__device__ __forceinline__ void wave_rstd(const float* ssq, int rowbase, int lane, float (&v)[2]) {
    const PG8_GAS f32x4* p0 = (const PG8_GAS f32x4*)(ssq + (size_t)(rowbase + lane) * 16);
    const PG8_GAS f32x4* p1 = p0 + HALF * 4;
    const f32x4 a = p0[0], b = p0[1], c = p0[2], d = p0[3], e = p1[0], f = p1[1], g = p1[2], h = p1[3];
    const float s0 = (((a[0] + a[1]) + (a[2] + a[3])) + ((b[0] + b[1]) + (b[2] + b[3]))) + (((c[0] + c[1]) + (c[2] + c[3])) + ((d[0] + d[1]) + (d[2] + d[3])));
    const float s1 = (((e[0] + e[1]) + (e[2] + e[3])) + ((f[0] + f[1]) + (f[2] + f[3]))) + (((g[0] + g[1]) + (g[2] + g[3])) + ((h[0] + h[1]) + (h[2] + h[3])));
    v[0] = rsqrtf(s0 * (1.0f / 1024.0f) + 1e-6f); v[1] = rsqrtf(s1 * (1.0f / 1024.0f) + 1e-6f);
}

struct EpiG1 {
    static constexpr bool PERM = true, AFTER_DRAIN = false;
    bf16_t* zq; bf16_t* zkv; const float* ssq;
    __device__ __forceinline__ void operator()(const f32x4 (&acc)[2][2][4][2], const Unit& u, int wr, int wc, int fr, int fq) const {
        const int row0 = u.pm * BM + wr * 64 + fr;
        bf16_t* base; int ldc, colt;
        if (u.pn < 6) { base = zq + (size_t)(u.pn >> 1) * ((size_t)MROWS * 512); ldc = 512; colt = (u.pn & 1) * 256; }
        else { base = zkv + (size_t)(u.pn - 6) * ((size_t)MROWS * 256); ldc = 256; colt = 0; }
        const int col0 = colt + wc * 32 + 8 * fq;
        float rv[2]; wave_rstd(ssq, u.pm * BM + wr * 64, fq * 16 + fr, rv);
#pragma unroll
        for (int ai = 0; ai < 2; ++ai)
#pragma unroll
            for (int m = 0; m < 4; ++m) { const int row = row0 + ai * HALF + m * 16; const float rs = __shfl(rv[ai], m * 16 + fr); bf16_t* rowp = base + (size_t)row * ldc + col0;
#pragma unroll
                for (int bj = 0; bj < 2; ++bj) { const f32x4 v0 = acc[ai][bj][m][0] * rs, v1 = acc[ai][bj][m][1] * rs;
                    u32x4 w; w.x = pk_bf16(v0[0], v0[1]); w.y = pk_bf16(v0[2], v0[3]); w.z = pk_bf16(v1[0], v1[1]); w.w = pk_bf16(v1[2], v1[3]);
                    *(PG8_GAS u32x4*)(rowp + bj * HALF) = w; } }
    }
};
struct EpiG4 {
    static constexpr bool PERM = true, AFTER_DRAIN = false;
    bf16_t* h; const float* ssq;
    __device__ __forceinline__ void operator()(const f32x4 (&acc)[2][2][4][2], const Unit& u, int wr, int wc, int fr, int fq) const {
        const int row0 = u.pm * BM + wr * 64 + fr; const int col0 = u.pn * BM + wc * 32 + 8 * fq;
        float rv[2]; wave_rstd(ssq, u.pm * BM + wr * 64, fq * 16 + fr, rv);
#pragma unroll
        for (int ai = 0; ai < 2; ++ai)
#pragma unroll
            for (int m = 0; m < 4; ++m) { const int row = row0 + ai * HALF + m * 16; const float rs = __shfl(rv[ai], m * 16 + fr); bf16_t* rowp = h + (size_t)row * 4096 + col0;
#pragma unroll
                for (int bj = 0; bj < 2; ++bj) { f32x4 v0 = acc[ai][bj][m][0] * rs, v1 = acc[ai][bj][m][1] * rs;
#pragma unroll
                    for (int e = 0; e < 4; ++e) { v0[e] = fmaxf(v0[e], 0.f); v0[e] *= v0[e]; v1[e] = fmaxf(v1[e], 0.f); v1[e] *= v1[e]; }
                    u32x4 w; w.x = pk_bf16(v0[0], v0[1]); w.y = pk_bf16(v0[2], v0[3]); w.z = pk_bf16(v1[0], v1[1]); w.w = pk_bf16(v1[2], v1[3]);
                    *(PG8_GAS u32x4*)(rowp + bj * HALF) = w; } }
    }
};
struct EpiRes {
    static constexpr bool PERM = true, AFTER_DRAIN = false;
    float* xout; bf16_t* xb; float* ssq;
    __device__ __forceinline__ void operator()(const f32x4 (&acc)[2][2][4][2], const Unit& u, int wr, int wc, int fr, int fq) const {
        const int row0 = u.pm * BM + wr * 64 + fr; const int col0 = u.pn * BM + wc * 32 + 8 * fq;
        const bool last = xout != nullptr;
#pragma unroll
        for (int ai = 0; ai < 2; ++ai) {
            u32x4 xo[4][2];
#pragma unroll
            for (int m = 0; m < 4; ++m)
#pragma unroll
                for (int bj = 0; bj < 2; ++bj) { const size_t off = (size_t)(row0 + ai * HALF + m * 16) * 1024 + col0 + bj * HALF;
                    xo[m][bj] = *(const PG8_GAS u32x4*)(xb + off); }
#pragma unroll
            for (int m = 0; m < 4; ++m) { const int row = row0 + ai * HALF + m * 16; float part = 0.f;
#pragma unroll
                for (int bj = 0; bj < 2; ++bj) { const size_t off = (size_t)row * 1024 + col0 + bj * HALF;
                    const u32x4 xw = xo[m][bj];
                    const f32x4 x0 = {bf_lo(xw.x), bf_hi(xw.x), bf_lo(xw.y), bf_hi(xw.y)}, x1 = {bf_lo(xw.z), bf_hi(xw.z), bf_lo(xw.w), bf_hi(xw.w)};
                    const f32x4 v0 = acc[ai][bj][m][0] + x0, v1 = acc[ai][bj][m][1] + x1;
                    if (last) { __builtin_nontemporal_store(v0, (PG8_GAS f32x4*)(xout + off)); __builtin_nontemporal_store(v1, (PG8_GAS f32x4*)(xout + off + 4)); }
                    else {
                        u32x4 w; w.x = pk_bf16(v0[0], v0[1]); w.y = pk_bf16(v0[2], v0[3]); w.z = pk_bf16(v1[0], v1[1]); w.w = pk_bf16(v1[2], v1[3]);
                        *(PG8_GAS u32x4*)(xb + off) = w;
                        const float r0 = bf_lo(w.x), r1 = bf_hi(w.x), r2 = bf_lo(w.y), r3 = bf_hi(w.y), r4 = bf_lo(w.z), r5 = bf_hi(w.z), r6 = bf_lo(w.w), r7 = bf_hi(w.w);
                        part += ((r0 * r0 + r1 * r1) + (r2 * r2 + r3 * r3)) + ((r4 * r4 + r5 * r5) + (r6 * r6 + r7 * r7)); } }
                if (!last) { part += __shfl_xor(part, 16); part += __shfl_xor(part, 32);
                    if (fq == 0) ((PG8_GAS float*)ssq)[(size_t)row * 16 + u.pn * 4 + wc] = part; } }
            asm volatile("" ::: "memory"); }
    }
};
struct EpiStash {
    static constexpr bool PERM = true, AFTER_DRAIN = true;
    __device__ __forceinline__ void fused(f32x4 (&acc)[2][2][4][2], const Unit& u, int wr, int wc, int fr, int fq, PG8_LAS unsigned char*, int, int) const { (*this)(acc, u, wr, wc, fr, fq); }
    bf16_t* ys;
    __device__ __forceinline__ void operator()(const f32x4 (&acc)[2][2][4][2], const Unit& u, int wr, int wc, int fr, int fq) const {
        bf16_t* base = ys + (size_t)(u.pm * 4 + u.pn) * 65536; const int row0 = wr * 64 + fr, col0 = wc * 32 + 8 * fq;
#pragma unroll
        for (int ai = 0; ai < 2; ++ai)
#pragma unroll
            for (int m = 0; m < 4; ++m) { bf16_t* rowp = base + (row0 + ai * HALF + m * 16) * 256 + col0;
#pragma unroll
                for (int bj = 0; bj < 2; ++bj) { const f32x4 v0 = acc[ai][bj][m][0], v1 = acc[ai][bj][m][1];
                    u32x4 w; w.x = pk_bf16(v0[0], v0[1]); w.y = pk_bf16(v0[2], v0[3]); w.z = pk_bf16(v1[0], v1[1]); w.w = pk_bf16(v1[2], v1[3]);
                    *(PG8_GAS u32x4*)(rowp + bj * HALF) = w; } }
    }
};
struct EpiGate {
    static constexpr bool PERM = true, AFTER_DRAIN = true;
    __device__ __forceinline__ void fused(f32x4 (&acc)[2][2][4][2], const Unit& u, int wr, int wc, int fr, int fq, PG8_LAS unsigned char*, int, int) const { (*this)(acc, u, wr, wc, fr, fq); }
    const bf16_t* ys; bf16_t* mb; const float* ssq; int first;
    __device__ __forceinline__ void operator()(const f32x4 (&acc)[2][2][4][2], const Unit& u, int wr, int wc, int fr, int fq) const {
        const bf16_t* sbase = ys + (size_t)(u.pm * 4 + u.pn) * 65536; const int lrow0 = wr * 64 + fr, lcol0 = wc * 32 + 8 * fq;
        float rv[2]; wave_rstd(ssq, u.pm * BM + wr * 64, fq * 16 + fr, rv);
        const bool fst = first != 0;
#pragma unroll
        for (int ai = 0; ai < 2; ++ai)
#pragma unroll
        for (int mh = 0; mh < 2; ++mh) {
            u32x4 yv[2][2], pv[2][2];
#pragma unroll
            for (int m2 = 0; m2 < 2; ++m2)
#pragma unroll
                for (int bj = 0; bj < 2; ++bj) { const int lrow = lrow0 + ai * HALF + (mh * 2 + m2) * 16;
                    yv[m2][bj] = *(const PG8_GAS u32x4*)(sbase + lrow * 256 + lcol0 + bj * HALF);
                    pv[m2][bj] = *(const PG8_GAS u32x4*)(mb + (size_t)(u.pm * BM + lrow) * 1024 + u.pn * BM + lcol0 + bj * HALF); }
#pragma unroll
            for (int m2 = 0; m2 < 2; ++m2) { const int m = mh * 2 + m2; const int lrow = lrow0 + ai * HALF + m * 16, row = u.pm * BM + lrow; const float rs = __shfl(rv[ai], m * 16 + fr);
#pragma unroll
                for (int bj = 0; bj < 2; ++bj) { const f32x4 a0 = acc[ai][bj][m][0] * rs, a1 = acc[ai][bj][m][1] * rs;
                    const u32x4 y = yv[m2][bj], p = pv[m2][bj];
                    bf16_t* mp = mb + (size_t)row * 1024 + u.pn * BM + lcol0 + bj * HALF;
                    float r[8];
                    const float sg[8] = {sigmoidf_(a0[0]), sigmoidf_(a0[1]), sigmoidf_(a0[2]), sigmoidf_(a0[3]), sigmoidf_(a1[0]), sigmoidf_(a1[1]), sigmoidf_(a1[2]), sigmoidf_(a1[3])};
                    const float yy[8] = {bf_lo(y.x), bf_hi(y.x), bf_lo(y.y), bf_hi(y.y), bf_lo(y.z), bf_hi(y.z), bf_lo(y.w), bf_hi(y.w)};
                    if (fst) {
#pragma unroll
                        for (int e = 0; e < 8; ++e) r[e] = sg[e] * yy[e];
                    } else {
                        const float q[8] = {bf_lo(p.x), bf_hi(p.x), bf_lo(p.y), bf_hi(p.y), bf_lo(p.z), bf_hi(p.z), bf_lo(p.w), bf_hi(p.w)};
#pragma unroll
                        for (int e = 0; e < 8; ++e) r[e] = fmaf(sg[e], yy[e], q[e]);
                    }
                    u32x4 w; w.x = pk_bf16(r[0], r[1]); w.y = pk_bf16(r[2], r[3]); w.z = pk_bf16(r[4], r[5]); w.w = pk_bf16(r[6], r[7]);
                    *(PG8_GAS u32x4*)mp = w; } }
            asm volatile("" ::: "memory"); }
    }
};
struct EpiNull {
    static constexpr bool PERM = true, AFTER_DRAIN = false;
    __device__ __forceinline__ void operator()(const f32x4 (&acc)[2][2][4][2], const Unit& u, int wr, int wc, int fr, int fq) const {
#pragma unroll
        for (int ai = 0; ai < 2; ++ai)
#pragma unroll
            for (int bj = 0; bj < 2; ++bj)
#pragma unroll
                for (int m = 0; m < 4; ++m) { asm volatile("" :: "v"(acc[ai][bj][m][0]), "v"(acc[ai][bj][m][1])); }
    }
};
}

namespace pg8 {
struct UnitX { int pm, pn; const char* A; const char* Bt; int K; int nk; int kind; };
template <class Prog, bool ALIGN_EPI = false>
__device__ __forceinline__ void gemm_chain(PG8_LAS unsigned char* lds, const Prog& P) {
    int tid_l = threadIdx.x; asm volatile("" : "+v"(tid_l));
    const int tid = tid_l, wid = __builtin_amdgcn_readfirstlane(tid >> 6), lane = tid & 63, wr = wid >> 2, wc = wid & 3, fr = lane & 15, fq = lane >> 4;
    int RA[2], RB[2], C2[2];
#pragma unroll
    for (int i = 0; i < 2; ++i) { int R, C; stage_rc(tid * 16 + i * 8192, R, C); RA[i] = R * 2; RB[i] = ((R & ~31) + perm32(R & 31)) * 2; C2[i] = C * 2; }
    const size_t kstep = (size_t)(BK * 2);
    const unsigned ldsw = (unsigned)wid * 1024u;
    const int aoff = lds_byte(wr * 64 + fr, fq * 8), boff = lds_byte(wc * 32 + fr, fq * 8);
#define PG8_SA(b, h) (((b) * 2 + (h)) * HTB)
#define PG8_SB(b, h) ((4 + (b) * 2 + (h)) * HTB)
#define PG8_STAGE(bufoff, gbase, voff) do { _Pragma("unroll") for (int _i = 0; _i < 2; ++_i) \
        __builtin_amdgcn_global_load_lds((const unsigned*)((const char*)(gbase) + (voff)[_i]), (PG8_LAS unsigned*)(lds + (bufoff) + ldsw + _i * 8192), 16, 0, 0); } while (0)
#define PG8_LDA(dst, b, h) do { _Pragma("unroll") for (int m = 0; m < 4; ++m) _Pragma("unroll") for (int k = 0; k < 2; ++k) dst[m][k] = *(const PG8_LAS bf16x8*)(lds + PG8_SA(b, h) + aoff + m * 2048 + k * 1024); } while (0)
#define PG8_LDB(dst, b, h) do { _Pragma("unroll") for (int n = 0; n < 2; ++n) _Pragma("unroll") for (int k = 0; k < 2; ++k) dst[n][k] = *(const PG8_LAS bf16x8*)(lds + PG8_SB(b, h) + boff + n * 2048 + k * 1024); } while (0)
#define PG8_MMA(ai, bj, At, Bt) do { __builtin_amdgcn_s_setprio(1); _Pragma("unroll") for (int m = 0; m < 4; ++m) _Pragma("unroll") for (int n = 0; n < 2; ++n) _Pragma("unroll") for (int k = 0; k < 2; ++k) \
        acc[ai][bj][m][n] = __builtin_amdgcn_mfma_f32_16x16x32_bf16(Bt[n][k], At[m][k], acc[ai][bj][m][n], 0, 0, 0); __builtin_amdgcn_s_setprio(0); } while (0)
#define PG8_WAIT_V(n) asm volatile("s_waitcnt vmcnt(" #n ")" ::: "memory")
#define PG8_WAIT_L(n) asm volatile("s_waitcnt lgkmcnt(" #n ")" ::: "memory")
#define PG8_BAR __builtin_amdgcn_s_barrier()
#define PG8_SCHED __builtin_amdgcn_sched_barrier(0)
    UnitX cur, nxt; int ui = 0;
    if (!P.get(0, cur)) return;
    f32x4 acc[2][2][4][2];
#pragma unroll
    for (int a = 0; a < 2; ++a)
#pragma unroll
        for (int b = 0; b < 2; ++b)
#pragma unroll
            for (int m = 0; m < 4; ++m)
#pragma unroll
                for (int n = 0; n < 2; ++n) acc[a][b][m][n] = (f32x4){0.f, 0.f, 0.f, 0.f};
    bf16x8 At[4][2], B0[2][2], B1[2][2];
    int Kc = cur.K; size_t hsc = (size_t)HALF * Kc * 2;
    const char* cA = cur.A + (size_t)cur.pm * 2 * hsc; const char* cB = cur.Bt + (size_t)cur.pn * 2 * hsc;
    unsigned vAc[2], vBc[2];
#pragma unroll
    for (int i = 0; i < 2; ++i) { vAc[i] = (unsigned)(RA[i] * Kc + C2[i]); vBc[i] = (unsigned)(RB[i] * Kc + C2[i]); }
    P.a_ready(cur);
    PG8_STAGE(PG8_SB(0, 0), cB, vBc); PG8_STAGE(PG8_SB(0, 1), cB + hsc, vBc); PG8_STAGE(PG8_SA(0, 0), cA, vAc); PG8_STAGE(PG8_SA(0, 1), cA + hsc, vAc);
    if (wr == 1) PG8_BAR;
    PG8_WAIT_V(2); PG8_BAR;
    PG8_STAGE(PG8_SB(1, 0), cB + kstep, vBc); PG8_STAGE(PG8_SA(1, 0), cA + kstep, vAc); PG8_STAGE(PG8_SB(1, 1), cB + hsc + kstep, vBc);
    PG8_WAIT_V(6); PG8_BAR;
    for (;;) {
        const bool has_next = P.get(ui + 1, nxt);
        const int Kn = has_next ? nxt.K : Kc; const size_t hsn = (size_t)HALF * Kn * 2;
        const char* nA = has_next ? nxt.A + (size_t)nxt.pm * 2 * hsn : cA; const char* nB = has_next ? nxt.Bt + (size_t)nxt.pn * 2 * hsn : cB;
        const int nt = cur.nk;
        for (int t = 0; t < nt; t += 2) {
            const bool last = (t == nt - 2);
            const char* a1 = cA + (size_t)(t + 1) * kstep;
            const char* a2 = last ? nA : cA + (size_t)(t + 2) * kstep; const char* b2 = last ? nB : cB + (size_t)(t + 2) * kstep;
            const char* a3 = a2 + kstep; const char* b3 = b2 + kstep;
            const size_t hs2 = last ? hsn : hsc; const int K2 = last ? Kn : Kc;
            unsigned vA2[2], vB2[2];
#pragma unroll
            for (int i = 0; i < 2; ++i) { vA2[i] = (unsigned)(RA[i] * K2 + C2[i]); vB2[i] = (unsigned)(RB[i] * K2 + C2[i]); }
            if (last && has_next) P.a_ready(nxt);
            PG8_LDB(B0, 0, 0); PG8_LDB(B1, 0, 1); PG8_SCHED; PG8_LDA(At, 0, 0); PG8_STAGE(PG8_SA(1, 1), a1 + hsc, vAc);
            PG8_WAIT_V(8); PG8_WAIT_L(0); PG8_BAR; PG8_MMA(0, 0, At, B0); PG8_MMA(0, 1, At, B1); PG8_BAR; PG8_SCHED;
            PG8_LDA(At, 0, 1); PG8_STAGE(PG8_SB(0, 0), b2, vB2); PG8_STAGE(PG8_SB(0, 1), b2 + hs2, vB2); PG8_STAGE(PG8_SA(0, 0), a2, vA2);
            PG8_WAIT_V(8); PG8_WAIT_L(0); PG8_BAR; PG8_MMA(1, 0, At, B0); PG8_MMA(1, 1, At, B1); PG8_BAR; PG8_SCHED;
            PG8_LDB(B0, 1, 0); PG8_LDB(B1, 1, 1); PG8_SCHED; PG8_LDA(At, 1, 0); PG8_STAGE(PG8_SA(0, 1), a2 + hs2, vA2);
            PG8_WAIT_V(8); PG8_WAIT_L(0); PG8_BAR; PG8_MMA(0, 0, At, B0); PG8_MMA(0, 1, At, B1); PG8_BAR; PG8_SCHED;
            PG8_LDA(At, 1, 1); PG8_STAGE(PG8_SB(1, 0), b3, vB2); PG8_STAGE(PG8_SB(1, 1), b3 + hs2, vB2); PG8_STAGE(PG8_SA(1, 0), a3, vA2);
            PG8_WAIT_V(8); PG8_WAIT_L(0); PG8_BAR; PG8_MMA(1, 0, At, B0); PG8_MMA(1, 1, At, B1); PG8_BAR; PG8_SCHED;
        }
        if constexpr (ALIGN_EPI) { if (wr == 0) PG8_BAR; }
        { int fr_e = fr, fq_e = fq, wr_e = wr, wc_e = wc; asm volatile("" : "+v"(fr_e), "+v"(fq_e), "+s"(wr_e), "+s"(wc_e));
          P.epi(acc, cur, wr_e, wc_e, fr_e, fq_e); }
        if (!has_next) break;
#pragma unroll
        for (int a = 0; a < 2; ++a)
#pragma unroll
            for (int b = 0; b < 2; ++b)
#pragma unroll
                for (int m = 0; m < 4; ++m)
#pragma unroll
                    for (int n = 0; n < 2; ++n) acc[a][b][m][n] = (f32x4){0.f, 0.f, 0.f, 0.f};
        cur = nxt; cA = nA; cB = nB; Kc = Kn; hsc = hsn; ++ui;
#pragma unroll
        for (int i = 0; i < 2; ++i) { vAc[i] = (unsigned)(RA[i] * Kc + C2[i]); vBc[i] = (unsigned)(RB[i] * Kc + C2[i]); }
        if constexpr (ALIGN_EPI) { if (wr == 1) PG8_BAR; }
    }
    PG8_WAIT_V(0);
    if constexpr (!ALIGN_EPI) { if (wr == 0) PG8_BAR; }
    PG8_BAR;
#undef PG8_SA
#undef PG8_SB
#undef PG8_STAGE
#undef PG8_LDA
#undef PG8_LDB
#undef PG8_MMA
#undef PG8_WAIT_V
#undef PG8_WAIT_L
#undef PG8_BAR
#undef PG8_SCHED
}
struct ProgG2 {
    int pm, pn; const bf16_t* zq; const bf16_t* wbr; const bf16_t* xb; const bf16_t* wg; bf16_t* ys; bf16_t* mb; const float* ssq;
    __device__ __forceinline__ bool get(int i, UnitX& u) const {
        if (i >= 6) return false;
        const int n = i >> 1; u.pm = pm; u.pn = pn; u.kind = i;
        if (i & 1) { u.A = (const char*)xb; u.Bt = (const char*)(wg + (size_t)n * 1024 * 1024); u.K = 1024; u.nk = 16; }
        else { u.A = (const char*)(zq + (size_t)n * MROWS * 512); u.Bt = (const char*)(wbr + (size_t)n * 1024 * 512); u.K = 512; u.nk = 8; }
        return true; }
    __device__ __forceinline__ void a_ready(const UnitX&) const {}
    __device__ __forceinline__ void epi(const f32x4 (&acc)[2][2][4][2], const UnitX& ux, int wr, int wc, int fr, int fq) const {
        Unit u; u.pm = ux.pm; u.pn = ux.pn;
        if (ux.kind & 1) { EpiGate E{ys, mb, ssq, ux.kind == 1 ? 1 : 0}; E(acc, u, wr, wc, fr, fq); }
        else { EpiStash E{ys}; E(acc, u, wr, wc, fr, fq); }
    }
};
struct EpiMiscPart {
    float* part;
    __device__ __forceinline__ void operator()(const f32x4 (&acc)[2][2][4][2], int pm, int kq, int wr, int wc, int fr, int fq) const {
        if (wc >= 3) return;
        float* base = part + ((size_t)kq * MROWS + (size_t)pm * BM + wr * 64 + fr) * 96 + wc * 32 + 8 * fq;
#pragma unroll
        for (int ai = 0; ai < 2; ++ai)
#pragma unroll
            for (int m = 0; m < 4; ++m) { float* rp = base + (size_t)(ai * HALF + m * 16) * 96;
                *(PG8_GAS f32x4*)rp = acc[ai][0][m][0]; *(PG8_GAS f32x4*)(rp + 4) = acc[ai][0][m][1]; }
    }
};
struct ProgG1 {
    StaticOrder S; int spm, skq; const bf16_t* xb; const bf16_t* win; bf16_t* zq; bf16_t* zkv; const float* ssq; float* part;
    __device__ __forceinline__ bool get(int i, UnitX& u) const {
        if (i >= 4) return false;
        u.K = 1024; u.A = (const char*)xb; u.Bt = (const char*)win;
        const int first = S.c & 1; const int j = first ? i - 1 : i;
        if (j >= 0 && j < 3) { Unit t; S.next(j, t); u.pm = t.pm; u.pn = t.pn; u.nk = 16; u.kind = 0; }
        else { u.pm = spm; u.pn = 12; u.A = (const char*)(xb + skq * 256); u.Bt = (const char*)(win + skq * 256); u.nk = 4; u.kind = 1; }
        return true; }
    __device__ __forceinline__ void a_ready(const UnitX&) const {}
    __device__ __forceinline__ void epi(const f32x4 (&acc)[2][2][4][2], const UnitX& ux, int wr, int wc, int fr, int fq) const {
        if (ux.kind == 0) { Unit u; u.pm = ux.pm; u.pn = ux.pn; EpiG1 E{zq, zkv, ssq}; E(acc, u, wr, wc, fr, fq); }
        else { EpiMiscPart E{part}; E(acc, ux.pm, skq, wr, wc, fr, fq); }
    }
};
}

#define GAS __attribute__((address_space(1)))
#define LAS __attribute__((address_space(3)))
typedef unsigned short bf16;
typedef unsigned v4u __attribute__((ext_vector_type(4)));
typedef float f32x4 __attribute__((ext_vector_type(4)));
typedef short bf16x8 __attribute__((ext_vector_type(8)));
typedef GAS unsigned gu32;
typedef GAS unsigned long long gu64;
#define RLX_AGENT __ATOMIC_RELAXED, __HIP_MEMORY_SCOPE_AGENT
#define LDS_WAIT() asm volatile("s_waitcnt lgkmcnt(0)" ::: "memory")
#define VM_WAIT() asm volatile("s_waitcnt vmcnt(0)" ::: "memory")
__device__ __forceinline__ unsigned long long rt() { return __builtin_amdgcn_s_memrealtime(); }
__device__ __forceinline__ unsigned f2bf(float f) { unsigned u = __builtin_bit_cast(unsigned, f); return (u + 0x7fffu + ((u >> 16) & 1u)) >> 16; }
__device__ __forceinline__ unsigned pk2(float lo, float hi) { return f2bf(lo) | (f2bf(hi) << 16); }

#define XB_TMO      128
#define XB_XCNT(j)  (256  + 64 * (j))
#define XB_XSUB(j)  (1280 + 64 * (j))
#define XB_XGEN(j)  (2304 + 64 * (j))
#define XB_TOP      3328
#define XB_TOPGEN   3392
#define XCD_BAR_WORDS 3456
#define XB_SPIN_CAP (1u << 18)

__device__ __forceinline__ unsigned xb_ld(unsigned* p)              { return __hip_atomic_load(p, __ATOMIC_RELAXED, __HIP_MEMORY_SCOPE_AGENT); }
__device__ __forceinline__ unsigned xb_add(unsigned* p, unsigned v) { return __hip_atomic_fetch_add(p, v, __ATOMIC_RELAXED, __HIP_MEMORY_SCOPE_AGENT); }
__device__ __forceinline__ unsigned xb_xcc_id() { return (unsigned)__builtin_amdgcn_s_getreg((3 << 11) | 20) & 0xFu; }
#define XB_SPIN(cond, bar) do { unsigned _sp = 0; while (cond) { __builtin_amdgcn_s_sleep(1); \
    if ((++_sp & 255u) == 0u) { if (xb_ld(&(bar)[XB_TMO])) break; if (_sp > XB_SPIN_CAP) { atomicAdd(&(bar)[XB_TMO], 1u); break; } } } } while (0)

struct XcdBarrier {
    unsigned* bar; unsigned x;
    volatile LAS unsigned* st;
};

__device__ __forceinline__ XcdBarrier xcd_barrier_post(unsigned* bar, volatile LAS unsigned* st) {
    XcdBarrier b; b.bar = bar; b.x = xb_xcc_id(); b.st = st;
    if (threadIdx.x == 0) (void)xb_add(&bar[XB_XCNT(b.x)], 1u);
    return b;
}
__device__ __forceinline__ void xcd_barrier_complete(unsigned* bar, unsigned x, unsigned& nloc, unsigned& nx) {
    const unsigned G = gridDim.x * gridDim.y * gridDim.z;
    unsigned sum, cnt, mine, sp = 0u;
    for (;;) {
        sum = 0u; cnt = 0u; mine = 0u;
#pragma unroll
        for (unsigned j = 0; j < 16; ++j) { const unsigned c = xb_ld(&bar[XB_XCNT(j)]); sum += c; cnt += (c > 0u) ? 1u : 0u; mine = (j == x) ? c : mine; }
        if (sum == G) break;
        __builtin_amdgcn_s_sleep(1);
        if ((++sp & 255u) == 0u) { if (xb_ld(&bar[XB_TMO])) break; if (sp > XB_SPIN_CAP) { atomicAdd(&bar[XB_TMO], 1u); break; } }
    }
    nloc = mine > 0u ? mine : 1u; nx = cnt > 0u ? cnt : 1u;
}

__device__ __forceinline__ void xcd_barrier(const XcdBarrier& b) {
    asm volatile("s_waitcnt vmcnt(0)" ::: "memory");
    __syncthreads();
    if (threadIdx.x < 64 && b.st[0] == 0u) {
        unsigned* bar = b.bar; const unsigned G = gridDim.x * gridDim.y * gridDim.z; const unsigned ln = threadIdx.x;
        unsigned c = 0u, sum = 0u, sp = 0u;
        for (;;) {
            c = ln < 16u ? xb_ld(&bar[XB_XCNT(ln)]) : 0u;
            sum = c;
#pragma unroll
            for (int o2 = 1; o2 < 64; o2 <<= 1) sum += __shfl_xor(sum, o2);
            if (sum == G) break;
            __builtin_amdgcn_s_sleep(1);
            if ((++sp & 255u) == 0u) { if (xb_ld(&bar[XB_TMO])) break; if (sp > XB_SPIN_CAP) { if (ln == 0u) atomicAdd(&bar[XB_TMO], 1u); break; } }
        }
        const unsigned cnt = (unsigned)__builtin_popcountll(__ballot(c > 0u));
        const unsigned mine = (unsigned)__builtin_amdgcn_readlane((int)c, (int)(b.x & 15u));
        if (ln == 0u) { b.st[0] = mine > 0u ? mine : 1u; b.st[1] = cnt > 0u ? cnt : 1u; }
        asm volatile("s_waitcnt lgkmcnt(0)" ::: "memory");
    }
    if (threadIdx.x == 0) {
        unsigned* bar = b.bar;
        __builtin_amdgcn_s_waitcnt(0);
        unsigned nloc = b.st[0], nx = b.st[1];
        if (nloc == 0u) { xcd_barrier_complete(bar, b.x, nloc, nx); b.st[0] = nloc; b.st[1] = nx; }
        const unsigned old = xb_add(&bar[XB_XSUB(b.x)], 1u);
        const unsigned gen = old / nloc;
        if (old + 1u == (gen + 1u) * nloc) {
            __builtin_amdgcn_fence(__ATOMIC_RELEASE, "agent");
            asm volatile("s_waitcnt vmcnt(0)" ::: "memory");
            const unsigned og = xb_add(&bar[XB_TOP], 1u);
            const unsigned tg = og / nx;
            if (og + 1u == (tg + 1u) * nx) xb_add(&bar[XB_TOPGEN], 1u);
            else XB_SPIN(xb_ld(&bar[XB_TOPGEN]) == tg, bar);
            __builtin_amdgcn_fence(__ATOMIC_ACQUIRE, "agent");
            xb_add(&bar[XB_XGEN(b.x)], 1u);
            asm volatile("s_waitcnt vmcnt(0)" ::: "memory");
        } else {
            XB_SPIN(xb_ld(&bar[XB_XGEN(b.x)]) == gen, bar);
            __builtin_amdgcn_fence(__ATOMIC_ACQUIRE, "agent");
            asm volatile("s_waitcnt vmcnt(0)" ::: "memory");
        }
    }
    __syncthreads();
}

namespace att {
typedef short bf16x8 __attribute__((ext_vector_type(8)));
typedef short s16x4 __attribute__((ext_vector_type(4)));
typedef float f32x16 __attribute__((ext_vector_type(16)));
typedef unsigned u32x4 __attribute__((ext_vector_type(4)));
typedef unsigned short bf16_t;
typedef unsigned long long u64;
constexpr int NKB = 4, NVB = 5;
constexpr int WSF_W = 320;
constexpr int L_K0 = 0, L_V0 = NKB * 8320, L_IMP = L_V0  , L_WSF = L_V0 + NVB * 8192, L_SEL = L_WSF + 8 * WSF_W * 4, L_OST = L_SEL + 512  , L_END = L_OST + 65536;
__device__ __forceinline__ int crow(int r, int hi) { return (r & 3) + 8 * (r >> 2) + 4 * hi; }
__device__ __forceinline__ unsigned pk2(float lo, float hi) { typedef float f2 __attribute__((ext_vector_type(2))); typedef __bf16 b2 __attribute__((ext_vector_type(2)));
    f2 v = {lo, hi}; b2 b = __builtin_convertvector(v, b2); return __builtin_bit_cast(unsigned, b); }
__device__ __forceinline__ s16x4 vtr(LAS const char* p) { typedef short v4i16_t __attribute__((ext_vector_type(4))); return __builtin_bit_cast(s16x4, __builtin_amdgcn_ds_read_tr16_b64_v4i16((LAS v4i16_t*)p)); }

struct KVSrc { const GAS bf16_t* k; const GAS bf16_t* v; int pitch; int nrows; };

struct Lane { int tid, lane, r32, hi, wid; };

__device__ __forceinline__ void tile_gload(const KVSrc& S, int t, int tid, u32x4& kr, u32x4& vr) {
    const int row = 64 * t + (tid >> 3), ch = tid & 7;
    kr = *(const GAS u32x4*)(S.k + (size_t)row * S.pitch + ch * 8); vr = *(const GAS u32x4*)(S.v + (size_t)row * S.pitch + ch * 8);
}
__device__ __forceinline__ void tile_lstore(LAS char* kb, LAS char* vb, int tid, const u32x4& kr, const u32x4& vr) {
    const int key = tid >> 3, ch = tid & 7;
    *(LAS u32x4*)(kb + ch * 1040 + (key >> 5) * 512 + (key & 31) * 16) = kr;
    *(LAS u32x4*)(vb + (ch >> 2) * 4096 + (key >> 4) * 1024 + ((key >> 3) & 1) * 512 + (key & 7) * 64 + (ch & 3) * 16) = vr;
}
__device__ __forceinline__ void qk_tile(LAS const char* kbuf, const bf16x8 (&qr)[4], f32x16& p0, f32x16& p1, int r32, int hi) {
    LAS const char* kb = kbuf + hi * 1040 + r32 * 16;
#pragma unroll
    for (int d0 = 0; d0 < 4; ++d0) {
        const bf16x8 b0 = *(LAS const bf16x8*)(kb + d0 * 2080);
        const bf16x8 b1 = *(LAS const bf16x8*)(kb + d0 * 2080 + 512);
        p0 = __builtin_amdgcn_mfma_f32_32x32x16_bf16(b0, qr[d0], p0, 0, 0, 0);
        p1 = __builtin_amdgcn_mfma_f32_32x32x16_bf16(b1, qr[d0], p1, 0, 0, 0);
    }
}
__device__ __forceinline__ void qk_tile_c(LAS const char* kbuf, const bf16x8 (&qr)[4], const f32x16& negm, f32x16& p0, f32x16& p1, int r32, int hi) {
    const unsigned ka = (unsigned)(size_t)kbuf + hi * 1040 + r32 * 16;
    bf16x8 kf[8];
#pragma unroll
    for (int d0 = 0; d0 < 4; ++d0) {
        asm volatile("ds_read_b128 %0, %1 offset:%c2" : "=&v"(kf[2 * d0]) : "v"(ka), "i"(d0 * 2080) : "memory");
        asm volatile("ds_read_b128 %0, %1 offset:%c2" : "=&v"(kf[2 * d0 + 1]) : "v"(ka), "i"(d0 * 2080 + 512) : "memory");
    }
    asm volatile("s_waitcnt lgkmcnt(0)" : "+v"(kf[0]), "+v"(kf[1]), "+v"(kf[2]), "+v"(kf[3]), "+v"(kf[4]), "+v"(kf[5]), "+v"(kf[6]), "+v"(kf[7]) :: "memory");
    __builtin_amdgcn_sched_barrier(0);
    p0 = __builtin_amdgcn_mfma_f32_32x32x16_bf16(kf[0], qr[0], negm, 0, 0, 0); p1 = __builtin_amdgcn_mfma_f32_32x32x16_bf16(kf[1], qr[0], negm, 0, 0, 0);
#pragma unroll
    for (int d0 = 1; d0 < 4; ++d0) { p0 = __builtin_amdgcn_mfma_f32_32x32x16_bf16(kf[2 * d0], qr[d0], p0, 0, 0, 0); p1 = __builtin_amdgcn_mfma_f32_32x32x16_bf16(kf[2 * d0 + 1], qr[d0], p1, 0, 0, 0); }
}
__device__ __forceinline__ void pv_tile(LAS const char* vbuf, const u32x4 (&pw)[4], f32x16 (&o)[2], f32x16& ol, int lane, int hi) {
    const unsigned va = (unsigned)(size_t)vbuf + ((lane >> 4) & 1) * 32 + (lane & 3) * 8 + (4 * hi + ((lane & 15) >> 2)) * 64;
#pragma unroll
    for (int d0 = 0; d0 < 2; ++d0) {
        s16x4 lo[4], h2[4];
#pragma unroll
        for (int ks = 0; ks < 4; ++ks) {
            asm volatile("ds_read_b64_tr_b16 %0, %1 offset:%c2" : "=&v"(lo[ks]) : "v"(va), "i"(d0 * 4096 + ks * 1024) : "memory");
            asm volatile("ds_read_b64_tr_b16 %0, %1 offset:%c2" : "=&v"(h2[ks]) : "v"(va), "i"(d0 * 4096 + ks * 1024 + 512) : "memory");
        }
        asm volatile("s_waitcnt lgkmcnt(0)" : "+v"(lo[0]), "+v"(lo[1]), "+v"(lo[2]), "+v"(lo[3]), "+v"(h2[0]), "+v"(h2[1]), "+v"(h2[2]), "+v"(h2[3]) :: "memory");
        __builtin_amdgcn_sched_barrier(0);
#pragma unroll
        for (int ks = 0; ks < 4; ++ks) {
            const bf16x8 vf = (bf16x8){lo[ks][0], lo[ks][1], lo[ks][2], lo[ks][3], h2[ks][0], h2[ks][1], h2[ks][2], h2[ks][3]};
            o[d0] = __builtin_amdgcn_mfma_f32_32x32x16_bf16(__builtin_bit_cast(bf16x8, pw[ks]), vf, o[d0], 0, 0, 0);
        }
        if (d0 == 0) {
            const bf16x8 ones = (bf16x8){0x3f80, 0x3f80, 0x3f80, 0x3f80, 0x3f80, 0x3f80, 0x3f80, 0x3f80};
#pragma unroll
            for (int ks = 0; ks < 4; ++ks) ol = __builtin_amdgcn_mfma_f32_32x32x16_bf16(__builtin_bit_cast(bf16x8, pw[ks]), ones, ol, 0, 0, 0);
        }
    }
}
__device__ __forceinline__ void mask_exp_pack(f32x16& p0, f32x16& p1, u64 mask, int hi, u32x4 (&pw)[4]) {
    const bool rowuni = __all(mask == ~0ull || mask == 0ull);
    if (rowuni) {
        const unsigned rm = mask ? ~0u : 0u;
        if (__all(mask == ~0ull)) {
#pragma unroll
            for (int r = 0; r < 16; ++r) { p0[r] = __builtin_amdgcn_exp2f(p0[r]); p1[r] = __builtin_amdgcn_exp2f(p1[r]); }
        } else {
#pragma unroll
            for (int r = 0; r < 16; ++r) { p0[r] = __uint_as_float(__float_as_uint(__builtin_amdgcn_exp2f(p0[r])) & rm); p1[r] = __uint_as_float(__float_as_uint(__builtin_amdgcn_exp2f(p1[r])) & rm); }
        }
    } else {
        const int m0 = (int)(unsigned)(mask >> (4 * hi)), m1 = (int)(unsigned)(mask >> (32 + 4 * hi));
#pragma unroll
        for (int r = 0; r < 16; ++r) { const int bit = (r & 3) + 8 * (r >> 2);
            const unsigned e0 = __float_as_uint(__builtin_amdgcn_exp2f(p0[r])), e1 = __float_as_uint(__builtin_amdgcn_exp2f(p1[r]));
            unsigned k0, k1;
            asm("v_bfe_i32 %0, %1, %2, 1" : "=v"(k0) : "v"(m0), "n"(bit)); asm("v_bfe_i32 %0, %1, %2, 1" : "=v"(k1) : "v"(m1), "n"(bit));
            p0[r] = __uint_as_float(e0 & k0); p1[r] = __uint_as_float(e1 & k1); }
    }
    pw[0] = (u32x4){pk2(p0[0], p0[1]), pk2(p0[2], p0[3]), pk2(p0[4], p0[5]), pk2(p0[6], p0[7])};
    pw[1] = (u32x4){pk2(p0[8], p0[9]), pk2(p0[10], p0[11]), pk2(p0[12], p0[13]), pk2(p0[14], p0[15])};
    pw[2] = (u32x4){pk2(p1[0], p1[1]), pk2(p1[2], p1[3]), pk2(p1[4], p1[5]), pk2(p1[6], p1[7])};
    pw[3] = (u32x4){pk2(p1[8], p1[9]), pk2(p1[10], p1[11]), pk2(p1[12], p1[13]), pk2(p1[14], p1[15])};
}
__device__ __forceinline__ u64 mask_le(int c) { return c >= 63 ? ~0ull : (c < 0 ? 0ull : ((2ull << c) - 1ull)); }
__device__ __forceinline__ u64 mask_ge(int a) { return a <= 0 ? ~0ull : (a > 63 ? 0ull : (~0ull << a)); }


__device__ __forceinline__ void glds16(const GAS void* gsrc, unsigned lds_dst) { unsigned keep;
    asm volatile("s_mov_b32 %0, m0\n\ts_mov_b32 m0, %2\n\ts_nop 0\n\tglobal_load_lds_dwordx4 %1, off\n\ts_mov_b32 m0, %0" : "=&s"(keep) : "v"(gsrc), "s"(lds_dst) : "memory"); }
__device__ __forceinline__ void tile_dma(const KVSrc& S, int t, unsigned kslot, unsigned vslot, const Lane& L) {
    const GAS bf16_t* ks = S.k + (size_t)(64 * t + L.lane) * S.pitch + L.wid * 8;
    const GAS bf16_t* vs = S.v + (size_t)(64 * t + 16 * (L.wid & 3) + (L.lane >> 2)) * S.pitch + (L.wid >> 2) * 32 + (L.lane & 3) * 8;
    glds16(ks, (unsigned)__builtin_amdgcn_readfirstlane(kslot + L.wid * 1040));
    glds16(vs, (unsigned)__builtin_amdgcn_readfirstlane(vslot + (L.wid >> 2) * 4096 + (L.wid & 3) * 1024));
}
#define ATT_WAIT_BAR(N) asm volatile("s_waitcnt vmcnt(" #N ") lgkmcnt(0)\n\ts_barrier" ::: "memory")
template <class MF>
__device__ __forceinline__ void attend_range(LAS char* lds, const KVSrc& S, int t0, int t1, const MF& mf, const bf16x8 (&qr)[4], float negC, f32x16& ol, f32x16 (&o)[2], const Lane& L, bool abl = false) {
    if (t0 >= t1) return;
    const bool late = L.wid >= 4;
    const unsigned lds0 = (unsigned)(size_t)lds;
    const f32x16 negm = {0.f, 0.f, 0.f, 0.f, 0.f, 0.f, 0.f, 0.f, 0.f, 0.f, 0.f, 0.f, 0.f, 0.f, 0.f, 0.f};
    (void)negC;
    tile_dma(S, t0, lds0 + L_K0, lds0 + L_V0, L);
    if (t0 + 1 < t1) tile_dma(S, t0 + 1, lds0 + L_K0 + 8320, lds0 + L_V0 + 8192, L);
    if (t0 + 2 < t1) tile_dma(S, t0 + 2, lds0 + L_K0 + 2 * 8320, lds0 + L_V0 + 2 * 8192, L);
    if (t0 + 2 < t1) ATT_WAIT_BAR(4); else if (t0 + 1 < t1) ATT_WAIT_BAR(2); else ATT_WAIT_BAR(0);
    u32x4 pwp[4];
#pragma unroll
    for (int k = 0; k < 4; ++k) asm volatile("" : "=v"(pwp[k]));
    int kcur = 0, vcur = 0, vprev = 0;
    u64 mk_next = mf(t0);
#if defined(PROBE_ABL) && PROBE_ABL == 12
    if (abl) { for (int t = t0; t < t1; ++t) { asm volatile("s_nop 0" ::: "memory"); } return; }
#endif
#if defined(PROBE_ABL) && PROBE_ABL == 13
    if (abl) { for (int t = t0; t < t1; ++t) { ATT_WAIT_BAR(0); } return; }
#endif
#if defined(PROBE_ABL) && PROBE_ABL == 14
    if (abl) { u64 acc_ = 0; for (int t = t0; t < t1; ++t) { acc_ ^= mf(t); asm volatile("s_waitcnt lgkmcnt(0)" : "+v"(acc_) :: "memory"); } asm volatile("" :: "v"(acc_)); return; }
#endif
#if defined(PROBE_ABL) && PROBE_ABL == 15
    if (abl) { for (int t = t0; t < t1; ++t) { f32x16 p0, p1; qk_tile_c(lds + L_K0, qr, negm, p0, p1, L.r32, L.hi); asm volatile("" :: "v"(p0), "v"(p1)); } return; }
#endif
#pragma unroll 1
    for (int t = t0; t < t1; ++t) {
        const u64 mk = mk_next;
        if (t + 1 < t1) mk_next = mf(t + 1);
#if defined(PROBE_ABL) && PROBE_ABL >= 10
        if (t + 3 < t1 && !abl) {
#else
        if (t + 3 < t1) {
#endif
            const int ks = kcur == 0 ? NKB - 1 : kcur - 1; int vs = vcur + 3; vs = vs >= NVB ? vs - NVB : vs;
            tile_dma(S, t + 3, lds0 + L_K0 + ks * 8320, lds0 + L_V0 + vs * 8192, L); }
#if defined(PROBE_ABL) && (PROBE_ABL == 6 || PROBE_ABL >= 10)
        if (late && t > t0 && !abl) pv_tile(lds + L_V0 + vprev * 8192, pwp, o, ol, L.lane, L.hi);
#else
        if (late && t > t0) pv_tile(lds + L_V0 + vprev * 8192, pwp, o, ol, L.lane, L.hi);
#endif
        f32x16 p0, p1;
#if defined(PROBE_ABL) && (PROBE_ABL == 6 || PROBE_ABL >= 10)
        if (abl) { p0 = negm; p1 = negm; asm volatile("" : "+v"(p0), "+v"(p1)); } else
#endif
        qk_tile_c(lds + L_K0 + kcur * 8320, qr, negm, p0, p1, L.r32, L.hi);
        u32x4 pw[4];
#if defined(PROBE_ABL) && (PROBE_ABL == 2 || PROBE_ABL >= 10)
        if (abl) {
#pragma unroll
            for (int k = 0; k < 4; ++k) pw[k] = (u32x4){__float_as_uint(p0[4 * k]) ^ (unsigned)mk, __float_as_uint(p0[4 * k + 1]), __float_as_uint(p1[4 * k + 2]), __float_as_uint(p1[4 * k + 3])}; }
        else
#endif
        mask_exp_pack(p0, p1, mk, L.hi, pw);
#if defined(PROBE_ABL) && (PROBE_ABL == 6 || PROBE_ABL >= 10)
        if (!late && !abl) pv_tile(lds + L_V0 + vcur * 8192, pw, o, ol, L.lane, L.hi);
        else if (!late) { asm volatile("" :: "v"(pw[0]), "v"(pw[1]), "v"(pw[2]), "v"(pw[3])); }
#else
        if (!late) pv_tile(lds + L_V0 + vcur * 8192, pw, o, ol, L.lane, L.hi);
#endif
        else {
#pragma unroll
            for (int k = 0; k < 4; ++k) pwp[k] = pw[k]; }
#if defined(PROBE_ABL) && PROBE_ABL == 11
        if (abl) { asm volatile("s_waitcnt lgkmcnt(0)" ::: "memory"); } else
#endif
        if (t + 3 < t1) ATT_WAIT_BAR(4); else if (t + 2 < t1) ATT_WAIT_BAR(2); else ATT_WAIT_BAR(0);
        vprev = vcur; vcur = vcur == NVB - 1 ? 0 : vcur + 1; kcur = kcur == NKB - 1 ? 0 : kcur + 1;
    }
    if (late) pv_tile(lds + L_V0 + vprev * 8192, pwp, o, ol, L.lane, L.hi);
    ATT_WAIT_BAR(0);
}
__device__ __forceinline__ void rows_to_regs(LAS float* wsf, float v, int r32, int hi, float (&sc)[16]) {
    asm volatile("s_waitcnt lgkmcnt(0)" ::: "memory");
    if (hi == 0) wsf[r32] = v;
    asm volatile("s_waitcnt lgkmcnt(0)" ::: "memory");
#pragma unroll
    for (int r = 0; r < 16; ++r) sc[r] = wsf[crow(r, hi)];
}
__device__ __forceinline__ void load_q(const bf16_t* qrow, int hi, bf16x8 (&qr)[4]) {
#pragma unroll
    for (int d0 = 0; d0 < 4; ++d0) qr[d0] = *(const GAS bf16x8*)(qrow + d0 * 16 + hi * 8);
}
template <class RowPtr>
__device__ __forceinline__ void store_o(LAS char* stage, const f32x16 (&acc)[2], const RowPtr& rowptr, int lane, int r32, int hi) {
    LAS bf16_t* stg = (LAS bf16_t*)stage;
#pragma unroll
    for (int r = 0; r < 16; ++r) { const int orow = crow(r, hi);
#pragma unroll
        for (int d0 = 0; d0 < 2; ++d0) stg[orow * 64 + d0 * 32 + r32] = (bf16_t)(pk2(acc[d0][r], 0.f) & 0xffffu); }
    asm volatile("s_waitcnt lgkmcnt(0)" ::: "memory");
#pragma unroll
    for (int i = 0; i < 4; ++i) { const int row = i * 8 + (lane >> 3), ch = lane & 7; const u32x4 v = *(LAS const u32x4*)(stg + row * 64 + ch * 8); *(GAS u32x4*)(rowptr(row) + ch * 8) = v; }
    asm volatile("s_waitcnt lgkmcnt(0)" ::: "memory");
}
}

constexpr int NWAVES = 8;
constexpr int BATCH = 4, SEQ = 4096, DM = 1024, DFF = 4096, DEPTH = 2, D_IN = 6236;
constexpr int M = BATCH * SEQ;
constexpr size_t MiB = 1u << 20;
constexpr size_t WS_ZQ = 0;
constexpr size_t WS_ZKV = 48 * MiB;
constexpr size_t WS_YS = WS_ZKV;
constexpr size_t WS_MB = 104 * MiB;
constexpr size_t WS_KC2 = WS_MB, WS_VC2 = WS_MB + 4 * MiB;
constexpr size_t WS_PART = 112 * MiB;
constexpr size_t WS_XB = 136 * MiB;
constexpr size_t WS_W = 168 * MiB, W_LAYER = 36 * MiB;
constexpr size_t W_IN = 0, W_G = 7 * MiB, W_BR = 13 * MiB, W_OUT = 16 * MiB, W_UP = 18 * MiB, W_DN = 26 * MiB, W_CK1 = 34 * MiB, W_CV1 = 35 * MiB;
constexpr size_t WS_BM = 240 * MiB;
constexpr size_t WS_MISC = 248 * MiB;
constexpr size_t WS_CTL = WS_MISC, CTL_BYTES = 128 * 1024;
constexpr size_t WS_COS = WS_MISC + 1 * MiB, WS_SIN = WS_MISC + 1 * MiB + 512 * 1024;
constexpr size_t WS_KCMP = WS_MISC + 2 * MiB;
constexpr size_t WS_SSQ = WS_MISC + 2 * MiB + 512 * 1024;
constexpr size_t WS_B1P = WS_MISC + 3 * MiB + 512 * 1024;
constexpr size_t WS_W2 = WS_B1P + 64 * 1024;
constexpr size_t WS_IKF = WS_MISC + 4 * MiB;
constexpr size_t WS_HMID = 0;
constexpr size_t WS_END = 256 * MiB;
constexpr int CW_BAR = 4096, CW_Q = 8192, CW_KMAX = 12288;
constexpr int LDS_BYTES = 163840, LDS_UNIT = 163776;
constexpr float C2 = 0.125f * 1.4426950408889634f, LOG2E = 1.4426950408889634f;


struct Args { const float* in[17]; float* out; unsigned char* ws; };
struct Frame {
    LAS unsigned char* lds;
    gu32* ctl;
    int tid, lane, wave, G, gw, NGW;
    unsigned char* ws;
    const struct Args* a;
};
__device__ __forceinline__ float wave_sum(float v) {
#pragma unroll
    for (int o = 1; o < 64; o <<= 1) v += __shfl_xor(v, o);
    return v;
}
__device__ __forceinline__ float wave_max(float v) {
#pragma unroll
    for (int o = 1; o < 64; o <<= 1) v = fmaxf(v, __shfl_xor(v, o));
    return v;
}
__device__ __forceinline__ float bf2f(bf16 h) { return __uint_as_float((unsigned)h << 16); }
__device__ __constant__ float c_inv_freq[32] = {
    1.0f, 0.7498942093324559f, 0.5623413251903491f, 0.4216965034285822f, 0.31622776601683794f, 0.23713737056616552f, 0.1778279410038923f, 0.1333521432163324f,
    0.1f, 0.07498942093324558f, 0.05623413251903491f, 0.042169650342858224f, 0.03162277660168379f, 0.023713737056616554f, 0.01778279410038923f, 0.01333521432163324f,
    0.01f, 0.007498942093324558f, 0.005623413251903491f, 0.004216965034285823f, 0.0031622776601683794f, 0.0023713737056616554f, 0.0017782794100389228f, 0.001333521432163324f,
    0.001f, 0.0007498942093324559f, 0.0005623413251903491f, 0.00042169650342858224f, 0.00031622776601683794f, 0.00023713737056616554f, 0.00017782794100389227f, 0.0001333521432163324f};

__device__ __forceinline__ int mix_src_col(int j) {
    if (j < 512) return j;
    if (j < 1024) return 1092 + (j - 512);
    if (j < 1536) return 1860 + (j - 1024);
    if (j < 1792) return 512 + (j - 1536);
    if (j < 2048) return 1604 + (j - 1792);
    if (j < 2304) return 2372 + (j - 2048);
    if (j < 2560) return 2628 + (j - 2304);
    if (j < 2816) return 2884 + (j - 2560);
    if (j < 3072) return 768 + (j - 2816);
    const int r = j - 3072;
    if (r < 64) return 1024 + r;
    if (r < 68) return 1088 + (r - 64);
    if (r < 92) return 3140 + (r - 68);
    return -1;
}
template <int MODE>
__device__ __forceinline__ void p0_item(const float* W, int ldw, int K, bf16* WT, int nblk, int item, const float* gain, int coff, LAS float* scr, int lane) {
    const int kb = item / nblk, nb = item % nblk, k0 = 64 * kb, n0 = 32 * nb;
    const int nq = 4 * (lane & 7), rr = lane >> 3;
    const int sc = MODE != 1 ? (n0 + nq + coff) : mix_src_col(n0 + nq);
    f32x4 v[8];
#pragma unroll
    for (int i = 0; i < 8; ++i) { v[i] = (f32x4){0.f, 0.f, 0.f, 0.f}; if (sc >= 0) v[i] = *(const GAS f32x4*)(W + (size_t)(k0 + 8 * i + rr) * ldw + sc); }
#pragma unroll
    for (int i = 0; i < 8; ++i) { const int kk = 8 * i + rr; const float g = gain ? gain[k0 + kk] : 1.0f;
        scr[kk * 33 + nq + 0] = v[i][0] * g; scr[kk * 33 + nq + 1] = v[i][1] * g; scr[kk * 33 + nq + 2] = v[i][2] * g; scr[kk * 33 + nq + 3] = v[i][3] * g; }
    LDS_WAIT(); asm volatile("" ::: "memory");
    const int c = lane & 7;
#pragma unroll
    for (int j = 0; j < 4; ++j) { const int n = (lane >> 3) + 8 * j; const LAS float* s = scr + (8 * c) * 33 + n;
        v4u o; o.x = pk2(s[0 * 33], s[1 * 33]); o.y = pk2(s[2 * 33], s[3 * 33]); o.z = pk2(s[4 * 33], s[5 * 33]); o.w = pk2(s[6 * 33], s[7 * 33]);
        if (MODE == 2) *(GAS v4u*)(WT + (size_t)nb * (32 * K) + (size_t)(4 * kb + (c >> 1)) * 512 + (c & 1) * 256 + n * 8) = o;
        else *(GAS v4u*)(WT + (size_t)(n0 + n) * K + k0 + 8 * c) = o; }
    LDS_WAIT(); asm volatile("" ::: "memory");
}
__device__ __forceinline__ void p0_prologue(Frame& F) {
    LAS float* scr = (LAS float*)(F.lds + F.wave * 16384);
    constexpr int I_IN = 16 * 104, I_G = 16 * 96, I_BR = 8 * 32, I_OUT = 16 * 32, I_UP = 16 * 128, I_DN = 64 * 32, I_C1 = 32 * 8, I_C2 = 4 * 2;
    constexpr int PER_LAYER = I_IN + I_G + 3 * I_BR + I_OUT + I_UP + I_DN + 2 * I_C1 + 2 * I_C2;
    for (int it = F.gw; it < 2 * PER_LAYER; it += F.NGW) {
        const int l = it / PER_LAYER; int r = it % PER_LAYER;
        unsigned char* wl = F.ws + WS_W + (size_t)l * W_LAYER;
        const float* w_in = F.a->in[2] + (size_t)l * DM * D_IN;
        if (r < I_IN) { p0_item<1>(w_in, D_IN, DM, (bf16*)(wl + W_IN), 104, r, F.a->in[1] + l * DM, 0, scr, F.lane); continue; } r -= I_IN;
        if (r < I_G) { p0_item<0>(w_in, D_IN, DM, (bf16*)(wl + W_G), 96, r, F.a->in[1] + l * DM, 3164, scr, F.lane); continue; } r -= I_G;
        if (r < 3 * I_BR) { const int n = r / I_BR; p0_item<0>(F.a->in[12] + ((size_t)l * 3 + n) * 512 * DM, DM, 512, (bf16*)(wl + W_BR) + (size_t)n * DM * 512, 32, r % I_BR, nullptr, 0, scr, F.lane); continue; } r -= 3 * I_BR;
        if (r < I_OUT) { p0_item<0>(F.a->in[13] + (size_t)l * DM * DM, DM, DM, (bf16*)(wl + W_OUT), 32, r, nullptr, 0, scr, F.lane); continue; } r -= I_OUT;
        if (r < I_UP) { p0_item<0>(F.a->in[15] + (size_t)l * DM * DFF, DFF, DM, (bf16*)(wl + W_UP), 128, r, F.a->in[14] + l * DM, 0, scr, F.lane); continue; } r -= I_UP;
        if (r < I_DN) { p0_item<0>(F.a->in[16] + (size_t)l * DFF * DM, DM, DFF, (bf16*)(wl + W_DN), 32, r, nullptr, 0, scr, F.lane); continue; } r -= I_DN;
        if (r < I_C1) { p0_item<2>(F.a->in[8] + (size_t)l * 2048 * 256, 256, 2048, (bf16*)(wl + W_CK1), 8, r, nullptr, 0, scr, F.lane); continue; } r -= I_C1;
        if (r < I_C1) { p0_item<2>(F.a->in[10] + (size_t)l * 2048 * 256, 256, 2048, (bf16*)(wl + W_CV1), 8, r, nullptr, 0, scr, F.lane); continue; } r -= I_C1;
        if (r < I_C2) { p0_item<0>(F.a->in[9] + (size_t)l * 256 * 64, 64, 256, (bf16*)(F.ws + WS_W2) + (size_t)(l * 2 + 0) * 64 * 256, 2, r, nullptr, 0, scr, F.lane); continue; } r -= I_C2;
        p0_item<0>(F.a->in[11] + (size_t)l * 256 * 64, 64, 256, (bf16*)(F.ws + WS_W2) + (size_t)(l * 2 + 1) * 64 * 256, 2, r, nullptr, 0, scr, F.lane);
    }
    for (int it = F.gw; it < 128; it += F.NGW) {
        const int kp = it & 7, jb = (it >> 3) & 3, which = (it >> 5) & 1, l = it >> 6; const int j = jb * 64 + F.lane;
        const float* pe = (which ? F.a->in[7] : F.a->in[6]) + l * 2048; const float* w1 = (which ? F.a->in[10] : F.a->in[8]) + (size_t)l * 2048 * 256;
        float a = 0.f;
        for (int k = kp * 256; k < kp * 256 + 256; ++k) a = fmaf(pe[k], w1[(size_t)k * 256 + j], a);
        ((float*)(F.ws + WS_B1P))[((l * 2 + which) * 8 + kp) * 256 + j] = a;
    }
    for (int m = F.gw; m < M; m += F.NGW) {
        const GAS f32x4* xr = (const GAS f32x4*)(F.a->in[0] + (size_t)m * DM) + F.lane;
        GAS unsigned long long* o8 = (GAS unsigned long long*)((bf16*)(F.ws + WS_XB) + (size_t)m * DM) + F.lane;
        float s = 0.f;
#pragma unroll
        for (int j = 0; j < 4; ++j) { const f32x4 v = xr[64 * j]; s += (v.x * v.x + v.y * v.y) + (v.z * v.z + v.w * v.w);
            o8[64 * j] = (unsigned long long)pk2(v.x, v.y) | ((unsigned long long)pk2(v.z, v.w) << 32); }
        s = wave_sum(s);
        if (F.lane < 16) ((float*)(F.ws + WS_SSQ))[(size_t)m * 16 + F.lane] = F.lane == 0 ? s : 0.f;
    }
    for (int i = F.gw * 64 + F.lane; i < SEQ * 32; i += F.NGW * 64) {
        const float ang = (float)(i >> 5) * c_inv_freq[i & 31];
        ((float*)(F.ws + WS_COS))[i] = (float)cos((double)ang); ((float*)(F.ws + WS_SIN))[i] = (float)sin((double)ang);
    }
}
typedef unsigned u32x4_t __attribute__((ext_vector_type(4)));
__device__ __forceinline__ void post_group(u32x4_t raw, bool act, bool norm, bool rope, const float (&gain)[8], float scale, const float (&cs)[8], const float (&sn)[8], int lane, bf16* dst) {
    float v[8];
    v[0] = __uint_as_float(raw.x << 16); v[1] = __uint_as_float(raw.x & 0xffff0000u); v[2] = __uint_as_float(raw.y << 16); v[3] = __uint_as_float(raw.y & 0xffff0000u);
    v[4] = __uint_as_float(raw.z << 16); v[5] = __uint_as_float(raw.z & 0xffff0000u); v[6] = __uint_as_float(raw.w << 16); v[7] = __uint_as_float(raw.w & 0xffff0000u);
    float ss = ((v[0] * v[0] + v[1] * v[1]) + (v[2] * v[2] + v[3] * v[3])) + ((v[4] * v[4] + v[5] * v[5]) + (v[6] * v[6] + v[7] * v[7]));
    ss += __shfl_xor(ss, 1); ss += __shfl_xor(ss, 2); ss += __shfl_xor(ss, 4);
    const float rs = norm ? rsqrtf(ss * (1.0f / 64.0f) + 1e-6f) : 1.0f;
    const bool lo = (lane & 4) == 0;
    float r[8];
#pragma unroll
    for (int j = 0; j < 8; ++j) { const float x = norm ? v[j] * rs * gain[j] : v[j]; const float o = __shfl_xor(x, 4);
        r[j] = rope ? (lo ? (x * cs[j] - o * sn[j]) : (x * cs[j] + o * sn[j])) : x; r[j] *= scale; }
    if (act) { u32x4_t w; w.x = pk2(r[0], r[1]); w.y = pk2(r[2], r[3]); w.z = pk2(r[4], r[5]); w.w = pk2(r[6], r[7]); *(GAS u32x4_t*)dst = w; }
}
struct PostRow { u32x4_t r0, r1, r2, r3, r4; f32x4 c0, c1, s0, s1; };
__device__ __forceinline__ void post_issue(Frame& F, int m, PostRow& R) {
    const int lane = F.lane, g = lane >> 3, c = lane & 7;
    const int t = m & (SEQ - 1);
    const bf16* zq = (const bf16*)(F.ws + WS_ZQ); const bf16* zkv = (const bf16*)(F.ws + WS_ZKV);
    const float* cst = (const float*)(F.ws + WS_COS); const float* snt = (const float*)(F.ws + WS_SIN);
    const GAS f32x4* cp = (const GAS f32x4*)(cst + t * 32 + 8 * (c & 3)); const GAS f32x4* sp = (const GAS f32x4*)(snt + t * 32 + 8 * (c & 3));
    R.c0 = cp[0]; R.c1 = cp[1]; R.s0 = sp[0]; R.s1 = sp[1];
    const bf16* pqa = zq + (size_t)m * 512 + lane * 8;
    const int t3 = (g >> 1) < 2 ? (g >> 1) : (g >> 1) + 1;
    const bf16* p3 = zkv + (size_t)t3 * M * 256 + (size_t)m * 256 + (g & 1) * 64 + c * 8;
    const bf16* s4 = g < 4 ? zkv + (size_t)2 * M * 256 + (size_t)m * 256 + g * 64 + c * 8 : zkv + (size_t)5 * M * 256 + (size_t)m * 256 + (g - 4) * 64 + c * 8;
    R.r0 = *(const GAS u32x4_t*)pqa; R.r1 = *(const GAS u32x4_t*)(pqa + (size_t)M * 512); R.r2 = *(const GAS u32x4_t*)(pqa + (size_t)2 * M * 512);
    R.r3 = *(const GAS u32x4_t*)p3; R.r4 = *(const GAS u32x4_t*)s4;
}
__device__ __forceinline__ void post_finish(Frame& F, int m, const PostRow& R, const float (&gq0)[8], const float (&gq1)[8], const float (&gq2)[8], const float (&gk3)[8], const float (&gk2)[8], bool dry) {
    const int lane = F.lane, g = lane >> 3, c = lane & 7;
    const int t = m & (SEQ - 1), b = m >> 12;
    bf16* zq = (bf16*)(F.ws + WS_ZQ); bf16* zkv = (bf16*)(F.ws + WS_ZKV);
    float cs[8], sn[8];
    cs[0] = R.c0[0]; cs[1] = R.c0[1]; cs[2] = R.c0[2]; cs[3] = R.c0[3]; cs[4] = R.c1[0]; cs[5] = R.c1[1]; cs[6] = R.c1[2]; cs[7] = R.c1[3];
    sn[0] = R.s0[0]; sn[1] = R.s0[1]; sn[2] = R.s0[2]; sn[3] = R.s0[3]; sn[4] = R.s1[0]; sn[5] = R.s1[1]; sn[6] = R.s1[2]; sn[7] = R.s1[3];
    f32x4 pa[4], pb[4]; f32x4 q0, q1, q2, q3;
    { const int cg = (g == 1 && c < 4) ? 8 + c : c;
      const float* pp = (const float*)(F.ws + WS_PART) + (size_t)m * 96 + cg * 8;
#pragma unroll
      for (int kq = 0; kq < 4; ++kq) { pa[kq] = *(const GAS f32x4*)(pp + (size_t)kq * M * 96); pb[kq] = *(const GAS f32x4*)(pp + (size_t)kq * M * 96 + 4); }
      const GAS f32x4* qp = (const GAS f32x4*)((const float*)(F.ws + WS_SSQ) + (size_t)m * 16);
      q0 = qp[0]; q1 = qp[1]; q2 = qp[2]; q3 = qp[3]; }
    __builtin_amdgcn_sched_barrier(0);
    bf16* pqa = zq + (size_t)m * 512 + lane * 8; bf16* pqb = pqa + (size_t)M * 512; bf16* pqc = pqa + (size_t)2 * M * 512;
    const int t3 = (g >> 1) < 2 ? (g >> 1) : (g >> 1) + 1;
    bf16* p3 = zkv + (size_t)t3 * M * 256 + (size_t)m * 256 + (g & 1) * 64 + c * 8;
    bf16* s4 = g < 4 ? zkv + (size_t)2 * M * 256 + (size_t)m * 256 + g * 64 + c * 8 : zkv + (size_t)5 * M * 256 + (size_t)m * 256 + (g - 4) * 64 + c * 8;
    bf16* d4 = g < 2 ? (bf16*)(F.ws + WS_KC2) + ((size_t)(b * 2 + g) * SEQ + t) * 64 + c * 8
             : (g < 4 ? (bf16*)(F.ws + WS_VC2) + ((size_t)(b * 2 + (g - 2)) * SEQ + t) * 64 + c * 8 : s4);
    bf16* d5 = (bf16*)(F.ws + WS_IKF) + ((size_t)(b * (SEQ / 32) + (t >> 5)) * 8 + c) * 256 + (t & 31) * 8;
    post_group(R.r0, !dry, true, true, gq0, C2, cs, sn, lane, pqa);
    post_group(R.r1, !dry, true, true, gq1, C2, cs, sn, lane, pqb);
    post_group(R.r2, !dry, true, true, gq2, C2, cs, sn, lane, pqc);
    post_group(R.r3, !dry, true, true, gk3, 1.f, cs, sn, lane, p3);
    post_group(R.r4, !dry, g < 2, g < 2 || g >= 4, gk2, 1.f, cs, sn, lane, d4);
    u32x4_t r5;
    { const f32x4 s0 = (pa[0] + pa[1]) + (pa[2] + pa[3]), s1 = (pb[0] + pb[1]) + (pb[2] + pb[3]);
      const float ssum = (((q0[0] + q0[1]) + (q0[2] + q0[3])) + ((q1[0] + q1[1]) + (q1[2] + q1[3]))) + (((q2[0] + q2[1]) + (q2[2] + q2[3])) + ((q3[0] + q3[1]) + (q3[2] + q3[3])));
      const float rs = rsqrtf(ssum * (1.0f / 1024.0f) + 1e-6f);
      r5.x = pk2(s0[0] * rs, s0[1] * rs); r5.y = pk2(s0[2] * rs, s0[3] * rs); r5.z = pk2(s1[0] * rs, s1[1] * rs); r5.w = pk2(s1[2] * rs, s1[3] * rs);
      if (g == 1 && c < 4 && !dry) *(GAS u32x4_t*)(zkv + (size_t)6 * M * 256 + (size_t)m * 256 + 64 + c * 8) = r5; }
    post_group(r5, g == 0 && !dry, false, true, gk2, 1.f, cs, sn, lane, d5);
}
__device__ __forceinline__ void post_phase(Frame& F, int l, bool dry = false) {
    const float* qn = F.a->in[3] + l * 192; const float* kn = F.a->in[4] + l * 192;
    const int lane = F.lane, g = lane >> 3, c = lane & 7;
    float gq0[8], gq1[8], gq2[8], gk3[8], gk2[8];
#pragma unroll
    for (int j = 0; j < 8; ++j) { gq0[j] = qn[8 * c + j]; gq1[j] = qn[64 + 8 * c + j]; gq2[j] = qn[128 + 8 * c + j]; gk2[j] = kn[128 + 8 * c + j];
        gk3[j] = (g >> 1) == 0 ? kn[8 * c + j] : ((g >> 1) == 1 ? kn[64 + 8 * c + j] : kn[128 + 8 * c + j]); }
    PostRow A, B;
    int m = F.gw;
    if (m < M) post_issue(F, m, A);
#pragma unroll 1
    for (; m < M; m += 2 * F.NGW) {
        const int m2 = m + F.NGW, m3 = m + 2 * F.NGW;
        if (m2 < M) post_issue(F, m2, B);
        __builtin_amdgcn_sched_barrier(0);
        post_finish(F, m, A, gq0, gq1, gq2, gk3, gk2, dry);
        __builtin_amdgcn_sched_barrier(0);
        if (m3 < M) post_issue(F, m3, A);
        __builtin_amdgcn_sched_barrier(0);
        if (m2 < M) post_finish(F, m2, B, gq0, gq1, gq2, gk3, gk2, dry);
        __builtin_amdgcn_sched_barrier(0);
    }
}

#define WAVE_LDS_FENCE() asm volatile("s_waitcnt lgkmcnt(0)" ::: "memory")
__device__ __forceinline__ int next_unit(Frame& F, gu32* counter, int step = 1) {
    LAS int* slot = (LAS int*)(F.lds + LDS_UNIT);
    __syncthreads();
    if (F.tid == 0) *slot = (int)__hip_atomic_fetch_add(counter, (unsigned)step, RLX_AGENT);
    __syncthreads();
    return *slot;
}
__device__ __forceinline__ int work_mask(Frame& F, gu32* q0, unsigned limit) {
    LAS int* slot = (LAS int*)(F.lds + LDS_UNIT);
    __syncthreads();
    if (F.tid < 8) { const unsigned c = __hip_atomic_load(q0 + 64 * F.tid, RLX_AGENT); const unsigned long long bal = __ballot(c < limit); if (F.tid == 0) *slot = (int)(bal & 0xffull); }
    __syncthreads();
    return *slot;
}
__device__ __forceinline__ unsigned f2key(float f) { const unsigned u = __float_as_uint(f); return (u & 0x80000000u) ? ~u : (u | 0x80000000u); }
__device__ __forceinline__ float dpp_quad_sum(float v) {
    v += __int_as_float(__builtin_amdgcn_update_dpp(0, __float_as_int(v), 0xB1, 0xF, 0xF, true));
    v += __int_as_float(__builtin_amdgcn_update_dpp(0, __float_as_int(v), 0x4E, 0xF, 0xF, true));
    return v;
}
__device__ __forceinline__ void radix_select_list(LAS const unsigned* list, int nblk, int k, LAS unsigned* hist, int lane, unsigned& T, int& need, int npass = 4, int* eqcnt = nullptr) {
    typedef unsigned u32x4_ __attribute__((ext_vector_type(4)));
    unsigned prefix = 0u; int kk = k; int hsel = 0;
    int pass0 = 0;
    if (nblk <= 2) {
        const u32x4_ k0 = *(LAS const u32x4_*)(list + lane * 4); u32x4_ k1 = k0;
        if (nblk == 2) k1 = *(LAS const u32x4_*)(list + 256 + lane * 4);
        unsigned tb[8];
#pragma unroll
        for (int c = 0; c < 4; ++c) { tb[c] = k0[c] >> 24; tb[4 + c] = nblk == 2 ? (k1[c] >> 24) : 0u; }
        unsigned bound = 256u; int accn = 0;
#pragma unroll 1
        for (;;) {
            unsigned m = 0u;
#pragma unroll
            for (int c = 0; c < 8; ++c) { const unsigned t = tb[c] < bound ? tb[c] : 0u; m = t > m ? t : m; }
            unsigned o_;
            o_ = (unsigned)__builtin_amdgcn_update_dpp(0, (int)m, 0x111, 0xf, 0xf, false); m = o_ > m ? o_ : m; o_ = (unsigned)__builtin_amdgcn_update_dpp(0, (int)m, 0x112, 0xf, 0xf, false); m = o_ > m ? o_ : m;
            o_ = (unsigned)__builtin_amdgcn_update_dpp(0, (int)m, 0x114, 0xf, 0xf, false); m = o_ > m ? o_ : m; o_ = (unsigned)__builtin_amdgcn_update_dpp(0, (int)m, 0x118, 0xf, 0xf, false); m = o_ > m ? o_ : m;
            o_ = (unsigned)__builtin_amdgcn_update_dpp(0, (int)m, 0x142, 0xa, 0xf, false); m = o_ > m ? o_ : m; o_ = (unsigned)__builtin_amdgcn_update_dpp(0, (int)m, 0x143, 0xc, 0xf, false); m = o_ > m ? o_ : m;
            const unsigned M_ = (unsigned)__builtin_amdgcn_readlane((int)m, 63);
            int cnt = 0;
#pragma unroll
            for (int c = 0; c < 8; ++c) cnt += __builtin_popcountll(__ballot(tb[c] == M_));
            if (accn + cnt >= kk || M_ == 0u) { prefix = M_; hsel = cnt; kk = kk - accn; break; }
            accn += cnt; bound = M_;
        }
        pass0 = 1;
    }
#pragma unroll 1
    for (int pass = pass0; pass < npass; ++pass) {
        const int shift = 24 - 8 * pass;
#pragma unroll
        for (int i = 0; i < 4; ++i) hist[lane * 4 + i] = 0u;
        WAVE_LDS_FENCE();
#pragma unroll 2
        for (int jb = 0; jb < nblk; ++jb) { const u32x4_ v = *(LAS const u32x4_*)(list + jb * 256 + lane * 4);
#pragma unroll
            for (int c = 0; c < 4; ++c) { const unsigned key = v[c];
                const unsigned bin = (pass == 0 || (key >> (shift + 8)) == prefix) ? ((key >> shift) & 255u) : 256u + (unsigned)lane;
                __hip_atomic_fetch_add(&hist[bin], 1u, __ATOMIC_RELAXED, __HIP_MEMORY_SCOPE_WORKGROUP); } }
        WAVE_LDS_FENCE();
        const unsigned h0 = hist[lane * 4], h1 = hist[lane * 4 + 1], h2 = hist[lane * 4 + 2], h3 = hist[lane * 4 + 3];
        const int tot4 = (int)(h0 + h1 + h2 + h3);
        int pre = tot4;
        pre += __builtin_amdgcn_update_dpp(0, pre, 0x111, 0xf, 0xf, false);
        pre += __builtin_amdgcn_update_dpp(0, pre, 0x112, 0xf, 0xf, false);
        pre += __builtin_amdgcn_update_dpp(0, pre, 0x114, 0xf, 0xf, false);
        pre += __builtin_amdgcn_update_dpp(0, pre, 0x118, 0xf, 0xf, false);
        pre += __builtin_amdgcn_update_dpp(0, pre, 0x142, 0xa, 0xf, false);
        pre += __builtin_amdgcn_update_dpp(0, pre, 0x143, 0xc, 0xf, false);
        const int total = __builtin_amdgcn_readlane(pre, 63);
        const int above = total - pre;
        const int a3 = above, a2 = a3 + (int)h3, a1 = a2 + (int)h2, a0 = a1 + (int)h1;
        int dsel = -1, nk = 0, hs = 0;
        if (a3 < kk && kk <= a3 + (int)h3) { dsel = lane * 4 + 3; nk = kk - a3; hs = (int)h3; }
        else if (a2 < kk && kk <= a2 + (int)h2) { dsel = lane * 4 + 2; nk = kk - a2; hs = (int)h2; }
        else if (a1 < kk && kk <= a1 + (int)h1) { dsel = lane * 4 + 1; nk = kk - a1; hs = (int)h1; }
        else if (a0 < kk && kk <= a0 + (int)h0) { dsel = lane * 4 + 0; nk = kk - a0; hs = (int)h0; }
        const unsigned long long bal = __ballot(dsel >= 0);
        const int src = (int)__builtin_ctzll(bal);
        dsel = __builtin_amdgcn_readlane(dsel, src); nk = __builtin_amdgcn_readlane(nk, src); hsel = __builtin_amdgcn_readlane(hs, src);
        WAVE_LDS_FENCE();
        prefix = (prefix << 8) | (unsigned)dsel; kk = nk;
    }
    if (eqcnt) *eqcnt = hsel;
    T = prefix << (32 - 8 * npass); need = kk;
}
__device__ __forceinline__ void select_unit(Frame& F, int b, int qblk, int abl = 0) {
    using namespace att;
    int tid_ = F.tid; asm volatile("" : "+v"(tid_));
    const int lane = tid_ & 63, r32 = lane & 31, hi = lane >> 5, w = F.wave;
    LAS unsigned* sc = (LAS unsigned*)F.lds;
    LAS unsigned* hist = (LAS unsigned*)(F.lds + 131072) + w * 320;
    LAS unsigned* cand = (LAS unsigned*)(F.lds + 131072 + 10240) + w * 512;
    const int t0 = qblk * 8; const size_t m0 = (size_t)b * SEQ + t0;
    const bf16* IQ = (const bf16*)(F.ws + WS_ZKV) + (size_t)5 * M * 256; const bf16* MISC = (const bf16*)(F.ws + WS_ZKV) + (size_t)6 * M * 256;
    const bf16* IKF = (const bf16*)(F.ws + WS_IKF) + (size_t)b * SEQ * 64;
    u64* BM = (u64*)(F.ws + WS_BM);
    const int nkeys = t0 + 8;
    if (nkeys > 256 && abl < 2) {
        bf16x8 iqf[4];
        { const bf16* qrow = IQ + (m0 + (r32 >> 2)) * 256 + (r32 & 3) * 64;
#pragma unroll
          for (int d0 = 0; d0 < 4; ++d0) iqf[d0] = *(const GAS bf16x8*)(qrow + d0 * 16 + hi * 8); }
        const int ntile = (nkeys + 31) >> 5;
        bf16x8 kf[2][4];
#define SEL_ISSUE(dst, tl0) do { _Pragma("unroll") for (int u = 0; u < 2; ++u) { const int tile_ = (tl0) + 8 * u < ntile ? (tl0) + 8 * u : (tl0); \
            const bf16* kt_ = IKF + (size_t)tile_ * 2048 + hi * 256 + r32 * 8; _Pragma("unroll") for (int d0 = 0; d0 < 4; ++d0) dst[u][d0] = *(const GAS bf16x8*)(kt_ + d0 * 512); } } while (0)
        float wreg[16];
        { u64 wq[4];
#pragma unroll
          for (int gq = 0; gq < 4; ++gq) wq[gq] = *(const GAS u64*)(MISC + (m0 + 2 * gq + hi) * 256 + 64);
          if (w < ntile) SEL_ISSUE(kf, w);
          __builtin_amdgcn_sched_barrier(0);
#pragma unroll
          for (int gq = 0; gq < 4; ++gq) { const unsigned lo_ = (unsigned)wq[gq], hi_ = (unsigned)(wq[gq] >> 32);
              wreg[4 * gq + 0] = __uint_as_float(lo_ << 16); wreg[4 * gq + 1] = __uint_as_float(lo_ & 0xffff0000u); wreg[4 * gq + 2] = __uint_as_float(hi_ << 16); wreg[4 * gq + 3] = __uint_as_float(hi_ & 0xffff0000u); } }
#pragma unroll 1
        for (int tile0 = w; tile0 < ntile; tile0 += 16) {
            bf16x8 kn[2][4];
            { const int tn_ = tile0 + 16 < ntile ? tile0 + 16 : tile0; SEL_ISSUE(kn, tn_); }
            __builtin_amdgcn_sched_barrier(0);
#pragma unroll
            for (int u = 0; u < 2; ++u) { const int tile = tile0 + 8 * u;
                if (tile < ntile) {
                    const int s0 = tile * 32;
                    f32x16 acc;
#pragma unroll
                    for (int r = 0; r < 16; ++r) acc[r] = 0.f;
#pragma unroll
                    for (int d0 = 0; d0 < 4; ++d0) acc = __builtin_amdgcn_mfma_f32_32x32x16_bf16(iqf[d0], kf[u][d0], acc, 0, 0, 0);
#pragma unroll
                    for (int gq = 0; gq < 4; ++gq) { float sv = 0.f;
#pragma unroll
                        for (int h = 0; h < 4; ++h) { const int ai_ = __float_as_int(acc[4 * gq + h]); sv = fmaf(__int_as_float(ai_ > 0 ? ai_ : 0), wreg[4 * gq + h], sv); }
                        const unsigned u_ = __float_as_uint(sv);
                        sc[(2 * gq + hi) * 4096 + s0 + r32] = u_ ^ ((unsigned)((int)u_ >> 31) | 0x80000000u); }
                } }
            __builtin_amdgcn_sched_barrier(0);
#pragma unroll
            for (int u = 0; u < 2; ++u)
#pragma unroll
                for (int d0 = 0; d0 < 4; ++d0) kf[u][d0] = kn[u][d0];
        }
#undef SEL_ISSUE
    }
    __syncthreads();
    if (abl != 1) {
        const int t = t0 + w, n = t + 1; LAS unsigned* row = sc + w * 4096;
        u64 myword = 0ull;
        if (n <= 256) {
            const int c0 = 64 * lane;
            myword = (c0 + 63 < n) ? ~0ull : (c0 >= n ? 0ull : ((1ull << (n - c0)) - 1ull));
        } else {
            const int nblk = (n + 255) >> 8;
            { const int s = (n & ~3) + lane * 4;
              if (s < nblk * 256) { u32x4 v = *(LAS u32x4*)(row + s);
#pragma unroll
                  for (int c = 0; c < 4; ++c) if (s + c >= n) v[c] = 0u;
                  *(LAS u32x4*)(row + s) = v; } }
            WAVE_LDS_FENCE();
            unsigned T = 0u; int need = 0, E = -1; bool done = false;
            if (n > 512 && abl != 5) {
#pragma unroll
                for (int c = 0; c < 8; ++c) { const int i = lane + 64 * c; cand[i] = row[(i * n) >> 9]; }
                WAVE_LDS_FENCE();
                const float er = 131072.0f / (float)n;
                int rr = (int)(er + 2.5f * __builtin_sqrtf(er * (1.0f - 256.0f / (float)n)) + 2.0f); rr = rr > 512 ? 512 : rr;
                unsigned P; int dummy; radix_select_list(cand, 2, rr, hist, lane, P, dummy, 2); P -= 1u;
                int C = 0; bool ovf = false;
#pragma unroll 1
                for (int jb = 0; jb < nblk; ++jb) { const u32x4 v = *(LAS const u32x4*)(row + jb * 256 + lane * 4);
#pragma unroll
                    for (int c = 0; c < 4; ++c) { const bool in = v[c] > P; const u64 bal = __ballot(in); const int pos = C + __builtin_popcountll(bal & ((1ull << lane) - 1ull));
                        C += __builtin_popcountll(bal); if (C > 512) ovf = true;
                        LAS unsigned* dst_ = (in && !ovf) ? cand + pos : hist + 256 + lane;
                        *dst_ = v[c]; } }
                if (!ovf && C >= 256) {
                    WAVE_LDS_FENCE();
                    const int cb = (C + 255) >> 8;
                    { const int s = C + lane; if (s < cb * 256) cand[s] = 0u; const int s2 = s + 64; if (s2 < cb * 256) cand[s2] = 0u; const int s3 = s + 128; if (s3 < cb * 256) cand[s3] = 0u; const int s4 = s + 192; if (s4 < cb * 256) cand[s4] = 0u; }
                    WAVE_LDS_FENCE();
                    radix_select_list(cand, cb, 256, hist, lane, T, need, 4, &E); done = true;
                }
            }
            if (!done && abl < 3) radix_select_list(row, nblk, 256, hist, lane, T, need, 4, &E);
            int base = 0;
            int nch = abl >= 4 ? 0 : (n + 63) >> 6;
            if (need == E && nch > 0) {
                unsigned wlo = 0u, whi = 0u;
                const int nc4 = nblk * 4;
                unsigned vv[4], vn[4];
#pragma unroll
                for (int u2 = 0; u2 < 4; ++u2) vv[u2] = row[64 * u2 + lane];
#pragma unroll 1
                for (int c = 0; c < nc4; c += 4) {
                    const int cn = c + 4 < nc4 ? c + 4 : c;
#pragma unroll
                    for (int u2 = 0; u2 < 4; ++u2) vn[u2] = row[64 * (cn + u2) + lane];
#pragma unroll
                    for (int u2 = 0; u2 < 4; ++u2) { const u64 word = __ballot(vv[u2] >= T);
                        const unsigned w0 = (unsigned)word, w1 = (unsigned)(word >> 32); const int ln = c + u2;
                        unsigned m0s_; asm volatile("s_mov_b32 %2, m0\n\ts_mov_b32 m0, %5\n\ts_nop 0\n\tv_writelane_b32 %0, %3, m0\n\tv_writelane_b32 %1, %4, m0\n\ts_mov_b32 m0, %2" : "+v"(wlo), "+v"(whi), "=&s"(m0s_) : "s"(w0), "s"(w1), "s"(ln)); }
#pragma unroll
                    for (int u2 = 0; u2 < 4; ++u2) vv[u2] = vn[u2];
                }
                myword = (u64)wlo | ((u64)whi << 32);
                nch = 0;
            }
#pragma unroll 1
            for (int c = 0; c < nch; c += 4) {
                unsigned vv[4];
#pragma unroll
                for (int u2 = 0; u2 < 4; ++u2) vv[u2] = row[64 * (c + u2) + lane];
#pragma unroll
                for (int u2 = 0; u2 < 4; ++u2) {
                    const int s = 64 * (c + u2) + lane; const bool valid = s < n; const unsigned key = valid ? vv[u2] : 0u;
                    const bool gt = valid && key > T, eq = valid && key == T;
                    const u64 beq = __ballot(eq);
                    const int rank = base + __builtin_popcountll(beq & ((1ull << lane) - 1ull));
                    const u64 word = __ballot(gt || (eq && rank < need));
                    if (lane == c + u2) myword = word;
                    base += __builtin_popcountll(beq);
                }
            }
        }
        if (abl >= 2) ((GAS u64*)(F.ws + WS_MB + 24 * MiB))[((size_t)b * SEQ + t) * 64 + lane] = myword;
        else ((GAS u64*)BM)[((size_t)b * SEQ + t) * 64 + lane] = myword;
    }
    __syncthreads();
}
__device__ __forceinline__ void compress_unit(Frame& F, int l, int u) {
    using namespace att;
    int tid_ = F.tid; asm volatile("" : "+v"(tid_));
    const int lane = tid_ & 63, r32 = lane & 31, hi = lane >> 5, w = F.wave;
    const int which = u & 1, h = (u >> 1) & 1, b = (u >> 2) & 3, cb = u >> 4;
    const bf16* src = (const bf16*)(F.ws + (which ? WS_VC2 : WS_KC2)) + (size_t)(b * 2 + h) * SEQ * 64;
    const bf16* W1t = (const bf16*)(F.ws + WS_W + (size_t)l * W_LAYER + (which ? W_CV1 : W_CK1));
    const bf16* W2t = (const bf16*)(F.ws + WS_W2) + (size_t)(l * 2 + which) * 64 * 256;
    const float* b1p = (const float*)(F.ws + WS_B1P) + (size_t)(l * 2 + which) * 8 * 256;
    LAS bf16* hid = (LAS bf16*)F.lds;
    int cc = 32 * cb + r32; if (cc > 254) cc = 254;
    LAS char* aspan = (LAS char*)F.lds + 32768;
    const int tok0 = 512 * cb; const int npc = ((SEQ - tok0) < 528 ? (SEQ - tok0) : 528) * 8;
    const bf16* brow = W1t + (size_t)w * 65536 + hi * 256 + r32 * 8;
    float bp[8]; bf16x8 bcur[16];
    { u32x4 sv[9];
#pragma unroll
      for (int i = 0; i < 9; ++i) { const int pc = tid_ + 512 * i; const int pcl = pc < npc ? pc : npc - 1; sv[i] = *(const GAS u32x4*)(src + (size_t)tok0 * 64 + (size_t)pcl * 8); }
#pragma unroll
      for (int kp = 0; kp < 8; ++kp) bp[kp] = ((const GAS float*)b1p)[kp * 256 + 32 * w + r32];
#pragma unroll
      for (int i = 0; i < 16; ++i) bcur[i] = *(const GAS bf16x8*)(brow + i * 512);
      __builtin_amdgcn_sched_barrier(0);
#pragma unroll
      for (int i = 0; i < 9; ++i) { const int pc = tid_ + 512 * i; if (pc < npc) { const int tk = pc >> 3, c = pc & 7; *(LAS u32x4*)(aspan + tk * 128 + ((c ^ ((tk >> 4) & 7)) << 4)) = sv[i]; } } }
    __syncthreads();
    const int rtok = 16 * cc - tok0;
    f32x16 acc;
#pragma unroll
    for (int r = 0; r < 16; ++r) acc[r] = 0.f;
#pragma unroll 1
    for (int kb = 0; kb < 8; ++kb) {
        bf16x8 bnext[16];
        { const int kn = kb < 7 ? kb + 1 : kb;
#pragma unroll
          for (int i = 0; i < 16; ++i) bnext[i] = *(const GAS bf16x8*)(brow + (kn * 16 + i) * 512); }
        __builtin_amdgcn_sched_barrier(0);
#pragma unroll
        for (int hf = 0; hf < 2; ++hf) {
            bf16x8 af[8];
#pragma unroll
            for (int i = 0; i < 8; ++i) { const int ks = kb * 16 + hf * 8 + i; const int tk = rtok + (ks >> 2), c = ((ks & 3) << 1) + hi;
                af[i] = *(LAS const bf16x8*)(aspan + tk * 128 + ((c ^ ((tk >> 4) & 7)) << 4)); }
#pragma unroll
            for (int i = 0; i < 8; ++i) acc = __builtin_amdgcn_mfma_f32_32x32x16_bf16(af[i], bcur[hf * 8 + i], acc, 0, 0, 0);
        }
        __builtin_amdgcn_sched_barrier(0);
#pragma unroll
        for (int i = 0; i < 16; ++i) bcur[i] = bnext[i];
    }
    float b1 = 0.f;
#pragma unroll
    for (int kp = 0; kp < 8; ++kp) b1 += bp[kp];
    const bf16* w2row = W2t + (size_t)(32 * (w & 1) + r32) * 256 + hi * 8;
    bf16x8 bw[16];
    if (w < 2) {
#pragma unroll
        for (int ks = 0; ks < 16; ++ks) bw[ks] = *(const GAS bf16x8*)(w2row + ks * 16);
    }
    __builtin_amdgcn_sched_barrier(0);
#pragma unroll
    for (int r = 0; r < 16; ++r) hid[crow(r, hi) * 264 + 32 * w + r32] = (bf16)f2bf(fmaxf(acc[r] + b1, 0.f));
    __syncthreads();
    if (w < 2) {
        f32x16 o;
#pragma unroll
        for (int r = 0; r < 16; ++r) o[r] = 0.f;
#pragma unroll
        for (int ks = 0; ks < 16; ++ks) { const bf16x8 a = *(LAS const bf16x8*)(hid + r32 * 264 + ks * 16 + hi * 8); o = __builtin_amdgcn_mfma_f32_32x32x16_bf16(a, bw[ks], o, 0, 0, 0); }
        bf16* dst = (bf16*)(F.ws + WS_KCMP) + ((size_t)((which * 4 + b) * 2 + h) * 256) * 64;
        float mx = 0.f;
#pragma unroll
        for (int r = 0; r < 16; ++r) { const int c = 32 * cb + crow(r, hi); const float v = c < 255 ? o[r] : 0.f; mx = fmaxf(mx, fabsf(v)); ((GAS bf16*)dst)[(size_t)c * 64 + 32 * w + r32] = (bf16)f2bf(v); }
        if (which == 0) { mx = wave_max(mx); if (lane == 0) __hip_atomic_fetch_max(F.ctl + CW_KMAX + 64 * (l * 8 + b * 2 + h), __float_as_uint(mx), RLX_AGENT); }
    }
    __syncthreads();
}
__device__ __forceinline__ void misc_phase(Frame& F, int l, int mode = 0) {
    using namespace att;
    int tid_ = F.tid; asm volatile("" : "+v"(tid_));
    const int lane = tid_ & 63, r32 = lane & 31, hi = lane >> 5, w = F.wave;
    if (w >= 6) return;
    const int task = (int)blockIdx.x * 6 + w, tile = task / 3, cb = task % 3;
    const bf16* arow = (const bf16*)(F.ws + WS_XB) + (size_t)(tile * 32 + r32) * 1024 + hi * 32;
    const bf16* brow = (const bf16*)(F.ws + WS_W + (size_t)l * W_LAYER + W_IN) + (size_t)(3072 + cb * 32 + r32) * 1024 + hi * 32;
    f32x16 acc;
#pragma unroll
    for (int r = 0; r < 16; ++r) acc[r] = 0.f;
#pragma unroll 1
    for (int it = 0; it < (mode == 1 ? 0 : 4); ++it) { const int lb = (it + w + (int)blockIdx.x) & 3;
        bf16x8 af[16], bfr[16];
#pragma unroll
        for (int i = 0; i < 16; ++i) { af[i] = *(const GAS bf16x8*)(arow + lb * 256 + (i >> 2) * 64 + (i & 3) * 8); bfr[i] = *(const GAS bf16x8*)(brow + lb * 256 + (i >> 2) * 64 + (i & 3) * 8); }
        __builtin_amdgcn_sched_barrier(0);
#pragma unroll
        for (int i = 0; i < 16; ++i) acc = __builtin_amdgcn_mfma_f32_32x32x16_bf16(af[i], bfr[i], acc, 0, 0, 0);
        __builtin_amdgcn_sched_barrier(0);
    }
    const float rv = pg8::row_rstd((const float*)(F.ws + WS_SSQ), tile * 32 + r32);
    bf16* dst = (bf16*)(F.ws + (mode ? WS_MB + 24 * MiB : WS_ZKV + (size_t)6 * M * 256 * 2)) + (size_t)(tile * 32) * 256 + cb * 32;
    LAS unsigned short* tp = (LAS unsigned short*)(F.lds + w * 4096);
#pragma unroll
    for (int r = 0; r < 16; ++r) { const int row = crow(r, hi); const float rs = __shfl(rv, row); tp[row * 40 + r32] = (unsigned short)f2bf(acc[r] * rs); }
    WAVE_LDS_FENCE();
#pragma unroll
    for (int u = 0; u < 2; ++u) { const int pc = lane + 64 * u, row = pc >> 2, q = pc & 3;
        const u32x4 v = *(LAS const u32x4*)(tp + row * 40 + q * 8);
        *(GAS u32x4*)(dst + (size_t)row * 256 + q * 8) = v; }
    WAVE_LDS_FENCE();
}
struct UnitGeom { int b, kvh, i; att::Lane L; int q; int head; size_t mrow; };
__device__ __forceinline__ UnitGeom unit_geom(Frame& F, int b, int kvh, int i) {
    int tid = F.tid; asm volatile("" : "+v"(tid));
    UnitGeom U; U.b = b; U.kvh = kvh; U.i = i; U.L.tid = tid; U.L.lane = tid & 63; U.L.r32 = tid & 31; U.L.hi = (tid >> 5) & 1; U.L.wid = F.wave;
    U.q = 64 * i + 8 * F.wave + (U.L.r32 >> 2); U.head = 4 * kvh + (U.L.r32 & 3); U.mrow = (size_t)b * SEQ + U.q; return U;
}
__device__ __forceinline__ void branch_finish(LAS float* wsf, const att::f32x16& ol, const float (&extra)[4], float rowscale, bool has_scale, const att::f32x16 (&o)[2], att::f32x16 (&acc)[2], const att::Lane& L, bool first) {
    float sc[16];
    if (has_scale) att::rows_to_regs(wsf, rowscale, L.r32, L.hi, sc);
#pragma unroll
    for (int r = 0; r < 16; ++r) { const float lf = ol[r] + extra[r & 3]; const float inv = lf > 0.f ? __builtin_amdgcn_rcpf(lf) : 0.f; sc[r] = has_scale ? sc[r] * inv : inv; }
#pragma unroll
    for (int d0 = 0; d0 < 2; ++d0)
#pragma unroll
        for (int r = 0; r < 16; ++r) acc[d0][r] = first ? o[d0][r] * sc[r] : acc[d0][r] + o[d0][r] * sc[r];
}
__device__ __forceinline__ void branch_finish_lds(LAS float* wsf, LAS float* accw, const att::f32x16& ol, float rowscale, const att::f32x16 (&o)[2], const att::Lane& L, bool first) {
    float sc[16]; att::rows_to_regs(wsf, rowscale, L.r32, L.hi, sc);
#pragma unroll
    for (int r = 0; r < 16; ++r) sc[r] = ol[r] > 0.f ? sc[r] * __builtin_amdgcn_rcpf(ol[r]) : 0.f;
#pragma unroll
    for (int d0 = 0; d0 < 2; ++d0)
#pragma unroll
        for (int r = 0; r < 16; ++r) { float v = o[d0][r] * sc[r]; if (!first) v += accw[(d0 * 16 + r) * 64 + L.lane]; accw[(d0 * 16 + r) * 64 + L.lane] = v; }
}
__device__ __forceinline__ float gain_bound(const float* g, int lane) { return wave_max(fabsf(g[lane])); }

template <int KIND  >
__device__ __forceinline__ void simple_unit(Frame& F, int l, int b, int kvh, int i, bf16* odst = nullptr) {
    using namespace att;
    const UnitGeom U = unit_geom(F, b, kvh, i); const Lane& L = U.L;
    constexpr int QT = KIND == 0 ? 1 : 0, KT = KIND == 0 ? 1 : 0, NM = KIND == 0 ? 1 : 0;
    bf16* Q = (bf16*)(F.ws + WS_ZQ) + (size_t)QT * M * 512; const bf16* KV = (const bf16*)(F.ws + WS_ZKV) + (size_t)KT * M * 256;
    bf16x8 qr[4]; load_q(Q + U.mrow * 512 + U.head * 64, L.hi, qr);
    const float C = 0.f; (void)NM;
    KVSrc S{(const GAS bf16*)(KV + (size_t)b * SEQ * 256 + kvh * 64), (const GAS bf16*)(KV + (size_t)b * SEQ * 256 + 128 + kvh * 64), 256, SEQ};
    f32x16 ol, o[2];
#pragma unroll
    for (int r = 0; r < 16; ++r) { o[0][r] = 0.f; o[1][r] = 0.f; ol[r] = 0.f; }
    const int q = U.q;
    if (KIND == 0) {
        auto mf = [q](int t) -> u64 { return mask_le(q - 64 * t) & mask_ge(q - 127 - 64 * t); };
        attend_range((LAS char*)F.lds, S, i - 2 < 0 ? 0 : i - 2, i + 1, mf, qr, -C, ol, o, L);
    } else {
        LAS char* mrows = (LAS char*)F.lds + L_OST + L.wid * 8192 + 4096;
        { const GAS u32x4* src = (const GAS u32x4*)((const GAS u64*)(F.ws + WS_BM) + ((size_t)b * SEQ + 64 * i + 8 * L.wid) * 64);
#pragma unroll
          for (int k = 0; k < 4; ++k) *(LAS u32x4*)(mrows + (k * 64 + L.lane) * 16) = src[k * 64 + L.lane];
          WAVE_LDS_FENCE(); }
        LAS const char* mrow = mrows + (L.r32 >> 2) * 512;
        auto mf = [mrow](int t) -> u64 { return *(LAS const u64*)(mrow + t * 8); };
#ifdef PROBE_TILES
        attend_range((LAS char*)F.lds, S, 0, odst ? (i + 1 < PROBE_TILES ? i + 1 : PROBE_TILES) : i + 1, mf, qr, -C, ol, o, L, odst != nullptr);
#else
        attend_range((LAS char*)F.lds, S, 0, i + 1, mf, qr, -C, ol, o, L, odst != nullptr);
#endif
    }
    const UnitGeom V = unit_geom(F, b, kvh, i); const Lane& L2 = V.L;
    float extra[4] = {0.f, 0.f, 0.f, 0.f};
    if (KIND == 0) {
#pragma unroll
        for (int g = 0; g < 4; ++g) extra[g] = __builtin_amdgcn_exp2f(F.a->in[5][l * 8 + 4 * kvh + g] * LOG2E);
    }
    f32x16 acc[2];
    branch_finish((LAS float*)((LAS char*)F.lds + L_WSF) + L2.wid * WSF_W, ol, extra, 1.f, false, o, acc, L2, true);
    bf16* Q2 = (bf16*)(F.ws + WS_ZQ) + (size_t)QT * M * 512;
    const size_t tok0 = (size_t)b * SEQ + 64 * i + 8 * L2.wid; const int kvh4 = 4 * kvh;
    bf16* Od = odst ? odst : Q2;
    auto rowptr = [Od, tok0, kvh4](int row) -> bf16* { return Od + (tok0 + (row >> 2)) * 512 + (kvh4 + (row & 3)) * 64; };
    store_o((LAS char*)F.lds + L_OST + L2.wid * 8192, acc, rowptr, L2.lane, L2.r32, L2.hi);
}
__device__ __forceinline__ void nsa_unit(Frame& F, int l, int b, int kvh, int i, bf16* odst = nullptr) {
    using namespace att;
    f32x16 o[2], ol;
    bf16x8 qr[4];
    {
        const UnitGeom U = unit_geom(F, b, kvh, i); const Lane& L = U.L;
        const bf16* Q = (const bf16*)(F.ws + WS_ZQ) + (size_t)2 * M * 512; const bf16* MISC = (const bf16*)(F.ws + WS_ZKV) + (size_t)6 * M * 256;
        load_q(Q + U.mrow * 512 + U.head * 64, L.hi, qr);
        LAS float* wsf = (LAS float*)((LAS char*)F.lds + L_WSF) + L.wid * WSF_W;
#pragma unroll
        for (int br = 0; br < 3; ++br) wsf[64 + br * 64 + L.lane] = pg8::sigmoidf_(bf2f(((const GAS bf16*)MISC)[U.mrow * 256 + 68 + U.head * 3 + br]));
        WAVE_LDS_FENCE();
    }
    const float Ck = 0.f, Cc = 0.f;
    const int qmax = 64 * i + 63; const int nvmax = qmax >= 31 ? (((qmax - 31) >> 4) + 1 < 255 ? ((qmax - 31) >> 4) + 1 : 255) : 0;
    const int tc = (nvmax + 63) >> 6;
    const bf16* kcmp = (const bf16*)(F.ws + WS_KCMP) + (size_t)((0 * 4 + b) * 2 + kvh) * 256 * 64; const bf16* vcmp = (const bf16*)(F.ws + WS_KCMP) + (size_t)((1 * 4 + b) * 2 + kvh) * 256 * 64;
    {
        const UnitGeom U = unit_geom(F, b, kvh, i); const Lane& L = U.L; const int q = U.q;
        const int nval = q >= 31 ? (((q - 31) >> 4) + 1 < 255 ? ((q - 31) >> 4) + 1 : 255) : 0;
        KVSrc Sc{(const GAS bf16*)kcmp, (const GAS bf16*)vcmp, 64, 256};
        auto mfc = [nval](int t) -> u64 { return mask_le(nval - 1 - 64 * t); };
#pragma unroll
        for (int r = 0; r < 16; ++r) { o[0][r] = 0.f; o[1][r] = 0.f; ol[r] = 0.f; }
        attend_range((LAS char*)F.lds, Sc, 0, tc, mfc, qr, -Cc, ol, o, L);
    }
    const UnitGeom U = unit_geom(F, b, kvh, i); const Lane& L = U.L; const int q = U.q;
    LAS float* wsf = (LAS float*)((LAS char*)F.lds + L_WSF) + L.wid * WSF_W;
    LAS float* accw = (LAS float*)((LAS char*)F.lds + L_OST + L.wid * 8192);
    const int nval = q >= 31 ? (((q - 31) >> 4) + 1 < 255 ? ((q - 31) >> 4) + 1 : 255) : 0;
    auto mfc = [nval](int t) -> u64 { return mask_le(nval - 1 - 64 * t); };
    WAVE_LDS_FENCE();
    if (L.r32 == 0) {
#pragma unroll
        for (int r = 0; r < 16; ++r) wsf[32 + crow(r, L.hi)] = ol[r]; }
    WAVE_LDS_FENCE();
    const float lc = wsf[32 + L.r32]; const float rlc = lc > 0.f ? __builtin_amdgcn_rcpf(lc) : 0.f;
    branch_finish_lds(wsf, accw, ol, wsf[64 + L.lane], o, L, true);
    LAS float* impw = (LAS float*)((LAS char*)F.lds + L_IMP) + L.wid * 512;
#pragma unroll
    for (int k = 0; k < 8; ++k) impw[L.lane + 64 * k] = 0.f;
    WAVE_LDS_FENCE();
    for (int t = 0; t < tc; ++t) {
        f32x16 p0, p1;
#pragma unroll
        for (int r = 0; r < 16; ++r) { p0[r] = 0.f; p1[r] = 0.f; }
        qk_tile((LAS char*)F.lds + L_K0 + t * 8320, qr, p0, p1, L.r32, L.hi);
        const u64 mk = mfc(t); const unsigned m0 = (unsigned)(mk >> (4 * L.hi)), m1 = (unsigned)(mk >> (32 + 4 * L.hi));
        const int qloc = L.r32 >> 2; const bool wr = (L.r32 & 3) == 0;
#pragma unroll
        for (int half = 0; half < 2; ++half)
#pragma unroll
            for (int m = 0; m < 4; ++m) {
                float e[4];
#pragma unroll
                for (int k = 0; k < 4; ++k) { const int r = 4 * m + k, bit = k + 8 * m; const float x = half ? p1[r] : p0[r]; const unsigned mm = half ? m1 : m0;
                    e[k] = ((mm >> bit) & 1u) ? __builtin_amdgcn_exp2f(x) * rlc : 0.f; }
                const float core = dpp_quad_sum((e[0] + e[1]) + (e[2] + e[3])), edge = dpp_quad_sum(e[3]);
                const int j = 16 * t + 8 * half + 2 * m + L.hi;
                if (wr) { impw[qloc * 64 + j] += core; }
                WAVE_LDS_FENCE();
                if (wr && j + 1 < 64) { impw[qloc * 64 + j + 1] += edge; }
                WAVE_LDS_FENCE();
            }
    }
    __syncthreads();
    {
        const int qloc = L.lane >> 3, sub = L.lane & 7; const int cur = i;
        u64 keys[8];
#pragma unroll
        for (int k = 0; k < 8; ++k) { const int j = sub + 8 * k; float v = impw[qloc * 64 + j];
            if (j == 0 || j == cur || j == cur - 1) v = 1e9f;
            if (j > cur) v = -1e30f;
            keys[k] = ((u64)f2key(v) << 32) | (u64)(63 - j); }
        __syncthreads();
        u64 selm = 0ull; unsigned used = 0u;
#pragma unroll 1
        for (int it = 0; it < 16; ++it) {
            u64 best = 0ull;
#pragma unroll
            for (int k = 0; k < 8; ++k) { const u64 c = ((used >> k) & 1u) ? 0ull : keys[k]; best = c > best ? c : best; }
#define NSA_DPP_MAX(ctrl) do { const unsigned lo_ = (unsigned)__builtin_amdgcn_update_dpp(0, (int)(unsigned)best, ctrl, 0xf, 0xf, true), hi_ = (unsigned)__builtin_amdgcn_update_dpp(0, (int)(unsigned)(best >> 32), ctrl, 0xf, 0xf, true); \
                const u64 ob_ = ((u64)hi_ << 32) | lo_; best = ob_ > best ? ob_ : best; } while (0)
            NSA_DPP_MAX(0xB1); NSA_DPP_MAX(0x4E); NSA_DPP_MAX(0x141);
#undef NSA_DPP_MAX
            const int jsel = 63 - (int)(best & 63ull);
            if ((jsel & 7) == sub) used |= 1u << (jsel >> 3);
            selm |= 1ull << jsel;
        }
        LAS u64* selw = (LAS u64*)((LAS char*)F.lds + L_SEL) + L.wid * 8;
        if (sub == 0) selw[qloc] = selm;
        WAVE_LDS_FENCE();
    }
    {
        const UnitGeom X = unit_geom(F, b, kvh, i); const Lane& L = X.L; const int q = X.q;
        const u64 sel = ((LAS const u64*)((LAS char*)F.lds + L_SEL))[L.wid * 8 + (L.r32 >> 2)];
        const bf16* KV = (const bf16*)(F.ws + WS_ZKV) + (size_t)3 * M * 256;
        KVSrc S{(const GAS bf16*)(KV + (size_t)b * SEQ * 256 + kvh * 64), (const GAS bf16*)(KV + (size_t)b * SEQ * 256 + 128 + kvh * 64), 256, SEQ};
        auto mf = [sel, q](int t) -> u64 { return ((sel >> t) & 1ull) ? mask_le(q - 64 * t) : 0ull; };
#pragma unroll
        for (int r = 0; r < 16; ++r) { o[0][r] = 0.f; o[1][r] = 0.f; ol[r] = 0.f; }
        attend_range((LAS char*)F.lds, S, 0, i + 1, mf, qr, -Ck, ol, o, L);
        const UnitGeom W = unit_geom(F, b, kvh, i); LAS float* wsf2 = (LAS float*)((LAS char*)F.lds + L_WSF) + W.L.wid * WSF_W;
        branch_finish_lds(wsf2, (LAS float*)((LAS char*)F.lds + L_OST + W.L.wid * 8192), ol, wsf2[128 + W.L.lane], o, W.L, false);
    }
    {
        const UnitGeom X = unit_geom(F, b, kvh, i); const Lane& L = X.L; const int q = X.q;
        const bf16* KV = (const bf16*)(F.ws + WS_ZKV) + (size_t)4 * M * 256;
        KVSrc S{(const GAS bf16*)(KV + (size_t)b * SEQ * 256 + kvh * 64), (const GAS bf16*)(KV + (size_t)b * SEQ * 256 + 128 + kvh * 64), 256, SEQ};
        auto mf = [q](int t) -> u64 { return mask_le(q - 64 * t) & mask_ge(q - 511 - 64 * t); };
#pragma unroll
        for (int r = 0; r < 16; ++r) { o[0][r] = 0.f; o[1][r] = 0.f; ol[r] = 0.f; }
        attend_range((LAS char*)F.lds, S, i - 8 < 0 ? 0 : i - 8, i + 1, mf, qr, -Ck, ol, o, L);
        const UnitGeom W = unit_geom(F, b, kvh, i); LAS float* wsf2 = (LAS float*)((LAS char*)F.lds + L_WSF) + W.L.wid * WSF_W;
        branch_finish_lds(wsf2, (LAS float*)((LAS char*)F.lds + L_OST + W.L.wid * 8192), ol, wsf2[192 + W.L.lane], o, W.L, false);
    }
    {
        const UnitGeom X = unit_geom(F, b, kvh, i); const Lane& L = X.L;
        LAS float* accw2 = (LAS float*)((LAS char*)F.lds + L_OST + L.wid * 8192);
        const size_t tok0 = (size_t)b * SEQ + 64 * i + 8 * L.wid; const int kvh4 = 4 * kvh;
        bf16* Od = odst ? odst : (bf16*)(F.ws + WS_ZQ) + (size_t)2 * M * 512;
        auto rowptr = [Od, tok0, kvh4](int row) -> bf16* { return Od + (tok0 + (row >> 2)) * 512 + (kvh4 + (row & 3)) * 64; };
        f32x16 acc[2];
#pragma unroll
        for (int d0 = 0; d0 < 2; ++d0)
#pragma unroll
            for (int r = 0; r < 16; ++r) acc[d0][r] = accw2[(d0 * 16 + r) * 64 + L.lane];
        WAVE_LDS_FENCE();
        store_o((LAS char*)F.lds + L_OST + L.wid * 8192, acc, rowptr, L.lane, L.r32, L.hi);
    }
}

__global__ void __launch_bounds__(NWAVES * 64, 2) mk_fwd(Args args) {
    extern __shared__ __attribute__((aligned(16))) unsigned char lds_raw[];
    LAS unsigned char* lds = (LAS unsigned char*)lds_raw;
    volatile LAS unsigned* MISCW = (volatile LAS unsigned*)(lds + LDS_UNIT + 16);
    if (threadIdx.x < 8) MISCW[threadIdx.x] = 0u;
    __syncthreads();
    (void)xcd_barrier_post((unsigned*)((gu32*)(args.ws + WS_CTL) + CW_BAR), MISCW);
#define GRID_BARRIER() do { unsigned char* wsb_ = args.ws; asm volatile("" : "+s"(wsb_)); XcdBarrier bar_; bar_.bar = (unsigned*)((gu32*)(wsb_ + WS_CTL) + CW_BAR); bar_.x = xb_xcc_id(); \
    bar_.st = (volatile LAS unsigned*)(lds + LDS_UNIT + 16); xcd_barrier(bar_); } while (0)
#define MKFRAME() Frame F; { unsigned char* ws_ = args.ws; asm volatile("" : "+s"(ws_)); int tid_ = threadIdx.x; asm volatile("" : "+v"(tid_)); \
    F.lds = lds; F.tid = tid_; F.lane = tid_ & 63; F.wave = __builtin_amdgcn_readfirstlane(tid_ >> 6); F.G = gridDim.x; F.gw = 0; F.NGW = F.G * NWAVES; \
    F.ws = ws_; F.ctl = (gu32*)(ws_ + WS_CTL); F.a = &args; } int bid = blockIdx.x; asm volatile("" : "+s"(bid)); F.gw = bid * NWAVES + F.wave; \
    unsigned char* ws = F.ws; bf16* XB = (bf16*)(ws + WS_XB); bf16* MB = (bf16*)(ws + WS_MB); bf16* ZQ = (bf16*)(ws + WS_ZQ); bf16* ZKV = (bf16*)(ws + WS_ZKV); bf16* YS = (bf16*)(ws + WS_YS); bf16* HM = (bf16*)(ws + WS_HMID); \
    float* SSQ = (float*)(ws + WS_SSQ); (void)XB; (void)MB; (void)ZQ; (void)ZKV; (void)YS; (void)HM; (void)SSQ;
#define WL(l) (ws + WS_W + (size_t)(l) * W_LAYER)
#ifdef PROBE_T
#define STAMP(k) do { if (blockIdx.x == 0 && threadIdx.x == 0) ((unsigned long long*)(args.ws + WS_CTL + 96 * 1024))[k] = __builtin_amdgcn_s_memrealtime(); } while (0)
#else
#define STAMP(k) do { } while (0)
#endif

    STAMP(0);
#ifndef NO_P0
    { MKFRAME(); p0_prologue(F); }
#ifdef DBL_P0
    { MKFRAME(); p0_prologue(F); }
#endif
#endif
    GRID_BARRIER();
    STAMP(1);
#pragma unroll 1
    for (int l = 0; l < DEPTH; ++l) {
#ifndef NO_G1
#ifdef DBL_G1
        for (int rep_ = 0; rep_ < 2; ++rep_)
#endif
        {
            MKFRAME(); unsigned char* wl = WL(l);
            pg8::ProgG1 P; P.S.init(M, 3072, F.G, bid); P.spm = (bid & 7) * 8 + (bid >> 5); P.skq = (bid >> 3) & 3;
            P.xb = XB; P.win = (const bf16*)(wl + W_IN); P.zq = ZQ; P.zkv = ZKV; P.ssq = SSQ; P.part = (float*)(ws + WS_PART);
            pg8::gemm_chain<pg8::ProgG1, true>(F.lds, P);
        }
#endif
        GRID_BARRIER();
        STAMP(2 + 8 * l);
#ifndef NO_POST
        { MKFRAME(); post_phase(F, l); }
#ifdef DBL_POST
        { MKFRAME(); post_phase(F, l, true); }
#endif
#endif
        GRID_BARRIER();
        STAMP(3 + 8 * l);
#ifdef DBL_ATT1
        for (int rep1_ = 0; rep1_ < 2; ++rep1_)
#else
        const int rep1_ = 0;
#endif
        {
            MKFRAME();
            const int xcd = (int)(xb_xcc_id() & 7u);
            int wm = 0xff;
#pragma unroll 1
            for (int qi = 0; qi < 8; ++qi) {
                const int x = (xcd + qi) & 7, b = x >> 1, sub = x & 1;
                if (qi == 1) wm = work_mask(F, F.ctl + CW_Q + 64 * ((2 * l + 4 * rep1_) * 8), 16 + 256 + 64);
                if (qi >= 1 && !((wm >> x) & 1)) continue;
                gu32* ctr = F.ctl + CW_Q + 64 * ((2 * l + 4 * rep1_) * 8 + x);
                for (;;) { const int v0_ = next_unit(F, ctr, 2); if (v0_ >= 16 + 256 + 64) break;
#pragma unroll 1
                  for (int v = v0_; v < v0_ + 2; ++v) { if (v >= 16 + 256 + 64) break;
#ifdef DBL_ATT1
                    if (v < 16) { if (rep1_ == 0 || DBL_ATT1 == 1 || DBL_ATT1 == 2) compress_unit(F, l, (v & 1) | (sub << 1) | (b << 2) | ((v >> 1) << 4)); }
                    else if (v < 16 + 256) { if (rep1_ == 0 || DBL_ATT1 == 1 || DBL_ATT1 == 3 || DBL_ATT1 >= 5) select_unit(F, b, 2 * (255 - (v - 16)) + sub, rep1_ ? (DBL_ATT1 >= 5 ? DBL_ATT1 - 4 : 0) : 0  ); }
                    else if (rep1_ && DBL_ATT1 != 1 && DBL_ATT1 != 4) { }
#else
                    if (v < 16) { compress_unit(F, l, (v & 1) | (sub << 1) | (b << 2) | ((v >> 1) << 4)); }
                    else if (v < 16 + 256) { select_unit(F, b, 2 * (255 - (v - 16)) + sub); }
#endif
                    else { simple_unit<0>(F, l, b, sub, 63 - (v - 272), rep1_ ? (bf16*)(ws + WS_MB + 8 * MiB) : nullptr); }
                  }
                }
            }
        }
        GRID_BARRIER();
        STAMP(4 + 8 * l);
#ifdef DBL_ATT2
        for (int rep_ = 0; rep_ < 2; ++rep_)
#else
        const int rep_ = 0;
#endif
        {
#ifdef DBL_ATT2_BAR
            if (rep_ == 1) GRID_BARRIER();
#endif
            MKFRAME();
            bf16* od = rep_ ? (bf16*)(ws + WS_MB) : nullptr;
            const int xcd = (int)(xb_xcc_id() & 7u);
            int wm = 0xff;
#pragma unroll 1
            for (int qi = 0; qi < 8; ++qi) {
                const int x = (xcd + qi) & 7, b = x >> 1, kvh = x & 1;
                if (qi == 1) wm = work_mask(F, F.ctl + CW_Q + 64 * ((2 * l + 1 + 4 * rep_) * 8), 128);
                if (qi >= 1 && !((wm >> x) & 1)) continue;
                gu32* ctr = F.ctl + CW_Q + 64 * ((2 * l + 1 + 4 * rep_) * 8 + x);
                for (;;) { const int v0_ = next_unit(F, ctr, 2); if (v0_ >= 128) break;
#pragma unroll 1
                  for (int v = v0_; v < v0_ + 2; ++v) {
                    const int i = 63 - (v >> 1);
#ifdef DBL_ATT2
                    if ((v & 1) && (rep_ == 0 || DBL_ATT2 != 3)) simple_unit<1>(F, l, b, kvh, i, od);
                    if (!(v & 1) && (rep_ == 0 || DBL_ATT2 != 2)) nsa_unit(F, l, b, kvh, i, od);
#else
                    if (v & 1) simple_unit<1>(F, l, b, kvh, i, od); else nsa_unit(F, l, b, kvh, i, od);
#endif
                  }
                }
            }
        }
        GRID_BARRIER();
        STAMP(5 + 8 * l);
#ifndef NO_G2
#ifdef DBL_G2
        for (int rep_ = 0; rep_ < 2; ++rep_)
#endif
        {   MKFRAME(); unsigned char* wl = WL(l);
            pg8::StaticOrder S; S.init(M, DM, F.G, bid); pg8::Unit u0; S.next(0, u0);
            pg8::ProgG2 P{u0.pm, u0.pn, ZQ, (const bf16*)(wl + W_BR), XB, (const bf16*)(wl + W_G), YS, MB, SSQ};
            pg8::gemm_chain<pg8::ProgG2, true>(F.lds, P); }
#endif
        GRID_BARRIER();
        STAMP(6 + 8 * l);
#ifndef NO_G3
        {
            MKFRAME(); unsigned char* wl = WL(l);
            pg8::Gemm g{MB, (const bf16*)(wl + W_OUT), M, DM, DM}; pg8::StaticOrder S; S.init(M, DM, F.G, bid);
            pg8::EpiRes E{nullptr, XB, SSQ};
            pg8::gemm_phase<pg8::EpiRes, pg8::StaticOrder, false, true>(F.lds, g, S, E);
        }
#ifdef DBL_G3
        {   MKFRAME(); unsigned char* wl = WL(l);
            pg8::Gemm g{MB, (const bf16*)(wl + W_OUT), M, DM, DM}; pg8::StaticOrder S; S.init(M, DM, F.G, bid);
            pg8::EpiRes E{nullptr, (bf16*)(ws + 64 * MiB), (float*)(ws + 96 * MiB)};
            pg8::gemm_phase<pg8::EpiRes, pg8::StaticOrder, false, true>(F.lds, g, S, E);
        }
#endif
#endif
        GRID_BARRIER();
        STAMP(7 + 8 * l);
#ifndef NO_G4
#ifdef DBL_G4
        for (int rep_ = 0; rep_ < 2; ++rep_)
#endif
        {
            MKFRAME(); unsigned char* wl = WL(l);
            pg8::Gemm g{XB, (const bf16*)(wl + W_UP), M, DFF, DM}; pg8::StaticOrder S; S.init(M, DFF, F.G, bid);
            pg8::EpiG4 E{HM, SSQ};
            pg8::gemm_phase<pg8::EpiG4, pg8::StaticOrder, true, true>(F.lds, g, S, E);
        }
#endif
        GRID_BARRIER();
        STAMP(8 + 8 * l);
#ifndef NO_G5
        {
            MKFRAME(); unsigned char* wl = WL(l);
            pg8::Gemm g{HM, (const bf16*)(wl + W_DN), M, DM, DFF}; pg8::StaticOrder S; S.init(M, DM, F.G, bid);
            pg8::EpiRes E{l + 1 == DEPTH ? F.a->out : nullptr, XB, SSQ};
            pg8::gemm_phase<pg8::EpiRes, pg8::StaticOrder, false, true>(F.lds, g, S, E);
        }
#ifdef DBL_G5
        {   MKFRAME(); unsigned char* wl = WL(l);
            pg8::Gemm g{HM, (const bf16*)(wl + W_DN), M, DM, DFF}; pg8::StaticOrder S; S.init(M, DM, F.G, bid);
            pg8::EpiNull E{};
            pg8::gemm_phase<pg8::EpiNull, pg8::StaticOrder, false, true>(F.lds, g, S, E);
        }
#endif
#endif
#ifdef PROBE_T
        GRID_BARRIER();
        STAMP(9 + 8 * l);
#else
        if (l + 1 < DEPTH) GRID_BARRIER();
#endif
#ifdef DBL_BAR
        for (int rep_ = 0; rep_ < 16; ++rep_) GRID_BARRIER();
#endif
    }
#ifdef PROBE_T
    {
        GRID_BARRIER();
        const unsigned long long* st = (const unsigned long long*)(args.ws + WS_CTL + 96 * 1024);
        float tus;
        if (PROBE_T == 0) tus = (float)(st[1] - st[0]) * 0.01f;
        else tus = 0.5f * ((float)(st[PROBE_T + 1] - st[PROBE_T]) + (float)(st[PROBE_T + 9] - st[PROBE_T + 8])) * 0.01f;
        const float sc = 1.0f + tus * 0.001f;
        float* o = args.out;
        for (size_t i = (size_t)blockIdx.x * 512 + threadIdx.x; i < (size_t)M * DM; i += (size_t)gridDim.x * 512) o[i] *= sc;
    }
#endif
}

extern "C" void kernel_launch(void* const* d_in, const int* in_sizes, int n_in, void* d_out, int out_size, void* d_ws, size_t ws_size, hipStream_t stream) {
    static int grid = 0;
    if (grid == 0) {
        if (n_in != 17 || out_size != M * DM || ws_size < WS_END) { fprintf(stderr, "kernel_launch: unexpected problem shape (n_in %d out %d ws %zu)\n", n_in, out_size, ws_size); grid = -1; return; }
        int dev = 0, cus = 0, per_cu = 0;
        if (hipGetDevice(&dev) != hipSuccess || hipDeviceGetAttribute(&cus, hipDeviceAttributeMultiprocessorCount, dev) != hipSuccess) { grid = -1; return; }
        if (hipFuncSetAttribute((const void*)mk_fwd, hipFuncAttributeMaxDynamicSharedMemorySize, LDS_BYTES) != hipSuccess) { fprintf(stderr, "kernel_launch: hipFuncSetAttribute failed\n"); grid = -1; return; }
        if (hipOccupancyMaxActiveBlocksPerMultiprocessor(&per_cu, (const void*)mk_fwd, NWAVES * 64, LDS_BYTES) != hipSuccess || per_cu < 1) { fprintf(stderr, "kernel_launch: occupancy query says %d blocks/CU\n", per_cu); }
        (void)hipGetLastError();
        if (cus != 256) { fprintf(stderr, "kernel_launch: built for a 256-CU device (one 256x256 GEMM unit per workgroup in the N=1024 phases), found %d CUs\n", cus); grid = -1; return; }
        grid = cus;
    }
    if (grid < 0) return;
    (void)hipMemsetAsync((char*)d_ws + WS_CTL, 0, CTL_BYTES, stream);
    Args a{};
    for (int i = 0; i < 17; ++i) a.in[i] = (const float*)d_in[i];
    a.out = (float*)d_out; a.ws = (unsigned char*)d_ws;
    hipLaunchKernelGGL(mk_fwd, dim3(grid), dim3(NWAVES * 64), LDS_BYTES, stream, a);
}
```
